# Optimizing an MI355X kernel written in HIP

```python
import jax, jax.numpy as jnp
from jax import lax
import numpy as np

D_MODEL = 1024
BATCH = 2
SEQ = 16384
DEPTH = 4

N_MIXERS = 2
HEAD_DIM = 64
NSA_HEADS = D_MODEL // HEAD_DIM
NSA_KV_GROUPS = 4
NSA_HEADS_PER_GROUP = NSA_HEADS // NSA_KV_GROUPS
CMP_BLOCK = 32
CMP_STRIDE = 16
CMP_HIDDEN = 256
SLC_BLOCK = 64
SLC_TOPK = 16
WINDOW = 512
Q_BLOCK = 128
N_BRANCHES = 3
NSA_Q_WIDTH = NSA_HEADS * HEAD_DIM
NSA_KV_WIDTH = NSA_KV_GROUPS * HEAD_DIM
NSA_PROJ = NSA_Q_WIDTH + 2 * N_BRANCHES * NSA_KV_WIDTH + N_BRANCHES * NSA_HEADS
ROPE_THETA = 500000.0
ROPE_DIM = HEAD_DIM // 4
RWKV_HEAD_SIZE = 64
RWKV_HEADS = D_MODEL // RWKV_HEAD_SIZE
DECAY_LORA = 64
AAA_LORA = 64
MV_LORA = 32
GATE_LORA = 160
D_FF = 4 * D_MODEL
N_NSA = (DEPTH + N_MIXERS - 1) // N_MIXERS
N_RWKV = DEPTH // N_MIXERS
N_VRES = max(N_RWKV - 1, 0)
NORM_EPS = 1e-5
GN_EPS = 64e-5
NEG_INF = -1e30
SEL_FORCE = 1e30

kernel_name = "nsa_rwkv7_hybrid_trunk"


def rms_norm(x, g):
    xf = x.astype(jnp.float32)
    y = xf * lax.rsqrt(jnp.mean(xf * xf, axis=-1, keepdims=True) + NORM_EPS)
    return (y * g).astype(x.dtype)


def partial_rope(x, pos):
    half = ROPE_DIM // 2
    inv = ROPE_THETA ** (-jnp.arange(0, ROPE_DIM, 2, dtype=jnp.float32) / ROPE_DIM)
    ang = pos.astype(jnp.float32)[:, None] * inv[None, :]
    cos = jnp.cos(ang)[:, None, :]
    sin = jnp.sin(ang)[:, None, :]
    x1 = x[..., :half].astype(jnp.float32)
    x2 = x[..., half:ROPE_DIM].astype(jnp.float32)
    rot = jnp.concatenate([x1 * cos - x2 * sin, x2 * cos + x1 * sin], axis=-1)
    return jnp.concatenate([rot.astype(x.dtype), x[..., ROPE_DIM:]], axis=-1)


def compress_blocks(t, pe, w1, w2):
    B, S, G, dh = t.shape
    ratio = CMP_BLOCK // CMP_STRIDE
    n_chunks = S // CMP_STRIDE
    n_cmp = n_chunks - ratio + 1
    c = t.reshape(B, n_chunks, CMP_STRIDE, G, dh)
    blocks = jnp.concatenate([c[:, i:i + n_cmp] for i in range(ratio)], axis=2)
    blocks = blocks + pe[None, None, :, None, :]
    flat = jnp.moveaxis(blocks, 3, 2).reshape(B, n_cmp, G, CMP_BLOCK * dh)
    return jax.nn.gelu(flat @ w1) @ w2


def nsa_mixer(h, w_in, pe_k, w1_k, w2_k, pe_v, w1_v, w2_v, w_out):
    B, S, _ = h.shape
    G, Hg, dh = NSA_KV_GROUPS, NSA_HEADS_PER_GROUP, HEAD_DIM
    proj = h @ w_in
    q = proj[..., :NSA_Q_WIDTH].reshape(B, S, NSA_HEADS, dh)
    kv = [proj[..., NSA_Q_WIDTH + i * NSA_KV_WIDTH:NSA_Q_WIDTH + (i + 1) * NSA_KV_WIDTH].reshape(B, S, G, dh)
          for i in range(2 * N_BRANCHES)]
    k_cmp, v_cmp, k_slc, v_slc, k_win, v_win = kv
    gates = jax.nn.sigmoid(proj[..., NSA_Q_WIDTH + 2 * N_BRANCHES * NSA_KV_WIDTH:].astype(jnp.float32))
    gates = gates.reshape(B, S, G, Hg, N_BRANCHES)
    pos = jnp.arange(S)
    q = partial_rope(q, pos)
    k_cmp = partial_rope(k_cmp, pos)
    k_slc = partial_rope(k_slc, pos)
    k_win = partial_rope(k_win, pos)

    kc = compress_blocks(k_cmp, pe_k, w1_k, w2_k)
    vc = compress_blocks(v_cmp, pe_v, w1_v, w2_v)
    n_cmp = kc.shape[1]
    cmp_end = jnp.arange(n_cmp) * CMP_STRIDE + CMP_BLOCK - 1

    n_slc = S // SLC_BLOCK
    n_sel = min(SLC_TOPK, n_slc)
    ks_blocks = k_slc.reshape(B, n_slc, SLC_BLOCK, G, dh).transpose(0, 3, 1, 2, 4)
    vs_blocks = v_slc.reshape(B, n_slc, SLC_BLOCK, G, dh).transpose(0, 3, 1, 2, 4)
    ci = jnp.arange(n_cmp)[:, None]
    sj = jnp.arange(n_slc)[None, :]
    overlap = ((ci * CMP_STRIDE <= sj * SLC_BLOCK + SLC_BLOCK - 1)
               & (ci * CMP_STRIDE + CMP_BLOCK - 1 >= sj * SLC_BLOCK)).astype(jnp.float32)

    kw_pad = jnp.pad(k_win, ((0, 0), (WINDOW, 0), (0, 0), (0, 0)))
    vw_pad = jnp.pad(v_win, ((0, 0), (WINDOW, 0), (0, 0), (0, 0)))
    scale = HEAD_DIM ** -0.5
    b_idx = jnp.arange(B)[:, None, None, None]
    g_idx = jnp.arange(G)[None, :, None, None]
    blk = jnp.arange(n_slc)

    def query_block(bi):
        t0 = bi * Q_BLOCK
        tpos = t0 + jnp.arange(Q_BLOCK)
        qb = lax.dynamic_slice_in_dim(q, t0, Q_BLOCK, axis=1).reshape(B, Q_BLOCK, G, Hg, dh)
        gb = lax.dynamic_slice_in_dim(gates, t0, Q_BLOCK, axis=1)

        s_c = jnp.einsum('btghd,bngd->bghtn', qb, kc).astype(jnp.float32) * scale
        valid_c = cmp_end[None, :] <= tpos[:, None]
        p_c = jax.nn.softmax(jnp.where(valid_c, s_c, NEG_INF), axis=-1) * valid_c
        o_c = jnp.einsum('bghtn,bngd->btghd', p_c.astype(vc.dtype), vc)

        imp = jnp.einsum('bgtn,ns->bgts', p_c.sum(axis=2), overlap)
        cur = (tpos // SLC_BLOCK)[:, None]
        forced = (blk[None] == 0) | (blk[None] == cur) | (blk[None] == cur - 1)
        imp = jnp.where(forced, SEL_FORCE, jnp.where(blk[None] <= cur, imp, NEG_INF))
        _, idx = lax.top_k(imp, n_sel)
        k_sel = ks_blocks[b_idx, g_idx, idx]
        v_sel = vs_blocks[b_idx, g_idx, idx]
        s_s = jnp.einsum('btghd,bgtnkd->bghtnk', qb, k_sel).astype(jnp.float32) * scale
        kpos = idx[..., None] * SLC_BLOCK + jnp.arange(SLC_BLOCK)
        valid_s = (kpos <= tpos[None, None, :, None, None])[:, :, None]
        s_s = jnp.where(valid_s, s_s, NEG_INF).reshape(B, G, Hg, Q_BLOCK, n_sel * SLC_BLOCK)
        p_s = jax.nn.softmax(s_s, axis=-1).reshape(B, G, Hg, Q_BLOCK, n_sel, SLC_BLOCK)
        o_s = jnp.einsum('bghtnk,bgtnkd->btghd', p_s.astype(v_sel.dtype), v_sel)

        kw = lax.dynamic_slice_in_dim(kw_pad, t0, Q_BLOCK + WINDOW, axis=1)
        vw = lax.dynamic_slice_in_dim(vw_pad, t0, Q_BLOCK + WINDOW, axis=1)
        wpos = t0 - WINDOW + jnp.arange(Q_BLOCK + WINDOW)
        valid_w = ((wpos[None] <= tpos[:, None]) & (wpos[None] > tpos[:, None] - WINDOW)
                   & (wpos[None] >= 0))
        s_w = jnp.einsum('btghd,bkgd->bghtk', qb, kw).astype(jnp.float32) * scale
        p_w = jax.nn.softmax(jnp.where(valid_w, s_w, NEG_INF), axis=-1)
        o_w = jnp.einsum('bghtk,bkgd->btghd', p_w.astype(vw.dtype), vw)

        o = gb[..., 0:1] * o_c + gb[..., 1:2] * o_s + gb[..., 2:3] * o_w
        return o.reshape(B, Q_BLOCK, NSA_Q_WIDTH).astype(h.dtype)

    out = lax.map(query_block, jnp.arange(S // Q_BLOCK))
    out = jnp.moveaxis(out, 0, 1).reshape(B, S, NSA_Q_WIDTH)
    return out @ w_out


def rwkv7_mixer(h, v_first, x_mix, w_rkv, w0, w1, w2, a0, a1, a2, g1, g2,
                k_k, k_a, r_k, ln_w, ln_b, w_out, v_res):
    B, S, D = h.shape
    H, N = RWKV_HEADS, RWKV_HEAD_SIZE
    f32 = jnp.float32
    dx = jnp.pad(h, ((0, 0), (1, 0), (0, 0)))[:, :-1] - h
    xr, xw, xk, xv, xa, xg = (h + dx * x_mix[i] for i in range(6))
    r = xr @ w_rkv[0]
    k = xk @ w_rkv[1]
    v = xv @ w_rkv[2]
    w_log = -jax.nn.softplus(-(w0 + jnp.tanh(xw @ w1) @ w2).astype(f32)) - 0.5
    decay = jnp.exp(-jnp.exp(w_log))
    if v_res is None:
        v_first = v
    else:
        v0, v1, v2 = v_res
        v = v + (v_first - v) * jax.nn.sigmoid(v0 + (xv @ v1) @ v2)
    a = jax.nn.sigmoid((a0 + (xa @ a1) @ a2).astype(f32))
    g = jax.nn.sigmoid(xg @ g1) @ g2

    def heads(t):
        return t.astype(f32).reshape(B, S, H, N)

    kk = heads(k * k_k)
    kk = kk / jnp.maximum(jnp.sqrt(jnp.sum(kk * kk, axis=-1, keepdims=True)), 1e-12)
    kh = heads(k.astype(f32) * (1.0 + (a - 1.0) * k_a.astype(f32)))
    rh, vh, wh, ah = heads(r), heads(v), heads(decay), heads(a)

    def step(state, inp):
        r_t, w_t, k_t, v_t, kk_t, a_t = inp
        sa = jnp.einsum('bhij,bhj->bhi', state, -kk_t)
        state = (state * w_t[:, :, None, :] + sa[..., None] * (kk_t * a_t)[:, :, None, :]
                 + v_t[..., None] * k_t[:, :, None, :])
        return state, jnp.einsum('bhij,bhj->bhi', state, r_t)

    xs = tuple(jnp.moveaxis(t, 1, 0) for t in (rh, wh, kh, vh, kk, ah))
    _, ys = lax.scan(step, jnp.zeros((B, H, N, N), f32), xs)
    y = jnp.moveaxis(ys, 0, 1)
    mu = jnp.mean(y, axis=-1, keepdims=True)
    var = jnp.mean(jnp.square(y - mu), axis=-1, keepdims=True)
    yn = ((y - mu) * lax.rsqrt(var + GN_EPS)).reshape(B, S, D) * ln_w + ln_b
    bonus = jnp.sum(rh * kh * r_k.astype(f32).reshape(H, N), axis=-1, keepdims=True) * vh
    y = yn + bonus.reshape(B, S, D)
    return (y.astype(h.dtype) * g) @ w_out, v_first


def sq_relu_mlp(h, w1, w2):
    return jnp.square(jax.nn.relu(h @ w1)) @ w2


def setup_inputs(seed: int = 0) -> dict:
    key = jax.random.key(seed)
    ks = iter(jax.random.split(key, 64))
    f32 = jnp.float32

    def nrm(shape, scale):
        return jax.random.normal(next(ks), shape, f32) * scale

    D = D_MODEL
    return {
        "x": nrm((BATCH, SEQ, D), 1.0),
        "norm_mix": 1.0 + nrm((DEPTH, D), 0.02),
        "norm_mlp": 1.0 + nrm((DEPTH, D), 0.02),
        "norm_final": 1.0 + nrm((D,), 0.02),
        "mlp_w1": nrm((DEPTH, D, D_FF), D ** -0.5),
        "mlp_w2": nrm((DEPTH, D_FF, D), D_FF ** -0.5),
        "nsa_w_in": nrm((N_NSA, D, NSA_PROJ), D ** -0.5),
        "nsa_cmp_pe_k": nrm((N_NSA, CMP_BLOCK, HEAD_DIM), 0.1),
        "nsa_cmp_w1_k": nrm((N_NSA, CMP_BLOCK * HEAD_DIM, CMP_HIDDEN), (CMP_BLOCK * HEAD_DIM) ** -0.5),
        "nsa_cmp_w2_k": nrm((N_NSA, CMP_HIDDEN, HEAD_DIM), CMP_HIDDEN ** -0.5),
        "nsa_cmp_pe_v": nrm((N_NSA, CMP_BLOCK, HEAD_DIM), 0.1),
        "nsa_cmp_w1_v": nrm((N_NSA, CMP_BLOCK * HEAD_DIM, CMP_HIDDEN), (CMP_BLOCK * HEAD_DIM) ** -0.5),
        "nsa_cmp_w2_v": nrm((N_NSA, CMP_HIDDEN, HEAD_DIM), CMP_HIDDEN ** -0.5),
        "nsa_w_out": nrm((N_NSA, NSA_Q_WIDTH, D), NSA_Q_WIDTH ** -0.5),
        "rwkv_x_mix": jax.random.uniform(next(ks), (N_RWKV, 6, D), f32),
        "rwkv_w_rkv": nrm((N_RWKV, 3, D, D), D ** -0.5),
        "rwkv_w0": jax.random.uniform(next(ks), (N_RWKV, D), f32, minval=-6.5, maxval=-1.5),
        "rwkv_w1": nrm((N_RWKV, D, DECAY_LORA), D ** -0.5),
        "rwkv_w2": nrm((N_RWKV, DECAY_LORA, D), 0.1 * DECAY_LORA ** -0.5),
        "rwkv_a0": nrm((N_RWKV, D), 0.1),
        "rwkv_a1": nrm((N_RWKV, D, AAA_LORA), D ** -0.5),
        "rwkv_a2": nrm((N_RWKV, AAA_LORA, D), 0.5 * AAA_LORA ** -0.5),
        "rwkv_g1": nrm((N_RWKV, D, GATE_LORA), D ** -0.5),
        "rwkv_g2": nrm((N_RWKV, GATE_LORA, D), GATE_LORA ** -0.5),
        "rwkv_k_k": 0.85 + nrm((N_RWKV, D), 0.02),
        "rwkv_k_a": 1.0 + nrm((N_RWKV, D), 0.02),
        "rwkv_r_k": -0.04 + nrm((N_RWKV, D), 0.02),
        "rwkv_ln_w": 1.0 + nrm((N_RWKV, D), 0.02),
        "rwkv_ln_b": nrm((N_RWKV, D), 0.02),
        "rwkv_w_out": nrm((N_RWKV, D, D), D ** -0.5),
        "rwkv_v0": 1.0 + nrm((N_VRES, D), 0.1),
        "rwkv_v1": nrm((N_VRES, D, MV_LORA), D ** -0.5),
        "rwkv_v2": nrm((N_VRES, MV_LORA, D), 0.5 * MV_LORA ** -0.5),
    }


def reference(x, norm_mix, norm_mlp, norm_final, mlp_w1, mlp_w2,
              nsa_w_in, nsa_cmp_pe_k, nsa_cmp_w1_k, nsa_cmp_w2_k,
              nsa_cmp_pe_v, nsa_cmp_w1_v, nsa_cmp_w2_v, nsa_w_out,
              rwkv_x_mix, rwkv_w_rkv, rwkv_w0, rwkv_w1, rwkv_w2,
              rwkv_a0, rwkv_a1, rwkv_a2, rwkv_g1, rwkv_g2,
              rwkv_k_k, rwkv_k_a, rwkv_r_k, rwkv_ln_w, rwkv_ln_b, rwkv_w_out,
              rwkv_v0, rwkv_v1, rwkv_v2):
    v_first = None
    for i in range(DEPTH):
        j = i // N_MIXERS
        hn = rms_norm(x, norm_mix[i])
        if i % N_MIXERS == 0:
            x = x + nsa_mixer(hn, nsa_w_in[j], nsa_cmp_pe_k[j], nsa_cmp_w1_k[j], nsa_cmp_w2_k[j],
                              nsa_cmp_pe_v[j], nsa_cmp_w1_v[j], nsa_cmp_w2_v[j], nsa_w_out[j])
        else:
            v_res = None if j == 0 else (rwkv_v0[j - 1], rwkv_v1[j - 1], rwkv_v2[j - 1])
            y, v_first = rwkv7_mixer(hn, v_first, rwkv_x_mix[j], rwkv_w_rkv[j], rwkv_w0[j],
                                     rwkv_w1[j], rwkv_w2[j], rwkv_a0[j], rwkv_a1[j], rwkv_a2[j],
                                     rwkv_g1[j], rwkv_g2[j], rwkv_k_k[j], rwkv_k_a[j], rwkv_r_k[j],
                                     rwkv_ln_w[j], rwkv_ln_b[j], rwkv_w_out[j], v_res)
            x = x + y
        x = x + sq_relu_mlp(rms_norm(x, norm_mlp[i]), mlp_w1[i], mlp_w2[i])
    return rms_norm(x, norm_final)
```

```cpp
#include <hip/hip_runtime.h>
#include <hip/hip_cooperative_groups.h>
#include <cstdio>
#include <cstdint>
namespace cg = cooperative_groups;

#define LAS __attribute__((address_space(3)))
typedef unsigned short bf16_t;
typedef short bf16x8 __attribute__((ext_vector_type(8)));
typedef float f32x4 __attribute__((ext_vector_type(4)));
typedef float f32x2 __attribute__((ext_vector_type(2)));
typedef unsigned u32x4 __attribute__((ext_vector_type(4)));
typedef unsigned u32x2 __attribute__((ext_vector_type(2)));
typedef _Float16 h16;
typedef _Float16 h16x2 __attribute__((ext_vector_type(2)));

constexpr int S = 16384, NB = 2, M = NB * S, D = 1024, FF = 4096;
constexpr int NWAVES = 8, NTHREADS = 512;
constexpr int LDS_BYTES = 147456;
constexpr size_t MiB = 1u << 20;
constexpr size_t WS_W = 0;
constexpr size_t W_MLP1 = 0, W_MLP2 = 8 * MiB;
constexpr size_t W_NSA_IN = 16 * MiB, W_NSA_V = 21 * MiB, W_NSA_O = 22 * MiB, W_C1K = 24 * MiB, W_C1V = 25 * MiB, W_C2K = 26 * MiB, W_C2V = 26 * MiB + 256 * 1024, W_CBIAS = 26 * MiB + 512 * 1024;
constexpr size_t W_RW_IN = 16 * MiB, W_RW_W2 = 31 * MiB, W_RW_A2 = 31 * MiB + 256 * 1024, W_RW_V2 = 31 * MiB + 512 * 1024, W_RW_G2 = 31 * MiB + 768 * 1024, W_RW_O = 33 * MiB;
constexpr size_t WS_ROPE = 36 * MiB;
constexpr size_t WS_VF = 40 * MiB;
constexpr size_t ACT = 104 * MiB;
constexpr size_t A_HN = ACT;
constexpr size_t A_Q = ACT + 65 * MiB;
constexpr size_t A_KF = ACT + 129 * MiB;
constexpr size_t A_VF = ACT + 194 * MiB;
constexpr size_t A_GATES = ACT + 226 * MiB;
constexpr size_t A_CHK = ACT + 233 * MiB, A_CHV = ACT + 237 * MiB, A_KC = ACT + 241 * MiB, A_VC = ACT + 242 * MiB;
constexpr size_t A_HID = ACT + 65 * MiB;
constexpr size_t A_R = ACT + 65 * MiB, A_K = ACT + 129 * MiB, A_V2 = ACT + 193 * MiB, A_A = ACT + 257 * MiB, A_LH = ACT + 321 * MiB;
constexpr size_t WS_NEED = ACT + 370 * MiB;

__device__ __forceinline__ unsigned cvt_pk_bf16(float lo, float hi) { unsigned r; asm volatile("v_cvt_pk_bf16_f32 %0, %1, %2" : "=v"(r) : "v"(lo), "v"(hi)); return r; }
__device__ __forceinline__ unsigned pk_h16(float lo, float hi) { h16x2 v; v.x = (h16)lo; v.y = (h16)hi; return __builtin_bit_cast(unsigned, v); }
__device__ __forceinline__ float bf2f(bf16_t b) { return __uint_as_float(((unsigned)b) << 16); }
__device__ __forceinline__ float wave_sum(float v) {
#pragma unroll
    for (int o = 1; o < 64; o <<= 1) v += __shfl_xor(v, o);
    return v;
}
__device__ __forceinline__ float sigmoidf_(float x) { return 1.0f / (1.0f + __expf(-x)); }
__device__ __forceinline__ float tanhf_(float x) { float e = __expf(-2.0f * fabsf(x)); float t = (1.0f - e) / (1.0f + e); return x < 0.f ? -t : t; }

namespace pg8 {
constexpr int BM = 256, BK = 64, HALF = 128, HTB = HALF * BK * 2, STAGE_BYTES = 8 * HTB, NXCD = 8, WGM = 8;
__host__ __device__ __forceinline__ int lds_byte(int r, int c) { const int st = (r >> 4) * 2 + (c >> 5), rr = r & 15, cc = c & 31, ob = rr * 64 + cc * 2; return st * 1024 + (ob ^ (((ob >> 9) & 1) << 5)); }
__host__ __device__ __forceinline__ void stage_rc(int b, int& R, int& C) { const int st = b / 1024, sb = b % 1024, swz = sb ^ (((sb >> 9) & 1) << 5); R = (st >> 1) * 16 + swz / 64; C = (st & 1) * 32 + (swz % 64) / 2; }
__host__ __device__ __forceinline__ int perm32(int rho) { const int n = rho >> 4, i = rho & 15; return 8 * (i >> 2) + 4 * n + (i & 3); }
struct Unit { int pm, pn; };
struct Gemm { const bf16_t* A; const bf16_t* Bt; int M, N, K, lda, ldb, amode; };
struct StaticOrder {
    int nM, nN, nwg, G, c;
    __device__ void init(int M_, int N_, int G_, int c_) { nM = M_ / BM; nN = N_ / BM; nwg = nM * nN; G = G_; c = c_; }
    __device__ bool next(int i, Unit& u) const {
        const long L = (long)i * G + c; if (L >= nwg) return false;
        int wgid = (int)L; { const int q = nwg / NXCD, r = nwg % NXCD, xcd = wgid % NXCD, off = wgid / NXCD; wgid = (xcd < r ? xcd * (q + 1) : r * (q + 1) + (xcd - r) * q) + off; }
        const int nig = WGM * nN, gid = wgid / nig, fm = gid * WGM, gsz = (nM - fm) < WGM ? (nM - fm) : WGM;
        u.pm = fm + ((wgid % nig) % gsz); u.pn = (wgid % nig) / gsz; return true;
    }
};
__device__ __forceinline__ const char* a_base(const Gemm& g, int pm) { const size_t row = (size_t)pm * BM + (g.amode == 1 ? (size_t)(pm / 64) : 0); return (const char*)g.A + row * (size_t)g.lda * 2; }

template <class Epi, bool ALIGN_EPI>
__device__ __forceinline__ void gemm_phase(LAS unsigned char* lds, const Gemm g, const StaticOrder& S, const Epi& E) {
    int tid = threadIdx.x; asm volatile("" : "+v"(tid));
    const int wid = __builtin_amdgcn_readfirstlane(tid >> 6), lane = tid & 63, wr = wid >> 2, wc = wid & 3, fr = lane & 15, fq = lane >> 4;
    int K = g.K; asm volatile("" : "+s"(K));
    const int nt = K / BK;
    unsigned voffA[2], voffB[2];
#pragma unroll
    for (int i = 0; i < 2; ++i) { int R, C; stage_rc(tid * 16 + i * 8192, R, C); const int Rb = Epi::PERM ? ((R & ~31) + perm32(R & 31)) : R;
        voffA[i] = (unsigned)(R * g.lda + C) * 2u; voffB[i] = (unsigned)(Rb * g.ldb + C) * 2u; }
    const size_t kstep = (size_t)(BK * 2);
    const size_t hstepA = (size_t)HALF * g.lda * 2, hstepB = (size_t)HALF * g.ldb * 2;
    const size_t tstepB = 2 * hstepB;
    const unsigned ldsw = (unsigned)wid * 1024u;
    const int aoff = lds_byte(wr * 64 + fr, fq * 8), boff = lds_byte(wc * 32 + fr, fq * 8);
#define PG8_SA(b, h) (((b) * 2 + (h)) * HTB)
#define PG8_SB(b, h) ((4 + (b) * 2 + (h)) * HTB)
#define PG8_STAGE(bufoff, gbase, voff) do { _Pragma("unroll") for (int _i = 0; _i < 2; ++_i) \
        __builtin_amdgcn_global_load_lds((const unsigned*)((const char*)(gbase) + (voff)[_i]), (LAS unsigned*)(lds + (bufoff) + ldsw + _i * 8192), 16, 0, 0); } while (0)
#define PG8_LDA(dst, b, h) do { _Pragma("unroll") for (int m = 0; m < 4; ++m) _Pragma("unroll") for (int k = 0; k < 2; ++k) dst[m][k] = *(const LAS bf16x8*)(lds + PG8_SA(b, h) + aoff + m * 2048 + k * 1024); } while (0)
#define PG8_LDB(dst, b, h) do { _Pragma("unroll") for (int n = 0; n < 2; ++n) _Pragma("unroll") for (int k = 0; k < 2; ++k) dst[n][k] = *(const LAS bf16x8*)(lds + PG8_SB(b, h) + boff + n * 2048 + k * 1024); } while (0)
#define PG8_MMA(ai, bj, At, Bt) do { __builtin_amdgcn_s_setprio(1); _Pragma("unroll") for (int m = 0; m < 4; ++m) _Pragma("unroll") for (int n = 0; n < 2; ++n) _Pragma("unroll") for (int k = 0; k < 2; ++k) \
        acc[ai][bj][m][n] = __builtin_amdgcn_mfma_f32_16x16x32_bf16(Bt[n][k], At[m][k], acc[ai][bj][m][n], 0, 0, 0); __builtin_amdgcn_s_setprio(0); } while (0)
#define PG8_WAIT_V(n) asm volatile("s_waitcnt vmcnt(" #n ")" ::: "memory")
#define PG8_WAIT_L(n) asm volatile("s_waitcnt lgkmcnt(" #n ")" ::: "memory")
#define PG8_BAR __builtin_amdgcn_s_barrier()
#define PG8_SCHED __builtin_amdgcn_sched_barrier(0)
    Unit cur, nxt; int ui = 0;
    if (!S.next(0, cur)) return;
    f32x4 acc[2][2][4][2];
#pragma unroll
    for (int a = 0; a < 2; ++a)
#pragma unroll
        for (int b = 0; b < 2; ++b)
#pragma unroll
            for (int m = 0; m < 4; ++m)
#pragma unroll
                for (int n = 0; n < 2; ++n) acc[a][b][m][n] = (f32x4){0.f, 0.f, 0.f, 0.f};
    bf16x8 At[4][2], B0[2][2], B1[2][2];
    const char* cA = a_base(g, cur.pm); const char* cB = (const char*)g.Bt + (size_t)cur.pn * tstepB;
    PG8_STAGE(PG8_SB(0, 0), cB, voffB); PG8_STAGE(PG8_SB(0, 1), cB + hstepB, voffB); PG8_STAGE(PG8_SA(0, 0), cA, voffA); PG8_STAGE(PG8_SA(0, 1), cA + hstepA, voffA);
    if (wr == 1) PG8_BAR;
    PG8_WAIT_V(2); PG8_BAR;
    PG8_STAGE(PG8_SB(1, 0), cB + kstep, voffB); PG8_STAGE(PG8_SA(1, 0), cA + kstep, voffA); PG8_STAGE(PG8_SB(1, 1), cB + hstepB + kstep, voffB);
    PG8_WAIT_V(6); PG8_BAR;
    for (;;) {
        const bool has_next = S.next(ui + 1, nxt);
        const char* nA = has_next ? a_base(g, nxt.pm) : cA; const char* nB = has_next ? (const char*)g.Bt + (size_t)nxt.pn * tstepB : cB;
        for (int t = 0; t < nt; t += 2) {
            const bool last = (t == nt - 2);
            const char* a1 = cA + (size_t)(t + 1) * kstep;
            const char* a2 = last ? nA : cA + (size_t)(t + 2) * kstep; const char* b2 = last ? nB : cB + (size_t)(t + 2) * kstep;
            const char* a3 = a2 + kstep; const char* b3 = b2 + kstep;
            PG8_LDB(B0, 0, 0); PG8_LDB(B1, 0, 1); PG8_SCHED; PG8_LDA(At, 0, 0); PG8_STAGE(PG8_SA(1, 1), a1 + hstepA, voffA);
            PG8_WAIT_V(8); PG8_WAIT_L(0); PG8_BAR; PG8_MMA(0, 0, At, B0); PG8_MMA(0, 1, At, B1); PG8_BAR; PG8_SCHED;
            PG8_LDA(At, 0, 1); PG8_STAGE(PG8_SB(0, 0), b2, voffB); PG8_STAGE(PG8_SB(0, 1), b2 + hstepB, voffB); PG8_STAGE(PG8_SA(0, 0), a2, voffA);
            PG8_WAIT_V(8); PG8_WAIT_L(0); PG8_BAR; PG8_MMA(1, 0, At, B0); PG8_MMA(1, 1, At, B1); PG8_BAR; PG8_SCHED;
            PG8_LDB(B0, 1, 0); PG8_LDB(B1, 1, 1); PG8_SCHED; PG8_LDA(At, 1, 0); PG8_STAGE(PG8_SA(0, 1), a2 + hstepA, voffA);
            PG8_WAIT_V(8); PG8_WAIT_L(0); PG8_BAR; PG8_MMA(0, 0, At, B0); PG8_MMA(0, 1, At, B1); PG8_BAR; PG8_SCHED;
            PG8_LDA(At, 1, 1); PG8_STAGE(PG8_SB(1, 0), b3, voffB); PG8_STAGE(PG8_SB(1, 1), b3 + hstepB, voffB); PG8_STAGE(PG8_SA(1, 0), a3, voffA);
            PG8_WAIT_V(8); PG8_WAIT_L(0); PG8_BAR; PG8_MMA(1, 0, At, B0); PG8_MMA(1, 1, At, B1); PG8_BAR; PG8_SCHED;
        }
        if constexpr (ALIGN_EPI) { if (wr == 0) PG8_BAR; }
        E(acc, cur, wr, wc, fr, fq);
        if (!has_next) break;
#pragma unroll
        for (int a = 0; a < 2; ++a)
#pragma unroll
            for (int b = 0; b < 2; ++b)
#pragma unroll
                for (int m = 0; m < 4; ++m)
#pragma unroll
                    for (int n = 0; n < 2; ++n) acc[a][b][m][n] = (f32x4){0.f, 0.f, 0.f, 0.f};
        cur = nxt; cA = nA; cB = nB; ++ui;
        if constexpr (ALIGN_EPI) { if (wr == 1) PG8_BAR; }
    }
    PG8_WAIT_V(0);
    if constexpr (!ALIGN_EPI) { if (wr == 0) PG8_BAR; }
    PG8_BAR;
#undef PG8_SA
#undef PG8_SB
#undef PG8_STAGE
#undef PG8_LDA
#undef PG8_LDB
#undef PG8_MMA
#undef PG8_WAIT_V
#undef PG8_WAIT_L
#undef PG8_BAR
#undef PG8_SCHED
}
template <class F> struct EpiP {
    static constexpr bool PERM = true; F f;
    __device__ __forceinline__ void operator()(const f32x4 (&acc)[2][2][4][2], const Unit& u, int wr, int wc, int fr, int fq) const {
#pragma unroll
        for (int ai = 0; ai < 2; ++ai)
#pragma unroll
            for (int m = 0; m < 4; ++m) { int row = u.pm * BM + ai * HALF + wr * 64 + m * 16 + fr; asm volatile("" : "+v"(row));
#pragma unroll
                for (int bj = 0; bj < 2; ++bj) { const int col0 = u.pn * BM + bj * HALF + wc * 32 + 8 * fq; f(row, col0, acc[ai][bj][m][0], acc[ai][bj][m][1]); } asm volatile("" ::: "memory"); }
    }
};
template <class F> struct EpiN {
    static constexpr bool PERM = false; F f;
    __device__ __forceinline__ void operator()(const f32x4 (&acc)[2][2][4][2], const Unit& u, int wr, int wc, int fr, int fq) const {
#pragma unroll
        for (int ai = 0; ai < 2; ++ai)
#pragma unroll
            for (int m = 0; m < 4; ++m) { int row = u.pm * BM + ai * HALF + wr * 64 + m * 16 + fr; asm volatile("" : "+v"(row));
#pragma unroll
                for (int bj = 0; bj < 2; ++bj)
#pragma unroll
                    for (int n = 0; n < 2; ++n) { const int col0 = u.pn * BM + bj * HALF + wc * 32 + 16 * n + 4 * fq; f(row, col0, acc[ai][bj][m][n]); } asm volatile("" ::: "memory"); }
    }
};
}

struct Params {
    const float* in[33];
    float* out;
    unsigned char* ws;
};

struct TJob { const float* W; int ldw, n0src, Nsrc, Ksrc; bf16_t* WT; int ldt, row_off, col_off, Npad, Kpad; const float* mix; int mode; };
__device__ __forceinline__ void transpose_job(const TJob& j, LAS float* scr, int gw, int NGW, int lane_) {
    int lane = lane_; asm volatile("" : "+v"(lane));
    const int nblk = j.Npad / 32, kblk = j.Kpad / 64, items = nblk * kblk;
    for (int it = gw; it < items; it += NGW) {
        const int kb = it / nblk, nb = it % nblk, k0 = 64 * kb, n0 = 32 * nb;
#pragma unroll 4
        for (int i = 0; i < 32; ++i) { const int kk = 2 * i + (lane >> 5), n = lane & 31; float v = 0.f;
            if (k0 + kk < j.Ksrc && n0 + n < j.Nsrc) { v = j.W[(size_t)(k0 + kk) * j.ldw + j.n0src + n0 + n];
                if (j.mode == 1) v *= j.mix[k0 + kk]; else if (j.mode == 2) v *= (1.0f - j.mix[k0 + kk]); }
            scr[kk * 33 + n] = v; }
        asm volatile("s_waitcnt lgkmcnt(0)" ::: "memory");
        const int c = lane & 7;
#pragma unroll
        for (int jj = 0; jj < 4; ++jj) { const int n = (lane >> 3) + 8 * jj; const LAS float* s = scr + (8 * c) * 33 + n;
            u32x4 o; o.x = cvt_pk_bf16(s[0 * 33], s[1 * 33]); o.y = cvt_pk_bf16(s[2 * 33], s[3 * 33]); o.z = cvt_pk_bf16(s[4 * 33], s[5 * 33]); o.w = cvt_pk_bf16(s[6 * 33], s[7 * 33]);
            *(u32x4*)(j.WT + (size_t)(j.row_off + n0 + n) * j.ldt + j.col_off + k0 + 8 * c) = o; }
        asm volatile("s_waitcnt lgkmcnt(0)" ::: "memory");
    }
}

__device__ __forceinline__ void rms_row_bf16(const float* xrow, const float* g, bf16_t* orow, float* copy_to, int lane_) {
    int lane = lane_; asm volatile("" : "+v"(lane));
    const f32x4* xr = (const f32x4*)xrow + lane; const f32x4* gr = (const f32x4*)g + lane;
    f32x4 v[4]; float s = 0.f;
#pragma unroll
    for (int j = 0; j < 4; ++j) { v[j] = xr[64 * j]; s += (v[j].x * v[j].x + v[j].y * v[j].y) + (v[j].z * v[j].z + v[j].w * v[j].w); }
    if (copy_to) {
#pragma unroll
        for (int j = 0; j < 4; ++j) ((f32x4*)copy_to + lane)[64 * j] = v[j];
    }
    const float r = rsqrtf(wave_sum(s) * (1.f / D) + 1e-5f);
    u32x2* o8 = (u32x2*)orow + lane;
#pragma unroll
    for (int j = 0; j < 4; ++j) { const f32x4 gg = gr[64 * j]; u32x2 w; w.x = cvt_pk_bf16(v[j].x * r * gg.x, v[j].y * r * gg.y); w.y = cvt_pk_bf16(v[j].z * r * gg.z, v[j].w * r * gg.w); o8[64 * j] = w; }
}

struct FRelu2 { bf16_t* O; __device__ __forceinline__ void operator()(int row, int col0, f32x4 a, f32x4 b) const {
    f32x4 x = a, y = b;
#pragma unroll
    for (int i = 0; i < 4; ++i) { float t = fmaxf(x[i], 0.f); x[i] = t * t; t = fmaxf(y[i], 0.f); y[i] = t * t; }
    u32x4 w; w.x = cvt_pk_bf16(x[0], x[1]); w.y = cvt_pk_bf16(x[2], x[3]); w.z = cvt_pk_bf16(y[0], y[1]); w.w = cvt_pk_bf16(y[2], y[3]);
    *(u32x4*)(O + (size_t)row * FF + col0) = w; } };
struct FResAdd { float* X; __device__ __forceinline__ void operator()(int row, int col0, f32x4 a) const {
    f32x4* p = (f32x4*)(X + (size_t)row * D + col0); *p = *p + a; } };


struct FRwIn { h16* R; h16* Kk; h16* V; bf16_t* LH;
    __device__ __forceinline__ void operator()(int row, int col0, f32x4 a, f32x4 b) const {
        const int seg = __builtin_amdgcn_readfirstlane(col0 >> 10);
        if (seg < 3) { const long dK = (const char*)Kk - (const char*)R, dV = (const char*)V - (const char*)R; const long off = (seg == 1 ? dK : 0l) + (seg == 2 ? dV : 0l); h16* dst = (h16*)((char*)R + off); const int c = col0 & 1023;
            u32x4 w; w.x = pk_h16(a[0], a[1]); w.y = pk_h16(a[2], a[3]); w.z = pk_h16(b[0], b[1]); w.w = pk_h16(b[2], b[3]);
            *(u32x4*)(dst + (size_t)row * D + c) = w; }
        else { const int c = col0 - 3072; f32x4 x = a, y = b;
            if (c < 128) {
#pragma unroll
                for (int i = 0; i < 4; ++i) { x[i] = tanhf_(x[i]); y[i] = tanhf_(y[i]); } }
            else if (c >= 256 && c < 512) {
#pragma unroll
                for (int i = 0; i < 4; ++i) { x[i] = sigmoidf_(x[i]); y[i] = sigmoidf_(y[i]); } }
            u32x4 w; w.x = cvt_pk_bf16(x[0], x[1]); w.y = cvt_pk_bf16(x[2], x[3]); w.z = cvt_pk_bf16(y[0], y[1]); w.w = cvt_pk_bf16(y[2], y[3]);
            *(u32x4*)(LH + (size_t)row * 768 + c) = w; }
    } };
struct FLoraW { h16* EW; const float* w0;
    __device__ __forceinline__ void operator()(int row, int col0, f32x4 a, f32x4 b) const {
        const f32x4 p = *(const f32x4*)(w0 + col0), q = *(const f32x4*)(w0 + col0 + 4); float o[8];
#pragma unroll
        for (int i = 0; i < 4; ++i) { o[i] = 0.60653066f * sigmoidf_(p[i] + a[i]); o[4 + i] = 0.60653066f * sigmoidf_(q[i] + b[i]); }
        u32x4 w; w.x = pk_h16(o[0], o[1]); w.y = pk_h16(o[2], o[3]); w.z = pk_h16(o[4], o[5]); w.w = pk_h16(o[6], o[7]);
        *(u32x4*)(EW + (size_t)row * D + col0) = w; } };
struct FLoraA { h16* Aa; const float* a0;
    __device__ __forceinline__ void operator()(int row, int col0, f32x4 a, f32x4 b) const {
        const f32x4 p = *(const f32x4*)(a0 + col0), q = *(const f32x4*)(a0 + col0 + 4); float o[8];
#pragma unroll
        for (int i = 0; i < 4; ++i) { o[i] = sigmoidf_(p[i] + a[i]); o[4 + i] = sigmoidf_(q[i] + b[i]); }
        u32x4 w; w.x = pk_h16(o[0], o[1]); w.y = pk_h16(o[2], o[3]); w.z = pk_h16(o[4], o[5]); w.w = pk_h16(o[6], o[7]);
        *(u32x4*)(Aa + (size_t)row * D + col0) = w; } };
struct FLoraV { h16* V; const h16* VFm; const float* v0;
    __device__ __forceinline__ void operator()(int row, int col0, f32x4 a, f32x4 b) const {
        const f32x4 p = *(const f32x4*)(v0 + col0), q = *(const f32x4*)(v0 + col0 + 4);
        typedef h16 h16x8 __attribute__((ext_vector_type(8)));
        const h16x8 vv = *(const h16x8*)(V + (size_t)row * D + col0), vf = *(const h16x8*)(VFm + (size_t)row * D + col0); float o[8];
#pragma unroll
        for (int i = 0; i < 4; ++i) { float v = (float)vv[i], f = (float)vf[i]; o[i] = v + (f - v) * sigmoidf_(p[i] + a[i]); v = (float)vv[4 + i]; f = (float)vf[4 + i]; o[4 + i] = v + (f - v) * sigmoidf_(q[i] + b[i]); }
        u32x4 w; w.x = pk_h16(o[0], o[1]); w.y = pk_h16(o[2], o[3]); w.z = pk_h16(o[4], o[5]); w.w = pk_h16(o[6], o[7]);
        *(u32x4*)(V + (size_t)row * D + col0) = w; } };
struct FGate { bf16_t* O; const h16* Y;
    __device__ __forceinline__ void operator()(int row, int col0, f32x4 a, f32x4 b) const {
        typedef h16 h16x8 __attribute__((ext_vector_type(8)));
        const h16x8 yy = *(const h16x8*)(Y + (size_t)row * D + col0);
        u32x4 w; w.x = cvt_pk_bf16(a[0] * (float)yy[0], a[1] * (float)yy[1]); w.y = cvt_pk_bf16(a[2] * (float)yy[2], a[3] * (float)yy[3]);
        w.z = cvt_pk_bf16(b[0] * (float)yy[4], b[1] * (float)yy[5]); w.w = cvt_pk_bf16(b[2] * (float)yy[6], b[3] * (float)yy[7]);
        *(u32x4*)(O + (size_t)row * D + col0) = w; } };

template <int CTRL> __device__ __forceinline__ float dppmov(float v) { return __builtin_bit_cast(float, __builtin_amdgcn_update_dpp(0, __builtin_bit_cast(int, v), CTRL, 0xF, 0xF, true)); }
__device__ __forceinline__ float row16_sum(float v) { v += dppmov<0xB1>(v); v += dppmov<0x4E>(v); v += dppmov<0x124>(v); v += dppmov<0x128>(v); return v; }
typedef _Float16 h16x4 __attribute__((ext_vector_type(4)));
__device__ __forceinline__ void h4_to_f(h16x4 u, float* f) { f[0] = (float)u[0]; f[1] = (float)u[1]; f[2] = (float)u[2]; f[3] = (float)u[3]; }
__device__ __forceinline__ void rwkv_scan(const h16* R, const h16* Kk, const h16* V, const h16* EW, const h16* Aa, const float* k_k, const float* k_a, h16* Yraw, int G, int wave, int lane_) {
    int lane = lane_; asm volatile("" : "+v"(lane));
    const int NT = G * NWAVES;
    for (int task = wave * G + (int)blockIdx.x; task < 512; task += NT) {
        const int bh = task >> 4, rg = task & 15, b = bh >> 4, h = bh & 15;
        const int row = lane >> 4, jg = lane & 15, i = rg * 4 + row;
        const int colj = h * 64 + 4 * jg, coli = h * 64 + i;
        float kkc[4], kac[4];
#pragma unroll
        for (int j = 0; j < 4; ++j) { kkc[j] = k_k[colj + j]; kac[j] = k_a[colj + j]; }
        float s[4] = {0.f, 0.f, 0.f, 0.f};
        const size_t base = (size_t)b * S * D;
        const h16* pR = R + base + colj; const h16* pK = Kk + base + colj; const h16* pA = Aa + base + colj; const h16* pE = EW + base + colj; const h16* pV = V + base + coli;
        h16* pY = Yraw + ((size_t)task * S) * 4 + row;
        constexpr int TC = 4;
        h16x4 cr[TC], ck[TC], ca[TC], ce[TC]; h16 cv[TC];
#pragma unroll
        for (int u = 0; u < TC; ++u) { const size_t o = (size_t)u * D; cr[u] = *(const h16x4*)(pR + o); ck[u] = *(const h16x4*)(pK + o); ca[u] = *(const h16x4*)(pA + o); ce[u] = *(const h16x4*)(pE + o); cv[u] = pV[o]; }
        for (int t0 = 0; t0 < S; t0 += TC) {
            const int tn = (t0 + TC < S) ? t0 + TC : t0;
            h16x4 nr[TC], nk[TC], na[TC], ne[TC]; h16 nv[TC];
#pragma unroll
            for (int u = 0; u < TC; ++u) { const size_t o = (size_t)(tn + u) * D; nr[u] = *(const h16x4*)(pR + o); nk[u] = *(const h16x4*)(pK + o); na[u] = *(const h16x4*)(pA + o); ne[u] = *(const h16x4*)(pE + o); nv[u] = pV[o]; }
#pragma unroll
            for (int u = 0; u < TC; ++u) {
                float rv[4], kv[4], av[4], ev[4]; h4_to_f(cr[u], rv); h4_to_f(ck[u], kv); h4_to_f(ca[u], av); h4_to_f(ce[u], ev);
                const float vi = (float)cv[u];
                float kq[4], n2 = 0.f;
#pragma unroll
                for (int j = 0; j < 4; ++j) { kq[j] = kv[j] * kkc[j]; n2 += kq[j] * kq[j]; }
                n2 = row16_sum(n2);
                const float inv = 1.0f / fmaxf(sqrtf(n2), 1e-12f);
                float kkj[4], kt[4], bb[4], w[4], dot = 0.f;
#pragma unroll
                for (int j = 0; j < 4; ++j) { kkj[j] = kq[j] * inv; kt[j] = kv[j] * (1.0f + (av[j] - 1.0f) * kac[j]); bb[j] = kkj[j] * av[j]; w[j] = __expf(-ev[j]); dot += s[j] * kkj[j]; }
                const float sa = -row16_sum(dot);
                float yd = 0.f;
#pragma unroll
                for (int j = 0; j < 4; ++j) { s[j] = s[j] * w[j] + (sa * bb[j] + vi * kt[j]); yd += s[j] * rv[j]; }
                const float y = row16_sum(yd);
                if (jg == 0) pY[(size_t)(t0 + u) * 4] = (h16)y;
            }
#pragma unroll
            for (int u = 0; u < TC; ++u) { cr[u] = nr[u]; ck[u] = nk[u]; ca[u] = na[u]; ce[u] = ne[u]; cv[u] = nv[u]; }
        }
    }
}
__device__ __forceinline__ void rwkv_gn(h16* R, const h16* Kk, const h16* V, const h16* Aa, const h16* Yraw, const float* k_a, const float* r_k, const float* ln_w, const float* ln_b, int gw, int NGW, int lane_) {
    int lane = lane_; asm volatile("" : "+v"(lane));
    for (int idx = gw; idx < M * 16; idx += NGW) {
        const int m = idx >> 4, h = idx & 15, col = h * 64 + lane; const size_t o = (size_t)m * D + col;
        const int bq = m / S, tq = m - bq * S;
        const float y = (float)Yraw[((size_t)((bq * 16 + h) * 16 + (lane >> 2)) * S + tq) * 4 + (lane & 3)], r = (float)R[o], k = (float)Kk[o], a = (float)Aa[o], v = (float)V[o];
        const float mu = wave_sum(y) * (1.f / 64.f); const float d = y - mu; const float var = wave_sum(d * d) * (1.f / 64.f);
        const float yn = d * rsqrtf(var + 64e-5f) * ln_w[col] + ln_b[col];
        const float kt = k * (1.0f + (a - 1.0f) * k_a[col]);
        const float bs = wave_sum(r * kt * r_k[col]);
        R[o] = (h16)(yn + bs * v);
    }
}


constexpr size_t KF_STRIDE = (size_t)NB * 4 * S * 64;
__device__ __forceinline__ float gelu_tanh(float x) { const float u = 0.7978845608f * (x + 0.044715f * x * x * x); return 0.5f * x * (1.0f + tanhf_(u)); }
__device__ __forceinline__ void store_vf8(bf16_t* chunk_base_d, int keyp0  , f32x4 a, f32x4 b) {
    const int tile = keyp0 >> 4, rq0 = (keyp0 & 15) >> 2;
    u32x2 w0, w1; w0.x = cvt_pk_bf16(a[0], a[1]); w0.y = cvt_pk_bf16(a[2], a[3]); w1.x = cvt_pk_bf16(b[0], b[1]); w1.y = cvt_pk_bf16(b[2], b[3]);
    *(u32x2*)(chunk_base_d + 8 * rq0 + 4 * tile) = w0; *(u32x2*)(chunk_base_d + 8 * (rq0 + 1) + 4 * tile) = w1;
}
struct FNsaIn { bf16_t* Q; bf16_t* KF; float* gates; const float* rope;
    __device__ __forceinline__ void operator()(int row, int col0, f32x4 a, f32x4 b) const {
        const int tile = __builtin_amdgcn_readfirstlane(col0 >> 8);
        const int bb = row / S, t = row - bb * S;
        if (tile < 7) {
            f32x4 x = a, y = b;
            if ((col0 & 32) == 0) {
                f32x4 px, py;
#pragma unroll
                for (int i = 0; i < 4; ++i) { px[i] = __shfl_xor(x[i], 16); py[i] = __shfl_xor(y[i], 16); }
                const int d0 = col0 & 63;
                if (d0 < 16) { const f32x4 c0 = *(const f32x4*)(rope + t * 16), c1 = *(const f32x4*)(rope + t * 16 + 4), s0 = *(const f32x4*)(rope + t * 16 + 8), s1 = *(const f32x4*)(rope + t * 16 + 12);
                    if (d0 == 0) { x = x * c0 - px * s0; y = y * c1 - py * s1; } else { x = x * c0 + px * s0; y = y * c1 + py * s1; } }
            }
            if (tile < 4) { x = x * 0.125f; y = y * 0.125f;
                u32x4 w; w.x = cvt_pk_bf16(x[0], x[1]); w.y = cvt_pk_bf16(x[2], x[3]); w.z = cvt_pk_bf16(y[0], y[1]); w.w = cvt_pk_bf16(y[2], y[3]);
                *(u32x4*)(Q + (size_t)row * D + col0) = w; }
            else { const int idx = tile - 4, g = (col0 & 255) >> 6, d0 = col0 & 63;
                u32x4 w; w.x = cvt_pk_bf16(x[0], x[1]); w.y = cvt_pk_bf16(x[2], x[3]); w.z = cvt_pk_bf16(y[0], y[1]); w.w = cvt_pk_bf16(y[2], y[3]);
                *(u32x4*)(KF + (size_t)idx * KF_STRIDE + ((size_t)(bb * 4 + g) * S + t) * 64 + d0) = w; }
        } else if (tile == 7) { const int g = (col0 & 255) >> 6, d0 = col0 & 63;
            u32x4 w; w.x = cvt_pk_bf16(a[0], a[1]); w.y = cvt_pk_bf16(a[2], a[3]); w.z = cvt_pk_bf16(b[0], b[1]); w.w = cvt_pk_bf16(b[2], b[3]);
            *(u32x4*)(KF + (size_t)3 * KF_STRIDE + ((size_t)(bb * 4 + g) * S + t) * 64 + d0) = w;
        } else { const int c = col0 - 2048;
            if (c < 48) { f32x4 x, y;
#pragma unroll
                for (int i = 0; i < 4; ++i) { x[i] = sigmoidf_(a[i]); y[i] = sigmoidf_(b[i]); }
                *(f32x4*)(gates + (size_t)row * 48 + c) = x; *(f32x4*)(gates + (size_t)row * 48 + c + 4) = y; }
        }
    } };
struct FNsaVT { bf16_t* VF;
    __device__ __forceinline__ void operator()(int row, int col0, f32x4 a, f32x4 b) const {
        const int br = row >> 8, g = (row >> 6) & 3, d = row & 63, bb = col0 / S, t0 = col0 - bb * S;
        bf16_t* base = VF + (size_t)br * KF_STRIDE + (size_t)(bb * 4 + g) * S * 64 + (size_t)(t0 >> 5) * 2048 + d * 32;
        store_vf8(base, t0 & 31, a, b); } };
struct FCmp1 { bf16_t* CH; const float* bias;
    __device__ __forceinline__ void operator()(int row, int col0, f32x4 a, f32x4 b) const {
        const f32x4 p = *(const f32x4*)(bias + col0), q = *(const f32x4*)(bias + col0 + 4); float o[8];
#pragma unroll
        for (int i = 0; i < 4; ++i) { o[i] = gelu_tanh(a[i] + p[i]); o[4 + i] = gelu_tanh(b[i] + q[i]); }
        u32x4 w; w.x = cvt_pk_bf16(o[0], o[1]); w.y = cvt_pk_bf16(o[2], o[3]); w.z = cvt_pk_bf16(o[4], o[5]); w.w = cvt_pk_bf16(o[6], o[7]);
        *(u32x4*)(CH + (size_t)row * 256 + col0) = w; } };
struct FCmp2K { bf16_t* KC;
    __device__ __forceinline__ void operator()(int row, int col0, f32x4 a, f32x4 b) const {
        if (col0 < 64) { u32x4 w; w.x = cvt_pk_bf16(a[0], a[1]); w.y = cvt_pk_bf16(a[2], a[3]); w.z = cvt_pk_bf16(b[0], b[1]); w.w = cvt_pk_bf16(b[2], b[3]);
            *(u32x4*)(KC + (size_t)row * 64 + col0) = w; } } };
struct FCmp2VT { bf16_t* VC;
    __device__ __forceinline__ void operator()(int row, int col0, f32x4 a, f32x4 b) const {
        if (row < 64) { const int bg = col0 >> 10, n0 = col0 & 1023;
            bf16_t* base = VC + (size_t)bg * 65536 + (size_t)(n0 >> 5) * 2048 + row * 32; store_vf8(base, n0 & 31, a, b); } } };

__device__ __forceinline__ f32x4 mfma16(bf16x8 a, bf16x8 b, f32x4 c) { return __builtin_amdgcn_mfma_f32_16x16x32_bf16(a, b, c, 0, 0, 0); }
__device__ __forceinline__ bf16x8 ld8(const bf16_t* p) { return *(const bf16x8*)p; }
__device__ __forceinline__ bf16x8 pack8(f32x4 a, f32x4 b) { u32x4 w; w.x = cvt_pk_bf16(a[0], a[1]); w.y = cvt_pk_bf16(a[2], a[3]); w.z = cvt_pk_bf16(b[0], b[1]); w.w = cvt_pk_bf16(b[2], b[3]); return __builtin_bit_cast(bf16x8, w); }
__device__ __forceinline__ float colmax(float x) { x = fmaxf(x, __shfl_xor(x, 16)); return fmaxf(x, __shfl_xor(x, 32)); }
__device__ __forceinline__ float colsum(float x) { x += __shfl_xor(x, 16); return x + __shfl_xor(x, 32); }
struct AttnState { float m, l; f32x4 o[4]; };
__device__ __forceinline__ void attn_init(AttnState& st) { st.m = -1e30f; st.l = 0.f;
#pragma unroll
    for (int d = 0; d < 4; ++d) st.o[d] = (f32x4){0.f, 0.f, 0.f, 0.f}; }
__device__ __forceinline__ void attn_chunk(AttnState& st, const bf16_t* kptr, const bf16_t* vptr, const bf16x8 q0, const bf16x8 q1, unsigned vmask) {
    f32x4 s[2];
#pragma unroll
    for (int tl = 0; tl < 2; ++tl) { const bf16x8 k0 = ld8(kptr + tl * 1024), k1 = ld8(kptr + tl * 1024 + 32);
        s[tl] = mfma16(k0, q0, (f32x4){0.f, 0.f, 0.f, 0.f}); s[tl] = mfma16(k1, q1, s[tl]); }
    float mx = -1e30f;
#pragma unroll
    for (int tl = 0; tl < 2; ++tl)
#pragma unroll
        for (int i = 0; i < 4; ++i) { const bool v = (vmask >> (tl * 4 + i)) & 1u; s[tl][i] = v ? s[tl][i] : -1e30f; mx = fmaxf(mx, s[tl][i]); }
    mx = colmax(mx);
    const float mnew = fmaxf(st.m, mx), alpha = __expf(st.m - mnew);
    f32x4 p[2]; float ps = 0.f;
#pragma unroll
    for (int tl = 0; tl < 2; ++tl)
#pragma unroll
        for (int i = 0; i < 4; ++i) { const bool v = (vmask >> (tl * 4 + i)) & 1u; p[tl][i] = v ? __expf(s[tl][i] - mnew) : 0.f; ps += p[tl][i]; }
    st.l = st.l * alpha + ps; st.m = mnew;
    const bf16x8 pb = pack8(p[0], p[1]);
#pragma unroll
    for (int d = 0; d < 4; ++d) { st.o[d] = st.o[d] * alpha; st.o[d] = mfma16(ld8(vptr + d * 512), pb, st.o[d]); }
}

__device__ __forceinline__ void nsa_attention(const bf16_t* Q, const bf16_t* KF, const bf16_t* VF, const bf16_t* KC, const bf16_t* VC, const float* gates, bf16_t* OUT, LAS unsigned char* lds, int G, int wave, int lane_) {
    int lane = lane_; asm volatile("" : "+v"(lane));
    const int col = lane & 15, rq = lane >> 4;
    LAS float* imp = (LAS float*)(lds + wave * 18432);
    LAS int* sel = (LAS int*)(lds + wave * 18432 + 16384);
    const int NGWv = G * NWAVES;
#pragma unroll 1
    for (int task = (int)blockIdx.x * NWAVES + wave; task < 8192; task += NGWv) {
        const int tilei = task >> 3, bg = task & 7, b = bg >> 2, g = bg & 3, t0 = tilei * 16, t = t0 + col;
        const size_t rowq = (size_t)b * S + t;
        const bf16_t* qrow = Q + rowq * D + (g * 4) * 64 + 8 * rq;
        const float* grow = gates + rowq * 48 + g * 12;
        f32x4 total[4][4];
        float mc[4], lc[4];
        const int cur_max = (t0 + 15) >> 6;
        int n_end = 4 * (cur_max + 1); if (n_end > 1024) n_end = 1024;
        const int nchunk_c = (n_end + 31) >> 5;
        const bf16_t* kc_l = KC + (size_t)bg * 65536 + (size_t)col * 64 + 8 * rq;
        const bf16_t* vc_l = VC + (size_t)bg * 65536 + (size_t)col * 32 + 8 * rq;
#pragma unroll
        for (int h = 0; h < 4; ++h) {
            const bf16x8 q0 = ld8(qrow + h * 64), q1 = ld8(qrow + h * 64 + 32);
            AttnState st; attn_init(st);
#pragma unroll 1
            for (int kc = 0; kc < nchunk_c; ++kc) {
                unsigned vm = 0u;
#pragma unroll
                for (int tl = 0; tl < 2; ++tl)
#pragma unroll
                    for (int i = 0; i < 4; ++i) { const int n = kc * 32 + tl * 16 + 4 * rq + i; if (16 * n + 31 <= t) vm |= 1u << (tl * 4 + i); }
                attn_chunk(st, kc_l + (size_t)kc * 2048, vc_l + (size_t)kc * 2048, q0, q1, vm);
            }
            const float lt = colsum(st.l); const float inv = lt > 0.f ? 1.0f / lt : 0.f; const float gc = grow[h * 3 + 0] * inv;
            mc[h] = st.m; lc[h] = inv;
#pragma unroll
            for (int d = 0; d < 4; ++d) total[h][d] = st.o[d] * gc;
        }
        {
            float carry = 0.f;
#pragma unroll 1
            for (int kc = 0; kc < nchunk_c; ++kc) {
#pragma unroll
                for (int tl = 0; tl < 2; ++tl) {
                    const bf16x8 k0 = ld8(kc_l + (size_t)kc * 2048 + tl * 1024), k1 = ld8(kc_l + (size_t)kc * 2048 + tl * 1024 + 32);
                    float own = 0.f, p3 = 0.f;
#pragma unroll
                    for (int h = 0; h < 4; ++h) {
                        const bf16x8 q0 = ld8(qrow + h * 64), q1 = ld8(qrow + h * 64 + 32);
                        f32x4 sc = mfma16(k0, q0, (f32x4){0.f, 0.f, 0.f, 0.f}); sc = mfma16(k1, q1, sc);
#pragma unroll
                        for (int i = 0; i < 4; ++i) { const int n = kc * 32 + tl * 16 + 4 * rq + i; const float p = (16 * n + 31 <= t) ? __expf(sc[i] - mc[h]) * lc[h] : 0.f; own += p; if (i == 3) p3 += p; }
                    }
                    const float up = __shfl(p3, (lane + 48) & 63);
                    const float add = (rq == 0) ? carry : up;
                    imp[col * 256 + kc * 8 + tl * 4 + rq] = own + add;
                    carry = __shfl(p3, col + 48);
                }
            }
        }
#pragma unroll 1
        for (int c = 0; c < 16; ++c) {
            const int tc = t0 + c, cur = tc >> 6;
            if (cur < 16) { if (lane <= cur) sel[c * 17 + lane] = lane; if (lane == 0) sel[c * 17 + 16] = cur + 1; }
            else {
                unsigned key[4];
#pragma unroll
                for (int j = 0; j < 4; ++j) { const int sb = lane + 64 * j; const float v = imp[c * 256 + sb]; key[j] = (sb >= 1 && sb <= cur - 2) ? ((__float_as_uint(v) & 0xFFFFFF00u) | (unsigned)(255 - sb)) : 0u; }
                if (lane == 0) { sel[c * 17 + 0] = 0; sel[c * 17 + 1] = cur - 1; sel[c * 17 + 2] = cur; sel[c * 17 + 16] = 16; }
#pragma unroll 1
                for (int r = 0; r < 13; ++r) {
                    unsigned best = max(max(key[0], key[1]), max(key[2], key[3]));
#pragma unroll
                    for (int o = 1; o < 64; o <<= 1) best = max(best, (unsigned)__shfl_xor((int)best, o));
                    if (lane == 0) sel[c * 17 + 3 + r] = 255 - (int)(best & 255u);
#pragma unroll
                    for (int j = 0; j < 4; ++j) if (key[j] == best) key[j] = 0u;
                }
            }
        }
        {
            const bf16_t* ks_b = KF + (size_t)1 * KF_STRIDE + (size_t)bg * S * 64 + (size_t)col * 64 + 8 * rq;
            const bf16_t* vs_b = VF + (size_t)bg * S * 64 + (size_t)col * 32 + 8 * rq;
#pragma unroll 1
            for (int c = 0; c < 16; ++c) {
                const int tc = t0 + c;
                bf16x8 q0 = (bf16x8){0, 0, 0, 0, 0, 0, 0, 0}, q1 = q0;
                if (col < 4) { const bf16_t* qp = Q + ((size_t)b * S + tc) * D + (g * 4 + col) * 64 + 8 * rq; q0 = ld8(qp); q1 = ld8(qp + 32); }
                AttnState st; attn_init(st);
                const int cnt = __builtin_amdgcn_readfirstlane(sel[c * 17 + 16]);
#pragma unroll 1
                for (int bi = 0; bi < cnt; ++bi) {
                    const int j = __builtin_amdgcn_readfirstlane(sel[c * 17 + bi]);
#pragma unroll
                    for (int k2 = 0; k2 < 2; ++k2) {
                        const int kp0 = j * 64 + k2 * 32 + 4 * rq; unsigned vm = 0u;
#pragma unroll
                        for (int tl = 0; tl < 2; ++tl)
#pragma unroll
                            for (int i = 0; i < 4; ++i) if (kp0 + tl * 16 + i <= tc) vm |= 1u << (tl * 4 + i);
                        attn_chunk(st, ks_b + (size_t)(j * 64 + k2 * 32) * 64, vs_b + (size_t)(j * 2 + k2) * 2048, q0, q1, vm);
                    }
                }
                const float lt = colsum(st.l); const float inv = lt > 0.f ? 1.0f / lt : 0.f;
                const float gs = (col < 4) ? gates[((size_t)b * S + tc) * 48 + g * 12 + col * 3 + 1] * inv : 0.f;
#pragma unroll
                for (int h = 0; h < 4; ++h)
#pragma unroll
                    for (int d = 0; d < 4; ++d)
#pragma unroll
                        for (int i = 0; i < 4; ++i) { const float v = __shfl(st.o[d][i] * gs, h + (lane & 48)); total[h][d][i] += (col == c) ? v : 0.f; }
            }
        }
        {
            int lo = t0 - 511; if (lo < 0) lo = 0; const int c0 = lo >> 5, c1 = (t0 + 15) >> 5;
            const bf16_t* kw_b = KF + (size_t)2 * KF_STRIDE + (size_t)bg * S * 64 + (size_t)col * 64 + 8 * rq;
            const bf16_t* vw_b = VF + (size_t)1 * KF_STRIDE + (size_t)bg * S * 64 + (size_t)col * 32 + 8 * rq;
#pragma unroll
            for (int h = 0; h < 4; ++h) {
                const bf16x8 q0 = ld8(qrow + h * 64), q1 = ld8(qrow + h * 64 + 32);
                AttnState st; attn_init(st);
#pragma unroll 1
                for (int ch = c0; ch <= c1; ++ch) {
                    unsigned vm = 0u;
#pragma unroll
                    for (int tl = 0; tl < 2; ++tl)
#pragma unroll
                        for (int i = 0; i < 4; ++i) { const int kp = ch * 32 + tl * 16 + 4 * rq + i; if (kp <= t && kp + 512 > t) vm |= 1u << (tl * 4 + i); }
                    attn_chunk(st, kw_b + (size_t)ch * 2048, vw_b + (size_t)ch * 2048, q0, q1, vm);
                }
                const float lt = colsum(st.l); const float inv = lt > 0.f ? 1.0f / lt : 0.f; const float gwv = grow[h * 3 + 2] * inv;
#pragma unroll
                for (int d = 0; d < 4; ++d) total[h][d] = total[h][d] + st.o[d] * gwv;
            }
        }
#pragma unroll
        for (int h = 0; h < 4; ++h)
#pragma unroll
            for (int d = 0; d < 4; ++d) { u32x2 w; w.x = cvt_pk_bf16(total[h][d][0], total[h][d][1]); w.y = cvt_pk_bf16(total[h][d][2], total[h][d][3]);
                *(u32x2*)(OUT + rowq * D + (g * 4 + h) * 64 + d * 16 + 4 * rq) = w; }
    }
}

#define GSYNC() do { asm volatile("s_waitcnt vmcnt(0)" ::: "memory"); __builtin_amdgcn_fence(__ATOMIC_RELEASE, "agent"); grid.sync(); __builtin_amdgcn_fence(__ATOMIC_ACQUIRE, "agent"); } while (0)
__global__ void __launch_bounds__(NTHREADS, 2) fwd_kernel(Params P) {
    extern __shared__ __attribute__((aligned(16))) unsigned char lds_raw[];
    LAS unsigned char* lds = (LAS unsigned char*)lds_raw;
    cg::grid_group grid = cg::this_grid();
    const int tid = threadIdx.x, lane = tid & 63, wave = __builtin_amdgcn_readfirstlane(tid >> 6);
    const int G = gridDim.x, gw = blockIdx.x * NWAVES + wave, NGW = G * NWAVES;
    unsigned char* ws = P.ws;
    float* xres = P.out;
    LAS float* scr = (LAS float*)(lds + wave * 16384);
    const float* x_in = P.in[0];
    const float* norm_mix = P.in[1]; const float* norm_mlp = P.in[2]; const float* norm_final = P.in[3];
    const float* mlp_w1 = P.in[4]; const float* mlp_w2 = P.in[5];

    for (int layer = 0; layer < 4; ++layer) {
        int lane = threadIdx.x & 63; asm volatile("" : "+v"(lane));
        const bool is_rwkv = (layer & 1) != 0; const int lj = layer >> 1;
        const float* xsrc = (layer == 0) ? x_in : xres;
        {
            TJob j1{mlp_w1 + (size_t)layer * D * FF, FF, 0, FF, D, (bf16_t*)(ws + WS_W + W_MLP1), D, 0, 0, FF, D, nullptr, 0};
            transpose_job(j1, scr, gw, NGW, lane);
            TJob j2{mlp_w2 + (size_t)layer * FF * D, D, 0, D, FF, (bf16_t*)(ws + WS_W + W_MLP2), FF, 0, 0, D, FF, nullptr, 0};
            transpose_job(j2, scr, gw, NGW, lane);
            if (is_rwkv) {
                const float* mix = P.in[14] + (size_t)lj * 6 * D;
                bf16_t* WrT = (bf16_t*)(ws + WS_W + W_RW_IN);
                const float* wrkv = P.in[15] + (size_t)lj * 3 * D * D;
                for (int part = 0; part < 8; ++part) {
                    const float* W; int ldw, Nsrc, mi, r0, Npad;
                    if (part == 0) { W = wrkv; ldw = D; Nsrc = D; mi = 0; r0 = 0; Npad = D; }
                    else if (part == 1) { W = wrkv + (size_t)D * D; ldw = D; Nsrc = D; mi = 2; r0 = 1024; Npad = D; }
                    else if (part == 2) { W = wrkv + (size_t)2 * D * D; ldw = D; Nsrc = D; mi = 3; r0 = 2048; Npad = D; }
                    else if (part == 3) { W = P.in[17] + (size_t)lj * D * 64; ldw = 64; Nsrc = 64; mi = 1; r0 = 3072; Npad = 128; }
                    else if (part == 4) { W = P.in[20] + (size_t)lj * D * 64; ldw = 64; Nsrc = 64; mi = 4; r0 = 3200; Npad = 128; }
                    else if (part == 5) { W = P.in[22] + (size_t)lj * D * 160; ldw = 160; Nsrc = 160; mi = 5; r0 = 3328; Npad = 256; }
                    else if (part == 6) { W = P.in[31]; ldw = 32; Nsrc = (lj >= 1) ? 32 : 0; mi = 3; r0 = 3584; Npad = 128; }
                    else { W = P.in[31]; ldw = 32; Nsrc = 0; mi = 3; r0 = 3712; Npad = 128; }
                    TJob ja{W, ldw, 0, Nsrc, D, WrT, 2048, r0, 0, Npad, D, mix + mi * D, 1};
                    transpose_job(ja, scr, gw, NGW, lane);
                    TJob jb{W, ldw, 0, Nsrc, D, WrT, 2048, r0, 1024, Npad, D, mix + mi * D, 2};
                    transpose_job(jb, scr, gw, NGW, lane);
                }
                TJob jw{P.in[18] + (size_t)lj * 64 * D, D, 0, D, 64, (bf16_t*)(ws + WS_W + W_RW_W2), 128, 0, 0, D, 128, nullptr, 0}; transpose_job(jw, scr, gw, NGW, lane);
                TJob jaa{P.in[21] + (size_t)lj * 64 * D, D, 0, D, 64, (bf16_t*)(ws + WS_W + W_RW_A2), 128, 0, 0, D, 128, nullptr, 0}; transpose_job(jaa, scr, gw, NGW, lane);
                TJob jv{P.in[32], D, 0, D, (lj >= 1) ? 32 : 0, (bf16_t*)(ws + WS_W + W_RW_V2), 128, 0, 0, D, 128, nullptr, 0}; transpose_job(jv, scr, gw, NGW, lane);
                TJob jg{P.in[23] + (size_t)lj * 160 * D, D, 0, D, 160, (bf16_t*)(ws + WS_W + W_RW_G2), 256, 0, 0, D, 256, nullptr, 0}; transpose_job(jg, scr, gw, NGW, lane);
                TJob jo{P.in[29] + (size_t)lj * D * D, D, 0, D, D, (bf16_t*)(ws + WS_W + W_RW_O), D, 0, 0, D, D, nullptr, 0}; transpose_job(jo, scr, gw, NGW, lane);
                bf16_t* HN = (bf16_t*)(ws + A_HN);
                if (gw < 2) { u32x4* z = (u32x4*)(HN + (size_t)gw * (S + 1) * D); for (int q = lane; q < D / 8; q += 64) z[q] = (u32x4){0u, 0u, 0u, 0u}; }
                for (int m = gw; m < M; m += NGW) { const int b = m / S; rms_row_bf16(xsrc + (size_t)m * D, norm_mix + layer * D, HN + ((size_t)m + b + 1) * D, nullptr, lane); }
            } else {
                const float* win = P.in[6] + (size_t)lj * D * 2608;
                bf16_t* WnT = (bf16_t*)(ws + WS_W + W_NSA_IN); bf16_t* WvT = (bf16_t*)(ws + WS_W + W_NSA_V);
                for (int part = 0; part < 8; ++part) {
                    int n0src, Nsrc, r0, Npad; bf16_t* WT = WnT;
                    if (part == 0) { n0src = 0; Nsrc = 1024; r0 = 0; Npad = 1024; }
                    else if (part == 1) { n0src = 1024; Nsrc = 256; r0 = 1024; Npad = 256; }
                    else if (part == 2) { n0src = 1024 + 512; Nsrc = 256; r0 = 1280; Npad = 256; }
                    else if (part == 3) { n0src = 1024 + 1024; Nsrc = 256; r0 = 1536; Npad = 256; }
                    else if (part == 4) { n0src = 1024 + 256; Nsrc = 256; r0 = 1792; Npad = 256; }
                    else if (part == 5) { n0src = 2560; Nsrc = 48; r0 = 2048; Npad = 256; }
                    else if (part == 6) { n0src = 1024 + 768; Nsrc = 256; r0 = 0; Npad = 256; WT = WvT; }
                    else { n0src = 1024 + 1280; Nsrc = 256; r0 = 256; Npad = 256; WT = WvT; }
                    TJob jn{win, 2608, n0src, Nsrc, D, WT, D, r0, 0, Npad, D, nullptr, 0}; transpose_job(jn, scr, gw, NGW, lane);
                }
                TJob jo{P.in[13] + (size_t)lj * D * D, D, 0, D, D, (bf16_t*)(ws + WS_W + W_NSA_O), D, 0, 0, D, D, nullptr, 0}; transpose_job(jo, scr, gw, NGW, lane);
                TJob jc1k{P.in[8] + (size_t)lj * 2048 * 256, 256, 0, 256, 2048, (bf16_t*)(ws + WS_W + W_C1K), 2048, 0, 0, 256, 2048, nullptr, 0}; transpose_job(jc1k, scr, gw, NGW, lane);
                TJob jc1v{P.in[11] + (size_t)lj * 2048 * 256, 256, 0, 256, 2048, (bf16_t*)(ws + WS_W + W_C1V), 2048, 0, 0, 256, 2048, nullptr, 0}; transpose_job(jc1v, scr, gw, NGW, lane);
                TJob jc2k{P.in[9] + (size_t)lj * 256 * 64, 64, 0, 64, 256, (bf16_t*)(ws + WS_W + W_C2K), 256, 0, 0, 256, 256, nullptr, 0}; transpose_job(jc2k, scr, gw, NGW, lane);
                TJob jc2v{P.in[12] + (size_t)lj * 256 * 64, 64, 0, 64, 256, (bf16_t*)(ws + WS_W + W_C2V), 256, 0, 0, 256, 256, nullptr, 0}; transpose_job(jc2v, scr, gw, NGW, lane);
                {
                    int ln = lane; asm volatile("" : "+v"(ln));
                    float* cb = (float*)(ws + WS_W + W_CBIAS);
#pragma unroll 1
                    for (int o = gw; o < 512; o += NGW) { const int isv = o >> 8, c = o & 255;
                        const float* pe = (isv ? P.in[10] : P.in[7]) + (size_t)lj * 2048; const float* w1 = (isv ? P.in[11] : P.in[8]) + (size_t)lj * 2048 * 256;
                        float acc = 0.f;
#pragma unroll 1
                        for (int k = ln; k < 2048; k += 64) acc += pe[k] * w1[(size_t)k * 256 + c];
                        acc = wave_sum(acc); if (ln == 0) cb[o] = acc; }
                    if (layer == 0) {
                        float* rt = (float*)(ws + WS_ROPE);
                        int tix = threadIdx.x; asm volatile("" : "+v"(tix)); const int gt = (int)blockIdx.x * NTHREADS + tix;
#pragma unroll 1
                        for (int e = gt; e < S * 8; e += G * NTHREADS) { const int tt = e >> 3, i = e & 7;
                            const float invf = (i == 0) ? 1.0f : (i == 1) ? 0.1939227432012558f : (i == 2) ? 0.03760603070259094f : (i == 3) ? 0.007292664609849453f : (i == 4) ? 0.0014142135623842478f : (i == 5) ? 0.00027424818836152554f : (i == 6) ? 5.318296098266728e-05f : 1.0313386155758053e-05f;
                            const float ang = (float)tt * invf; const double rev = (double)ang * 0.15915494309189535; const float fr = (float)(rev - __builtin_rint(rev));
                            rt[tt * 16 + i] = __builtin_amdgcn_cosf(fr); rt[tt * 16 + 8 + i] = __builtin_amdgcn_sinf(fr); }
                    }
                }
                for (int m = gw; m < M; m += NGW) rms_row_bf16(xsrc + (size_t)m * D, norm_mix + layer * D, (bf16_t*)(ws + A_HN) + (size_t)m * D, (layer == 0) ? xres + (size_t)m * D : nullptr, lane);
            }
        }
        GSYNC();
        if (!is_rwkv) {
            bf16_t* HN = (bf16_t*)(ws + A_HN); bf16_t* Qb = (bf16_t*)(ws + A_Q); bf16_t* KFb = (bf16_t*)(ws + A_KF); bf16_t* VFb = (bf16_t*)(ws + A_VF);
            float* GT = (float*)(ws + A_GATES); bf16_t* CHK = (bf16_t*)(ws + A_CHK); bf16_t* CHV = (bf16_t*)(ws + A_CHV); bf16_t* KCb = (bf16_t*)(ws + A_KC); bf16_t* VCb = (bf16_t*)(ws + A_VC);
            {
                pg8::Gemm g{HN, (const bf16_t*)(ws + WS_W + W_NSA_IN), M, 2304, D, D, D, 0};
                pg8::StaticOrder so; so.init(M, 2304, G, (int)blockIdx.x);
                pg8::EpiP<FNsaIn> E{FNsaIn{Qb, KFb, GT, (const float*)(ws + WS_ROPE)}};
                pg8::gemm_phase<pg8::EpiP<FNsaIn>, true>(lds, g, so, E);
                pg8::Gemm g2{(const bf16_t*)(ws + WS_W + W_NSA_V), HN, 512, M, D, D, D, 0};
                pg8::StaticOrder so2; so2.init(512, M, G, (int)blockIdx.x);
                pg8::EpiP<FNsaVT> E2{FNsaVT{VFb}};
                pg8::gemm_phase<pg8::EpiP<FNsaVT>, true>(lds, g2, so2, E2);
            }
            GSYNC();
            {
                pg8::StaticOrder so; so.init(8192, 256, G, (int)blockIdx.x);
                { pg8::Gemm g{KFb, (const bf16_t*)(ws + WS_W + W_C1K), 8192, 256, 2048, 1024, 2048, 0}; pg8::EpiP<FCmp1> E{FCmp1{CHK, (const float*)(ws + WS_W + W_CBIAS)}}; pg8::gemm_phase<pg8::EpiP<FCmp1>, true>(lds, g, so, E); }
                { pg8::Gemm g{KFb + 3 * KF_STRIDE, (const bf16_t*)(ws + WS_W + W_C1V), 8192, 256, 2048, 1024, 2048, 0}; pg8::EpiP<FCmp1> E{FCmp1{CHV, (const float*)(ws + WS_W + W_CBIAS) + 256}}; pg8::gemm_phase<pg8::EpiP<FCmp1>, true>(lds, g, so, E); }
            }
            GSYNC();
            {
                { pg8::StaticOrder so; so.init(8192, 256, G, (int)blockIdx.x); pg8::Gemm g{CHK, (const bf16_t*)(ws + WS_W + W_C2K), 8192, 256, 256, 256, 256, 0}; pg8::EpiP<FCmp2K> E{FCmp2K{KCb}}; pg8::gemm_phase<pg8::EpiP<FCmp2K>, true>(lds, g, so, E); }
                { pg8::StaticOrder so; so.init(256, 8192, G, (int)blockIdx.x); pg8::Gemm g{(const bf16_t*)(ws + WS_W + W_C2V), CHV, 256, 8192, 256, 256, 256, 0}; pg8::EpiP<FCmp2VT> E{FCmp2VT{VCb}}; pg8::gemm_phase<pg8::EpiP<FCmp2VT>, true>(lds, g, so, E); }
            }
            GSYNC();
            nsa_attention(Qb, KFb, VFb, KCb, VCb, GT, HN, lds, G, wave, lane);
            GSYNC();
            {
                pg8::StaticOrder so; so.init(M, D, G, (int)blockIdx.x);
                pg8::Gemm g{HN, (const bf16_t*)(ws + WS_W + W_NSA_O), M, D, D, D, D, 0}; pg8::EpiN<FResAdd> E{FResAdd{xres}}; pg8::gemm_phase<pg8::EpiN<FResAdd>, true>(lds, g, so, E);
            }
            GSYNC();
        }
        if (is_rwkv) {
            h16* Rb = (h16*)(ws + A_R); h16* Kb = (h16*)(ws + A_K); h16* Ab = (h16*)(ws + A_A); h16* EWb = (h16*)(ws + A_HN);
            h16* Vb = (lj == 0) ? (h16*)(ws + WS_VF) : (h16*)(ws + A_V2);
            h16* Yraw = (lj == 0) ? (h16*)(ws + A_V2) : (h16*)(ws + WS_VF);
            bf16_t* LH = (bf16_t*)(ws + A_LH);
            {
                pg8::Gemm g{(const bf16_t*)(ws + A_HN), (const bf16_t*)(ws + WS_W + W_RW_IN), M, 3840, 2048, D, 2048, 1};
                pg8::StaticOrder so; so.init(M, 3840, G, (int)blockIdx.x);
                pg8::EpiP<FRwIn> E{FRwIn{Rb, Kb, Vb, LH}};
                pg8::gemm_phase<pg8::EpiP<FRwIn>, true>(lds, g, so, E);
            }
            GSYNC();
            {
                pg8::StaticOrder so; so.init(M, D, G, (int)blockIdx.x);
                { pg8::Gemm g{LH, (const bf16_t*)(ws + WS_W + W_RW_W2), M, D, 128, 768, 128, 0}; pg8::EpiP<FLoraW> E{FLoraW{EWb, P.in[16] + lj * D}}; pg8::gemm_phase<pg8::EpiP<FLoraW>, true>(lds, g, so, E); }
                { pg8::Gemm g{LH + 128, (const bf16_t*)(ws + WS_W + W_RW_A2), M, D, 128, 768, 128, 0}; pg8::EpiP<FLoraA> E{FLoraA{Ab, P.in[19] + lj * D}}; pg8::gemm_phase<pg8::EpiP<FLoraA>, true>(lds, g, so, E); }
                if (lj >= 1) { pg8::Gemm g{LH + 512, (const bf16_t*)(ws + WS_W + W_RW_V2), M, D, 128, 768, 128, 0}; pg8::EpiP<FLoraV> E{FLoraV{Vb, (const h16*)(ws + WS_VF), P.in[30]}}; pg8::gemm_phase<pg8::EpiP<FLoraV>, true>(lds, g, so, E); }
            }
            GSYNC();
            rwkv_scan(Rb, Kb, Vb, EWb, Ab, P.in[24] + lj * D, P.in[25] + lj * D, Yraw, G, wave, lane);
            GSYNC();
            rwkv_gn(Rb, Kb, Vb, Ab, Yraw, P.in[25] + lj * D, P.in[26] + lj * D, P.in[27] + lj * D, P.in[28] + lj * D, gw, NGW, lane);
            GSYNC();
            {
                pg8::StaticOrder so; so.init(M, D, G, (int)blockIdx.x);
                pg8::Gemm g{LH + 256, (const bf16_t*)(ws + WS_W + W_RW_G2), M, D, 256, 768, 256, 0}; pg8::EpiP<FGate> E{FGate{(bf16_t*)Kb, Rb}}; pg8::gemm_phase<pg8::EpiP<FGate>, true>(lds, g, so, E);
            }
            GSYNC();
            {
                pg8::StaticOrder so; so.init(M, D, G, (int)blockIdx.x);
                pg8::Gemm g{(const bf16_t*)Kb, (const bf16_t*)(ws + WS_W + W_RW_O), M, D, D, D, D, 0}; pg8::EpiN<FResAdd> E{FResAdd{xres}}; pg8::gemm_phase<pg8::EpiN<FResAdd>, true>(lds, g, so, E);
            }
            GSYNC();
        }
        for (int m = gw; m < M; m += NGW) rms_row_bf16(xres + (size_t)m * D, norm_mlp + layer * D, (bf16_t*)(ws + A_HN) + (size_t)m * D, nullptr, lane);
        GSYNC();
        {
            pg8::Gemm g{(const bf16_t*)(ws + A_HN), (const bf16_t*)(ws + WS_W + W_MLP1), M, FF, D, D, D, 0};
            pg8::StaticOrder so; so.init(M, FF, G, (int)blockIdx.x);
            pg8::EpiP<FRelu2> E{FRelu2{(bf16_t*)(ws + A_HID)}};
            pg8::gemm_phase<pg8::EpiP<FRelu2>, true>(lds, g, so, E);
        }
        GSYNC();
        {
            pg8::Gemm g{(const bf16_t*)(ws + A_HID), (const bf16_t*)(ws + WS_W + W_MLP2), M, D, FF, FF, FF, 0};
            pg8::StaticOrder so; so.init(M, D, G, (int)blockIdx.x);
            pg8::EpiN<FResAdd> E{FResAdd{xres}};
            pg8::gemm_phase<pg8::EpiN<FResAdd>, true>(lds, g, so, E);
        }
        GSYNC();
    }
    for (int m = gw; m < M; m += NGW) {
        int lane2 = lane; asm volatile("" : "+v"(lane2));
        f32x4* xr = (f32x4*)(xres + (size_t)m * D) + lane2; const f32x4* gr = (const f32x4*)norm_final + lane2;
        f32x4 v[4]; float s = 0.f;
#pragma unroll
        for (int j = 0; j < 4; ++j) { v[j] = xr[64 * j]; s += (v[j].x * v[j].x + v[j].y * v[j].y) + (v[j].z * v[j].z + v[j].w * v[j].w); }
        const float r = rsqrtf(wave_sum(s) * (1.f / D) + 1e-5f);
#pragma unroll
        for (int j = 0; j < 4; ++j) { const f32x4 gg = gr[64 * j]; xr[64 * j] = v[j] * r * gg; }
    }
}

extern "C" void kernel_launch(void* const* d_in, const int* in_sizes, int n_in, void* d_out, int out_size, void* d_ws, size_t ws_size, hipStream_t stream) {
    static int grid = 0;
    if (grid == 0) {
        if (n_in != 33 || out_size != M * D || ws_size < WS_NEED) { fprintf(stderr, "kernel_launch: unexpected sizes n_in %d out %d ws %zu (need %zu)\n", n_in, out_size, ws_size, (size_t)WS_NEED); grid = -1; return; }
        int dev = 0, cus = 0, per_cu = 0;
        hipGetDevice(&dev);
        hipDeviceGetAttribute(&cus, hipDeviceAttributeMultiprocessorCount, dev);
        if (hipFuncSetAttribute((const void*)fwd_kernel, hipFuncAttributeMaxDynamicSharedMemorySize, LDS_BYTES) != hipSuccess) { fprintf(stderr, "hipFuncSetAttribute failed\n"); grid = -1; return; }
        hipOccupancyMaxActiveBlocksPerMultiprocessor(&per_cu, (const void*)fwd_kernel, NTHREADS, LDS_BYTES);
        if (per_cu < 1) { fprintf(stderr, "occupancy query returned %d\n", per_cu); per_cu = 1; }
        (void)hipGetLastError();
        grid = cus * 1;
    }
    if (grid < 0) return;
    Params p{};
    for (int i = 0; i < 33; ++i) p.in[i] = (const float*)d_in[i];
    p.out = (float*)d_out; p.ws = (unsigned char*)d_ws;
    void* args[] = {&p};
    hipError_t e = hipLaunchCooperativeKernel((const void*)fwd_kernel, dim3(grid), dim3(NTHREADS), args, LDS_BYTES, stream);
    if (e != hipSuccess) fprintf(stderr, "cooperative launch failed: %s (grid %d)\n", hipGetErrorString(e), grid);
}
```

```cpp
#include <hip/hip_runtime.h>
#include <hip/hip_cooperative_groups.h>
#include <cstdio>
#include <cstdint>
namespace cg = cooperative_groups;

#define LAS __attribute__((address_space(3)))
typedef unsigned short bf16_t;
typedef short bf16x8 __attribute__((ext_vector_type(8)));
typedef float f32x4 __attribute__((ext_vector_type(4)));
typedef float f32x2 __attribute__((ext_vector_type(2)));
typedef unsigned u32x4 __attribute__((ext_vector_type(4)));
typedef unsigned u32x2 __attribute__((ext_vector_type(2)));
typedef _Float16 h16;
typedef _Float16 h16x2 __attribute__((ext_vector_type(2)));

constexpr int S = 16384, NB = 2, M = NB * S, D = 1024, FF = 4096;
constexpr int NWAVES = 8, NTHREADS = 512;
constexpr int LDS_BYTES = 147456;
constexpr size_t MiB = 1u << 20;
constexpr size_t WS_W = 0;
constexpr size_t W_MLP1 = 0, W_MLP2 = 8 * MiB;
constexpr size_t W_NSA_IN = 16 * MiB, W_NSA_V = 21 * MiB, W_NSA_O = 22 * MiB, W_C1K = 24 * MiB, W_C1V = 25 * MiB, W_C2K = 26 * MiB, W_C2V = 26 * MiB + 256 * 1024, W_CBIAS = 26 * MiB + 512 * 1024;
constexpr size_t W_RW_IN = 16 * MiB, W_RW_W2 = 31 * MiB, W_RW_A2 = 31 * MiB + 256 * 1024, W_RW_V2 = 31 * MiB + 512 * 1024, W_RW_G2 = 31 * MiB + 768 * 1024, W_RW_O = 33 * MiB;
constexpr size_t WS_ROPE = 36 * MiB;
constexpr size_t WS_VF = 40 * MiB;
constexpr size_t ACT = 104 * MiB;
constexpr size_t A_HN = ACT;
constexpr size_t A_Q = ACT + 65 * MiB;
constexpr size_t A_KF = ACT + 129 * MiB;
constexpr size_t A_VF = ACT + 194 * MiB;
constexpr size_t A_GATES = ACT + 226 * MiB;
constexpr size_t A_CHK = ACT + 233 * MiB, A_CHV = ACT + 237 * MiB, A_KC = ACT + 241 * MiB, A_VC = ACT + 242 * MiB;
constexpr size_t A_HID = ACT + 65 * MiB;
constexpr size_t A_R = ACT + 65 * MiB, A_K = ACT + 129 * MiB, A_V2 = ACT + 193 * MiB, A_A = ACT + 257 * MiB, A_LH = ACT + 321 * MiB;
constexpr size_t WS_NEED = ACT + 370 * MiB;

__device__ __forceinline__ unsigned cvt_pk_bf16(float lo, float hi) { unsigned r; asm volatile("v_cvt_pk_bf16_f32 %0, %1, %2" : "=v"(r) : "v"(lo), "v"(hi)); return r; }
__device__ __forceinline__ unsigned pk_h16(float lo, float hi) { h16x2 v; v.x = (h16)lo; v.y = (h16)hi; return __builtin_bit_cast(unsigned, v); }
__device__ __forceinline__ float bf2f(bf16_t b) { return __uint_as_float(((unsigned)b) << 16); }
__device__ __forceinline__ float wave_sum(float v) {
#pragma unroll
    for (int o = 1; o < 64; o <<= 1) v += __shfl_xor(v, o);
    return v;
}
__device__ __forceinline__ float sigmoidf_(float x) { return 1.0f / (1.0f + __expf(-x)); }
__device__ __forceinline__ float tanhf_(float x) { float e = __expf(-2.0f * fabsf(x)); float t = (1.0f - e) / (1.0f + e); return x < 0.f ? -t : t; }

namespace pg8 {
constexpr int BM = 256, BK = 64, HALF = 128, HTB = HALF * BK * 2, STAGE_BYTES = 8 * HTB, NXCD = 8, WGM = 8;
__host__ __device__ __forceinline__ int lds_byte(int r, int c) { const int st = (r >> 4) * 2 + (c >> 5), rr = r & 15, cc = c & 31, ob = rr * 64 + cc * 2; return st * 1024 + (ob ^ (((ob >> 9) & 1) << 5)); }
__host__ __device__ __forceinline__ void stage_rc(int b, int& R, int& C) { const int st = b / 1024, sb = b % 1024, swz = sb ^ (((sb >> 9) & 1) << 5); R = (st >> 1) * 16 + swz / 64; C = (st & 1) * 32 + (swz % 64) / 2; }
__host__ __device__ __forceinline__ int perm32(int rho) { const int n = rho >> 4, i = rho & 15; return 8 * (i >> 2) + 4 * n + (i & 3); }
struct Unit { int pm, pn; };
struct Gemm { const bf16_t* A; const bf16_t* Bt; int M, N, K, lda, ldb, amode; };
struct StaticOrder {
    int nM, nN, nwg, G, c;
    __device__ void init(int M_, int N_, int G_, int c_) { nM = M_ / BM; nN = N_ / BM; nwg = nM * nN; G = G_; c = c_; }
    __device__ bool next(int i, Unit& u) const {
        const long L = (long)i * G + c; if (L >= nwg) return false;
        int wgid = (int)L; { const int q = nwg / NXCD, r = nwg % NXCD, xcd = wgid % NXCD, off = wgid / NXCD; wgid = (xcd < r ? xcd * (q + 1) : r * (q + 1) + (xcd - r) * q) + off; }
        const int nig = WGM * nN, gid = wgid / nig, fm = gid * WGM, gsz = (nM - fm) < WGM ? (nM - fm) : WGM;
        u.pm = fm + ((wgid % nig) % gsz); u.pn = (wgid % nig) / gsz; return true;
    }
};
__device__ __forceinline__ const char* a_base(const Gemm& g, int pm) { const size_t row = (size_t)pm * BM + (g.amode == 1 ? (size_t)(pm / 64) : 0); return (const char*)g.A + row * (size_t)g.lda * 2; }

template <class Epi, bool ALIGN_EPI>
__device__ __forceinline__ void gemm_phase(LAS unsigned char* lds, const Gemm g, const StaticOrder& S, const Epi& E) {
    int tid = threadIdx.x; asm volatile("" : "+v"(tid));
    const int wid = __builtin_amdgcn_readfirstlane(tid >> 6), lane = tid & 63, wr = wid >> 2, wc = wid & 3, fr = lane & 15, fq = lane >> 4;
    int K = g.K; asm volatile("" : "+s"(K));
    const int nt = K / BK;
    unsigned voffA[2], voffB[2];
#pragma unroll
    for (int i = 0; i < 2; ++i) { int R, C; stage_rc(tid * 16 + i * 8192, R, C); const int Rb = Epi::PERM ? ((R & ~31) + perm32(R & 31)) : R;
        voffA[i] = (unsigned)(R * g.lda + C) * 2u; voffB[i] = (unsigned)(Rb * g.ldb + C) * 2u; }
    const size_t kstep = (size_t)(BK * 2);
    const size_t hstepA = (size_t)HALF * g.lda * 2, hstepB = (size_t)HALF * g.ldb * 2;
    const size_t tstepB = 2 * hstepB;
    const unsigned ldsw = (unsigned)wid * 1024u;
    const int aoff = lds_byte(wr * 64 + fr, fq * 8), boff = lds_byte(wc * 32 + fr, fq * 8);
#define PG8_SA(b, h) (((b) * 2 + (h)) * HTB)
#define PG8_SB(b, h) ((4 + (b) * 2 + (h)) * HTB)
#define PG8_STAGE(bufoff, gbase, voff) do { _Pragma("unroll") for (int _i = 0; _i < 2; ++_i) \
        __builtin_amdgcn_global_load_lds((const unsigned*)((const char*)(gbase) + (voff)[_i]), (LAS unsigned*)(lds + (bufoff) + ldsw + _i * 8192), 16, 0, 0); } while (0)
#define PG8_LDA(dst, b, h) do { _Pragma("unroll") for (int m = 0; m < 4; ++m) _Pragma("unroll") for (int k = 0; k < 2; ++k) dst[m][k] = *(const LAS bf16x8*)(lds + PG8_SA(b, h) + aoff + m * 2048 + k * 1024); } while (0)
#define PG8_LDB(dst, b, h) do { _Pragma("unroll") for (int n = 0; n < 2; ++n) _Pragma("unroll") for (int k = 0; k < 2; ++k) dst[n][k] = *(const LAS bf16x8*)(lds + PG8_SB(b, h) + boff + n * 2048 + k * 1024); } while (0)
#define PG8_MMA(ai, bj, At, Bt) do { __builtin_amdgcn_s_setprio(1); _Pragma("unroll") for (int m = 0; m < 4; ++m) _Pragma("unroll") for (int n = 0; n < 2; ++n) _Pragma("unroll") for (int k = 0; k < 2; ++k) \
        acc[ai][bj][m][n] = __builtin_amdgcn_mfma_f32_16x16x32_bf16(Bt[n][k], At[m][k], acc[ai][bj][m][n], 0, 0, 0); __builtin_amdgcn_s_setprio(0); } while (0)
#define PG8_WAIT_V(n) asm volatile("s_waitcnt vmcnt(" #n ")" ::: "memory")
#define PG8_WAIT_L(n) asm volatile("s_waitcnt lgkmcnt(" #n ")" ::: "memory")
#define PG8_BAR __builtin_amdgcn_s_barrier()
#define PG8_SCHED __builtin_amdgcn_sched_barrier(0)
    Unit cur, nxt; int ui = 0;
    if (!S.next(0, cur)) return;
    f32x4 acc[2][2][4][2];
#pragma unroll
    for (int a = 0; a < 2; ++a)
#pragma unroll
        for (int b = 0; b < 2; ++b)
#pragma unroll
            for (int m = 0; m < 4; ++m)
#pragma unroll
                for (int n = 0; n < 2; ++n) acc[a][b][m][n] = (f32x4){0.f, 0.f, 0.f, 0.f};
    bf16x8 At[4][2], B0[2][2], B1[2][2];
    const char* cA = a_base(g, cur.pm); const char* cB = (const char*)g.Bt + (size_t)cur.pn * tstepB;
    PG8_STAGE(PG8_SB(0, 0), cB, voffB); PG8_STAGE(PG8_SB(0, 1), cB + hstepB, voffB); PG8_STAGE(PG8_SA(0, 0), cA, voffA); PG8_STAGE(PG8_SA(0, 1), cA + hstepA, voffA);
    if (wr == 1) PG8_BAR;
    PG8_WAIT_V(2); PG8_BAR;
    PG8_STAGE(PG8_SB(1, 0), cB + kstep, voffB); PG8_STAGE(PG8_SA(1, 0), cA + kstep, voffA); PG8_STAGE(PG8_SB(1, 1), cB + hstepB + kstep, voffB);
    PG8_WAIT_V(6); PG8_BAR;
    for (;;) {
        const bool has_next = S.next(ui + 1, nxt);
        const char* nA = has_next ? a_base(g, nxt.pm) : cA; const char* nB = has_next ? (const char*)g.Bt + (size_t)nxt.pn * tstepB : cB;
        for (int t = 0; t < nt; t += 2) {
            const bool last = (t == nt - 2);
            const char* a1 = cA + (size_t)(t + 1) * kstep;
            const char* a2 = last ? nA : cA + (size_t)(t + 2) * kstep; const char* b2 = last ? nB : cB + (size_t)(t + 2) * kstep;
            const char* a3 = a2 + kstep; const char* b3 = b2 + kstep;
            PG8_LDB(B0, 0, 0); PG8_LDB(B1, 0, 1); PG8_SCHED; PG8_LDA(At, 0, 0); PG8_STAGE(PG8_SA(1, 1), a1 + hstepA, voffA);
            PG8_WAIT_V(8); PG8_WAIT_L(0); PG8_BAR; PG8_MMA(0, 0, At, B0); PG8_MMA(0, 1, At, B1); PG8_BAR; PG8_SCHED;
            PG8_LDA(At, 0, 1); PG8_STAGE(PG8_SB(0, 0), b2, voffB); PG8_STAGE(PG8_SB(0, 1), b2 + hstepB, voffB); PG8_STAGE(PG8_SA(0, 0), a2, voffA);
            PG8_WAIT_V(8); PG8_WAIT_L(0); PG8_BAR; PG8_MMA(1, 0, At, B0); PG8_MMA(1, 1, At, B1); PG8_BAR; PG8_SCHED;
            PG8_LDB(B0, 1, 0); PG8_LDB(B1, 1, 1); PG8_SCHED; PG8_LDA(At, 1, 0); PG8_STAGE(PG8_SA(0, 1), a2 + hstepA, voffA);
            PG8_WAIT_V(8); PG8_WAIT_L(0); PG8_BAR; PG8_MMA(0, 0, At, B0); PG8_MMA(0, 1, At, B1); PG8_BAR; PG8_SCHED;
            PG8_LDA(At, 1, 1); PG8_STAGE(PG8_SB(1, 0), b3, voffB); PG8_STAGE(PG8_SB(1, 1), b3 + hstepB, voffB); PG8_STAGE(PG8_SA(1, 0), a3, voffA);
            PG8_WAIT_V(8); PG8_WAIT_L(0); PG8_BAR; PG8_MMA(1, 0, At, B0); PG8_MMA(1, 1, At, B1); PG8_BAR; PG8_SCHED;
        }
        if constexpr (ALIGN_EPI) { if (wr == 0) PG8_BAR; }
        E(acc, cur, wr, wc, fr, fq);
        if (!has_next) break;
#pragma unroll
        for (int a = 0; a < 2; ++a)
#pragma unroll
            for (int b = 0; b < 2; ++b)
#pragma unroll
                for (int m = 0; m < 4; ++m)
#pragma unroll
                    for (int n = 0; n < 2; ++n) acc[a][b][m][n] = (f32x4){0.f, 0.f, 0.f, 0.f};
        cur = nxt; cA = nA; cB = nB; ++ui;
        if constexpr (ALIGN_EPI) { if (wr == 1) PG8_BAR; }
    }
    PG8_WAIT_V(0);
    if constexpr (!ALIGN_EPI) { if (wr == 0) PG8_BAR; }
    PG8_BAR;
#undef PG8_SA
#undef PG8_SB
#undef PG8_STAGE
#undef PG8_LDA
#undef PG8_LDB
#undef PG8_MMA
#undef PG8_WAIT_V
#undef PG8_WAIT_L
#undef PG8_BAR
#undef PG8_SCHED
}
template <class F> struct EpiP {
    static constexpr bool PERM = true; F f;
    __device__ __forceinline__ void operator()(const f32x4 (&acc)[2][2][4][2], const Unit& u, int wr, int wc, int fr, int fq) const {
#pragma unroll
        for (int ai = 0; ai < 2; ++ai)
#pragma unroll
            for (int m = 0; m < 4; ++m) { int row = u.pm * BM + ai * HALF + wr * 64 + m * 16 + fr; asm volatile("" : "+v"(row));
#pragma unroll
                for (int bj = 0; bj < 2; ++bj) { const int col0 = u.pn * BM + bj * HALF + wc * 32 + 8 * fq; f(row, col0, acc[ai][bj][m][0], acc[ai][bj][m][1]); } asm volatile("" ::: "memory"); }
    }
};
template <class F> struct EpiN {
    static constexpr bool PERM = false; F f;
    __device__ __forceinline__ void operator()(const f32x4 (&acc)[2][2][4][2], const Unit& u, int wr, int wc, int fr, int fq) const {
#pragma unroll
        for (int ai = 0; ai < 2; ++ai)
#pragma unroll
            for (int m = 0; m < 4; ++m) { int row = u.pm * BM + ai * HALF + wr * 64 + m * 16 + fr; asm volatile("" : "+v"(row));
#pragma unroll
                for (int bj = 0; bj < 2; ++bj)
#pragma unroll
                    for (int n = 0; n < 2; ++n) { const int col0 = u.pn * BM + bj * HALF + wc * 32 + 16 * n + 4 * fq; f(row, col0, acc[ai][bj][m][n]); } asm volatile("" ::: "memory"); }
    }
};
}

struct Params {
    const float* in[33];
    float* out;
    unsigned char* ws;
};

struct TJob { const float* W; int ldw, n0src, Nsrc, Ksrc; bf16_t* WT; int ldt, row_off, col_off, Npad, Kpad; const float* mix; int mode; };
__device__ __forceinline__ void transpose_job(const TJob& j, LAS float* scr, int gw, int NGW, int lane_) {
    int lane = lane_; asm volatile("" : "+v"(lane));
    const int nblk = j.Npad / 32, kblk = j.Kpad / 64, items = nblk * kblk;
    for (int it = gw; it < items; it += NGW) {
        const int kb = it / nblk, nb = it % nblk, k0 = 64 * kb, n0 = 32 * nb;
#pragma unroll 4
        for (int i = 0; i < 32; ++i) { const int kk = 2 * i + (lane >> 5), n = lane & 31; float v = 0.f;
            if (k0 + kk < j.Ksrc && n0 + n < j.Nsrc) { v = j.W[(size_t)(k0 + kk) * j.ldw + j.n0src + n0 + n];
                if (j.mode == 1) v *= j.mix[k0 + kk]; else if (j.mode == 2) v *= (1.0f - j.mix[k0 + kk]); }
            scr[kk * 33 + n] = v; }
        asm volatile("s_waitcnt lgkmcnt(0)" ::: "memory");
        const int c = lane & 7;
#pragma unroll
        for (int jj = 0; jj < 4; ++jj) { const int n = (lane >> 3) + 8 * jj; const LAS float* s = scr + (8 * c) * 33 + n;
            u32x4 o; o.x = cvt_pk_bf16(s[0 * 33], s[1 * 33]); o.y = cvt_pk_bf16(s[2 * 33], s[3 * 33]); o.z = cvt_pk_bf16(s[4 * 33], s[5 * 33]); o.w = cvt_pk_bf16(s[6 * 33], s[7 * 33]);
            *(u32x4*)(j.WT + (size_t)(j.row_off + n0 + n) * j.ldt + j.col_off + k0 + 8 * c) = o; }
        asm volatile("s_waitcnt lgkmcnt(0)" ::: "memory");
    }
}

__device__ __forceinline__ void rms_row_bf16(const float* xrow, const float* g, bf16_t* orow, float* copy_to, int lane_) {
    int lane = lane_; asm volatile("" : "+v"(lane));
    const f32x4* xr = (const f32x4*)xrow + lane; const f32x4* gr = (const f32x4*)g + lane;
    f32x4 v[4]; float s = 0.f;
#pragma unroll
    for (int j = 0; j < 4; ++j) { v[j] = xr[64 * j]; s += (v[j].x * v[j].x + v[j].y * v[j].y) + (v[j].z * v[j].z + v[j].w * v[j].w); }
    if (copy_to) {
#pragma unroll
        for (int j = 0; j < 4; ++j) ((f32x4*)copy_to + lane)[64 * j] = v[j];
    }
    const float r = rsqrtf(wave_sum(s) * (1.f / D) + 1e-5f);
    u32x2* o8 = (u32x2*)orow + lane;
#pragma unroll
    for (int j = 0; j < 4; ++j) { const f32x4 gg = gr[64 * j]; u32x2 w; w.x = cvt_pk_bf16(v[j].x * r * gg.x, v[j].y * r * gg.y); w.y = cvt_pk_bf16(v[j].z * r * gg.z, v[j].w * r * gg.w); o8[64 * j] = w; }
}

struct FRelu2 { bf16_t* O; __device__ __forceinline__ void operator()(int row, int col0, f32x4 a, f32x4 b) const {
    f32x4 x = a, y = b;
#pragma unroll
    for (int i = 0; i < 4; ++i) { float t = fmaxf(x[i], 0.f); x[i] = t * t; t = fmaxf(y[i], 0.f); y[i] = t * t; }
    u32x4 w; w.x = cvt_pk_bf16(x[0], x[1]); w.y = cvt_pk_bf16(x[2], x[3]); w.z = cvt_pk_bf16(y[0], y[1]); w.w = cvt_pk_bf16(y[2], y[3]);
    *(u32x4*)(O + (size_t)row * FF + col0) = w; } };
struct FResAdd { float* X; __device__ __forceinline__ void operator()(int row, int col0, f32x4 a) const {
    f32x4* p = (f32x4*)(X + (size_t)row * D + col0); *p = *p + a; } };


struct FRwIn { h16* R; h16* Kk; h16* V; bf16_t* LH;
    __device__ __forceinline__ void operator()(int row, int col0, f32x4 a, f32x4 b) const {
        const int seg = __builtin_amdgcn_readfirstlane(col0 >> 10);
        if (seg < 3) { const long dK = (const char*)Kk - (const char*)R, dV = (const char*)V - (const char*)R; const long off = (seg == 1 ? dK : 0l) + (seg == 2 ? dV : 0l); h16* dst = (h16*)((char*)R + off); const int c = col0 & 1023;
            u32x4 w; w.x = pk_h16(a[0], a[1]); w.y = pk_h16(a[2], a[3]); w.z = pk_h16(b[0], b[1]); w.w = pk_h16(b[2], b[3]);
            *(u32x4*)(dst + (size_t)row * D + c) = w; }
        else { const int c = col0 - 3072; f32x4 x = a, y = b;
            if (c < 128) {
#pragma unroll
                for (int i = 0; i < 4; ++i) { x[i] = tanhf_(x[i]); y[i] = tanhf_(y[i]); } }
            else if (c >= 256 && c < 512) {
#pragma unroll
                for (int i = 0; i < 4; ++i) { x[i] = sigmoidf_(x[i]); y[i] = sigmoidf_(y[i]); } }
            u32x4 w; w.x = cvt_pk_bf16(x[0], x[1]); w.y = cvt_pk_bf16(x[2], x[3]); w.z = cvt_pk_bf16(y[0], y[1]); w.w = cvt_pk_bf16(y[2], y[3]);
            *(u32x4*)(LH + (size_t)row * 768 + c) = w; }
    } };
struct FLoraW { h16* EW; const float* w0;
    __device__ __forceinline__ void operator()(int row, int col0, f32x4 a, f32x4 b) const {
        const f32x4 p = *(const f32x4*)(w0 + col0), q = *(const f32x4*)(w0 + col0 + 4); float o[8];
#pragma unroll
        for (int i = 0; i < 4; ++i) { o[i] = 0.60653066f * sigmoidf_(p[i] + a[i]); o[4 + i] = 0.60653066f * sigmoidf_(q[i] + b[i]); }
        u32x4 w; w.x = pk_h16(o[0], o[1]); w.y = pk_h16(o[2], o[3]); w.z = pk_h16(o[4], o[5]); w.w = pk_h16(o[6], o[7]);
        *(u32x4*)(EW + (size_t)row * D + col0) = w; } };
struct FLoraA { h16* Aa; const float* a0;
    __device__ __forceinline__ void operator()(int row, int col0, f32x4 a, f32x4 b) const {
        const f32x4 p = *(const f32x4*)(a0 + col0), q = *(const f32x4*)(a0 + col0 + 4); float o[8];
#pragma unroll
        for (int i = 0; i < 4; ++i) { o[i] = sigmoidf_(p[i] + a[i]); o[4 + i] = sigmoidf_(q[i] + b[i]); }
        u32x4 w; w.x = pk_h16(o[0], o[1]); w.y = pk_h16(o[2], o[3]); w.z = pk_h16(o[4], o[5]); w.w = pk_h16(o[6], o[7]);
        *(u32x4*)(Aa + (size_t)row * D + col0) = w; } };
struct FLoraV { h16* V; const h16* VFm; const float* v0;
    __device__ __forceinline__ void operator()(int row, int col0, f32x4 a, f32x4 b) const {
        const f32x4 p = *(const f32x4*)(v0 + col0), q = *(const f32x4*)(v0 + col0 + 4);
        typedef h16 h16x8 __attribute__((ext_vector_type(8)));
        const h16x8 vv = *(const h16x8*)(V + (size_t)row * D + col0), vf = *(const h16x8*)(VFm + (size_t)row * D + col0); float o[8];
#pragma unroll
        for (int i = 0; i < 4; ++i) { float v = (float)vv[i], f = (float)vf[i]; o[i] = v + (f - v) * sigmoidf_(p[i] + a[i]); v = (float)vv[4 + i]; f = (float)vf[4 + i]; o[4 + i] = v + (f - v) * sigmoidf_(q[i] + b[i]); }
        u32x4 w; w.x = pk_h16(o[0], o[1]); w.y = pk_h16(o[2], o[3]); w.z = pk_h16(o[4], o[5]); w.w = pk_h16(o[6], o[7]);
        *(u32x4*)(V + (size_t)row * D + col0) = w; } };
struct FGate { bf16_t* O; const h16* Y;
    __device__ __forceinline__ void operator()(int row, int col0, f32x4 a, f32x4 b) const {
        typedef h16 h16x8 __attribute__((ext_vector_type(8)));
        const h16x8 yy = *(const h16x8*)(Y + (size_t)row * D + col0);
        u32x4 w; w.x = cvt_pk_bf16(a[0] * (float)yy[0], a[1] * (float)yy[1]); w.y = cvt_pk_bf16(a[2] * (float)yy[2], a[3] * (float)yy[3]);
        w.z = cvt_pk_bf16(b[0] * (float)yy[4], b[1] * (float)yy[5]); w.w = cvt_pk_bf16(b[2] * (float)yy[6], b[3] * (float)yy[7]);
        *(u32x4*)(O + (size_t)row * D + col0) = w; } };

template <int CTRL> __device__ __forceinline__ float dppmov(float v) { return __builtin_bit_cast(float, __builtin_amdgcn_update_dpp(0, __builtin_bit_cast(int, v), CTRL, 0xF, 0xF, true)); }
__device__ __forceinline__ float row16_sum(float v) { v += dppmov<0xB1>(v); v += dppmov<0x4E>(v); v += dppmov<0x124>(v); v += dppmov<0x128>(v); return v; }
typedef _Float16 h16x4 __attribute__((ext_vector_type(4)));
__device__ __forceinline__ void h4_to_f(h16x4 u, float* f) { f[0] = (float)u[0]; f[1] = (float)u[1]; f[2] = (float)u[2]; f[3] = (float)u[3]; }
__device__ __forceinline__ void rwkv_scan(const h16* R, const h16* Kk, const h16* V, const h16* EW, const h16* Aa, const float* k_k, const float* k_a, h16* Yraw, int G, int wave, int lane_) {
    int lane = lane_; asm volatile("" : "+v"(lane));
    const int NT = G * NWAVES;
    for (int task = wave * G + (int)blockIdx.x; task < 512; task += NT) {
        const int bh = task >> 4, rg = task & 15, b = bh >> 4, h = bh & 15;
        const int row = lane >> 4, jg = lane & 15, i = rg * 4 + row;
        const int colj = h * 64 + 4 * jg, coli = h * 64 + i;
        float kkc[4], kac[4];
#pragma unroll
        for (int j = 0; j < 4; ++j) { kkc[j] = k_k[colj + j]; kac[j] = k_a[colj + j]; }
        float s[4] = {0.f, 0.f, 0.f, 0.f};
        const size_t base = (size_t)b * S * D;
        const h16* pR = R + base + colj; const h16* pK = Kk + base + colj; const h16* pA = Aa + base + colj; const h16* pE = EW + base + colj; const h16* pV = V + base + coli;
        h16* pY = Yraw + ((size_t)task * S) * 4 + row;
        constexpr int TC = 4;
        h16x4 cr[TC], ck[TC], ca[TC], ce[TC]; h16 cv[TC];
#pragma unroll
        for (int u = 0; u < TC; ++u) { const size_t o = (size_t)u * D; cr[u] = *(const h16x4*)(pR + o); ck[u] = *(const h16x4*)(pK + o); ca[u] = *(const h16x4*)(pA + o); ce[u] = *(const h16x4*)(pE + o); cv[u] = pV[o]; }
        for (int t0 = 0; t0 < S; t0 += TC) {
            const int tn = (t0 + TC < S) ? t0 + TC : t0;
            h16x4 nr[TC], nk[TC], na[TC], ne[TC]; h16 nv[TC];
#pragma unroll
            for (int u = 0; u < TC; ++u) { const size_t o = (size_t)(tn + u) * D; nr[u] = *(const h16x4*)(pR + o); nk[u] = *(const h16x4*)(pK + o); na[u] = *(const h16x4*)(pA + o); ne[u] = *(const h16x4*)(pE + o); nv[u] = pV[o]; }
#pragma unroll
            for (int u = 0; u < TC; ++u) {
                float rv[4], kv[4], av[4], ev[4]; h4_to_f(cr[u], rv); h4_to_f(ck[u], kv); h4_to_f(ca[u], av); h4_to_f(ce[u], ev);
                const float vi = (float)cv[u];
                float kq[4], n2 = 0.f;
#pragma unroll
                for (int j = 0; j < 4; ++j) { kq[j] = kv[j] * kkc[j]; n2 += kq[j] * kq[j]; }
                n2 = row16_sum(n2);
                const float inv = 1.0f / fmaxf(sqrtf(n2), 1e-12f);
                float kkj[4], kt[4], bb[4], w[4], dot = 0.f;
#pragma unroll
                for (int j = 0; j < 4; ++j) { kkj[j] = kq[j] * inv; kt[j] = kv[j] * (1.0f + (av[j] - 1.0f) * kac[j]); bb[j] = kkj[j] * av[j]; w[j] = __expf(-ev[j]); dot += s[j] * kkj[j]; }
                const float sa = -row16_sum(dot);
                float yd = 0.f;
#pragma unroll
                for (int j = 0; j < 4; ++j) { s[j] = s[j] * w[j] + (sa * bb[j] + vi * kt[j]); yd += s[j] * rv[j]; }
                const float y = row16_sum(yd);
                if (jg == 0) pY[(size_t)(t0 + u) * 4] = (h16)y;
            }
#pragma unroll
            for (int u = 0; u < TC; ++u) { cr[u] = nr[u]; ck[u] = nk[u]; ca[u] = na[u]; ce[u] = ne[u]; cv[u] = nv[u]; }
        }
    }
}
constexpr int SC_CS = 32, SC_STEP_F = 5 * 64 + 8, SC_BUF_F = SC_CS * SC_STEP_F;
#define SC_BAR() do { asm volatile("s_waitcnt lgkmcnt(0)" ::: "memory"); __builtin_amdgcn_s_barrier(); asm volatile("" ::: "memory"); } while (0)
__device__ __forceinline__ float wave_sum_dpp(float v) {
    v = row16_sum(v);
    const float a = __builtin_bit_cast(float, __builtin_amdgcn_readlane(__builtin_bit_cast(int, v), 0)), b = __builtin_bit_cast(float, __builtin_amdgcn_readlane(__builtin_bit_cast(int, v), 16));
    const float c = __builtin_bit_cast(float, __builtin_amdgcn_readlane(__builtin_bit_cast(int, v), 32)), d = __builtin_bit_cast(float, __builtin_amdgcn_readlane(__builtin_bit_cast(int, v), 48));
    return (a + b) + (c + d);
}
struct ScRegs { h16 k[8], a[8], e[8], r[8], v[8]; };
__device__ __forceinline__ void sc_load(ScRegs& g, const h16* R, const h16* Kk, const h16* V, const h16* EW, const h16* Aa, size_t base, int c, int pw, int sub, int lane) {
#pragma unroll
    for (int q = 0; q < 8; ++q) { const size_t o = base + (size_t)(c * SC_CS + pw + 4 * q) * D;
        g.k[q] = Kk[o + lane]; g.a[q] = Aa[o + lane]; g.e[q] = EW[o + lane]; g.r[q] = R[o + lane]; g.v[q] = V[o + sub * 8 + (lane & 7)]; }
}
__device__ __forceinline__ void sc_compute(const ScRegs& g, LAS float* sb, int pw, float kkc, float kac, int lane) {
#pragma unroll
    for (int q = 0; q < 8; ++q) {
        const float kv = (float)g.k[q], av = (float)g.a[q], ev = (float)g.e[q], rv = (float)g.r[q]; const float kq = kv * kkc;
        const float n2 = wave_sum_dpp(kq * kq);
        const float kkj = kq * rsqrtf(fmaxf(n2, 1e-24f)); LAS float* p = sb + (pw + 4 * q) * SC_STEP_F;
        p[lane] = kkj; p[64 + lane] = kkj * av; p[128 + lane] = kv * (1.0f + (av - 1.0f) * kac); p[192 + lane] = __expf(-ev); p[256 + lane] = rv; if (lane < 8) p[320 + lane] = (float)g.v[q];
    }
}
__device__ __forceinline__ void rwkv_scan2(const h16* R, const h16* Kk, const h16* V, const h16* EW, const h16* Aa, const float* k_k, const float* k_a, h16* Yraw, LAS unsigned char* lds, int wave, int lane_) {
    int lane = lane_; asm volatile("" : "+v"(lane));
    LAS float* buf = (LAS float*)lds;
    constexpr int NCH = S / SC_CS;
#pragma unroll 1
    for (int vb = (int)blockIdx.x; vb < 256; vb += (int)gridDim.x) {
        const int bh = vb >> 3, sub = vb & 7, b = bh >> 4, h = bh & 15;
        const size_t base = (size_t)b * S * D + h * 64;
        if (wave >= 4) {
            const int pw = wave - 4;
            const float kkc = k_k[h * 64 + lane], kac = k_a[h * 64 + lane];
            ScRegs ga, gb;
            sc_load(ga, R, Kk, V, EW, Aa, base, 0, pw, sub, lane);
            sc_load(gb, R, Kk, V, EW, Aa, base, 1, pw, sub, lane);
            sc_compute(ga, buf, pw, kkc, kac, lane);
            SC_BAR();
#pragma unroll 1
            for (int c = 0; c < NCH; c += 2) {
                { const int c2 = (c + 2 < NCH) ? c + 2 : c; sc_load(ga, R, Kk, V, EW, Aa, base, c2, pw, sub, lane); }
                sc_compute(gb, buf + SC_BUF_F, pw, kkc, kac, lane);
                SC_BAR();
                { const int c3 = (c + 3 < NCH) ? c + 3 : c + 1; sc_load(gb, R, Kk, V, EW, Aa, base, c3, pw, sub, lane); }
                if (c + 2 < NCH) sc_compute(ga, buf, pw, kkc, kac, lane);
                SC_BAR();
            }
        } else if (wave < 2) {
            const int row = lane >> 4, jg = lane & 15, cw = wave;
            float s0 = 0.f, s1 = 0.f, s2 = 0.f, s3 = 0.f;
            h16* pY = Yraw + ((size_t)(bh * 16 + sub * 2 + cw) * S) * 4;
            LAS float* yb = buf + 2 * SC_BUF_F + cw * (SC_CS * 4);
            SC_BAR();
#pragma unroll 1
            for (int c = 0; c < NCH; ++c) {
                const LAS float* sb = buf + (c & 1) * SC_BUF_F + 4 * jg;
                const LAS float* vb_ = buf + (c & 1) * SC_BUF_F + 320 + cw * 4 + row;
                f32x4 kk4 = *(const LAS f32x4*)(sb), bb4 = *(const LAS f32x4*)(sb + 64), kt4 = *(const LAS f32x4*)(sb + 128), w4 = *(const LAS f32x4*)(sb + 192), r4 = *(const LAS f32x4*)(sb + 256); float vi = vb_[0];
#pragma unroll 4
                for (int st = 0; st < SC_CS; ++st) {
                    const int sn = (st + 1 < SC_CS) ? st + 1 : st;
                    const f32x4 nkk = *(const LAS f32x4*)(sb + sn * SC_STEP_F), nbb = *(const LAS f32x4*)(sb + sn * SC_STEP_F + 64), nkt = *(const LAS f32x4*)(sb + sn * SC_STEP_F + 128), nw = *(const LAS f32x4*)(sb + sn * SC_STEP_F + 192), nr4 = *(const LAS f32x4*)(sb + sn * SC_STEP_F + 256);
                    const float nvi = vb_[sn * SC_STEP_F];
                    const float sa = -row16_sum((s0 * kk4[0] + s1 * kk4[1]) + (s2 * kk4[2] + s3 * kk4[3]));
                    s0 = s0 * w4[0] + (sa * bb4[0] + vi * kt4[0]); s1 = s1 * w4[1] + (sa * bb4[1] + vi * kt4[1]);
                    s2 = s2 * w4[2] + (sa * bb4[2] + vi * kt4[2]); s3 = s3 * w4[3] + (sa * bb4[3] + vi * kt4[3]);
                    const float y = row16_sum((s0 * r4[0] + s1 * r4[1]) + (s2 * r4[2] + s3 * r4[3]));
                    if (jg == 0) yb[st * 4 + row] = y;
                    kk4 = nkk; bb4 = nbb; kt4 = nkt; w4 = nw; r4 = nr4; vi = nvi;
                }
                if (lane < SC_CS) { const f32x4 yv = *(const LAS f32x4*)(yb + lane * 4); h16x4 hv; hv[0] = (h16)yv[0]; hv[1] = (h16)yv[1]; hv[2] = (h16)yv[2]; hv[3] = (h16)yv[3];
                    *(h16x4*)(pY + (size_t)(c * SC_CS + lane) * 4) = hv; }
                SC_BAR();
            }
        } else {
            SC_BAR();
#pragma unroll 1
            for (int c = 0; c < NCH; ++c) SC_BAR();
        }
    }
}
__device__ __forceinline__ void rwkv_gn(h16* R, const h16* Kk, const h16* V, const h16* Aa, const h16* Yraw, const float* k_a, const float* r_k, const float* ln_w, const float* ln_b, int gw, int NGW, int lane_) {
    int lane = lane_; asm volatile("" : "+v"(lane));
    for (int idx = gw; idx < M * 16; idx += NGW) {
        const int m = idx >> 4, h = idx & 15, col = h * 64 + lane; const size_t o = (size_t)m * D + col;
        const int bq = m / S, tq = m - bq * S;
        const float y = (float)Yraw[((size_t)((bq * 16 + h) * 16 + (lane >> 2)) * S + tq) * 4 + (lane & 3)], r = (float)R[o], k = (float)Kk[o], a = (float)Aa[o], v = (float)V[o];
        const float mu = wave_sum(y) * (1.f / 64.f); const float d = y - mu; const float var = wave_sum(d * d) * (1.f / 64.f);
        const float yn = d * rsqrtf(var + 64e-5f) * ln_w[col] + ln_b[col];
        const float kt = k * (1.0f + (a - 1.0f) * k_a[col]);
        const float bs = wave_sum(r * kt * r_k[col]);
        R[o] = (h16)(yn + bs * v);
    }
}


constexpr size_t KF_STRIDE = (size_t)NB * 4 * S * 64;
__device__ __forceinline__ float gelu_tanh(float x) { const float u = 0.7978845608f * (x + 0.044715f * x * x * x); return 0.5f * x * (1.0f + tanhf_(u)); }
__device__ __forceinline__ void store_vf8(bf16_t* chunk_base_d, int keyp0  , f32x4 a, f32x4 b) {
    const int tile = keyp0 >> 4, rq0 = (keyp0 & 15) >> 2;
    u32x2 w0, w1; w0.x = cvt_pk_bf16(a[0], a[1]); w0.y = cvt_pk_bf16(a[2], a[3]); w1.x = cvt_pk_bf16(b[0], b[1]); w1.y = cvt_pk_bf16(b[2], b[3]);
    *(u32x2*)(chunk_base_d + 8 * rq0 + 4 * tile) = w0; *(u32x2*)(chunk_base_d + 8 * (rq0 + 1) + 4 * tile) = w1;
}
struct FNsaIn { bf16_t* Q; bf16_t* KF; float* gates; const float* rope;
    __device__ __forceinline__ void operator()(int row, int col0, f32x4 a, f32x4 b) const {
        const int tile = __builtin_amdgcn_readfirstlane(col0 >> 8);
        const int bb = row / S, t = row - bb * S;
        if (tile < 7) {
            f32x4 x = a, y = b;
            if ((col0 & 32) == 0) {
                f32x4 px, py;
#pragma unroll
                for (int i = 0; i < 4; ++i) { px[i] = __shfl_xor(x[i], 16); py[i] = __shfl_xor(y[i], 16); }
                const int d0 = col0 & 63;
                if (d0 < 16) { const f32x4 c0 = *(const f32x4*)(rope + t * 16), c1 = *(const f32x4*)(rope + t * 16 + 4), s0 = *(const f32x4*)(rope + t * 16 + 8), s1 = *(const f32x4*)(rope + t * 16 + 12);
                    if (d0 == 0) { x = x * c0 - px * s0; y = y * c1 - py * s1; } else { x = x * c0 + px * s0; y = y * c1 + py * s1; } }
            }
            if (tile < 4) { x = x * 0.125f; y = y * 0.125f;
                u32x4 w; w.x = cvt_pk_bf16(x[0], x[1]); w.y = cvt_pk_bf16(x[2], x[3]); w.z = cvt_pk_bf16(y[0], y[1]); w.w = cvt_pk_bf16(y[2], y[3]);
                *(u32x4*)(Q + (size_t)row * D + col0) = w; }
            else { const int idx = tile - 4, g = (col0 & 255) >> 6, d0 = col0 & 63;
                u32x4 w; w.x = cvt_pk_bf16(x[0], x[1]); w.y = cvt_pk_bf16(x[2], x[3]); w.z = cvt_pk_bf16(y[0], y[1]); w.w = cvt_pk_bf16(y[2], y[3]);
                *(u32x4*)(KF + (size_t)idx * KF_STRIDE + ((size_t)(bb * 4 + g) * S + t) * 64 + d0) = w; }
        } else if (tile == 7) { const int g = (col0 & 255) >> 6, d0 = col0 & 63;
            u32x4 w; w.x = cvt_pk_bf16(a[0], a[1]); w.y = cvt_pk_bf16(a[2], a[3]); w.z = cvt_pk_bf16(b[0], b[1]); w.w = cvt_pk_bf16(b[2], b[3]);
            *(u32x4*)(KF + (size_t)3 * KF_STRIDE + ((size_t)(bb * 4 + g) * S + t) * 64 + d0) = w;
        } else { const int c = col0 - 2048;
            if (c < 48) { f32x4 x, y;
#pragma unroll
                for (int i = 0; i < 4; ++i) { x[i] = sigmoidf_(a[i]); y[i] = sigmoidf_(b[i]); }
                *(f32x4*)(gates + (size_t)row * 48 + c) = x; *(f32x4*)(gates + (size_t)row * 48 + c + 4) = y; }
        }
    } };
struct FNsaVT { bf16_t* VF;
    __device__ __forceinline__ void operator()(int row, int col0, f32x4 a, f32x4 b) const {
        const int br = row >> 8, g = (row >> 6) & 3, d = row & 63, bb = col0 / S, t0 = col0 - bb * S;
        bf16_t* base = VF + (size_t)br * KF_STRIDE + (size_t)(bb * 4 + g) * S * 64 + (size_t)(t0 >> 5) * 2048 + d * 32;
        store_vf8(base, t0 & 31, a, b); } };
struct FCmp1 { bf16_t* CH; const float* bias;
    __device__ __forceinline__ void operator()(int row, int col0, f32x4 a, f32x4 b) const {
        const f32x4 p = *(const f32x4*)(bias + col0), q = *(const f32x4*)(bias + col0 + 4); float o[8];
#pragma unroll
        for (int i = 0; i < 4; ++i) { o[i] = gelu_tanh(a[i] + p[i]); o[4 + i] = gelu_tanh(b[i] + q[i]); }
        u32x4 w; w.x = cvt_pk_bf16(o[0], o[1]); w.y = cvt_pk_bf16(o[2], o[3]); w.z = cvt_pk_bf16(o[4], o[5]); w.w = cvt_pk_bf16(o[6], o[7]);
        *(u32x4*)(CH + (size_t)row * 256 + col0) = w; } };
struct FCmp2K { bf16_t* KC;
    __device__ __forceinline__ void operator()(int row, int col0, f32x4 a, f32x4 b) const {
        if (col0 < 64) { u32x4 w; w.x = cvt_pk_bf16(a[0], a[1]); w.y = cvt_pk_bf16(a[2], a[3]); w.z = cvt_pk_bf16(b[0], b[1]); w.w = cvt_pk_bf16(b[2], b[3]);
            *(u32x4*)(KC + (size_t)row * 64 + col0) = w; } } };
struct FCmp2VT { bf16_t* VC;
    __device__ __forceinline__ void operator()(int row, int col0, f32x4 a, f32x4 b) const {
        if (row < 64) { const int bg = col0 >> 10, n0 = col0 & 1023;
            bf16_t* base = VC + (size_t)bg * 65536 + (size_t)(n0 >> 5) * 2048 + row * 32; store_vf8(base, n0 & 31, a, b); } } };

__device__ __forceinline__ f32x4 mfma16(bf16x8 a, bf16x8 b, f32x4 c) { return __builtin_amdgcn_mfma_f32_16x16x32_bf16(a, b, c, 0, 0, 0); }
__device__ __forceinline__ bf16x8 ld8(const bf16_t* p) { return *(const bf16x8*)p; }
__device__ __forceinline__ bf16x8 pack8(f32x4 a, f32x4 b) { u32x4 w; w.x = cvt_pk_bf16(a[0], a[1]); w.y = cvt_pk_bf16(a[2], a[3]); w.z = cvt_pk_bf16(b[0], b[1]); w.w = cvt_pk_bf16(b[2], b[3]); return __builtin_bit_cast(bf16x8, w); }
__device__ __forceinline__ float colmax(float x) { x = fmaxf(x, __shfl_xor(x, 16)); return fmaxf(x, __shfl_xor(x, 32)); }
__device__ __forceinline__ float colsum(float x) { x += __shfl_xor(x, 16); return x + __shfl_xor(x, 32); }
struct AttnState { float m, l; f32x4 o[4]; };
__device__ __forceinline__ void attn_init(AttnState& st) { st.m = -1e30f; st.l = 0.f;
#pragma unroll
    for (int d = 0; d < 4; ++d) st.o[d] = (f32x4){0.f, 0.f, 0.f, 0.f}; }
__device__ __forceinline__ void attn_chunk(AttnState& st, const bf16_t* kptr, const bf16_t* vptr, const bf16x8 q0, const bf16x8 q1, unsigned vmask) {
    f32x4 s[2];
#pragma unroll
    for (int tl = 0; tl < 2; ++tl) { const bf16x8 k0 = ld8(kptr + tl * 1024), k1 = ld8(kptr + tl * 1024 + 32);
        s[tl] = mfma16(k0, q0, (f32x4){0.f, 0.f, 0.f, 0.f}); s[tl] = mfma16(k1, q1, s[tl]); }
    float mx = -1e30f;
#pragma unroll
    for (int tl = 0; tl < 2; ++tl)
#pragma unroll
        for (int i = 0; i < 4; ++i) { const bool v = (vmask >> (tl * 4 + i)) & 1u; s[tl][i] = v ? s[tl][i] : -1e30f; mx = fmaxf(mx, s[tl][i]); }
    mx = colmax(mx);
    const float mnew = fmaxf(st.m, mx), alpha = __expf(st.m - mnew);
    f32x4 p[2]; float ps = 0.f;
#pragma unroll
    for (int tl = 0; tl < 2; ++tl)
#pragma unroll
        for (int i = 0; i < 4; ++i) { const bool v = (vmask >> (tl * 4 + i)) & 1u; p[tl][i] = v ? __expf(s[tl][i] - mnew) : 0.f; ps += p[tl][i]; }
    st.l = st.l * alpha + ps; st.m = mnew;
    const bf16x8 pb = pack8(p[0], p[1]);
#pragma unroll
    for (int d = 0; d < 4; ++d) { st.o[d] = st.o[d] * alpha; st.o[d] = mfma16(ld8(vptr + d * 512), pb, st.o[d]); }
}

__device__ __forceinline__ void nsa_attention(const bf16_t* Q, const bf16_t* KF, const bf16_t* VF, const bf16_t* KC, const bf16_t* VC, const float* gates, bf16_t* OUT, LAS unsigned char* lds, int G, int wave, int lane_) {
    int lane = lane_; asm volatile("" : "+v"(lane));
    const int col = lane & 15, rq = lane >> 4;
    LAS float* imp = (LAS float*)(lds + wave * 18432);
    LAS int* sel = (LAS int*)(lds + wave * 18432 + 16384);
    const int NGWv = G * NWAVES;
#pragma unroll 1
    for (int task = (int)blockIdx.x * NWAVES + wave; task < 8192; task += NGWv) {
        const int tilei = task >> 3, bg = task & 7, b = bg >> 2, g = bg & 3, t0 = tilei * 16, t = t0 + col;
        const size_t rowq = (size_t)b * S + t;
        const bf16_t* qrow = Q + rowq * D + (g * 4) * 64 + 8 * rq;
        const float* grow = gates + rowq * 48 + g * 12;
        f32x4 total[4][4];
        float mc[4], lc[4];
        const int cur_max = (t0 + 15) >> 6;
        int n_end = 4 * (cur_max + 1); if (n_end > 1024) n_end = 1024;
        const int nchunk_c = (n_end + 31) >> 5;
        const bf16_t* kc_l = KC + (size_t)bg * 65536 + (size_t)col * 64 + 8 * rq;
        const bf16_t* vc_l = VC + (size_t)bg * 65536 + (size_t)col * 32 + 8 * rq;
#pragma unroll
        for (int h = 0; h < 4; ++h) {
            const bf16x8 q0 = ld8(qrow + h * 64), q1 = ld8(qrow + h * 64 + 32);
            AttnState st; attn_init(st);
#pragma unroll 1
            for (int kc = 0; kc < nchunk_c; ++kc) {
                unsigned vm = 0u;
#pragma unroll
                for (int tl = 0; tl < 2; ++tl)
#pragma unroll
                    for (int i = 0; i < 4; ++i) { const int n = kc * 32 + tl * 16 + 4 * rq + i; if (16 * n + 31 <= t) vm |= 1u << (tl * 4 + i); }
                attn_chunk(st, kc_l + (size_t)kc * 2048, vc_l + (size_t)kc * 2048, q0, q1, vm);
            }
            const float lt = colsum(st.l); const float inv = lt > 0.f ? 1.0f / lt : 0.f; const float gc = grow[h * 3 + 0] * inv;
            mc[h] = st.m; lc[h] = inv;
#pragma unroll
            for (int d = 0; d < 4; ++d) total[h][d] = st.o[d] * gc;
        }
        {
            float carry = 0.f;
#pragma unroll 1
            for (int kc = 0; kc < nchunk_c; ++kc) {
#pragma unroll
                for (int tl = 0; tl < 2; ++tl) {
                    const bf16x8 k0 = ld8(kc_l + (size_t)kc * 2048 + tl * 1024), k1 = ld8(kc_l + (size_t)kc * 2048 + tl * 1024 + 32);
                    float own = 0.f, p3 = 0.f;
#pragma unroll
                    for (int h = 0; h < 4; ++h) {
                        const bf16x8 q0 = ld8(qrow + h * 64), q1 = ld8(qrow + h * 64 + 32);
                        f32x4 sc = mfma16(k0, q0, (f32x4){0.f, 0.f, 0.f, 0.f}); sc = mfma16(k1, q1, sc);
#pragma unroll
                        for (int i = 0; i < 4; ++i) { const int n = kc * 32 + tl * 16 + 4 * rq + i; const float p = (16 * n + 31 <= t) ? __expf(sc[i] - mc[h]) * lc[h] : 0.f; own += p; if (i == 3) p3 += p; }
                    }
                    const float up = __shfl(p3, (lane + 48) & 63);
                    const float add = (rq == 0) ? carry : up;
                    imp[col * 256 + kc * 8 + tl * 4 + rq] = own + add;
                    carry = __shfl(p3, col + 48);
                }
            }
        }
#pragma unroll 1
        for (int c = 0; c < 16; ++c) {
            const int tc = t0 + c, cur = tc >> 6;
            if (cur < 16) { if (lane <= cur) sel[c * 17 + lane] = lane; if (lane == 0) sel[c * 17 + 16] = cur + 1; }
            else {
                unsigned key[4];
#pragma unroll
                for (int j = 0; j < 4; ++j) { const int sb = lane + 64 * j; const float v = imp[c * 256 + sb]; key[j] = (sb >= 1 && sb <= cur - 2) ? ((__float_as_uint(v) & 0xFFFFFF00u) | (unsigned)(255 - sb)) : 0u; }
                if (lane == 0) { sel[c * 17 + 0] = 0; sel[c * 17 + 1] = cur - 1; sel[c * 17 + 2] = cur; sel[c * 17 + 16] = 16; }
#pragma unroll 1
                for (int r = 0; r < 13; ++r) {
                    unsigned best = max(max(key[0], key[1]), max(key[2], key[3]));
#pragma unroll
                    for (int o = 1; o < 64; o <<= 1) best = max(best, (unsigned)__shfl_xor((int)best, o));
                    if (lane == 0) sel[c * 17 + 3 + r] = 255 - (int)(best & 255u);
#pragma unroll
                    for (int j = 0; j < 4; ++j) if (key[j] == best) key[j] = 0u;
                }
            }
        }
        {
            const bf16_t* ks_b = KF + (size_t)1 * KF_STRIDE + (size_t)bg * S * 64 + (size_t)col * 64 + 8 * rq;
            const bf16_t* vs_b = VF + (size_t)bg * S * 64 + (size_t)col * 32 + 8 * rq;
#pragma unroll 1
            for (int c = 0; c < 16; ++c) {
                const int tc = t0 + c;
                bf16x8 q0 = (bf16x8){0, 0, 0, 0, 0, 0, 0, 0}, q1 = q0;
                if (col < 4) { const bf16_t* qp = Q + ((size_t)b * S + tc) * D + (g * 4 + col) * 64 + 8 * rq; q0 = ld8(qp); q1 = ld8(qp + 32); }
                AttnState st; attn_init(st);
                const int cnt = __builtin_amdgcn_readfirstlane(sel[c * 17 + 16]);
#pragma unroll 1
                for (int bi = 0; bi < cnt; ++bi) {
                    const int j = __builtin_amdgcn_readfirstlane(sel[c * 17 + bi]);
#pragma unroll
                    for (int k2 = 0; k2 < 2; ++k2) {
                        const int kp0 = j * 64 + k2 * 32 + 4 * rq; unsigned vm = 0u;
#pragma unroll
                        for (int tl = 0; tl < 2; ++tl)
#pragma unroll
                            for (int i = 0; i < 4; ++i) if (kp0 + tl * 16 + i <= tc) vm |= 1u << (tl * 4 + i);
                        attn_chunk(st, ks_b + (size_t)(j * 64 + k2 * 32) * 64, vs_b + (size_t)(j * 2 + k2) * 2048, q0, q1, vm);
                    }
                }
                const float lt = colsum(st.l); const float inv = lt > 0.f ? 1.0f / lt : 0.f;
                const float gs = (col < 4) ? gates[((size_t)b * S + tc) * 48 + g * 12 + col * 3 + 1] * inv : 0.f;
#pragma unroll
                for (int h = 0; h < 4; ++h)
#pragma unroll
                    for (int d = 0; d < 4; ++d)
#pragma unroll
                        for (int i = 0; i < 4; ++i) { const float v = __shfl(st.o[d][i] * gs, h + (lane & 48)); total[h][d][i] += (col == c) ? v : 0.f; }
            }
        }
        {
            int lo = t0 - 511; if (lo < 0) lo = 0; const int c0 = lo >> 5, c1 = (t0 + 15) >> 5;
            const bf16_t* kw_b = KF + (size_t)2 * KF_STRIDE + (size_t)bg * S * 64 + (size_t)col * 64 + 8 * rq;
            const bf16_t* vw_b = VF + (size_t)1 * KF_STRIDE + (size_t)bg * S * 64 + (size_t)col * 32 + 8 * rq;
#pragma unroll
            for (int h = 0; h < 4; ++h) {
                const bf16x8 q0 = ld8(qrow + h * 64), q1 = ld8(qrow + h * 64 + 32);
                AttnState st; attn_init(st);
#pragma unroll 1
                for (int ch = c0; ch <= c1; ++ch) {
                    unsigned vm = 0u;
#pragma unroll
                    for (int tl = 0; tl < 2; ++tl)
#pragma unroll
                        for (int i = 0; i < 4; ++i) { const int kp = ch * 32 + tl * 16 + 4 * rq + i; if (kp <= t && kp + 512 > t) vm |= 1u << (tl * 4 + i); }
                    attn_chunk(st, kw_b + (size_t)ch * 2048, vw_b + (size_t)ch * 2048, q0, q1, vm);
                }
                const float lt = colsum(st.l); const float inv = lt > 0.f ? 1.0f / lt : 0.f; const float gwv = grow[h * 3 + 2] * inv;
#pragma unroll
                for (int d = 0; d < 4; ++d) total[h][d] = total[h][d] + st.o[d] * gwv;
            }
        }
#pragma unroll
        for (int h = 0; h < 4; ++h)
#pragma unroll
            for (int d = 0; d < 4; ++d) { u32x2 w; w.x = cvt_pk_bf16(total[h][d][0], total[h][d][1]); w.y = cvt_pk_bf16(total[h][d][2], total[h][d][3]);
                *(u32x2*)(OUT + rowq * D + (g * 4 + h) * 64 + d * 16 + 4 * rq) = w; }
    }
}

#define GSYNC() do { asm volatile("s_waitcnt vmcnt(0)" ::: "memory"); __builtin_amdgcn_fence(__ATOMIC_RELEASE, "agent"); grid.sync(); __builtin_amdgcn_fence(__ATOMIC_ACQUIRE, "agent"); } while (0)
__global__ void __launch_bounds__(NTHREADS, 2) fwd_kernel(Params P) {
    extern __shared__ __attribute__((aligned(16))) unsigned char lds_raw[];
    LAS unsigned char* lds = (LAS unsigned char*)lds_raw;
    cg::grid_group grid = cg::this_grid();
    const int tid = threadIdx.x, lane = tid & 63, wave = __builtin_amdgcn_readfirstlane(tid >> 6);
    const int G = gridDim.x, gw = blockIdx.x * NWAVES + wave, NGW = G * NWAVES;
    unsigned char* ws = P.ws;
    float* xres = P.out;
    LAS float* scr = (LAS float*)(lds + wave * 16384);
    const float* x_in = P.in[0];
    const float* norm_mix = P.in[1]; const float* norm_mlp = P.in[2]; const float* norm_final = P.in[3];
    const float* mlp_w1 = P.in[4]; const float* mlp_w2 = P.in[5];

    for (int layer = 0; layer < 4; ++layer) {
        int lane = threadIdx.x & 63; asm volatile("" : "+v"(lane));
        const bool is_rwkv = (layer & 1) != 0; const int lj = layer >> 1;
        const float* xsrc = (layer == 0) ? x_in : xres;
        {
            TJob j1{mlp_w1 + (size_t)layer * D * FF, FF, 0, FF, D, (bf16_t*)(ws + WS_W + W_MLP1), D, 0, 0, FF, D, nullptr, 0};
            transpose_job(j1, scr, gw, NGW, lane);
            TJob j2{mlp_w2 + (size_t)layer * FF * D, D, 0, D, FF, (bf16_t*)(ws + WS_W + W_MLP2), FF, 0, 0, D, FF, nullptr, 0};
            transpose_job(j2, scr, gw, NGW, lane);
            if (is_rwkv) {
                const float* mix = P.in[14] + (size_t)lj * 6 * D;
                bf16_t* WrT = (bf16_t*)(ws + WS_W + W_RW_IN);
                const float* wrkv = P.in[15] + (size_t)lj * 3 * D * D;
                for (int part = 0; part < 8; ++part) {
                    const float* W; int ldw, Nsrc, mi, r0, Npad;
                    if (part == 0) { W = wrkv; ldw = D; Nsrc = D; mi = 0; r0 = 0; Npad = D; }
                    else if (part == 1) { W = wrkv + (size_t)D * D; ldw = D; Nsrc = D; mi = 2; r0 = 1024; Npad = D; }
                    else if (part == 2) { W = wrkv + (size_t)2 * D * D; ldw = D; Nsrc = D; mi = 3; r0 = 2048; Npad = D; }
                    else if (part == 3) { W = P.in[17] + (size_t)lj * D * 64; ldw = 64; Nsrc = 64; mi = 1; r0 = 3072; Npad = 128; }
                    else if (part == 4) { W = P.in[20] + (size_t)lj * D * 64; ldw = 64; Nsrc = 64; mi = 4; r0 = 3200; Npad = 128; }
                    else if (part == 5) { W = P.in[22] + (size_t)lj * D * 160; ldw = 160; Nsrc = 160; mi = 5; r0 = 3328; Npad = 256; }
                    else if (part == 6) { W = P.in[31]; ldw = 32; Nsrc = (lj >= 1) ? 32 : 0; mi = 3; r0 = 3584; Npad = 128; }
                    else { W = P.in[31]; ldw = 32; Nsrc = 0; mi = 3; r0 = 3712; Npad = 128; }
                    TJob ja{W, ldw, 0, Nsrc, D, WrT, 2048, r0, 0, Npad, D, mix + mi * D, 1};
                    transpose_job(ja, scr, gw, NGW, lane);
                    TJob jb{W, ldw, 0, Nsrc, D, WrT, 2048, r0, 1024, Npad, D, mix + mi * D, 2};
                    transpose_job(jb, scr, gw, NGW, lane);
                }
                TJob jw{P.in[18] + (size_t)lj * 64 * D, D, 0, D, 64, (bf16_t*)(ws + WS_W + W_RW_W2), 128, 0, 0, D, 128, nullptr, 0}; transpose_job(jw, scr, gw, NGW, lane);
                TJob jaa{P.in[21] + (size_t)lj * 64 * D, D, 0, D, 64, (bf16_t*)(ws + WS_W + W_RW_A2), 128, 0, 0, D, 128, nullptr, 0}; transpose_job(jaa, scr, gw, NGW, lane);
                TJob jv{P.in[32], D, 0, D, (lj >= 1) ? 32 : 0, (bf16_t*)(ws + WS_W + W_RW_V2), 128, 0, 0, D, 128, nullptr, 0}; transpose_job(jv, scr, gw, NGW, lane);
                TJob jg{P.in[23] + (size_t)lj * 160 * D, D, 0, D, 160, (bf16_t*)(ws + WS_W + W_RW_G2), 256, 0, 0, D, 256, nullptr, 0}; transpose_job(jg, scr, gw, NGW, lane);
                TJob jo{P.in[29] + (size_t)lj * D * D, D, 0, D, D, (bf16_t*)(ws + WS_W + W_RW_O), D, 0, 0, D, D, nullptr, 0}; transpose_job(jo, scr, gw, NGW, lane);
                bf16_t* HN = (bf16_t*)(ws + A_HN);
                if (gw < 2) { u32x4* z = (u32x4*)(HN + (size_t)gw * (S + 1) * D); for (int q = lane; q < D / 8; q += 64) z[q] = (u32x4){0u, 0u, 0u, 0u}; }
                for (int m = gw; m < M; m += NGW) { const int b = m / S; rms_row_bf16(xsrc + (size_t)m * D, norm_mix + layer * D, HN + ((size_t)m + b + 1) * D, nullptr, lane); }
            } else {
                const float* win = P.in[6] + (size_t)lj * D * 2608;
                bf16_t* WnT = (bf16_t*)(ws + WS_W + W_NSA_IN); bf16_t* WvT = (bf16_t*)(ws + WS_W + W_NSA_V);
                for (int part = 0; part < 8; ++part) {
                    int n0src, Nsrc, r0, Npad; bf16_t* WT = WnT;
                    if (part == 0) { n0src = 0; Nsrc = 1024; r0 = 0; Npad = 1024; }
                    else if (part == 1) { n0src = 1024; Nsrc = 256; r0 = 1024; Npad = 256; }
                    else if (part == 2) { n0src = 1024 + 512; Nsrc = 256; r0 = 1280; Npad = 256; }
                    else if (part == 3) { n0src = 1024 + 1024; Nsrc = 256; r0 = 1536; Npad = 256; }
                    else if (part == 4) { n0src = 1024 + 256; Nsrc = 256; r0 = 1792; Npad = 256; }
                    else if (part == 5) { n0src = 2560; Nsrc = 48; r0 = 2048; Npad = 256; }
                    else if (part == 6) { n0src = 1024 + 768; Nsrc = 256; r0 = 0; Npad = 256; WT = WvT; }
                    else { n0src = 1024 + 1280; Nsrc = 256; r0 = 256; Npad = 256; WT = WvT; }
                    TJob jn{win, 2608, n0src, Nsrc, D, WT, D, r0, 0, Npad, D, nullptr, 0}; transpose_job(jn, scr, gw, NGW, lane);
                }
                TJob jo{P.in[13] + (size_t)lj * D * D, D, 0, D, D, (bf16_t*)(ws + WS_W + W_NSA_O), D, 0, 0, D, D, nullptr, 0}; transpose_job(jo, scr, gw, NGW, lane);
                TJob jc1k{P.in[8] + (size_t)lj * 2048 * 256, 256, 0, 256, 2048, (bf16_t*)(ws + WS_W + W_C1K), 2048, 0, 0, 256, 2048, nullptr, 0}; transpose_job(jc1k, scr, gw, NGW, lane);
                TJob jc1v{P.in[11] + (size_t)lj * 2048 * 256, 256, 0, 256, 2048, (bf16_t*)(ws + WS_W + W_C1V), 2048, 0, 0, 256, 2048, nullptr, 0}; transpose_job(jc1v, scr, gw, NGW, lane);
                TJob jc2k{P.in[9] + (size_t)lj * 256 * 64, 64, 0, 64, 256, (bf16_t*)(ws + WS_W + W_C2K), 256, 0, 0, 256, 256, nullptr, 0}; transpose_job(jc2k, scr, gw, NGW, lane);
                TJob jc2v{P.in[12] + (size_t)lj * 256 * 64, 64, 0, 64, 256, (bf16_t*)(ws + WS_W + W_C2V), 256, 0, 0, 256, 256, nullptr, 0}; transpose_job(jc2v, scr, gw, NGW, lane);
                {
                    int ln = lane; asm volatile("" : "+v"(ln));
                    float* cb = (float*)(ws + WS_W + W_CBIAS);
#pragma unroll 1
                    for (int o = gw; o < 512; o += NGW) { const int isv = o >> 8, c = o & 255;
                        const float* pe = (isv ? P.in[10] : P.in[7]) + (size_t)lj * 2048; const float* w1 = (isv ? P.in[11] : P.in[8]) + (size_t)lj * 2048 * 256;
                        float acc = 0.f;
#pragma unroll 1
                        for (int k = ln; k < 2048; k += 64) acc += pe[k] * w1[(size_t)k * 256 + c];
                        acc = wave_sum(acc); if (ln == 0) cb[o] = acc; }
                    if (layer == 0) {
                        float* rt = (float*)(ws + WS_ROPE);
                        int tix = threadIdx.x; asm volatile("" : "+v"(tix)); const int gt = (int)blockIdx.x * NTHREADS + tix;
#pragma unroll 1
                        for (int e = gt; e < S * 8; e += G * NTHREADS) { const int tt = e >> 3, i = e & 7;
                            const float invf = (i == 0) ? 1.0f : (i == 1) ? 0.1939227432012558f : (i == 2) ? 0.03760603070259094f : (i == 3) ? 0.007292664609849453f : (i == 4) ? 0.0014142135623842478f : (i == 5) ? 0.00027424818836152554f : (i == 6) ? 5.318296098266728e-05f : 1.0313386155758053e-05f;
                            const float ang = (float)tt * invf; const double rev = (double)ang * 0.15915494309189535; const float fr = (float)(rev - __builtin_rint(rev));
                            rt[tt * 16 + i] = __builtin_amdgcn_cosf(fr); rt[tt * 16 + 8 + i] = __builtin_amdgcn_sinf(fr); }
                    }
                }
                for (int m = gw; m < M; m += NGW) rms_row_bf16(xsrc + (size_t)m * D, norm_mix + layer * D, (bf16_t*)(ws + A_HN) + (size_t)m * D, (layer == 0) ? xres + (size_t)m * D : nullptr, lane);
            }
        }
        GSYNC();
        if (!is_rwkv) {
            bf16_t* HN = (bf16_t*)(ws + A_HN); bf16_t* Qb = (bf16_t*)(ws + A_Q); bf16_t* KFb = (bf16_t*)(ws + A_KF); bf16_t* VFb = (bf16_t*)(ws + A_VF);
            float* GT = (float*)(ws + A_GATES); bf16_t* CHK = (bf16_t*)(ws + A_CHK); bf16_t* CHV = (bf16_t*)(ws + A_CHV); bf16_t* KCb = (bf16_t*)(ws + A_KC); bf16_t* VCb = (bf16_t*)(ws + A_VC);
            {
                pg8::Gemm g{HN, (const bf16_t*)(ws + WS_W + W_NSA_IN), M, 2304, D, D, D, 0};
                pg8::StaticOrder so; so.init(M, 2304, G, (int)blockIdx.x);
                pg8::EpiP<FNsaIn> E{FNsaIn{Qb, KFb, GT, (const float*)(ws + WS_ROPE)}};
                pg8::gemm_phase<pg8::EpiP<FNsaIn>, true>(lds, g, so, E);
                pg8::Gemm g2{(const bf16_t*)(ws + WS_W + W_NSA_V), HN, 512, M, D, D, D, 0};
                pg8::StaticOrder so2; so2.init(512, M, G, (int)blockIdx.x);
                pg8::EpiP<FNsaVT> E2{FNsaVT{VFb}};
                pg8::gemm_phase<pg8::EpiP<FNsaVT>, true>(lds, g2, so2, E2);
            }
            GSYNC();
            {
                pg8::StaticOrder so; so.init(8192, 256, G, (int)blockIdx.x);
                { pg8::Gemm g{KFb, (const bf16_t*)(ws + WS_W + W_C1K), 8192, 256, 2048, 1024, 2048, 0}; pg8::EpiP<FCmp1> E{FCmp1{CHK, (const float*)(ws + WS_W + W_CBIAS)}}; pg8::gemm_phase<pg8::EpiP<FCmp1>, true>(lds, g, so, E); }
                { pg8::Gemm g{KFb + 3 * KF_STRIDE, (const bf16_t*)(ws + WS_W + W_C1V), 8192, 256, 2048, 1024, 2048, 0}; pg8::EpiP<FCmp1> E{FCmp1{CHV, (const float*)(ws + WS_W + W_CBIAS) + 256}}; pg8::gemm_phase<pg8::EpiP<FCmp1>, true>(lds, g, so, E); }
            }
            GSYNC();
            {
                { pg8::StaticOrder so; so.init(8192, 256, G, (int)blockIdx.x); pg8::Gemm g{CHK, (const bf16_t*)(ws + WS_W + W_C2K), 8192, 256, 256, 256, 256, 0}; pg8::EpiP<FCmp2K> E{FCmp2K{KCb}}; pg8::gemm_phase<pg8::EpiP<FCmp2K>, true>(lds, g, so, E); }
                { pg8::StaticOrder so; so.init(256, 8192, G, (int)blockIdx.x); pg8::Gemm g{(const bf16_t*)(ws + WS_W + W_C2V), CHV, 256, 8192, 256, 256, 256, 0}; pg8::EpiP<FCmp2VT> E{FCmp2VT{VCb}}; pg8::gemm_phase<pg8::EpiP<FCmp2VT>, true>(lds, g, so, E); }
            }
            GSYNC();
            nsa_attention(Qb, KFb, VFb, KCb, VCb, GT, HN, lds, G, wave, lane);
            GSYNC();
            {
                pg8::StaticOrder so; so.init(M, D, G, (int)blockIdx.x);
                pg8::Gemm g{HN, (const bf16_t*)(ws + WS_W + W_NSA_O), M, D, D, D, D, 0}; pg8::EpiN<FResAdd> E{FResAdd{xres}}; pg8::gemm_phase<pg8::EpiN<FResAdd>, true>(lds, g, so, E);
            }
            GSYNC();
        }
        if (is_rwkv) {
            h16* Rb = (h16*)(ws + A_R); h16* Kb = (h16*)(ws + A_K); h16* Ab = (h16*)(ws + A_A); h16* EWb = (h16*)(ws + A_HN);
            h16* Vb = (lj == 0) ? (h16*)(ws + WS_VF) : (h16*)(ws + A_V2);
            h16* Yraw = (lj == 0) ? (h16*)(ws + A_V2) : (h16*)(ws + WS_VF);
            bf16_t* LH = (bf16_t*)(ws + A_LH);
            {
                pg8::Gemm g{(const bf16_t*)(ws + A_HN), (const bf16_t*)(ws + WS_W + W_RW_IN), M, 3840, 2048, D, 2048, 1};
                pg8::StaticOrder so; so.init(M, 3840, G, (int)blockIdx.x);
                pg8::EpiP<FRwIn> E{FRwIn{Rb, Kb, Vb, LH}};
                pg8::gemm_phase<pg8::EpiP<FRwIn>, true>(lds, g, so, E);
            }
            GSYNC();
            {
                pg8::StaticOrder so; so.init(M, D, G, (int)blockIdx.x);
                { pg8::Gemm g{LH, (const bf16_t*)(ws + WS_W + W_RW_W2), M, D, 128, 768, 128, 0}; pg8::EpiP<FLoraW> E{FLoraW{EWb, P.in[16] + lj * D}}; pg8::gemm_phase<pg8::EpiP<FLoraW>, true>(lds, g, so, E); }
                { pg8::Gemm g{LH + 128, (const bf16_t*)(ws + WS_W + W_RW_A2), M, D, 128, 768, 128, 0}; pg8::EpiP<FLoraA> E{FLoraA{Ab, P.in[19] + lj * D}}; pg8::gemm_phase<pg8::EpiP<FLoraA>, true>(lds, g, so, E); }
                if (lj >= 1) { pg8::Gemm g{LH + 512, (const bf16_t*)(ws + WS_W + W_RW_V2), M, D, 128, 768, 128, 0}; pg8::EpiP<FLoraV> E{FLoraV{Vb, (const h16*)(ws + WS_VF), P.in[30]}}; pg8::gemm_phase<pg8::EpiP<FLoraV>, true>(lds, g, so, E); }
            }
            GSYNC();
            rwkv_scan2(Rb, Kb, Vb, EWb, Ab, P.in[24] + lj * D, P.in[25] + lj * D, Yraw, lds, wave, lane);
            GSYNC();
            rwkv_gn(Rb, Kb, Vb, Ab, Yraw, P.in[25] + lj * D, P.in[26] + lj * D, P.in[27] + lj * D, P.in[28] + lj * D, gw, NGW, lane);
            GSYNC();
            {
                pg8::StaticOrder so; so.init(M, D, G, (int)blockIdx.x);
                pg8::Gemm g{LH + 256, (const bf16_t*)(ws + WS_W + W_RW_G2), M, D, 256, 768, 256, 0}; pg8::EpiP<FGate> E{FGate{(bf16_t*)Kb, Rb}}; pg8::gemm_phase<pg8::EpiP<FGate>, true>(lds, g, so, E);
            }
            GSYNC();
            {
                pg8::StaticOrder so; so.init(M, D, G, (int)blockIdx.x);
                pg8::Gemm g{(const bf16_t*)Kb, (const bf16_t*)(ws + WS_W + W_RW_O), M, D, D, D, D, 0}; pg8::EpiN<FResAdd> E{FResAdd{xres}}; pg8::gemm_phase<pg8::EpiN<FResAdd>, true>(lds, g, so, E);
            }
            GSYNC();
        }
        for (int m = gw; m < M; m += NGW) rms_row_bf16(xres + (size_t)m * D, norm_mlp + layer * D, (bf16_t*)(ws + A_HN) + (size_t)m * D, nullptr, lane);
        GSYNC();
        {
            pg8::Gemm g{(const bf16_t*)(ws + A_HN), (const bf16_t*)(ws + WS_W + W_MLP1), M, FF, D, D, D, 0};
            pg8::StaticOrder so; so.init(M, FF, G, (int)blockIdx.x);
            pg8::EpiP<FRelu2> E{FRelu2{(bf16_t*)(ws + A_HID)}};
            pg8::gemm_phase<pg8::EpiP<FRelu2>, true>(lds, g, so, E);
        }
        GSYNC();
        {
            pg8::Gemm g{(const bf16_t*)(ws + A_HID), (const bf16_t*)(ws + WS_W + W_MLP2), M, D, FF, FF, FF, 0};
            pg8::StaticOrder so; so.init(M, D, G, (int)blockIdx.x);
            pg8::EpiN<FResAdd> E{FResAdd{xres}};
            pg8::gemm_phase<pg8::EpiN<FResAdd>, true>(lds, g, so, E);
        }
        GSYNC();
    }
    for (int m = gw; m < M; m += NGW) {
        int lane2 = lane; asm volatile("" : "+v"(lane2));
        f32x4* xr = (f32x4*)(xres + (size_t)m * D) + lane2; const f32x4* gr = (const f32x4*)norm_final + lane2;
        f32x4 v[4]; float s = 0.f;
#pragma unroll
        for (int j = 0; j < 4; ++j) { v[j] = xr[64 * j]; s += (v[j].x * v[j].x + v[j].y * v[j].y) + (v[j].z * v[j].z + v[j].w * v[j].w); }
        const float r = rsqrtf(wave_sum(s) * (1.f / D) + 1e-5f);
#pragma unroll
        for (int j = 0; j < 4; ++j) { const f32x4 gg = gr[64 * j]; xr[64 * j] = v[j] * r * gg; }
    }
}

extern "C" void kernel_launch(void* const* d_in, const int* in_sizes, int n_in, void* d_out, int out_size, void* d_ws, size_t ws_size, hipStream_t stream) {
    static int grid = 0;
    if (grid == 0) {
        if (n_in != 33 || out_size != M * D || ws_size < WS_NEED) { fprintf(stderr, "kernel_launch: unexpected sizes n_in %d out %d ws %zu (need %zu)\n", n_in, out_size, ws_size, (size_t)WS_NEED); grid = -1; return; }
        int dev = 0, cus = 0, per_cu = 0;
        hipGetDevice(&dev);
        hipDeviceGetAttribute(&cus, hipDeviceAttributeMultiprocessorCount, dev);
        if (hipFuncSetAttribute((const void*)fwd_kernel, hipFuncAttributeMaxDynamicSharedMemorySize, LDS_BYTES) != hipSuccess) { fprintf(stderr, "hipFuncSetAttribute failed\n"); grid = -1; return; }
        hipOccupancyMaxActiveBlocksPerMultiprocessor(&per_cu, (const void*)fwd_kernel, NTHREADS, LDS_BYTES);
        if (per_cu < 1) { fprintf(stderr, "occupancy query returned %d\n", per_cu); per_cu = 1; }
        (void)hipGetLastError();
        grid = cus * 1;
    }
    if (grid < 0) return;
    Params p{};
    for (int i = 0; i < 33; ++i) p.in[i] = (const float*)d_in[i];
    p.out = (float*)d_out; p.ws = (unsigned char*)d_ws;
    void* args[] = {&p};
    hipError_t e = hipLaunchCooperativeKernel((const void*)fwd_kernel, dim3(grid), dim3(NTHREADS), args, LDS_BYTES, stream);
    if (e != hipSuccess) fprintf(stderr, "cooperative launch failed: %s (grid %d)\n", hipGetErrorString(e), grid);
}
```

```cpp
#include <hip/hip_runtime.h>
#include <hip/hip_cooperative_groups.h>
#include <cstdio>
#include <cstdint>
namespace cg = cooperative_groups;

#define LAS __attribute__((address_space(3)))
typedef unsigned short bf16_t;
typedef short bf16x8 __attribute__((ext_vector_type(8)));
typedef float f32x4 __attribute__((ext_vector_type(4)));
typedef float f32x2 __attribute__((ext_vector_type(2)));
typedef unsigned u32x4 __attribute__((ext_vector_type(4)));
typedef unsigned u32x2 __attribute__((ext_vector_type(2)));
typedef _Float16 h16;
typedef _Float16 h16x2 __attribute__((ext_vector_type(2)));

constexpr int S = 16384, NB = 2, M = NB * S, D = 1024, FF = 4096;
constexpr int NWAVES = 8, NTHREADS = 512;
constexpr int LDS_BYTES = 147456;
constexpr size_t MiB = 1u << 20;
constexpr size_t WS_W = 0;
constexpr size_t W_MLP1 = 0, W_MLP2 = 8 * MiB;
constexpr size_t W_NSA_IN = 16 * MiB, W_NSA_V = 21 * MiB, W_NSA_O = 22 * MiB, W_C1K = 24 * MiB, W_C1V = 25 * MiB, W_C2K = 26 * MiB, W_C2V = 26 * MiB + 256 * 1024, W_CBIAS = 26 * MiB + 512 * 1024;
constexpr size_t W_RW_IN = 16 * MiB, W_RW_W2 = 31 * MiB, W_RW_A2 = 31 * MiB + 256 * 1024, W_RW_V2 = 31 * MiB + 512 * 1024, W_RW_G2 = 31 * MiB + 768 * 1024, W_RW_O = 33 * MiB;
constexpr size_t WS_ROPE = 36 * MiB;
constexpr size_t WS_VF = 40 * MiB;
constexpr size_t ACT = 104 * MiB;
constexpr size_t A_HN = ACT;
constexpr size_t A_Q = ACT + 65 * MiB;
constexpr size_t A_KF = ACT + 129 * MiB;
constexpr size_t A_VF = ACT + 194 * MiB;
constexpr size_t A_GATES = ACT + 226 * MiB;
constexpr size_t A_CHK = ACT + 233 * MiB, A_CHV = ACT + 237 * MiB, A_KC = ACT + 241 * MiB, A_VC = ACT + 242 * MiB;
constexpr size_t A_HID = ACT + 65 * MiB;
constexpr size_t A_R = ACT + 65 * MiB, A_K = ACT + 129 * MiB, A_V2 = ACT + 193 * MiB, A_A = ACT + 257 * MiB, A_LH = ACT + 321 * MiB;
constexpr size_t WS_NEED = ACT + 370 * MiB;

__device__ __forceinline__ unsigned cvt_pk_bf16(float lo, float hi) { unsigned r; asm volatile("v_cvt_pk_bf16_f32 %0, %1, %2" : "=v"(r) : "v"(lo), "v"(hi)); return r; }
__device__ __forceinline__ unsigned pk_h16(float lo, float hi) { h16x2 v; v.x = (h16)lo; v.y = (h16)hi; return __builtin_bit_cast(unsigned, v); }
__device__ __forceinline__ float bf2f(bf16_t b) { return __uint_as_float(((unsigned)b) << 16); }
__device__ __forceinline__ float wave_sum(float v) {
#pragma unroll
    for (int o = 1; o < 64; o <<= 1) v += __shfl_xor(v, o);
    return v;
}
__device__ __forceinline__ float sigmoidf_(float x) { return 1.0f / (1.0f + __expf(-x)); }
__device__ __forceinline__ float tanhf_(float x) { float e = __expf(-2.0f * fabsf(x)); float t = (1.0f - e) / (1.0f + e); return x < 0.f ? -t : t; }

namespace pg8 {
constexpr int BM = 256, BK = 64, HALF = 128, HTB = HALF * BK * 2, STAGE_BYTES = 8 * HTB, NXCD = 8, WGM = 8;
__host__ __device__ __forceinline__ int lds_byte(int r, int c) { const int st = (r >> 4) * 2 + (c >> 5), rr = r & 15, cc = c & 31, ob = rr * 64 + cc * 2; return st * 1024 + (ob ^ (((ob >> 9) & 1) << 5)); }
__host__ __device__ __forceinline__ void stage_rc(int b, int& R, int& C) { const int st = b / 1024, sb = b % 1024, swz = sb ^ (((sb >> 9) & 1) << 5); R = (st >> 1) * 16 + swz / 64; C = (st & 1) * 32 + (swz % 64) / 2; }
__host__ __device__ __forceinline__ int perm32(int rho) { const int n = rho >> 4, i = rho & 15; return 8 * (i >> 2) + 4 * n + (i & 3); }
struct Unit { int pm, pn; };
struct Gemm { const bf16_t* A; const bf16_t* Bt; int M, N, K, lda, ldb, amode; };
struct StaticOrder {
    int nM, nN, nwg, G, c;
    __device__ void init(int M_, int N_, int G_, int c_) { nM = M_ / BM; nN = N_ / BM; nwg = nM * nN; G = G_; c = c_; }
    __device__ bool next(int i, Unit& u) const {
        const long L = (long)i * G + c; if (L >= nwg) return false;
        int wgid = (int)L; { const int q = nwg / NXCD, r = nwg % NXCD, xcd = wgid % NXCD, off = wgid / NXCD; wgid = (xcd < r ? xcd * (q + 1) : r * (q + 1) + (xcd - r) * q) + off; }
        const int nig = WGM * nN, gid = wgid / nig, fm = gid * WGM, gsz = (nM - fm) < WGM ? (nM - fm) : WGM;
        u.pm = fm + ((wgid % nig) % gsz); u.pn = (wgid % nig) / gsz; return true;
    }
};
__device__ __forceinline__ const char* a_base(const Gemm& g, int pm) { const size_t row = (size_t)pm * BM + (g.amode == 1 ? (size_t)(pm / 64) : 0); return (const char*)g.A + row * (size_t)g.lda * 2; }

template <class Epi, bool ALIGN_EPI>
__device__ __forceinline__ void gemm_phase(LAS unsigned char* lds, const Gemm g, const StaticOrder& S, const Epi& E) {
    int tid = threadIdx.x; asm volatile("" : "+v"(tid));
    const int wid = __builtin_amdgcn_readfirstlane(tid >> 6), lane = tid & 63, wr = wid >> 2, wc = wid & 3, fr = lane & 15, fq = lane >> 4;
    int K = g.K; asm volatile("" : "+s"(K));
    const int nt = K / BK;
    unsigned voffA[2], voffB[2];
#pragma unroll
    for (int i = 0; i < 2; ++i) { int R, C; stage_rc(tid * 16 + i * 8192, R, C); const int Rb = Epi::PERM ? ((R & ~31) + perm32(R & 31)) : R;
        voffA[i] = (unsigned)(R * g.lda + C) * 2u; voffB[i] = (unsigned)(Rb * g.ldb + C) * 2u; }
    const size_t kstep = (size_t)(BK * 2);
    const size_t hstepA = (size_t)HALF * g.lda * 2, hstepB = (size_t)HALF * g.ldb * 2;
    const size_t tstepB = 2 * hstepB;
    const unsigned ldsw = (unsigned)wid * 1024u;
    const int aoff = lds_byte(wr * 64 + fr, fq * 8), boff = lds_byte(wc * 32 + fr, fq * 8);
#define PG8_SA(b, h) (((b) * 2 + (h)) * HTB)
#define PG8_SB(b, h) ((4 + (b) * 2 + (h)) * HTB)
#define PG8_STAGE(bufoff, gbase, voff) do { _Pragma("unroll") for (int _i = 0; _i < 2; ++_i) \
        __builtin_amdgcn_global_load_lds((const unsigned*)((const char*)(gbase) + (voff)[_i]), (LAS unsigned*)(lds + (bufoff) + ldsw + _i * 8192), 16, 0, 0); } while (0)
#define PG8_LDA(dst, b, h) do { _Pragma("unroll") for (int m = 0; m < 4; ++m) _Pragma("unroll") for (int k = 0; k < 2; ++k) dst[m][k] = *(const LAS bf16x8*)(lds + PG8_SA(b, h) + aoff + m * 2048 + k * 1024); } while (0)
#define PG8_LDB(dst, b, h) do { _Pragma("unroll") for (int n = 0; n < 2; ++n) _Pragma("unroll") for (int k = 0; k < 2; ++k) dst[n][k] = *(const LAS bf16x8*)(lds + PG8_SB(b, h) + boff + n * 2048 + k * 1024); } while (0)
#define PG8_MMA(ai, bj, At, Bt) do { __builtin_amdgcn_s_setprio(1); _Pragma("unroll") for (int m = 0; m < 4; ++m) _Pragma("unroll") for (int n = 0; n < 2; ++n) _Pragma("unroll") for (int k = 0; k < 2; ++k) \
        acc[ai][bj][m][n] = __builtin_amdgcn_mfma_f32_16x16x32_bf16(Bt[n][k], At[m][k], acc[ai][bj][m][n], 0, 0, 0); __builtin_amdgcn_s_setprio(0); } while (0)
#define PG8_WAIT_V(n) asm volatile("s_waitcnt vmcnt(" #n ")" ::: "memory")
#define PG8_WAIT_L(n) asm volatile("s_waitcnt lgkmcnt(" #n ")" ::: "memory")
#define PG8_BAR __builtin_amdgcn_s_barrier()
#define PG8_SCHED __builtin_amdgcn_sched_barrier(0)
    Unit cur, nxt; int ui = 0;
    if (!S.next(0, cur)) return;
    f32x4 acc[2][2][4][2];
#pragma unroll
    for (int a = 0; a < 2; ++a)
#pragma unroll
        for (int b = 0; b < 2; ++b)
#pragma unroll
            for (int m = 0; m < 4; ++m)
#pragma unroll
                for (int n = 0; n < 2; ++n) acc[a][b][m][n] = (f32x4){0.f, 0.f, 0.f, 0.f};
    bf16x8 At[4][2], B0[2][2], B1[2][2];
    const char* cA = a_base(g, cur.pm); const char* cB = (const char*)g.Bt + (size_t)cur.pn * tstepB;
    PG8_STAGE(PG8_SB(0, 0), cB, voffB); PG8_STAGE(PG8_SB(0, 1), cB + hstepB, voffB); PG8_STAGE(PG8_SA(0, 0), cA, voffA); PG8_STAGE(PG8_SA(0, 1), cA + hstepA, voffA);
    if (wr == 1) PG8_BAR;
    PG8_WAIT_V(2); PG8_BAR;
    PG8_STAGE(PG8_SB(1, 0), cB + kstep, voffB); PG8_STAGE(PG8_SA(1, 0), cA + kstep, voffA); PG8_STAGE(PG8_SB(1, 1), cB + hstepB + kstep, voffB);
    PG8_WAIT_V(6); PG8_BAR;
    for (;;) {
        const bool has_next = S.next(ui + 1, nxt);
        const char* nA = has_next ? a_base(g, nxt.pm) : cA; const char* nB = has_next ? (const char*)g.Bt + (size_t)nxt.pn * tstepB : cB;
        for (int t = 0; t < nt; t += 2) {
            const bool last = (t == nt - 2);
            const char* a1 = cA + (size_t)(t + 1) * kstep;
            const char* a2 = last ? nA : cA + (size_t)(t + 2) * kstep; const char* b2 = last ? nB : cB + (size_t)(t + 2) * kstep;
            const char* a3 = a2 + kstep; const char* b3 = b2 + kstep;
            PG8_LDB(B0, 0, 0); PG8_LDB(B1, 0, 1); PG8_SCHED; PG8_LDA(At, 0, 0); PG8_STAGE(PG8_SA(1, 1), a1 + hstepA, voffA);
            PG8_WAIT_V(8); PG8_WAIT_L(0); PG8_BAR; PG8_MMA(0, 0, At, B0); PG8_MMA(0, 1, At, B1); PG8_BAR; PG8_SCHED;
            PG8_LDA(At, 0, 1); PG8_STAGE(PG8_SB(0, 0), b2, voffB); PG8_STAGE(PG8_SB(0, 1), b2 + hstepB, voffB); PG8_STAGE(PG8_SA(0, 0), a2, voffA);
            PG8_WAIT_V(8); PG8_WAIT_L(0); PG8_BAR; PG8_MMA(1, 0, At, B0); PG8_MMA(1, 1, At, B1); PG8_BAR; PG8_SCHED;
            PG8_LDB(B0, 1, 0); PG8_LDB(B1, 1, 1); PG8_SCHED; PG8_LDA(At, 1, 0); PG8_STAGE(PG8_SA(0, 1), a2 + hstepA, voffA);
            PG8_WAIT_V(8); PG8_WAIT_L(0); PG8_BAR; PG8_MMA(0, 0, At, B0); PG8_MMA(0, 1, At, B1); PG8_BAR; PG8_SCHED;
            PG8_LDA(At, 1, 1); PG8_STAGE(PG8_SB(1, 0), b3, voffB); PG8_STAGE(PG8_SB(1, 1), b3 + hstepB, voffB); PG8_STAGE(PG8_SA(1, 0), a3, voffA);
            PG8_WAIT_V(8); PG8_WAIT_L(0); PG8_BAR; PG8_MMA(1, 0, At, B0); PG8_MMA(1, 1, At, B1); PG8_BAR; PG8_SCHED;
        }
        if constexpr (ALIGN_EPI) { if (wr == 0) PG8_BAR; }
        E(acc, cur, wr, wc, fr, fq);
        if (!has_next) break;
#pragma unroll
        for (int a = 0; a < 2; ++a)
#pragma unroll
            for (int b = 0; b < 2; ++b)
#pragma unroll
                for (int m = 0; m < 4; ++m)
#pragma unroll
                    for (int n = 0; n < 2; ++n) acc[a][b][m][n] = (f32x4){0.f, 0.f, 0.f, 0.f};
        cur = nxt; cA = nA; cB = nB; ++ui;
        if constexpr (ALIGN_EPI) { if (wr == 1) PG8_BAR; }
    }
    PG8_WAIT_V(0);
    if constexpr (!ALIGN_EPI) { if (wr == 0) PG8_BAR; }
    PG8_BAR;
#undef PG8_SA
#undef PG8_SB
#undef PG8_STAGE
#undef PG8_LDA
#undef PG8_LDB
#undef PG8_MMA
#undef PG8_WAIT_V
#undef PG8_WAIT_L
#undef PG8_BAR
#undef PG8_SCHED
}
template <class F> struct EpiP {
    static constexpr bool PERM = true; F f;
    __device__ __forceinline__ void operator()(const f32x4 (&acc)[2][2][4][2], const Unit& u, int wr, int wc, int fr, int fq) const {
#pragma unroll
        for (int ai = 0; ai < 2; ++ai)
#pragma unroll
            for (int m = 0; m < 4; ++m) { int row = u.pm * BM + ai * HALF + wr * 64 + m * 16 + fr; asm volatile("" : "+v"(row));
#pragma unroll
                for (int bj = 0; bj < 2; ++bj) { const int col0 = u.pn * BM + bj * HALF + wc * 32 + 8 * fq; f(row, col0, acc[ai][bj][m][0], acc[ai][bj][m][1]); } asm volatile("" ::: "memory"); }
    }
};
template <class F> struct EpiN {
    static constexpr bool PERM = false; F f;
    __device__ __forceinline__ void operator()(const f32x4 (&acc)[2][2][4][2], const Unit& u, int wr, int wc, int fr, int fq) const {
#pragma unroll
        for (int ai = 0; ai < 2; ++ai)
#pragma unroll
            for (int m = 0; m < 4; ++m) { int row = u.pm * BM + ai * HALF + wr * 64 + m * 16 + fr; asm volatile("" : "+v"(row));
#pragma unroll
                for (int bj = 0; bj < 2; ++bj)
#pragma unroll
                    for (int n = 0; n < 2; ++n) { const int col0 = u.pn * BM + bj * HALF + wc * 32 + 16 * n + 4 * fq; f(row, col0, acc[ai][bj][m][n]); } asm volatile("" ::: "memory"); }
    }
};
}

struct Params {
    const float* in[33];
    float* out;
    unsigned char* ws;
};

struct TJob { const float* W; int ldw, n0src, Nsrc, Ksrc; bf16_t* WT; int ldt, row_off, col_off, Npad, Kpad; const float* mix; int mode; };
__device__ __forceinline__ void transpose_job(const TJob& j, LAS float* scr, int gw, int NGW, int lane_) {
    int lane = lane_; asm volatile("" : "+v"(lane));
    const int nblk = j.Npad / 32, kblk = j.Kpad / 64, items = nblk * kblk;
    for (int it = gw; it < items; it += NGW) {
        const int kb = it / nblk, nb = it % nblk, k0 = 64 * kb, n0 = 32 * nb;
#pragma unroll 4
        for (int i = 0; i < 32; ++i) { const int kk = 2 * i + (lane >> 5), n = lane & 31; float v = 0.f;
            if (k0 + kk < j.Ksrc && n0 + n < j.Nsrc) { v = j.W[(size_t)(k0 + kk) * j.ldw + j.n0src + n0 + n];
                if (j.mode == 1) v *= j.mix[k0 + kk]; else if (j.mode == 2) v *= (1.0f - j.mix[k0 + kk]); }
            scr[kk * 33 + n] = v; }
        asm volatile("s_waitcnt lgkmcnt(0)" ::: "memory");
        const int c = lane & 7;
#pragma unroll
        for (int jj = 0; jj < 4; ++jj) { const int n = (lane >> 3) + 8 * jj; const LAS float* s = scr + (8 * c) * 33 + n;
            u32x4 o; o.x = cvt_pk_bf16(s[0 * 33], s[1 * 33]); o.y = cvt_pk_bf16(s[2 * 33], s[3 * 33]); o.z = cvt_pk_bf16(s[4 * 33], s[5 * 33]); o.w = cvt_pk_bf16(s[6 * 33], s[7 * 33]);
            *(u32x4*)(j.WT + (size_t)(j.row_off + n0 + n) * j.ldt + j.col_off + k0 + 8 * c) = o; }
        asm volatile("s_waitcnt lgkmcnt(0)" ::: "memory");
    }
}

__device__ __forceinline__ void rms_row_bf16(const float* xrow, const float* g, bf16_t* orow, float* copy_to, int lane_) {
    int lane = lane_; asm volatile("" : "+v"(lane));
    const f32x4* xr = (const f32x4*)xrow + lane; const f32x4* gr = (const f32x4*)g + lane;
    f32x4 v[4]; float s = 0.f;
#pragma unroll
    for (int j = 0; j < 4; ++j) { v[j] = xr[64 * j]; s += (v[j].x * v[j].x + v[j].y * v[j].y) + (v[j].z * v[j].z + v[j].w * v[j].w); }
    if (copy_to) {
#pragma unroll
        for (int j = 0; j < 4; ++j) ((f32x4*)copy_to + lane)[64 * j] = v[j];
    }
    const float r = rsqrtf(wave_sum(s) * (1.f / D) + 1e-5f);
    u32x2* o8 = (u32x2*)orow + lane;
#pragma unroll
    for (int j = 0; j < 4; ++j) { const f32x4 gg = gr[64 * j]; u32x2 w; w.x = cvt_pk_bf16(v[j].x * r * gg.x, v[j].y * r * gg.y); w.y = cvt_pk_bf16(v[j].z * r * gg.z, v[j].w * r * gg.w); o8[64 * j] = w; }
}

struct FRelu2 { bf16_t* O; __device__ __forceinline__ void operator()(int row, int col0, f32x4 a, f32x4 b) const {
    f32x4 x = a, y = b;
#pragma unroll
    for (int i = 0; i < 4; ++i) { float t = fmaxf(x[i], 0.f); x[i] = t * t; t = fmaxf(y[i], 0.f); y[i] = t * t; }
    u32x4 w; w.x = cvt_pk_bf16(x[0], x[1]); w.y = cvt_pk_bf16(x[2], x[3]); w.z = cvt_pk_bf16(y[0], y[1]); w.w = cvt_pk_bf16(y[2], y[3]);
    *(u32x4*)(O + (size_t)row * FF + col0) = w; } };
struct FResAdd { float* X; __device__ __forceinline__ void operator()(int row, int col0, f32x4 a) const {
    f32x4* p = (f32x4*)(X + (size_t)row * D + col0); *p = *p + a; } };


struct FRwIn { h16* R; h16* Kk; h16* V; bf16_t* LH;
    __device__ __forceinline__ void operator()(int row, int col0, f32x4 a, f32x4 b) const {
        const int seg = __builtin_amdgcn_readfirstlane(col0 >> 10);
        if (seg < 3) { const long dK = (const char*)Kk - (const char*)R, dV = (const char*)V - (const char*)R; const long off = (seg == 1 ? dK : 0l) + (seg == 2 ? dV : 0l); h16* dst = (h16*)((char*)R + off); const int c = col0 & 1023;
            u32x4 w; w.x = pk_h16(a[0], a[1]); w.y = pk_h16(a[2], a[3]); w.z = pk_h16(b[0], b[1]); w.w = pk_h16(b[2], b[3]);
            *(u32x4*)(dst + (size_t)row * D + c) = w; }
        else { const int c = col0 - 3072; f32x4 x = a, y = b;
            if (c < 128) {
#pragma unroll
                for (int i = 0; i < 4; ++i) { x[i] = tanhf_(x[i]); y[i] = tanhf_(y[i]); } }
            else if (c >= 256 && c < 512) {
#pragma unroll
                for (int i = 0; i < 4; ++i) { x[i] = sigmoidf_(x[i]); y[i] = sigmoidf_(y[i]); } }
            u32x4 w; w.x = cvt_pk_bf16(x[0], x[1]); w.y = cvt_pk_bf16(x[2], x[3]); w.z = cvt_pk_bf16(y[0], y[1]); w.w = cvt_pk_bf16(y[2], y[3]);
            *(u32x4*)(LH + (size_t)row * 768 + c) = w; }
    } };
struct FLoraW { h16* EW; const float* w0;
    __device__ __forceinline__ void operator()(int row, int col0, f32x4 a, f32x4 b) const {
        const f32x4 p = *(const f32x4*)(w0 + col0), q = *(const f32x4*)(w0 + col0 + 4); float o[8];
#pragma unroll
        for (int i = 0; i < 4; ++i) { o[i] = 0.60653066f * sigmoidf_(p[i] + a[i]); o[4 + i] = 0.60653066f * sigmoidf_(q[i] + b[i]); }
        u32x4 w; w.x = pk_h16(o[0], o[1]); w.y = pk_h16(o[2], o[3]); w.z = pk_h16(o[4], o[5]); w.w = pk_h16(o[6], o[7]);
        *(u32x4*)(EW + (size_t)row * D + col0) = w; } };
struct FLoraA { h16* Aa; const float* a0;
    __device__ __forceinline__ void operator()(int row, int col0, f32x4 a, f32x4 b) const {
        const f32x4 p = *(const f32x4*)(a0 + col0), q = *(const f32x4*)(a0 + col0 + 4); float o[8];
#pragma unroll
        for (int i = 0; i < 4; ++i) { o[i] = sigmoidf_(p[i] + a[i]); o[4 + i] = sigmoidf_(q[i] + b[i]); }
        u32x4 w; w.x = pk_h16(o[0], o[1]); w.y = pk_h16(o[2], o[3]); w.z = pk_h16(o[4], o[5]); w.w = pk_h16(o[6], o[7]);
        *(u32x4*)(Aa + (size_t)row * D + col0) = w; } };
struct FLoraV { h16* V; const h16* VFm; const float* v0;
    __device__ __forceinline__ void operator()(int row, int col0, f32x4 a, f32x4 b) const {
        const f32x4 p = *(const f32x4*)(v0 + col0), q = *(const f32x4*)(v0 + col0 + 4);
        typedef h16 h16x8 __attribute__((ext_vector_type(8)));
        const h16x8 vv = *(const h16x8*)(V + (size_t)row * D + col0), vf = *(const h16x8*)(VFm + (size_t)row * D + col0); float o[8];
#pragma unroll
        for (int i = 0; i < 4; ++i) { float v = (float)vv[i], f = (float)vf[i]; o[i] = v + (f - v) * sigmoidf_(p[i] + a[i]); v = (float)vv[4 + i]; f = (float)vf[4 + i]; o[4 + i] = v + (f - v) * sigmoidf_(q[i] + b[i]); }
        u32x4 w; w.x = pk_h16(o[0], o[1]); w.y = pk_h16(o[2], o[3]); w.z = pk_h16(o[4], o[5]); w.w = pk_h16(o[6], o[7]);
        *(u32x4*)(V + (size_t)row * D + col0) = w; } };
struct FGate { bf16_t* O; const h16* Y;
    __device__ __forceinline__ void operator()(int row, int col0, f32x4 a, f32x4 b) const {
        typedef h16 h16x8 __attribute__((ext_vector_type(8)));
        const h16x8 yy = *(const h16x8*)(Y + (size_t)row * D + col0);
        u32x4 w; w.x = cvt_pk_bf16(a[0] * (float)yy[0], a[1] * (float)yy[1]); w.y = cvt_pk_bf16(a[2] * (float)yy[2], a[3] * (float)yy[3]);
        w.z = cvt_pk_bf16(b[0] * (float)yy[4], b[1] * (float)yy[5]); w.w = cvt_pk_bf16(b[2] * (float)yy[6], b[3] * (float)yy[7]);
        *(u32x4*)(O + (size_t)row * D + col0) = w; } };

template <int CTRL> __device__ __forceinline__ float dppmov(float v) { return __builtin_bit_cast(float, __builtin_amdgcn_update_dpp(0, __builtin_bit_cast(int, v), CTRL, 0xF, 0xF, true)); }
__device__ __forceinline__ float row16_sum(float v) { v += dppmov<0xB1>(v); v += dppmov<0x4E>(v); v += dppmov<0x124>(v); v += dppmov<0x128>(v); return v; }
typedef _Float16 h16x4 __attribute__((ext_vector_type(4)));
__device__ __forceinline__ void h4_to_f(h16x4 u, float* f) { f[0] = (float)u[0]; f[1] = (float)u[1]; f[2] = (float)u[2]; f[3] = (float)u[3]; }
__device__ __forceinline__ void rwkv_scan(const h16* R, const h16* Kk, const h16* V, const h16* EW, const h16* Aa, const float* k_k, const float* k_a, h16* Yraw, int G, int wave, int lane_) {
    int lane = lane_; asm volatile("" : "+v"(lane));
    const int NT = G * NWAVES;
    for (int task = wave * G + (int)blockIdx.x; task < 512; task += NT) {
        const int bh = task >> 4, rg = task & 15, b = bh >> 4, h = bh & 15;
        const int row = lane >> 4, jg = lane & 15, i = rg * 4 + row;
        const int colj = h * 64 + 4 * jg, coli = h * 64 + i;
        float kkc[4], kac[4];
#pragma unroll
        for (int j = 0; j < 4; ++j) { kkc[j] = k_k[colj + j]; kac[j] = k_a[colj + j]; }
        float s[4] = {0.f, 0.f, 0.f, 0.f};
        const size_t base = (size_t)b * S * D;
        const h16* pR = R + base + colj; const h16* pK = Kk + base + colj; const h16* pA = Aa + base + colj; const h16* pE = EW + base + colj; const h16* pV = V + base + coli;
        h16* pY = Yraw + ((size_t)task * S) * 4 + row;
        constexpr int TC = 4;
        h16x4 cr[TC], ck[TC], ca[TC], ce[TC]; h16 cv[TC];
#pragma unroll
        for (int u = 0; u < TC; ++u) { const size_t o = (size_t)u * D; cr[u] = *(const h16x4*)(pR + o); ck[u] = *(const h16x4*)(pK + o); ca[u] = *(const h16x4*)(pA + o); ce[u] = *(const h16x4*)(pE + o); cv[u] = pV[o]; }
        for (int t0 = 0; t0 < S; t0 += TC) {
            const int tn = (t0 + TC < S) ? t0 + TC : t0;
            h16x4 nr[TC], nk[TC], na[TC], ne[TC]; h16 nv[TC];
#pragma unroll
            for (int u = 0; u < TC; ++u) { const size_t o = (size_t)(tn + u) * D; nr[u] = *(const h16x4*)(pR + o); nk[u] = *(const h16x4*)(pK + o); na[u] = *(const h16x4*)(pA + o); ne[u] = *(const h16x4*)(pE + o); nv[u] = pV[o]; }
#pragma unroll
            for (int u = 0; u < TC; ++u) {
                float rv[4], kv[4], av[4], ev[4]; h4_to_f(cr[u], rv); h4_to_f(ck[u], kv); h4_to_f(ca[u], av); h4_to_f(ce[u], ev);
                const float vi = (float)cv[u];
                float kq[4], n2 = 0.f;
#pragma unroll
                for (int j = 0; j < 4; ++j) { kq[j] = kv[j] * kkc[j]; n2 += kq[j] * kq[j]; }
                n2 = row16_sum(n2);
                const float inv = 1.0f / fmaxf(sqrtf(n2), 1e-12f);
                float kkj[4], kt[4], bb[4], w[4], dot = 0.f;
#pragma unroll
                for (int j = 0; j < 4; ++j) { kkj[j] = kq[j] * inv; kt[j] = kv[j] * (1.0f + (av[j] - 1.0f) * kac[j]); bb[j] = kkj[j] * av[j]; w[j] = __expf(-ev[j]); dot += s[j] * kkj[j]; }
                const float sa = -row16_sum(dot);
                float yd = 0.f;
#pragma unroll
                for (int j = 0; j < 4; ++j) { s[j] = s[j] * w[j] + (sa * bb[j] + vi * kt[j]); yd += s[j] * rv[j]; }
                const float y = row16_sum(yd);
                if (jg == 0) pY[(size_t)(t0 + u) * 4] = (h16)y;
            }
#pragma unroll
            for (int u = 0; u < TC; ++u) { cr[u] = nr[u]; ck[u] = nk[u]; ca[u] = na[u]; ce[u] = ne[u]; cv[u] = nv[u]; }
        }
    }
}
constexpr int SC_CS = 32, SC_STEP_F = 5 * 64 + 8, SC_BUF_F = SC_CS * SC_STEP_F;
#define SC_BAR() do { asm volatile("s_waitcnt lgkmcnt(0)" ::: "memory"); __builtin_amdgcn_s_barrier(); asm volatile("" ::: "memory"); } while (0)
__device__ __forceinline__ float wave_sum_dpp(float v) {
    v = row16_sum(v);
    const float a = __builtin_bit_cast(float, __builtin_amdgcn_readlane(__builtin_bit_cast(int, v), 0)), b = __builtin_bit_cast(float, __builtin_amdgcn_readlane(__builtin_bit_cast(int, v), 16));
    const float c = __builtin_bit_cast(float, __builtin_amdgcn_readlane(__builtin_bit_cast(int, v), 32)), d = __builtin_bit_cast(float, __builtin_amdgcn_readlane(__builtin_bit_cast(int, v), 48));
    return (a + b) + (c + d);
}
struct ScRegs { h16 k[8], a[8], e[8], r[8], v[8]; };
__device__ __forceinline__ void sc_load(ScRegs& g, const h16* R, const h16* Kk, const h16* V, const h16* EW, const h16* Aa, size_t base, int c, int pw, int sub, int lane) {
#pragma unroll
    for (int q = 0; q < 8; ++q) { const size_t o = base + (size_t)(c * SC_CS + pw + 4 * q) * D;
        g.k[q] = Kk[o + lane]; g.a[q] = Aa[o + lane]; g.e[q] = EW[o + lane]; g.r[q] = R[o + lane]; g.v[q] = V[o + sub * 8 + (lane & 7)]; }
}
__device__ __forceinline__ void sc_compute(const ScRegs& g, LAS float* sb, int pw, float kkc, float kac, int lane) {
#pragma unroll
    for (int q = 0; q < 8; ++q) {
        const float kv = (float)g.k[q], av = (float)g.a[q], ev = (float)g.e[q], rv = (float)g.r[q]; const float kq = kv * kkc;
        const float n2 = wave_sum_dpp(kq * kq);
        const float kkj = kq * rsqrtf(fmaxf(n2, 1e-24f)); LAS float* p = sb + (pw + 4 * q) * SC_STEP_F;
        p[lane] = kkj; p[64 + lane] = kkj * av; p[128 + lane] = kv * (1.0f + (av - 1.0f) * kac); p[192 + lane] = __expf(-ev); p[256 + lane] = rv; if (lane < 8) p[320 + lane] = (float)g.v[q];
    }
}
__device__ __forceinline__ void rwkv_scan2(const h16* R, const h16* Kk, const h16* V, const h16* EW, const h16* Aa, const float* k_k, const float* k_a, h16* Yraw, LAS unsigned char* lds, int wave, int lane_) {
    int lane = lane_; asm volatile("" : "+v"(lane));
    LAS float* buf = (LAS float*)lds;
    constexpr int NCH = S / SC_CS;
#pragma unroll 1
    for (int vb = (int)blockIdx.x; vb < 256; vb += (int)gridDim.x) {
        const int bh = vb >> 3, sub = vb & 7, b = bh >> 4, h = bh & 15;
        const size_t base = (size_t)b * S * D + h * 64;
        if (wave >= 4) {
            const int pw = wave - 4;
            const float kkc = k_k[h * 64 + lane], kac = k_a[h * 64 + lane];
            ScRegs ga, gb;
            sc_load(ga, R, Kk, V, EW, Aa, base, 0, pw, sub, lane);
            sc_load(gb, R, Kk, V, EW, Aa, base, 1, pw, sub, lane);
            sc_compute(ga, buf, pw, kkc, kac, lane);
            SC_BAR();
#pragma unroll 1
            for (int c = 0; c < NCH; c += 2) {
                { const int c2 = (c + 2 < NCH) ? c + 2 : c; sc_load(ga, R, Kk, V, EW, Aa, base, c2, pw, sub, lane); }
                sc_compute(gb, buf + SC_BUF_F, pw, kkc, kac, lane);
                SC_BAR();
                { const int c3 = (c + 3 < NCH) ? c + 3 : c + 1; sc_load(gb, R, Kk, V, EW, Aa, base, c3, pw, sub, lane); }
                if (c + 2 < NCH) sc_compute(ga, buf, pw, kkc, kac, lane);
                SC_BAR();
            }
            SC_BAR();
        } else if (wave < 2) {
            const int jg = lane & 15, cw = wave;
            float s0 = 0.f, s1 = 0.f, s2 = 0.f, s3 = 0.f;
            SC_BAR();
#pragma unroll 1
            for (int c = 0; c < NCH; ++c) {
                const LAS float* sb = buf + (c & 1) * SC_BUF_F + 4 * jg;
                const LAS float* vb_ = buf + (c & 1) * SC_BUF_F + 320 + cw * 4 + (lane >> 4);
                LAS float* yp = buf + 2 * SC_BUF_F + ((c & 1) * 2 + cw) * (SC_CS * 64) + lane;
                f32x4 kk4 = *(const LAS f32x4*)(sb), bb4 = *(const LAS f32x4*)(sb + 64), kt4 = *(const LAS f32x4*)(sb + 128), w4 = *(const LAS f32x4*)(sb + 192), r4 = *(const LAS f32x4*)(sb + 256); float vi = vb_[0];
#pragma unroll 4
                for (int st = 0; st < SC_CS; ++st) {
                    const int sn = (st + 1 < SC_CS) ? st + 1 : st;
                    const f32x4 nkk = *(const LAS f32x4*)(sb + sn * SC_STEP_F), nbb = *(const LAS f32x4*)(sb + sn * SC_STEP_F + 64), nkt = *(const LAS f32x4*)(sb + sn * SC_STEP_F + 128), nw = *(const LAS f32x4*)(sb + sn * SC_STEP_F + 192), nr4 = *(const LAS f32x4*)(sb + sn * SC_STEP_F + 256);
                    const float nvi = vb_[sn * SC_STEP_F];
                    const float sa = -row16_sum((s0 * kk4[0] + s1 * kk4[1]) + (s2 * kk4[2] + s3 * kk4[3]));
                    s0 = s0 * w4[0] + (sa * bb4[0] + vi * kt4[0]); s1 = s1 * w4[1] + (sa * bb4[1] + vi * kt4[1]);
                    s2 = s2 * w4[2] + (sa * bb4[2] + vi * kt4[2]); s3 = s3 * w4[3] + (sa * bb4[3] + vi * kt4[3]);
                    yp[st * 64] = (s0 * r4[0] + s1 * r4[1]) + (s2 * r4[2] + s3 * r4[3]);
                    kk4 = nkk; bb4 = nbb; kt4 = nkt; w4 = nw; r4 = nr4; vi = nvi;
                }
                SC_BAR();
            }
            SC_BAR();
        } else {
            const int cw = wave - 2;
            h16* pY = Yraw + ((size_t)(bh * 16 + sub * 2 + cw) * S) * 4;
            SC_BAR();
#pragma unroll 1
            for (int c = 0; c <= NCH; ++c) {
                if (c > 0) {
                    const LAS float* yp = buf + 2 * SC_BUF_F + (((c - 1) & 1) * 2 + cw) * (SC_CS * 64);
                    const int st = lane >> 1, r0 = 2 * (lane & 1);
                    float a0 = 0.f, a1 = 0.f;
#pragma unroll
                    for (int q = 0; q < 4; ++q) { const f32x4 x = *(const LAS f32x4*)(yp + st * 64 + r0 * 16 + 4 * q), z = *(const LAS f32x4*)(yp + st * 64 + (r0 + 1) * 16 + 4 * q);
                        a0 += (x[0] + x[1]) + (x[2] + x[3]); a1 += (z[0] + z[1]) + (z[2] + z[3]); }
                    *(unsigned*)(pY + (size_t)((c - 1) * SC_CS + st) * 4 + r0) = pk_h16(a0, a1);
                }
                SC_BAR();
            }
        }
        if (false) {
            SC_BAR();
#pragma unroll 1
            for (int c = 0; c < NCH; ++c) SC_BAR();
        }
    }
}
__device__ __forceinline__ void rwkv_gn(h16* R, const h16* Kk, const h16* V, const h16* Aa, const h16* Yraw, const float* k_a, const float* r_k, const float* ln_w, const float* ln_b, int gw, int NGW, int lane_) {
    int lane = lane_; asm volatile("" : "+v"(lane));
#pragma unroll 2
    for (int idx = gw; idx < M * 16; idx += NGW) {
        const int m = idx >> 4, h = idx & 15, col = h * 64 + lane; const size_t o = (size_t)m * D + col;
        const int bq = m / S, tq = m - bq * S;
        const float y = (float)Yraw[((size_t)((bq * 16 + h) * 16 + (lane >> 2)) * S + tq) * 4 + (lane & 3)], r = (float)R[o], k = (float)Kk[o], a = (float)Aa[o], v = (float)V[o];
        const float kt = k * (1.0f + (a - 1.0f) * k_a[col]);
        const float mu = wave_sum_dpp(y) * (1.f / 64.f); const float d = y - mu; const float var = wave_sum_dpp(d * d) * (1.f / 64.f);
        const float bs = wave_sum_dpp(r * kt * r_k[col]);
        const float yn = d * rsqrtf(var + 64e-5f) * ln_w[col] + ln_b[col];
        R[o] = (h16)(yn + bs * v);
    }
}

constexpr size_t KF_STRIDE = (size_t)NB * 4 * S * 64;
__device__ __forceinline__ float gelu_tanh(float x) { const float u = 0.7978845608f * (x + 0.044715f * x * x * x); return 0.5f * x * (1.0f + tanhf_(u)); }
__device__ __forceinline__ void store_vf8(bf16_t* chunk_base_d, int keyp0  , f32x4 a, f32x4 b) {
    const int tile = keyp0 >> 4, rq0 = (keyp0 & 15) >> 2;
    u32x2 w0, w1; w0.x = cvt_pk_bf16(a[0], a[1]); w0.y = cvt_pk_bf16(a[2], a[3]); w1.x = cvt_pk_bf16(b[0], b[1]); w1.y = cvt_pk_bf16(b[2], b[3]);
    *(u32x2*)(chunk_base_d + 8 * rq0 + 4 * tile) = w0; *(u32x2*)(chunk_base_d + 8 * (rq0 + 1) + 4 * tile) = w1;
}
struct FNsaIn { bf16_t* Q; bf16_t* KF; float* gates; const float* rope;
    __device__ __forceinline__ void operator()(int row, int col0, f32x4 a, f32x4 b) const {
        const int tile = __builtin_amdgcn_readfirstlane(col0 >> 8);
        const int bb = row / S, t = row - bb * S;
        if (tile < 7) {
            f32x4 x = a, y = b;
            if ((col0 & 32) == 0) {
                f32x4 px, py;
#pragma unroll
                for (int i = 0; i < 4; ++i) { px[i] = __shfl_xor(x[i], 16); py[i] = __shfl_xor(y[i], 16); }
                const int d0 = col0 & 63;
                if (d0 < 16) { const f32x4 c0 = *(const f32x4*)(rope + t * 16), c1 = *(const f32x4*)(rope + t * 16 + 4), s0 = *(const f32x4*)(rope + t * 16 + 8), s1 = *(const f32x4*)(rope + t * 16 + 12);
                    if (d0 == 0) { x = x * c0 - px * s0; y = y * c1 - py * s1; } else { x = x * c0 + px * s0; y = y * c1 + py * s1; } }
            }
            if (tile < 4) { x = x * 0.125f; y = y * 0.125f;
                u32x4 w; w.x = cvt_pk_bf16(x[0], x[1]); w.y = cvt_pk_bf16(x[2], x[3]); w.z = cvt_pk_bf16(y[0], y[1]); w.w = cvt_pk_bf16(y[2], y[3]);
                *(u32x4*)(Q + (size_t)row * D + col0) = w; }
            else { const int idx = tile - 4, g = (col0 & 255) >> 6, d0 = col0 & 63;
                u32x4 w; w.x = cvt_pk_bf16(x[0], x[1]); w.y = cvt_pk_bf16(x[2], x[3]); w.z = cvt_pk_bf16(y[0], y[1]); w.w = cvt_pk_bf16(y[2], y[3]);
                *(u32x4*)(KF + (size_t)idx * KF_STRIDE + ((size_t)(bb * 4 + g) * S + t) * 64 + d0) = w; }
        } else if (tile == 7) { const int g = (col0 & 255) >> 6, d0 = col0 & 63;
            u32x4 w; w.x = cvt_pk_bf16(a[0], a[1]); w.y = cvt_pk_bf16(a[2], a[3]); w.z = cvt_pk_bf16(b[0], b[1]); w.w = cvt_pk_bf16(b[2], b[3]);
            *(u32x4*)(KF + (size_t)3 * KF_STRIDE + ((size_t)(bb * 4 + g) * S + t) * 64 + d0) = w;
        } else { const int c = col0 - 2048;
            if (c < 48) { f32x4 x, y;
#pragma unroll
                for (int i = 0; i < 4; ++i) { x[i] = sigmoidf_(a[i]); y[i] = sigmoidf_(b[i]); }
                *(f32x4*)(gates + (size_t)row * 48 + c) = x; *(f32x4*)(gates + (size_t)row * 48 + c + 4) = y; }
        }
    } };
struct FNsaVT { bf16_t* VF;
    __device__ __forceinline__ void operator()(int row, int col0, f32x4 a, f32x4 b) const {
        const int br = row >> 8, g = (row >> 6) & 3, d = row & 63, bb = col0 / S, t0 = col0 - bb * S;
        bf16_t* base = VF + (size_t)br * KF_STRIDE + (size_t)(bb * 4 + g) * S * 64 + (size_t)(t0 >> 5) * 2048 + d * 32;
        store_vf8(base, t0 & 31, a, b); } };
struct FCmp1 { bf16_t* CH; const float* bias;
    __device__ __forceinline__ void operator()(int row, int col0, f32x4 a, f32x4 b) const {
        const f32x4 p = *(const f32x4*)(bias + col0), q = *(const f32x4*)(bias + col0 + 4); float o[8];
#pragma unroll
        for (int i = 0; i < 4; ++i) { o[i] = gelu_tanh(a[i] + p[i]); o[4 + i] = gelu_tanh(b[i] + q[i]); }
        u32x4 w; w.x = cvt_pk_bf16(o[0], o[1]); w.y = cvt_pk_bf16(o[2], o[3]); w.z = cvt_pk_bf16(o[4], o[5]); w.w = cvt_pk_bf16(o[6], o[7]);
        *(u32x4*)(CH + (size_t)row * 256 + col0) = w; } };
struct FCmp2K { bf16_t* KC;
    __device__ __forceinline__ void operator()(int row, int col0, f32x4 a, f32x4 b) const {
        if (col0 < 64) { u32x4 w; w.x = cvt_pk_bf16(a[0], a[1]); w.y = cvt_pk_bf16(a[2], a[3]); w.z = cvt_pk_bf16(b[0], b[1]); w.w = cvt_pk_bf16(b[2], b[3]);
            *(u32x4*)(KC + (size_t)row * 64 + col0) = w; } } };
struct FCmp2VT { bf16_t* VC;
    __device__ __forceinline__ void operator()(int row, int col0, f32x4 a, f32x4 b) const {
        if (row < 64) { const int bg = col0 >> 10, n0 = col0 & 1023;
            bf16_t* base = VC + (size_t)bg * 65536 + (size_t)(n0 >> 5) * 2048 + row * 32; store_vf8(base, n0 & 31, a, b); } } };

__device__ __forceinline__ f32x4 mfma16(bf16x8 a, bf16x8 b, f32x4 c) { return __builtin_amdgcn_mfma_f32_16x16x32_bf16(a, b, c, 0, 0, 0); }
__device__ __forceinline__ bf16x8 ld8(const bf16_t* p) { return *(const bf16x8*)p; }
__device__ __forceinline__ bf16x8 pack8(f32x4 a, f32x4 b) { u32x4 w; w.x = cvt_pk_bf16(a[0], a[1]); w.y = cvt_pk_bf16(a[2], a[3]); w.z = cvt_pk_bf16(b[0], b[1]); w.w = cvt_pk_bf16(b[2], b[3]); return __builtin_bit_cast(bf16x8, w); }
__device__ __forceinline__ float colmax(float x) { x = fmaxf(x, __shfl_xor(x, 16)); return fmaxf(x, __shfl_xor(x, 32)); }
__device__ __forceinline__ float colsum(float x) { x += __shfl_xor(x, 16); return x + __shfl_xor(x, 32); }
struct AttnState { float m, l; f32x4 o[4]; };
__device__ __forceinline__ void attn_init(AttnState& st) { st.m = -1e30f; st.l = 0.f;
#pragma unroll
    for (int d = 0; d < 4; ++d) st.o[d] = (f32x4){0.f, 0.f, 0.f, 0.f}; }
__device__ __forceinline__ void attn_chunk(AttnState& st, const bf16_t* kptr, const bf16_t* vptr, const bf16x8 q0, const bf16x8 q1, unsigned vmask) {
    f32x4 s[2];
#pragma unroll
    for (int tl = 0; tl < 2; ++tl) { const bf16x8 k0 = ld8(kptr + tl * 1024), k1 = ld8(kptr + tl * 1024 + 32);
        s[tl] = mfma16(k0, q0, (f32x4){0.f, 0.f, 0.f, 0.f}); s[tl] = mfma16(k1, q1, s[tl]); }
    float mx = -1e30f;
#pragma unroll
    for (int tl = 0; tl < 2; ++tl)
#pragma unroll
        for (int i = 0; i < 4; ++i) { const bool v = (vmask >> (tl * 4 + i)) & 1u; s[tl][i] = v ? s[tl][i] : -1e30f; mx = fmaxf(mx, s[tl][i]); }
    mx = colmax(mx);
    const float mnew = fmaxf(st.m, mx), alpha = __expf(st.m - mnew);
    f32x4 p[2]; float ps = 0.f;
#pragma unroll
    for (int tl = 0; tl < 2; ++tl)
#pragma unroll
        for (int i = 0; i < 4; ++i) { const bool v = (vmask >> (tl * 4 + i)) & 1u; p[tl][i] = v ? __expf(s[tl][i] - mnew) : 0.f; ps += p[tl][i]; }
    st.l = st.l * alpha + ps; st.m = mnew;
    const bf16x8 pb = pack8(p[0], p[1]);
#pragma unroll
    for (int d = 0; d < 4; ++d) { st.o[d] = st.o[d] * alpha; st.o[d] = mfma16(ld8(vptr + d * 512), pb, st.o[d]); }
}

__device__ __forceinline__ void nsa_attention(const bf16_t* Q, const bf16_t* KF, const bf16_t* VF, const bf16_t* KC, const bf16_t* VC, const float* gates, bf16_t* OUT, LAS unsigned char* lds, int G, int wave, int lane_) {
    int lane = lane_; asm volatile("" : "+v"(lane));
    const int col = lane & 15, rq = lane >> 4;
    LAS float* imp = (LAS float*)(lds + wave * 18432);
    LAS int* sel = (LAS int*)(lds + wave * 18432 + 16384);
    const bool xcd_map = (G % 8) == 0;
    const int nslots = xcd_map ? (G >> 3) * NWAVES : G * NWAVES, slot = xcd_map ? ((int)blockIdx.x >> 3) * NWAVES + wave : (int)blockIdx.x * NWAVES + wave;
    const int ntask = xcd_map ? 1024 : 8192;
#pragma unroll 1
    for (int task = slot; task < ntask; task += nslots) {
        const int tilei = xcd_map ? task : (task >> 3), bg = xcd_map ? ((int)blockIdx.x & 7) : (task & 7), b = bg >> 2, g = bg & 3, t0 = tilei * 16, t = t0 + col;
        const size_t rowq = (size_t)b * S + t;
        const bf16_t* qrow = Q + rowq * D + (g * 4) * 64 + 8 * rq;
        const float* grow = gates + rowq * 48 + g * 12;
        f32x4 total[4][4];
        float mc[4], lc[4];
        const int cur_max = (t0 + 15) >> 6;
        int n_end = 4 * (cur_max + 1); if (n_end > 1024) n_end = 1024;
        const int nchunk_c = (n_end + 31) >> 5;
        const bf16_t* kc_l = KC + (size_t)bg * 65536 + (size_t)col * 64 + 8 * rq;
        const bf16_t* vc_l = VC + (size_t)bg * 65536 + (size_t)col * 32 + 8 * rq;
#pragma unroll
        for (int h = 0; h < 4; ++h) {
            const bf16x8 q0 = ld8(qrow + h * 64), q1 = ld8(qrow + h * 64 + 32);
            AttnState st; attn_init(st);
#pragma unroll 1
            for (int kc = 0; kc < nchunk_c; ++kc) {
                unsigned vm = 0u;
#pragma unroll
                for (int tl = 0; tl < 2; ++tl)
#pragma unroll
                    for (int i = 0; i < 4; ++i) { const int n = kc * 32 + tl * 16 + 4 * rq + i; if (16 * n + 31 <= t) vm |= 1u << (tl * 4 + i); }
                attn_chunk(st, kc_l + (size_t)kc * 2048, vc_l + (size_t)kc * 2048, q0, q1, vm);
            }
            const float lt = colsum(st.l); const float inv = lt > 0.f ? 1.0f / lt : 0.f; const float gc = grow[h * 3 + 0] * inv;
            mc[h] = st.m; lc[h] = inv;
#pragma unroll
            for (int d = 0; d < 4; ++d) total[h][d] = st.o[d] * gc;
        }
        {
            float carry = 0.f;
#pragma unroll 1
            for (int kc = 0; kc < nchunk_c; ++kc) {
#pragma unroll
                for (int tl = 0; tl < 2; ++tl) {
                    const bf16x8 k0 = ld8(kc_l + (size_t)kc * 2048 + tl * 1024), k1 = ld8(kc_l + (size_t)kc * 2048 + tl * 1024 + 32);
                    float own = 0.f, p3 = 0.f;
#pragma unroll
                    for (int h = 0; h < 4; ++h) {
                        const bf16x8 q0 = ld8(qrow + h * 64), q1 = ld8(qrow + h * 64 + 32);
                        f32x4 sc = mfma16(k0, q0, (f32x4){0.f, 0.f, 0.f, 0.f}); sc = mfma16(k1, q1, sc);
#pragma unroll
                        for (int i = 0; i < 4; ++i) { const int n = kc * 32 + tl * 16 + 4 * rq + i; const float p = (16 * n + 31 <= t) ? __expf(sc[i] - mc[h]) * lc[h] : 0.f; own += p; if (i == 3) p3 += p; }
                    }
                    const float up = __shfl(p3, (lane + 48) & 63);
                    const float add = (rq == 0) ? carry : up;
                    imp[col * 256 + kc * 8 + tl * 4 + rq] = own + add;
                    carry = __shfl(p3, col + 48);
                }
            }
        }
#pragma unroll 1
        for (int c = 0; c < 16; ++c) {
            const int tc = t0 + c, cur = tc >> 6;
            if (cur < 16) { if (lane <= cur) sel[c * 17 + lane] = lane; if (lane == 0) sel[c * 17 + 16] = cur + 1; }
            else {
                unsigned key[4];
#pragma unroll
                for (int j = 0; j < 4; ++j) { const int sb = lane + 64 * j; const float v = imp[c * 256 + sb]; key[j] = (sb >= 1 && sb <= cur - 2) ? ((__float_as_uint(v) & 0xFFFFFF00u) | (unsigned)(255 - sb)) : 0u; }
                if (lane == 0) { sel[c * 17 + 0] = 0; sel[c * 17 + 1] = cur - 1; sel[c * 17 + 2] = cur; sel[c * 17 + 16] = 16; }
#pragma unroll 1
                for (int r = 0; r < 13; ++r) {
                    unsigned best = max(max(key[0], key[1]), max(key[2], key[3]));
#pragma unroll
                    for (int o = 1; o < 64; o <<= 1) best = max(best, (unsigned)__shfl_xor((int)best, o));
                    if (lane == 0) sel[c * 17 + 3 + r] = 255 - (int)(best & 255u);
#pragma unroll
                    for (int j = 0; j < 4; ++j) if (key[j] == best) key[j] = 0u;
                }
            }
        }
        {
            const bf16_t* ks_b = KF + (size_t)1 * KF_STRIDE + (size_t)bg * S * 64 + (size_t)col * 64 + 8 * rq;
            const bf16_t* vs_b = VF + (size_t)bg * S * 64 + (size_t)col * 32 + 8 * rq;
#pragma unroll 1
            for (int c = 0; c < 16; ++c) {
                const int tc = t0 + c;
                bf16x8 q0 = (bf16x8){0, 0, 0, 0, 0, 0, 0, 0}, q1 = q0;
                if (col < 4) { const bf16_t* qp = Q + ((size_t)b * S + tc) * D + (g * 4 + col) * 64 + 8 * rq; q0 = ld8(qp); q1 = ld8(qp + 32); }
                AttnState st; attn_init(st);
                const int cnt = __builtin_amdgcn_readfirstlane(sel[c * 17 + 16]);
#pragma unroll 1
                for (int bi = 0; bi < cnt; ++bi) {
                    const int j = __builtin_amdgcn_readfirstlane(sel[c * 17 + bi]);
#pragma unroll
                    for (int k2 = 0; k2 < 2; ++k2) {
                        const int kp0 = j * 64 + k2 * 32 + 4 * rq; unsigned vm = 0u;
#pragma unroll
                        for (int tl = 0; tl < 2; ++tl)
#pragma unroll
                            for (int i = 0; i < 4; ++i) if (kp0 + tl * 16 + i <= tc) vm |= 1u << (tl * 4 + i);
                        attn_chunk(st, ks_b + (size_t)(j * 64 + k2 * 32) * 64, vs_b + (size_t)(j * 2 + k2) * 2048, q0, q1, vm);
                    }
                }
                const float lt = colsum(st.l); const float inv = lt > 0.f ? 1.0f / lt : 0.f;
                const float gs = (col < 4) ? gates[((size_t)b * S + tc) * 48 + g * 12 + col * 3 + 1] * inv : 0.f;
#pragma unroll
                for (int h = 0; h < 4; ++h)
#pragma unroll
                    for (int d = 0; d < 4; ++d)
#pragma unroll
                        for (int i = 0; i < 4; ++i) { const float v = __shfl(st.o[d][i] * gs, h + (lane & 48)); total[h][d][i] += (col == c) ? v : 0.f; }
            }
        }
        {
            int lo = t0 - 511; if (lo < 0) lo = 0; const int c0 = lo >> 5, c1 = (t0 + 15) >> 5;
            const bf16_t* kw_b = KF + (size_t)2 * KF_STRIDE + (size_t)bg * S * 64 + (size_t)col * 64 + 8 * rq;
            const bf16_t* vw_b = VF + (size_t)1 * KF_STRIDE + (size_t)bg * S * 64 + (size_t)col * 32 + 8 * rq;
#pragma unroll
            for (int h = 0; h < 4; ++h) {
                const bf16x8 q0 = ld8(qrow + h * 64), q1 = ld8(qrow + h * 64 + 32);
                AttnState st; attn_init(st);
#pragma unroll 1
                for (int ch = c0; ch <= c1; ++ch) {
                    unsigned vm = 0u;
#pragma unroll
                    for (int tl = 0; tl < 2; ++tl)
#pragma unroll
                        for (int i = 0; i < 4; ++i) { const int kp = ch * 32 + tl * 16 + 4 * rq + i; if (kp <= t && kp + 512 > t) vm |= 1u << (tl * 4 + i); }
                    attn_chunk(st, kw_b + (size_t)ch * 2048, vw_b + (size_t)ch * 2048, q0, q1, vm);
                }
                const float lt = colsum(st.l); const float inv = lt > 0.f ? 1.0f / lt : 0.f; const float gwv = grow[h * 3 + 2] * inv;
#pragma unroll
                for (int d = 0; d < 4; ++d) total[h][d] = total[h][d] + st.o[d] * gwv;
            }
        }
#pragma unroll
        for (int h = 0; h < 4; ++h)
#pragma unroll
            for (int d = 0; d < 4; ++d) { u32x2 w; w.x = cvt_pk_bf16(total[h][d][0], total[h][d][1]); w.y = cvt_pk_bf16(total[h][d][2], total[h][d][3]);
                *(u32x2*)(OUT + rowq * D + (g * 4 + h) * 64 + d * 16 + 4 * rq) = w; }
    }
}

#define GSYNC() do { asm volatile("s_waitcnt vmcnt(0)" ::: "memory"); __builtin_amdgcn_fence(__ATOMIC_RELEASE, "agent"); grid.sync(); __builtin_amdgcn_fence(__ATOMIC_ACQUIRE, "agent"); } while (0)
__global__ void __launch_bounds__(NTHREADS, 2) fwd_kernel(Params P) {
    extern __shared__ __attribute__((aligned(16))) unsigned char lds_raw[];
    LAS unsigned char* lds = (LAS unsigned char*)lds_raw;
    cg::grid_group grid = cg::this_grid();
    const int tid = threadIdx.x, lane = tid & 63, wave = __builtin_amdgcn_readfirstlane(tid >> 6);
    const int G = gridDim.x, gw = blockIdx.x * NWAVES + wave, NGW = G * NWAVES;
    unsigned char* ws = P.ws;
    float* xres = P.out;
    LAS float* scr = (LAS float*)(lds + wave * 16384);
    const float* x_in = P.in[0];
    const float* norm_mix = P.in[1]; const float* norm_mlp = P.in[2]; const float* norm_final = P.in[3];
    const float* mlp_w1 = P.in[4]; const float* mlp_w2 = P.in[5];

    for (int layer = 0; layer < 4; ++layer) {
        int lane = threadIdx.x & 63; asm volatile("" : "+v"(lane));
        const bool is_rwkv = (layer & 1) != 0; const int lj = layer >> 1;
        const float* xsrc = (layer == 0) ? x_in : xres;
        {
            TJob j1{mlp_w1 + (size_t)layer * D * FF, FF, 0, FF, D, (bf16_t*)(ws + WS_W + W_MLP1), D, 0, 0, FF, D, nullptr, 0};
            transpose_job(j1, scr, gw, NGW, lane);
            TJob j2{mlp_w2 + (size_t)layer * FF * D, D, 0, D, FF, (bf16_t*)(ws + WS_W + W_MLP2), FF, 0, 0, D, FF, nullptr, 0};
            transpose_job(j2, scr, gw, NGW, lane);
            if (is_rwkv) {
                const float* mix = P.in[14] + (size_t)lj * 6 * D;
                bf16_t* WrT = (bf16_t*)(ws + WS_W + W_RW_IN);
                const float* wrkv = P.in[15] + (size_t)lj * 3 * D * D;
                for (int part = 0; part < 8; ++part) {
                    const float* W; int ldw, Nsrc, mi, r0, Npad;
                    if (part == 0) { W = wrkv; ldw = D; Nsrc = D; mi = 0; r0 = 0; Npad = D; }
                    else if (part == 1) { W = wrkv + (size_t)D * D; ldw = D; Nsrc = D; mi = 2; r0 = 1024; Npad = D; }
                    else if (part == 2) { W = wrkv + (size_t)2 * D * D; ldw = D; Nsrc = D; mi = 3; r0 = 2048; Npad = D; }
                    else if (part == 3) { W = P.in[17] + (size_t)lj * D * 64; ldw = 64; Nsrc = 64; mi = 1; r0 = 3072; Npad = 128; }
                    else if (part == 4) { W = P.in[20] + (size_t)lj * D * 64; ldw = 64; Nsrc = 64; mi = 4; r0 = 3200; Npad = 128; }
                    else if (part == 5) { W = P.in[22] + (size_t)lj * D * 160; ldw = 160; Nsrc = 160; mi = 5; r0 = 3328; Npad = 256; }
                    else if (part == 6) { W = P.in[31]; ldw = 32; Nsrc = (lj >= 1) ? 32 : 0; mi = 3; r0 = 3584; Npad = 128; }
                    else { W = P.in[31]; ldw = 32; Nsrc = 0; mi = 3; r0 = 3712; Npad = 128; }
                    TJob ja{W, ldw, 0, Nsrc, D, WrT, 2048, r0, 0, Npad, D, mix + mi * D, 1};
                    transpose_job(ja, scr, gw, NGW, lane);
                    TJob jb{W, ldw, 0, Nsrc, D, WrT, 2048, r0, 1024, Npad, D, mix + mi * D, 2};
                    transpose_job(jb, scr, gw, NGW, lane);
                }
                TJob jw{P.in[18] + (size_t)lj * 64 * D, D, 0, D, 64, (bf16_t*)(ws + WS_W + W_RW_W2), 128, 0, 0, D, 128, nullptr, 0}; transpose_job(jw, scr, gw, NGW, lane);
                TJob jaa{P.in[21] + (size_t)lj * 64 * D, D, 0, D, 64, (bf16_t*)(ws + WS_W + W_RW_A2), 128, 0, 0, D, 128, nullptr, 0}; transpose_job(jaa, scr, gw, NGW, lane);
                TJob jv{P.in[32], D, 0, D, (lj >= 1) ? 32 : 0, (bf16_t*)(ws + WS_W + W_RW_V2), 128, 0, 0, D, 128, nullptr, 0}; transpose_job(jv, scr, gw, NGW, lane);
                TJob jg{P.in[23] + (size_t)lj * 160 * D, D, 0, D, 160, (bf16_t*)(ws + WS_W + W_RW_G2), 256, 0, 0, D, 256, nullptr, 0}; transpose_job(jg, scr, gw, NGW, lane);
                TJob jo{P.in[29] + (size_t)lj * D * D, D, 0, D, D, (bf16_t*)(ws + WS_W + W_RW_O), D, 0, 0, D, D, nullptr, 0}; transpose_job(jo, scr, gw, NGW, lane);
                bf16_t* HN = (bf16_t*)(ws + A_HN);
                if (gw < 2) { u32x4* z = (u32x4*)(HN + (size_t)gw * (S + 1) * D); for (int q = lane; q < D / 8; q += 64) z[q] = (u32x4){0u, 0u, 0u, 0u}; }
                for (int m = gw; m < M; m += NGW) { const int b = m / S; rms_row_bf16(xsrc + (size_t)m * D, norm_mix + layer * D, HN + ((size_t)m + b + 1) * D, nullptr, lane); }
            } else {
                const float* win = P.in[6] + (size_t)lj * D * 2608;
                bf16_t* WnT = (bf16_t*)(ws + WS_W + W_NSA_IN); bf16_t* WvT = (bf16_t*)(ws + WS_W + W_NSA_V);
                for (int part = 0; part < 8; ++part) {
                    int n0src, Nsrc, r0, Npad; bf16_t* WT = WnT;
                    if (part == 0) { n0src = 0; Nsrc = 1024; r0 = 0; Npad = 1024; }
                    else if (part == 1) { n0src = 1024; Nsrc = 256; r0 = 1024; Npad = 256; }
                    else if (part == 2) { n0src = 1024 + 512; Nsrc = 256; r0 = 1280; Npad = 256; }
                    else if (part == 3) { n0src = 1024 + 1024; Nsrc = 256; r0 = 1536; Npad = 256; }
                    else if (part == 4) { n0src = 1024 + 256; Nsrc = 256; r0 = 1792; Npad = 256; }
                    else if (part == 5) { n0src = 2560; Nsrc = 48; r0 = 2048; Npad = 256; }
                    else if (part == 6) { n0src = 1024 + 768; Nsrc = 256; r0 = 0; Npad = 256; WT = WvT; }
                    else { n0src = 1024 + 1280; Nsrc = 256; r0 = 256; Npad = 256; WT = WvT; }
                    TJob jn{win, 2608, n0src, Nsrc, D, WT, D, r0, 0, Npad, D, nullptr, 0}; transpose_job(jn, scr, gw, NGW, lane);
                }
                TJob jo{P.in[13] + (size_t)lj * D * D, D, 0, D, D, (bf16_t*)(ws + WS_W + W_NSA_O), D, 0, 0, D, D, nullptr, 0}; transpose_job(jo, scr, gw, NGW, lane);
                TJob jc1k{P.in[8] + (size_t)lj * 2048 * 256, 256, 0, 256, 2048, (bf16_t*)(ws + WS_W + W_C1K), 2048, 0, 0, 256, 2048, nullptr, 0}; transpose_job(jc1k, scr, gw, NGW, lane);
                TJob jc1v{P.in[11] + (size_t)lj * 2048 * 256, 256, 0, 256, 2048, (bf16_t*)(ws + WS_W + W_C1V), 2048, 0, 0, 256, 2048, nullptr, 0}; transpose_job(jc1v, scr, gw, NGW, lane);
                TJob jc2k{P.in[9] + (size_t)lj * 256 * 64, 64, 0, 64, 256, (bf16_t*)(ws + WS_W + W_C2K), 256, 0, 0, 256, 256, nullptr, 0}; transpose_job(jc2k, scr, gw, NGW, lane);
                TJob jc2v{P.in[12] + (size_t)lj * 256 * 64, 64, 0, 64, 256, (bf16_t*)(ws + WS_W + W_C2V), 256, 0, 0, 256, 256, nullptr, 0}; transpose_job(jc2v, scr, gw, NGW, lane);
                {
                    int ln = lane; asm volatile("" : "+v"(ln));
                    float* cb = (float*)(ws + WS_W + W_CBIAS);
#pragma unroll 1
                    for (int o = gw; o < 512; o += NGW) { const int isv = o >> 8, c = o & 255;
                        const float* pe = (isv ? P.in[10] : P.in[7]) + (size_t)lj * 2048; const float* w1 = (isv ? P.in[11] : P.in[8]) + (size_t)lj * 2048 * 256;
                        float acc = 0.f;
#pragma unroll 1
                        for (int k = ln; k < 2048; k += 64) acc += pe[k] * w1[(size_t)k * 256 + c];
                        acc = wave_sum(acc); if (ln == 0) cb[o] = acc; }
                    if (layer == 0) {
                        float* rt = (float*)(ws + WS_ROPE);
                        int tix = threadIdx.x; asm volatile("" : "+v"(tix)); const int gt = (int)blockIdx.x * NTHREADS + tix;
#pragma unroll 1
                        for (int e = gt; e < S * 8; e += G * NTHREADS) { const int tt = e >> 3, i = e & 7;
                            const float invf = (i == 0) ? 1.0f : (i == 1) ? 0.1939227432012558f : (i == 2) ? 0.03760603070259094f : (i == 3) ? 0.007292664609849453f : (i == 4) ? 0.0014142135623842478f : (i == 5) ? 0.00027424818836152554f : (i == 6) ? 5.318296098266728e-05f : 1.0313386155758053e-05f;
                            const float ang = (float)tt * invf; const double rev = (double)ang * 0.15915494309189535; const float fr = (float)(rev - __builtin_rint(rev));
                            rt[tt * 16 + i] = __builtin_amdgcn_cosf(fr); rt[tt * 16 + 8 + i] = __builtin_amdgcn_sinf(fr); }
                    }
                }
                for (int m = gw; m < M; m += NGW) rms_row_bf16(xsrc + (size_t)m * D, norm_mix + layer * D, (bf16_t*)(ws + A_HN) + (size_t)m * D, (layer == 0) ? xres + (size_t)m * D : nullptr, lane);
            }
        }
        GSYNC();
        if (!is_rwkv) {
            bf16_t* HN = (bf16_t*)(ws + A_HN); bf16_t* Qb = (bf16_t*)(ws + A_Q); bf16_t* KFb = (bf16_t*)(ws + A_KF); bf16_t* VFb = (bf16_t*)(ws + A_VF);
            float* GT = (float*)(ws + A_GATES); bf16_t* CHK = (bf16_t*)(ws + A_CHK); bf16_t* CHV = (bf16_t*)(ws + A_CHV); bf16_t* KCb = (bf16_t*)(ws + A_KC); bf16_t* VCb = (bf16_t*)(ws + A_VC);
            {
                pg8::Gemm g{HN, (const bf16_t*)(ws + WS_W + W_NSA_IN), M, 2304, D, D, D, 0};
                pg8::StaticOrder so; so.init(M, 2304, G, (int)blockIdx.x);
                pg8::EpiP<FNsaIn> E{FNsaIn{Qb, KFb, GT, (const float*)(ws + WS_ROPE)}};
                pg8::gemm_phase<pg8::EpiP<FNsaIn>, true>(lds, g, so, E);
                pg8::Gemm g2{(const bf16_t*)(ws + WS_W + W_NSA_V), HN, 512, M, D, D, D, 0};
                pg8::StaticOrder so2; so2.init(512, M, G, (int)blockIdx.x);
                pg8::EpiP<FNsaVT> E2{FNsaVT{VFb}};
                pg8::gemm_phase<pg8::EpiP<FNsaVT>, true>(lds, g2, so2, E2);
            }
            GSYNC();
            {
                pg8::StaticOrder so; so.init(8192, 256, G, (int)blockIdx.x);
                { pg8::Gemm g{KFb, (const bf16_t*)(ws + WS_W + W_C1K), 8192, 256, 2048, 1024, 2048, 0}; pg8::EpiP<FCmp1> E{FCmp1{CHK, (const float*)(ws + WS_W + W_CBIAS)}}; pg8::gemm_phase<pg8::EpiP<FCmp1>, true>(lds, g, so, E); }
                { pg8::Gemm g{KFb + 3 * KF_STRIDE, (const bf16_t*)(ws + WS_W + W_C1V), 8192, 256, 2048, 1024, 2048, 0}; pg8::EpiP<FCmp1> E{FCmp1{CHV, (const float*)(ws + WS_W + W_CBIAS) + 256}}; pg8::gemm_phase<pg8::EpiP<FCmp1>, true>(lds, g, so, E); }
            }
            GSYNC();
            {
                { pg8::StaticOrder so; so.init(8192, 256, G, (int)blockIdx.x); pg8::Gemm g{CHK, (const bf16_t*)(ws + WS_W + W_C2K), 8192, 256, 256, 256, 256, 0}; pg8::EpiP<FCmp2K> E{FCmp2K{KCb}}; pg8::gemm_phase<pg8::EpiP<FCmp2K>, true>(lds, g, so, E); }
                { pg8::StaticOrder so; so.init(256, 8192, G, (int)blockIdx.x); pg8::Gemm g{(const bf16_t*)(ws + WS_W + W_C2V), CHV, 256, 8192, 256, 256, 256, 0}; pg8::EpiP<FCmp2VT> E{FCmp2VT{VCb}}; pg8::gemm_phase<pg8::EpiP<FCmp2VT>, true>(lds, g, so, E); }
            }
            GSYNC();
            nsa_attention(Qb, KFb, VFb, KCb, VCb, GT, HN, lds, G, wave, lane);
            GSYNC();
            {
                pg8::StaticOrder so; so.init(M, D, G, (int)blockIdx.x);
                pg8::Gemm g{HN, (const bf16_t*)(ws + WS_W + W_NSA_O), M, D, D, D, D, 0}; pg8::EpiN<FResAdd> E{FResAdd{xres}}; pg8::gemm_phase<pg8::EpiN<FResAdd>, true>(lds, g, so, E);
            }
            GSYNC();
        }
        if (is_rwkv) {
            h16* Rb = (h16*)(ws + A_R); h16* Kb = (h16*)(ws + A_K); h16* Ab = (h16*)(ws + A_A); h16* EWb = (h16*)(ws + A_HN);
            h16* Vb = (lj == 0) ? (h16*)(ws + WS_VF) : (h16*)(ws + A_V2);
            h16* Yraw = (lj == 0) ? (h16*)(ws + A_V2) : (h16*)(ws + WS_VF);
            bf16_t* LH = (bf16_t*)(ws + A_LH);
            {
                pg8::Gemm g{(const bf16_t*)(ws + A_HN), (const bf16_t*)(ws + WS_W + W_RW_IN), M, 3840, 2048, D, 2048, 1};
                pg8::StaticOrder so; so.init(M, 3840, G, (int)blockIdx.x);
                pg8::EpiP<FRwIn> E{FRwIn{Rb, Kb, Vb, LH}};
                pg8::gemm_phase<pg8::EpiP<FRwIn>, true>(lds, g, so, E);
            }
            GSYNC();
            {
                pg8::StaticOrder so; so.init(M, D, G, (int)blockIdx.x);
                { pg8::Gemm g{LH, (const bf16_t*)(ws + WS_W + W_RW_W2), M, D, 128, 768, 128, 0}; pg8::EpiP<FLoraW> E{FLoraW{EWb, P.in[16] + lj * D}}; pg8::gemm_phase<pg8::EpiP<FLoraW>, true>(lds, g, so, E); }
                { pg8::Gemm g{LH + 128, (const bf16_t*)(ws + WS_W + W_RW_A2), M, D, 128, 768, 128, 0}; pg8::EpiP<FLoraA> E{FLoraA{Ab, P.in[19] + lj * D}}; pg8::gemm_phase<pg8::EpiP<FLoraA>, true>(lds, g, so, E); }
                if (lj >= 1) { pg8::Gemm g{LH + 512, (const bf16_t*)(ws + WS_W + W_RW_V2), M, D, 128, 768, 128, 0}; pg8::EpiP<FLoraV> E{FLoraV{Vb, (const h16*)(ws + WS_VF), P.in[30]}}; pg8::gemm_phase<pg8::EpiP<FLoraV>, true>(lds, g, so, E); }
            }
            GSYNC();
            rwkv_scan2(Rb, Kb, Vb, EWb, Ab, P.in[24] + lj * D, P.in[25] + lj * D, Yraw, lds, wave, lane);
            GSYNC();
            rwkv_gn(Rb, Kb, Vb, Ab, Yraw, P.in[25] + lj * D, P.in[26] + lj * D, P.in[27] + lj * D, P.in[28] + lj * D, gw, NGW, lane);
            GSYNC();
            {
                pg8::StaticOrder so; so.init(M, D, G, (int)blockIdx.x);
                pg8::Gemm g{LH + 256, (const bf16_t*)(ws + WS_W + W_RW_G2), M, D, 256, 768, 256, 0}; pg8::EpiP<FGate> E{FGate{(bf16_t*)Kb, Rb}}; pg8::gemm_phase<pg8::EpiP<FGate>, true>(lds, g, so, E);
            }
            GSYNC();
            {
                pg8::StaticOrder so; so.init(M, D, G, (int)blockIdx.x);
                pg8::Gemm g{(const bf16_t*)Kb, (const bf16_t*)(ws + WS_W + W_RW_O), M, D, D, D, D, 0}; pg8::EpiN<FResAdd> E{FResAdd{xres}}; pg8::gemm_phase<pg8::EpiN<FResAdd>, true>(lds, g, so, E);
            }
            GSYNC();
        }
        for (int m = gw; m < M; m += NGW) rms_row_bf16(xres + (size_t)m * D, norm_mlp + layer * D, (bf16_t*)(ws + A_HN) + (size_t)m * D, nullptr, lane);
        GSYNC();
        {
            pg8::Gemm g{(const bf16_t*)(ws + A_HN), (const bf16_t*)(ws + WS_W + W_MLP1), M, FF, D, D, D, 0};
            pg8::StaticOrder so; so.init(M, FF, G, (int)blockIdx.x);
            pg8::EpiP<FRelu2> E{FRelu2{(bf16_t*)(ws + A_HID)}};
            pg8::gemm_phase<pg8::EpiP<FRelu2>, true>(lds, g, so, E);
        }
        GSYNC();
        {
            pg8::Gemm g{(const bf16_t*)(ws + A_HID), (const bf16_t*)(ws + WS_W + W_MLP2), M, D, FF, FF, FF, 0};
            pg8::StaticOrder so; so.init(M, D, G, (int)blockIdx.x);
            pg8::EpiN<FResAdd> E{FResAdd{xres}};
            pg8::gemm_phase<pg8::EpiN<FResAdd>, true>(lds, g, so, E);
        }
        GSYNC();
    }
    for (int m = gw; m < M; m += NGW) {
        int lane2 = lane; asm volatile("" : "+v"(lane2));
        f32x4* xr = (f32x4*)(xres + (size_t)m * D) + lane2; const f32x4* gr = (const f32x4*)norm_final + lane2;
        f32x4 v[4]; float s = 0.f;
#pragma unroll
        for (int j = 0; j < 4; ++j) { v[j] = xr[64 * j]; s += (v[j].x * v[j].x + v[j].y * v[j].y) + (v[j].z * v[j].z + v[j].w * v[j].w); }
        const float r = rsqrtf(wave_sum(s) * (1.f / D) + 1e-5f);
#pragma unroll
        for (int j = 0; j < 4; ++j) { const f32x4 gg = gr[64 * j]; xr[64 * j] = v[j] * r * gg; }
    }
}

extern "C" void kernel_launch(void* const* d_in, const int* in_sizes, int n_in, void* d_out, int out_size, void* d_ws, size_t ws_size, hipStream_t stream) {
    static int grid = 0;
    if (grid == 0) {
        if (n_in != 33 || out_size != M * D || ws_size < WS_NEED) { fprintf(stderr, "kernel_launch: unexpected sizes n_in %d out %d ws %zu (need %zu)\n", n_in, out_size, ws_size, (size_t)WS_NEED); grid = -1; return; }
        int dev = 0, cus = 0, per_cu = 0;
        hipGetDevice(&dev);
        hipDeviceGetAttribute(&cus, hipDeviceAttributeMultiprocessorCount, dev);
        if (hipFuncSetAttribute((const void*)fwd_kernel, hipFuncAttributeMaxDynamicSharedMemorySize, LDS_BYTES) != hipSuccess) { fprintf(stderr, "hipFuncSetAttribute failed\n"); grid = -1; return; }
        hipOccupancyMaxActiveBlocksPerMultiprocessor(&per_cu, (const void*)fwd_kernel, NTHREADS, LDS_BYTES);
        if (per_cu < 1) { fprintf(stderr, "occupancy query returned %d\n", per_cu); per_cu = 1; }
        (void)hipGetLastError();
        grid = cus * 1;
    }
    if (grid < 0) return;
    Params p{};
    for (int i = 0; i < 33; ++i) p.in[i] = (const float*)d_in[i];
    p.out = (float*)d_out; p.ws = (unsigned char*)d_ws;
    void* args[] = {&p};
    hipError_t e = hipLaunchCooperativeKernel((const void*)fwd_kernel, dim3(grid), dim3(NTHREADS), args, LDS_BYTES, stream);
    if (e != hipSuccess) fprintf(stderr, "cooperative launch failed: %s (grid %d)\n", hipGetErrorString(e), grid);
}
```

```cpp
#include <hip/hip_runtime.h>
#include <hip/hip_cooperative_groups.h>
#include <cstdio>
#include <cstdint>
namespace cg = cooperative_groups;

#define LAS __attribute__((address_space(3)))
typedef unsigned short bf16_t;
typedef short bf16x8 __attribute__((ext_vector_type(8)));
typedef float f32x4 __attribute__((ext_vector_type(4)));
typedef float f32x2 __attribute__((ext_vector_type(2)));
typedef unsigned u32x4 __attribute__((ext_vector_type(4)));
typedef unsigned u32x2 __attribute__((ext_vector_type(2)));
typedef _Float16 h16;
typedef _Float16 h16x2 __attribute__((ext_vector_type(2)));

constexpr int S = 16384, NB = 2, M = NB * S, D = 1024, FF = 4096;
constexpr int NWAVES = 8, NTHREADS = 512;
constexpr int LDS_BYTES = 147456;
constexpr size_t MiB = 1u << 20;
constexpr size_t WS_W = 0;
constexpr size_t W_MLP1 = 0, W_MLP2 = 8 * MiB;
constexpr size_t W_NSA_IN = 16 * MiB, W_NSA_V = 21 * MiB, W_NSA_O = 22 * MiB, W_C1K = 24 * MiB, W_C1V = 25 * MiB, W_C2K = 26 * MiB, W_C2V = 26 * MiB + 256 * 1024, W_CBIAS = 26 * MiB + 512 * 1024;
constexpr size_t W_RW_IN = 16 * MiB, W_RW_W2 = 31 * MiB, W_RW_A2 = 31 * MiB + 256 * 1024, W_RW_V2 = 31 * MiB + 512 * 1024, W_RW_G2 = 31 * MiB + 768 * 1024, W_RW_O = 33 * MiB;
constexpr size_t WS_ROPE = 36 * MiB;
constexpr size_t WS_VF = 40 * MiB;
constexpr size_t ACT = 104 * MiB;
constexpr size_t A_HN = ACT;
constexpr size_t A_Q = ACT + 65 * MiB;
constexpr size_t A_KF = ACT + 129 * MiB;
constexpr size_t A_VF = ACT + 194 * MiB;
constexpr size_t A_GATES = ACT + 226 * MiB;
constexpr size_t A_CHK = ACT + 233 * MiB, A_CHV = ACT + 237 * MiB, A_KC = ACT + 241 * MiB, A_VC = ACT + 242 * MiB;
constexpr size_t A_HID = ACT + 65 * MiB;
constexpr size_t A_R = ACT + 65 * MiB, A_K = ACT + 129 * MiB, A_V2 = ACT + 193 * MiB, A_A = ACT + 257 * MiB, A_LH = ACT + 321 * MiB;
constexpr size_t WS_NEED = ACT + 370 * MiB;

__device__ __forceinline__ int lane_id() { return (int)__builtin_amdgcn_mbcnt_hi(~0u, __builtin_amdgcn_mbcnt_lo(~0u, 0u)); }
__device__ __forceinline__ unsigned cvt_pk_bf16(float lo, float hi) { unsigned r; asm volatile("v_cvt_pk_bf16_f32 %0, %1, %2" : "=v"(r) : "v"(lo), "v"(hi)); return r; }
__device__ __forceinline__ unsigned pk_h16(float lo, float hi) { h16x2 v; v.x = (h16)lo; v.y = (h16)hi; return __builtin_bit_cast(unsigned, v); }
__device__ __forceinline__ float bf2f(bf16_t b) { return __uint_as_float(((unsigned)b) << 16); }
__device__ __forceinline__ float wave_sum(float v) {
#pragma unroll
    for (int o = 1; o < 64; o <<= 1) v += __shfl_xor(v, o);
    return v;
}
__device__ __forceinline__ float sigmoidf_(float x) { return 1.0f / (1.0f + __expf(-x)); }
__device__ __forceinline__ float tanhf_(float x) { float e = __expf(-2.0f * fabsf(x)); float t = (1.0f - e) / (1.0f + e); return x < 0.f ? -t : t; }

namespace pg8 {
constexpr int BM = 256, BK = 64, HALF = 128, HTB = HALF * BK * 2, STAGE_BYTES = 8 * HTB, NXCD = 8, WGM = 8;
__host__ __device__ __forceinline__ int lds_byte(int r, int c) { const int st = (r >> 4) * 2 + (c >> 5), rr = r & 15, cc = c & 31, ob = rr * 64 + cc * 2; return st * 1024 + (ob ^ (((ob >> 9) & 1) << 5)); }
__host__ __device__ __forceinline__ void stage_rc(int b, int& R, int& C) { const int st = b / 1024, sb = b % 1024, swz = sb ^ (((sb >> 9) & 1) << 5); R = (st >> 1) * 16 + swz / 64; C = (st & 1) * 32 + (swz % 64) / 2; }
__host__ __device__ __forceinline__ int perm32(int rho) { const int n = rho >> 4, i = rho & 15; return 8 * (i >> 2) + 4 * n + (i & 3); }
struct Unit { int pm, pn; };
struct Gemm { const bf16_t* A; const bf16_t* Bt; int M, N, K, lda, ldb, amode; };
struct StaticOrder {
    int nM, nN, nwg, G, c;
    __device__ void init(int M_, int N_, int G_, int c_) { nM = M_ / BM; nN = N_ / BM; nwg = nM * nN; G = G_; c = c_; }
    __device__ bool next(int i, Unit& u) const {
        const long L = (long)i * G + c; if (L >= nwg) return false;
        int wgid = (int)L; { const int q = nwg / NXCD, r = nwg % NXCD, xcd = wgid % NXCD, off = wgid / NXCD; wgid = (xcd < r ? xcd * (q + 1) : r * (q + 1) + (xcd - r) * q) + off; }
        const int nig = WGM * nN, gid = wgid / nig, fm = gid * WGM, gsz = (nM - fm) < WGM ? (nM - fm) : WGM;
        u.pm = fm + ((wgid % nig) % gsz); u.pn = (wgid % nig) / gsz; return true;
    }
};
__device__ __forceinline__ const char* a_base(const Gemm& g, int pm) { const size_t row = (size_t)pm * BM + (g.amode == 1 ? (size_t)(pm / 64) : 0); return (const char*)g.A + row * (size_t)g.lda * 2; }

template <class Epi, bool ALIGN_EPI>
__device__ __forceinline__ void gemm_phase(LAS unsigned char* lds, const Gemm g, const StaticOrder& S, const Epi& E, int tid_in) {
    int tid = tid_in; asm volatile("" : "+v"(tid));
    const int wid = __builtin_amdgcn_readfirstlane(tid >> 6), lane = tid & 63, wr = wid >> 2, wc = wid & 3, fr = lane & 15, fq = lane >> 4;
    int K = g.K; asm volatile("" : "+s"(K));
    const int nt = K / BK;
    unsigned voffA[2], voffB[2];
#pragma unroll
    for (int i = 0; i < 2; ++i) { int R, C; stage_rc(tid * 16 + i * 8192, R, C); const int Rb = Epi::PERM ? ((R & ~31) + perm32(R & 31)) : R;
        voffA[i] = (unsigned)(R * g.lda + C) * 2u; voffB[i] = (unsigned)(Rb * g.ldb + C) * 2u; }
    const size_t kstep = (size_t)(BK * 2);
    const size_t hstepA = (size_t)HALF * g.lda * 2, hstepB = (size_t)HALF * g.ldb * 2;
    const size_t tstepB = 2 * hstepB;
    const unsigned ldsw = (unsigned)wid * 1024u;
    const int aoff = lds_byte(wr * 64 + fr, fq * 8), boff = lds_byte(wc * 32 + fr, fq * 8);
#define PG8_SA(b, h) (((b) * 2 + (h)) * HTB)
#define PG8_SB(b, h) ((4 + (b) * 2 + (h)) * HTB)
#define PG8_STAGE(bufoff, gbase, voff) do { _Pragma("unroll") for (int _i = 0; _i < 2; ++_i) \
        __builtin_amdgcn_global_load_lds((const unsigned*)((const char*)(gbase) + (voff)[_i]), (LAS unsigned*)(lds + (bufoff) + ldsw + _i * 8192), 16, 0, 0); } while (0)
#define PG8_LDA(dst, b, h) do { _Pragma("unroll") for (int m = 0; m < 4; ++m) _Pragma("unroll") for (int k = 0; k < 2; ++k) dst[m][k] = *(const LAS bf16x8*)(lds + PG8_SA(b, h) + aoff + m * 2048 + k * 1024); } while (0)
#define PG8_LDB(dst, b, h) do { _Pragma("unroll") for (int n = 0; n < 2; ++n) _Pragma("unroll") for (int k = 0; k < 2; ++k) dst[n][k] = *(const LAS bf16x8*)(lds + PG8_SB(b, h) + boff + n * 2048 + k * 1024); } while (0)
#define PG8_MMA(ai, bj, At, Bt) do { __builtin_amdgcn_s_setprio(1); _Pragma("unroll") for (int m = 0; m < 4; ++m) _Pragma("unroll") for (int n = 0; n < 2; ++n) _Pragma("unroll") for (int k = 0; k < 2; ++k) \
        acc[ai][bj][m][n] = __builtin_amdgcn_mfma_f32_16x16x32_bf16(Bt[n][k], At[m][k], acc[ai][bj][m][n], 0, 0, 0); __builtin_amdgcn_s_setprio(0); } while (0)
#define PG8_WAIT_V(n) asm volatile("s_waitcnt vmcnt(" #n ")" ::: "memory")
#define PG8_WAIT_L(n) asm volatile("s_waitcnt lgkmcnt(" #n ")" ::: "memory")
#define PG8_BAR __builtin_amdgcn_s_barrier()
#define PG8_SCHED __builtin_amdgcn_sched_barrier(0)
    Unit cur, nxt; int ui = 0;
    if (!S.next(0, cur)) return;
    f32x4 acc[2][2][4][2];
#pragma unroll
    for (int a = 0; a < 2; ++a)
#pragma unroll
        for (int b = 0; b < 2; ++b)
#pragma unroll
            for (int m = 0; m < 4; ++m)
#pragma unroll
                for (int n = 0; n < 2; ++n) acc[a][b][m][n] = (f32x4){0.f, 0.f, 0.f, 0.f};
    bf16x8 At[4][2], B0[2][2], B1[2][2];
    const char* cA = a_base(g, cur.pm); const char* cB = (const char*)g.Bt + (size_t)cur.pn * tstepB;
    PG8_STAGE(PG8_SB(0, 0), cB, voffB); PG8_STAGE(PG8_SB(0, 1), cB + hstepB, voffB); PG8_STAGE(PG8_SA(0, 0), cA, voffA); PG8_STAGE(PG8_SA(0, 1), cA + hstepA, voffA);
    if (wr == 1) PG8_BAR;
    PG8_WAIT_V(2); PG8_BAR;
    PG8_STAGE(PG8_SB(1, 0), cB + kstep, voffB); PG8_STAGE(PG8_SA(1, 0), cA + kstep, voffA); PG8_STAGE(PG8_SB(1, 1), cB + hstepB + kstep, voffB);
    PG8_WAIT_V(6); PG8_BAR;
    for (;;) {
        const bool has_next = S.next(ui + 1, nxt);
        const char* nA = has_next ? a_base(g, nxt.pm) : cA; const char* nB = has_next ? (const char*)g.Bt + (size_t)nxt.pn * tstepB : cB;
        for (int t = 0; t < nt; t += 2) {
            const bool last = (t == nt - 2);
            const char* a1 = cA + (size_t)(t + 1) * kstep;
            const char* a2 = last ? nA : cA + (size_t)(t + 2) * kstep; const char* b2 = last ? nB : cB + (size_t)(t + 2) * kstep;
            const char* a3 = a2 + kstep; const char* b3 = b2 + kstep;
            PG8_LDB(B0, 0, 0); PG8_LDB(B1, 0, 1); PG8_SCHED; PG8_LDA(At, 0, 0); PG8_STAGE(PG8_SA(1, 1), a1 + hstepA, voffA);
            PG8_WAIT_V(8); PG8_WAIT_L(0); PG8_BAR; PG8_MMA(0, 0, At, B0); PG8_MMA(0, 1, At, B1); PG8_BAR; PG8_SCHED;
            PG8_LDA(At, 0, 1); PG8_STAGE(PG8_SB(0, 0), b2, voffB); PG8_STAGE(PG8_SB(0, 1), b2 + hstepB, voffB); PG8_STAGE(PG8_SA(0, 0), a2, voffA);
            PG8_WAIT_V(8); PG8_WAIT_L(0); PG8_BAR; PG8_MMA(1, 0, At, B0); PG8_MMA(1, 1, At, B1); PG8_BAR; PG8_SCHED;
            PG8_LDB(B0, 1, 0); PG8_LDB(B1, 1, 1); PG8_SCHED; PG8_LDA(At, 1, 0); PG8_STAGE(PG8_SA(0, 1), a2 + hstepA, voffA);
            PG8_WAIT_V(8); PG8_WAIT_L(0); PG8_BAR; PG8_MMA(0, 0, At, B0); PG8_MMA(0, 1, At, B1); PG8_BAR; PG8_SCHED;
            PG8_LDA(At, 1, 1); PG8_STAGE(PG8_SB(1, 0), b3, voffB); PG8_STAGE(PG8_SB(1, 1), b3 + hstepB, voffB); PG8_STAGE(PG8_SA(1, 0), a3, voffA);
            PG8_WAIT_V(8); PG8_WAIT_L(0); PG8_BAR; PG8_MMA(1, 0, At, B0); PG8_MMA(1, 1, At, B1); PG8_BAR; PG8_SCHED;
        }
        if constexpr (ALIGN_EPI) { if (wr == 0) PG8_BAR; }
        E(acc, cur, wr, wc, fr, fq);
        if (!has_next) break;
#pragma unroll
        for (int a = 0; a < 2; ++a)
#pragma unroll
            for (int b = 0; b < 2; ++b)
#pragma unroll
                for (int m = 0; m < 4; ++m)
#pragma unroll
                    for (int n = 0; n < 2; ++n) acc[a][b][m][n] = (f32x4){0.f, 0.f, 0.f, 0.f};
        cur = nxt; cA = nA; cB = nB; ++ui;
        if constexpr (ALIGN_EPI) { if (wr == 1) PG8_BAR; }
    }
    PG8_WAIT_V(0);
    if constexpr (!ALIGN_EPI) { if (wr == 0) PG8_BAR; }
    PG8_BAR;
#undef PG8_SA
#undef PG8_SB
#undef PG8_STAGE
#undef PG8_LDA
#undef PG8_LDB
#undef PG8_MMA
#undef PG8_WAIT_V
#undef PG8_WAIT_L
#undef PG8_BAR
#undef PG8_SCHED
}
template <class F> struct EpiP {
    static constexpr bool PERM = true; F f;
    __device__ __forceinline__ void operator()(const f32x4 (&acc)[2][2][4][2], const Unit& u, int wr, int wc, int fr, int fq) const {
#pragma unroll
        for (int ai = 0; ai < 2; ++ai)
#pragma unroll
            for (int m = 0; m < 4; ++m) { int row = u.pm * BM + ai * HALF + wr * 64 + m * 16 + fr; asm volatile("" : "+v"(row));
#pragma unroll
                for (int bj = 0; bj < 2; ++bj) { const int col0 = u.pn * BM + bj * HALF + wc * 32 + 8 * fq; f(row, col0, acc[ai][bj][m][0], acc[ai][bj][m][1]); } asm volatile("" ::: "memory"); }
    }
};
template <class F> struct EpiN {
    static constexpr bool PERM = false; F f;
    __device__ __forceinline__ void operator()(const f32x4 (&acc)[2][2][4][2], const Unit& u, int wr, int wc, int fr, int fq) const {
#pragma unroll
        for (int ai = 0; ai < 2; ++ai)
#pragma unroll
            for (int m = 0; m < 4; ++m) { int row = u.pm * BM + ai * HALF + wr * 64 + m * 16 + fr; asm volatile("" : "+v"(row));
#pragma unroll
                for (int bj = 0; bj < 2; ++bj)
#pragma unroll
                    for (int n = 0; n < 2; ++n) { const int col0 = u.pn * BM + bj * HALF + wc * 32 + 16 * n + 4 * fq; f(row, col0, acc[ai][bj][m][n]); } asm volatile("" ::: "memory"); }
    }
};
}

struct Params {
    const float* in[33];
    float* out;
    unsigned char* ws;
};

struct TJob { const float* W; int ldw, n0src, Nsrc, Ksrc; bf16_t* WT; int ldt, row_off, col_off, Npad, Kpad; const float* mix; int mode; };
__device__ __forceinline__ void transpose_job(const TJob& j, LAS float* scr, int gw, int NGW, int lane_) {
    int lane = lane_; asm volatile("" : "+v"(lane));
    const int nblk = j.Npad / 32, kblk = j.Kpad / 64, items = nblk * kblk;
    for (int it = gw; it < items; it += NGW) {
        const int kb = it / nblk, nb = it % nblk, k0 = 64 * kb, n0 = 32 * nb;
#pragma unroll 4
        for (int i = 0; i < 32; ++i) { const int kk = 2 * i + (lane >> 5), n = lane & 31; float v = 0.f;
            if (k0 + kk < j.Ksrc && n0 + n < j.Nsrc) { v = j.W[(size_t)(k0 + kk) * j.ldw + j.n0src + n0 + n];
                if (j.mode == 1) v *= j.mix[k0 + kk]; else if (j.mode == 2) v *= (1.0f - j.mix[k0 + kk]); }
            scr[kk * 33 + n] = v; }
        asm volatile("s_waitcnt lgkmcnt(0)" ::: "memory");
        const int c = lane & 7;
#pragma unroll
        for (int jj = 0; jj < 4; ++jj) { const int n = (lane >> 3) + 8 * jj; const LAS float* s = scr + (8 * c) * 33 + n;
            u32x4 o; o.x = cvt_pk_bf16(s[0 * 33], s[1 * 33]); o.y = cvt_pk_bf16(s[2 * 33], s[3 * 33]); o.z = cvt_pk_bf16(s[4 * 33], s[5 * 33]); o.w = cvt_pk_bf16(s[6 * 33], s[7 * 33]);
            *(u32x4*)(j.WT + (size_t)(j.row_off + n0 + n) * j.ldt + j.col_off + k0 + 8 * c) = o; }
        asm volatile("s_waitcnt lgkmcnt(0)" ::: "memory");
    }
}

__device__ __forceinline__ void rms_row_bf16(const float* xrow, const float* g, bf16_t* orow, float* copy_to, int lane_) {
    int lane = lane_; asm volatile("" : "+v"(lane));
    const f32x4* xr = (const f32x4*)xrow + lane; const f32x4* gr = (const f32x4*)g + lane;
    f32x4 v[4]; float s = 0.f;
#pragma unroll
    for (int j = 0; j < 4; ++j) { v[j] = xr[64 * j]; s += (v[j].x * v[j].x + v[j].y * v[j].y) + (v[j].z * v[j].z + v[j].w * v[j].w); }
    if (copy_to) {
#pragma unroll
        for (int j = 0; j < 4; ++j) ((f32x4*)copy_to + lane)[64 * j] = v[j];
    }
    const float r = rsqrtf(wave_sum(s) * (1.f / D) + 1e-5f);
    u32x2* o8 = (u32x2*)orow + lane;
#pragma unroll
    for (int j = 0; j < 4; ++j) { const f32x4 gg = gr[64 * j]; u32x2 w; w.x = cvt_pk_bf16(v[j].x * r * gg.x, v[j].y * r * gg.y); w.y = cvt_pk_bf16(v[j].z * r * gg.z, v[j].w * r * gg.w); o8[64 * j] = w; }
}

struct FRelu2 { bf16_t* O; __device__ __forceinline__ void operator()(int row, int col0, f32x4 a, f32x4 b) const {
    f32x4 x = a, y = b;
#pragma unroll
    for (int i = 0; i < 4; ++i) { float t = fmaxf(x[i], 0.f); x[i] = t * t; t = fmaxf(y[i], 0.f); y[i] = t * t; }
    u32x4 w; w.x = cvt_pk_bf16(x[0], x[1]); w.y = cvt_pk_bf16(x[2], x[3]); w.z = cvt_pk_bf16(y[0], y[1]); w.w = cvt_pk_bf16(y[2], y[3]);
    *(u32x4*)(O + (size_t)row * FF + col0) = w; } };
struct FResAdd { float* X; __device__ __forceinline__ void operator()(int row, int col0, f32x4 a) const {
    f32x4* p = (f32x4*)(X + (size_t)row * D + col0); *p = *p + a; } };


struct FRwIn { h16* R; h16* Kk; h16* V; bf16_t* LH;
    __device__ __forceinline__ void operator()(int row, int col0, f32x4 a, f32x4 b) const {
        const int seg = __builtin_amdgcn_readfirstlane(col0 >> 10);
        if (seg < 3) { const long dK = (const char*)Kk - (const char*)R, dV = (const char*)V - (const char*)R; const long off = (seg == 1 ? dK : 0l) + (seg == 2 ? dV : 0l); h16* dst = (h16*)((char*)R + off); const int c = col0 & 1023;
            u32x4 w; w.x = pk_h16(a[0], a[1]); w.y = pk_h16(a[2], a[3]); w.z = pk_h16(b[0], b[1]); w.w = pk_h16(b[2], b[3]);
            *(u32x4*)(dst + (size_t)row * D + c) = w; }
        else { const int c = col0 - 3072; f32x4 x = a, y = b;
            if (c < 128) {
#pragma unroll
                for (int i = 0; i < 4; ++i) { x[i] = tanhf_(x[i]); y[i] = tanhf_(y[i]); } }
            else if (c >= 256 && c < 512) {
#pragma unroll
                for (int i = 0; i < 4; ++i) { x[i] = sigmoidf_(x[i]); y[i] = sigmoidf_(y[i]); } }
            u32x4 w; w.x = cvt_pk_bf16(x[0], x[1]); w.y = cvt_pk_bf16(x[2], x[3]); w.z = cvt_pk_bf16(y[0], y[1]); w.w = cvt_pk_bf16(y[2], y[3]);
            *(u32x4*)(LH + (size_t)row * 768 + c) = w; }
    } };
struct FLoraW { h16* EW; const float* w0;
    __device__ __forceinline__ void operator()(int row, int col0, f32x4 a, f32x4 b) const {
        const f32x4 p = *(const f32x4*)(w0 + col0), q = *(const f32x4*)(w0 + col0 + 4); float o[8];
#pragma unroll
        for (int i = 0; i < 4; ++i) { o[i] = 0.60653066f * sigmoidf_(p[i] + a[i]); o[4 + i] = 0.60653066f * sigmoidf_(q[i] + b[i]); }
        u32x4 w; w.x = pk_h16(o[0], o[1]); w.y = pk_h16(o[2], o[3]); w.z = pk_h16(o[4], o[5]); w.w = pk_h16(o[6], o[7]);
        *(u32x4*)(EW + (size_t)row * D + col0) = w; } };
struct FLoraA { h16* Aa; const float* a0;
    __device__ __forceinline__ void operator()(int row, int col0, f32x4 a, f32x4 b) const {
        const f32x4 p = *(const f32x4*)(a0 + col0), q = *(const f32x4*)(a0 + col0 + 4); float o[8];
#pragma unroll
        for (int i = 0; i < 4; ++i) { o[i] = sigmoidf_(p[i] + a[i]); o[4 + i] = sigmoidf_(q[i] + b[i]); }
        u32x4 w; w.x = pk_h16(o[0], o[1]); w.y = pk_h16(o[2], o[3]); w.z = pk_h16(o[4], o[5]); w.w = pk_h16(o[6], o[7]);
        *(u32x4*)(Aa + (size_t)row * D + col0) = w; } };
struct FLoraV { h16* V; const h16* VFm; const float* v0;
    __device__ __forceinline__ void operator()(int row, int col0, f32x4 a, f32x4 b) const {
        const f32x4 p = *(const f32x4*)(v0 + col0), q = *(const f32x4*)(v0 + col0 + 4);
        typedef h16 h16x8 __attribute__((ext_vector_type(8)));
        const h16x8 vv = *(const h16x8*)(V + (size_t)row * D + col0), vf = *(const h16x8*)(VFm + (size_t)row * D + col0); float o[8];
#pragma unroll
        for (int i = 0; i < 4; ++i) { float v = (float)vv[i], f = (float)vf[i]; o[i] = v + (f - v) * sigmoidf_(p[i] + a[i]); v = (float)vv[4 + i]; f = (float)vf[4 + i]; o[4 + i] = v + (f - v) * sigmoidf_(q[i] + b[i]); }
        u32x4 w; w.x = pk_h16(o[0], o[1]); w.y = pk_h16(o[2], o[3]); w.z = pk_h16(o[4], o[5]); w.w = pk_h16(o[6], o[7]);
        *(u32x4*)(V + (size_t)row * D + col0) = w; } };
struct FGate { bf16_t* O; const h16* Y;
    __device__ __forceinline__ void operator()(int row, int col0, f32x4 a, f32x4 b) const {
        typedef h16 h16x8 __attribute__((ext_vector_type(8)));
        const h16x8 yy = *(const h16x8*)(Y + (size_t)row * D + col0);
        u32x4 w; w.x = cvt_pk_bf16(a[0] * (float)yy[0], a[1] * (float)yy[1]); w.y = cvt_pk_bf16(a[2] * (float)yy[2], a[3] * (float)yy[3]);
        w.z = cvt_pk_bf16(b[0] * (float)yy[4], b[1] * (float)yy[5]); w.w = cvt_pk_bf16(b[2] * (float)yy[6], b[3] * (float)yy[7]);
        *(u32x4*)(O + (size_t)row * D + col0) = w; } };

template <int CTRL> __device__ __forceinline__ float dppmov(float v) { return __builtin_bit_cast(float, __builtin_amdgcn_update_dpp(0, __builtin_bit_cast(int, v), CTRL, 0xF, 0xF, true)); }
__device__ __forceinline__ float row16_sum(float v) { v += dppmov<0xB1>(v); v += dppmov<0x4E>(v); v += dppmov<0x124>(v); v += dppmov<0x128>(v); return v; }
typedef _Float16 h16x4 __attribute__((ext_vector_type(4)));
__device__ __forceinline__ void h4_to_f(h16x4 u, float* f) { f[0] = (float)u[0]; f[1] = (float)u[1]; f[2] = (float)u[2]; f[3] = (float)u[3]; }
__device__ __forceinline__ void rwkv_scan(const h16* R, const h16* Kk, const h16* V, const h16* EW, const h16* Aa, const float* k_k, const float* k_a, h16* Yraw, int G, int wave, int lane_) {
    int lane = lane_; asm volatile("" : "+v"(lane));
    const int NT = G * NWAVES;
    for (int task = wave * G + (int)blockIdx.x; task < 512; task += NT) {
        const int bh = task >> 4, rg = task & 15, b = bh >> 4, h = bh & 15;
        const int row = lane >> 4, jg = lane & 15, i = rg * 4 + row;
        const int colj = h * 64 + 4 * jg, coli = h * 64 + i;
        float kkc[4], kac[4];
#pragma unroll
        for (int j = 0; j < 4; ++j) { kkc[j] = k_k[colj + j]; kac[j] = k_a[colj + j]; }
        float s[4] = {0.f, 0.f, 0.f, 0.f};
        const size_t base = (size_t)b * S * D;
        const h16* pR = R + base + colj; const h16* pK = Kk + base + colj; const h16* pA = Aa + base + colj; const h16* pE = EW + base + colj; const h16* pV = V + base + coli;
        h16* pY = Yraw + ((size_t)task * S) * 4 + row;
        constexpr int TC = 4;
        h16x4 cr[TC], ck[TC], ca[TC], ce[TC]; h16 cv[TC];
#pragma unroll
        for (int u = 0; u < TC; ++u) { const size_t o = (size_t)u * D; cr[u] = *(const h16x4*)(pR + o); ck[u] = *(const h16x4*)(pK + o); ca[u] = *(const h16x4*)(pA + o); ce[u] = *(const h16x4*)(pE + o); cv[u] = pV[o]; }
        for (int t0 = 0; t0 < S; t0 += TC) {
            const int tn = (t0 + TC < S) ? t0 + TC : t0;
            h16x4 nr[TC], nk[TC], na[TC], ne[TC]; h16 nv[TC];
#pragma unroll
            for (int u = 0; u < TC; ++u) { const size_t o = (size_t)(tn + u) * D; nr[u] = *(const h16x4*)(pR + o); nk[u] = *(const h16x4*)(pK + o); na[u] = *(const h16x4*)(pA + o); ne[u] = *(const h16x4*)(pE + o); nv[u] = pV[o]; }
#pragma unroll
            for (int u = 0; u < TC; ++u) {
                float rv[4], kv[4], av[4], ev[4]; h4_to_f(cr[u], rv); h4_to_f(ck[u], kv); h4_to_f(ca[u], av); h4_to_f(ce[u], ev);
                const float vi = (float)cv[u];
                float kq[4], n2 = 0.f;
#pragma unroll
                for (int j = 0; j < 4; ++j) { kq[j] = kv[j] * kkc[j]; n2 += kq[j] * kq[j]; }
                n2 = row16_sum(n2);
                const float inv = 1.0f / fmaxf(sqrtf(n2), 1e-12f);
                float kkj[4], kt[4], bb[4], w[4], dot = 0.f;
#pragma unroll
                for (int j = 0; j < 4; ++j) { kkj[j] = kq[j] * inv; kt[j] = kv[j] * (1.0f + (av[j] - 1.0f) * kac[j]); bb[j] = kkj[j] * av[j]; w[j] = __expf(-ev[j]); dot += s[j] * kkj[j]; }
                const float sa = -row16_sum(dot);
                float yd = 0.f;
#pragma unroll
                for (int j = 0; j < 4; ++j) { s[j] = s[j] * w[j] + (sa * bb[j] + vi * kt[j]); yd += s[j] * rv[j]; }
                const float y = row16_sum(yd);
                if (jg == 0) pY[(size_t)(t0 + u) * 4] = (h16)y;
            }
#pragma unroll
            for (int u = 0; u < TC; ++u) { cr[u] = nr[u]; ck[u] = nk[u]; ca[u] = na[u]; ce[u] = ne[u]; cv[u] = nv[u]; }
        }
    }
}
constexpr int SC_CS = 32, SC_STEP_F = 5 * 64 + 8, SC_BUF_F = SC_CS * SC_STEP_F;
#define SC_BAR() do { asm volatile("s_waitcnt lgkmcnt(0)" ::: "memory"); __builtin_amdgcn_s_barrier(); asm volatile("" ::: "memory"); } while (0)
__device__ __forceinline__ float wave_sum_dpp(float v) {
    v = row16_sum(v);
    const float a = __builtin_bit_cast(float, __builtin_amdgcn_readlane(__builtin_bit_cast(int, v), 0)), b = __builtin_bit_cast(float, __builtin_amdgcn_readlane(__builtin_bit_cast(int, v), 16));
    const float c = __builtin_bit_cast(float, __builtin_amdgcn_readlane(__builtin_bit_cast(int, v), 32)), d = __builtin_bit_cast(float, __builtin_amdgcn_readlane(__builtin_bit_cast(int, v), 48));
    return (a + b) + (c + d);
}
struct ScRegs { h16 k[8], a[8], e[8], r[8], v[8]; };
__device__ __forceinline__ void sc_load(ScRegs& g, const h16* R, const h16* Kk, const h16* V, const h16* EW, const h16* Aa, size_t base, int c, int pw, int sub, int lane) {
#pragma unroll
    for (int q = 0; q < 8; ++q) { const size_t o = base + (size_t)(c * SC_CS + pw + 4 * q) * D;
        g.k[q] = Kk[o + lane]; g.a[q] = Aa[o + lane]; g.e[q] = EW[o + lane]; g.r[q] = R[o + lane]; g.v[q] = V[o + sub * 8 + (lane & 7)]; }
}
__device__ __forceinline__ void sc_compute(const ScRegs& g, LAS float* sb, int pw, float kkc, float kac, int lane) {
#pragma unroll
    for (int q = 0; q < 8; ++q) {
        const float kv = (float)g.k[q], av = (float)g.a[q], ev = (float)g.e[q], rv = (float)g.r[q]; const float kq = kv * kkc;
        const float n2 = wave_sum_dpp(kq * kq);
        const float kkj = kq * rsqrtf(fmaxf(n2, 1e-24f)); LAS float* p = sb + (pw + 4 * q) * SC_STEP_F;
        p[lane] = kkj; p[64 + lane] = kkj * av; p[128 + lane] = kv * (1.0f + (av - 1.0f) * kac); p[192 + lane] = __expf(-ev); p[256 + lane] = rv; if (lane < 8) p[320 + lane] = (float)g.v[q];
    }
}
__device__ __forceinline__ void rwkv_scan2(const h16* R, const h16* Kk, const h16* V, const h16* EW, const h16* Aa, const float* k_k, const float* k_a, h16* Yraw, LAS unsigned char* lds, int wave, int lane_) {
    int lane = lane_; asm volatile("" : "+v"(lane));
    LAS float* buf = (LAS float*)lds;
    constexpr int NCH = S / SC_CS;
#pragma unroll 1
    for (int vb = (int)blockIdx.x; vb < 256; vb += (int)gridDim.x) {
        const int bh = vb >> 3, sub = vb & 7, b = bh >> 4, h = bh & 15;
        const size_t base = (size_t)b * S * D + h * 64;
        if (wave >= 4) {
            const int pw = wave - 4;
            const float kkc = k_k[h * 64 + lane], kac = k_a[h * 64 + lane];
            ScRegs ga, gb;
            sc_load(ga, R, Kk, V, EW, Aa, base, 0, pw, sub, lane);
            sc_load(gb, R, Kk, V, EW, Aa, base, 1, pw, sub, lane);
            sc_compute(ga, buf, pw, kkc, kac, lane);
            SC_BAR();
#pragma unroll 1
            for (int c = 0; c < NCH; c += 2) {
                { const int c2 = (c + 2 < NCH) ? c + 2 : c; sc_load(ga, R, Kk, V, EW, Aa, base, c2, pw, sub, lane); }
                sc_compute(gb, buf + SC_BUF_F, pw, kkc, kac, lane);
                SC_BAR();
                { const int c3 = (c + 3 < NCH) ? c + 3 : c + 1; sc_load(gb, R, Kk, V, EW, Aa, base, c3, pw, sub, lane); }
                if (c + 2 < NCH) sc_compute(ga, buf, pw, kkc, kac, lane);
                SC_BAR();
            }
            SC_BAR();
        } else if (wave < 2) {
            const int jg = lane & 15, cw = wave;
            float s0 = 0.f, s1 = 0.f, s2 = 0.f, s3 = 0.f;
            SC_BAR();
#pragma unroll 1
            for (int c = 0; c < NCH; ++c) {
                const LAS float* sb = buf + (c & 1) * SC_BUF_F + 4 * jg;
                const LAS float* vb_ = buf + (c & 1) * SC_BUF_F + 320 + cw * 4 + (lane >> 4);
                LAS float* yp = buf + 2 * SC_BUF_F + ((c & 1) * 2 + cw) * (SC_CS * 64) + lane;
                f32x4 kk4 = *(const LAS f32x4*)(sb), bb4 = *(const LAS f32x4*)(sb + 64), kt4 = *(const LAS f32x4*)(sb + 128), w4 = *(const LAS f32x4*)(sb + 192), r4 = *(const LAS f32x4*)(sb + 256); float vi = vb_[0];
#pragma unroll 4
                for (int st = 0; st < SC_CS; ++st) {
                    const int sn = (st + 1 < SC_CS) ? st + 1 : st;
                    const f32x4 nkk = *(const LAS f32x4*)(sb + sn * SC_STEP_F), nbb = *(const LAS f32x4*)(sb + sn * SC_STEP_F + 64), nkt = *(const LAS f32x4*)(sb + sn * SC_STEP_F + 128), nw = *(const LAS f32x4*)(sb + sn * SC_STEP_F + 192), nr4 = *(const LAS f32x4*)(sb + sn * SC_STEP_F + 256);
                    const float nvi = vb_[sn * SC_STEP_F];
                    const float sa = -row16_sum((s0 * kk4[0] + s1 * kk4[1]) + (s2 * kk4[2] + s3 * kk4[3]));
                    s0 = s0 * w4[0] + (sa * bb4[0] + vi * kt4[0]); s1 = s1 * w4[1] + (sa * bb4[1] + vi * kt4[1]);
                    s2 = s2 * w4[2] + (sa * bb4[2] + vi * kt4[2]); s3 = s3 * w4[3] + (sa * bb4[3] + vi * kt4[3]);
                    yp[st * 64] = (s0 * r4[0] + s1 * r4[1]) + (s2 * r4[2] + s3 * r4[3]);
                    kk4 = nkk; bb4 = nbb; kt4 = nkt; w4 = nw; r4 = nr4; vi = nvi;
                }
                SC_BAR();
            }
            SC_BAR();
        } else {
            const int cw = wave - 2;
            h16* pY = Yraw + ((size_t)(bh * 16 + sub * 2 + cw) * S) * 4;
            SC_BAR();
#pragma unroll 1
            for (int c = 0; c <= NCH; ++c) {
                if (c > 0) {
                    const LAS float* yp = buf + 2 * SC_BUF_F + (((c - 1) & 1) * 2 + cw) * (SC_CS * 64);
                    const int st = lane >> 1, r0 = 2 * (lane & 1);
                    float a0 = 0.f, a1 = 0.f;
#pragma unroll
                    for (int q = 0; q < 4; ++q) { const f32x4 x = *(const LAS f32x4*)(yp + st * 64 + r0 * 16 + 4 * q), z = *(const LAS f32x4*)(yp + st * 64 + (r0 + 1) * 16 + 4 * q);
                        a0 += (x[0] + x[1]) + (x[2] + x[3]); a1 += (z[0] + z[1]) + (z[2] + z[3]); }
                    *(unsigned*)(pY + (size_t)((c - 1) * SC_CS + st) * 4 + r0) = pk_h16(a0, a1);
                }
                SC_BAR();
            }
        }
        if (false) {
            SC_BAR();
#pragma unroll 1
            for (int c = 0; c < NCH; ++c) SC_BAR();
        }
    }
}
__device__ __forceinline__ void rwkv_gn(h16* R, const h16* Kk, const h16* V, const h16* Aa, const h16* Yraw, const float* k_a, const float* r_k, const float* ln_w, const float* ln_b, int gw, int NGW, int lane_) {
    int lane = lane_; asm volatile("" : "+v"(lane));
#pragma unroll 2
    for (int idx = gw; idx < M * 16; idx += NGW) {
        const int m = idx >> 4, h = idx & 15, col = h * 64 + lane; const size_t o = (size_t)m * D + col;
        const int bq = m / S, tq = m - bq * S;
        const float y = (float)Yraw[((size_t)((bq * 16 + h) * 16 + (lane >> 2)) * S + tq) * 4 + (lane & 3)], r = (float)R[o], k = (float)Kk[o], a = (float)Aa[o], v = (float)V[o];
        const float kt = k * (1.0f + (a - 1.0f) * k_a[col]);
        const float mu = wave_sum_dpp(y) * (1.f / 64.f); const float d = y - mu; const float var = wave_sum_dpp(d * d) * (1.f / 64.f);
        const float bs = wave_sum_dpp(r * kt * r_k[col]);
        const float yn = d * rsqrtf(var + 64e-5f) * ln_w[col] + ln_b[col];
        R[o] = (h16)(yn + bs * v);
    }
}

constexpr size_t KF_STRIDE = (size_t)NB * 4 * S * 64;
__device__ __forceinline__ float gelu_tanh(float x) { const float u = 0.7978845608f * (x + 0.044715f * x * x * x); return 0.5f * x * (1.0f + tanhf_(u)); }
__device__ __forceinline__ void store_vf8(bf16_t* chunk_base_d, int keyp0  , f32x4 a, f32x4 b) {
    const int tile = keyp0 >> 4, rq0 = (keyp0 & 15) >> 2;
    u32x2 w0, w1; w0.x = cvt_pk_bf16(a[0], a[1]); w0.y = cvt_pk_bf16(a[2], a[3]); w1.x = cvt_pk_bf16(b[0], b[1]); w1.y = cvt_pk_bf16(b[2], b[3]);
    *(u32x2*)(chunk_base_d + 8 * rq0 + 4 * tile) = w0; *(u32x2*)(chunk_base_d + 8 * (rq0 + 1) + 4 * tile) = w1;
}
struct FNsaIn { bf16_t* Q; bf16_t* KF; float* gates; const float* rope;
    __device__ __forceinline__ void operator()(int row, int col0, f32x4 a, f32x4 b) const {
        const int tile = __builtin_amdgcn_readfirstlane(col0 >> 8);
        const int bb = row / S, t = row - bb * S;
        if (tile < 7) {
            f32x4 x = a, y = b;
            if ((col0 & 32) == 0) {
                f32x4 px, py;
#pragma unroll
                for (int i = 0; i < 4; ++i) { px[i] = __shfl_xor(x[i], 16); py[i] = __shfl_xor(y[i], 16); }
                const int d0 = col0 & 63;
                if (d0 < 16) { const f32x4 c0 = *(const f32x4*)(rope + t * 16), c1 = *(const f32x4*)(rope + t * 16 + 4), s0 = *(const f32x4*)(rope + t * 16 + 8), s1 = *(const f32x4*)(rope + t * 16 + 12);
                    if (d0 == 0) { x = x * c0 - px * s0; y = y * c1 - py * s1; } else { x = x * c0 + px * s0; y = y * c1 + py * s1; } }
            }
            if (tile < 4) { x = x * 0.18033688011112042f; y = y * 0.18033688011112042f;
                u32x4 w; w.x = cvt_pk_bf16(x[0], x[1]); w.y = cvt_pk_bf16(x[2], x[3]); w.z = cvt_pk_bf16(y[0], y[1]); w.w = cvt_pk_bf16(y[2], y[3]);
                *(u32x4*)(Q + (size_t)row * D + col0) = w; }
            else { const int idx = tile - 4, g = (col0 & 255) >> 6, d0 = col0 & 63;
                u32x4 w; w.x = cvt_pk_bf16(x[0], x[1]); w.y = cvt_pk_bf16(x[2], x[3]); w.z = cvt_pk_bf16(y[0], y[1]); w.w = cvt_pk_bf16(y[2], y[3]);
                *(u32x4*)(KF + (size_t)idx * KF_STRIDE + ((size_t)(bb * 4 + g) * S + t) * 64 + d0) = w; }
        } else if (tile == 7) { const int g = (col0 & 255) >> 6, d0 = col0 & 63;
            u32x4 w; w.x = cvt_pk_bf16(a[0], a[1]); w.y = cvt_pk_bf16(a[2], a[3]); w.z = cvt_pk_bf16(b[0], b[1]); w.w = cvt_pk_bf16(b[2], b[3]);
            *(u32x4*)(KF + (size_t)3 * KF_STRIDE + ((size_t)(bb * 4 + g) * S + t) * 64 + d0) = w;
        } else { const int c = col0 - 2048;
            if (c < 48) { f32x4 x, y;
#pragma unroll
                for (int i = 0; i < 4; ++i) { x[i] = sigmoidf_(a[i]); y[i] = sigmoidf_(b[i]); }
                *(f32x4*)(gates + (size_t)row * 48 + c) = x; *(f32x4*)(gates + (size_t)row * 48 + c + 4) = y; }
        }
    } };
struct FNsaVT { bf16_t* VF;
    __device__ __forceinline__ void operator()(int row, int col0, f32x4 a, f32x4 b) const {
        const int br = row >> 8, g = (row >> 6) & 3, d = row & 63, bb = col0 / S, t0 = col0 - bb * S;
        bf16_t* base = VF + (size_t)br * KF_STRIDE + (size_t)(bb * 4 + g) * S * 64 + (size_t)(t0 >> 5) * 2048 + d * 32;
        store_vf8(base, t0 & 31, a, b); } };
struct FCmp1 { bf16_t* CH; const float* bias;
    __device__ __forceinline__ void operator()(int row, int col0, f32x4 a, f32x4 b) const {
        const f32x4 p = *(const f32x4*)(bias + col0), q = *(const f32x4*)(bias + col0 + 4); float o[8];
#pragma unroll
        for (int i = 0; i < 4; ++i) { o[i] = gelu_tanh(a[i] + p[i]); o[4 + i] = gelu_tanh(b[i] + q[i]); }
        u32x4 w; w.x = cvt_pk_bf16(o[0], o[1]); w.y = cvt_pk_bf16(o[2], o[3]); w.z = cvt_pk_bf16(o[4], o[5]); w.w = cvt_pk_bf16(o[6], o[7]);
        *(u32x4*)(CH + (size_t)row * 256 + col0) = w; } };
struct FCmp2K { bf16_t* KC;
    __device__ __forceinline__ void operator()(int row, int col0, f32x4 a, f32x4 b) const {
        if (col0 < 64) { u32x4 w; w.x = cvt_pk_bf16(a[0], a[1]); w.y = cvt_pk_bf16(a[2], a[3]); w.z = cvt_pk_bf16(b[0], b[1]); w.w = cvt_pk_bf16(b[2], b[3]);
            *(u32x4*)(KC + (size_t)row * 64 + col0) = w; } } };
struct FCmp2VT { bf16_t* VC;
    __device__ __forceinline__ void operator()(int row, int col0, f32x4 a, f32x4 b) const {
        if (row < 64) { const int bg = col0 >> 10, n0 = col0 & 1023;
            bf16_t* base = VC + (size_t)bg * 65536 + (size_t)(n0 >> 5) * 2048 + row * 32; store_vf8(base, n0 & 31, a, b); } } };

__device__ __forceinline__ f32x4 mfma16(bf16x8 a, bf16x8 b, f32x4 c) { return __builtin_amdgcn_mfma_f32_16x16x32_bf16(a, b, c, 0, 0, 0); }
__device__ __forceinline__ bf16x8 ld8(const bf16_t* p) { return *(const bf16x8*)p; }
__device__ __forceinline__ bf16x8 pack8(f32x4 a, f32x4 b) { u32x4 w; w.x = cvt_pk_bf16(a[0], a[1]); w.y = cvt_pk_bf16(a[2], a[3]); w.z = cvt_pk_bf16(b[0], b[1]); w.w = cvt_pk_bf16(b[2], b[3]); return __builtin_bit_cast(bf16x8, w); }
__device__ __forceinline__ float colmax(float x) { x = fmaxf(x, __shfl_xor(x, 16)); return fmaxf(x, __shfl_xor(x, 32)); }
__device__ __forceinline__ float colsum(float x) { x += __shfl_xor(x, 16); return x + __shfl_xor(x, 32); }
struct AttnState { float m, l; f32x4 o[4]; };
__device__ __forceinline__ void attn_init(AttnState& st) { st.m = -1e30f; st.l = 0.f;
#pragma unroll
    for (int d = 0; d < 4; ++d) st.o[d] = (f32x4){0.f, 0.f, 0.f, 0.f}; }
struct KVChunk { bf16x8 k[4]; bf16x8 v[4]; };
__device__ __forceinline__ void kv_load(KVChunk& B, const bf16_t* kptr, const bf16_t* vptr) {
#pragma unroll
    for (int tl = 0; tl < 2; ++tl) { B.k[tl * 2] = ld8(kptr + tl * 1024); B.k[tl * 2 + 1] = ld8(kptr + tl * 1024 + 32); }
#pragma unroll
    for (int d = 0; d < 4; ++d) B.v[d] = ld8(vptr + d * 512);
}
struct KRange { int klo, span; };
__device__ __forceinline__ KRange krange(int klo, int khi) { KRange r; if (khi < klo) { r.klo = 64; r.span = 0; } else { r.klo = klo; r.span = khi - klo; } return r; }
template <bool MASKED>
__device__ __forceinline__ void attn_chunk_r(AttnState& st, const bf16x8 (&kf)[4], const bf16x8 (&vf)[4], const bf16x8 q0, const bf16x8 q1, KRange kr) {
    f32x4 s[2];
#pragma unroll
    for (int tl = 0; tl < 2; ++tl) { s[tl] = mfma16(kf[tl * 2], q0, (f32x4){0.f, 0.f, 0.f, 0.f}); s[tl] = mfma16(kf[tl * 2 + 1], q1, s[tl]); }
    float mx = -1e30f;
#pragma unroll
    for (int tl = 0; tl < 2; ++tl)
#pragma unroll
        for (int i = 0; i < 4; ++i) { if (MASKED) { const bool v = (unsigned)(tl * 16 + i - kr.klo) <= (unsigned)kr.span; s[tl][i] = v ? s[tl][i] : -1e30f; } mx = fmaxf(mx, s[tl][i]); }
    mx = colmax(mx);
    if (__any(mx > st.m)) {
        const float mnew = fmaxf(st.m, mx), alpha = __builtin_amdgcn_exp2f(st.m - mnew);
        st.l *= alpha; st.m = mnew;
#pragma unroll
        for (int d = 0; d < 4; ++d) st.o[d] = st.o[d] * alpha;
    }
    const float mcur = st.m;
    f32x4 p[2]; float ps = 0.f;
#pragma unroll
    for (int tl = 0; tl < 2; ++tl)
#pragma unroll
        for (int i = 0; i < 4; ++i) { const float e = __builtin_amdgcn_exp2f(s[tl][i] - mcur); p[tl][i] = e; ps += e; }
    st.l += ps;
    const bf16x8 pb = pack8(p[0], p[1]);
#pragma unroll
    for (int d = 0; d < 4; ++d) st.o[d] = mfma16(vf[d], pb, st.o[d]);
}

#define ATT_STEPN(C, idx) do { _Pragma("unroll") for (int gg = 0; gg < NG; ++gg) { if (act(gg, idx)) { \
        if (ff(gg, idx)) attn_chunk_r<false>(gs[gg], C.k, C.v, gq[gg][0], gq[gg][1], KRange{0, 0}); else attn_chunk_r<true>(gs[gg], C.k, C.v, gq[gg][0], gq[gg][1], mf(gg, idx)); } \
        __builtin_amdgcn_sched_barrier(0); } } while (0)
template <int NG, class AddrK, class AddrV, class ActF, class FullF, class MaskF>
__device__ __forceinline__ void attn_chunksN(AttnState (&gs)[NG], const bf16x8 (&gq)[NG][2], int n, AddrK ak, AddrV av, ActF act, FullF ff, MaskF mf) {
    if constexpr (NG <= 2) {
        KVChunk C0, C1;
        if (n > 0) kv_load(C0, ak(0), av(0));
#pragma unroll 1
        for (int i = 0; i < n; i += 2) {
            if (i + 1 < n) kv_load(C1, ak(i + 1), av(i + 1));
            ATT_STEPN(C0, i);
            if (i + 1 < n) {
                if (i + 2 < n) kv_load(C0, ak(i + 2), av(i + 2));
                ATT_STEPN(C1, i + 1);
            }
        }
    } else {
#pragma unroll 1
        for (int i = 0; i < n; ++i) { KVChunk C0; kv_load(C0, ak(i), av(i)); ATT_STEPN(C0, i); }
    }
}

__device__ __forceinline__ void nsa_attention(const bf16_t* Q, const bf16_t* KF, const bf16_t* VF, const bf16_t* KC, const bf16_t* VC, const float* gates, bf16_t* OUT, LAS unsigned char* lds, int G, int wave, int lane_) {
    int lane0 = lane_; asm volatile("" : "+v"(lane0));
    LAS float* imp = (LAS float*)(lds + wave * 18432);
    LAS float* tl = imp;
    LAS int* sel = (LAS int*)(lds + wave * 18432 + 16384);
    LAS unsigned* smask32 = (LAS unsigned*)(lds + wave * 18432 + 16384 + 1088);
    LAS unsigned char* blist = (LAS unsigned char*)(lds + wave * 18432 + 16384 + 1088 + 512);
    const bool xcd_map = (G % 8) == 0;
    const int nslots = xcd_map ? (G >> 3) * NWAVES : G * NWAVES, slot = xcd_map ? ((int)blockIdx.x >> 3) * NWAVES + wave : (int)blockIdx.x * NWAVES + wave;
    const int ntask = xcd_map ? 1024 : 8192;
#pragma unroll 1
    for (int task = slot; task < ntask; task += nslots) {
        int lane = lane0; asm volatile("" : "+v"(lane)); lane &= 63;
        const int col = lane & 15, rq = lane >> 4;
        const int tilei = xcd_map ? task : (task >> 3), bg = xcd_map ? ((int)blockIdx.x & 7) : (task & 7), b = bg >> 2, g = bg & 3, t0 = tilei * 16, t = t0 + col;
        const size_t rowq = (size_t)b * S + t;
        const bf16_t* qrow = Q + rowq * D + (g * 4) * 64 + 8 * rq;
        const float* grow = gates + rowq * 48 + g * 12;
        const int cur_max = (t0 + 15) >> 6;
        int n_end = 4 * (cur_max + 1); if (n_end > 1024) n_end = 1024;
        const int nchunk_c = (n_end + 31) >> 5;
        const bf16_t* kc_l = KC + (size_t)bg * 65536 + (size_t)col * 64 + 8 * rq;
        const bf16_t* vc_l = VC + (size_t)bg * 65536 + (size_t)col * 32 + 8 * rq;
        {
        AttnState gs[4]; bf16x8 gq[4][2];
#pragma unroll
        for (int h = 0; h < 4; ++h) { gq[h][0] = ld8(qrow + h * 64); gq[h][1] = ld8(qrow + h * 64 + 32); attn_init(gs[h]); }
        attn_chunksN<4>(gs, gq, nchunk_c,
            [&](int ci) { return kc_l + (size_t)ci * 2048; }, [&](int ci) { return vc_l + (size_t)ci * 2048; },
            [&](int, int) { return true; },
            [&](int, int ci) { return 16 * (ci * 32 + 31) + 31 <= t0; },
            [&](int, int ci) { const int nhi = (t >= 31) ? ((t - 31) >> 4) : -1; return krange(0, nhi - ci * 32 - 4 * rq); });
        {
            float mc[4], lc[4];
#pragma unroll
            for (int h = 0; h < 4; ++h) { const float lt = colsum(gs[h].l); mc[h] = gs[h].m; lc[h] = (gs[h].m > -1e29f && lt > 0.f) ? 1.0f / lt : 0.f; }
            {
                float carry = 0.f;
#pragma unroll 1
                for (int kc = 0; kc < nchunk_c; ++kc) {
#pragma unroll
                    for (int tt = 0; tt < 2; ++tt) {
                        const bf16x8 k0 = ld8(kc_l + (size_t)kc * 2048 + tt * 1024), k1 = ld8(kc_l + (size_t)kc * 2048 + tt * 1024 + 32);
                        float own = 0.f, p3 = 0.f;
#pragma unroll
                        for (int h = 0; h < 4; ++h) {
                            f32x4 sc = mfma16(k0, gq[h][0], (f32x4){0.f, 0.f, 0.f, 0.f}); sc = mfma16(k1, gq[h][1], sc);
#pragma unroll
                            for (int i = 0; i < 4; ++i) { const int n = kc * 32 + tt * 16 + 4 * rq + i; const float p = (16 * n + 31 <= t) ? __builtin_amdgcn_exp2f(sc[i] - mc[h]) * lc[h] : 0.f; own += p; if (i == 3) p3 += p; }
                        }
                        const float up = __shfl(p3, (lane + 48) & 63);
                        const float add = (rq == 0) ? carry : up;
                        imp[col * 256 + kc * 8 + tt * 4 + rq] = own + add;
                        carry = __shfl(p3, col + 48);
                    }
                }
            }
#pragma unroll 1
            for (int c = 0; c < 16; ++c) {
                const int tc = t0 + c, cur = tc >> 6;
                if (cur < 16) { if (lane <= cur) sel[c * 17 + lane] = lane; if (lane == 0) sel[c * 17 + 16] = cur + 1; }
                else {
                    unsigned key[4];
#pragma unroll
                    for (int jx = 0; jx < 4; ++jx) { const int sb = lane + 64 * jx; const float v = imp[c * 256 + sb]; key[jx] = (sb >= 1 && sb <= cur - 2) ? ((__float_as_uint(v) & 0xFFFFFF00u) | (unsigned)(255 - sb)) : 0u; }
                    if (lane == 0) { sel[c * 17 + 0] = 0; sel[c * 17 + 1] = cur - 1; sel[c * 17 + 2] = cur; sel[c * 17 + 16] = 16; }
#pragma unroll 1
                    for (int r = 0; r < 13; ++r) {
                        unsigned best = max(max(key[0], key[1]), max(key[2], key[3]));
#pragma unroll
                        for (int o = 1; o < 64; o <<= 1) best = max(best, (unsigned)__shfl_xor((int)best, o));
                        if (lane == 0) sel[c * 17 + 3 + r] = 255 - (int)(best & 255u);
#pragma unroll
                        for (int jx = 0; jx < 4; ++jx) if (key[jx] == best) key[jx] = 0u;
                    }
                }
            }
#pragma unroll
            for (int h = 0; h < 4; ++h) { const float gc = grow[h * 3 + 0] * lc[h];
#pragma unroll
                for (int d = 0; d < 4; ++d)
#pragma unroll
                    for (int i = 0; i < 4; ++i) tl[(h * 16 + d * 4 + i) * 64 + lane] = gs[h].o[d][i] * gc; }
        }
        }
        {
            smask32[lane] = 0u; smask32[64 + lane] = 0u;
#pragma unroll
            for (int k4 = 0; k4 < 4; ++k4) { const int pp = lane + 64 * k4, c = pp >> 4, e = pp & 15; if (e < sel[c * 17 + 16]) { const int jb = sel[c * 17 + e]; atomicOr((unsigned*)(smask32 + (jb >> 1)), 1u << (c + 16 * (jb & 1))); } }
            const bf16_t* ks_b = KF + (size_t)1 * KF_STRIDE + (size_t)bg * S * 64 + (size_t)col * 64 + 8 * rq;
            const bf16_t* vs_b = VF + (size_t)bg * S * 64 + (size_t)col * 32 + 8 * rq;
            const int tokl = col >> 2, hd = col & 3;
#pragma unroll 1
            for (int quad = 0; quad < 4; ++quad) {
                int nblk = 0;
#pragma unroll
                for (int k4 = 0; k4 < 4; ++k4) { const int jb = lane + 64 * k4; const unsigned mk = (smask32[jb >> 1] >> (16 * (jb & 1) + 4 * quad)) & 0xFu;
                    const unsigned long long bal = __ballot(mk != 0u); const int pos = nblk + __popcll(bal & ((1ull << lane) - 1ull)); if (mk != 0u) blist[pos] = (unsigned char)jb; nblk += __popcll(bal); }
                AttnState hs[1]; bf16x8 hq[1][2];
                { const bf16_t* qp = Q + ((size_t)b * S + t0 + 4 * quad + tokl) * D + (g * 4 + hd) * 64 + 8 * rq; hq[0][0] = ld8(qp); hq[0][1] = ld8(qp + 32); attn_init(hs[0]); }
                auto blk_of = [&](int ci) { return (int)__builtin_amdgcn_readfirstlane((int)blist[ci >> 1]); };
                auto msk_of = [&](int jb) { return (unsigned)__builtin_amdgcn_readfirstlane((int)((smask32[jb >> 1] >> (16 * (jb & 1) + 4 * quad)) & 0xFu)); };
                const int tb = t0 + 4 * quad;
                attn_chunksN<1>(hs, hq, nblk * 2,
                    [&](int ci) { return ks_b + (size_t)(blk_of(ci) * 2 + (ci & 1)) * 2048; },
                    [&](int ci) { return vs_b + (size_t)(blk_of(ci) * 2 + (ci & 1)) * 2048; },
                    [&](int, int) { return true; },
                    [&](int, int ci) { const int jb = blk_of(ci); return msk_of(jb) == 15u && jb * 64 + (ci & 1) * 32 + 31 <= tb; },
                    [&](int, int ci) { const int jb = blk_of(ci); const unsigned mk = msk_of(jb); const int kp0 = jb * 64 + (ci & 1) * 32 + 4 * rq;
                        return krange(0, ((mk >> tokl) & 1u) ? (tb + tokl - kp0) : -1); });
                { const int tok = 4 * quad + tokl;
                    const float lt = colsum(hs[0].l); const float inv = (hs[0].m > -1e29f && lt > 0.f) ? 1.0f / lt : 0.f;
                    const float gsv = gates[((size_t)b * S + t0 + tok) * 48 + g * 12 + hd * 3 + 1] * inv;
#pragma unroll
                    for (int d = 0; d < 4; ++d)
#pragma unroll
                        for (int i = 0; i < 4; ++i) tl[(hd * 16 + d * 4 + i) * 64 + tok + 16 * rq] += hs[0].o[d][i] * gsv; }
            }
        }
        {
            int lo = t0 - 511; if (lo < 0) lo = 0; const int c0 = lo >> 5, c1 = (t0 + 15) >> 5;
            const bf16_t* kw_b = KF + (size_t)2 * KF_STRIDE + (size_t)bg * S * 64 + (size_t)col * 64 + 8 * rq;
            const bf16_t* vw_b = VF + (size_t)1 * KF_STRIDE + (size_t)bg * S * 64 + (size_t)col * 32 + 8 * rq;
#pragma unroll 1
            for (int hp = 0; hp < 2; ++hp) {
                AttnState gs[2]; bf16x8 gq[2][2];
#pragma unroll
                for (int h = 0; h < 2; ++h) { gq[h][0] = ld8(qrow + (2 * hp + h) * 64); gq[h][1] = ld8(qrow + (2 * hp + h) * 64 + 32); attn_init(gs[h]); }
                attn_chunksN<2>(gs, gq, c1 - c0 + 1,
                    [&](int ci) { return kw_b + (size_t)(c0 + ci) * 2048; }, [&](int ci) { return vw_b + (size_t)(c0 + ci) * 2048; },
                    [&](int, int) { return true; },
                    [&](int, int ci) { return (c0 + ci) * 32 + 31 <= t0 && (c0 + ci) * 32 + 512 > t0 + 15; },
                    [&](int, int ci) { const int cb = (c0 + ci) * 32 + 4 * rq; return krange(t - 511 - cb, t - cb); });
#pragma unroll
                for (int h = 0; h < 2; ++h) { const int hh = 2 * hp + h; const float lt = colsum(gs[h].l); const float inv = (gs[h].m > -1e29f && lt > 0.f) ? 1.0f / lt : 0.f; const float gwv = grow[hh * 3 + 2] * inv;
#pragma unroll
                    for (int d = 0; d < 4; ++d)
#pragma unroll
                        for (int i = 0; i < 4; ++i) tl[(hh * 16 + d * 4 + i) * 64 + lane] += gs[h].o[d][i] * gwv; }
            }
        }
#pragma unroll
        for (int h = 0; h < 4; ++h)
#pragma unroll
            for (int d = 0; d < 4; ++d) { float v4[4];
#pragma unroll
                for (int i = 0; i < 4; ++i) v4[i] = tl[(h * 16 + d * 4 + i) * 64 + lane];
                u32x2 w; w.x = cvt_pk_bf16(v4[0], v4[1]); w.y = cvt_pk_bf16(v4[2], v4[3]);
                *(u32x2*)(OUT + rowq * D + (g * 4 + h) * 64 + d * 16 + 4 * rq) = w; }
    }
}

#define GSYNC() do { asm volatile("s_waitcnt vmcnt(0)" ::: "memory"); __builtin_amdgcn_fence(__ATOMIC_RELEASE, "agent"); grid.sync(); __builtin_amdgcn_fence(__ATOMIC_ACQUIRE, "agent"); } while (0)
__global__ void __launch_bounds__(NTHREADS, 2) fwd_kernel(Params P) {
    extern __shared__ __attribute__((aligned(16))) unsigned char lds_raw[];
    LAS unsigned char* lds = (LAS unsigned char*)lds_raw;
    cg::grid_group grid = cg::this_grid();
    int tidv = threadIdx.x;
    const int wave = __builtin_amdgcn_readfirstlane(tidv >> 6);
    const int G = gridDim.x, gw_k = blockIdx.x * NWAVES + wave, NGW = G * NWAVES;
    unsigned char* ws = P.ws;
    float* xres = P.out;
    LAS float* scr = (LAS float*)(lds + wave * 16384);
    const float* x_in = P.in[0];
    const float* norm_mix = P.in[1]; const float* norm_mlp = P.in[2]; const float* norm_final = P.in[3];
    const float* mlp_w1 = P.in[4]; const float* mlp_w2 = P.in[5];

    for (int layer = 0; layer < 4; ++layer) {
        int lane = tidv; asm volatile("" : "+v"(lane)); lane &= 63;
        int gw = gw_k; asm volatile("" : "+s"(gw));
        const bool is_rwkv = (layer & 1) != 0; const int lj = layer >> 1;
        const float* xsrc = (layer == 0) ? x_in : xres;
        {
            TJob j1{mlp_w1 + (size_t)layer * D * FF, FF, 0, FF, D, (bf16_t*)(ws + WS_W + W_MLP1), D, 0, 0, FF, D, nullptr, 0};
            transpose_job(j1, scr, gw, NGW, lane);
            TJob j2{mlp_w2 + (size_t)layer * FF * D, D, 0, D, FF, (bf16_t*)(ws + WS_W + W_MLP2), FF, 0, 0, D, FF, nullptr, 0};
            transpose_job(j2, scr, gw, NGW, lane);
            if (is_rwkv) {
                const float* mix = P.in[14] + (size_t)lj * 6 * D;
                bf16_t* WrT = (bf16_t*)(ws + WS_W + W_RW_IN);
                const float* wrkv = P.in[15] + (size_t)lj * 3 * D * D;
                for (int part = 0; part < 8; ++part) {
                    const float* W; int ldw, Nsrc, mi, r0, Npad;
                    if (part == 0) { W = wrkv; ldw = D; Nsrc = D; mi = 0; r0 = 0; Npad = D; }
                    else if (part == 1) { W = wrkv + (size_t)D * D; ldw = D; Nsrc = D; mi = 2; r0 = 1024; Npad = D; }
                    else if (part == 2) { W = wrkv + (size_t)2 * D * D; ldw = D; Nsrc = D; mi = 3; r0 = 2048; Npad = D; }
                    else if (part == 3) { W = P.in[17] + (size_t)lj * D * 64; ldw = 64; Nsrc = 64; mi = 1; r0 = 3072; Npad = 128; }
                    else if (part == 4) { W = P.in[20] + (size_t)lj * D * 64; ldw = 64; Nsrc = 64; mi = 4; r0 = 3200; Npad = 128; }
                    else if (part == 5) { W = P.in[22] + (size_t)lj * D * 160; ldw = 160; Nsrc = 160; mi = 5; r0 = 3328; Npad = 256; }
                    else if (part == 6) { W = P.in[31]; ldw = 32; Nsrc = (lj >= 1) ? 32 : 0; mi = 3; r0 = 3584; Npad = 128; }
                    else { W = P.in[31]; ldw = 32; Nsrc = 0; mi = 3; r0 = 3712; Npad = 128; }
                    TJob ja{W, ldw, 0, Nsrc, D, WrT, 2048, r0, 0, Npad, D, mix + mi * D, 1};
                    transpose_job(ja, scr, gw, NGW, lane);
                    TJob jb{W, ldw, 0, Nsrc, D, WrT, 2048, r0, 1024, Npad, D, mix + mi * D, 2};
                    transpose_job(jb, scr, gw, NGW, lane);
                }
                TJob jw{P.in[18] + (size_t)lj * 64 * D, D, 0, D, 64, (bf16_t*)(ws + WS_W + W_RW_W2), 128, 0, 0, D, 128, nullptr, 0}; transpose_job(jw, scr, gw, NGW, lane);
                TJob jaa{P.in[21] + (size_t)lj * 64 * D, D, 0, D, 64, (bf16_t*)(ws + WS_W + W_RW_A2), 128, 0, 0, D, 128, nullptr, 0}; transpose_job(jaa, scr, gw, NGW, lane);
                TJob jv{P.in[32], D, 0, D, (lj >= 1) ? 32 : 0, (bf16_t*)(ws + WS_W + W_RW_V2), 128, 0, 0, D, 128, nullptr, 0}; transpose_job(jv, scr, gw, NGW, lane);
                TJob jg{P.in[23] + (size_t)lj * 160 * D, D, 0, D, 160, (bf16_t*)(ws + WS_W + W_RW_G2), 256, 0, 0, D, 256, nullptr, 0}; transpose_job(jg, scr, gw, NGW, lane);
                TJob jo{P.in[29] + (size_t)lj * D * D, D, 0, D, D, (bf16_t*)(ws + WS_W + W_RW_O), D, 0, 0, D, D, nullptr, 0}; transpose_job(jo, scr, gw, NGW, lane);
                bf16_t* HN = (bf16_t*)(ws + A_HN);
                if (gw < 2) { u32x4* z = (u32x4*)(HN + (size_t)gw * (S + 1) * D); unsigned zz; asm volatile("v_mov_b32 %0, 0" : "=v"(zz)); for (int q = lane; q < D / 8; q += 64) z[q] = (u32x4){zz, zz, zz, zz}; }
                for (int m = gw; m < M; m += NGW) { const int b = m / S; rms_row_bf16(xsrc + (size_t)m * D, norm_mix + layer * D, HN + ((size_t)m + b + 1) * D, nullptr, lane); }
            } else {
                const float* win = P.in[6] + (size_t)lj * D * 2608;
                bf16_t* WnT = (bf16_t*)(ws + WS_W + W_NSA_IN); bf16_t* WvT = (bf16_t*)(ws + WS_W + W_NSA_V);
                for (int part = 0; part < 8; ++part) {
                    int n0src, Nsrc, r0, Npad; bf16_t* WT = WnT;
                    if (part == 0) { n0src = 0; Nsrc = 1024; r0 = 0; Npad = 1024; }
                    else if (part == 1) { n0src = 1024; Nsrc = 256; r0 = 1024; Npad = 256; }
                    else if (part == 2) { n0src = 1024 + 512; Nsrc = 256; r0 = 1280; Npad = 256; }
                    else if (part == 3) { n0src = 1024 + 1024; Nsrc = 256; r0 = 1536; Npad = 256; }
                    else if (part == 4) { n0src = 1024 + 256; Nsrc = 256; r0 = 1792; Npad = 256; }
                    else if (part == 5) { n0src = 2560; Nsrc = 48; r0 = 2048; Npad = 256; }
                    else if (part == 6) { n0src = 1024 + 768; Nsrc = 256; r0 = 0; Npad = 256; WT = WvT; }
                    else { n0src = 1024 + 1280; Nsrc = 256; r0 = 256; Npad = 256; WT = WvT; }
                    TJob jn{win, 2608, n0src, Nsrc, D, WT, D, r0, 0, Npad, D, nullptr, 0}; transpose_job(jn, scr, gw, NGW, lane);
                }
                TJob jo{P.in[13] + (size_t)lj * D * D, D, 0, D, D, (bf16_t*)(ws + WS_W + W_NSA_O), D, 0, 0, D, D, nullptr, 0}; transpose_job(jo, scr, gw, NGW, lane);
                TJob jc1k{P.in[8] + (size_t)lj * 2048 * 256, 256, 0, 256, 2048, (bf16_t*)(ws + WS_W + W_C1K), 2048, 0, 0, 256, 2048, nullptr, 0}; transpose_job(jc1k, scr, gw, NGW, lane);
                TJob jc1v{P.in[11] + (size_t)lj * 2048 * 256, 256, 0, 256, 2048, (bf16_t*)(ws + WS_W + W_C1V), 2048, 0, 0, 256, 2048, nullptr, 0}; transpose_job(jc1v, scr, gw, NGW, lane);
                TJob jc2k{P.in[9] + (size_t)lj * 256 * 64, 64, 0, 64, 256, (bf16_t*)(ws + WS_W + W_C2K), 256, 0, 0, 256, 256, nullptr, 0}; transpose_job(jc2k, scr, gw, NGW, lane);
                TJob jc2v{P.in[12] + (size_t)lj * 256 * 64, 64, 0, 64, 256, (bf16_t*)(ws + WS_W + W_C2V), 256, 0, 0, 256, 256, nullptr, 0}; transpose_job(jc2v, scr, gw, NGW, lane);
                {
                    int ln = lane; asm volatile("" : "+v"(ln));
                    float* cb = (float*)(ws + WS_W + W_CBIAS);
#pragma unroll 1
                    for (int o = gw; o < 512; o += NGW) { const int isv = o >> 8, c = o & 255;
                        const float* pe = (isv ? P.in[10] : P.in[7]) + (size_t)lj * 2048; const float* w1 = (isv ? P.in[11] : P.in[8]) + (size_t)lj * 2048 * 256;
                        float acc = 0.f;
#pragma unroll 1
                        for (int k = ln; k < 2048; k += 64) acc += pe[k] * w1[(size_t)k * 256 + c];
                        acc = wave_sum(acc); if (ln == 0) cb[o] = acc; }
                    if (layer == 0) {
                        float* rt = (float*)(ws + WS_ROPE);
                        int tix = tidv; asm volatile("" : "+v"(tix)); const int gt = (int)blockIdx.x * NTHREADS + tix;
#pragma unroll 1
                        for (int e = gt; e < S * 8; e += G * NTHREADS) { const int tt = e >> 3, i = e & 7;
                            const float invf = (i == 0) ? 1.0f : (i == 1) ? 0.1939227432012558f : (i == 2) ? 0.03760603070259094f : (i == 3) ? 0.007292664609849453f : (i == 4) ? 0.0014142135623842478f : (i == 5) ? 0.00027424818836152554f : (i == 6) ? 5.318296098266728e-05f : 1.0313386155758053e-05f;
                            const float ang = (float)tt * invf; const double rev = (double)ang * 0.15915494309189535; const float fr = (float)(rev - __builtin_rint(rev));
                            rt[tt * 16 + i] = __builtin_amdgcn_cosf(fr); rt[tt * 16 + 8 + i] = __builtin_amdgcn_sinf(fr); }
                    }
                }
                for (int m = gw; m < M; m += NGW) rms_row_bf16(xsrc + (size_t)m * D, norm_mix + layer * D, (bf16_t*)(ws + A_HN) + (size_t)m * D, (layer == 0) ? xres + (size_t)m * D : nullptr, lane);
            }
        }
        GSYNC();
        if (!is_rwkv) {
            bf16_t* HN = (bf16_t*)(ws + A_HN); bf16_t* Qb = (bf16_t*)(ws + A_Q); bf16_t* KFb = (bf16_t*)(ws + A_KF); bf16_t* VFb = (bf16_t*)(ws + A_VF);
            float* GT = (float*)(ws + A_GATES); bf16_t* CHK = (bf16_t*)(ws + A_CHK); bf16_t* CHV = (bf16_t*)(ws + A_CHV); bf16_t* KCb = (bf16_t*)(ws + A_KC); bf16_t* VCb = (bf16_t*)(ws + A_VC);
            {
                pg8::Gemm g{HN, (const bf16_t*)(ws + WS_W + W_NSA_IN), M, 2304, D, D, D, 0};
                pg8::StaticOrder so; so.init(M, 2304, G, (int)blockIdx.x);
                pg8::EpiP<FNsaIn> E{FNsaIn{Qb, KFb, GT, (const float*)(ws + WS_ROPE)}};
                pg8::gemm_phase<pg8::EpiP<FNsaIn>, true>(lds, g, so, E, tidv);
                pg8::Gemm g2{(const bf16_t*)(ws + WS_W + W_NSA_V), HN, 512, M, D, D, D, 0};
                pg8::StaticOrder so2; so2.init(512, M, G, (int)blockIdx.x);
                pg8::EpiP<FNsaVT> E2{FNsaVT{VFb}};
                pg8::gemm_phase<pg8::EpiP<FNsaVT>, true>(lds, g2, so2, E2, tidv);
            }
            GSYNC();
            {
                pg8::StaticOrder so; so.init(8192, 256, G, (int)blockIdx.x);
                { pg8::Gemm g{KFb, (const bf16_t*)(ws + WS_W + W_C1K), 8192, 256, 2048, 1024, 2048, 0}; pg8::EpiP<FCmp1> E{FCmp1{CHK, (const float*)(ws + WS_W + W_CBIAS)}}; pg8::gemm_phase<pg8::EpiP<FCmp1>, true>(lds, g, so, E, tidv); }
                { pg8::Gemm g{KFb + 3 * KF_STRIDE, (const bf16_t*)(ws + WS_W + W_C1V), 8192, 256, 2048, 1024, 2048, 0}; pg8::EpiP<FCmp1> E{FCmp1{CHV, (const float*)(ws + WS_W + W_CBIAS) + 256}}; pg8::gemm_phase<pg8::EpiP<FCmp1>, true>(lds, g, so, E, tidv); }
            }
            GSYNC();
            {
                { pg8::StaticOrder so; so.init(8192, 256, G, (int)blockIdx.x); pg8::Gemm g{CHK, (const bf16_t*)(ws + WS_W + W_C2K), 8192, 256, 256, 256, 256, 0}; pg8::EpiP<FCmp2K> E{FCmp2K{KCb}}; pg8::gemm_phase<pg8::EpiP<FCmp2K>, true>(lds, g, so, E, tidv); }
                { pg8::StaticOrder so; so.init(256, 8192, G, (int)blockIdx.x); pg8::Gemm g{(const bf16_t*)(ws + WS_W + W_C2V), CHV, 256, 8192, 256, 256, 256, 0}; pg8::EpiP<FCmp2VT> E{FCmp2VT{VCb}}; pg8::gemm_phase<pg8::EpiP<FCmp2VT>, true>(lds, g, so, E, tidv); }
            }
            GSYNC();
            nsa_attention(Qb, KFb, VFb, KCb, VCb, GT, HN, lds, G, wave, lane_id());
            tidv = wave * 64 + (lane_id() & 63); asm volatile("" : "+v"(tidv)); tidv &= 511; lane = tidv & 63;
            GSYNC();
            {
                pg8::StaticOrder so; so.init(M, D, G, (int)blockIdx.x);
                pg8::Gemm g{HN, (const bf16_t*)(ws + WS_W + W_NSA_O), M, D, D, D, D, 0}; pg8::EpiN<FResAdd> E{FResAdd{xres}}; pg8::gemm_phase<pg8::EpiN<FResAdd>, true>(lds, g, so, E, tidv);
            }
            GSYNC();
        }
        if (is_rwkv) {
            h16* Rb = (h16*)(ws + A_R); h16* Kb = (h16*)(ws + A_K); h16* Ab = (h16*)(ws + A_A); h16* EWb = (h16*)(ws + A_HN);
            h16* Vb = (lj == 0) ? (h16*)(ws + WS_VF) : (h16*)(ws + A_V2);
            h16* Yraw = (lj == 0) ? (h16*)(ws + A_V2) : (h16*)(ws + WS_VF);
            bf16_t* LH = (bf16_t*)(ws + A_LH);
            {
                pg8::Gemm g{(const bf16_t*)(ws + A_HN), (const bf16_t*)(ws + WS_W + W_RW_IN), M, 3840, 2048, D, 2048, 1};
                pg8::StaticOrder so; so.init(M, 3840, G, (int)blockIdx.x);
                pg8::EpiP<FRwIn> E{FRwIn{Rb, Kb, Vb, LH}};
                pg8::gemm_phase<pg8::EpiP<FRwIn>, true>(lds, g, so, E, tidv);
            }
            GSYNC();
            {
                pg8::StaticOrder so; so.init(M, D, G, (int)blockIdx.x);
                { pg8::Gemm g{LH, (const bf16_t*)(ws + WS_W + W_RW_W2), M, D, 128, 768, 128, 0}; pg8::EpiP<FLoraW> E{FLoraW{EWb, P.in[16] + lj * D}}; pg8::gemm_phase<pg8::EpiP<FLoraW>, true>(lds, g, so, E, tidv); }
                { pg8::Gemm g{LH + 128, (const bf16_t*)(ws + WS_W + W_RW_A2), M, D, 128, 768, 128, 0}; pg8::EpiP<FLoraA> E{FLoraA{Ab, P.in[19] + lj * D}}; pg8::gemm_phase<pg8::EpiP<FLoraA>, true>(lds, g, so, E, tidv); }
                if (lj >= 1) { pg8::Gemm g{LH + 512, (const bf16_t*)(ws + WS_W + W_RW_V2), M, D, 128, 768, 128, 0}; pg8::EpiP<FLoraV> E{FLoraV{Vb, (const h16*)(ws + WS_VF), P.in[30]}}; pg8::gemm_phase<pg8::EpiP<FLoraV>, true>(lds, g, so, E, tidv); }
            }
            GSYNC();
            rwkv_scan2(Rb, Kb, Vb, EWb, Ab, P.in[24] + lj * D, P.in[25] + lj * D, Yraw, lds, wave, lane);
            GSYNC();
            rwkv_gn(Rb, Kb, Vb, Ab, Yraw, P.in[25] + lj * D, P.in[26] + lj * D, P.in[27] + lj * D, P.in[28] + lj * D, gw, NGW, lane);
            GSYNC();
            {
                pg8::StaticOrder so; so.init(M, D, G, (int)blockIdx.x);
                pg8::Gemm g{LH + 256, (const bf16_t*)(ws + WS_W + W_RW_G2), M, D, 256, 768, 256, 0}; pg8::EpiP<FGate> E{FGate{(bf16_t*)Kb, Rb}}; pg8::gemm_phase<pg8::EpiP<FGate>, true>(lds, g, so, E, tidv);
            }
            GSYNC();
            {
                pg8::StaticOrder so; so.init(M, D, G, (int)blockIdx.x);
                pg8::Gemm g{(const bf16_t*)Kb, (const bf16_t*)(ws + WS_W + W_RW_O), M, D, D, D, D, 0}; pg8::EpiN<FResAdd> E{FResAdd{xres}}; pg8::gemm_phase<pg8::EpiN<FResAdd>, true>(lds, g, so, E, tidv);
            }
            GSYNC();
        }
        for (int m = gw; m < M; m += NGW) rms_row_bf16(xres + (size_t)m * D, norm_mlp + layer * D, (bf16_t*)(ws + A_HN) + (size_t)m * D, nullptr, lane);
        GSYNC();
        {
            pg8::Gemm g{(const bf16_t*)(ws + A_HN), (const bf16_t*)(ws + WS_W + W_MLP1), M, FF, D, D, D, 0};
            pg8::StaticOrder so; so.init(M, FF, G, (int)blockIdx.x);
            pg8::EpiP<FRelu2> E{FRelu2{(bf16_t*)(ws + A_HID)}};
            pg8::gemm_phase<pg8::EpiP<FRelu2>, true>(lds, g, so, E, tidv);
        }
        GSYNC();
        {
            pg8::Gemm g{(const bf16_t*)(ws + A_HID), (const bf16_t*)(ws + WS_W + W_MLP2), M, D, FF, FF, FF, 0};
            pg8::StaticOrder so; so.init(M, D, G, (int)blockIdx.x);
            pg8::EpiN<FResAdd> E{FResAdd{xres}};
            pg8::gemm_phase<pg8::EpiN<FResAdd>, true>(lds, g, so, E, tidv);
        }
        GSYNC();
    }
    for (int m = gw_k; m < M; m += NGW) {
        int lane2 = tidv; asm volatile("" : "+v"(lane2)); lane2 &= 63;
        f32x4* xr = (f32x4*)(xres + (size_t)m * D) + lane2; const f32x4* gr = (const f32x4*)norm_final + lane2;
        f32x4 v[4]; float s = 0.f;
#pragma unroll
        for (int j = 0; j < 4; ++j) { v[j] = xr[64 * j]; s += (v[j].x * v[j].x + v[j].y * v[j].y) + (v[j].z * v[j].z + v[j].w * v[j].w); }
        const float r = rsqrtf(wave_sum(s) * (1.f / D) + 1e-5f);
#pragma unroll
        for (int j = 0; j < 4; ++j) { const f32x4 gg = gr[64 * j]; xr[64 * j] = v[j] * r * gg; }
    }
}

extern "C" void kernel_launch(void* const* d_in, const int* in_sizes, int n_in, void* d_out, int out_size, void* d_ws, size_t ws_size, hipStream_t stream) {
    static int grid = 0;
    if (grid == 0) {
        if (n_in != 33 || out_size != M * D || ws_size < WS_NEED) { fprintf(stderr, "kernel_launch: unexpected sizes n_in %d out %d ws %zu (need %zu)\n", n_in, out_size, ws_size, (size_t)WS_NEED); grid = -1; return; }
        int dev = 0, cus = 0, per_cu = 0;
        hipGetDevice(&dev);
        hipDeviceGetAttribute(&cus, hipDeviceAttributeMultiprocessorCount, dev);
        if (hipFuncSetAttribute((const void*)fwd_kernel, hipFuncAttributeMaxDynamicSharedMemorySize, LDS_BYTES) != hipSuccess) { fprintf(stderr, "hipFuncSetAttribute failed\n"); grid = -1; return; }
        hipOccupancyMaxActiveBlocksPerMultiprocessor(&per_cu, (const void*)fwd_kernel, NTHREADS, LDS_BYTES);
        if (per_cu < 1) { fprintf(stderr, "occupancy query returned %d\n", per_cu); per_cu = 1; }
        (void)hipGetLastError();
        grid = cus * 1;
    }
    if (grid < 0) return;
    Params p{};
    for (int i = 0; i < 33; ++i) p.in[i] = (const float*)d_in[i];
    p.out = (float*)d_out; p.ws = (unsigned char*)d_ws;
    void* args[] = {&p};
    hipError_t e = hipLaunchCooperativeKernel((const void*)fwd_kernel, dim3(grid), dim3(NTHREADS), args, LDS_BYTES, stream);
    if (e != hipSuccess) fprintf(stderr, "cooperative launch failed: %s (grid %d)\n", hipGetErrorString(e), grid);
}
```

```cpp
#include <hip/hip_runtime.h>
#include <hip/hip_cooperative_groups.h>
#include <cstdio>
#include <cstdint>
namespace cg = cooperative_groups;

#define LAS __attribute__((address_space(3)))
typedef unsigned short bf16_t;
typedef short bf16x8 __attribute__((ext_vector_type(8)));
typedef float f32x4 __attribute__((ext_vector_type(4)));
typedef float f32x2 __attribute__((ext_vector_type(2)));
typedef unsigned u32x4 __attribute__((ext_vector_type(4)));
typedef unsigned u32x2 __attribute__((ext_vector_type(2)));
typedef _Float16 h16;
typedef _Float16 h16x2 __attribute__((ext_vector_type(2)));

constexpr int S = 16384, NB = 2, M = NB * S, D = 1024, FF = 4096;
constexpr int NWAVES = 8, NTHREADS = 512;
constexpr int LDS_BYTES = 147456;
constexpr size_t MiB = 1u << 20;
constexpr size_t WS_W = 0;
constexpr size_t W_MLP1 = 0, W_MLP2 = 8 * MiB;
constexpr size_t W_NSA_IN = 16 * MiB, W_NSA_V = 21 * MiB, W_NSA_O = 22 * MiB, W_C1K = 24 * MiB, W_C1V = 25 * MiB, W_C2K = 26 * MiB, W_C2V = 26 * MiB + 256 * 1024, W_CBIAS = 26 * MiB + 512 * 1024;
constexpr size_t W_RW_IN = 16 * MiB, W_RW_W2 = 31 * MiB, W_RW_A2 = 31 * MiB + 256 * 1024, W_RW_V2 = 31 * MiB + 512 * 1024, W_RW_G2 = 31 * MiB + 768 * 1024, W_RW_O = 33 * MiB;
constexpr size_t WS_ROPE = 36 * MiB;
constexpr size_t WS_VF = 40 * MiB;
constexpr size_t ACT = 104 * MiB;
constexpr size_t A_HN = ACT;
constexpr size_t A_Q = ACT + 65 * MiB;
constexpr size_t A_KF = ACT + 129 * MiB;
constexpr size_t A_VF = ACT + 194 * MiB;
constexpr size_t A_GATES = ACT + 226 * MiB;
constexpr size_t A_CHK = ACT + 233 * MiB, A_CHV = ACT + 237 * MiB, A_KC = ACT + 241 * MiB, A_VC = ACT + 242 * MiB;
constexpr size_t A_HID = ACT + 65 * MiB;
constexpr size_t A_R = ACT + 65 * MiB, A_K = ACT + 129 * MiB, A_V2 = ACT + 193 * MiB, A_A = ACT + 257 * MiB, A_LH = ACT + 321 * MiB;
constexpr size_t WS_NEED = ACT + 370 * MiB;

__device__ __forceinline__ int lane_id() { return (int)__builtin_amdgcn_mbcnt_hi(~0u, __builtin_amdgcn_mbcnt_lo(~0u, 0u)); }
__device__ __forceinline__ unsigned cvt_pk_bf16(float lo, float hi) { unsigned r; asm volatile("v_cvt_pk_bf16_f32 %0, %1, %2" : "=v"(r) : "v"(lo), "v"(hi)); return r; }
__device__ __forceinline__ unsigned pk_h16(float lo, float hi) { h16x2 v; v.x = (h16)lo; v.y = (h16)hi; return __builtin_bit_cast(unsigned, v); }
__device__ __forceinline__ float bf2f(bf16_t b) { return __uint_as_float(((unsigned)b) << 16); }
__device__ __forceinline__ float wave_sum(float v) {
#pragma unroll
    for (int o = 1; o < 64; o <<= 1) v += __shfl_xor(v, o);
    return v;
}
__device__ __forceinline__ float sigmoidf_(float x) { return 1.0f / (1.0f + __expf(-x)); }
__device__ __forceinline__ float tanhf_(float x) { float e = __expf(-2.0f * fabsf(x)); float t = (1.0f - e) / (1.0f + e); return x < 0.f ? -t : t; }

namespace pg8 {
constexpr int BM = 256, BK = 64, HALF = 128, HTB = HALF * BK * 2, STAGE_BYTES = 8 * HTB, NXCD = 8, WGM = 8;
__host__ __device__ __forceinline__ int lds_byte(int r, int c) { const int st = (r >> 4) * 2 + (c >> 5), rr = r & 15, cc = c & 31, ob = rr * 64 + cc * 2; return st * 1024 + (ob ^ (((ob >> 9) & 1) << 5)); }
__host__ __device__ __forceinline__ void stage_rc(int b, int& R, int& C) { const int st = b / 1024, sb = b % 1024, swz = sb ^ (((sb >> 9) & 1) << 5); R = (st >> 1) * 16 + swz / 64; C = (st & 1) * 32 + (swz % 64) / 2; }
__host__ __device__ __forceinline__ int perm32(int rho) { const int n = rho >> 4, i = rho & 15; return 8 * (i >> 2) + 4 * n + (i & 3); }
struct Unit { int pm, pn; };
struct Gemm { const bf16_t* A; const bf16_t* Bt; int M, N, K, lda, ldb, amode; };
struct StaticOrder {
    int nM, nN, nwg, G, c;
    __device__ void init(int M_, int N_, int G_, int c_) { nM = M_ / BM; nN = N_ / BM; nwg = nM * nN; G = G_; c = c_; }
    __device__ bool next(int i, Unit& u) const {
        const long L = (long)i * G + c; if (L >= nwg) return false;
        int wgid = (int)L; { const int q = nwg / NXCD, r = nwg % NXCD, xcd = wgid % NXCD, off = wgid / NXCD; wgid = (xcd < r ? xcd * (q + 1) : r * (q + 1) + (xcd - r) * q) + off; }
        const int nig = WGM * nN, gid = wgid / nig, fm = gid * WGM, gsz = (nM - fm) < WGM ? (nM - fm) : WGM;
        u.pm = fm + ((wgid % nig) % gsz); u.pn = (wgid % nig) / gsz; return true;
    }
};
__device__ __forceinline__ const char* a_base(const Gemm& g, int pm) { const size_t row = (size_t)pm * BM + (g.amode == 1 ? (size_t)(pm / 64) : 0); return (const char*)g.A + row * (size_t)g.lda * 2; }

template <class Epi, bool ALIGN_EPI>
__device__ __forceinline__ void gemm_phase(LAS unsigned char* lds, const Gemm g, const StaticOrder& S, const Epi& E, int tid_in) {
    int tid = tid_in; asm volatile("" : "+v"(tid));
    const int wid = __builtin_amdgcn_readfirstlane(tid >> 6), lane = tid & 63, wr = wid >> 2, wc = wid & 3, fr = lane & 15, fq = lane >> 4;
    int K = g.K; asm volatile("" : "+s"(K));
    const int nt = K / BK;
    unsigned voffA[2], voffB[2];
#pragma unroll
    for (int i = 0; i < 2; ++i) { int R, C; stage_rc(tid * 16 + i * 8192, R, C); const int Rb = Epi::PERM ? ((R & ~31) + perm32(R & 31)) : R;
        voffA[i] = (unsigned)(R * g.lda + C) * 2u; voffB[i] = (unsigned)(Rb * g.ldb + C) * 2u; }
    const size_t kstep = (size_t)(BK * 2);
    const size_t hstepA = (size_t)HALF * g.lda * 2, hstepB = (size_t)HALF * g.ldb * 2;
    const size_t tstepB = 2 * hstepB;
    const unsigned ldsw = (unsigned)wid * 1024u;
    const int aoff = lds_byte(wr * 64 + fr, fq * 8), boff = lds_byte(wc * 32 + fr, fq * 8);
#define PG8_SA(b, h) (((b) * 2 + (h)) * HTB)
#define PG8_SB(b, h) ((4 + (b) * 2 + (h)) * HTB)
#define PG8_STAGE(bufoff, gbase, voff) do { _Pragma("unroll") for (int _i = 0; _i < 2; ++_i) \
        __builtin_amdgcn_global_load_lds((const unsigned*)((const char*)(gbase) + (voff)[_i]), (LAS unsigned*)(lds + (bufoff) + ldsw + _i * 8192), 16, 0, 0); } while (0)
#define PG8_LDA(dst, b, h) do { _Pragma("unroll") for (int m = 0; m < 4; ++m) _Pragma("unroll") for (int k = 0; k < 2; ++k) dst[m][k] = *(const LAS bf16x8*)(lds + PG8_SA(b, h) + aoff + m * 2048 + k * 1024); } while (0)
#define PG8_LDB(dst, b, h) do { _Pragma("unroll") for (int n = 0; n < 2; ++n) _Pragma("unroll") for (int k = 0; k < 2; ++k) dst[n][k] = *(const LAS bf16x8*)(lds + PG8_SB(b, h) + boff + n * 2048 + k * 1024); } while (0)
#define PG8_MMA(ai, bj, At, Bt) do { __builtin_amdgcn_s_setprio(1); _Pragma("unroll") for (int m = 0; m < 4; ++m) _Pragma("unroll") for (int n = 0; n < 2; ++n) _Pragma("unroll") for (int k = 0; k < 2; ++k) \
        acc[ai][bj][m][n] = __builtin_amdgcn_mfma_f32_16x16x32_bf16(Bt[n][k], At[m][k], acc[ai][bj][m][n], 0, 0, 0); __builtin_amdgcn_s_setprio(0); } while (0)
#define PG8_WAIT_V(n) asm volatile("s_waitcnt vmcnt(" #n ")" ::: "memory")
#define PG8_WAIT_L(n) asm volatile("s_waitcnt lgkmcnt(" #n ")" ::: "memory")
#define PG8_BAR __builtin_amdgcn_s_barrier()
#define PG8_SCHED __builtin_amdgcn_sched_barrier(0)
    Unit cur, nxt; int ui = 0;
    if (!S.next(0, cur)) return;
    f32x4 acc[2][2][4][2];
#pragma unroll
    for (int a = 0; a < 2; ++a)
#pragma unroll
        for (int b = 0; b < 2; ++b)
#pragma unroll
            for (int m = 0; m < 4; ++m)
#pragma unroll
                for (int n = 0; n < 2; ++n) acc[a][b][m][n] = (f32x4){0.f, 0.f, 0.f, 0.f};
    bf16x8 At[4][2], B0[2][2], B1[2][2];
    const char* cA = a_base(g, cur.pm); const char* cB = (const char*)g.Bt + (size_t)cur.pn * tstepB;
    PG8_STAGE(PG8_SB(0, 0), cB, voffB); PG8_STAGE(PG8_SB(0, 1), cB + hstepB, voffB); PG8_STAGE(PG8_SA(0, 0), cA, voffA); PG8_STAGE(PG8_SA(0, 1), cA + hstepA, voffA);
    if (wr == 1) PG8_BAR;
    PG8_WAIT_V(2); PG8_BAR;
    PG8_STAGE(PG8_SB(1, 0), cB + kstep, voffB); PG8_STAGE(PG8_SA(1, 0), cA + kstep, voffA); PG8_STAGE(PG8_SB(1, 1), cB + hstepB + kstep, voffB);
    PG8_WAIT_V(6); PG8_BAR;
    for (;;) {
        const bool has_next = S.next(ui + 1, nxt);
        const char* nA = has_next ? a_base(g, nxt.pm) : cA; const char* nB = has_next ? (const char*)g.Bt + (size_t)nxt.pn * tstepB : cB;
        for (int t = 0; t < nt; t += 2) {
            const bool last = (t == nt - 2);
            const char* a1 = cA + (size_t)(t + 1) * kstep;
            const char* a2 = last ? nA : cA + (size_t)(t + 2) * kstep; const char* b2 = last ? nB : cB + (size_t)(t + 2) * kstep;
            const char* a3 = a2 + kstep; const char* b3 = b2 + kstep;
            PG8_LDB(B0, 0, 0); PG8_LDB(B1, 0, 1); PG8_SCHED; PG8_LDA(At, 0, 0); PG8_STAGE(PG8_SA(1, 1), a1 + hstepA, voffA);
            PG8_WAIT_V(8); PG8_WAIT_L(0); PG8_BAR; PG8_MMA(0, 0, At, B0); PG8_MMA(0, 1, At, B1); PG8_BAR; PG8_SCHED;
            PG8_LDA(At, 0, 1); PG8_STAGE(PG8_SB(0, 0), b2, voffB); PG8_STAGE(PG8_SB(0, 1), b2 + hstepB, voffB); PG8_STAGE(PG8_SA(0, 0), a2, voffA);
            PG8_WAIT_V(8); PG8_WAIT_L(0); PG8_BAR; PG8_MMA(1, 0, At, B0); PG8_MMA(1, 1, At, B1); PG8_BAR; PG8_SCHED;
            PG8_LDB(B0, 1, 0); PG8_LDB(B1, 1, 1); PG8_SCHED; PG8_LDA(At, 1, 0); PG8_STAGE(PG8_SA(0, 1), a2 + hstepA, voffA);
            PG8_WAIT_V(8); PG8_WAIT_L(0); PG8_BAR; PG8_MMA(0, 0, At, B0); PG8_MMA(0, 1, At, B1); PG8_BAR; PG8_SCHED;
            PG8_LDA(At, 1, 1); PG8_STAGE(PG8_SB(1, 0), b3, voffB); PG8_STAGE(PG8_SB(1, 1), b3 + hstepB, voffB); PG8_STAGE(PG8_SA(1, 0), a3, voffA);
            PG8_WAIT_V(8); PG8_WAIT_L(0); PG8_BAR; PG8_MMA(1, 0, At, B0); PG8_MMA(1, 1, At, B1); PG8_BAR; PG8_SCHED;
        }
        if constexpr (ALIGN_EPI) { if (wr == 0) PG8_BAR; }
        E(acc, cur, wr, wc, fr, fq);
        if (!has_next) break;
#pragma unroll
        for (int a = 0; a < 2; ++a)
#pragma unroll
            for (int b = 0; b < 2; ++b)
#pragma unroll
                for (int m = 0; m < 4; ++m)
#pragma unroll
                    for (int n = 0; n < 2; ++n) acc[a][b][m][n] = (f32x4){0.f, 0.f, 0.f, 0.f};
        cur = nxt; cA = nA; cB = nB; ++ui;
        if constexpr (ALIGN_EPI) { if (wr == 1) PG8_BAR; }
    }
    PG8_WAIT_V(0);
    if constexpr (!ALIGN_EPI) { if (wr == 0) PG8_BAR; }
    PG8_BAR;
#undef PG8_SA
#undef PG8_SB
#undef PG8_STAGE
#undef PG8_LDA
#undef PG8_LDB
#undef PG8_MMA
#undef PG8_WAIT_V
#undef PG8_WAIT_L
#undef PG8_BAR
#undef PG8_SCHED
}
template <class F> struct EpiP {
    static constexpr bool PERM = true; F f;
    __device__ __forceinline__ void operator()(const f32x4 (&acc)[2][2][4][2], const Unit& u, int wr, int wc, int fr, int fq) const {
#pragma unroll
        for (int ai = 0; ai < 2; ++ai)
#pragma unroll
            for (int m = 0; m < 4; ++m) { int row = u.pm * BM + ai * HALF + wr * 64 + m * 16 + fr; asm volatile("" : "+v"(row));
#pragma unroll
                for (int bj = 0; bj < 2; ++bj) { const int col0 = u.pn * BM + bj * HALF + wc * 32 + 8 * fq; f(row, col0, acc[ai][bj][m][0], acc[ai][bj][m][1]); } asm volatile("" ::: "memory"); }
    }
};
template <class F> struct EpiN {
    static constexpr bool PERM = false; F f;
    __device__ __forceinline__ void operator()(const f32x4 (&acc)[2][2][4][2], const Unit& u, int wr, int wc, int fr, int fq) const {
#pragma unroll
        for (int ai = 0; ai < 2; ++ai)
#pragma unroll
            for (int m = 0; m < 4; ++m) { int row = u.pm * BM + ai * HALF + wr * 64 + m * 16 + fr; asm volatile("" : "+v"(row));
#pragma unroll
                for (int bj = 0; bj < 2; ++bj)
#pragma unroll
                    for (int n = 0; n < 2; ++n) { const int col0 = u.pn * BM + bj * HALF + wc * 32 + 16 * n + 4 * fq; f(row, col0, acc[ai][bj][m][n]); } asm volatile("" ::: "memory"); }
    }
};
}

struct Params {
    const float* in[33];
    float* out;
    unsigned char* ws;
};

struct TJob { const float* W; int ldw, n0src, Nsrc, Ksrc; bf16_t* WT; int ldt, row_off, col_off, Npad, Kpad; const float* mix; int mode; };
__device__ __forceinline__ void transpose_job(const TJob& j, LAS float* scr, int gw, int NGW, int lane_) {
    int lane = lane_; asm volatile("" : "+v"(lane));
    const int nblk = j.Npad / 32, kblk = j.Kpad / 64, items = nblk * kblk;
    for (int it = gw; it < items; it += NGW) {
        const int kb = it / nblk, nb = it % nblk, k0 = 64 * kb, n0 = 32 * nb;
#pragma unroll 4
        for (int i = 0; i < 32; ++i) { const int kk = 2 * i + (lane >> 5), n = lane & 31; float v = 0.f;
            if (k0 + kk < j.Ksrc && n0 + n < j.Nsrc) { v = j.W[(size_t)(k0 + kk) * j.ldw + j.n0src + n0 + n];
                if (j.mode == 1) v *= j.mix[k0 + kk]; else if (j.mode == 2) v *= (1.0f - j.mix[k0 + kk]); }
            scr[kk * 33 + n] = v; }
        asm volatile("s_waitcnt lgkmcnt(0)" ::: "memory");
        const int c = lane & 7;
#pragma unroll
        for (int jj = 0; jj < 4; ++jj) { const int n = (lane >> 3) + 8 * jj; const LAS float* s = scr + (8 * c) * 33 + n;
            u32x4 o; o.x = cvt_pk_bf16(s[0 * 33], s[1 * 33]); o.y = cvt_pk_bf16(s[2 * 33], s[3 * 33]); o.z = cvt_pk_bf16(s[4 * 33], s[5 * 33]); o.w = cvt_pk_bf16(s[6 * 33], s[7 * 33]);
            *(u32x4*)(j.WT + (size_t)(j.row_off + n0 + n) * j.ldt + j.col_off + k0 + 8 * c) = o; }
        asm volatile("s_waitcnt lgkmcnt(0)" ::: "memory");
    }
}

__device__ __forceinline__ void rms_row_bf16(const float* xrow, const float* g, bf16_t* orow, float* copy_to, int lane_) {
    int lane = lane_; asm volatile("" : "+v"(lane));
    const f32x4* xr = (const f32x4*)xrow + lane; const f32x4* gr = (const f32x4*)g + lane;
    f32x4 v[4]; float s = 0.f;
#pragma unroll
    for (int j = 0; j < 4; ++j) { v[j] = xr[64 * j]; s += (v[j].x * v[j].x + v[j].y * v[j].y) + (v[j].z * v[j].z + v[j].w * v[j].w); }
    if (copy_to) {
#pragma unroll
        for (int j = 0; j < 4; ++j) ((f32x4*)copy_to + lane)[64 * j] = v[j];
    }
    const float r = rsqrtf(wave_sum(s) * (1.f / D) + 1e-5f);
    u32x2* o8 = (u32x2*)orow + lane;
#pragma unroll
    for (int j = 0; j < 4; ++j) { const f32x4 gg = gr[64 * j]; u32x2 w; w.x = cvt_pk_bf16(v[j].x * r * gg.x, v[j].y * r * gg.y); w.y = cvt_pk_bf16(v[j].z * r * gg.z, v[j].w * r * gg.w); o8[64 * j] = w; }
}

struct FRelu2 { bf16_t* O; __device__ __forceinline__ void operator()(int row, int col0, f32x4 a, f32x4 b) const {
    f32x4 x = a, y = b;
#pragma unroll
    for (int i = 0; i < 4; ++i) { float t = fmaxf(x[i], 0.f); x[i] = t * t; t = fmaxf(y[i], 0.f); y[i] = t * t; }
    u32x4 w; w.x = cvt_pk_bf16(x[0], x[1]); w.y = cvt_pk_bf16(x[2], x[3]); w.z = cvt_pk_bf16(y[0], y[1]); w.w = cvt_pk_bf16(y[2], y[3]);
    *(u32x4*)(O + (size_t)row * FF + col0) = w; } };
struct FResAdd { float* X; __device__ __forceinline__ void operator()(int row, int col0, f32x4 a) const {
    f32x4* p = (f32x4*)(X + (size_t)row * D + col0); *p = *p + a; } };


struct FRwIn { h16* R; h16* Kk; h16* V; bf16_t* LH;
    __device__ __forceinline__ void operator()(int row, int col0, f32x4 a, f32x4 b) const {
        const int seg = __builtin_amdgcn_readfirstlane(col0 >> 10);
        if (seg < 3) { const long dK = (const char*)Kk - (const char*)R, dV = (const char*)V - (const char*)R; const long off = (seg == 1 ? dK : 0l) + (seg == 2 ? dV : 0l); h16* dst = (h16*)((char*)R + off); const int c = col0 & 1023;
            u32x4 w; w.x = pk_h16(a[0], a[1]); w.y = pk_h16(a[2], a[3]); w.z = pk_h16(b[0], b[1]); w.w = pk_h16(b[2], b[3]);
            *(u32x4*)(dst + (size_t)row * D + c) = w; }
        else { const int c = col0 - 3072; f32x4 x = a, y = b;
            if (c < 128) {
#pragma unroll
                for (int i = 0; i < 4; ++i) { x[i] = tanhf_(x[i]); y[i] = tanhf_(y[i]); } }
            else if (c >= 256 && c < 512) {
#pragma unroll
                for (int i = 0; i < 4; ++i) { x[i] = sigmoidf_(x[i]); y[i] = sigmoidf_(y[i]); } }
            u32x4 w; w.x = cvt_pk_bf16(x[0], x[1]); w.y = cvt_pk_bf16(x[2], x[3]); w.z = cvt_pk_bf16(y[0], y[1]); w.w = cvt_pk_bf16(y[2], y[3]);
            *(u32x4*)(LH + (size_t)row * 768 + c) = w; }
    } };
struct FLoraW { h16* EW; const float* w0;
    __device__ __forceinline__ void operator()(int row, int col0, f32x4 a, f32x4 b) const {
        const f32x4 p = *(const f32x4*)(w0 + col0), q = *(const f32x4*)(w0 + col0 + 4); float o[8];
#pragma unroll
        for (int i = 0; i < 4; ++i) { o[i] = 0.60653066f * sigmoidf_(p[i] + a[i]); o[4 + i] = 0.60653066f * sigmoidf_(q[i] + b[i]); }
        u32x4 w; w.x = pk_h16(o[0], o[1]); w.y = pk_h16(o[2], o[3]); w.z = pk_h16(o[4], o[5]); w.w = pk_h16(o[6], o[7]);
        *(u32x4*)(EW + (size_t)row * D + col0) = w; } };
struct FLoraA { h16* Aa; const float* a0;
    __device__ __forceinline__ void operator()(int row, int col0, f32x4 a, f32x4 b) const {
        const f32x4 p = *(const f32x4*)(a0 + col0), q = *(const f32x4*)(a0 + col0 + 4); float o[8];
#pragma unroll
        for (int i = 0; i < 4; ++i) { o[i] = sigmoidf_(p[i] + a[i]); o[4 + i] = sigmoidf_(q[i] + b[i]); }
        u32x4 w; w.x = pk_h16(o[0], o[1]); w.y = pk_h16(o[2], o[3]); w.z = pk_h16(o[4], o[5]); w.w = pk_h16(o[6], o[7]);
        *(u32x4*)(Aa + (size_t)row * D + col0) = w; } };
struct FLoraV { h16* V; const h16* VFm; const float* v0;
    __device__ __forceinline__ void operator()(int row, int col0, f32x4 a, f32x4 b) const {
        const f32x4 p = *(const f32x4*)(v0 + col0), q = *(const f32x4*)(v0 + col0 + 4);
        typedef h16 h16x8 __attribute__((ext_vector_type(8)));
        const h16x8 vv = *(const h16x8*)(V + (size_t)row * D + col0), vf = *(const h16x8*)(VFm + (size_t)row * D + col0); float o[8];
#pragma unroll
        for (int i = 0; i < 4; ++i) { float v = (float)vv[i], f = (float)vf[i]; o[i] = v + (f - v) * sigmoidf_(p[i] + a[i]); v = (float)vv[4 + i]; f = (float)vf[4 + i]; o[4 + i] = v + (f - v) * sigmoidf_(q[i] + b[i]); }
        u32x4 w; w.x = pk_h16(o[0], o[1]); w.y = pk_h16(o[2], o[3]); w.z = pk_h16(o[4], o[5]); w.w = pk_h16(o[6], o[7]);
        *(u32x4*)(V + (size_t)row * D + col0) = w; } };
struct FGate { bf16_t* O; const h16* Y;
    __device__ __forceinline__ void operator()(int row, int col0, f32x4 a, f32x4 b) const {
        typedef h16 h16x8 __attribute__((ext_vector_type(8)));
        const h16x8 yy = *(const h16x8*)(Y + (size_t)row * D + col0);
        u32x4 w; w.x = cvt_pk_bf16(a[0] * (float)yy[0], a[1] * (float)yy[1]); w.y = cvt_pk_bf16(a[2] * (float)yy[2], a[3] * (float)yy[3]);
        w.z = cvt_pk_bf16(b[0] * (float)yy[4], b[1] * (float)yy[5]); w.w = cvt_pk_bf16(b[2] * (float)yy[6], b[3] * (float)yy[7]);
        *(u32x4*)(O + (size_t)row * D + col0) = w; } };

template <int CTRL> __device__ __forceinline__ float dppmov(float v) { return __builtin_bit_cast(float, __builtin_amdgcn_update_dpp(0, __builtin_bit_cast(int, v), CTRL, 0xF, 0xF, true)); }
__device__ __forceinline__ float row16_sum(float v) { v += dppmov<0xB1>(v); v += dppmov<0x4E>(v); v += dppmov<0x124>(v); v += dppmov<0x128>(v); return v; }
typedef _Float16 h16x4 __attribute__((ext_vector_type(4)));
__device__ __forceinline__ void h4_to_f(h16x4 u, float* f) { f[0] = (float)u[0]; f[1] = (float)u[1]; f[2] = (float)u[2]; f[3] = (float)u[3]; }
__device__ __forceinline__ void rwkv_scan(const h16* R, const h16* Kk, const h16* V, const h16* EW, const h16* Aa, const float* k_k, const float* k_a, h16* Yraw, int G, int wave, int lane_) {
    int lane = lane_; asm volatile("" : "+v"(lane));
    const int NT = G * NWAVES;
    for (int task = wave * G + (int)blockIdx.x; task < 512; task += NT) {
        const int bh = task >> 4, rg = task & 15, b = bh >> 4, h = bh & 15;
        const int row = lane >> 4, jg = lane & 15, i = rg * 4 + row;
        const int colj = h * 64 + 4 * jg, coli = h * 64 + i;
        float kkc[4], kac[4];
#pragma unroll
        for (int j = 0; j < 4; ++j) { kkc[j] = k_k[colj + j]; kac[j] = k_a[colj + j]; }
        float s[4] = {0.f, 0.f, 0.f, 0.f};
        const size_t base = (size_t)b * S * D;
        const h16* pR = R + base + colj; const h16* pK = Kk + base + colj; const h16* pA = Aa + base + colj; const h16* pE = EW + base + colj; const h16* pV = V + base + coli;
        h16* pY = Yraw + ((size_t)task * S) * 4 + row;
        constexpr int TC = 4;
        h16x4 cr[TC], ck[TC], ca[TC], ce[TC]; h16 cv[TC];
#pragma unroll
        for (int u = 0; u < TC; ++u) { const size_t o = (size_t)u * D; cr[u] = *(const h16x4*)(pR + o); ck[u] = *(const h16x4*)(pK + o); ca[u] = *(const h16x4*)(pA + o); ce[u] = *(const h16x4*)(pE + o); cv[u] = pV[o]; }
        for (int t0 = 0; t0 < S; t0 += TC) {
            const int tn = (t0 + TC < S) ? t0 + TC : t0;
            h16x4 nr[TC], nk[TC], na[TC], ne[TC]; h16 nv[TC];
#pragma unroll
            for (int u = 0; u < TC; ++u) { const size_t o = (size_t)(tn + u) * D; nr[u] = *(const h16x4*)(pR + o); nk[u] = *(const h16x4*)(pK + o); na[u] = *(const h16x4*)(pA + o); ne[u] = *(const h16x4*)(pE + o); nv[u] = pV[o]; }
#pragma unroll
            for (int u = 0; u < TC; ++u) {
                float rv[4], kv[4], av[4], ev[4]; h4_to_f(cr[u], rv); h4_to_f(ck[u], kv); h4_to_f(ca[u], av); h4_to_f(ce[u], ev);
                const float vi = (float)cv[u];
                float kq[4], n2 = 0.f;
#pragma unroll
                for (int j = 0; j < 4; ++j) { kq[j] = kv[j] * kkc[j]; n2 += kq[j] * kq[j]; }
                n2 = row16_sum(n2);
                const float inv = 1.0f / fmaxf(sqrtf(n2), 1e-12f);
                float kkj[4], kt[4], bb[4], w[4], dot = 0.f;
#pragma unroll
                for (int j = 0; j < 4; ++j) { kkj[j] = kq[j] * inv; kt[j] = kv[j] * (1.0f + (av[j] - 1.0f) * kac[j]); bb[j] = kkj[j] * av[j]; w[j] = __expf(-ev[j]); dot += s[j] * kkj[j]; }
                const float sa = -row16_sum(dot);
                float yd = 0.f;
#pragma unroll
                for (int j = 0; j < 4; ++j) { s[j] = s[j] * w[j] + (sa * bb[j] + vi * kt[j]); yd += s[j] * rv[j]; }
                const float y = row16_sum(yd);
                if (jg == 0) pY[(size_t)(t0 + u) * 4] = (h16)y;
            }
#pragma unroll
            for (int u = 0; u < TC; ++u) { cr[u] = nr[u]; ck[u] = nk[u]; ca[u] = na[u]; ce[u] = ne[u]; cv[u] = nv[u]; }
        }
    }
}
constexpr int SC_CS = 32, SC_STEP_F = 5 * 64 + 8, SC_BUF_F = SC_CS * SC_STEP_F;
#define SC_BAR() do { asm volatile("s_waitcnt lgkmcnt(0)" ::: "memory"); __builtin_amdgcn_s_barrier(); asm volatile("" ::: "memory"); } while (0)
__device__ __forceinline__ float wave_sum_dpp(float v) {
    v = row16_sum(v);
    const float a = __builtin_bit_cast(float, __builtin_amdgcn_readlane(__builtin_bit_cast(int, v), 0)), b = __builtin_bit_cast(float, __builtin_amdgcn_readlane(__builtin_bit_cast(int, v), 16));
    const float c = __builtin_bit_cast(float, __builtin_amdgcn_readlane(__builtin_bit_cast(int, v), 32)), d = __builtin_bit_cast(float, __builtin_amdgcn_readlane(__builtin_bit_cast(int, v), 48));
    return (a + b) + (c + d);
}
struct ScRegs { h16 k[8], a[8], e[8], r[8], v[8]; };
__device__ __forceinline__ void sc_load(ScRegs& g, const h16* R, const h16* Kk, const h16* V, const h16* EW, const h16* Aa, size_t base, int c, int pw, int sub, int lane) {
#pragma unroll
    for (int q = 0; q < 8; ++q) { const size_t o = base + (size_t)(c * SC_CS + pw + 4 * q) * D;
        g.k[q] = Kk[o + lane]; g.a[q] = Aa[o + lane]; g.e[q] = EW[o + lane]; g.r[q] = R[o + lane]; g.v[q] = V[o + sub * 8 + (lane & 7)]; }
}
__device__ __forceinline__ void sc_compute(const ScRegs& g, LAS float* sb, int pw, float kkc, float kac, int lane) {
#pragma unroll
    for (int q = 0; q < 8; ++q) {
        const float kv = (float)g.k[q], av = (float)g.a[q], ev = (float)g.e[q], rv = (float)g.r[q]; const float kq = kv * kkc;
        const float n2 = wave_sum_dpp(kq * kq);
        const float kkj = kq * rsqrtf(fmaxf(n2, 1e-24f)); LAS float* p = sb + (pw + 4 * q) * SC_STEP_F;
        p[lane] = kkj; p[64 + lane] = kkj * av; p[128 + lane] = kv * (1.0f + (av - 1.0f) * kac); p[192 + lane] = __expf(-ev); p[256 + lane] = rv; if (lane < 8) p[320 + lane] = (float)g.v[q];
    }
}
__device__ __forceinline__ void rwkv_scan2(const h16* R, const h16* Kk, const h16* V, const h16* EW, const h16* Aa, const float* k_k, const float* k_a, h16* Yraw, LAS unsigned char* lds, int wave, int lane_) {
    int lane = lane_; asm volatile("" : "+v"(lane));
    LAS float* buf = (LAS float*)lds;
    constexpr int NCH = S / SC_CS;
#pragma unroll 1
    for (int vb = (int)blockIdx.x; vb < 256; vb += (int)gridDim.x) {
        const int bh = vb >> 3, sub = vb & 7, b = bh >> 4, h = bh & 15;
        const size_t base = (size_t)b * S * D + h * 64;
        if (wave >= 4) {
            const int pw = wave - 4;
            const float kkc = k_k[h * 64 + lane], kac = k_a[h * 64 + lane];
            ScRegs ga, gb;
            sc_load(ga, R, Kk, V, EW, Aa, base, 0, pw, sub, lane);
            sc_load(gb, R, Kk, V, EW, Aa, base, 1, pw, sub, lane);
            sc_compute(ga, buf, pw, kkc, kac, lane);
            SC_BAR();
#pragma unroll 1
            for (int c = 0; c < NCH; c += 2) {
                { const int c2 = (c + 2 < NCH) ? c + 2 : c; sc_load(ga, R, Kk, V, EW, Aa, base, c2, pw, sub, lane); }
                sc_compute(gb, buf + SC_BUF_F, pw, kkc, kac, lane);
                SC_BAR();
                { const int c3 = (c + 3 < NCH) ? c + 3 : c + 1; sc_load(gb, R, Kk, V, EW, Aa, base, c3, pw, sub, lane); }
                if (c + 2 < NCH) sc_compute(ga, buf, pw, kkc, kac, lane);
                SC_BAR();
            }
            SC_BAR();
        } else if (wave < 2) {
            const int jg = lane & 15, cw = wave;
            float s0 = 0.f, s1 = 0.f, s2 = 0.f, s3 = 0.f;
            SC_BAR();
#pragma unroll 1
            for (int c = 0; c < NCH; ++c) {
                const LAS float* sb = buf + (c & 1) * SC_BUF_F + 4 * jg;
                const LAS float* vb_ = buf + (c & 1) * SC_BUF_F + 320 + cw * 4 + (lane >> 4);
                LAS float* yp = buf + 2 * SC_BUF_F + ((c & 1) * 2 + cw) * (SC_CS * 64) + lane;
                f32x4 kk4 = *(const LAS f32x4*)(sb), bb4 = *(const LAS f32x4*)(sb + 64), kt4 = *(const LAS f32x4*)(sb + 128), w4 = *(const LAS f32x4*)(sb + 192), r4 = *(const LAS f32x4*)(sb + 256); float vi = vb_[0];
#pragma unroll 4
                for (int st = 0; st < SC_CS; ++st) {
                    const int sn = (st + 1 < SC_CS) ? st + 1 : st;
                    const f32x4 nkk = *(const LAS f32x4*)(sb + sn * SC_STEP_F), nbb = *(const LAS f32x4*)(sb + sn * SC_STEP_F + 64), nkt = *(const LAS f32x4*)(sb + sn * SC_STEP_F + 128), nw = *(const LAS f32x4*)(sb + sn * SC_STEP_F + 192), nr4 = *(const LAS f32x4*)(sb + sn * SC_STEP_F + 256);
                    const float nvi = vb_[sn * SC_STEP_F];
                    const float sa = -row16_sum((s0 * kk4[0] + s1 * kk4[1]) + (s2 * kk4[2] + s3 * kk4[3]));
                    s0 = s0 * w4[0] + (sa * bb4[0] + vi * kt4[0]); s1 = s1 * w4[1] + (sa * bb4[1] + vi * kt4[1]);
                    s2 = s2 * w4[2] + (sa * bb4[2] + vi * kt4[2]); s3 = s3 * w4[3] + (sa * bb4[3] + vi * kt4[3]);
                    yp[st * 64] = (s0 * r4[0] + s1 * r4[1]) + (s2 * r4[2] + s3 * r4[3]);
                    kk4 = nkk; bb4 = nbb; kt4 = nkt; w4 = nw; r4 = nr4; vi = nvi;
                }
                SC_BAR();
            }
            SC_BAR();
        } else {
            const int cw = wave - 2;
            h16* pY = Yraw + ((size_t)(bh * 16 + sub * 2 + cw) * S) * 4;
            SC_BAR();
#pragma unroll 1
            for (int c = 0; c <= NCH; ++c) {
                if (c > 0) {
                    const LAS float* yp = buf + 2 * SC_BUF_F + (((c - 1) & 1) * 2 + cw) * (SC_CS * 64);
                    const int st = lane >> 1, r0 = 2 * (lane & 1);
                    float a0 = 0.f, a1 = 0.f;
#pragma unroll
                    for (int q = 0; q < 4; ++q) { const f32x4 x = *(const LAS f32x4*)(yp + st * 64 + r0 * 16 + 4 * q), z = *(const LAS f32x4*)(yp + st * 64 + (r0 + 1) * 16 + 4 * q);
                        a0 += (x[0] + x[1]) + (x[2] + x[3]); a1 += (z[0] + z[1]) + (z[2] + z[3]); }
                    *(unsigned*)(pY + (size_t)((c - 1) * SC_CS + st) * 4 + r0) = pk_h16(a0, a1);
                }
                SC_BAR();
            }
        }
        if (false) {
            SC_BAR();
#pragma unroll 1
            for (int c = 0; c < NCH; ++c) SC_BAR();
        }
    }
}
__device__ __forceinline__ void rwkv_gn(h16* R, const h16* Kk, const h16* V, const h16* Aa, const h16* Yraw, const float* k_a, const float* r_k, const float* ln_w, const float* ln_b, int gw, int NGW, int lane_) {
    int lane = lane_; asm volatile("" : "+v"(lane));
#pragma unroll 2
    for (int idx = gw; idx < M * 16; idx += NGW) {
        const int m = idx >> 4, h = idx & 15, col = h * 64 + lane; const size_t o = (size_t)m * D + col;
        const int bq = m / S, tq = m - bq * S;
        const float y = (float)Yraw[((size_t)((bq * 16 + h) * 16 + (lane >> 2)) * S + tq) * 4 + (lane & 3)], r = (float)R[o], k = (float)Kk[o], a = (float)Aa[o], v = (float)V[o];
        const float kt = k * (1.0f + (a - 1.0f) * k_a[col]);
        const float mu = wave_sum_dpp(y) * (1.f / 64.f); const float d = y - mu; const float var = wave_sum_dpp(d * d) * (1.f / 64.f);
        const float bs = wave_sum_dpp(r * kt * r_k[col]);
        const float yn = d * rsqrtf(var + 64e-5f) * ln_w[col] + ln_b[col];
        R[o] = (h16)(yn + bs * v);
    }
}

constexpr size_t KF_STRIDE = (size_t)NB * 4 * S * 64;
__device__ __forceinline__ float gelu_tanh(float x) { const float u = 0.7978845608f * (x + 0.044715f * x * x * x); return 0.5f * x * (1.0f + tanhf_(u)); }
__device__ __forceinline__ void store_vf8(bf16_t* chunk_base_d, int keyp0  , f32x4 a, f32x4 b) {
    const int tile = keyp0 >> 4, rq0 = (keyp0 & 15) >> 2;
    u32x2 w0, w1; w0.x = cvt_pk_bf16(a[0], a[1]); w0.y = cvt_pk_bf16(a[2], a[3]); w1.x = cvt_pk_bf16(b[0], b[1]); w1.y = cvt_pk_bf16(b[2], b[3]);
    *(u32x2*)(chunk_base_d + 8 * rq0 + 4 * tile) = w0; *(u32x2*)(chunk_base_d + 8 * (rq0 + 1) + 4 * tile) = w1;
}
struct FNsaIn { bf16_t* Q; bf16_t* KF; float* gates; const float* rope;
    __device__ __forceinline__ void operator()(int row, int col0, f32x4 a, f32x4 b) const {
        const int tile = __builtin_amdgcn_readfirstlane(col0 >> 8);
        const int bb = row / S, t = row - bb * S;
        if (tile < 7) {
            f32x4 x = a, y = b;
            if ((col0 & 32) == 0) {
                f32x4 px, py;
#pragma unroll
                for (int i = 0; i < 4; ++i) { px[i] = __shfl_xor(x[i], 16); py[i] = __shfl_xor(y[i], 16); }
                const int d0 = col0 & 63;
                if (d0 < 16) { const f32x4 c0 = *(const f32x4*)(rope + t * 16), c1 = *(const f32x4*)(rope + t * 16 + 4), s0 = *(const f32x4*)(rope + t * 16 + 8), s1 = *(const f32x4*)(rope + t * 16 + 12);
                    if (d0 == 0) { x = x * c0 - px * s0; y = y * c1 - py * s1; } else { x = x * c0 + px * s0; y = y * c1 + py * s1; } }
            }
            if (tile < 4) { x = x * 0.18033688011112042f; y = y * 0.18033688011112042f;
                u32x4 w; w.x = cvt_pk_bf16(x[0], x[1]); w.y = cvt_pk_bf16(x[2], x[3]); w.z = cvt_pk_bf16(y[0], y[1]); w.w = cvt_pk_bf16(y[2], y[3]);
                *(u32x4*)(Q + (size_t)row * D + col0) = w; }
            else { const int idx = tile - 4, g = (col0 & 255) >> 6, d0 = col0 & 63;
                u32x4 w; w.x = cvt_pk_bf16(x[0], x[1]); w.y = cvt_pk_bf16(x[2], x[3]); w.z = cvt_pk_bf16(y[0], y[1]); w.w = cvt_pk_bf16(y[2], y[3]);
                *(u32x4*)(KF + (size_t)idx * KF_STRIDE + ((size_t)(bb * 4 + g) * S + t) * 64 + d0) = w; }
        } else if (tile == 7) { const int g = (col0 & 255) >> 6, d0 = col0 & 63;
            u32x4 w; w.x = cvt_pk_bf16(a[0], a[1]); w.y = cvt_pk_bf16(a[2], a[3]); w.z = cvt_pk_bf16(b[0], b[1]); w.w = cvt_pk_bf16(b[2], b[3]);
            *(u32x4*)(KF + (size_t)3 * KF_STRIDE + ((size_t)(bb * 4 + g) * S + t) * 64 + d0) = w;
        } else { const int c = col0 - 2048;
            if (c < 48) { f32x4 x, y;
#pragma unroll
                for (int i = 0; i < 4; ++i) { x[i] = sigmoidf_(a[i]); y[i] = sigmoidf_(b[i]); }
                *(f32x4*)(gates + (size_t)row * 48 + c) = x; *(f32x4*)(gates + (size_t)row * 48 + c + 4) = y; }
        }
    } };
struct FNsaVT { bf16_t* VF;
    __device__ __forceinline__ void operator()(int row, int col0, f32x4 a, f32x4 b) const {
        const int br = row >> 8, g = (row >> 6) & 3, d = row & 63, bb = col0 / S, t0 = col0 - bb * S;
        bf16_t* base = VF + (size_t)br * KF_STRIDE + (size_t)(bb * 4 + g) * S * 64 + (size_t)(t0 >> 5) * 2048 + d * 32;
        store_vf8(base, t0 & 31, a, b); } };
struct FCmp1 { bf16_t* CH; const float* bias;
    __device__ __forceinline__ void operator()(int row, int col0, f32x4 a, f32x4 b) const {
        const f32x4 p = *(const f32x4*)(bias + col0), q = *(const f32x4*)(bias + col0 + 4); float o[8];
#pragma unroll
        for (int i = 0; i < 4; ++i) { o[i] = gelu_tanh(a[i] + p[i]); o[4 + i] = gelu_tanh(b[i] + q[i]); }
        u32x4 w; w.x = cvt_pk_bf16(o[0], o[1]); w.y = cvt_pk_bf16(o[2], o[3]); w.z = cvt_pk_bf16(o[4], o[5]); w.w = cvt_pk_bf16(o[6], o[7]);
        *(u32x4*)(CH + (size_t)row * 256 + col0) = w; } };
struct FCmp2K { bf16_t* KC;
    __device__ __forceinline__ void operator()(int row, int col0, f32x4 a, f32x4 b) const {
        if (col0 < 64) { u32x4 w; w.x = cvt_pk_bf16(a[0], a[1]); w.y = cvt_pk_bf16(a[2], a[3]); w.z = cvt_pk_bf16(b[0], b[1]); w.w = cvt_pk_bf16(b[2], b[3]);
            *(u32x4*)(KC + (size_t)row * 64 + col0) = w; } } };
struct FCmp2VT { bf16_t* VC;
    __device__ __forceinline__ void operator()(int row, int col0, f32x4 a, f32x4 b) const {
        if (row < 64) { const int bg = col0 >> 10, n0 = col0 & 1023;
            bf16_t* base = VC + (size_t)bg * 65536 + (size_t)(n0 >> 5) * 2048 + row * 32; store_vf8(base, n0 & 31, a, b); } } };

__device__ __forceinline__ f32x4 mfma16(bf16x8 a, bf16x8 b, f32x4 c) { return __builtin_amdgcn_mfma_f32_16x16x32_bf16(a, b, c, 0, 0, 0); }
__device__ __forceinline__ bf16x8 ld8(const bf16_t* p) { return *(const bf16x8*)p; }
__device__ __forceinline__ bf16x8 pack8(f32x4 a, f32x4 b) { u32x4 w; w.x = cvt_pk_bf16(a[0], a[1]); w.y = cvt_pk_bf16(a[2], a[3]); w.z = cvt_pk_bf16(b[0], b[1]); w.w = cvt_pk_bf16(b[2], b[3]); return __builtin_bit_cast(bf16x8, w); }
__device__ __forceinline__ float colmax(float x) { x = fmaxf(x, __shfl_xor(x, 16)); return fmaxf(x, __shfl_xor(x, 32)); }
__device__ __forceinline__ float colsum(float x) { x += __shfl_xor(x, 16); return x + __shfl_xor(x, 32); }
struct AttnState { float m, l; f32x4 o[4]; };
__device__ __forceinline__ void attn_init(AttnState& st) { st.m = -1e30f; st.l = 0.f;
#pragma unroll
    for (int d = 0; d < 4; ++d) st.o[d] = (f32x4){0.f, 0.f, 0.f, 0.f}; }
struct KVChunk { bf16x8 k[4]; bf16x8 v[4]; };
__device__ __forceinline__ void kv_load(KVChunk& B, const bf16_t* kptr, const bf16_t* vptr) {
#pragma unroll
    for (int tl = 0; tl < 2; ++tl) { B.k[tl * 2] = ld8(kptr + tl * 1024); B.k[tl * 2 + 1] = ld8(kptr + tl * 1024 + 32); }
#pragma unroll
    for (int d = 0; d < 4; ++d) B.v[d] = ld8(vptr + d * 512);
}
struct KRange { int klo, span; };
__device__ __forceinline__ KRange krange(int klo, int khi) { KRange r; if (khi < klo) { r.klo = 64; r.span = 0; } else { r.klo = klo; r.span = khi - klo; } return r; }
template <bool MASKED>
__device__ __forceinline__ void attn_chunk_r(AttnState& st, const bf16x8 (&kf)[4], const bf16x8 (&vf)[4], const bf16x8 q0, const bf16x8 q1, KRange kr) {
    f32x4 s[2];
#pragma unroll
    for (int tl = 0; tl < 2; ++tl) { s[tl] = mfma16(kf[tl * 2], q0, (f32x4){0.f, 0.f, 0.f, 0.f}); s[tl] = mfma16(kf[tl * 2 + 1], q1, s[tl]); }
    float mx = -1e30f;
#pragma unroll
    for (int tl = 0; tl < 2; ++tl)
#pragma unroll
        for (int i = 0; i < 4; ++i) { if (MASKED) { const bool v = (unsigned)(tl * 16 + i - kr.klo) <= (unsigned)kr.span; s[tl][i] = v ? s[tl][i] : -1e30f; } mx = fmaxf(mx, s[tl][i]); }
    mx = colmax(mx);
    if (__any(mx > st.m)) {
        const float mnew = fmaxf(st.m, mx), alpha = __builtin_amdgcn_exp2f(st.m - mnew);
        st.l *= alpha; st.m = mnew;
#pragma unroll
        for (int d = 0; d < 4; ++d) st.o[d] = st.o[d] * alpha;
    }
    const float mcur = st.m;
    f32x4 p[2]; float ps = 0.f;
#pragma unroll
    for (int tl = 0; tl < 2; ++tl)
#pragma unroll
        for (int i = 0; i < 4; ++i) { const float e = __builtin_amdgcn_exp2f(s[tl][i] - mcur); p[tl][i] = e; ps += e; }
    st.l += ps;
    const bf16x8 pb = pack8(p[0], p[1]);
#pragma unroll
    for (int d = 0; d < 4; ++d) st.o[d] = mfma16(vf[d], pb, st.o[d]);
}

#define ATT_STEPN(C, idx) do { _Pragma("unroll") for (int gg = 0; gg < NG; ++gg) { if (act(gg, idx)) { \
        if (ff(gg, idx)) attn_chunk_r<false>(gs[gg], C.k, C.v, gq[gg][0], gq[gg][1], KRange{0, 0}); else attn_chunk_r<true>(gs[gg], C.k, C.v, gq[gg][0], gq[gg][1], mf(gg, idx)); } \
        __builtin_amdgcn_sched_barrier(0); } } while (0)
template <int NG, class AddrK, class AddrV, class ActF, class FullF, class MaskF>
__device__ __forceinline__ void attn_chunksN(AttnState (&gs)[NG], const bf16x8 (&gq)[NG][2], int n, AddrK ak, AddrV av, ActF act, FullF ff, MaskF mf) {
    if constexpr (NG <= 2) {
        KVChunk C0, C1;
        if (n > 0) kv_load(C0, ak(0), av(0));
#pragma unroll 1
        for (int i = 0; i < n; i += 2) {
            if (i + 1 < n) kv_load(C1, ak(i + 1), av(i + 1));
            ATT_STEPN(C0, i);
            if (i + 1 < n) {
                if (i + 2 < n) kv_load(C0, ak(i + 2), av(i + 2));
                ATT_STEPN(C1, i + 1);
            }
        }
    } else {
#pragma unroll 1
        for (int i = 0; i < n; ++i) { KVChunk C0; kv_load(C0, ak(i), av(i)); ATT_STEPN(C0, i); }
    }
}

__device__ __forceinline__ void nsa_attention(const bf16_t* Q, const bf16_t* KF, const bf16_t* VF, const bf16_t* KC, const bf16_t* VC, const float* gates, bf16_t* OUT, LAS unsigned char* lds, int G, int wave, int lane_) {
    int lane0 = lane_; asm volatile("" : "+v"(lane0));
    LAS float* imp = (LAS float*)(lds + wave * 18432);
    LAS float* tl = imp;
    LAS int* sel = (LAS int*)(lds + wave * 18432 + 16384);
    LAS unsigned* smask32 = (LAS unsigned*)(lds + wave * 18432 + 16384 + 1088);
    LAS unsigned char* blist = (LAS unsigned char*)(lds + wave * 18432 + 16384 + 1088 + 512);
    const bool xcd_map = (G % 8) == 0;
    const int nslots = xcd_map ? (G >> 3) * NWAVES : G * NWAVES, slot = xcd_map ? ((int)blockIdx.x >> 3) * NWAVES + wave : (int)blockIdx.x * NWAVES + wave;
    const int ntask = xcd_map ? 1024 : 8192;
#pragma unroll 1
    for (int task = slot; task < ntask; task += nslots) {
        int lane = lane0; asm volatile("" : "+v"(lane)); lane &= 63;
        const int col = lane & 15, rq = lane >> 4;
        const int tilei = xcd_map ? task : (task >> 3), bg = xcd_map ? ((int)blockIdx.x & 7) : (task & 7), b = bg >> 2, g = bg & 3, t0 = tilei * 16, t = t0 + col;
        const size_t rowq = (size_t)b * S + t;
        const bf16_t* qrow = Q + rowq * D + (g * 4) * 64 + 8 * rq;
        const float* grow = gates + rowq * 48 + g * 12;
        const int cur_max = (t0 + 15) >> 6;
        int n_end = 4 * (cur_max + 1); if (n_end > 1024) n_end = 1024;
        const int nchunk_c = (n_end + 31) >> 5;
        const bf16_t* kc_l = KC + (size_t)bg * 65536 + (size_t)col * 64 + 8 * rq;
        const bf16_t* vc_l = VC + (size_t)bg * 65536 + (size_t)col * 32 + 8 * rq;
        {
        AttnState gs[4]; bf16x8 gq[4][2];
#pragma unroll
        for (int h = 0; h < 4; ++h) { gq[h][0] = ld8(qrow + h * 64); gq[h][1] = ld8(qrow + h * 64 + 32); attn_init(gs[h]); }
        attn_chunksN<4>(gs, gq, nchunk_c,
            [&](int ci) { return kc_l + (size_t)ci * 2048; }, [&](int ci) { return vc_l + (size_t)ci * 2048; },
            [&](int, int) { return true; },
            [&](int, int ci) { return 16 * (ci * 32 + 31) + 31 <= t0; },
            [&](int, int ci) { const int nhi = (t >= 31) ? ((t - 31) >> 4) : -1; return krange(0, nhi - ci * 32 - 4 * rq); });
        {
            float mc[4], lc[4];
#pragma unroll
            for (int h = 0; h < 4; ++h) { const float lt = colsum(gs[h].l); mc[h] = gs[h].m; lc[h] = (gs[h].m > -1e29f && lt > 0.f) ? 1.0f / lt : 0.f; }
            {
                float carry = 0.f;
#pragma unroll 1
                for (int kc = 0; kc < nchunk_c; ++kc) {
#pragma unroll
                    for (int tt = 0; tt < 2; ++tt) {
                        const bf16x8 k0 = ld8(kc_l + (size_t)kc * 2048 + tt * 1024), k1 = ld8(kc_l + (size_t)kc * 2048 + tt * 1024 + 32);
                        float own = 0.f, p3 = 0.f;
#pragma unroll
                        for (int h = 0; h < 4; ++h) {
                            f32x4 sc = mfma16(k0, gq[h][0], (f32x4){0.f, 0.f, 0.f, 0.f}); sc = mfma16(k1, gq[h][1], sc);
#pragma unroll
                            for (int i = 0; i < 4; ++i) { const int n = kc * 32 + tt * 16 + 4 * rq + i; const float p = (16 * n + 31 <= t) ? __builtin_amdgcn_exp2f(sc[i] - mc[h]) * lc[h] : 0.f; own += p; if (i == 3) p3 += p; }
                        }
                        const float up = __shfl(p3, (lane + 48) & 63);
                        const float add = (rq == 0) ? carry : up;
                        imp[col * 256 + kc * 8 + tt * 4 + rq] = own + add;
                        carry = __shfl(p3, col + 48);
                    }
                }
            }
#pragma unroll 1
            for (int c = 0; c < 16; ++c) {
                const int tc = t0 + c, cur = tc >> 6;
                if (cur < 16) { if (lane <= cur) sel[c * 17 + lane] = lane; if (lane == 0) sel[c * 17 + 16] = cur + 1; }
                else {
                    unsigned key[4];
#pragma unroll
                    for (int jx = 0; jx < 4; ++jx) { const int sb = lane + 64 * jx; const float v = imp[c * 256 + sb]; key[jx] = (sb >= 1 && sb <= cur - 2) ? ((__float_as_uint(v) & 0xFFFFFF00u) | (unsigned)(255 - sb)) : 0u; }
                    if (lane == 0) { sel[c * 17 + 0] = 0; sel[c * 17 + 1] = cur - 1; sel[c * 17 + 2] = cur; sel[c * 17 + 16] = 16; }
#pragma unroll 1
                    for (int r = 0; r < 13; ++r) {
                        unsigned best = max(max(key[0], key[1]), max(key[2], key[3]));
#pragma unroll
                        for (int o = 1; o < 64; o <<= 1) best = max(best, (unsigned)__shfl_xor((int)best, o));
                        if (lane == 0) sel[c * 17 + 3 + r] = 255 - (int)(best & 255u);
#pragma unroll
                        for (int jx = 0; jx < 4; ++jx) if (key[jx] == best) key[jx] = 0u;
                    }
                }
            }
#pragma unroll
            for (int h = 0; h < 4; ++h) { const float gc = grow[h * 3 + 0] * lc[h];
#pragma unroll
                for (int d = 0; d < 4; ++d)
#pragma unroll
                    for (int i = 0; i < 4; ++i) tl[(h * 16 + d * 4 + i) * 64 + lane] = gs[h].o[d][i] * gc; }
        }
        }
        {
            smask32[lane] = 0u; smask32[64 + lane] = 0u;
#pragma unroll
            for (int k4 = 0; k4 < 4; ++k4) { const int pp = lane + 64 * k4, c = pp >> 4, e = pp & 15; if (e < sel[c * 17 + 16]) { const int jb = sel[c * 17 + e]; atomicOr((unsigned*)(smask32 + (jb >> 1)), 1u << (c + 16 * (jb & 1))); } }
            const bf16_t* ks_b = KF + (size_t)1 * KF_STRIDE + (size_t)bg * S * 64 + (size_t)col * 64 + 8 * rq;
            const bf16_t* vs_b = VF + (size_t)bg * S * 64 + (size_t)col * 32 + 8 * rq;
            const int tokl = col >> 2, hd = col & 3;
            {
                int nblk = 0;
#pragma unroll
                for (int k4 = 0; k4 < 4; ++k4) { const int jb = lane + 64 * k4; const unsigned mk = (smask32[jb >> 1] >> (16 * (jb & 1))) & 0xFFFFu;
                    const unsigned long long bal = __ballot(mk != 0u); const int pos = nblk + __popcll(bal & ((1ull << lane) - 1ull)); if (mk != 0u) blist[pos] = (unsigned char)jb; nblk += __popcll(bal); }
                AttnState hs[4]; bf16x8 hq[4][2];
#pragma unroll
                for (int cg = 0; cg < 4; ++cg) { const bf16_t* qp = Q + ((size_t)b * S + t0 + 4 * cg + tokl) * D + (g * 4 + hd) * 64 + 8 * rq; hq[cg][0] = ld8(qp); hq[cg][1] = ld8(qp + 32); attn_init(hs[cg]); }
                auto blk_of = [&](int ci) { return (int)__builtin_amdgcn_readfirstlane((int)blist[ci >> 1]); };
                auto msk_of = [&](int jb) { return (unsigned)__builtin_amdgcn_readfirstlane((int)((smask32[jb >> 1] >> (16 * (jb & 1))) & 0xFFFFu)); };
                const int tb = t0;
                attn_chunksN<4>(hs, hq, nblk * 2,
                    [&](int ci) { return ks_b + (size_t)(blk_of(ci) * 2 + (ci & 1)) * 2048; },
                    [&](int ci) { return vs_b + (size_t)(blk_of(ci) * 2 + (ci & 1)) * 2048; },
                    [&](int cg, int ci) { return ((msk_of(blk_of(ci)) >> (4 * cg)) & 15u) != 0u; },
                    [&](int cg, int ci) { const int jb = blk_of(ci); return ((msk_of(jb) >> (4 * cg)) & 15u) == 15u && jb * 64 + (ci & 1) * 32 + 31 <= tb + 4 * cg; },
                    [&](int cg, int ci) { const int jb = blk_of(ci); const unsigned mk = msk_of(jb); const int tok = 4 * cg + tokl; const int kp0 = jb * 64 + (ci & 1) * 32 + 4 * rq;
                        return krange(0, ((mk >> tok) & 1u) ? (tb + tok - kp0) : -1); });
#pragma unroll
                for (int cg = 0; cg < 4; ++cg) { const int tok = 4 * cg + tokl;
                    const float lt = colsum(hs[cg].l); const float inv = (hs[cg].m > -1e29f && lt > 0.f) ? 1.0f / lt : 0.f;
                    const float gsv = gates[((size_t)b * S + t0 + tok) * 48 + g * 12 + hd * 3 + 1] * inv;
#pragma unroll
                    for (int d = 0; d < 4; ++d)
#pragma unroll
                        for (int i = 0; i < 4; ++i) tl[(hd * 16 + d * 4 + i) * 64 + tok + 16 * rq] += hs[cg].o[d][i] * gsv; }
            }
        }
        {
            int lo = t0 - 511; if (lo < 0) lo = 0; const int c0 = lo >> 5, c1 = (t0 + 15) >> 5;
            const bf16_t* kw_b = KF + (size_t)2 * KF_STRIDE + (size_t)bg * S * 64 + (size_t)col * 64 + 8 * rq;
            const bf16_t* vw_b = VF + (size_t)1 * KF_STRIDE + (size_t)bg * S * 64 + (size_t)col * 32 + 8 * rq;
            {
                AttnState gs[4]; bf16x8 gq[4][2];
#pragma unroll
                for (int h = 0; h < 4; ++h) { gq[h][0] = ld8(qrow + h * 64); gq[h][1] = ld8(qrow + h * 64 + 32); attn_init(gs[h]); }
                attn_chunksN<4>(gs, gq, c1 - c0 + 1,
                    [&](int ci) { return kw_b + (size_t)(c0 + ci) * 2048; }, [&](int ci) { return vw_b + (size_t)(c0 + ci) * 2048; },
                    [&](int, int) { return true; },
                    [&](int, int ci) { return (c0 + ci) * 32 + 31 <= t0 && (c0 + ci) * 32 + 512 > t0 + 15; },
                    [&](int, int ci) { const int cb = (c0 + ci) * 32 + 4 * rq; return krange(t - 511 - cb, t - cb); });
#pragma unroll
                for (int h = 0; h < 4; ++h) { const float lt = colsum(gs[h].l); const float inv = (gs[h].m > -1e29f && lt > 0.f) ? 1.0f / lt : 0.f; const float gwv = grow[h * 3 + 2] * inv;
#pragma unroll
                    for (int d = 0; d < 4; ++d)
#pragma unroll
                        for (int i = 0; i < 4; ++i) tl[(h * 16 + d * 4 + i) * 64 + lane] += gs[h].o[d][i] * gwv; }
            }
        }
#pragma unroll
        for (int h = 0; h < 4; ++h)
#pragma unroll
            for (int d = 0; d < 4; ++d) { float v4[4];
#pragma unroll
                for (int i = 0; i < 4; ++i) v4[i] = tl[(h * 16 + d * 4 + i) * 64 + lane];
                u32x2 w; w.x = cvt_pk_bf16(v4[0], v4[1]); w.y = cvt_pk_bf16(v4[2], v4[3]);
                *(u32x2*)(OUT + rowq * D + (g * 4 + h) * 64 + d * 16 + 4 * rq) = w; }
    }
}

#define GSYNC() do { asm volatile("s_waitcnt vmcnt(0)" ::: "memory"); __builtin_amdgcn_fence(__ATOMIC_RELEASE, "agent"); grid.sync(); __builtin_amdgcn_fence(__ATOMIC_ACQUIRE, "agent"); } while (0)
__global__ void __launch_bounds__(NTHREADS, 2) fwd_kernel(Params P) {
    extern __shared__ __attribute__((aligned(16))) unsigned char lds_raw[];
    LAS unsigned char* lds = (LAS unsigned char*)lds_raw;
    cg::grid_group grid = cg::this_grid();
    int tidv = threadIdx.x;
    const int wave = __builtin_amdgcn_readfirstlane(tidv >> 6);
    const int G = gridDim.x, gw_k = blockIdx.x * NWAVES + wave, NGW = G * NWAVES;
    unsigned char* ws = P.ws;
    float* xres = P.out;
    LAS float* scr = (LAS float*)(lds + wave * 16384);
    const float* x_in = P.in[0];
    const float* norm_mix = P.in[1]; const float* norm_mlp = P.in[2]; const float* norm_final = P.in[3];
    const float* mlp_w1 = P.in[4]; const float* mlp_w2 = P.in[5];

    for (int layer = 0; layer < 4; ++layer) {
        int lane = tidv; asm volatile("" : "+v"(lane)); lane &= 63;
        int gw = gw_k; asm volatile("" : "+s"(gw));
        const bool is_rwkv = (layer & 1) != 0; const int lj = layer >> 1;
        const float* xsrc = (layer == 0) ? x_in : xres;
        {
            TJob j1{mlp_w1 + (size_t)layer * D * FF, FF, 0, FF, D, (bf16_t*)(ws + WS_W + W_MLP1), D, 0, 0, FF, D, nullptr, 0};
            transpose_job(j1, scr, gw, NGW, lane);
            TJob j2{mlp_w2 + (size_t)layer * FF * D, D, 0, D, FF, (bf16_t*)(ws + WS_W + W_MLP2), FF, 0, 0, D, FF, nullptr, 0};
            transpose_job(j2, scr, gw, NGW, lane);
            if (is_rwkv) {
                const float* mix = P.in[14] + (size_t)lj * 6 * D;
                bf16_t* WrT = (bf16_t*)(ws + WS_W + W_RW_IN);
                const float* wrkv = P.in[15] + (size_t)lj * 3 * D * D;
                for (int part = 0; part < 8; ++part) {
                    const float* W; int ldw, Nsrc, mi, r0, Npad;
                    if (part == 0) { W = wrkv; ldw = D; Nsrc = D; mi = 0; r0 = 0; Npad = D; }
                    else if (part == 1) { W = wrkv + (size_t)D * D; ldw = D; Nsrc = D; mi = 2; r0 = 1024; Npad = D; }
                    else if (part == 2) { W = wrkv + (size_t)2 * D * D; ldw = D; Nsrc = D; mi = 3; r0 = 2048; Npad = D; }
                    else if (part == 3) { W = P.in[17] + (size_t)lj * D * 64; ldw = 64; Nsrc = 64; mi = 1; r0 = 3072; Npad = 128; }
                    else if (part == 4) { W = P.in[20] + (size_t)lj * D * 64; ldw = 64; Nsrc = 64; mi = 4; r0 = 3200; Npad = 128; }
                    else if (part == 5) { W = P.in[22] + (size_t)lj * D * 160; ldw = 160; Nsrc = 160; mi = 5; r0 = 3328; Npad = 256; }
                    else if (part == 6) { W = P.in[31]; ldw = 32; Nsrc = (lj >= 1) ? 32 : 0; mi = 3; r0 = 3584; Npad = 128; }
                    else { W = P.in[31]; ldw = 32; Nsrc = 0; mi = 3; r0 = 3712; Npad = 128; }
                    TJob ja{W, ldw, 0, Nsrc, D, WrT, 2048, r0, 0, Npad, D, mix + mi * D, 1};
                    transpose_job(ja, scr, gw, NGW, lane);
                    TJob jb{W, ldw, 0, Nsrc, D, WrT, 2048, r0, 1024, Npad, D, mix + mi * D, 2};
                    transpose_job(jb, scr, gw, NGW, lane);
                }
                TJob jw{P.in[18] + (size_t)lj * 64 * D, D, 0, D, 64, (bf16_t*)(ws + WS_W + W_RW_W2), 128, 0, 0, D, 128, nullptr, 0}; transpose_job(jw, scr, gw, NGW, lane);
                TJob jaa{P.in[21] + (size_t)lj * 64 * D, D, 0, D, 64, (bf16_t*)(ws + WS_W + W_RW_A2), 128, 0, 0, D, 128, nullptr, 0}; transpose_job(jaa, scr, gw, NGW, lane);
                TJob jv{P.in[32], D, 0, D, (lj >= 1) ? 32 : 0, (bf16_t*)(ws + WS_W + W_RW_V2), 128, 0, 0, D, 128, nullptr, 0}; transpose_job(jv, scr, gw, NGW, lane);
                TJob jg{P.in[23] + (size_t)lj * 160 * D, D, 0, D, 160, (bf16_t*)(ws + WS_W + W_RW_G2), 256, 0, 0, D, 256, nullptr, 0}; transpose_job(jg, scr, gw, NGW, lane);
                TJob jo{P.in[29] + (size_t)lj * D * D, D, 0, D, D, (bf16_t*)(ws + WS_W + W_RW_O), D, 0, 0, D, D, nullptr, 0}; transpose_job(jo, scr, gw, NGW, lane);
                bf16_t* HN = (bf16_t*)(ws + A_HN);
                if (gw < 2) { u32x4* z = (u32x4*)(HN + (size_t)gw * (S + 1) * D); unsigned zz; asm volatile("v_mov_b32 %0, 0" : "=v"(zz)); for (int q = lane; q < D / 8; q += 64) z[q] = (u32x4){zz, zz, zz, zz}; }
                for (int m = gw; m < M; m += NGW) { const int b = m / S; rms_row_bf16(xsrc + (size_t)m * D, norm_mix + layer * D, HN + ((size_t)m + b + 1) * D, nullptr, lane); }
            } else {
                const float* win = P.in[6] + (size_t)lj * D * 2608;
                bf16_t* WnT = (bf16_t*)(ws + WS_W + W_NSA_IN); bf16_t* WvT = (bf16_t*)(ws + WS_W + W_NSA_V);
                for (int part = 0; part < 8; ++part) {
                    int n0src, Nsrc, r0, Npad; bf16_t* WT = WnT;
                    if (part == 0) { n0src = 0; Nsrc = 1024; r0 = 0; Npad = 1024; }
                    else if (part == 1) { n0src = 1024; Nsrc = 256; r0 = 1024; Npad = 256; }
                    else if (part == 2) { n0src = 1024 + 512; Nsrc = 256; r0 = 1280; Npad = 256; }
                    else if (part == 3) { n0src = 1024 + 1024; Nsrc = 256; r0 = 1536; Npad = 256; }
                    else if (part == 4) { n0src = 1024 + 256; Nsrc = 256; r0 = 1792; Npad = 256; }
                    else if (part == 5) { n0src = 2560; Nsrc = 48; r0 = 2048; Npad = 256; }
                    else if (part == 6) { n0src = 1024 + 768; Nsrc = 256; r0 = 0; Npad = 256; WT = WvT; }
                    else { n0src = 1024 + 1280; Nsrc = 256; r0 = 256; Npad = 256; WT = WvT; }
                    TJob jn{win, 2608, n0src, Nsrc, D, WT, D, r0, 0, Npad, D, nullptr, 0}; transpose_job(jn, scr, gw, NGW, lane);
                }
                TJob jo{P.in[13] + (size_t)lj * D * D, D, 0, D, D, (bf16_t*)(ws + WS_W + W_NSA_O), D, 0, 0, D, D, nullptr, 0}; transpose_job(jo, scr, gw, NGW, lane);
                TJob jc1k{P.in[8] + (size_t)lj * 2048 * 256, 256, 0, 256, 2048, (bf16_t*)(ws + WS_W + W_C1K), 2048, 0, 0, 256, 2048, nullptr, 0}; transpose_job(jc1k, scr, gw, NGW, lane);
                TJob jc1v{P.in[11] + (size_t)lj * 2048 * 256, 256, 0, 256, 2048, (bf16_t*)(ws + WS_W + W_C1V), 2048, 0, 0, 256, 2048, nullptr, 0}; transpose_job(jc1v, scr, gw, NGW, lane);
                TJob jc2k{P.in[9] + (size_t)lj * 256 * 64, 64, 0, 64, 256, (bf16_t*)(ws + WS_W + W_C2K), 256, 0, 0, 256, 256, nullptr, 0}; transpose_job(jc2k, scr, gw, NGW, lane);
                TJob jc2v{P.in[12] + (size_t)lj * 256 * 64, 64, 0, 64, 256, (bf16_t*)(ws + WS_W + W_C2V), 256, 0, 0, 256, 256, nullptr, 0}; transpose_job(jc2v, scr, gw, NGW, lane);
                {
                    int ln = lane; asm volatile("" : "+v"(ln));
                    float* cb = (float*)(ws + WS_W + W_CBIAS);
#pragma unroll 1
                    for (int o = gw; o < 512; o += NGW) { const int isv = o >> 8, c = o & 255;
                        const float* pe = (isv ? P.in[10] : P.in[7]) + (size_t)lj * 2048; const float* w1 = (isv ? P.in[11] : P.in[8]) + (size_t)lj * 2048 * 256;
                        float acc = 0.f;
#pragma unroll 1
                        for (int k = ln; k < 2048; k += 64) acc += pe[k] * w1[(size_t)k * 256 + c];
                        acc = wave_sum(acc); if (ln == 0) cb[o] = acc; }
                    if (layer == 0) {
                        float* rt = (float*)(ws + WS_ROPE);
                        int tix = tidv; asm volatile("" : "+v"(tix)); const int gt = (int)blockIdx.x * NTHREADS + tix;
#pragma unroll 1
                        for (int e = gt; e < S * 8; e += G * NTHREADS) { const int tt = e >> 3, i = e & 7;
                            const float invf = (i == 0) ? 1.0f : (i == 1) ? 0.1939227432012558f : (i == 2) ? 0.03760603070259094f : (i == 3) ? 0.007292664609849453f : (i == 4) ? 0.0014142135623842478f : (i == 5) ? 0.00027424818836152554f : (i == 6) ? 5.318296098266728e-05f : 1.0313386155758053e-05f;
                            const float ang = (float)tt * invf; const double rev = (double)ang * 0.15915494309189535; const float fr = (float)(rev - __builtin_rint(rev));
                            rt[tt * 16 + i] = __builtin_amdgcn_cosf(fr); rt[tt * 16 + 8 + i] = __builtin_amdgcn_sinf(fr); }
                    }
                }
                for (int m = gw; m < M; m += NGW) rms_row_bf16(xsrc + (size_t)m * D, norm_mix + layer * D, (bf16_t*)(ws + A_HN) + (size_t)m * D, (layer == 0) ? xres + (size_t)m * D : nullptr, lane);
            }
        }
        GSYNC();
        if (!is_rwkv) {
            bf16_t* HN = (bf16_t*)(ws + A_HN); bf16_t* Qb = (bf16_t*)(ws + A_Q); bf16_t* KFb = (bf16_t*)(ws + A_KF); bf16_t* VFb = (bf16_t*)(ws + A_VF);
            float* GT = (float*)(ws + A_GATES); bf16_t* CHK = (bf16_t*)(ws + A_CHK); bf16_t* CHV = (bf16_t*)(ws + A_CHV); bf16_t* KCb = (bf16_t*)(ws + A_KC); bf16_t* VCb = (bf16_t*)(ws + A_VC);
            {
                pg8::Gemm g{HN, (const bf16_t*)(ws + WS_W + W_NSA_IN), M, 2304, D, D, D, 0};
                pg8::StaticOrder so; so.init(M, 2304, G, (int)blockIdx.x);
                pg8::EpiP<FNsaIn> E{FNsaIn{Qb, KFb, GT, (const float*)(ws + WS_ROPE)}};
                pg8::gemm_phase<pg8::EpiP<FNsaIn>, true>(lds, g, so, E, tidv);
                pg8::Gemm g2{(const bf16_t*)(ws + WS_W + W_NSA_V), HN, 512, M, D, D, D, 0};
                pg8::StaticOrder so2; so2.init(512, M, G, (int)blockIdx.x);
                pg8::EpiP<FNsaVT> E2{FNsaVT{VFb}};
                pg8::gemm_phase<pg8::EpiP<FNsaVT>, true>(lds, g2, so2, E2, tidv);
            }
            GSYNC();
            {
                pg8::StaticOrder so; so.init(8192, 256, G, (int)blockIdx.x);
                { pg8::Gemm g{KFb, (const bf16_t*)(ws + WS_W + W_C1K), 8192, 256, 2048, 1024, 2048, 0}; pg8::EpiP<FCmp1> E{FCmp1{CHK, (const float*)(ws + WS_W + W_CBIAS)}}; pg8::gemm_phase<pg8::EpiP<FCmp1>, true>(lds, g, so, E, tidv); }
                { pg8::Gemm g{KFb + 3 * KF_STRIDE, (const bf16_t*)(ws + WS_W + W_C1V), 8192, 256, 2048, 1024, 2048, 0}; pg8::EpiP<FCmp1> E{FCmp1{CHV, (const float*)(ws + WS_W + W_CBIAS) + 256}}; pg8::gemm_phase<pg8::EpiP<FCmp1>, true>(lds, g, so, E, tidv); }
            }
            GSYNC();
            {
                { pg8::StaticOrder so; so.init(8192, 256, G, (int)blockIdx.x); pg8::Gemm g{CHK, (const bf16_t*)(ws + WS_W + W_C2K), 8192, 256, 256, 256, 256, 0}; pg8::EpiP<FCmp2K> E{FCmp2K{KCb}}; pg8::gemm_phase<pg8::EpiP<FCmp2K>, true>(lds, g, so, E, tidv); }
                { pg8::StaticOrder so; so.init(256, 8192, G, (int)blockIdx.x); pg8::Gemm g{(const bf16_t*)(ws + WS_W + W_C2V), CHV, 256, 8192, 256, 256, 256, 0}; pg8::EpiP<FCmp2VT> E{FCmp2VT{VCb}}; pg8::gemm_phase<pg8::EpiP<FCmp2VT>, true>(lds, g, so, E, tidv); }
            }
            GSYNC();
            nsa_attention(Qb, KFb, VFb, KCb, VCb, GT, HN, lds, G, wave, lane_id());
            tidv = wave * 64 + (lane_id() & 63); asm volatile("" : "+v"(tidv)); tidv &= 511; lane = tidv & 63;
            GSYNC();
            {
                pg8::StaticOrder so; so.init(M, D, G, (int)blockIdx.x);
                pg8::Gemm g{HN, (const bf16_t*)(ws + WS_W + W_NSA_O), M, D, D, D, D, 0}; pg8::EpiN<FResAdd> E{FResAdd{xres}}; pg8::gemm_phase<pg8::EpiN<FResAdd>, true>(lds, g, so, E, tidv);
            }
            GSYNC();
        }
        if (is_rwkv) {
            h16* Rb = (h16*)(ws + A_R); h16* Kb = (h16*)(ws + A_K); h16* Ab = (h16*)(ws + A_A); h16* EWb = (h16*)(ws + A_HN);
            h16* Vb = (lj == 0) ? (h16*)(ws + WS_VF) : (h16*)(ws + A_V2);
            h16* Yraw = (lj == 0) ? (h16*)(ws + A_V2) : (h16*)(ws + WS_VF);
            bf16_t* LH = (bf16_t*)(ws + A_LH);
            {
                pg8::Gemm g{(const bf16_t*)(ws + A_HN), (const bf16_t*)(ws + WS_W + W_RW_IN), M, 3840, 2048, D, 2048, 1};
                pg8::StaticOrder so; so.init(M, 3840, G, (int)blockIdx.x);
                pg8::EpiP<FRwIn> E{FRwIn{Rb, Kb, Vb, LH}};
                pg8::gemm_phase<pg8::EpiP<FRwIn>, true>(lds, g, so, E, tidv);
            }
            GSYNC();
            {
                pg8::StaticOrder so; so.init(M, D, G, (int)blockIdx.x);
                { pg8::Gemm g{LH, (const bf16_t*)(ws + WS_W + W_RW_W2), M, D, 128, 768, 128, 0}; pg8::EpiP<FLoraW> E{FLoraW{EWb, P.in[16] + lj * D}}; pg8::gemm_phase<pg8::EpiP<FLoraW>, true>(lds, g, so, E, tidv); }
                { pg8::Gemm g{LH + 128, (const bf16_t*)(ws + WS_W + W_RW_A2), M, D, 128, 768, 128, 0}; pg8::EpiP<FLoraA> E{FLoraA{Ab, P.in[19] + lj * D}}; pg8::gemm_phase<pg8::EpiP<FLoraA>, true>(lds, g, so, E, tidv); }
                if (lj >= 1) { pg8::Gemm g{LH + 512, (const bf16_t*)(ws + WS_W + W_RW_V2), M, D, 128, 768, 128, 0}; pg8::EpiP<FLoraV> E{FLoraV{Vb, (const h16*)(ws + WS_VF), P.in[30]}}; pg8::gemm_phase<pg8::EpiP<FLoraV>, true>(lds, g, so, E, tidv); }
            }
            GSYNC();
            rwkv_scan2(Rb, Kb, Vb, EWb, Ab, P.in[24] + lj * D, P.in[25] + lj * D, Yraw, lds, wave, lane);
            GSYNC();
            rwkv_gn(Rb, Kb, Vb, Ab, Yraw, P.in[25] + lj * D, P.in[26] + lj * D, P.in[27] + lj * D, P.in[28] + lj * D, gw, NGW, lane);
            GSYNC();
            {
                pg8::StaticOrder so; so.init(M, D, G, (int)blockIdx.x);
                pg8::Gemm g{LH + 256, (const bf16_t*)(ws + WS_W + W_RW_G2), M, D, 256, 768, 256, 0}; pg8::EpiP<FGate> E{FGate{(bf16_t*)Kb, Rb}}; pg8::gemm_phase<pg8::EpiP<FGate>, true>(lds, g, so, E, tidv);
            }
            GSYNC();
            {
                pg8::StaticOrder so; so.init(M, D, G, (int)blockIdx.x);
                pg8::Gemm g{(const bf16_t*)Kb, (const bf16_t*)(ws + WS_W + W_RW_O), M, D, D, D, D, 0}; pg8::EpiN<FResAdd> E{FResAdd{xres}}; pg8::gemm_phase<pg8::EpiN<FResAdd>, true>(lds, g, so, E, tidv);
            }
            GSYNC();
        }
        for (int m = gw; m < M; m += NGW) rms_row_bf16(xres + (size_t)m * D, norm_mlp + layer * D, (bf16_t*)(ws + A_HN) + (size_t)m * D, nullptr, lane);
        GSYNC();
        {
            pg8::Gemm g{(const bf16_t*)(ws + A_HN), (const bf16_t*)(ws + WS_W + W_MLP1), M, FF, D, D, D, 0};
            pg8::StaticOrder so; so.init(M, FF, G, (int)blockIdx.x);
            pg8::EpiP<FRelu2> E{FRelu2{(bf16_t*)(ws + A_HID)}};
            pg8::gemm_phase<pg8::EpiP<FRelu2>, true>(lds, g, so, E, tidv);
        }
        GSYNC();
        {
            pg8::Gemm g{(const bf16_t*)(ws + A_HID), (const bf16_t*)(ws + WS_W + W_MLP2), M, D, FF, FF, FF, 0};
            pg8::StaticOrder so; so.init(M, D, G, (int)blockIdx.x);
            pg8::EpiN<FResAdd> E{FResAdd{xres}};
            pg8::gemm_phase<pg8::EpiN<FResAdd>, true>(lds, g, so, E, tidv);
        }
        GSYNC();
    }
    for (int m = gw_k; m < M; m += NGW) {
        int lane2 = tidv; asm volatile("" : "+v"(lane2)); lane2 &= 63;
        f32x4* xr = (f32x4*)(xres + (size_t)m * D) + lane2; const f32x4* gr = (const f32x4*)norm_final + lane2;
        f32x4 v[4]; float s = 0.f;
#pragma unroll
        for (int j = 0; j < 4; ++j) { v[j] = xr[64 * j]; s += (v[j].x * v[j].x + v[j].y * v[j].y) + (v[j].z * v[j].z + v[j].w * v[j].w); }
        const float r = rsqrtf(wave_sum(s) * (1.f / D) + 1e-5f);
#pragma unroll
        for (int j = 0; j < 4; ++j) { const f32x4 gg = gr[64 * j]; xr[64 * j] = v[j] * r * gg; }
    }
}

extern "C" void kernel_launch(void* const* d_in, const int* in_sizes, int n_in, void* d_out, int out_size, void* d_ws, size_t ws_size, hipStream_t stream) {
    static int grid = 0;
    if (grid == 0) {
        if (n_in != 33 || out_size != M * D || ws_size < WS_NEED) { fprintf(stderr, "kernel_launch: unexpected sizes n_in %d out %d ws %zu (need %zu)\n", n_in, out_size, ws_size, (size_t)WS_NEED); grid = -1; return; }
        int dev = 0, cus = 0, per_cu = 0;
        hipGetDevice(&dev);
        hipDeviceGetAttribute(&cus, hipDeviceAttributeMultiprocessorCount, dev);
        if (hipFuncSetAttribute((const void*)fwd_kernel, hipFuncAttributeMaxDynamicSharedMemorySize, LDS_BYTES) != hipSuccess) { fprintf(stderr, "hipFuncSetAttribute failed\n"); grid = -1; return; }
        hipOccupancyMaxActiveBlocksPerMultiprocessor(&per_cu, (const void*)fwd_kernel, NTHREADS, LDS_BYTES);
        if (per_cu < 1) { fprintf(stderr, "occupancy query returned %d\n", per_cu); per_cu = 1; }
        (void)hipGetLastError();
        grid = cus * 1;
    }
    if (grid < 0) return;
    Params p{};
    for (int i = 0; i < 33; ++i) p.in[i] = (const float*)d_in[i];
    p.out = (float*)d_out; p.ws = (unsigned char*)d_ws;
    void* args[] = {&p};
    hipError_t e = hipLaunchCooperativeKernel((const void*)fwd_kernel, dim3(grid), dim3(NTHREADS), args, LDS_BYTES, stream);
    if (e != hipSuccess) fprintf(stderr, "cooperative launch failed: %s (grid %d)\n", hipGetErrorString(e), grid);
}
```

```cpp
#include <hip/hip_runtime.h>
#include <hip/hip_cooperative_groups.h>
#include <cstdio>
#include <cstdint>
namespace cg = cooperative_groups;

#define LAS __attribute__((address_space(3)))
typedef unsigned short bf16_t;
typedef short bf16x8 __attribute__((ext_vector_type(8)));
typedef float f32x4 __attribute__((ext_vector_type(4)));
typedef float f32x2 __attribute__((ext_vector_type(2)));
typedef unsigned u32x4 __attribute__((ext_vector_type(4)));
typedef unsigned u32x2 __attribute__((ext_vector_type(2)));
typedef _Float16 h16;
typedef _Float16 h16x2 __attribute__((ext_vector_type(2)));

constexpr int S = 16384, NB = 2, M = NB * S, D = 1024, FF = 4096;
constexpr int NWAVES = 8, NTHREADS = 512;
constexpr int LDS_BYTES = 147456;
constexpr size_t MiB = 1u << 20;
constexpr size_t WS_W = 0;
constexpr size_t W_MLP1 = 0, W_MLP2 = 8 * MiB;
constexpr size_t W_NSA_IN = 16 * MiB, W_NSA_V = 21 * MiB, W_NSA_O = 22 * MiB, W_C1K = 24 * MiB, W_C1V = 25 * MiB, W_C2K = 26 * MiB, W_C2V = 26 * MiB + 256 * 1024, W_CBIAS = 26 * MiB + 512 * 1024;
constexpr size_t W_RW_IN = 16 * MiB, W_RW_W2 = 31 * MiB, W_RW_A2 = 31 * MiB + 256 * 1024, W_RW_V2 = 31 * MiB + 512 * 1024, W_RW_G2 = 31 * MiB + 768 * 1024, W_RW_O = 33 * MiB;
constexpr size_t WS_ROPE = 36 * MiB;
constexpr size_t WS_VF = 40 * MiB;
constexpr size_t ACT = 104 * MiB;
constexpr size_t A_HN = ACT;
constexpr size_t A_Q = ACT + 65 * MiB;
constexpr size_t A_KF = ACT + 129 * MiB;
constexpr size_t A_VF = ACT + 194 * MiB;
constexpr size_t A_GATES = ACT + 226 * MiB;
constexpr size_t A_CHK = ACT + 233 * MiB, A_CHV = ACT + 237 * MiB, A_KC = ACT + 241 * MiB, A_VC = ACT + 242 * MiB;
constexpr size_t A_HID = ACT + 65 * MiB;
constexpr size_t A_R = ACT + 65 * MiB, A_K = ACT + 129 * MiB, A_V2 = ACT + 193 * MiB, A_A = ACT + 257 * MiB, A_LH = ACT + 321 * MiB;
constexpr size_t WS_NEED = ACT + 370 * MiB;

__device__ __forceinline__ int lane_id() { return (int)__builtin_amdgcn_mbcnt_hi(~0u, __builtin_amdgcn_mbcnt_lo(~0u, 0u)); }
__device__ __forceinline__ unsigned cvt_pk_bf16(float lo, float hi) { unsigned r; asm volatile("v_cvt_pk_bf16_f32 %0, %1, %2" : "=v"(r) : "v"(lo), "v"(hi)); return r; }
__device__ __forceinline__ unsigned pk_h16(float lo, float hi) { h16x2 v; v.x = (h16)lo; v.y = (h16)hi; return __builtin_bit_cast(unsigned, v); }
__device__ __forceinline__ float bf2f(bf16_t b) { return __uint_as_float(((unsigned)b) << 16); }
__device__ __forceinline__ float wave_sum(float v) {
#pragma unroll
    for (int o = 1; o < 64; o <<= 1) v += __shfl_xor(v, o);
    return v;
}
__device__ __forceinline__ float sigmoidf_(float x) { return 1.0f / (1.0f + __expf(-x)); }
__device__ __forceinline__ float tanhf_(float x) { float e = __expf(-2.0f * fabsf(x)); float t = (1.0f - e) / (1.0f + e); return x < 0.f ? -t : t; }

namespace pg8 {
constexpr int BM = 256, BK = 64, HALF = 128, HTB = HALF * BK * 2, STAGE_BYTES = 8 * HTB, NXCD = 8, WGM = 8;
__host__ __device__ __forceinline__ int lds_byte(int r, int c) { const int st = (r >> 4) * 2 + (c >> 5), rr = r & 15, cc = c & 31, ob = rr * 64 + cc * 2; return st * 1024 + (ob ^ (((ob >> 9) & 1) << 5)); }
__host__ __device__ __forceinline__ void stage_rc(int b, int& R, int& C) { const int st = b / 1024, sb = b % 1024, swz = sb ^ (((sb >> 9) & 1) << 5); R = (st >> 1) * 16 + swz / 64; C = (st & 1) * 32 + (swz % 64) / 2; }
__host__ __device__ __forceinline__ int perm32(int rho) { const int n = rho >> 4, i = rho & 15; return 8 * (i >> 2) + 4 * n + (i & 3); }
struct Unit { int pm, pn; };
struct Gemm { const bf16_t* A; const bf16_t* Bt; int M, N, K, lda, ldb, amode; };
struct StaticOrder {
    int nM, nN, nwg, G, c;
    __device__ void init(int M_, int N_, int G_, int c_) { nM = M_ / BM; nN = N_ / BM; nwg = nM * nN; G = G_; c = c_; }
    __device__ bool next(int i, Unit& u) const {
        const long L = (long)i * G + c; if (L >= nwg) return false;
        int wgid = (int)L; { const int q = nwg / NXCD, r = nwg % NXCD, xcd = wgid % NXCD, off = wgid / NXCD; wgid = (xcd < r ? xcd * (q + 1) : r * (q + 1) + (xcd - r) * q) + off; }
        const int nig = WGM * nN, gid = wgid / nig, fm = gid * WGM, gsz = (nM - fm) < WGM ? (nM - fm) : WGM;
        u.pm = fm + ((wgid % nig) % gsz); u.pn = (wgid % nig) / gsz; return true;
    }
};
__device__ __forceinline__ const char* a_base(const Gemm& g, int pm) { const size_t row = (size_t)pm * BM + (g.amode == 1 ? (size_t)(pm / 64) : 0); return (const char*)g.A + row * (size_t)g.lda * 2; }

template <class Epi, bool ALIGN_EPI>
__device__ __forceinline__ void gemm_phase(LAS unsigned char* lds, const Gemm g, const StaticOrder& S, const Epi& E, int tid_in) {
    int tid = tid_in; asm volatile("" : "+v"(tid));
    const int wid = __builtin_amdgcn_readfirstlane(tid >> 6), lane = tid & 63, wr = wid >> 2, wc = wid & 3, fr = lane & 15, fq = lane >> 4;
    int K = g.K; asm volatile("" : "+s"(K));
    const int nt = K / BK;
    unsigned voffA[2], voffB[2];
#pragma unroll
    for (int i = 0; i < 2; ++i) { int R, C; stage_rc(tid * 16 + i * 8192, R, C); const int Rb = Epi::PERM ? ((R & ~31) + perm32(R & 31)) : R;
        voffA[i] = (unsigned)(R * g.lda + C) * 2u; voffB[i] = (unsigned)(Rb * g.ldb + C) * 2u; }
    const size_t kstep = (size_t)(BK * 2);
    const size_t hstepA = (size_t)HALF * g.lda * 2, hstepB = (size_t)HALF * g.ldb * 2;
    const size_t tstepB = 2 * hstepB;
    const unsigned ldsw = (unsigned)wid * 1024u;
    const int aoff = lds_byte(wr * 64 + fr, fq * 8), boff = lds_byte(wc * 32 + fr, fq * 8);
#define PG8_SA(b, h) (((b) * 2 + (h)) * HTB)
#define PG8_SB(b, h) ((4 + (b) * 2 + (h)) * HTB)
#define PG8_STAGE(bufoff, gbase, voff) do { _Pragma("unroll") for (int _i = 0; _i < 2; ++_i) \
        __builtin_amdgcn_global_load_lds((const unsigned*)((const char*)(gbase) + (voff)[_i]), (LAS unsigned*)(lds + (bufoff) + ldsw + _i * 8192), 16, 0, 0); } while (0)
#define PG8_LDA(dst, b, h) do { _Pragma("unroll") for (int m = 0; m < 4; ++m) _Pragma("unroll") for (int k = 0; k < 2; ++k) dst[m][k] = *(const LAS bf16x8*)(lds + PG8_SA(b, h) + aoff + m * 2048 + k * 1024); } while (0)
#define PG8_LDB(dst, b, h) do { _Pragma("unroll") for (int n = 0; n < 2; ++n) _Pragma("unroll") for (int k = 0; k < 2; ++k) dst[n][k] = *(const LAS bf16x8*)(lds + PG8_SB(b, h) + boff + n * 2048 + k * 1024); } while (0)
#define PG8_MMA(ai, bj, At, Bt) do { __builtin_amdgcn_s_setprio(1); _Pragma("unroll") for (int m = 0; m < 4; ++m) _Pragma("unroll") for (int n = 0; n < 2; ++n) _Pragma("unroll") for (int k = 0; k < 2; ++k) \
        acc[ai][bj][m][n] = __builtin_amdgcn_mfma_f32_16x16x32_bf16(Bt[n][k], At[m][k], acc[ai][bj][m][n], 0, 0, 0); __builtin_amdgcn_s_setprio(0); } while (0)
#define PG8_WAIT_V(n) asm volatile("s_waitcnt vmcnt(" #n ")" ::: "memory")
#define PG8_WAIT_L(n) asm volatile("s_waitcnt lgkmcnt(" #n ")" ::: "memory")
#define PG8_BAR __builtin_amdgcn_s_barrier()
#define PG8_SCHED __builtin_amdgcn_sched_barrier(0)
    Unit cur, nxt; int ui = 0;
    if (!S.next(0, cur)) return;
    f32x4 acc[2][2][4][2];
#pragma unroll
    for (int a = 0; a < 2; ++a)
#pragma unroll
        for (int b = 0; b < 2; ++b)
#pragma unroll
            for (int m = 0; m < 4; ++m)
#pragma unroll
                for (int n = 0; n < 2; ++n) acc[a][b][m][n] = (f32x4){0.f, 0.f, 0.f, 0.f};
    bf16x8 At[4][2], B0[2][2], B1[2][2];
    const char* cA = a_base(g, cur.pm); const char* cB = (const char*)g.Bt + (size_t)cur.pn * tstepB;
    PG8_STAGE(PG8_SB(0, 0), cB, voffB); PG8_STAGE(PG8_SB(0, 1), cB + hstepB, voffB); PG8_STAGE(PG8_SA(0, 0), cA, voffA); PG8_STAGE(PG8_SA(0, 1), cA + hstepA, voffA);
    if (wr == 1) PG8_BAR;
    PG8_WAIT_V(2); PG8_BAR;
    PG8_STAGE(PG8_SB(1, 0), cB + kstep, voffB); PG8_STAGE(PG8_SA(1, 0), cA + kstep, voffA); PG8_STAGE(PG8_SB(1, 1), cB + hstepB + kstep, voffB);
    PG8_WAIT_V(6); PG8_BAR;
    for (;;) {
        const bool has_next = S.next(ui + 1, nxt);
        const char* nA = has_next ? a_base(g, nxt.pm) : cA; const char* nB = has_next ? (const char*)g.Bt + (size_t)nxt.pn * tstepB : cB;
        for (int t = 0; t < nt; t += 2) {
            const bool last = (t == nt - 2);
            const char* a1 = cA + (size_t)(t + 1) * kstep;
            const char* a2 = last ? nA : cA + (size_t)(t + 2) * kstep; const char* b2 = last ? nB : cB + (size_t)(t + 2) * kstep;
            const char* a3 = a2 + kstep; const char* b3 = b2 + kstep;
            PG8_LDB(B0, 0, 0); PG8_LDB(B1, 0, 1); PG8_SCHED; PG8_LDA(At, 0, 0); PG8_STAGE(PG8_SA(1, 1), a1 + hstepA, voffA);
            PG8_WAIT_V(8); PG8_WAIT_L(0); PG8_BAR; PG8_MMA(0, 0, At, B0); PG8_MMA(0, 1, At, B1); PG8_BAR; PG8_SCHED;
            PG8_LDA(At, 0, 1); PG8_STAGE(PG8_SB(0, 0), b2, voffB); PG8_STAGE(PG8_SB(0, 1), b2 + hstepB, voffB); PG8_STAGE(PG8_SA(0, 0), a2, voffA);
            PG8_WAIT_V(8); PG8_WAIT_L(0); PG8_BAR; PG8_MMA(1, 0, At, B0); PG8_MMA(1, 1, At, B1); PG8_BAR; PG8_SCHED;
            PG8_LDB(B0, 1, 0); PG8_LDB(B1, 1, 1); PG8_SCHED; PG8_LDA(At, 1, 0); PG8_STAGE(PG8_SA(0, 1), a2 + hstepA, voffA);
            PG8_WAIT_V(8); PG8_WAIT_L(0); PG8_BAR; PG8_MMA(0, 0, At, B0); PG8_MMA(0, 1, At, B1); PG8_BAR; PG8_SCHED;
            PG8_LDA(At, 1, 1); PG8_STAGE(PG8_SB(1, 0), b3, voffB); PG8_STAGE(PG8_SB(1, 1), b3 + hstepB, voffB); PG8_STAGE(PG8_SA(1, 0), a3, voffA);
            PG8_WAIT_V(8); PG8_WAIT_L(0); PG8_BAR; PG8_MMA(1, 0, At, B0); PG8_MMA(1, 1, At, B1); PG8_BAR; PG8_SCHED;
        }
        if constexpr (ALIGN_EPI) { if (wr == 0) PG8_BAR; }
        E(acc, cur, wr, wc, fr, fq);
        if (!has_next) break;
#pragma unroll
        for (int a = 0; a < 2; ++a)
#pragma unroll
            for (int b = 0; b < 2; ++b)
#pragma unroll
                for (int m = 0; m < 4; ++m)
#pragma unroll
                    for (int n = 0; n < 2; ++n) acc[a][b][m][n] = (f32x4){0.f, 0.f, 0.f, 0.f};
        cur = nxt; cA = nA; cB = nB; ++ui;
        if constexpr (ALIGN_EPI) { if (wr == 1) PG8_BAR; }
    }
    PG8_WAIT_V(0);
    if constexpr (!ALIGN_EPI) { if (wr == 0) PG8_BAR; }
    PG8_BAR;
#undef PG8_SA
#undef PG8_SB
#undef PG8_STAGE
#undef PG8_LDA
#undef PG8_LDB
#undef PG8_MMA
#undef PG8_WAIT_V
#undef PG8_WAIT_L
#undef PG8_BAR
#undef PG8_SCHED
}
template <class F> struct EpiP {
    static constexpr bool PERM = true; F f;
    __device__ __forceinline__ void operator()(const f32x4 (&acc)[2][2][4][2], const Unit& u, int wr, int wc, int fr, int fq) const {
#pragma unroll
        for (int ai = 0; ai < 2; ++ai)
#pragma unroll
            for (int m = 0; m < 4; ++m) { int row = u.pm * BM + ai * HALF + wr * 64 + m * 16 + fr; asm volatile("" : "+v"(row));
#pragma unroll
                for (int bj = 0; bj < 2; ++bj) { const int col0 = u.pn * BM + bj * HALF + wc * 32 + 8 * fq; f(row, col0, acc[ai][bj][m][0], acc[ai][bj][m][1]); } asm volatile("" ::: "memory"); }
    }
};
template <class F> struct EpiN {
    static constexpr bool PERM = false; F f;
    __device__ __forceinline__ void operator()(const f32x4 (&acc)[2][2][4][2], const Unit& u, int wr, int wc, int fr, int fq) const {
#pragma unroll
        for (int ai = 0; ai < 2; ++ai)
#pragma unroll
            for (int m = 0; m < 4; ++m) { int row = u.pm * BM + ai * HALF + wr * 64 + m * 16 + fr; asm volatile("" : "+v"(row));
#pragma unroll
                for (int bj = 0; bj < 2; ++bj)
#pragma unroll
                    for (int n = 0; n < 2; ++n) { const int col0 = u.pn * BM + bj * HALF + wc * 32 + 16 * n + 4 * fq; f(row, col0, acc[ai][bj][m][n]); } asm volatile("" ::: "memory"); }
    }
};
}

struct Params {
    const float* in[33];
    float* out;
    unsigned char* ws;
};

struct TJob { const float* W; int ldw, n0src, Nsrc, Ksrc; bf16_t* WT; int ldt, row_off, col_off, Npad, Kpad; const float* mix; int mode; };
__device__ __forceinline__ void transpose_job(const TJob& j, LAS float* scr, int gw, int NGW, int lane_) {
    int lane = lane_; asm volatile("" : "+v"(lane));
    const int nblk = j.Npad / 32, kblk = j.Kpad / 64, items = nblk * kblk;
    for (int it = gw; it < items; it += NGW) {
        const int kb = it / nblk, nb = it % nblk, k0 = 64 * kb, n0 = 32 * nb;
#pragma unroll 4
        for (int i = 0; i < 32; ++i) { const int kk = 2 * i + (lane >> 5), n = lane & 31; float v = 0.f;
            if (k0 + kk < j.Ksrc && n0 + n < j.Nsrc) { v = j.W[(size_t)(k0 + kk) * j.ldw + j.n0src + n0 + n];
                if (j.mode == 1) v *= j.mix[k0 + kk]; else if (j.mode == 2) v *= (1.0f - j.mix[k0 + kk]); }
            scr[kk * 33 + n] = v; }
        asm volatile("s_waitcnt lgkmcnt(0)" ::: "memory");
        const int c = lane & 7;
#pragma unroll
        for (int jj = 0; jj < 4; ++jj) { const int n = (lane >> 3) + 8 * jj; const LAS float* s = scr + (8 * c) * 33 + n;
            u32x4 o; o.x = cvt_pk_bf16(s[0 * 33], s[1 * 33]); o.y = cvt_pk_bf16(s[2 * 33], s[3 * 33]); o.z = cvt_pk_bf16(s[4 * 33], s[5 * 33]); o.w = cvt_pk_bf16(s[6 * 33], s[7 * 33]);
            *(u32x4*)(j.WT + (size_t)(j.row_off + n0 + n) * j.ldt + j.col_off + k0 + 8 * c) = o; }
        asm volatile("s_waitcnt lgkmcnt(0)" ::: "memory");
    }
}

__device__ __forceinline__ void rms_row_bf16(const float* xrow, const float* g, bf16_t* orow, float* copy_to, int lane_) {
    int lane = lane_; asm volatile("" : "+v"(lane));
    const f32x4* xr = (const f32x4*)xrow + lane; const f32x4* gr = (const f32x4*)g + lane;
    f32x4 v[4]; float s = 0.f;
#pragma unroll
    for (int j = 0; j < 4; ++j) { v[j] = xr[64 * j]; s += (v[j].x * v[j].x + v[j].y * v[j].y) + (v[j].z * v[j].z + v[j].w * v[j].w); }
    if (copy_to) {
#pragma unroll
        for (int j = 0; j < 4; ++j) ((f32x4*)copy_to + lane)[64 * j] = v[j];
    }
    const float r = rsqrtf(wave_sum(s) * (1.f / D) + 1e-5f);
    u32x2* o8 = (u32x2*)orow + lane;
#pragma unroll
    for (int j = 0; j < 4; ++j) { const f32x4 gg = gr[64 * j]; u32x2 w; w.x = cvt_pk_bf16(v[j].x * r * gg.x, v[j].y * r * gg.y); w.y = cvt_pk_bf16(v[j].z * r * gg.z, v[j].w * r * gg.w); o8[64 * j] = w; }
}

struct FRelu2 { bf16_t* O; __device__ __forceinline__ void operator()(int row, int col0, f32x4 a, f32x4 b) const {
    f32x4 x = a, y = b;
#pragma unroll
    for (int i = 0; i < 4; ++i) { float t = fmaxf(x[i], 0.f); x[i] = t * t; t = fmaxf(y[i], 0.f); y[i] = t * t; }
    u32x4 w; w.x = cvt_pk_bf16(x[0], x[1]); w.y = cvt_pk_bf16(x[2], x[3]); w.z = cvt_pk_bf16(y[0], y[1]); w.w = cvt_pk_bf16(y[2], y[3]);
    *(u32x4*)(O + (size_t)row * FF + col0) = w; } };
struct FResAdd { float* X; __device__ __forceinline__ void operator()(int row, int col0, f32x4 a) const {
    f32x4* p = (f32x4*)(X + (size_t)row * D + col0); *p = *p + a; } };


struct FRwIn { h16* R; h16* Kk; h16* V; bf16_t* LH;
    __device__ __forceinline__ void operator()(int row, int col0, f32x4 a, f32x4 b) const {
        const int seg = __builtin_amdgcn_readfirstlane(col0 >> 10);
        if (seg < 3) { const long dK = (const char*)Kk - (const char*)R, dV = (const char*)V - (const char*)R; const long off = (seg == 1 ? dK : 0l) + (seg == 2 ? dV : 0l); h16* dst = (h16*)((char*)R + off); const int c = col0 & 1023;
            u32x4 w; w.x = pk_h16(a[0], a[1]); w.y = pk_h16(a[2], a[3]); w.z = pk_h16(b[0], b[1]); w.w = pk_h16(b[2], b[3]);
            *(u32x4*)(dst + (size_t)row * D + c) = w; }
        else { const int c = col0 - 3072; f32x4 x = a, y = b;
            if (c < 128) {
#pragma unroll
                for (int i = 0; i < 4; ++i) { x[i] = tanhf_(x[i]); y[i] = tanhf_(y[i]); } }
            else if (c >= 256 && c < 512) {
#pragma unroll
                for (int i = 0; i < 4; ++i) { x[i] = sigmoidf_(x[i]); y[i] = sigmoidf_(y[i]); } }
            u32x4 w; w.x = cvt_pk_bf16(x[0], x[1]); w.y = cvt_pk_bf16(x[2], x[3]); w.z = cvt_pk_bf16(y[0], y[1]); w.w = cvt_pk_bf16(y[2], y[3]);
            *(u32x4*)(LH + (size_t)row * 768 + c) = w; }
    } };
struct FLoraW { h16* EW; const float* w0;
    __device__ __forceinline__ void operator()(int row, int col0, f32x4 a, f32x4 b) const {
        const f32x4 p = *(const f32x4*)(w0 + col0), q = *(const f32x4*)(w0 + col0 + 4); float o[8];
#pragma unroll
        for (int i = 0; i < 4; ++i) { o[i] = 0.60653066f * sigmoidf_(p[i] + a[i]); o[4 + i] = 0.60653066f * sigmoidf_(q[i] + b[i]); }
        u32x4 w; w.x = pk_h16(o[0], o[1]); w.y = pk_h16(o[2], o[3]); w.z = pk_h16(o[4], o[5]); w.w = pk_h16(o[6], o[7]);
        *(u32x4*)(EW + (size_t)row * D + col0) = w; } };
struct FLoraA { h16* Aa; const float* a0;
    __device__ __forceinline__ void operator()(int row, int col0, f32x4 a, f32x4 b) const {
        const f32x4 p = *(const f32x4*)(a0 + col0), q = *(const f32x4*)(a0 + col0 + 4); float o[8];
#pragma unroll
        for (int i = 0; i < 4; ++i) { o[i] = sigmoidf_(p[i] + a[i]); o[4 + i] = sigmoidf_(q[i] + b[i]); }
        u32x4 w; w.x = pk_h16(o[0], o[1]); w.y = pk_h16(o[2], o[3]); w.z = pk_h16(o[4], o[5]); w.w = pk_h16(o[6], o[7]);
        *(u32x4*)(Aa + (size_t)row * D + col0) = w; } };
struct FLoraV { h16* V; const h16* VFm; const float* v0;
    __device__ __forceinline__ void operator()(int row, int col0, f32x4 a, f32x4 b) const {
        const f32x4 p = *(const f32x4*)(v0 + col0), q = *(const f32x4*)(v0 + col0 + 4);
        typedef h16 h16x8 __attribute__((ext_vector_type(8)));
        const h16x8 vv = *(const h16x8*)(V + (size_t)row * D + col0), vf = *(const h16x8*)(VFm + (size_t)row * D + col0); float o[8];
#pragma unroll
        for (int i = 0; i < 4; ++i) { float v = (float)vv[i], f = (float)vf[i]; o[i] = v + (f - v) * sigmoidf_(p[i] + a[i]); v = (float)vv[4 + i]; f = (float)vf[4 + i]; o[4 + i] = v + (f - v) * sigmoidf_(q[i] + b[i]); }
        u32x4 w; w.x = pk_h16(o[0], o[1]); w.y = pk_h16(o[2], o[3]); w.z = pk_h16(o[4], o[5]); w.w = pk_h16(o[6], o[7]);
        *(u32x4*)(V + (size_t)row * D + col0) = w; } };
struct FGate { bf16_t* O; const h16* Y;
    __device__ __forceinline__ void operator()(int row, int col0, f32x4 a, f32x4 b) const {
        typedef h16 h16x8 __attribute__((ext_vector_type(8)));
        const h16x8 yy = *(const h16x8*)(Y + (size_t)row * D + col0);
        u32x4 w; w.x = cvt_pk_bf16(a[0] * (float)yy[0], a[1] * (float)yy[1]); w.y = cvt_pk_bf16(a[2] * (float)yy[2], a[3] * (float)yy[3]);
        w.z = cvt_pk_bf16(b[0] * (float)yy[4], b[1] * (float)yy[5]); w.w = cvt_pk_bf16(b[2] * (float)yy[6], b[3] * (float)yy[7]);
        *(u32x4*)(O + (size_t)row * D + col0) = w; } };

template <int CTRL> __device__ __forceinline__ float dppmov(float v) { return __builtin_bit_cast(float, __builtin_amdgcn_update_dpp(0, __builtin_bit_cast(int, v), CTRL, 0xF, 0xF, true)); }
__device__ __forceinline__ float row16_sum(float v) { v += dppmov<0xB1>(v); v += dppmov<0x4E>(v); v += dppmov<0x124>(v); v += dppmov<0x128>(v); return v; }
typedef _Float16 h16x4 __attribute__((ext_vector_type(4)));
__device__ __forceinline__ void h4_to_f(h16x4 u, float* f) { f[0] = (float)u[0]; f[1] = (float)u[1]; f[2] = (float)u[2]; f[3] = (float)u[3]; }
__device__ __forceinline__ void rwkv_scan(const h16* R, const h16* Kk, const h16* V, const h16* EW, const h16* Aa, const float* k_k, const float* k_a, h16* Yraw, int G, int wave, int lane_) {
    int lane = lane_; asm volatile("" : "+v"(lane));
    const int NT = G * NWAVES;
    for (int task = wave * G + (int)blockIdx.x; task < 512; task += NT) {
        const int bh = task >> 4, rg = task & 15, b = bh >> 4, h = bh & 15;
        const int row = lane >> 4, jg = lane & 15, i = rg * 4 + row;
        const int colj = h * 64 + 4 * jg, coli = h * 64 + i;
        float kkc[4], kac[4];
#pragma unroll
        for (int j = 0; j < 4; ++j) { kkc[j] = k_k[colj + j]; kac[j] = k_a[colj + j]; }
        float s[4] = {0.f, 0.f, 0.f, 0.f};
        const size_t base = (size_t)b * S * D;
        const h16* pR = R + base + colj; const h16* pK = Kk + base + colj; const h16* pA = Aa + base + colj; const h16* pE = EW + base + colj; const h16* pV = V + base + coli;
        h16* pY = Yraw + ((size_t)task * S) * 4 + row;
        constexpr int TC = 4;
        h16x4 cr[TC], ck[TC], ca[TC], ce[TC]; h16 cv[TC];
#pragma unroll
        for (int u = 0; u < TC; ++u) { const size_t o = (size_t)u * D; cr[u] = *(const h16x4*)(pR + o); ck[u] = *(const h16x4*)(pK + o); ca[u] = *(const h16x4*)(pA + o); ce[u] = *(const h16x4*)(pE + o); cv[u] = pV[o]; }
        for (int t0 = 0; t0 < S; t0 += TC) {
            const int tn = (t0 + TC < S) ? t0 + TC : t0;
            h16x4 nr[TC], nk[TC], na[TC], ne[TC]; h16 nv[TC];
#pragma unroll
            for (int u = 0; u < TC; ++u) { const size_t o = (size_t)(tn + u) * D; nr[u] = *(const h16x4*)(pR + o); nk[u] = *(const h16x4*)(pK + o); na[u] = *(const h16x4*)(pA + o); ne[u] = *(const h16x4*)(pE + o); nv[u] = pV[o]; }
#pragma unroll
            for (int u = 0; u < TC; ++u) {
                float rv[4], kv[4], av[4], ev[4]; h4_to_f(cr[u], rv); h4_to_f(ck[u], kv); h4_to_f(ca[u], av); h4_to_f(ce[u], ev);
                const float vi = (float)cv[u];
                float kq[4], n2 = 0.f;
#pragma unroll
                for (int j = 0; j < 4; ++j) { kq[j] = kv[j] * kkc[j]; n2 += kq[j] * kq[j]; }
                n2 = row16_sum(n2);
                const float inv = 1.0f / fmaxf(sqrtf(n2), 1e-12f);
                float kkj[4], kt[4], bb[4], w[4], dot = 0.f;
#pragma unroll
                for (int j = 0; j < 4; ++j) { kkj[j] = kq[j] * inv; kt[j] = kv[j] * (1.0f + (av[j] - 1.0f) * kac[j]); bb[j] = kkj[j] * av[j]; w[j] = __expf(-ev[j]); dot += s[j] * kkj[j]; }
                const float sa = -row16_sum(dot);
                float yd = 0.f;
#pragma unroll
                for (int j = 0; j < 4; ++j) { s[j] = s[j] * w[j] + (sa * bb[j] + vi * kt[j]); yd += s[j] * rv[j]; }
                const float y = row16_sum(yd);
                if (jg == 0) pY[(size_t)(t0 + u) * 4] = (h16)y;
            }
#pragma unroll
            for (int u = 0; u < TC; ++u) { cr[u] = nr[u]; ck[u] = nk[u]; ca[u] = na[u]; ce[u] = ne[u]; cv[u] = nv[u]; }
        }
    }
}
constexpr int SC_CS = 32, SC_STEP_F = 5 * 64 + 8, SC_BUF_F = SC_CS * SC_STEP_F;
#define SC_BAR() do { asm volatile("s_waitcnt lgkmcnt(0)" ::: "memory"); __builtin_amdgcn_s_barrier(); asm volatile("" ::: "memory"); } while (0)
__device__ __forceinline__ float wave_sum_dpp(float v) {
    v = row16_sum(v);
    const float a = __builtin_bit_cast(float, __builtin_amdgcn_readlane(__builtin_bit_cast(int, v), 0)), b = __builtin_bit_cast(float, __builtin_amdgcn_readlane(__builtin_bit_cast(int, v), 16));
    const float c = __builtin_bit_cast(float, __builtin_amdgcn_readlane(__builtin_bit_cast(int, v), 32)), d = __builtin_bit_cast(float, __builtin_amdgcn_readlane(__builtin_bit_cast(int, v), 48));
    return (a + b) + (c + d);
}
struct ScRegs { h16 k[8], a[8], e[8], r[8], v[8]; };
__device__ __forceinline__ void sc_load(ScRegs& g, const h16* R, const h16* Kk, const h16* V, const h16* EW, const h16* Aa, size_t base, int c, int pw, int sub, int lane) {
#pragma unroll
    for (int q = 0; q < 8; ++q) { const size_t o = base + (size_t)(c * SC_CS + pw + 4 * q) * D;
        g.k[q] = Kk[o + lane]; g.a[q] = Aa[o + lane]; g.e[q] = EW[o + lane]; g.r[q] = R[o + lane]; g.v[q] = V[o + sub * 8 + (lane & 7)]; }
}
__device__ __forceinline__ void sc_compute(const ScRegs& g, LAS float* sb, int pw, float kkc, float kac, int lane) {
#pragma unroll
    for (int q = 0; q < 8; ++q) {
        const float kv = (float)g.k[q], av = (float)g.a[q], ev = (float)g.e[q], rv = (float)g.r[q]; const float kq = kv * kkc;
        const float n2 = wave_sum_dpp(kq * kq);
        const float kkj = kq * rsqrtf(fmaxf(n2, 1e-24f)); LAS float* p = sb + (pw + 4 * q) * SC_STEP_F;
        p[lane] = kkj; p[64 + lane] = kkj * av; p[128 + lane] = kv * (1.0f + (av - 1.0f) * kac); p[192 + lane] = __expf(-ev); p[256 + lane] = rv; if (lane < 8) p[320 + lane] = (float)g.v[q];
    }
}
__device__ __forceinline__ void rwkv_scan2(const h16* R, const h16* Kk, const h16* V, const h16* EW, const h16* Aa, const float* k_k, const float* k_a, h16* Yraw, LAS unsigned char* lds, int wave, int lane_) {
    int lane = lane_; asm volatile("" : "+v"(lane));
    LAS float* buf = (LAS float*)lds;
    constexpr int NCH = S / SC_CS;
#pragma unroll 1
    for (int vb = (int)blockIdx.x; vb < 256; vb += (int)gridDim.x) {
        const int bh = vb >> 3, sub = vb & 7, b = bh >> 4, h = bh & 15;
        const size_t base = (size_t)b * S * D + h * 64;
        if (wave >= 4) {
            const int pw = wave - 4;
            const float kkc = k_k[h * 64 + lane], kac = k_a[h * 64 + lane];
            ScRegs ga, gb;
            sc_load(ga, R, Kk, V, EW, Aa, base, 0, pw, sub, lane);
            sc_load(gb, R, Kk, V, EW, Aa, base, 1, pw, sub, lane);
            sc_compute(ga, buf, pw, kkc, kac, lane);
            SC_BAR();
#pragma unroll 1
            for (int c = 0; c < NCH; c += 2) {
                { const int c2 = (c + 2 < NCH) ? c + 2 : c; sc_load(ga, R, Kk, V, EW, Aa, base, c2, pw, sub, lane); }
                sc_compute(gb, buf + SC_BUF_F, pw, kkc, kac, lane);
                SC_BAR();
                { const int c3 = (c + 3 < NCH) ? c + 3 : c + 1; sc_load(gb, R, Kk, V, EW, Aa, base, c3, pw, sub, lane); }
                if (c + 2 < NCH) sc_compute(ga, buf, pw, kkc, kac, lane);
                SC_BAR();
            }
            SC_BAR();
        } else if (wave < 2) {
            const int jg = lane & 15, cw = wave;
            float s0 = 0.f, s1 = 0.f, s2 = 0.f, s3 = 0.f;
            SC_BAR();
#pragma unroll 1
            for (int c = 0; c < NCH; ++c) {
                const LAS float* sb = buf + (c & 1) * SC_BUF_F + 4 * jg;
                const LAS float* vb_ = buf + (c & 1) * SC_BUF_F + 320 + cw * 4 + (lane >> 4);
                LAS float* yp = buf + 2 * SC_BUF_F + ((c & 1) * 2 + cw) * (SC_CS * 64) + lane;
                f32x4 kk4 = *(const LAS f32x4*)(sb), bb4 = *(const LAS f32x4*)(sb + 64), kt4 = *(const LAS f32x4*)(sb + 128), w4 = *(const LAS f32x4*)(sb + 192), r4 = *(const LAS f32x4*)(sb + 256); float vi = vb_[0];
#pragma unroll 4
                for (int st = 0; st < SC_CS; ++st) {
                    const int sn = (st + 1 < SC_CS) ? st + 1 : st;
                    const f32x4 nkk = *(const LAS f32x4*)(sb + sn * SC_STEP_F), nbb = *(const LAS f32x4*)(sb + sn * SC_STEP_F + 64), nkt = *(const LAS f32x4*)(sb + sn * SC_STEP_F + 128), nw = *(const LAS f32x4*)(sb + sn * SC_STEP_F + 192), nr4 = *(const LAS f32x4*)(sb + sn * SC_STEP_F + 256);
                    const float nvi = vb_[sn * SC_STEP_F];
                    const float sa = -row16_sum((s0 * kk4[0] + s1 * kk4[1]) + (s2 * kk4[2] + s3 * kk4[3]));
                    s0 = s0 * w4[0] + (sa * bb4[0] + vi * kt4[0]); s1 = s1 * w4[1] + (sa * bb4[1] + vi * kt4[1]);
                    s2 = s2 * w4[2] + (sa * bb4[2] + vi * kt4[2]); s3 = s3 * w4[3] + (sa * bb4[3] + vi * kt4[3]);
                    yp[st * 64] = (s0 * r4[0] + s1 * r4[1]) + (s2 * r4[2] + s3 * r4[3]);
                    kk4 = nkk; bb4 = nbb; kt4 = nkt; w4 = nw; r4 = nr4; vi = nvi;
                }
                SC_BAR();
            }
            SC_BAR();
        } else {
            const int cw = wave - 2;
            h16* pY = Yraw + ((size_t)(bh * 16 + sub * 2 + cw) * S) * 4;
            SC_BAR();
#pragma unroll 1
            for (int c = 0; c <= NCH; ++c) {
                if (c > 0) {
                    const LAS float* yp = buf + 2 * SC_BUF_F + (((c - 1) & 1) * 2 + cw) * (SC_CS * 64);
                    const int st = lane >> 1, r0 = 2 * (lane & 1);
                    float a0 = 0.f, a1 = 0.f;
#pragma unroll
                    for (int q = 0; q < 4; ++q) { const f32x4 x = *(const LAS f32x4*)(yp + st * 64 + r0 * 16 + 4 * q), z = *(const LAS f32x4*)(yp + st * 64 + (r0 + 1) * 16 + 4 * q);
                        a0 += (x[0] + x[1]) + (x[2] + x[3]); a1 += (z[0] + z[1]) + (z[2] + z[3]); }
                    *(unsigned*)(pY + (size_t)((c - 1) * SC_CS + st) * 4 + r0) = pk_h16(a0, a1);
                }
                SC_BAR();
            }
        }
        if (false) {
            SC_BAR();
#pragma unroll 1
            for (int c = 0; c < NCH; ++c) SC_BAR();
        }
    }
}
__device__ __forceinline__ void rwkv_gn(h16* R, const h16* Kk, const h16* V, const h16* Aa, const h16* Yraw, const float* k_a, const float* r_k, const float* ln_w, const float* ln_b, int gw, int NGW, int lane_) {
    int lane = lane_; asm volatile("" : "+v"(lane));
    const int hq = lane >> 4, c4 = 4 * (lane & 15);
#pragma unroll 2
    for (int idx = gw; idx < M * 4; idx += NGW) {
        const int m = idx >> 2, h = (idx & 3) * 4 + hq, col = h * 64 + c4; const size_t o = (size_t)m * D + col;
        const int bq = m / S, tq = m - bq * S;
        float y[4], r[4], k[4], a[4], v[4];
        h4_to_f(*(const h16x4*)(Yraw + ((size_t)((bq * 16 + h) * 16 + (lane & 15)) * S + tq) * 4), y);
        h4_to_f(*(const h16x4*)(R + o), r); h4_to_f(*(const h16x4*)(Kk + o), k); h4_to_f(*(const h16x4*)(Aa + o), a); h4_to_f(*(const h16x4*)(V + o), v);
        const f32x4 ka4 = *(const f32x4*)(k_a + col), rk4 = *(const f32x4*)(r_k + col), lw4 = *(const f32x4*)(ln_w + col), lb4 = *(const f32x4*)(ln_b + col);
        const float mu = row16_sum((y[0] + y[1]) + (y[2] + y[3])) * (1.f / 64.f);
        float d[4], q = 0.f, bsp = 0.f;
#pragma unroll
        for (int i = 0; i < 4; ++i) { d[i] = y[i] - mu; q += d[i] * d[i]; const float kt = k[i] * (1.0f + (a[i] - 1.0f) * ka4[i]); bsp += r[i] * kt * rk4[i]; }
        const float rstd = rsqrtf(row16_sum(q) * (1.f / 64.f) + 64e-5f), bs = row16_sum(bsp);
        h16x4 outv;
#pragma unroll
        for (int i = 0; i < 4; ++i) outv[i] = (h16)(d[i] * rstd * lw4[i] + lb4[i] + bs * v[i]);
        *(h16x4*)(R + o) = outv;
    }
}

constexpr size_t KF_STRIDE = (size_t)NB * 4 * S * 64;
__device__ __forceinline__ float gelu_tanh(float x) { const float u = 0.7978845608f * (x + 0.044715f * x * x * x); return 0.5f * x * (1.0f + tanhf_(u)); }
__device__ __forceinline__ void store_vf8(bf16_t* chunk_base_d, int keyp0  , f32x4 a, f32x4 b) {
    const int tile = keyp0 >> 4, rq0 = (keyp0 & 15) >> 2;
    u32x2 w0, w1; w0.x = cvt_pk_bf16(a[0], a[1]); w0.y = cvt_pk_bf16(a[2], a[3]); w1.x = cvt_pk_bf16(b[0], b[1]); w1.y = cvt_pk_bf16(b[2], b[3]);
    *(u32x2*)(chunk_base_d + 8 * rq0 + 4 * tile) = w0; *(u32x2*)(chunk_base_d + 8 * (rq0 + 1) + 4 * tile) = w1;
}
struct FNsaIn { bf16_t* Q; bf16_t* KF; float* gates; const float* rope;
    __device__ __forceinline__ void operator()(int row, int col0, f32x4 a, f32x4 b) const {
        const int tile = __builtin_amdgcn_readfirstlane(col0 >> 8);
        const int bb = row / S, t = row - bb * S;
        if (tile < 7) {
            f32x4 x = a, y = b;
            if ((col0 & 32) == 0) {
                f32x4 px, py;
#pragma unroll
                for (int i = 0; i < 4; ++i) { px[i] = __shfl_xor(x[i], 16); py[i] = __shfl_xor(y[i], 16); }
                const int d0 = col0 & 63;
                if (d0 < 16) { const f32x4 c0 = *(const f32x4*)(rope + t * 16), c1 = *(const f32x4*)(rope + t * 16 + 4), s0 = *(const f32x4*)(rope + t * 16 + 8), s1 = *(const f32x4*)(rope + t * 16 + 12);
                    if (d0 == 0) { x = x * c0 - px * s0; y = y * c1 - py * s1; } else { x = x * c0 + px * s0; y = y * c1 + py * s1; } }
            }
            if (tile < 4) { x = x * 0.18033688011112042f; y = y * 0.18033688011112042f;
                u32x4 w; w.x = cvt_pk_bf16(x[0], x[1]); w.y = cvt_pk_bf16(x[2], x[3]); w.z = cvt_pk_bf16(y[0], y[1]); w.w = cvt_pk_bf16(y[2], y[3]);
                *(u32x4*)(Q + (size_t)row * D + col0) = w; }
            else { const int idx = tile - 4, g = (col0 & 255) >> 6, d0 = col0 & 63;
                u32x4 w; w.x = cvt_pk_bf16(x[0], x[1]); w.y = cvt_pk_bf16(x[2], x[3]); w.z = cvt_pk_bf16(y[0], y[1]); w.w = cvt_pk_bf16(y[2], y[3]);
                *(u32x4*)(KF + (size_t)idx * KF_STRIDE + ((size_t)(bb * 4 + g) * S + t) * 64 + d0) = w; }
        } else if (tile == 7) { const int g = (col0 & 255) >> 6, d0 = col0 & 63;
            u32x4 w; w.x = cvt_pk_bf16(a[0], a[1]); w.y = cvt_pk_bf16(a[2], a[3]); w.z = cvt_pk_bf16(b[0], b[1]); w.w = cvt_pk_bf16(b[2], b[3]);
            *(u32x4*)(KF + (size_t)3 * KF_STRIDE + ((size_t)(bb * 4 + g) * S + t) * 64 + d0) = w;
        } else { const int c = col0 - 2048;
            if (c < 48) { f32x4 x, y;
#pragma unroll
                for (int i = 0; i < 4; ++i) { x[i] = sigmoidf_(a[i]); y[i] = sigmoidf_(b[i]); }
                *(f32x4*)(gates + (size_t)row * 48 + c) = x; *(f32x4*)(gates + (size_t)row * 48 + c + 4) = y; }
        }
    } };
struct FNsaVT { bf16_t* VF;
    __device__ __forceinline__ void operator()(int row, int col0, f32x4 a, f32x4 b) const {
        const int br = row >> 8, g = (row >> 6) & 3, d = row & 63, bb = col0 / S, t0 = col0 - bb * S;
        bf16_t* base = VF + (size_t)br * KF_STRIDE + (size_t)(bb * 4 + g) * S * 64 + (size_t)(t0 >> 5) * 2048 + d * 32;
        store_vf8(base, t0 & 31, a, b); } };
struct FCmp1 { bf16_t* CH; const float* bias;
    __device__ __forceinline__ void operator()(int row, int col0, f32x4 a, f32x4 b) const {
        const f32x4 p = *(const f32x4*)(bias + col0), q = *(const f32x4*)(bias + col0 + 4); float o[8];
#pragma unroll
        for (int i = 0; i < 4; ++i) { o[i] = gelu_tanh(a[i] + p[i]); o[4 + i] = gelu_tanh(b[i] + q[i]); }
        u32x4 w; w.x = cvt_pk_bf16(o[0], o[1]); w.y = cvt_pk_bf16(o[2], o[3]); w.z = cvt_pk_bf16(o[4], o[5]); w.w = cvt_pk_bf16(o[6], o[7]);
        *(u32x4*)(CH + (size_t)row * 256 + col0) = w; } };
struct FCmp2K { bf16_t* KC;
    __device__ __forceinline__ void operator()(int row, int col0, f32x4 a, f32x4 b) const {
        if (col0 < 64) { u32x4 w; w.x = cvt_pk_bf16(a[0], a[1]); w.y = cvt_pk_bf16(a[2], a[3]); w.z = cvt_pk_bf16(b[0], b[1]); w.w = cvt_pk_bf16(b[2], b[3]);
            *(u32x4*)(KC + (size_t)row * 64 + col0) = w; } } };
struct FCmp2VT { bf16_t* VC;
    __device__ __forceinline__ void operator()(int row, int col0, f32x4 a, f32x4 b) const {
        if (row < 64) { const int bg = col0 >> 10, n0 = col0 & 1023;
            bf16_t* base = VC + (size_t)bg * 65536 + (size_t)(n0 >> 5) * 2048 + row * 32; store_vf8(base, n0 & 31, a, b); } } };

__device__ __forceinline__ f32x4 mfma16(bf16x8 a, bf16x8 b, f32x4 c) { return __builtin_amdgcn_mfma_f32_16x16x32_bf16(a, b, c, 0, 0, 0); }
__device__ __forceinline__ bf16x8 ld8(const bf16_t* p) { return *(const bf16x8*)p; }
__device__ __forceinline__ bf16x8 pack8(f32x4 a, f32x4 b) { u32x4 w; w.x = cvt_pk_bf16(a[0], a[1]); w.y = cvt_pk_bf16(a[2], a[3]); w.z = cvt_pk_bf16(b[0], b[1]); w.w = cvt_pk_bf16(b[2], b[3]); return __builtin_bit_cast(bf16x8, w); }
__device__ __forceinline__ float colmax(float x) {
    const auto r = __builtin_amdgcn_permlane16_swap(__float_as_uint(x), __float_as_uint(x), false, false); x = fmaxf(__uint_as_float(r[0]), __uint_as_float(r[1]));
    const auto q = __builtin_amdgcn_permlane32_swap(__float_as_uint(x), __float_as_uint(x), false, false); return fmaxf(__uint_as_float(q[0]), __uint_as_float(q[1])); }
__device__ __forceinline__ float colsum(float x) {
    const auto r = __builtin_amdgcn_permlane16_swap(__float_as_uint(x), __float_as_uint(x), false, false); x = __uint_as_float(r[0]) + __uint_as_float(r[1]);
    const auto q = __builtin_amdgcn_permlane32_swap(__float_as_uint(x), __float_as_uint(x), false, false); return __uint_as_float(q[0]) + __uint_as_float(q[1]); }
template <int CTRL> __device__ __forceinline__ unsigned dppmov_u(unsigned v) { return (unsigned)__builtin_amdgcn_update_dpp(0, (int)v, CTRL, 0xF, 0xF, true); }
__device__ __forceinline__ unsigned wave_max_u32(unsigned v) {
    v = max(v, dppmov_u<0xB1>(v)); v = max(v, dppmov_u<0x4E>(v)); v = max(v, dppmov_u<0x124>(v)); v = max(v, dppmov_u<0x128>(v));
    const auto r = __builtin_amdgcn_permlane16_swap(v, v, false, false); v = max((unsigned)r[0], (unsigned)r[1]);
    const auto q = __builtin_amdgcn_permlane32_swap(v, v, false, false); return max((unsigned)q[0], (unsigned)q[1]); }
struct AttnState { float m, l; f32x4 o[4]; };
__device__ __forceinline__ void attn_init(AttnState& st) { st.m = -1e30f; st.l = 0.f;
#pragma unroll
    for (int d = 0; d < 4; ++d) st.o[d] = (f32x4){0.f, 0.f, 0.f, 0.f}; }
struct KVChunk { bf16x8 k[4]; bf16x8 v[4]; };
__device__ __forceinline__ void kv_load(KVChunk& B, const bf16_t* kptr, const bf16_t* vptr) {
#pragma unroll
    for (int tl = 0; tl < 2; ++tl) { B.k[tl * 2] = ld8(kptr + tl * 1024); B.k[tl * 2 + 1] = ld8(kptr + tl * 1024 + 32); }
#pragma unroll
    for (int d = 0; d < 4; ++d) B.v[d] = ld8(vptr + d * 512);
}
struct KRange { int klo, span; };
__device__ __forceinline__ KRange krange(int klo, int khi) { KRange r; if (khi < klo) { r.klo = 64; r.span = 0; } else { r.klo = klo; r.span = khi - klo; } return r; }
template <bool MASKED>
__device__ __forceinline__ void attn_chunk_r(AttnState& st, const bf16x8 (&kf)[4], const bf16x8 (&vf)[4], const bf16x8 q0, const bf16x8 q1, KRange kr) {
    f32x4 s[2];
#pragma unroll
    for (int tl = 0; tl < 2; ++tl) { s[tl] = mfma16(kf[tl * 2], q0, (f32x4){0.f, 0.f, 0.f, 0.f}); s[tl] = mfma16(kf[tl * 2 + 1], q1, s[tl]); }
    float mx = -1e30f;
#pragma unroll
    for (int tl = 0; tl < 2; ++tl)
#pragma unroll
        for (int i = 0; i < 4; ++i) { if (MASKED) { const bool v = (unsigned)(tl * 16 + i - kr.klo) <= (unsigned)kr.span; s[tl][i] = v ? s[tl][i] : -1e30f; } mx = fmaxf(mx, s[tl][i]); }
    mx = colmax(mx);
    if (__any(mx > st.m)) {
        const float mnew = fmaxf(st.m, mx), alpha = __builtin_amdgcn_exp2f(st.m - mnew);
        st.l *= alpha; st.m = mnew;
#pragma unroll
        for (int d = 0; d < 4; ++d) st.o[d] = st.o[d] * alpha;
    }
    const float mcur = st.m;
    f32x4 p[2]; float ps = 0.f;
#pragma unroll
    for (int tl = 0; tl < 2; ++tl)
#pragma unroll
        for (int i = 0; i < 4; ++i) { const float e = __builtin_amdgcn_exp2f(s[tl][i] - mcur); p[tl][i] = e; ps += e; }
    st.l += ps;
    const bf16x8 pb = pack8(p[0], p[1]);
#pragma unroll
    for (int d = 0; d < 4; ++d) st.o[d] = mfma16(vf[d], pb, st.o[d]);
}

#define ATT_STEPN(C, idx) do { _Pragma("unroll") for (int gg = 0; gg < NG; ++gg) { if (act(gg, idx)) { \
        if (ff(gg, idx)) attn_chunk_r<false>(gs[gg], C.k, C.v, gq[gg][0], gq[gg][1], KRange{0, 0}); else attn_chunk_r<true>(gs[gg], C.k, C.v, gq[gg][0], gq[gg][1], mf(gg, idx)); } \
        __builtin_amdgcn_sched_barrier(0); } } while (0)
template <int NG, class AddrK, class AddrV, class ActF, class FullF, class MaskF>
__device__ __forceinline__ void attn_chunksN(AttnState (&gs)[NG], const bf16x8 (&gq)[NG][2], int n, AddrK ak, AddrV av, ActF act, FullF ff, MaskF mf) {
    if constexpr (NG <= 2) {
        KVChunk C0, C1;
        if (n > 0) kv_load(C0, ak(0), av(0));
#pragma unroll 1
        for (int i = 0; i < n; i += 2) {
            if (i + 1 < n) kv_load(C1, ak(i + 1), av(i + 1));
            ATT_STEPN(C0, i);
            if (i + 1 < n) {
                if (i + 2 < n) kv_load(C0, ak(i + 2), av(i + 2));
                ATT_STEPN(C1, i + 1);
            }
        }
    } else {
#pragma unroll 1
        for (int i = 0; i < n; ++i) { KVChunk C0; kv_load(C0, ak(i), av(i)); ATT_STEPN(C0, i); }
    }
}

__device__ __forceinline__ void nsa_attention(const bf16_t* Q, const bf16_t* KF, const bf16_t* VF, const bf16_t* KC, const bf16_t* VC, const float* gates, bf16_t* OUT, LAS unsigned char* lds, int G, int wave, int lane_) {
    int lane0 = lane_; asm volatile("" : "+v"(lane0));
    LAS float* imp = (LAS float*)(lds + wave * 18432);
    LAS float* tl = imp;
    LAS int* sel = (LAS int*)(lds + wave * 18432 + 16384);
    LAS unsigned* smask32 = (LAS unsigned*)(lds + wave * 18432 + 16384 + 1088);
    LAS unsigned char* blist = (LAS unsigned char*)(lds + wave * 18432 + 16384 + 1088 + 512);
    const bool xcd_map = (G % 8) == 0;
    const int nslots = xcd_map ? (G >> 3) * NWAVES : G * NWAVES, slot = xcd_map ? ((int)blockIdx.x >> 3) * NWAVES + wave : (int)blockIdx.x * NWAVES + wave;
    const int ntask = xcd_map ? 1024 : 8192;
#pragma unroll 1
    for (int task = slot; task < ntask; task += nslots) {
        int lane = lane0; asm volatile("" : "+v"(lane)); lane &= 63;
        const int col = lane & 15, rq = lane >> 4;
        const int tilei = xcd_map ? task : (task >> 3), bg = xcd_map ? ((int)blockIdx.x & 7) : (task & 7), b = bg >> 2, g = bg & 3, t0 = tilei * 16, t = t0 + col;
        const size_t rowq = (size_t)b * S + t;
        const bf16_t* qrow = Q + rowq * D + (g * 4) * 64 + 8 * rq;
        const float* grow = gates + rowq * 48 + g * 12;
        const int cur_max = (t0 + 15) >> 6;
        int n_end = 4 * (cur_max + 1); if (n_end > 1024) n_end = 1024;
        const int nchunk_c = (n_end + 31) >> 5;
        const bf16_t* kc_l = KC + (size_t)bg * 65536 + (size_t)col * 64 + 8 * rq;
        const bf16_t* vc_l = VC + (size_t)bg * 65536 + (size_t)col * 32 + 8 * rq;
        {
        AttnState gs[4]; bf16x8 gq[4][2];
#pragma unroll
        for (int h = 0; h < 4; ++h) { gq[h][0] = ld8(qrow + h * 64); gq[h][1] = ld8(qrow + h * 64 + 32); attn_init(gs[h]); }
        attn_chunksN<4>(gs, gq, nchunk_c,
            [&](int ci) { return kc_l + (size_t)ci * 2048; }, [&](int ci) { return vc_l + (size_t)ci * 2048; },
            [&](int, int) { return true; },
            [&](int, int ci) { return 16 * (ci * 32 + 31) + 31 <= t0; },
            [&](int, int ci) { const int nhi = (t >= 31) ? ((t - 31) >> 4) : -1; return krange(0, nhi - ci * 32 - 4 * rq); });
        {
            float mc[4], lc[4];
#pragma unroll
            for (int h = 0; h < 4; ++h) { const float lt = colsum(gs[h].l); mc[h] = gs[h].m; lc[h] = (gs[h].m > -1e29f && lt > 0.f) ? 1.0f / lt : 0.f; }
            {
                float carry = 0.f;
#pragma unroll 1
                for (int kc = 0; kc < nchunk_c; ++kc) {
#pragma unroll
                    for (int tt = 0; tt < 2; ++tt) {
                        const bf16x8 k0 = ld8(kc_l + (size_t)kc * 2048 + tt * 1024), k1 = ld8(kc_l + (size_t)kc * 2048 + tt * 1024 + 32);
                        float own = 0.f, p3 = 0.f;
#pragma unroll
                        for (int h = 0; h < 4; ++h) {
                            f32x4 sc = mfma16(k0, gq[h][0], (f32x4){0.f, 0.f, 0.f, 0.f}); sc = mfma16(k1, gq[h][1], sc);
#pragma unroll
                            for (int i = 0; i < 4; ++i) { const int n = kc * 32 + tt * 16 + 4 * rq + i; const float p = (16 * n + 31 <= t) ? __builtin_amdgcn_exp2f(sc[i] - mc[h]) * lc[h] : 0.f; own += p; if (i == 3) p3 += p; }
                        }
                        const float up = __shfl(p3, (lane + 48) & 63);
                        const float add = (rq == 0) ? carry : up;
                        imp[col * 256 + kc * 8 + tt * 4 + rq] = own + add;
                        carry = __shfl(p3, col + 48);
                    }
                }
            }
#pragma unroll 1
            for (int c = 0; c < 16; ++c) {
                const int tc = t0 + c, cur = tc >> 6;
                if (cur < 16) { if (lane <= cur) sel[c * 17 + lane] = lane; if (lane == 0) sel[c * 17 + 16] = cur + 1; }
                else {
                    unsigned key[4];
#pragma unroll
                    for (int jx = 0; jx < 4; ++jx) { const int sb = lane + 64 * jx; const float v = imp[c * 256 + sb]; key[jx] = (sb >= 1 && sb <= cur - 2) ? ((__float_as_uint(v) & 0xFFFFFF00u) | (unsigned)(255 - sb)) : 0u; }
                    if (lane == 0) { sel[c * 17 + 0] = 0; sel[c * 17 + 1] = cur - 1; sel[c * 17 + 2] = cur; sel[c * 17 + 16] = 16; }
#pragma unroll 1
                    for (int r = 0; r < 13; ++r) {
                        unsigned best = max(max(key[0], key[1]), max(key[2], key[3]));
                        best = wave_max_u32(best);
                        if (lane == 0) sel[c * 17 + 3 + r] = 255 - (int)(best & 255u);
#pragma unroll
                        for (int jx = 0; jx < 4; ++jx) if (key[jx] == best) key[jx] = 0u;
                    }
                }
            }
#pragma unroll
            for (int h = 0; h < 4; ++h) { const float gc = grow[h * 3 + 0] * lc[h];
#pragma unroll
                for (int d = 0; d < 4; ++d)
#pragma unroll
                    for (int i = 0; i < 4; ++i) tl[(h * 16 + d * 4 + i) * 64 + lane] = gs[h].o[d][i] * gc; }
        }
        }
        {
            smask32[lane] = 0u; smask32[64 + lane] = 0u;
#pragma unroll
            for (int k4 = 0; k4 < 4; ++k4) { const int pp = lane + 64 * k4, c = pp >> 4, e = pp & 15; if (e < sel[c * 17 + 16]) { const int jb = sel[c * 17 + e]; atomicOr((unsigned*)(smask32 + (jb >> 1)), 1u << (c + 16 * (jb & 1))); } }
            const bf16_t* ks_b = KF + (size_t)1 * KF_STRIDE + (size_t)bg * S * 64 + (size_t)col * 64 + 8 * rq;
            const bf16_t* vs_b = VF + (size_t)bg * S * 64 + (size_t)col * 32 + 8 * rq;
            const int tokl = col >> 2, hd = col & 3;
            {
                int nblk = 0;
#pragma unroll
                for (int k4 = 0; k4 < 4; ++k4) { const int jb = lane + 64 * k4; const unsigned mk = (smask32[jb >> 1] >> (16 * (jb & 1))) & 0xFFFFu;
                    const unsigned long long bal = __ballot(mk != 0u); const int pos = nblk + __popcll(bal & ((1ull << lane) - 1ull)); if (mk != 0u) blist[pos] = (unsigned char)jb; nblk += __popcll(bal); }
                AttnState hs[4]; bf16x8 hq[4][2];
#pragma unroll
                for (int cg = 0; cg < 4; ++cg) { const bf16_t* qp = Q + ((size_t)b * S + t0 + 4 * cg + tokl) * D + (g * 4 + hd) * 64 + 8 * rq; hq[cg][0] = ld8(qp); hq[cg][1] = ld8(qp + 32); attn_init(hs[cg]); }
                auto blk_of = [&](int ci) { return (int)__builtin_amdgcn_readfirstlane((int)blist[ci >> 1]); };
                auto msk_of = [&](int jb) { return (unsigned)__builtin_amdgcn_readfirstlane((int)((smask32[jb >> 1] >> (16 * (jb & 1))) & 0xFFFFu)); };
                const int tb = t0;
                attn_chunksN<4>(hs, hq, nblk * 2,
                    [&](int ci) { return ks_b + (size_t)(blk_of(ci) * 2 + (ci & 1)) * 2048; },
                    [&](int ci) { return vs_b + (size_t)(blk_of(ci) * 2 + (ci & 1)) * 2048; },
                    [&](int cg, int ci) { return ((msk_of(blk_of(ci)) >> (4 * cg)) & 15u) != 0u; },
                    [&](int cg, int ci) { const int jb = blk_of(ci); return ((msk_of(jb) >> (4 * cg)) & 15u) == 15u && jb * 64 + (ci & 1) * 32 + 31 <= tb + 4 * cg; },
                    [&](int cg, int ci) { const int jb = blk_of(ci); const unsigned mk = msk_of(jb); const int tok = 4 * cg + tokl; const int kp0 = jb * 64 + (ci & 1) * 32 + 4 * rq;
                        return krange(0, ((mk >> tok) & 1u) ? (tb + tok - kp0) : -1); });
#pragma unroll
                for (int cg = 0; cg < 4; ++cg) { const int tok = 4 * cg + tokl;
                    const float lt = colsum(hs[cg].l); const float inv = (hs[cg].m > -1e29f && lt > 0.f) ? 1.0f / lt : 0.f;
                    const float gsv = gates[((size_t)b * S + t0 + tok) * 48 + g * 12 + hd * 3 + 1] * inv;
#pragma unroll
                    for (int d = 0; d < 4; ++d)
#pragma unroll
                        for (int i = 0; i < 4; ++i) tl[(hd * 16 + d * 4 + i) * 64 + tok + 16 * rq] += hs[cg].o[d][i] * gsv; }
            }
        }
        {
            int lo = t0 - 511; if (lo < 0) lo = 0; const int c0 = lo >> 5, c1 = (t0 + 15) >> 5;
            const bf16_t* kw_b = KF + (size_t)2 * KF_STRIDE + (size_t)bg * S * 64 + (size_t)col * 64 + 8 * rq;
            const bf16_t* vw_b = VF + (size_t)1 * KF_STRIDE + (size_t)bg * S * 64 + (size_t)col * 32 + 8 * rq;
            {
                AttnState gs[4]; bf16x8 gq[4][2];
#pragma unroll
                for (int h = 0; h < 4; ++h) { gq[h][0] = ld8(qrow + h * 64); gq[h][1] = ld8(qrow + h * 64 + 32); attn_init(gs[h]); }
                attn_chunksN<4>(gs, gq, c1 - c0 + 1,
                    [&](int ci) { return kw_b + (size_t)(c0 + ci) * 2048; }, [&](int ci) { return vw_b + (size_t)(c0 + ci) * 2048; },
                    [&](int, int) { return true; },
                    [&](int, int ci) { return (c0 + ci) * 32 + 31 <= t0 && (c0 + ci) * 32 + 512 > t0 + 15; },
                    [&](int, int ci) { const int cb = (c0 + ci) * 32 + 4 * rq; return krange(t - 511 - cb, t - cb); });
#pragma unroll
                for (int h = 0; h < 4; ++h) { const float lt = colsum(gs[h].l); const float inv = (gs[h].m > -1e29f && lt > 0.f) ? 1.0f / lt : 0.f; const float gwv = grow[h * 3 + 2] * inv;
#pragma unroll
                    for (int d = 0; d < 4; ++d)
#pragma unroll
                        for (int i = 0; i < 4; ++i) tl[(h * 16 + d * 4 + i) * 64 + lane] += gs[h].o[d][i] * gwv; }
            }
        }
#pragma unroll
        for (int h = 0; h < 4; ++h)
#pragma unroll
            for (int d = 0; d < 4; ++d) { float v4[4];
#pragma unroll
                for (int i = 0; i < 4; ++i) v4[i] = tl[(h * 16 + d * 4 + i) * 64 + lane];
                u32x2 w; w.x = cvt_pk_bf16(v4[0], v4[1]); w.y = cvt_pk_bf16(v4[2], v4[3]);
                *(u32x2*)(OUT + rowq * D + (g * 4 + h) * 64 + d * 16 + 4 * rq) = w; }
    }
}

#define GSYNC() do { asm volatile("s_waitcnt vmcnt(0)" ::: "memory"); grid.sync(); } while (0)
__global__ void __launch_bounds__(NTHREADS, 2) fwd_kernel(Params P) {
    extern __shared__ __attribute__((aligned(16))) unsigned char lds_raw[];
    LAS unsigned char* lds = (LAS unsigned char*)lds_raw;
    cg::grid_group grid = cg::this_grid();
    int tidv = threadIdx.x;
    const int wave = __builtin_amdgcn_readfirstlane(tidv >> 6);
    const int G = gridDim.x, gw_k = blockIdx.x * NWAVES + wave, NGW = G * NWAVES;
    unsigned char* ws = P.ws;
    float* xres = P.out;
    LAS float* scr = (LAS float*)(lds + wave * 16384);
    const float* x_in = P.in[0];
    const float* norm_mix = P.in[1]; const float* norm_mlp = P.in[2]; const float* norm_final = P.in[3];
    const float* mlp_w1 = P.in[4]; const float* mlp_w2 = P.in[5];

    for (int layer = 0; layer < 4; ++layer) {
        int lane = tidv; asm volatile("" : "+v"(lane)); lane &= 63;
        int gw = gw_k; asm volatile("" : "+s"(gw));
        const bool is_rwkv = (layer & 1) != 0; const int lj = layer >> 1;
        const float* xsrc = (layer == 0) ? x_in : xres;
        {
            TJob j1{mlp_w1 + (size_t)layer * D * FF, FF, 0, FF, D, (bf16_t*)(ws + WS_W + W_MLP1), D, 0, 0, FF, D, nullptr, 0};
            transpose_job(j1, scr, gw, NGW, lane);
            TJob j2{mlp_w2 + (size_t)layer * FF * D, D, 0, D, FF, (bf16_t*)(ws + WS_W + W_MLP2), FF, 0, 0, D, FF, nullptr, 0};
            transpose_job(j2, scr, gw, NGW, lane);
            if (is_rwkv) {
                const float* mix = P.in[14] + (size_t)lj * 6 * D;
                bf16_t* WrT = (bf16_t*)(ws + WS_W + W_RW_IN);
                const float* wrkv = P.in[15] + (size_t)lj * 3 * D * D;
                for (int part = 0; part < 8; ++part) {
                    const float* W; int ldw, Nsrc, mi, r0, Npad;
                    if (part == 0) { W = wrkv; ldw = D; Nsrc = D; mi = 0; r0 = 0; Npad = D; }
                    else if (part == 1) { W = wrkv + (size_t)D * D; ldw = D; Nsrc = D; mi = 2; r0 = 1024; Npad = D; }
                    else if (part == 2) { W = wrkv + (size_t)2 * D * D; ldw = D; Nsrc = D; mi = 3; r0 = 2048; Npad = D; }
                    else if (part == 3) { W = P.in[17] + (size_t)lj * D * 64; ldw = 64; Nsrc = 64; mi = 1; r0 = 3072; Npad = 128; }
                    else if (part == 4) { W = P.in[20] + (size_t)lj * D * 64; ldw = 64; Nsrc = 64; mi = 4; r0 = 3200; Npad = 128; }
                    else if (part == 5) { W = P.in[22] + (size_t)lj * D * 160; ldw = 160; Nsrc = 160; mi = 5; r0 = 3328; Npad = 256; }
                    else if (part == 6) { W = P.in[31]; ldw = 32; Nsrc = (lj >= 1) ? 32 : 0; mi = 3; r0 = 3584; Npad = 128; }
                    else { W = P.in[31]; ldw = 32; Nsrc = 0; mi = 3; r0 = 3712; Npad = 128; }
                    TJob ja{W, ldw, 0, Nsrc, D, WrT, 2048, r0, 0, Npad, D, mix + mi * D, 1};
                    transpose_job(ja, scr, gw, NGW, lane);
                    TJob jb{W, ldw, 0, Nsrc, D, WrT, 2048, r0, 1024, Npad, D, mix + mi * D, 2};
                    transpose_job(jb, scr, gw, NGW, lane);
                }
                TJob jw{P.in[18] + (size_t)lj * 64 * D, D, 0, D, 64, (bf16_t*)(ws + WS_W + W_RW_W2), 128, 0, 0, D, 128, nullptr, 0}; transpose_job(jw, scr, gw, NGW, lane);
                TJob jaa{P.in[21] + (size_t)lj * 64 * D, D, 0, D, 64, (bf16_t*)(ws + WS_W + W_RW_A2), 128, 0, 0, D, 128, nullptr, 0}; transpose_job(jaa, scr, gw, NGW, lane);
                TJob jv{P.in[32], D, 0, D, (lj >= 1) ? 32 : 0, (bf16_t*)(ws + WS_W + W_RW_V2), 128, 0, 0, D, 128, nullptr, 0}; transpose_job(jv, scr, gw, NGW, lane);
                TJob jg{P.in[23] + (size_t)lj * 160 * D, D, 0, D, 160, (bf16_t*)(ws + WS_W + W_RW_G2), 256, 0, 0, D, 256, nullptr, 0}; transpose_job(jg, scr, gw, NGW, lane);
                TJob jo{P.in[29] + (size_t)lj * D * D, D, 0, D, D, (bf16_t*)(ws + WS_W + W_RW_O), D, 0, 0, D, D, nullptr, 0}; transpose_job(jo, scr, gw, NGW, lane);
                bf16_t* HN = (bf16_t*)(ws + A_HN);
                if (gw < 2) { u32x4* z = (u32x4*)(HN + (size_t)gw * (S + 1) * D); unsigned zz; asm volatile("v_mov_b32 %0, 0" : "=v"(zz)); for (int q = lane; q < D / 8; q += 64) z[q] = (u32x4){zz, zz, zz, zz}; }
                for (int m = gw; m < M; m += NGW) { const int b = m / S; rms_row_bf16(xsrc + (size_t)m * D, norm_mix + layer * D, HN + ((size_t)m + b + 1) * D, nullptr, lane); }
            } else {
                const float* win = P.in[6] + (size_t)lj * D * 2608;
                bf16_t* WnT = (bf16_t*)(ws + WS_W + W_NSA_IN); bf16_t* WvT = (bf16_t*)(ws + WS_W + W_NSA_V);
                for (int part = 0; part < 8; ++part) {
                    int n0src, Nsrc, r0, Npad; bf16_t* WT = WnT;
                    if (part == 0) { n0src = 0; Nsrc = 1024; r0 = 0; Npad = 1024; }
                    else if (part == 1) { n0src = 1024; Nsrc = 256; r0 = 1024; Npad = 256; }
                    else if (part == 2) { n0src = 1024 + 512; Nsrc = 256; r0 = 1280; Npad = 256; }
                    else if (part == 3) { n0src = 1024 + 1024; Nsrc = 256; r0 = 1536; Npad = 256; }
                    else if (part == 4) { n0src = 1024 + 256; Nsrc = 256; r0 = 1792; Npad = 256; }
                    else if (part == 5) { n0src = 2560; Nsrc = 48; r0 = 2048; Npad = 256; }
                    else if (part == 6) { n0src = 1024 + 768; Nsrc = 256; r0 = 0; Npad = 256; WT = WvT; }
                    else { n0src = 1024 + 1280; Nsrc = 256; r0 = 256; Npad = 256; WT = WvT; }
                    TJob jn{win, 2608, n0src, Nsrc, D, WT, D, r0, 0, Npad, D, nullptr, 0}; transpose_job(jn, scr, gw, NGW, lane);
                }
                TJob jo{P.in[13] + (size_t)lj * D * D, D, 0, D, D, (bf16_t*)(ws + WS_W + W_NSA_O), D, 0, 0, D, D, nullptr, 0}; transpose_job(jo, scr, gw, NGW, lane);
                TJob jc1k{P.in[8] + (size_t)lj * 2048 * 256, 256, 0, 256, 2048, (bf16_t*)(ws + WS_W + W_C1K), 2048, 0, 0, 256, 2048, nullptr, 0}; transpose_job(jc1k, scr, gw, NGW, lane);
                TJob jc1v{P.in[11] + (size_t)lj * 2048 * 256, 256, 0, 256, 2048, (bf16_t*)(ws + WS_W + W_C1V), 2048, 0, 0, 256, 2048, nullptr, 0}; transpose_job(jc1v, scr, gw, NGW, lane);
                TJob jc2k{P.in[9] + (size_t)lj * 256 * 64, 64, 0, 64, 256, (bf16_t*)(ws + WS_W + W_C2K), 256, 0, 0, 256, 256, nullptr, 0}; transpose_job(jc2k, scr, gw, NGW, lane);
                TJob jc2v{P.in[12] + (size_t)lj * 256 * 64, 64, 0, 64, 256, (bf16_t*)(ws + WS_W + W_C2V), 256, 0, 0, 256, 256, nullptr, 0}; transpose_job(jc2v, scr, gw, NGW, lane);
                {
                    int ln = lane; asm volatile("" : "+v"(ln));
                    float* cb = (float*)(ws + WS_W + W_CBIAS);
#pragma unroll 1
                    for (int o = gw; o < 512; o += NGW) { const int isv = o >> 8, c = o & 255;
                        const float* pe = (isv ? P.in[10] : P.in[7]) + (size_t)lj * 2048; const float* w1 = (isv ? P.in[11] : P.in[8]) + (size_t)lj * 2048 * 256;
                        float acc = 0.f;
#pragma unroll 1
                        for (int k = ln; k < 2048; k += 64) acc += pe[k] * w1[(size_t)k * 256 + c];
                        acc = wave_sum(acc); if (ln == 0) cb[o] = acc; }
                    if (layer == 0) {
                        float* rt = (float*)(ws + WS_ROPE);
                        int tix = tidv; asm volatile("" : "+v"(tix)); const int gt = (int)blockIdx.x * NTHREADS + tix;
#pragma unroll 1
                        for (int e = gt; e < S * 8; e += G * NTHREADS) { const int tt = e >> 3, i = e & 7;
                            const float invf = (i == 0) ? 1.0f : (i == 1) ? 0.1939227432012558f : (i == 2) ? 0.03760603070259094f : (i == 3) ? 0.007292664609849453f : (i == 4) ? 0.0014142135623842478f : (i == 5) ? 0.00027424818836152554f : (i == 6) ? 5.318296098266728e-05f : 1.0313386155758053e-05f;
                            const float ang = (float)tt * invf; const double rev = (double)ang * 0.15915494309189535; const float fr = (float)(rev - __builtin_rint(rev));
                            rt[tt * 16 + i] = __builtin_amdgcn_cosf(fr); rt[tt * 16 + 8 + i] = __builtin_amdgcn_sinf(fr); }
                    }
                }
                for (int m = gw; m < M; m += NGW) rms_row_bf16(xsrc + (size_t)m * D, norm_mix + layer * D, (bf16_t*)(ws + A_HN) + (size_t)m * D, (layer == 0) ? xres + (size_t)m * D : nullptr, lane);
            }
        }
        GSYNC();
        if (!is_rwkv) {
            bf16_t* HN = (bf16_t*)(ws + A_HN); bf16_t* Qb = (bf16_t*)(ws + A_Q); bf16_t* KFb = (bf16_t*)(ws + A_KF); bf16_t* VFb = (bf16_t*)(ws + A_VF);
            float* GT = (float*)(ws + A_GATES); bf16_t* CHK = (bf16_t*)(ws + A_CHK); bf16_t* CHV = (bf16_t*)(ws + A_CHV); bf16_t* KCb = (bf16_t*)(ws + A_KC); bf16_t* VCb = (bf16_t*)(ws + A_VC);
            {
                pg8::Gemm g{HN, (const bf16_t*)(ws + WS_W + W_NSA_IN), M, 2304, D, D, D, 0};
                pg8::StaticOrder so; so.init(M, 2304, G, (int)blockIdx.x);
                pg8::EpiP<FNsaIn> E{FNsaIn{Qb, KFb, GT, (const float*)(ws + WS_ROPE)}};
                pg8::gemm_phase<pg8::EpiP<FNsaIn>, true>(lds, g, so, E, tidv);
                pg8::Gemm g2{(const bf16_t*)(ws + WS_W + W_NSA_V), HN, 512, M, D, D, D, 0};
                pg8::StaticOrder so2; so2.init(512, M, G, (int)blockIdx.x);
                pg8::EpiP<FNsaVT> E2{FNsaVT{VFb}};
                pg8::gemm_phase<pg8::EpiP<FNsaVT>, true>(lds, g2, so2, E2, tidv);
            }
            GSYNC();
            {
                pg8::StaticOrder so; so.init(8192, 256, G, (int)blockIdx.x);
                { pg8::Gemm g{KFb, (const bf16_t*)(ws + WS_W + W_C1K), 8192, 256, 2048, 1024, 2048, 0}; pg8::EpiP<FCmp1> E{FCmp1{CHK, (const float*)(ws + WS_W + W_CBIAS)}}; pg8::gemm_phase<pg8::EpiP<FCmp1>, true>(lds, g, so, E, tidv); }
                { pg8::Gemm g{KFb + 3 * KF_STRIDE, (const bf16_t*)(ws + WS_W + W_C1V), 8192, 256, 2048, 1024, 2048, 0}; pg8::EpiP<FCmp1> E{FCmp1{CHV, (const float*)(ws + WS_W + W_CBIAS) + 256}}; pg8::gemm_phase<pg8::EpiP<FCmp1>, true>(lds, g, so, E, tidv); }
            }
            GSYNC();
            {
                { pg8::StaticOrder so; so.init(8192, 256, G, (int)blockIdx.x); pg8::Gemm g{CHK, (const bf16_t*)(ws + WS_W + W_C2K), 8192, 256, 256, 256, 256, 0}; pg8::EpiP<FCmp2K> E{FCmp2K{KCb}}; pg8::gemm_phase<pg8::EpiP<FCmp2K>, true>(lds, g, so, E, tidv); }
                { pg8::StaticOrder so; so.init(256, 8192, G, (int)blockIdx.x); pg8::Gemm g{(const bf16_t*)(ws + WS_W + W_C2V), CHV, 256, 8192, 256, 256, 256, 0}; pg8::EpiP<FCmp2VT> E{FCmp2VT{VCb}}; pg8::gemm_phase<pg8::EpiP<FCmp2VT>, true>(lds, g, so, E, tidv); }
            }
            GSYNC();
            nsa_attention(Qb, KFb, VFb, KCb, VCb, GT, HN, lds, G, wave, lane_id());
            tidv = wave * 64 + (lane_id() & 63); asm volatile("" : "+v"(tidv)); tidv &= 511; lane = tidv & 63;
            GSYNC();
            {
                pg8::StaticOrder so; so.init(M, D, G, (int)blockIdx.x);
                pg8::Gemm g{HN, (const bf16_t*)(ws + WS_W + W_NSA_O), M, D, D, D, D, 0}; pg8::EpiN<FResAdd> E{FResAdd{xres}}; pg8::gemm_phase<pg8::EpiN<FResAdd>, true>(lds, g, so, E, tidv);
            }
            GSYNC();
        }
        if (is_rwkv) {
            h16* Rb = (h16*)(ws + A_R); h16* Kb = (h16*)(ws + A_K); h16* Ab = (h16*)(ws + A_A); h16* EWb = (h16*)(ws + A_HN);
            h16* Vb = (lj == 0) ? (h16*)(ws + WS_VF) : (h16*)(ws + A_V2);
            h16* Yraw = (lj == 0) ? (h16*)(ws + A_V2) : (h16*)(ws + WS_VF);
            bf16_t* LH = (bf16_t*)(ws + A_LH);
            {
                pg8::Gemm g{(const bf16_t*)(ws + A_HN), (const bf16_t*)(ws + WS_W + W_RW_IN), M, 3840, 2048, D, 2048, 1};
                pg8::StaticOrder so; so.init(M, 3840, G, (int)blockIdx.x);
                pg8::EpiP<FRwIn> E{FRwIn{Rb, Kb, Vb, LH}};
                pg8::gemm_phase<pg8::EpiP<FRwIn>, true>(lds, g, so, E, tidv);
            }
            GSYNC();
            {
                pg8::StaticOrder so; so.init(M, D, G, (int)blockIdx.x);
                { pg8::Gemm g{LH, (const bf16_t*)(ws + WS_W + W_RW_W2), M, D, 128, 768, 128, 0}; pg8::EpiP<FLoraW> E{FLoraW{EWb, P.in[16] + lj * D}}; pg8::gemm_phase<pg8::EpiP<FLoraW>, true>(lds, g, so, E, tidv); }
                { pg8::Gemm g{LH + 128, (const bf16_t*)(ws + WS_W + W_RW_A2), M, D, 128, 768, 128, 0}; pg8::EpiP<FLoraA> E{FLoraA{Ab, P.in[19] + lj * D}}; pg8::gemm_phase<pg8::EpiP<FLoraA>, true>(lds, g, so, E, tidv); }
                if (lj >= 1) { pg8::Gemm g{LH + 512, (const bf16_t*)(ws + WS_W + W_RW_V2), M, D, 128, 768, 128, 0}; pg8::EpiP<FLoraV> E{FLoraV{Vb, (const h16*)(ws + WS_VF), P.in[30]}}; pg8::gemm_phase<pg8::EpiP<FLoraV>, true>(lds, g, so, E, tidv); }
            }
            GSYNC();
            rwkv_scan2(Rb, Kb, Vb, EWb, Ab, P.in[24] + lj * D, P.in[25] + lj * D, Yraw, lds, wave, lane);
            GSYNC();
            rwkv_gn(Rb, Kb, Vb, Ab, Yraw, P.in[25] + lj * D, P.in[26] + lj * D, P.in[27] + lj * D, P.in[28] + lj * D, gw, NGW, lane);
            GSYNC();
            {
                pg8::StaticOrder so; so.init(M, D, G, (int)blockIdx.x);
                pg8::Gemm g{LH + 256, (const bf16_t*)(ws + WS_W + W_RW_G2), M, D, 256, 768, 256, 0}; pg8::EpiP<FGate> E{FGate{(bf16_t*)Kb, Rb}}; pg8::gemm_phase<pg8::EpiP<FGate>, true>(lds, g, so, E, tidv);
            }
            GSYNC();
            {
                pg8::StaticOrder so; so.init(M, D, G, (int)blockIdx.x);
                pg8::Gemm g{(const bf16_t*)Kb, (const bf16_t*)(ws + WS_W + W_RW_O), M, D, D, D, D, 0}; pg8::EpiN<FResAdd> E{FResAdd{xres}}; pg8::gemm_phase<pg8::EpiN<FResAdd>, true>(lds, g, so, E, tidv);
            }
            GSYNC();
        }
        for (int m = gw; m < M; m += NGW) rms_row_bf16(xres + (size_t)m * D, norm_mlp + layer * D, (bf16_t*)(ws + A_HN) + (size_t)m * D, nullptr, lane);
        GSYNC();
        {
            pg8::Gemm g{(const bf16_t*)(ws + A_HN), (const bf16_t*)(ws + WS_W + W_MLP1), M, FF, D, D, D, 0};
            pg8::StaticOrder so; so.init(M, FF, G, (int)blockIdx.x);
            pg8::EpiP<FRelu2> E{FRelu2{(bf16_t*)(ws + A_HID)}};
            pg8::gemm_phase<pg8::EpiP<FRelu2>, true>(lds, g, so, E, tidv);
        }
        GSYNC();
        {
            pg8::Gemm g{(const bf16_t*)(ws + A_HID), (const bf16_t*)(ws + WS_W + W_MLP2), M, D, FF, FF, FF, 0};
            pg8::StaticOrder so; so.init(M, D, G, (int)blockIdx.x);
            pg8::EpiN<FResAdd> E{FResAdd{xres}};
            pg8::gemm_phase<pg8::EpiN<FResAdd>, true>(lds, g, so, E, tidv);
        }
        GSYNC();
    }
    for (int m = gw_k; m < M; m += NGW) {
        int lane2 = tidv; asm volatile("" : "+v"(lane2)); lane2 &= 63;
        f32x4* xr = (f32x4*)(xres + (size_t)m * D) + lane2; const f32x4* gr = (const f32x4*)norm_final + lane2;
        f32x4 v[4]; float s = 0.f;
#pragma unroll
        for (int j = 0; j < 4; ++j) { v[j] = xr[64 * j]; s += (v[j].x * v[j].x + v[j].y * v[j].y) + (v[j].z * v[j].z + v[j].w * v[j].w); }
        const float r = rsqrtf(wave_sum(s) * (1.f / D) + 1e-5f);
#pragma unroll
        for (int j = 0; j < 4; ++j) { const f32x4 gg = gr[64 * j]; xr[64 * j] = v[j] * r * gg; }
    }
}

extern "C" void kernel_launch(void* const* d_in, const int* in_sizes, int n_in, void* d_out, int out_size, void* d_ws, size_t ws_size, hipStream_t stream) {
    static int grid = 0;
    if (grid == 0) {
        if (n_in != 33 || out_size != M * D || ws_size < WS_NEED) { fprintf(stderr, "kernel_launch: unexpected sizes n_in %d out %d ws %zu (need %zu)\n", n_in, out_size, ws_size, (size_t)WS_NEED); grid = -1; return; }
        int dev = 0, cus = 0, per_cu = 0;
        hipGetDevice(&dev);
        hipDeviceGetAttribute(&cus, hipDeviceAttributeMultiprocessorCount, dev);
        if (hipFuncSetAttribute((const void*)fwd_kernel, hipFuncAttributeMaxDynamicSharedMemorySize, LDS_BYTES) != hipSuccess) { fprintf(stderr, "hipFuncSetAttribute failed\n"); grid = -1; return; }
        hipOccupancyMaxActiveBlocksPerMultiprocessor(&per_cu, (const void*)fwd_kernel, NTHREADS, LDS_BYTES);
        if (per_cu < 1) { fprintf(stderr, "occupancy query returned %d\n", per_cu); per_cu = 1; }
        (void)hipGetLastError();
        grid = cus * 1;
    }
    if (grid < 0) return;
    Params p{};
    for (int i = 0; i < 33; ++i) p.in[i] = (const float*)d_in[i];
    p.out = (float*)d_out; p.ws = (unsigned char*)d_ws;
    void* args[] = {&p};
    hipError_t e = hipLaunchCooperativeKernel((const void*)fwd_kernel, dim3(grid), dim3(NTHREADS), args, LDS_BYTES, stream);
    if (e != hipSuccess) fprintf(stderr, "cooperative launch failed: %s (grid %d)\n", hipGetErrorString(e), grid);
}
```

```cpp
#include <hip/hip_runtime.h>
#include <hip/hip_cooperative_groups.h>
#include <cstdio>
#include <cstdint>
namespace cg = cooperative_groups;

#define LAS __attribute__((address_space(3)))
typedef unsigned short bf16_t;
typedef short bf16x8 __attribute__((ext_vector_type(8)));
typedef float f32x4 __attribute__((ext_vector_type(4)));
typedef float f32x2 __attribute__((ext_vector_type(2)));
typedef unsigned u32x4 __attribute__((ext_vector_type(4)));
typedef unsigned u32x2 __attribute__((ext_vector_type(2)));
typedef _Float16 h16;
typedef _Float16 h16x2 __attribute__((ext_vector_type(2)));

constexpr int S = 16384, NB = 2, M = NB * S, D = 1024, FF = 4096;
constexpr int NWAVES = 8, NTHREADS = 512;
constexpr int LDS_BYTES = 147456 + 64;
constexpr size_t MiB = 1u << 20;
constexpr size_t WS_W = 0;
constexpr size_t W_MLP1 = 0, W_MLP2 = 8 * MiB;
constexpr size_t W_NSA_IN = 16 * MiB, W_NSA_V = 21 * MiB, W_NSA_O = 22 * MiB, W_C1K = 24 * MiB, W_C1V = 25 * MiB, W_C2K = 26 * MiB, W_C2V = 26 * MiB + 256 * 1024, W_CBIAS = 26 * MiB + 512 * 1024;
constexpr size_t W_RW_IN = 16 * MiB, W_RW_W2 = 31 * MiB, W_RW_A2 = 31 * MiB + 256 * 1024, W_RW_V2 = 31 * MiB + 512 * 1024, W_RW_G2 = 31 * MiB + 768 * 1024, W_RW_O = 33 * MiB;
constexpr size_t WS_ROPE = 36 * MiB;
constexpr size_t WS_BAR = 38 * MiB;
constexpr size_t WS_VF = 40 * MiB;
constexpr size_t ACT = 104 * MiB;
constexpr size_t A_HN = ACT;
constexpr size_t A_Q = ACT + 65 * MiB;
constexpr size_t A_KF = ACT + 129 * MiB;
constexpr size_t A_VF = ACT + 194 * MiB;
constexpr size_t A_GATES = ACT + 226 * MiB;
constexpr size_t A_CHK = ACT + 233 * MiB, A_CHV = ACT + 237 * MiB, A_KC = ACT + 241 * MiB, A_VC = ACT + 242 * MiB;
constexpr size_t A_HID = ACT + 65 * MiB;
constexpr size_t A_R = ACT + 65 * MiB, A_K = ACT + 129 * MiB, A_V2 = ACT + 193 * MiB, A_A = ACT + 257 * MiB, A_LH = ACT + 321 * MiB;
constexpr size_t WS_NEED = ACT + 370 * MiB;

__device__ __forceinline__ int lane_id() { return (int)__builtin_amdgcn_mbcnt_hi(~0u, __builtin_amdgcn_mbcnt_lo(~0u, 0u)); }
__device__ __forceinline__ unsigned cvt_pk_bf16(float lo, float hi) { unsigned r; asm volatile("v_cvt_pk_bf16_f32 %0, %1, %2" : "=v"(r) : "v"(lo), "v"(hi)); return r; }
__device__ __forceinline__ unsigned pk_h16(float lo, float hi) { h16x2 v; v.x = (h16)lo; v.y = (h16)hi; return __builtin_bit_cast(unsigned, v); }
__device__ __forceinline__ float bf2f(bf16_t b) { return __uint_as_float(((unsigned)b) << 16); }
__device__ __forceinline__ float wave_sum(float v) {
#pragma unroll
    for (int o = 1; o < 64; o <<= 1) v += __shfl_xor(v, o);
    return v;
}
__device__ __forceinline__ float sigmoidf_(float x) { return 1.0f / (1.0f + __expf(-x)); }
__device__ __forceinline__ float tanhf_(float x) { float e = __expf(-2.0f * fabsf(x)); float t = (1.0f - e) / (1.0f + e); return x < 0.f ? -t : t; }

namespace pg8 {
constexpr int BM = 256, BK = 64, HALF = 128, HTB = HALF * BK * 2, STAGE_BYTES = 8 * HTB, NXCD = 8, WGM = 8;
__host__ __device__ __forceinline__ int lds_byte(int r, int c) { const int st = (r >> 4) * 2 + (c >> 5), rr = r & 15, cc = c & 31, ob = rr * 64 + cc * 2; return st * 1024 + (ob ^ (((ob >> 9) & 1) << 5)); }
__host__ __device__ __forceinline__ void stage_rc(int b, int& R, int& C) { const int st = b / 1024, sb = b % 1024, swz = sb ^ (((sb >> 9) & 1) << 5); R = (st >> 1) * 16 + swz / 64; C = (st & 1) * 32 + (swz % 64) / 2; }
__host__ __device__ __forceinline__ int perm32(int rho) { const int n = rho >> 4, i = rho & 15; return 8 * (i >> 2) + 4 * n + (i & 3); }
struct Unit { int pm, pn; };
struct Gemm { const bf16_t* A; const bf16_t* Bt; int M, N, K, lda, ldb, amode; };
struct StaticOrder {
    int nM, nN, nwg, G, c;
    __device__ void init(int M_, int N_, int G_, int c_) { nM = M_ / BM; nN = N_ / BM; nwg = nM * nN; G = G_; c = c_; }
    __device__ bool next(int i, Unit& u) const {
        const long L = (long)i * G + c; if (L >= nwg) return false;
        int wgid = (int)L; { const int q = nwg / NXCD, r = nwg % NXCD, xcd = wgid % NXCD, off = wgid / NXCD; wgid = (xcd < r ? xcd * (q + 1) : r * (q + 1) + (xcd - r) * q) + off; }
        const int nig = WGM * nN, gid = wgid / nig, fm = gid * WGM, gsz = (nM - fm) < WGM ? (nM - fm) : WGM;
        u.pm = fm + ((wgid % nig) % gsz); u.pn = (wgid % nig) / gsz; return true;
    }
};
__device__ __forceinline__ const char* a_base(const Gemm& g, int pm) { const size_t row = (size_t)pm * BM + (g.amode == 1 ? (size_t)(pm / 64) : 0); return (const char*)g.A + row * (size_t)g.lda * 2; }

template <class Epi, bool ALIGN_EPI>
__device__ __forceinline__ void gemm_phase(LAS unsigned char* lds, const Gemm g, const StaticOrder& S, const Epi& E, int tid_in) {
    int tid = tid_in; asm volatile("" : "+v"(tid));
    const int wid = __builtin_amdgcn_readfirstlane(tid >> 6), lane = tid & 63, wr = wid >> 2, wc = wid & 3, fr = lane & 15, fq = lane >> 4;
    int K = g.K; asm volatile("" : "+s"(K));
    const int nt = K / BK;
    unsigned voffA[2], voffB[2];
#pragma unroll
    for (int i = 0; i < 2; ++i) { int R, C; stage_rc(tid * 16 + i * 8192, R, C); const int Rb = Epi::PERM ? ((R & ~31) + perm32(R & 31)) : R;
        voffA[i] = (unsigned)(R * g.lda + C) * 2u; voffB[i] = (unsigned)(Rb * g.ldb + C) * 2u; }
    const size_t kstep = (size_t)(BK * 2);
    const size_t hstepA = (size_t)HALF * g.lda * 2, hstepB = (size_t)HALF * g.ldb * 2;
    const size_t tstepB = 2 * hstepB;
    const unsigned ldsw = (unsigned)wid * 1024u;
    const int aoff = lds_byte(wr * 64 + fr, fq * 8), boff = lds_byte(wc * 32 + fr, fq * 8);
#define PG8_SA(b, h) (((b) * 2 + (h)) * HTB)
#define PG8_SB(b, h) ((4 + (b) * 2 + (h)) * HTB)
#define PG8_STAGE(bufoff, gbase, voff) do { _Pragma("unroll") for (int _i = 0; _i < 2; ++_i) \
        __builtin_amdgcn_global_load_lds((const unsigned*)((const char*)(gbase) + (voff)[_i]), (LAS unsigned*)(lds + (bufoff) + ldsw + _i * 8192), 16, 0, 0); } while (0)
#define PG8_LDA(dst, b, h) do { _Pragma("unroll") for (int m = 0; m < 4; ++m) _Pragma("unroll") for (int k = 0; k < 2; ++k) dst[m][k] = *(const LAS bf16x8*)(lds + PG8_SA(b, h) + aoff + m * 2048 + k * 1024); } while (0)
#define PG8_LDB(dst, b, h) do { _Pragma("unroll") for (int n = 0; n < 2; ++n) _Pragma("unroll") for (int k = 0; k < 2; ++k) dst[n][k] = *(const LAS bf16x8*)(lds + PG8_SB(b, h) + boff + n * 2048 + k * 1024); } while (0)
#define PG8_MMA(ai, bj, At, Bt) do { __builtin_amdgcn_s_setprio(1); _Pragma("unroll") for (int m = 0; m < 4; ++m) _Pragma("unroll") for (int n = 0; n < 2; ++n) _Pragma("unroll") for (int k = 0; k < 2; ++k) \
        acc[ai][bj][m][n] = __builtin_amdgcn_mfma_f32_16x16x32_bf16(Bt[n][k], At[m][k], acc[ai][bj][m][n], 0, 0, 0); __builtin_amdgcn_s_setprio(0); } while (0)
#define PG8_WAIT_V(n) asm volatile("s_waitcnt vmcnt(" #n ")" ::: "memory")
#define PG8_WAIT_L(n) asm volatile("s_waitcnt lgkmcnt(" #n ")" ::: "memory")
#define PG8_BAR __builtin_amdgcn_s_barrier()
#define PG8_SCHED __builtin_amdgcn_sched_barrier(0)
    Unit cur, nxt; int ui = 0;
    if (!S.next(0, cur)) return;
    f32x4 acc[2][2][4][2];
#pragma unroll
    for (int a = 0; a < 2; ++a)
#pragma unroll
        for (int b = 0; b < 2; ++b)
#pragma unroll
            for (int m = 0; m < 4; ++m)
#pragma unroll
                for (int n = 0; n < 2; ++n) acc[a][b][m][n] = (f32x4){0.f, 0.f, 0.f, 0.f};
    bf16x8 At[4][2], B0[2][2], B1[2][2];
    const char* cA = a_base(g, cur.pm); const char* cB = (const char*)g.Bt + (size_t)cur.pn * tstepB;
    PG8_STAGE(PG8_SB(0, 0), cB, voffB); PG8_STAGE(PG8_SB(0, 1), cB + hstepB, voffB); PG8_STAGE(PG8_SA(0, 0), cA, voffA); PG8_STAGE(PG8_SA(0, 1), cA + hstepA, voffA);
    if (wr == 1) PG8_BAR;
    PG8_WAIT_V(2); PG8_BAR;
    PG8_STAGE(PG8_SB(1, 0), cB + kstep, voffB); PG8_STAGE(PG8_SA(1, 0), cA + kstep, voffA); PG8_STAGE(PG8_SB(1, 1), cB + hstepB + kstep, voffB);
    PG8_WAIT_V(6); PG8_BAR;
    for (;;) {
        const bool has_next = S.next(ui + 1, nxt);
        const char* nA = has_next ? a_base(g, nxt.pm) : cA; const char* nB = has_next ? (const char*)g.Bt + (size_t)nxt.pn * tstepB : cB;
        for (int t = 0; t < nt; t += 2) {
            const bool last = (t == nt - 2);
            const char* a1 = cA + (size_t)(t + 1) * kstep;
            const char* a2 = last ? nA : cA + (size_t)(t + 2) * kstep; const char* b2 = last ? nB : cB + (size_t)(t + 2) * kstep;
            const char* a3 = a2 + kstep; const char* b3 = b2 + kstep;
            PG8_LDB(B0, 0, 0); PG8_LDB(B1, 0, 1); PG8_SCHED; PG8_LDA(At, 0, 0); PG8_STAGE(PG8_SA(1, 1), a1 + hstepA, voffA);
            PG8_WAIT_V(8); PG8_WAIT_L(0); PG8_BAR; PG8_MMA(0, 0, At, B0); PG8_MMA(0, 1, At, B1); PG8_BAR; PG8_SCHED;
            PG8_LDA(At, 0, 1); PG8_STAGE(PG8_SB(0, 0), b2, voffB); PG8_STAGE(PG8_SB(0, 1), b2 + hstepB, voffB); PG8_STAGE(PG8_SA(0, 0), a2, voffA);
            PG8_WAIT_V(8); PG8_WAIT_L(0); PG8_BAR; PG8_MMA(1, 0, At, B0); PG8_MMA(1, 1, At, B1); PG8_BAR; PG8_SCHED;
            PG8_LDB(B0, 1, 0); PG8_LDB(B1, 1, 1); PG8_SCHED; PG8_LDA(At, 1, 0); PG8_STAGE(PG8_SA(0, 1), a2 + hstepA, voffA);
            PG8_WAIT_V(8); PG8_WAIT_L(0); PG8_BAR; PG8_MMA(0, 0, At, B0); PG8_MMA(0, 1, At, B1); PG8_BAR; PG8_SCHED;
            PG8_LDA(At, 1, 1); PG8_STAGE(PG8_SB(1, 0), b3, voffB); PG8_STAGE(PG8_SB(1, 1), b3 + hstepB, voffB); PG8_STAGE(PG8_SA(1, 0), a3, voffA);
            PG8_WAIT_V(8); PG8_WAIT_L(0); PG8_BAR; PG8_MMA(1, 0, At, B0); PG8_MMA(1, 1, At, B1); PG8_BAR; PG8_SCHED;
        }
        if constexpr (ALIGN_EPI) { if (wr == 0) PG8_BAR; }
        E(acc, cur, wr, wc, fr, fq);
        if (!has_next) break;
#pragma unroll
        for (int a = 0; a < 2; ++a)
#pragma unroll
            for (int b = 0; b < 2; ++b)
#pragma unroll
                for (int m = 0; m < 4; ++m)
#pragma unroll
                    for (int n = 0; n < 2; ++n) acc[a][b][m][n] = (f32x4){0.f, 0.f, 0.f, 0.f};
        cur = nxt; cA = nA; cB = nB; ++ui;
        if constexpr (ALIGN_EPI) { if (wr == 1) PG8_BAR; }
    }
    PG8_WAIT_V(0);
    if constexpr (!ALIGN_EPI) { if (wr == 0) PG8_BAR; }
    PG8_BAR;
#undef PG8_SA
#undef PG8_SB
#undef PG8_STAGE
#undef PG8_LDA
#undef PG8_LDB
#undef PG8_MMA
#undef PG8_WAIT_V
#undef PG8_WAIT_L
#undef PG8_BAR
#undef PG8_SCHED
}
template <class F> struct EpiP {
    static constexpr bool PERM = true; F f;
    __device__ __forceinline__ void operator()(const f32x4 (&acc)[2][2][4][2], const Unit& u, int wr, int wc, int fr, int fq) const {
#pragma unroll
        for (int ai = 0; ai < 2; ++ai)
#pragma unroll
            for (int m = 0; m < 4; ++m) { int row = u.pm * BM + ai * HALF + wr * 64 + m * 16 + fr; asm volatile("" : "+v"(row));
#pragma unroll
                for (int bj = 0; bj < 2; ++bj) { const int col0 = u.pn * BM + bj * HALF + wc * 32 + 8 * fq; f(row, col0, acc[ai][bj][m][0], acc[ai][bj][m][1]); } asm volatile("" ::: "memory"); }
    }
};
template <class F> struct EpiN {
    static constexpr bool PERM = false; F f;
    __device__ __forceinline__ void operator()(const f32x4 (&acc)[2][2][4][2], const Unit& u, int wr, int wc, int fr, int fq) const {
#pragma unroll
        for (int ai = 0; ai < 2; ++ai)
#pragma unroll
            for (int m = 0; m < 4; ++m) { int row = u.pm * BM + ai * HALF + wr * 64 + m * 16 + fr; asm volatile("" : "+v"(row));
#pragma unroll
                for (int bj = 0; bj < 2; ++bj)
#pragma unroll
                    for (int n = 0; n < 2; ++n) { const int col0 = u.pn * BM + bj * HALF + wc * 32 + 16 * n + 4 * fq; f(row, col0, acc[ai][bj][m][n]); } asm volatile("" ::: "memory"); }
    }
};
}

struct Params {
    const float* in[33];
    float* out;
    unsigned char* ws;
};

struct TJob { const float* W; int ldw, n0src, Nsrc, Ksrc; bf16_t* WT; int ldt, row_off, col_off, Npad, Kpad; const float* mix; int mode; };
__device__ __forceinline__ void transpose_job(const TJob& j, LAS float* scr, int gw, int NGW, int lane_) {
    int lane = lane_; asm volatile("" : "+v"(lane));
    const int nblk = j.Npad / 32, kblk = j.Kpad / 64, items = nblk * kblk;
    for (int it = gw; it < items; it += NGW) {
        const int kb = it / nblk, nb = it % nblk, k0 = 64 * kb, n0 = 32 * nb;
#pragma unroll 4
        for (int i = 0; i < 32; ++i) { const int kk = 2 * i + (lane >> 5), n = lane & 31; float v = 0.f;
            if (k0 + kk < j.Ksrc && n0 + n < j.Nsrc) { v = j.W[(size_t)(k0 + kk) * j.ldw + j.n0src + n0 + n];
                if (j.mode == 1) v *= j.mix[k0 + kk]; else if (j.mode == 2) v *= (1.0f - j.mix[k0 + kk]); }
            scr[kk * 33 + n] = v; }
        asm volatile("s_waitcnt lgkmcnt(0)" ::: "memory");
        const int c = lane & 7;
#pragma unroll
        for (int jj = 0; jj < 4; ++jj) { const int n = (lane >> 3) + 8 * jj; const LAS float* s = scr + (8 * c) * 33 + n;
            u32x4 o; o.x = cvt_pk_bf16(s[0 * 33], s[1 * 33]); o.y = cvt_pk_bf16(s[2 * 33], s[3 * 33]); o.z = cvt_pk_bf16(s[4 * 33], s[5 * 33]); o.w = cvt_pk_bf16(s[6 * 33], s[7 * 33]);
            *(u32x4*)(j.WT + (size_t)(j.row_off + n0 + n) * j.ldt + j.col_off + k0 + 8 * c) = o; }
        asm volatile("s_waitcnt lgkmcnt(0)" ::: "memory");
    }
}

__device__ __forceinline__ void rms_row_bf16(const float* xrow, const float* g, bf16_t* orow, float* copy_to, int lane_) {
    int lane = lane_; asm volatile("" : "+v"(lane));
    const f32x4* xr = (const f32x4*)xrow + lane; const f32x4* gr = (const f32x4*)g + lane;
    f32x4 v[4]; float s = 0.f;
#pragma unroll
    for (int j = 0; j < 4; ++j) { v[j] = xr[64 * j]; s += (v[j].x * v[j].x + v[j].y * v[j].y) + (v[j].z * v[j].z + v[j].w * v[j].w); }
    if (copy_to) {
#pragma unroll
        for (int j = 0; j < 4; ++j) ((f32x4*)copy_to + lane)[64 * j] = v[j];
    }
    const float r = rsqrtf(wave_sum(s) * (1.f / D) + 1e-5f);
    u32x2* o8 = (u32x2*)orow + lane;
#pragma unroll
    for (int j = 0; j < 4; ++j) { const f32x4 gg = gr[64 * j]; u32x2 w; w.x = cvt_pk_bf16(v[j].x * r * gg.x, v[j].y * r * gg.y); w.y = cvt_pk_bf16(v[j].z * r * gg.z, v[j].w * r * gg.w); o8[64 * j] = w; }
}

struct FRelu2 { bf16_t* O; __device__ __forceinline__ void operator()(int row, int col0, f32x4 a, f32x4 b) const {
    f32x4 x = a, y = b;
#pragma unroll
    for (int i = 0; i < 4; ++i) { float t = fmaxf(x[i], 0.f); x[i] = t * t; t = fmaxf(y[i], 0.f); y[i] = t * t; }
    u32x4 w; w.x = cvt_pk_bf16(x[0], x[1]); w.y = cvt_pk_bf16(x[2], x[3]); w.z = cvt_pk_bf16(y[0], y[1]); w.w = cvt_pk_bf16(y[2], y[3]);
    *(u32x4*)(O + (size_t)row * FF + col0) = w; } };
struct FResAdd { float* X; __device__ __forceinline__ void operator()(int row, int col0, f32x4 a) const {
    f32x4* p = (f32x4*)(X + (size_t)row * D + col0); *p = *p + a; } };


struct FRwIn { h16* R; h16* Kk; h16* V; bf16_t* LH;
    __device__ __forceinline__ void operator()(int row, int col0, f32x4 a, f32x4 b) const {
        const int seg = __builtin_amdgcn_readfirstlane(col0 >> 10);
        if (seg < 3) { const long dK = (const char*)Kk - (const char*)R, dV = (const char*)V - (const char*)R; const long off = (seg == 1 ? dK : 0l) + (seg == 2 ? dV : 0l); h16* dst = (h16*)((char*)R + off); const int c = col0 & 1023;
            u32x4 w; w.x = pk_h16(a[0], a[1]); w.y = pk_h16(a[2], a[3]); w.z = pk_h16(b[0], b[1]); w.w = pk_h16(b[2], b[3]);
            *(u32x4*)(dst + (size_t)row * D + c) = w; }
        else { const int c = col0 - 3072; f32x4 x = a, y = b;
            if (c < 128) {
#pragma unroll
                for (int i = 0; i < 4; ++i) { x[i] = tanhf_(x[i]); y[i] = tanhf_(y[i]); } }
            else if (c >= 256 && c < 512) {
#pragma unroll
                for (int i = 0; i < 4; ++i) { x[i] = sigmoidf_(x[i]); y[i] = sigmoidf_(y[i]); } }
            u32x4 w; w.x = cvt_pk_bf16(x[0], x[1]); w.y = cvt_pk_bf16(x[2], x[3]); w.z = cvt_pk_bf16(y[0], y[1]); w.w = cvt_pk_bf16(y[2], y[3]);
            *(u32x4*)(LH + (size_t)row * 768 + c) = w; }
    } };
struct FLoraW { h16* EW; const float* w0;
    __device__ __forceinline__ void operator()(int row, int col0, f32x4 a, f32x4 b) const {
        const f32x4 p = *(const f32x4*)(w0 + col0), q = *(const f32x4*)(w0 + col0 + 4); float o[8];
#pragma unroll
        for (int i = 0; i < 4; ++i) { o[i] = 0.60653066f * sigmoidf_(p[i] + a[i]); o[4 + i] = 0.60653066f * sigmoidf_(q[i] + b[i]); }
        u32x4 w; w.x = pk_h16(o[0], o[1]); w.y = pk_h16(o[2], o[3]); w.z = pk_h16(o[4], o[5]); w.w = pk_h16(o[6], o[7]);
        *(u32x4*)(EW + (size_t)row * D + col0) = w; } };
struct FLoraA { h16* Aa; const float* a0;
    __device__ __forceinline__ void operator()(int row, int col0, f32x4 a, f32x4 b) const {
        const f32x4 p = *(const f32x4*)(a0 + col0), q = *(const f32x4*)(a0 + col0 + 4); float o[8];
#pragma unroll
        for (int i = 0; i < 4; ++i) { o[i] = sigmoidf_(p[i] + a[i]); o[4 + i] = sigmoidf_(q[i] + b[i]); }
        u32x4 w; w.x = pk_h16(o[0], o[1]); w.y = pk_h16(o[2], o[3]); w.z = pk_h16(o[4], o[5]); w.w = pk_h16(o[6], o[7]);
        *(u32x4*)(Aa + (size_t)row * D + col0) = w; } };
struct FLoraV { h16* V; const h16* VFm; const float* v0;
    __device__ __forceinline__ void operator()(int row, int col0, f32x4 a, f32x4 b) const {
        const f32x4 p = *(const f32x4*)(v0 + col0), q = *(const f32x4*)(v0 + col0 + 4);
        typedef h16 h16x8 __attribute__((ext_vector_type(8)));
        const h16x8 vv = *(const h16x8*)(V + (size_t)row * D + col0), vf = *(const h16x8*)(VFm + (size_t)row * D + col0); float o[8];
#pragma unroll
        for (int i = 0; i < 4; ++i) { float v = (float)vv[i], f = (float)vf[i]; o[i] = v + (f - v) * sigmoidf_(p[i] + a[i]); v = (float)vv[4 + i]; f = (float)vf[4 + i]; o[4 + i] = v + (f - v) * sigmoidf_(q[i] + b[i]); }
        u32x4 w; w.x = pk_h16(o[0], o[1]); w.y = pk_h16(o[2], o[3]); w.z = pk_h16(o[4], o[5]); w.w = pk_h16(o[6], o[7]);
        *(u32x4*)(V + (size_t)row * D + col0) = w; } };
struct FGate { bf16_t* O; const h16* Y;
    __device__ __forceinline__ void operator()(int row, int col0, f32x4 a, f32x4 b) const {
        typedef h16 h16x8 __attribute__((ext_vector_type(8)));
        const h16x8 yy = *(const h16x8*)(Y + (size_t)row * D + col0);
        u32x4 w; w.x = cvt_pk_bf16(a[0] * (float)yy[0], a[1] * (float)yy[1]); w.y = cvt_pk_bf16(a[2] * (float)yy[2], a[3] * (float)yy[3]);
        w.z = cvt_pk_bf16(b[0] * (float)yy[4], b[1] * (float)yy[5]); w.w = cvt_pk_bf16(b[2] * (float)yy[6], b[3] * (float)yy[7]);
        *(u32x4*)(O + (size_t)row * D + col0) = w; } };

template <int CTRL> __device__ __forceinline__ float dppmov(float v) { return __builtin_bit_cast(float, __builtin_amdgcn_update_dpp(0, __builtin_bit_cast(int, v), CTRL, 0xF, 0xF, true)); }
__device__ __forceinline__ float row16_sum(float v) { v += dppmov<0xB1>(v); v += dppmov<0x4E>(v); v += dppmov<0x124>(v); v += dppmov<0x128>(v); return v; }
typedef _Float16 h16x4 __attribute__((ext_vector_type(4)));
__device__ __forceinline__ void h4_to_f(h16x4 u, float* f) { f[0] = (float)u[0]; f[1] = (float)u[1]; f[2] = (float)u[2]; f[3] = (float)u[3]; }
__device__ __forceinline__ void rwkv_scan(const h16* R, const h16* Kk, const h16* V, const h16* EW, const h16* Aa, const float* k_k, const float* k_a, h16* Yraw, int G, int wave, int lane_) {
    int lane = lane_; asm volatile("" : "+v"(lane));
    const int NT = G * NWAVES;
    for (int task = wave * G + (int)blockIdx.x; task < 512; task += NT) {
        const int bh = task >> 4, rg = task & 15, b = bh >> 4, h = bh & 15;
        const int row = lane >> 4, jg = lane & 15, i = rg * 4 + row;
        const int colj = h * 64 + 4 * jg, coli = h * 64 + i;
        float kkc[4], kac[4];
#pragma unroll
        for (int j = 0; j < 4; ++j) { kkc[j] = k_k[colj + j]; kac[j] = k_a[colj + j]; }
        float s[4] = {0.f, 0.f, 0.f, 0.f};
        const size_t base = (size_t)b * S * D;
        const h16* pR = R + base + colj; const h16* pK = Kk + base + colj; const h16* pA = Aa + base + colj; const h16* pE = EW + base + colj; const h16* pV = V + base + coli;
        h16* pY = Yraw + ((size_t)task * S) * 4 + row;
        constexpr int TC = 4;
        h16x4 cr[TC], ck[TC], ca[TC], ce[TC]; h16 cv[TC];
#pragma unroll
        for (int u = 0; u < TC; ++u) { const size_t o = (size_t)u * D; cr[u] = *(const h16x4*)(pR + o); ck[u] = *(const h16x4*)(pK + o); ca[u] = *(const h16x4*)(pA + o); ce[u] = *(const h16x4*)(pE + o); cv[u] = pV[o]; }
        for (int t0 = 0; t0 < S; t0 += TC) {
            const int tn = (t0 + TC < S) ? t0 + TC : t0;
            h16x4 nr[TC], nk[TC], na[TC], ne[TC]; h16 nv[TC];
#pragma unroll
            for (int u = 0; u < TC; ++u) { const size_t o = (size_t)(tn + u) * D; nr[u] = *(const h16x4*)(pR + o); nk[u] = *(const h16x4*)(pK + o); na[u] = *(const h16x4*)(pA + o); ne[u] = *(const h16x4*)(pE + o); nv[u] = pV[o]; }
#pragma unroll
            for (int u = 0; u < TC; ++u) {
                float rv[4], kv[4], av[4], ev[4]; h4_to_f(cr[u], rv); h4_to_f(ck[u], kv); h4_to_f(ca[u], av); h4_to_f(ce[u], ev);
                const float vi = (float)cv[u];
                float kq[4], n2 = 0.f;
#pragma unroll
                for (int j = 0; j < 4; ++j) { kq[j] = kv[j] * kkc[j]; n2 += kq[j] * kq[j]; }
                n2 = row16_sum(n2);
                const float inv = 1.0f / fmaxf(sqrtf(n2), 1e-12f);
                float kkj[4], kt[4], bb[4], w[4], dot = 0.f;
#pragma unroll
                for (int j = 0; j < 4; ++j) { kkj[j] = kq[j] * inv; kt[j] = kv[j] * (1.0f + (av[j] - 1.0f) * kac[j]); bb[j] = kkj[j] * av[j]; w[j] = __expf(-ev[j]); dot += s[j] * kkj[j]; }
                const float sa = -row16_sum(dot);
                float yd = 0.f;
#pragma unroll
                for (int j = 0; j < 4; ++j) { s[j] = s[j] * w[j] + (sa * bb[j] + vi * kt[j]); yd += s[j] * rv[j]; }
                const float y = row16_sum(yd);
                if (jg == 0) pY[(size_t)(t0 + u) * 4] = (h16)y;
            }
#pragma unroll
            for (int u = 0; u < TC; ++u) { cr[u] = nr[u]; ck[u] = nk[u]; ca[u] = na[u]; ce[u] = ne[u]; cv[u] = nv[u]; }
        }
    }
}
constexpr int SC_CS = 32, SC_STEP_F = 5 * 64 + 8, SC_BUF_F = SC_CS * SC_STEP_F;
#define SC_BAR() do { asm volatile("s_waitcnt lgkmcnt(0)" ::: "memory"); __builtin_amdgcn_s_barrier(); asm volatile("" ::: "memory"); } while (0)
__device__ __forceinline__ float wave_sum_dpp(float v) {
    v = row16_sum(v);
    const float a = __builtin_bit_cast(float, __builtin_amdgcn_readlane(__builtin_bit_cast(int, v), 0)), b = __builtin_bit_cast(float, __builtin_amdgcn_readlane(__builtin_bit_cast(int, v), 16));
    const float c = __builtin_bit_cast(float, __builtin_amdgcn_readlane(__builtin_bit_cast(int, v), 32)), d = __builtin_bit_cast(float, __builtin_amdgcn_readlane(__builtin_bit_cast(int, v), 48));
    return (a + b) + (c + d);
}
struct ScRegs { h16 k[8], a[8], e[8], r[8], v[8]; };
__device__ __forceinline__ void sc_load(ScRegs& g, const h16* R, const h16* Kk, const h16* V, const h16* EW, const h16* Aa, size_t base, int c, int pw, int sub, int lane) {
#pragma unroll
    for (int q = 0; q < 8; ++q) { const size_t o = base + (size_t)(c * SC_CS + pw + 4 * q) * D;
        g.k[q] = Kk[o + lane]; g.a[q] = Aa[o + lane]; g.e[q] = EW[o + lane]; g.r[q] = R[o + lane]; g.v[q] = V[o + sub * 8 + (lane & 7)]; }
}
__device__ __forceinline__ void sc_compute(const ScRegs& g, LAS float* sb, int pw, float kkc, float kac, int lane) {
#pragma unroll
    for (int q = 0; q < 8; ++q) {
        const float kv = (float)g.k[q], av = (float)g.a[q], ev = (float)g.e[q], rv = (float)g.r[q]; const float kq = kv * kkc;
        const float n2 = wave_sum_dpp(kq * kq);
        const float kkj = kq * rsqrtf(fmaxf(n2, 1e-24f)); LAS float* p = sb + (pw + 4 * q) * SC_STEP_F;
        p[lane] = kkj; p[64 + lane] = kkj * av; p[128 + lane] = kv * (1.0f + (av - 1.0f) * kac); p[192 + lane] = __expf(-ev); p[256 + lane] = rv; if (lane < 8) p[320 + lane] = (float)g.v[q];
    }
}
__device__ __forceinline__ void rwkv_scan2(const h16* R, const h16* Kk, const h16* V, const h16* EW, const h16* Aa, const float* k_k, const float* k_a, h16* Yraw, LAS unsigned char* lds, int wave, int lane_) {
    int lane = lane_; asm volatile("" : "+v"(lane));
    LAS float* buf = (LAS float*)lds;
    constexpr int NCH = S / SC_CS;
#pragma unroll 1
    for (int vb = (int)blockIdx.x; vb < 256; vb += (int)gridDim.x) {
        const int bh = vb >> 3, sub = vb & 7, b = bh >> 4, h = bh & 15;
        const size_t base = (size_t)b * S * D + h * 64;
        if (wave >= 4) {
            const int pw = wave - 4;
            const float kkc = k_k[h * 64 + lane], kac = k_a[h * 64 + lane];
            ScRegs ga, gb;
            sc_load(ga, R, Kk, V, EW, Aa, base, 0, pw, sub, lane);
            sc_load(gb, R, Kk, V, EW, Aa, base, 1, pw, sub, lane);
            sc_compute(ga, buf, pw, kkc, kac, lane);
            SC_BAR();
#pragma unroll 1
            for (int c = 0; c < NCH; c += 2) {
                { const int c2 = (c + 2 < NCH) ? c + 2 : c; sc_load(ga, R, Kk, V, EW, Aa, base, c2, pw, sub, lane); }
                sc_compute(gb, buf + SC_BUF_F, pw, kkc, kac, lane);
                SC_BAR();
                { const int c3 = (c + 3 < NCH) ? c + 3 : c + 1; sc_load(gb, R, Kk, V, EW, Aa, base, c3, pw, sub, lane); }
                if (c + 2 < NCH) sc_compute(ga, buf, pw, kkc, kac, lane);
                SC_BAR();
            }
            SC_BAR();
        } else if (wave < 2) {
            const int jg = lane & 15, cw = wave;
            float s0 = 0.f, s1 = 0.f, s2 = 0.f, s3 = 0.f;
            SC_BAR();
#pragma unroll 1
            for (int c = 0; c < NCH; ++c) {
                const LAS float* sb = buf + (c & 1) * SC_BUF_F + 4 * jg;
                const LAS float* vb_ = buf + (c & 1) * SC_BUF_F + 320 + cw * 4 + (lane >> 4);
                LAS float* yp = buf + 2 * SC_BUF_F + ((c & 1) * 2 + cw) * (SC_CS * 64) + lane;
                f32x4 kk4 = *(const LAS f32x4*)(sb), bb4 = *(const LAS f32x4*)(sb + 64), kt4 = *(const LAS f32x4*)(sb + 128), w4 = *(const LAS f32x4*)(sb + 192), r4 = *(const LAS f32x4*)(sb + 256); float vi = vb_[0];
#pragma unroll 4
                for (int st = 0; st < SC_CS; ++st) {
                    const int sn = (st + 1 < SC_CS) ? st + 1 : st;
                    const f32x4 nkk = *(const LAS f32x4*)(sb + sn * SC_STEP_F), nbb = *(const LAS f32x4*)(sb + sn * SC_STEP_F + 64), nkt = *(const LAS f32x4*)(sb + sn * SC_STEP_F + 128), nw = *(const LAS f32x4*)(sb + sn * SC_STEP_F + 192), nr4 = *(const LAS f32x4*)(sb + sn * SC_STEP_F + 256);
                    const float nvi = vb_[sn * SC_STEP_F];
                    const float sa = -row16_sum((s0 * kk4[0] + s1 * kk4[1]) + (s2 * kk4[2] + s3 * kk4[3]));
                    s0 = s0 * w4[0] + (sa * bb4[0] + vi * kt4[0]); s1 = s1 * w4[1] + (sa * bb4[1] + vi * kt4[1]);
                    s2 = s2 * w4[2] + (sa * bb4[2] + vi * kt4[2]); s3 = s3 * w4[3] + (sa * bb4[3] + vi * kt4[3]);
                    yp[st * 64] = (s0 * r4[0] + s1 * r4[1]) + (s2 * r4[2] + s3 * r4[3]);
                    kk4 = nkk; bb4 = nbb; kt4 = nkt; w4 = nw; r4 = nr4; vi = nvi;
                }
                SC_BAR();
            }
            SC_BAR();
        } else {
            const int cw = wave - 2;
            h16* pY = Yraw + ((size_t)(bh * 16 + sub * 2 + cw) * S) * 4;
            SC_BAR();
#pragma unroll 1
            for (int c = 0; c <= NCH; ++c) {
                if (c > 0) {
                    const LAS float* yp = buf + 2 * SC_BUF_F + (((c - 1) & 1) * 2 + cw) * (SC_CS * 64);
                    const int st = lane >> 1, r0 = 2 * (lane & 1);
                    float a0 = 0.f, a1 = 0.f;
#pragma unroll
                    for (int q = 0; q < 4; ++q) { const f32x4 x = *(const LAS f32x4*)(yp + st * 64 + r0 * 16 + 4 * q), z = *(const LAS f32x4*)(yp + st * 64 + (r0 + 1) * 16 + 4 * q);
                        a0 += (x[0] + x[1]) + (x[2] + x[3]); a1 += (z[0] + z[1]) + (z[2] + z[3]); }
                    *(unsigned*)(pY + (size_t)((c - 1) * SC_CS + st) * 4 + r0) = pk_h16(a0, a1);
                }
                SC_BAR();
            }
        }
        if (false) {
            SC_BAR();
#pragma unroll 1
            for (int c = 0; c < NCH; ++c) SC_BAR();
        }
    }
}
__device__ __forceinline__ void rwkv_gn(h16* R, const h16* Kk, const h16* V, const h16* Aa, const h16* Yraw, const float* k_a, const float* r_k, const float* ln_w, const float* ln_b, int gw, int NGW, int lane_) {
    int lane = lane_; asm volatile("" : "+v"(lane));
    const int hq = lane >> 4, c4 = 4 * (lane & 15);
#pragma unroll 2
    for (int idx = gw; idx < M * 4; idx += NGW) {
        const int m = idx >> 2, h = (idx & 3) * 4 + hq, col = h * 64 + c4; const size_t o = (size_t)m * D + col;
        const int bq = m / S, tq = m - bq * S;
        float y[4], r[4], k[4], a[4], v[4];
        h4_to_f(*(const h16x4*)(Yraw + ((size_t)((bq * 16 + h) * 16 + (lane & 15)) * S + tq) * 4), y);
        h4_to_f(*(const h16x4*)(R + o), r); h4_to_f(*(const h16x4*)(Kk + o), k); h4_to_f(*(const h16x4*)(Aa + o), a); h4_to_f(*(const h16x4*)(V + o), v);
        const f32x4 ka4 = *(const f32x4*)(k_a + col), rk4 = *(const f32x4*)(r_k + col), lw4 = *(const f32x4*)(ln_w + col), lb4 = *(const f32x4*)(ln_b + col);
        const float mu = row16_sum((y[0] + y[1]) + (y[2] + y[3])) * (1.f / 64.f);
        float d[4], q = 0.f, bsp = 0.f;
#pragma unroll
        for (int i = 0; i < 4; ++i) { d[i] = y[i] - mu; q += d[i] * d[i]; const float kt = k[i] * (1.0f + (a[i] - 1.0f) * ka4[i]); bsp += r[i] * kt * rk4[i]; }
        const float rstd = rsqrtf(row16_sum(q) * (1.f / 64.f) + 64e-5f), bs = row16_sum(bsp);
        h16x4 outv;
#pragma unroll
        for (int i = 0; i < 4; ++i) outv[i] = (h16)(d[i] * rstd * lw4[i] + lb4[i] + bs * v[i]);
        *(h16x4*)(R + o) = outv;
    }
}

constexpr size_t KF_STRIDE = (size_t)NB * 4 * S * 64;
__device__ __forceinline__ float gelu_tanh(float x) { const float u = 0.7978845608f * (x + 0.044715f * x * x * x); return 0.5f * x * (1.0f + tanhf_(u)); }
__device__ __forceinline__ void store_vf8(bf16_t* chunk_base_d, int keyp0  , f32x4 a, f32x4 b) {
    const int tile = keyp0 >> 4, rq0 = (keyp0 & 15) >> 2;
    u32x2 w0, w1; w0.x = cvt_pk_bf16(a[0], a[1]); w0.y = cvt_pk_bf16(a[2], a[3]); w1.x = cvt_pk_bf16(b[0], b[1]); w1.y = cvt_pk_bf16(b[2], b[3]);
    *(u32x2*)(chunk_base_d + 8 * rq0 + 4 * tile) = w0; *(u32x2*)(chunk_base_d + 8 * (rq0 + 1) + 4 * tile) = w1;
}
struct FNsaIn { bf16_t* Q; bf16_t* KF; float* gates; const float* rope;
    __device__ __forceinline__ void operator()(int row, int col0, f32x4 a, f32x4 b) const {
        const int tile = __builtin_amdgcn_readfirstlane(col0 >> 8);
        const int bb = row / S, t = row - bb * S;
        if (tile < 7) {
            f32x4 x = a, y = b;
            if ((col0 & 32) == 0) {
                f32x4 px, py;
#pragma unroll
                for (int i = 0; i < 4; ++i) { px[i] = __shfl_xor(x[i], 16); py[i] = __shfl_xor(y[i], 16); }
                const int d0 = col0 & 63;
                if (d0 < 16) { const f32x4 c0 = *(const f32x4*)(rope + t * 16), c1 = *(const f32x4*)(rope + t * 16 + 4), s0 = *(const f32x4*)(rope + t * 16 + 8), s1 = *(const f32x4*)(rope + t * 16 + 12);
                    if (d0 == 0) { x = x * c0 - px * s0; y = y * c1 - py * s1; } else { x = x * c0 + px * s0; y = y * c1 + py * s1; } }
            }
            if (tile < 4) { x = x * 0.18033688011112042f; y = y * 0.18033688011112042f;
                u32x4 w; w.x = cvt_pk_bf16(x[0], x[1]); w.y = cvt_pk_bf16(x[2], x[3]); w.z = cvt_pk_bf16(y[0], y[1]); w.w = cvt_pk_bf16(y[2], y[3]);
                *(u32x4*)(Q + (size_t)row * D + col0) = w; }
            else { const int idx = tile - 4, g = (col0 & 255) >> 6, d0 = col0 & 63;
                u32x4 w; w.x = cvt_pk_bf16(x[0], x[1]); w.y = cvt_pk_bf16(x[2], x[3]); w.z = cvt_pk_bf16(y[0], y[1]); w.w = cvt_pk_bf16(y[2], y[3]);
                *(u32x4*)(KF + (size_t)idx * KF_STRIDE + ((size_t)(bb * 4 + g) * S + t) * 64 + d0) = w; }
        } else if (tile == 7) { const int g = (col0 & 255) >> 6, d0 = col0 & 63;
            u32x4 w; w.x = cvt_pk_bf16(a[0], a[1]); w.y = cvt_pk_bf16(a[2], a[3]); w.z = cvt_pk_bf16(b[0], b[1]); w.w = cvt_pk_bf16(b[2], b[3]);
            *(u32x4*)(KF + (size_t)3 * KF_STRIDE + ((size_t)(bb * 4 + g) * S + t) * 64 + d0) = w;
        } else { const int c = col0 - 2048;
            if (c < 48) { f32x4 x, y;
#pragma unroll
                for (int i = 0; i < 4; ++i) { x[i] = sigmoidf_(a[i]); y[i] = sigmoidf_(b[i]); }
                *(f32x4*)(gates + (size_t)row * 48 + c) = x; *(f32x4*)(gates + (size_t)row * 48 + c + 4) = y; }
        }
    } };
struct FNsaVT { bf16_t* VF;
    __device__ __forceinline__ void operator()(int row, int col0, f32x4 a, f32x4 b) const {
        const int br = row >> 8, g = (row >> 6) & 3, d = row & 63, bb = col0 / S, t0 = col0 - bb * S;
        bf16_t* base = VF + (size_t)br * KF_STRIDE + (size_t)(bb * 4 + g) * S * 64 + (size_t)(t0 >> 5) * 2048 + d * 32;
        store_vf8(base, t0 & 31, a, b); } };
struct FCmp1 { bf16_t* CH; const float* bias;
    __device__ __forceinline__ void operator()(int row, int col0, f32x4 a, f32x4 b) const {
        const f32x4 p = *(const f32x4*)(bias + col0), q = *(const f32x4*)(bias + col0 + 4); float o[8];
#pragma unroll
        for (int i = 0; i < 4; ++i) { o[i] = gelu_tanh(a[i] + p[i]); o[4 + i] = gelu_tanh(b[i] + q[i]); }
        u32x4 w; w.x = cvt_pk_bf16(o[0], o[1]); w.y = cvt_pk_bf16(o[2], o[3]); w.z = cvt_pk_bf16(o[4], o[5]); w.w = cvt_pk_bf16(o[6], o[7]);
        *(u32x4*)(CH + (size_t)row * 256 + col0) = w; } };
struct FCmp2K { bf16_t* KC;
    __device__ __forceinline__ void operator()(int row, int col0, f32x4 a, f32x4 b) const {
        if (col0 < 64) { u32x4 w; w.x = cvt_pk_bf16(a[0], a[1]); w.y = cvt_pk_bf16(a[2], a[3]); w.z = cvt_pk_bf16(b[0], b[1]); w.w = cvt_pk_bf16(b[2], b[3]);
            *(u32x4*)(KC + (size_t)row * 64 + col0) = w; } } };
struct FCmp2VT { bf16_t* VC;
    __device__ __forceinline__ void operator()(int row, int col0, f32x4 a, f32x4 b) const {
        if (row < 64) { const int bg = col0 >> 10, n0 = col0 & 1023;
            bf16_t* base = VC + (size_t)bg * 65536 + (size_t)(n0 >> 5) * 2048 + row * 32; store_vf8(base, n0 & 31, a, b); } } };

__device__ __forceinline__ f32x4 mfma16(bf16x8 a, bf16x8 b, f32x4 c) { return __builtin_amdgcn_mfma_f32_16x16x32_bf16(a, b, c, 0, 0, 0); }
__device__ __forceinline__ bf16x8 ld8(const bf16_t* p) { return *(const bf16x8*)p; }
__device__ __forceinline__ bf16x8 pack8(f32x4 a, f32x4 b) { u32x4 w; w.x = cvt_pk_bf16(a[0], a[1]); w.y = cvt_pk_bf16(a[2], a[3]); w.z = cvt_pk_bf16(b[0], b[1]); w.w = cvt_pk_bf16(b[2], b[3]); return __builtin_bit_cast(bf16x8, w); }
__device__ __forceinline__ float colmax(float x) {
    const auto r = __builtin_amdgcn_permlane16_swap(__float_as_uint(x), __float_as_uint(x), false, false); x = fmaxf(__uint_as_float(r[0]), __uint_as_float(r[1]));
    const auto q = __builtin_amdgcn_permlane32_swap(__float_as_uint(x), __float_as_uint(x), false, false); return fmaxf(__uint_as_float(q[0]), __uint_as_float(q[1])); }
__device__ __forceinline__ float colsum(float x) {
    const auto r = __builtin_amdgcn_permlane16_swap(__float_as_uint(x), __float_as_uint(x), false, false); x = __uint_as_float(r[0]) + __uint_as_float(r[1]);
    const auto q = __builtin_amdgcn_permlane32_swap(__float_as_uint(x), __float_as_uint(x), false, false); return __uint_as_float(q[0]) + __uint_as_float(q[1]); }
template <int CTRL> __device__ __forceinline__ unsigned dppmov_u(unsigned v) { return (unsigned)__builtin_amdgcn_update_dpp(0, (int)v, CTRL, 0xF, 0xF, true); }
__device__ __forceinline__ unsigned wave_max_u32(unsigned v) {
    v = max(v, dppmov_u<0xB1>(v)); v = max(v, dppmov_u<0x4E>(v)); v = max(v, dppmov_u<0x124>(v)); v = max(v, dppmov_u<0x128>(v));
    const auto r = __builtin_amdgcn_permlane16_swap(v, v, false, false); v = max((unsigned)r[0], (unsigned)r[1]);
    const auto q = __builtin_amdgcn_permlane32_swap(v, v, false, false); return max((unsigned)q[0], (unsigned)q[1]); }
struct AttnState { float m, l; f32x4 o[4]; };
__device__ __forceinline__ void attn_init(AttnState& st) { st.m = -1e30f; st.l = 0.f;
#pragma unroll
    for (int d = 0; d < 4; ++d) st.o[d] = (f32x4){0.f, 0.f, 0.f, 0.f}; }
struct KVChunk { bf16x8 k[4]; bf16x8 v[4]; };
__device__ __forceinline__ void kv_load(KVChunk& B, const bf16_t* kptr, const bf16_t* vptr) {
#pragma unroll
    for (int tl = 0; tl < 2; ++tl) { B.k[tl * 2] = ld8(kptr + tl * 1024); B.k[tl * 2 + 1] = ld8(kptr + tl * 1024 + 32); }
#pragma unroll
    for (int d = 0; d < 4; ++d) B.v[d] = ld8(vptr + d * 512);
}
struct KRange { int klo, span; };
__device__ __forceinline__ KRange krange(int klo, int khi) { KRange r; if (khi < klo) { r.klo = 64; r.span = 0; } else { r.klo = klo; r.span = khi - klo; } return r; }
template <bool MASKED>
__device__ __forceinline__ void attn_chunk_r(AttnState& st, const bf16x8 (&kf)[4], const bf16x8 (&vf)[4], const bf16x8 q0, const bf16x8 q1, KRange kr) {
    f32x4 s[2];
#pragma unroll
    for (int tl = 0; tl < 2; ++tl) { s[tl] = mfma16(kf[tl * 2], q0, (f32x4){0.f, 0.f, 0.f, 0.f}); s[tl] = mfma16(kf[tl * 2 + 1], q1, s[tl]); }
    float mx = -1e30f;
#pragma unroll
    for (int tl = 0; tl < 2; ++tl)
#pragma unroll
        for (int i = 0; i < 4; ++i) { if (MASKED) { const bool v = (unsigned)(tl * 16 + i - kr.klo) <= (unsigned)kr.span; s[tl][i] = v ? s[tl][i] : -1e30f; } mx = fmaxf(mx, s[tl][i]); }
    mx = colmax(mx);
    if (__any(mx > st.m)) {
        const float mnew = fmaxf(st.m, mx), alpha = __builtin_amdgcn_exp2f(st.m - mnew);
        st.l *= alpha; st.m = mnew;
#pragma unroll
        for (int d = 0; d < 4; ++d) st.o[d] = st.o[d] * alpha;
    }
    const float mcur = st.m;
    f32x4 p[2]; float ps = 0.f;
#pragma unroll
    for (int tl = 0; tl < 2; ++tl)
#pragma unroll
        for (int i = 0; i < 4; ++i) { const float e = __builtin_amdgcn_exp2f(s[tl][i] - mcur); p[tl][i] = e; ps += e; }
    st.l += ps;
    const bf16x8 pb = pack8(p[0], p[1]);
#pragma unroll
    for (int d = 0; d < 4; ++d) st.o[d] = mfma16(vf[d], pb, st.o[d]);
}

#define ATT_STEPN(C, idx) do { _Pragma("unroll") for (int gg = 0; gg < NG; ++gg) { if (act(gg, idx)) { \
        if (ff(gg, idx)) attn_chunk_r<false>(gs[gg], C.k, C.v, gq[gg][0], gq[gg][1], KRange{0, 0}); else attn_chunk_r<true>(gs[gg], C.k, C.v, gq[gg][0], gq[gg][1], mf(gg, idx)); } \
        __builtin_amdgcn_sched_barrier(0); } } while (0)
template <int NG, class AddrK, class AddrV, class ActF, class FullF, class MaskF>
__device__ __forceinline__ void attn_chunksN(AttnState (&gs)[NG], const bf16x8 (&gq)[NG][2], int n, AddrK ak, AddrV av, ActF act, FullF ff, MaskF mf) {
    if constexpr (NG <= 2) {
        KVChunk C0, C1;
        if (n > 0) kv_load(C0, ak(0), av(0));
#pragma unroll 1
        for (int i = 0; i < n; i += 2) {
            if (i + 1 < n) kv_load(C1, ak(i + 1), av(i + 1));
            ATT_STEPN(C0, i);
            if (i + 1 < n) {
                if (i + 2 < n) kv_load(C0, ak(i + 2), av(i + 2));
                ATT_STEPN(C1, i + 1);
            }
        }
    } else {
#pragma unroll 1
        for (int i = 0; i < n; ++i) { KVChunk C0; kv_load(C0, ak(i), av(i)); ATT_STEPN(C0, i); }
    }
}

__device__ __forceinline__ void nsa_attention(const bf16_t* Q, const bf16_t* KF, const bf16_t* VF, const bf16_t* KC, const bf16_t* VC, const float* gates, bf16_t* OUT, LAS unsigned char* lds, int G, int wave, int lane_) {
    int lane0 = lane_; asm volatile("" : "+v"(lane0));
    LAS float* imp = (LAS float*)(lds + wave * 18432);
    LAS float* tl = imp;
    LAS int* sel = (LAS int*)(lds + wave * 18432 + 16384);
    LAS unsigned* smask32 = (LAS unsigned*)(lds + wave * 18432 + 16384 + 1088);
    LAS unsigned char* blist = (LAS unsigned char*)(lds + wave * 18432 + 16384 + 1088 + 512);
    const bool xcd_map = (G % 8) == 0;
    const int nslots = xcd_map ? (G >> 3) * NWAVES : G * NWAVES, slot = xcd_map ? ((int)blockIdx.x >> 3) * NWAVES + wave : (int)blockIdx.x * NWAVES + wave;
    const int ntask = xcd_map ? 1024 : 8192;
#pragma unroll 1
    for (int task = slot; task < ntask; task += nslots) {
        int lane = lane0; asm volatile("" : "+v"(lane)); lane &= 63;
        const int col = lane & 15, rq = lane >> 4;
        const int tilei = xcd_map ? task : (task >> 3), bg = xcd_map ? ((int)blockIdx.x & 7) : (task & 7), b = bg >> 2, g = bg & 3, t0 = tilei * 16, t = t0 + col;
        const size_t rowq = (size_t)b * S + t;
        const bf16_t* qrow = Q + rowq * D + (g * 4) * 64 + 8 * rq;
        const float* grow = gates + rowq * 48 + g * 12;
        const int cur_max = (t0 + 15) >> 6;
        int n_end = 4 * (cur_max + 1); if (n_end > 1024) n_end = 1024;
        const int nchunk_c = (n_end + 31) >> 5;
        const bf16_t* kc_l = KC + (size_t)bg * 65536 + (size_t)col * 64 + 8 * rq;
        const bf16_t* vc_l = VC + (size_t)bg * 65536 + (size_t)col * 32 + 8 * rq;
        {
        AttnState gs[4]; bf16x8 gq[4][2];
#pragma unroll
        for (int h = 0; h < 4; ++h) { gq[h][0] = ld8(qrow + h * 64); gq[h][1] = ld8(qrow + h * 64 + 32); attn_init(gs[h]); }
        attn_chunksN<4>(gs, gq, nchunk_c,
            [&](int ci) { return kc_l + (size_t)ci * 2048; }, [&](int ci) { return vc_l + (size_t)ci * 2048; },
            [&](int, int) { return true; },
            [&](int, int ci) { return 16 * (ci * 32 + 31) + 31 <= t0; },
            [&](int, int ci) { const int nhi = (t >= 31) ? ((t - 31) >> 4) : -1; return krange(0, nhi - ci * 32 - 4 * rq); });
        {
            float mc[4], lc[4];
#pragma unroll
            for (int h = 0; h < 4; ++h) { const float lt = colsum(gs[h].l); mc[h] = gs[h].m; lc[h] = (gs[h].m > -1e29f && lt > 0.f) ? 1.0f / lt : 0.f; }
            {
                float carry = 0.f;
#pragma unroll 1
                for (int kc = 0; kc < nchunk_c; ++kc) {
#pragma unroll
                    for (int tt = 0; tt < 2; ++tt) {
                        const bf16x8 k0 = ld8(kc_l + (size_t)kc * 2048 + tt * 1024), k1 = ld8(kc_l + (size_t)kc * 2048 + tt * 1024 + 32);
                        float own = 0.f, p3 = 0.f;
#pragma unroll
                        for (int h = 0; h < 4; ++h) {
                            f32x4 sc = mfma16(k0, gq[h][0], (f32x4){0.f, 0.f, 0.f, 0.f}); sc = mfma16(k1, gq[h][1], sc);
#pragma unroll
                            for (int i = 0; i < 4; ++i) { const int n = kc * 32 + tt * 16 + 4 * rq + i; const float p = (16 * n + 31 <= t) ? __builtin_amdgcn_exp2f(sc[i] - mc[h]) * lc[h] : 0.f; own += p; if (i == 3) p3 += p; }
                        }
                        const float up = __shfl(p3, (lane + 48) & 63);
                        const float add = (rq == 0) ? carry : up;
                        imp[col * 256 + kc * 8 + tt * 4 + rq] = own + add;
                        carry = __shfl(p3, col + 48);
                    }
                }
            }
#pragma unroll 1
            for (int c = 0; c < 16; ++c) {
                const int tc = t0 + c, cur = tc >> 6;
                if (cur < 16) { if (lane <= cur) sel[c * 17 + lane] = lane; if (lane == 0) sel[c * 17 + 16] = cur + 1; }
                else {
                    unsigned key[4];
#pragma unroll
                    for (int jx = 0; jx < 4; ++jx) { const int sb = lane + 64 * jx; const float v = imp[c * 256 + sb]; key[jx] = (sb >= 1 && sb <= cur - 2) ? ((__float_as_uint(v) & 0xFFFFFF00u) | (unsigned)(255 - sb)) : 0u; }
                    if (lane == 0) { sel[c * 17 + 0] = 0; sel[c * 17 + 1] = cur - 1; sel[c * 17 + 2] = cur; sel[c * 17 + 16] = 16; }
#pragma unroll 1
                    for (int r = 0; r < 13; ++r) {
                        unsigned best = max(max(key[0], key[1]), max(key[2], key[3]));
                        best = wave_max_u32(best);
                        if (lane == 0) sel[c * 17 + 3 + r] = 255 - (int)(best & 255u);
#pragma unroll
                        for (int jx = 0; jx < 4; ++jx) if (key[jx] == best) key[jx] = 0u;
                    }
                }
            }
#pragma unroll
            for (int h = 0; h < 4; ++h) { const float gc = grow[h * 3 + 0] * lc[h];
#pragma unroll
                for (int d = 0; d < 4; ++d)
#pragma unroll
                    for (int i = 0; i < 4; ++i) tl[(h * 16 + d * 4 + i) * 64 + lane] = gs[h].o[d][i] * gc; }
        }
        }
        {
            smask32[lane] = 0u; smask32[64 + lane] = 0u;
#pragma unroll
            for (int k4 = 0; k4 < 4; ++k4) { const int pp = lane + 64 * k4, c = pp >> 4, e = pp & 15; if (e < sel[c * 17 + 16]) { const int jb = sel[c * 17 + e]; atomicOr((unsigned*)(smask32 + (jb >> 1)), 1u << (c + 16 * (jb & 1))); } }
            const bf16_t* ks_b = KF + (size_t)1 * KF_STRIDE + (size_t)bg * S * 64 + (size_t)col * 64 + 8 * rq;
            const bf16_t* vs_b = VF + (size_t)bg * S * 64 + (size_t)col * 32 + 8 * rq;
            const int tokl = col >> 2, hd = col & 3;
            {
                int nblk = 0;
#pragma unroll
                for (int k4 = 0; k4 < 4; ++k4) { const int jb = lane + 64 * k4; const unsigned mk = (smask32[jb >> 1] >> (16 * (jb & 1))) & 0xFFFFu;
                    const unsigned long long bal = __ballot(mk != 0u); const int pos = nblk + __popcll(bal & ((1ull << lane) - 1ull)); if (mk != 0u) blist[pos] = (unsigned char)jb; nblk += __popcll(bal); }
                AttnState hs[4]; bf16x8 hq[4][2];
#pragma unroll
                for (int cg = 0; cg < 4; ++cg) { const bf16_t* qp = Q + ((size_t)b * S + t0 + 4 * cg + tokl) * D + (g * 4 + hd) * 64 + 8 * rq; hq[cg][0] = ld8(qp); hq[cg][1] = ld8(qp + 32); attn_init(hs[cg]); }
                auto blk_of = [&](int ci) { return (int)__builtin_amdgcn_readfirstlane((int)blist[ci >> 1]); };
                auto msk_of = [&](int jb) { return (unsigned)__builtin_amdgcn_readfirstlane((int)((smask32[jb >> 1] >> (16 * (jb & 1))) & 0xFFFFu)); };
                const int tb = t0;
                attn_chunksN<4>(hs, hq, nblk * 2,
                    [&](int ci) { return ks_b + (size_t)(blk_of(ci) * 2 + (ci & 1)) * 2048; },
                    [&](int ci) { return vs_b + (size_t)(blk_of(ci) * 2 + (ci & 1)) * 2048; },
                    [&](int cg, int ci) { return ((msk_of(blk_of(ci)) >> (4 * cg)) & 15u) != 0u; },
                    [&](int cg, int ci) { const int jb = blk_of(ci); return ((msk_of(jb) >> (4 * cg)) & 15u) == 15u && jb * 64 + (ci & 1) * 32 + 31 <= tb + 4 * cg; },
                    [&](int cg, int ci) { const int jb = blk_of(ci); const unsigned mk = msk_of(jb); const int tok = 4 * cg + tokl; const int kp0 = jb * 64 + (ci & 1) * 32 + 4 * rq;
                        return krange(0, ((mk >> tok) & 1u) ? (tb + tok - kp0) : -1); });
#pragma unroll
                for (int cg = 0; cg < 4; ++cg) { const int tok = 4 * cg + tokl;
                    const float lt = colsum(hs[cg].l); const float inv = (hs[cg].m > -1e29f && lt > 0.f) ? 1.0f / lt : 0.f;
                    const float gsv = gates[((size_t)b * S + t0 + tok) * 48 + g * 12 + hd * 3 + 1] * inv;
#pragma unroll
                    for (int d = 0; d < 4; ++d)
#pragma unroll
                        for (int i = 0; i < 4; ++i) tl[(hd * 16 + d * 4 + i) * 64 + tok + 16 * rq] += hs[cg].o[d][i] * gsv; }
            }
        }
        {
            int lo = t0 - 511; if (lo < 0) lo = 0; const int c0 = lo >> 5, c1 = (t0 + 15) >> 5;
            const bf16_t* kw_b = KF + (size_t)2 * KF_STRIDE + (size_t)bg * S * 64 + (size_t)col * 64 + 8 * rq;
            const bf16_t* vw_b = VF + (size_t)1 * KF_STRIDE + (size_t)bg * S * 64 + (size_t)col * 32 + 8 * rq;
            {
                AttnState gs[4]; bf16x8 gq[4][2];
#pragma unroll
                for (int h = 0; h < 4; ++h) { gq[h][0] = ld8(qrow + h * 64); gq[h][1] = ld8(qrow + h * 64 + 32); attn_init(gs[h]); }
                attn_chunksN<4>(gs, gq, c1 - c0 + 1,
                    [&](int ci) { return kw_b + (size_t)(c0 + ci) * 2048; }, [&](int ci) { return vw_b + (size_t)(c0 + ci) * 2048; },
                    [&](int, int) { return true; },
                    [&](int, int ci) { return (c0 + ci) * 32 + 31 <= t0 && (c0 + ci) * 32 + 512 > t0 + 15; },
                    [&](int, int ci) { const int cb = (c0 + ci) * 32 + 4 * rq; return krange(t - 511 - cb, t - cb); });
#pragma unroll
                for (int h = 0; h < 4; ++h) { const float lt = colsum(gs[h].l); const float inv = (gs[h].m > -1e29f && lt > 0.f) ? 1.0f / lt : 0.f; const float gwv = grow[h * 3 + 2] * inv;
#pragma unroll
                    for (int d = 0; d < 4; ++d)
#pragma unroll
                        for (int i = 0; i < 4; ++i) tl[(h * 16 + d * 4 + i) * 64 + lane] += gs[h].o[d][i] * gwv; }
            }
        }
#pragma unroll
        for (int h = 0; h < 4; ++h)
#pragma unroll
            for (int d = 0; d < 4; ++d) { float v4[4];
#pragma unroll
                for (int i = 0; i < 4; ++i) v4[i] = tl[(h * 16 + d * 4 + i) * 64 + lane];
                u32x2 w; w.x = cvt_pk_bf16(v4[0], v4[1]); w.y = cvt_pk_bf16(v4[2], v4[3]);
                *(u32x2*)(OUT + rowq * D + (g * 4 + h) * 64 + d * 16 + 4 * rq) = w; }
    }
}

#define XB_TMO      128
#define XB_XCNT(j)  (256  + 64 * (j))
#define XB_XSUB(j)  (1280 + 64 * (j))
#define XB_XGEN(j)  (2304 + 64 * (j))
#define XB_TOP      3328
#define XB_TOPGEN   3392
#define XCD_BAR_WORDS 3456
#define XB_SPIN_CAP (1u << 22)
__device__ __forceinline__ unsigned xb_ld(unsigned* p)              { return __hip_atomic_load(p, __ATOMIC_RELAXED, __HIP_MEMORY_SCOPE_AGENT); }
__device__ __forceinline__ unsigned xb_add(unsigned* p, unsigned v) { return __hip_atomic_fetch_add(p, v, __ATOMIC_RELAXED, __HIP_MEMORY_SCOPE_AGENT); }
__device__ __forceinline__ unsigned xb_xcc_id() { return (unsigned)__builtin_amdgcn_s_getreg((3 << 11) | 20) & 0xFu; }
#define XB_SPIN(cond, bar) do { unsigned _sp = 0; while (cond) { __builtin_amdgcn_s_sleep(1); \
    if ((++_sp & 255u) == 0u) { if (xb_ld(&(bar)[XB_TMO])) break; if (_sp > XB_SPIN_CAP) { atomicAdd(&(bar)[XB_TMO], 1u); break; } } } } while (0)
struct XcdBarrier { unsigned* bar; unsigned x; volatile LAS unsigned* st; };
__device__ __forceinline__ void xcd_barrier_complete(unsigned* bar, unsigned x, unsigned& nloc, unsigned& nx) {
    const unsigned Gn = gridDim.x * gridDim.y * gridDim.z;
    unsigned sum, cnt, mine, sp = 0u;
    for (;;) {
        sum = 0u; cnt = 0u; mine = 0u;
#pragma unroll
        for (unsigned j = 0; j < 16; ++j) { const unsigned c = xb_ld(&bar[XB_XCNT(j)]); sum += c; cnt += (c > 0u) ? 1u : 0u; mine = (j == x) ? c : mine; }
        if (sum == Gn) break;
        __builtin_amdgcn_s_sleep(1);
        if ((++sp & 255u) == 0u) { if (xb_ld(&bar[XB_TMO])) break; if (sp > XB_SPIN_CAP) { atomicAdd(&bar[XB_TMO], 1u); break; } }
    }
    nloc = mine > 0u ? mine : 1u; nx = cnt > 0u ? cnt : 1u;
}
__device__ __forceinline__ void xcd_barrier(const XcdBarrier& b, bool leader) {
    asm volatile("s_waitcnt vmcnt(0)" ::: "memory");
    __syncthreads();
    if (leader) {
        unsigned* bar = b.bar;
        __builtin_amdgcn_s_waitcnt(0);
        unsigned nloc = b.st[0], nx = b.st[1];
        if (nloc == 0u) { xcd_barrier_complete(bar, b.x, nloc, nx); b.st[0] = nloc; b.st[1] = nx; }
        const unsigned old = xb_add(&bar[XB_XSUB(b.x)], 1u);
        const unsigned gen = old / nloc;
        if (old + 1u == (gen + 1u) * nloc) {
            __builtin_amdgcn_fence(__ATOMIC_RELEASE, "agent");
            asm volatile("s_waitcnt vmcnt(0)" ::: "memory");
            const unsigned og = xb_add(&bar[XB_TOP], 1u);
            const unsigned tg = og / nx;
            if (og + 1u == (tg + 1u) * nx) xb_add(&bar[XB_TOPGEN], 1u);
            else XB_SPIN(xb_ld(&bar[XB_TOPGEN]) == tg, bar);
            __builtin_amdgcn_fence(__ATOMIC_ACQUIRE, "agent");
            xb_add(&bar[XB_XGEN(b.x)], 1u);
            asm volatile("s_waitcnt vmcnt(0)" ::: "memory");
        } else {
            XB_SPIN(xb_ld(&bar[XB_XGEN(b.x)]) == gen, bar);
            __builtin_amdgcn_fence(__ATOMIC_ACQUIRE, "agent");
            asm volatile("s_waitcnt vmcnt(0)" ::: "memory");
        }
    }
    __syncthreads();
}
#define GSYNC() xcd_barrier(xbar, wave == 0 && lane_id() == 0)

__global__ void __launch_bounds__(NTHREADS, 2) fwd_kernel(Params P) {
    extern __shared__ __attribute__((aligned(16))) unsigned char lds_raw[];
    LAS unsigned char* lds = (LAS unsigned char*)lds_raw;
    cg::grid_group grid = cg::this_grid();
    int tidv = threadIdx.x;
    const int wave = __builtin_amdgcn_readfirstlane(tidv >> 6);
    const int G = gridDim.x, gw_k = blockIdx.x * NWAVES + wave, NGW = G * NWAVES;
    unsigned char* ws = P.ws;
    float* xres = P.out;
    LAS float* scr = (LAS float*)(lds + wave * 16384);
    const float* x_in = P.in[0];
    const float* norm_mix = P.in[1]; const float* norm_mlp = P.in[2]; const float* norm_final = P.in[3];
    const float* mlp_w1 = P.in[4]; const float* mlp_w2 = P.in[5];

    XcdBarrier xbar; xbar.bar = (unsigned*)(ws + WS_BAR); xbar.x = xb_xcc_id(); xbar.st = (volatile LAS unsigned*)(lds + 147456);
    if (tidv < 2) xbar.st[tidv] = 0u;
    if (tidv == 0) (void)xb_add(&xbar.bar[XB_XCNT(xbar.x)], 1u);
    __syncthreads();
    grid.sync();
    for (int layer = 0; layer < 4; ++layer) {
        int lane = tidv; asm volatile("" : "+v"(lane)); lane &= 63;
        int gw = gw_k; asm volatile("" : "+s"(gw));
        const bool is_rwkv = (layer & 1) != 0; const int lj = layer >> 1;
        const float* xsrc = (layer == 0) ? x_in : xres;
        {
            TJob j1{mlp_w1 + (size_t)layer * D * FF, FF, 0, FF, D, (bf16_t*)(ws + WS_W + W_MLP1), D, 0, 0, FF, D, nullptr, 0};
            transpose_job(j1, scr, gw, NGW, lane);
            TJob j2{mlp_w2 + (size_t)layer * FF * D, D, 0, D, FF, (bf16_t*)(ws + WS_W + W_MLP2), FF, 0, 0, D, FF, nullptr, 0};
            transpose_job(j2, scr, gw, NGW, lane);
            if (is_rwkv) {
                const float* mix = P.in[14] + (size_t)lj * 6 * D;
                bf16_t* WrT = (bf16_t*)(ws + WS_W + W_RW_IN);
                const float* wrkv = P.in[15] + (size_t)lj * 3 * D * D;
                for (int part = 0; part < 8; ++part) {
                    const float* W; int ldw, Nsrc, mi, r0, Npad;
                    if (part == 0) { W = wrkv; ldw = D; Nsrc = D; mi = 0; r0 = 0; Npad = D; }
                    else if (part == 1) { W = wrkv + (size_t)D * D; ldw = D; Nsrc = D; mi = 2; r0 = 1024; Npad = D; }
                    else if (part == 2) { W = wrkv + (size_t)2 * D * D; ldw = D; Nsrc = D; mi = 3; r0 = 2048; Npad = D; }
                    else if (part == 3) { W = P.in[17] + (size_t)lj * D * 64; ldw = 64; Nsrc = 64; mi = 1; r0 = 3072; Npad = 128; }
                    else if (part == 4) { W = P.in[20] + (size_t)lj * D * 64; ldw = 64; Nsrc = 64; mi = 4; r0 = 3200; Npad = 128; }
                    else if (part == 5) { W = P.in[22] + (size_t)lj * D * 160; ldw = 160; Nsrc = 160; mi = 5; r0 = 3328; Npad = 256; }
                    else if (part == 6) { W = P.in[31]; ldw = 32; Nsrc = (lj >= 1) ? 32 : 0; mi = 3; r0 = 3584; Npad = 128; }
                    else { W = P.in[31]; ldw = 32; Nsrc = 0; mi = 3; r0 = 3712; Npad = 128; }
                    TJob ja{W, ldw, 0, Nsrc, D, WrT, 2048, r0, 0, Npad, D, mix + mi * D, 1};
                    transpose_job(ja, scr, gw, NGW, lane);
                    TJob jb{W, ldw, 0, Nsrc, D, WrT, 2048, r0, 1024, Npad, D, mix + mi * D, 2};
                    transpose_job(jb, scr, gw, NGW, lane);
                }
                TJob jw{P.in[18] + (size_t)lj * 64 * D, D, 0, D, 64, (bf16_t*)(ws + WS_W + W_RW_W2), 128, 0, 0, D, 128, nullptr, 0}; transpose_job(jw, scr, gw, NGW, lane);
                TJob jaa{P.in[21] + (size_t)lj * 64 * D, D, 0, D, 64, (bf16_t*)(ws + WS_W + W_RW_A2), 128, 0, 0, D, 128, nullptr, 0}; transpose_job(jaa, scr, gw, NGW, lane);
                TJob jv{P.in[32], D, 0, D, (lj >= 1) ? 32 : 0, (bf16_t*)(ws + WS_W + W_RW_V2), 128, 0, 0, D, 128, nullptr, 0}; transpose_job(jv, scr, gw, NGW, lane);
                TJob jg{P.in[23] + (size_t)lj * 160 * D, D, 0, D, 160, (bf16_t*)(ws + WS_W + W_RW_G2), 256, 0, 0, D, 256, nullptr, 0}; transpose_job(jg, scr, gw, NGW, lane);
                TJob jo{P.in[29] + (size_t)lj * D * D, D, 0, D, D, (bf16_t*)(ws + WS_W + W_RW_O), D, 0, 0, D, D, nullptr, 0}; transpose_job(jo, scr, gw, NGW, lane);
                bf16_t* HN = (bf16_t*)(ws + A_HN);
                if (gw < 2) { u32x4* z = (u32x4*)(HN + (size_t)gw * (S + 1) * D); unsigned zz; asm volatile("v_mov_b32 %0, 0" : "=v"(zz)); for (int q = lane; q < D / 8; q += 64) z[q] = (u32x4){zz, zz, zz, zz}; }
                for (int m = gw; m < M; m += NGW) { const int b = m / S; rms_row_bf16(xsrc + (size_t)m * D, norm_mix + layer * D, HN + ((size_t)m + b + 1) * D, nullptr, lane); }
            } else {
                const float* win = P.in[6] + (size_t)lj * D * 2608;
                bf16_t* WnT = (bf16_t*)(ws + WS_W + W_NSA_IN); bf16_t* WvT = (bf16_t*)(ws + WS_W + W_NSA_V);
                for (int part = 0; part < 8; ++part) {
                    int n0src, Nsrc, r0, Npad; bf16_t* WT = WnT;
                    if (part == 0) { n0src = 0; Nsrc = 1024; r0 = 0; Npad = 1024; }
                    else if (part == 1) { n0src = 1024; Nsrc = 256; r0 = 1024; Npad = 256; }
                    else if (part == 2) { n0src = 1024 + 512; Nsrc = 256; r0 = 1280; Npad = 256; }
                    else if (part == 3) { n0src = 1024 + 1024; Nsrc = 256; r0 = 1536; Npad = 256; }
                    else if (part == 4) { n0src = 1024 + 256; Nsrc = 256; r0 = 1792; Npad = 256; }
                    else if (part == 5) { n0src = 2560; Nsrc = 48; r0 = 2048; Npad = 256; }
                    else if (part == 6) { n0src = 1024 + 768; Nsrc = 256; r0 = 0; Npad = 256; WT = WvT; }
                    else { n0src = 1024 + 1280; Nsrc = 256; r0 = 256; Npad = 256; WT = WvT; }
                    TJob jn{win, 2608, n0src, Nsrc, D, WT, D, r0, 0, Npad, D, nullptr, 0}; transpose_job(jn, scr, gw, NGW, lane);
                }
                TJob jo{P.in[13] + (size_t)lj * D * D, D, 0, D, D, (bf16_t*)(ws + WS_W + W_NSA_O), D, 0, 0, D, D, nullptr, 0}; transpose_job(jo, scr, gw, NGW, lane);
                TJob jc1k{P.in[8] + (size_t)lj * 2048 * 256, 256, 0, 256, 2048, (bf16_t*)(ws + WS_W + W_C1K), 2048, 0, 0, 256, 2048, nullptr, 0}; transpose_job(jc1k, scr, gw, NGW, lane);
                TJob jc1v{P.in[11] + (size_t)lj * 2048 * 256, 256, 0, 256, 2048, (bf16_t*)(ws + WS_W + W_C1V), 2048, 0, 0, 256, 2048, nullptr, 0}; transpose_job(jc1v, scr, gw, NGW, lane);
                TJob jc2k{P.in[9] + (size_t)lj * 256 * 64, 64, 0, 64, 256, (bf16_t*)(ws + WS_W + W_C2K), 256, 0, 0, 256, 256, nullptr, 0}; transpose_job(jc2k, scr, gw, NGW, lane);
                TJob jc2v{P.in[12] + (size_t)lj * 256 * 64, 64, 0, 64, 256, (bf16_t*)(ws + WS_W + W_C2V), 256, 0, 0, 256, 256, nullptr, 0}; transpose_job(jc2v, scr, gw, NGW, lane);
                {
                    int ln = lane; asm volatile("" : "+v"(ln));
                    float* cb = (float*)(ws + WS_W + W_CBIAS);
#pragma unroll 1
                    for (int o = gw; o < 512; o += NGW) { const int isv = o >> 8, c = o & 255;
                        const float* pe = (isv ? P.in[10] : P.in[7]) + (size_t)lj * 2048; const float* w1 = (isv ? P.in[11] : P.in[8]) + (size_t)lj * 2048 * 256;
                        float acc = 0.f;
#pragma unroll 1
                        for (int k = ln; k < 2048; k += 64) acc += pe[k] * w1[(size_t)k * 256 + c];
                        acc = wave_sum(acc); if (ln == 0) cb[o] = acc; }
                    if (layer == 0) {
                        float* rt = (float*)(ws + WS_ROPE);
                        int tix = tidv; asm volatile("" : "+v"(tix)); const int gt = (int)blockIdx.x * NTHREADS + tix;
#pragma unroll 1
                        for (int e = gt; e < S * 8; e += G * NTHREADS) { const int tt = e >> 3, i = e & 7;
                            const float invf = (i == 0) ? 1.0f : (i == 1) ? 0.1939227432012558f : (i == 2) ? 0.03760603070259094f : (i == 3) ? 0.007292664609849453f : (i == 4) ? 0.0014142135623842478f : (i == 5) ? 0.00027424818836152554f : (i == 6) ? 5.318296098266728e-05f : 1.0313386155758053e-05f;
                            const float ang = (float)tt * invf; const double rev = (double)ang * 0.15915494309189535; const float fr = (float)(rev - __builtin_rint(rev));
                            rt[tt * 16 + i] = __builtin_amdgcn_cosf(fr); rt[tt * 16 + 8 + i] = __builtin_amdgcn_sinf(fr); }
                    }
                }
                for (int m = gw; m < M; m += NGW) rms_row_bf16(xsrc + (size_t)m * D, norm_mix + layer * D, (bf16_t*)(ws + A_HN) + (size_t)m * D, (layer == 0) ? xres + (size_t)m * D : nullptr, lane);
            }
        }
        GSYNC();
        if (!is_rwkv) {
            bf16_t* HN = (bf16_t*)(ws + A_HN); bf16_t* Qb = (bf16_t*)(ws + A_Q); bf16_t* KFb = (bf16_t*)(ws + A_KF); bf16_t* VFb = (bf16_t*)(ws + A_VF);
            float* GT = (float*)(ws + A_GATES); bf16_t* CHK = (bf16_t*)(ws + A_CHK); bf16_t* CHV = (bf16_t*)(ws + A_CHV); bf16_t* KCb = (bf16_t*)(ws + A_KC); bf16_t* VCb = (bf16_t*)(ws + A_VC);
            {
                pg8::Gemm g{HN, (const bf16_t*)(ws + WS_W + W_NSA_IN), M, 2304, D, D, D, 0};
                pg8::StaticOrder so; so.init(M, 2304, G, (int)blockIdx.x);
                pg8::EpiP<FNsaIn> E{FNsaIn{Qb, KFb, GT, (const float*)(ws + WS_ROPE)}};
                pg8::gemm_phase<pg8::EpiP<FNsaIn>, true>(lds, g, so, E, tidv);
                pg8::Gemm g2{(const bf16_t*)(ws + WS_W + W_NSA_V), HN, 512, M, D, D, D, 0};
                pg8::StaticOrder so2; so2.init(512, M, G, (int)blockIdx.x);
                pg8::EpiP<FNsaVT> E2{FNsaVT{VFb}};
                pg8::gemm_phase<pg8::EpiP<FNsaVT>, true>(lds, g2, so2, E2, tidv);
            }
            GSYNC();
            {
                pg8::StaticOrder so; so.init(8192, 256, G, (int)blockIdx.x);
                pg8::StaticOrder sov; sov.init(8192, 256, G, (int)((blockIdx.x + G - G / 2) % G));
                { pg8::Gemm g{KFb, (const bf16_t*)(ws + WS_W + W_C1K), 8192, 256, 2048, 1024, 2048, 0}; pg8::EpiP<FCmp1> E{FCmp1{CHK, (const float*)(ws + WS_W + W_CBIAS)}}; pg8::gemm_phase<pg8::EpiP<FCmp1>, true>(lds, g, so, E, tidv); }
                { pg8::Gemm g{KFb + 3 * KF_STRIDE, (const bf16_t*)(ws + WS_W + W_C1V), 8192, 256, 2048, 1024, 2048, 0}; pg8::EpiP<FCmp1> E{FCmp1{CHV, (const float*)(ws + WS_W + W_CBIAS) + 256}}; pg8::gemm_phase<pg8::EpiP<FCmp1>, true>(lds, g, sov, E, tidv); }
            }
            GSYNC();
            {
                { pg8::StaticOrder so; so.init(8192, 256, G, (int)blockIdx.x); pg8::Gemm g{CHK, (const bf16_t*)(ws + WS_W + W_C2K), 8192, 256, 256, 256, 256, 0}; pg8::EpiP<FCmp2K> E{FCmp2K{KCb}}; pg8::gemm_phase<pg8::EpiP<FCmp2K>, true>(lds, g, so, E, tidv); }
                { pg8::StaticOrder so; so.init(256, 8192, G, (int)((blockIdx.x + G - G / 2) % G)); pg8::Gemm g{(const bf16_t*)(ws + WS_W + W_C2V), CHV, 256, 8192, 256, 256, 256, 0}; pg8::EpiP<FCmp2VT> E{FCmp2VT{VCb}}; pg8::gemm_phase<pg8::EpiP<FCmp2VT>, true>(lds, g, so, E, tidv); }
            }
            GSYNC();
            nsa_attention(Qb, KFb, VFb, KCb, VCb, GT, HN, lds, G, wave, lane_id());
            tidv = wave * 64 + (lane_id() & 63); asm volatile("" : "+v"(tidv)); tidv &= 511; lane = tidv & 63;
            GSYNC();
            {
                pg8::StaticOrder so; so.init(M, D, G, (int)blockIdx.x);
                pg8::Gemm g{HN, (const bf16_t*)(ws + WS_W + W_NSA_O), M, D, D, D, D, 0}; pg8::EpiN<FResAdd> E{FResAdd{xres}}; pg8::gemm_phase<pg8::EpiN<FResAdd>, true>(lds, g, so, E, tidv);
            }
            GSYNC();
        }
        if (is_rwkv) {
            h16* Rb = (h16*)(ws + A_R); h16* Kb = (h16*)(ws + A_K); h16* Ab = (h16*)(ws + A_A); h16* EWb = (h16*)(ws + A_HN);
            h16* Vb = (lj == 0) ? (h16*)(ws + WS_VF) : (h16*)(ws + A_V2);
            h16* Yraw = (lj == 0) ? (h16*)(ws + A_V2) : (h16*)(ws + WS_VF);
            bf16_t* LH = (bf16_t*)(ws + A_LH);
            {
                pg8::Gemm g{(const bf16_t*)(ws + A_HN), (const bf16_t*)(ws + WS_W + W_RW_IN), M, 3840, 2048, D, 2048, 1};
                pg8::StaticOrder so; so.init(M, 3840, G, (int)blockIdx.x);
                pg8::EpiP<FRwIn> E{FRwIn{Rb, Kb, Vb, LH}};
                pg8::gemm_phase<pg8::EpiP<FRwIn>, true>(lds, g, so, E, tidv);
            }
            GSYNC();
            {
                pg8::StaticOrder so; so.init(M, D, G, (int)blockIdx.x);
                { pg8::Gemm g{LH, (const bf16_t*)(ws + WS_W + W_RW_W2), M, D, 128, 768, 128, 0}; pg8::EpiP<FLoraW> E{FLoraW{EWb, P.in[16] + lj * D}}; pg8::gemm_phase<pg8::EpiP<FLoraW>, true>(lds, g, so, E, tidv); }
                { pg8::Gemm g{LH + 128, (const bf16_t*)(ws + WS_W + W_RW_A2), M, D, 128, 768, 128, 0}; pg8::EpiP<FLoraA> E{FLoraA{Ab, P.in[19] + lj * D}}; pg8::gemm_phase<pg8::EpiP<FLoraA>, true>(lds, g, so, E, tidv); }
                if (lj >= 1) { pg8::Gemm g{LH + 512, (const bf16_t*)(ws + WS_W + W_RW_V2), M, D, 128, 768, 128, 0}; pg8::EpiP<FLoraV> E{FLoraV{Vb, (const h16*)(ws + WS_VF), P.in[30]}}; pg8::gemm_phase<pg8::EpiP<FLoraV>, true>(lds, g, so, E, tidv); }
            }
            GSYNC();
            rwkv_scan2(Rb, Kb, Vb, EWb, Ab, P.in[24] + lj * D, P.in[25] + lj * D, Yraw, lds, wave, lane);
            GSYNC();
            rwkv_gn(Rb, Kb, Vb, Ab, Yraw, P.in[25] + lj * D, P.in[26] + lj * D, P.in[27] + lj * D, P.in[28] + lj * D, gw, NGW, lane);
            GSYNC();
            {
                pg8::StaticOrder so; so.init(M, D, G, (int)blockIdx.x);
                pg8::Gemm g{LH + 256, (const bf16_t*)(ws + WS_W + W_RW_G2), M, D, 256, 768, 256, 0}; pg8::EpiP<FGate> E{FGate{(bf16_t*)Kb, Rb}}; pg8::gemm_phase<pg8::EpiP<FGate>, true>(lds, g, so, E, tidv);
            }
            GSYNC();
            {
                pg8::StaticOrder so; so.init(M, D, G, (int)blockIdx.x);
                pg8::Gemm g{(const bf16_t*)Kb, (const bf16_t*)(ws + WS_W + W_RW_O), M, D, D, D, D, 0}; pg8::EpiN<FResAdd> E{FResAdd{xres}}; pg8::gemm_phase<pg8::EpiN<FResAdd>, true>(lds, g, so, E, tidv);
            }
            GSYNC();
        }
        for (int m = gw; m < M; m += NGW) rms_row_bf16(xres + (size_t)m * D, norm_mlp + layer * D, (bf16_t*)(ws + A_HN) + (size_t)m * D, nullptr, lane);
        GSYNC();
        {
            pg8::Gemm g{(const bf16_t*)(ws + A_HN), (const bf16_t*)(ws + WS_W + W_MLP1), M, FF, D, D, D, 0};
            pg8::StaticOrder so; so.init(M, FF, G, (int)blockIdx.x);
            pg8::EpiP<FRelu2> E{FRelu2{(bf16_t*)(ws + A_HID)}};
            pg8::gemm_phase<pg8::EpiP<FRelu2>, true>(lds, g, so, E, tidv);
        }
        GSYNC();
        {
            pg8::Gemm g{(const bf16_t*)(ws + A_HID), (const bf16_t*)(ws + WS_W + W_MLP2), M, D, FF, FF, FF, 0};
            pg8::StaticOrder so; so.init(M, D, G, (int)blockIdx.x);
            pg8::EpiN<FResAdd> E{FResAdd{xres}};
            pg8::gemm_phase<pg8::EpiN<FResAdd>, true>(lds, g, so, E, tidv);
        }
        GSYNC();
    }
    for (int m = gw_k; m < M; m += NGW) {
        int lane2 = tidv; asm volatile("" : "+v"(lane2)); lane2 &= 63;
        f32x4* xr = (f32x4*)(xres + (size_t)m * D) + lane2; const f32x4* gr = (const f32x4*)norm_final + lane2;
        f32x4 v[4]; float s = 0.f;
#pragma unroll
        for (int j = 0; j < 4; ++j) { v[j] = xr[64 * j]; s += (v[j].x * v[j].x + v[j].y * v[j].y) + (v[j].z * v[j].z + v[j].w * v[j].w); }
        const float r = rsqrtf(wave_sum(s) * (1.f / D) + 1e-5f);
#pragma unroll
        for (int j = 0; j < 4; ++j) { const f32x4 gg = gr[64 * j]; xr[64 * j] = v[j] * r * gg; }
    }
}

extern "C" void kernel_launch(void* const* d_in, const int* in_sizes, int n_in, void* d_out, int out_size, void* d_ws, size_t ws_size, hipStream_t stream) {
    static int grid = 0;
    if (grid == 0) {
        if (n_in != 33 || out_size != M * D || ws_size < WS_NEED) { fprintf(stderr, "kernel_launch: unexpected sizes n_in %d out %d ws %zu (need %zu)\n", n_in, out_size, ws_size, (size_t)WS_NEED); grid = -1; return; }
        int dev = 0, cus = 0, per_cu = 0;
        hipGetDevice(&dev);
        hipDeviceGetAttribute(&cus, hipDeviceAttributeMultiprocessorCount, dev);
        if (hipFuncSetAttribute((const void*)fwd_kernel, hipFuncAttributeMaxDynamicSharedMemorySize, LDS_BYTES) != hipSuccess) { fprintf(stderr, "hipFuncSetAttribute failed\n"); grid = -1; return; }
        hipOccupancyMaxActiveBlocksPerMultiprocessor(&per_cu, (const void*)fwd_kernel, NTHREADS, LDS_BYTES);
        if (per_cu < 1) { fprintf(stderr, "occupancy query returned %d\n", per_cu); per_cu = 1; }
        (void)hipGetLastError();
        grid = cus * 1;
    }
    if (grid < 0) return;
    if (hipMemsetAsync((char*)d_ws + WS_BAR, 0, 16384, stream) != hipSuccess) { fprintf(stderr, "hipMemsetAsync of the barrier words failed\n"); return; }
    Params p{};
    for (int i = 0; i < 33; ++i) p.in[i] = (const float*)d_in[i];
    p.out = (float*)d_out; p.ws = (unsigned char*)d_ws;
    void* args[] = {&p};
    hipError_t e = hipLaunchCooperativeKernel((const void*)fwd_kernel, dim3(grid), dim3(NTHREADS), args, LDS_BYTES, stream);
    if (e != hipSuccess) fprintf(stderr, "cooperative launch failed: %s (grid %d)\n", hipGetErrorString(e), grid);
}
```

```cpp
#include <hip/hip_runtime.h>
#include <hip/hip_cooperative_groups.h>
#include <cstdio>
#include <cstdint>
namespace cg = cooperative_groups;

#define LAS __attribute__((address_space(3)))
typedef unsigned short bf16_t;
typedef short bf16x8 __attribute__((ext_vector_type(8)));
typedef float f32x4 __attribute__((ext_vector_type(4)));
typedef float f32x2 __attribute__((ext_vector_type(2)));
typedef unsigned u32x4 __attribute__((ext_vector_type(4)));
typedef unsigned u32x2 __attribute__((ext_vector_type(2)));
typedef _Float16 h16;
typedef _Float16 h16x2 __attribute__((ext_vector_type(2)));

constexpr int S = 16384, NB = 2, M = NB * S, D = 1024, FF = 4096;
constexpr int NWAVES = 8, NTHREADS = 512;
constexpr int LDS_BYTES = 147456 + 64;
constexpr size_t MiB = 1u << 20;
constexpr size_t WS_W = 0;
constexpr size_t W_MLP1 = 0, W_MLP2 = 8 * MiB;
constexpr size_t W_NSA_IN = 16 * MiB, W_NSA_V = 21 * MiB, W_NSA_O = 22 * MiB, W_C1K = 24 * MiB, W_C1V = 25 * MiB, W_C2K = 26 * MiB, W_C2V = 26 * MiB + 256 * 1024, W_CBIAS = 26 * MiB + 512 * 1024;
constexpr size_t W_RW_IN = 16 * MiB, W_RW_W2 = 31 * MiB, W_RW_A2 = 31 * MiB + 256 * 1024, W_RW_V2 = 31 * MiB + 512 * 1024, W_RW_G2 = 31 * MiB + 768 * 1024, W_RW_O = 33 * MiB;
constexpr size_t WS_ROPE = 36 * MiB;
constexpr size_t WS_BAR = 38 * MiB;
constexpr size_t WS_VF = 40 * MiB;
constexpr size_t ACT = 104 * MiB;
constexpr size_t A_HN = ACT;
constexpr size_t A_Q = ACT + 65 * MiB;
constexpr size_t A_KF = ACT + 129 * MiB;
constexpr size_t A_VF = ACT + 194 * MiB;
constexpr size_t A_GATES = ACT + 226 * MiB;
constexpr size_t A_CHK = ACT + 233 * MiB, A_CHV = ACT + 237 * MiB, A_KC = ACT + 241 * MiB, A_VC = ACT + 242 * MiB;
constexpr size_t A_HID = ACT + 65 * MiB;
constexpr size_t A_R = ACT + 65 * MiB, A_K = ACT + 129 * MiB, A_V2 = ACT + 193 * MiB, A_A = ACT + 257 * MiB, A_LH = ACT + 321 * MiB;
constexpr size_t WS_NEED = ACT + 370 * MiB;

__device__ __forceinline__ int lane_id() { return (int)__builtin_amdgcn_mbcnt_hi(~0u, __builtin_amdgcn_mbcnt_lo(~0u, 0u)); }
__device__ __forceinline__ unsigned cvt_pk_bf16(float lo, float hi) { unsigned r; asm volatile("v_cvt_pk_bf16_f32 %0, %1, %2" : "=v"(r) : "v"(lo), "v"(hi)); return r; }
__device__ __forceinline__ unsigned pk_h16(float lo, float hi) { h16x2 v; v.x = (h16)lo; v.y = (h16)hi; return __builtin_bit_cast(unsigned, v); }
__device__ __forceinline__ float bf2f(bf16_t b) { return __uint_as_float(((unsigned)b) << 16); }
__device__ __forceinline__ float wave_sum(float v) {
#pragma unroll
    for (int o = 1; o < 64; o <<= 1) v += __shfl_xor(v, o);
    return v;
}
__device__ __forceinline__ float sigmoidf_(float x) { return 1.0f / (1.0f + __expf(-x)); }
__device__ __forceinline__ float tanhf_(float x) { float e = __expf(-2.0f * fabsf(x)); float t = (1.0f - e) / (1.0f + e); return x < 0.f ? -t : t; }

namespace pg8 {
constexpr int BM = 256, BK = 64, HALF = 128, HTB = HALF * BK * 2, STAGE_BYTES = 8 * HTB, NXCD = 8, WGM = 8;
__host__ __device__ __forceinline__ int lds_byte(int r, int c) { const int st = (r >> 4) * 2 + (c >> 5), rr = r & 15, cc = c & 31, ob = rr * 64 + cc * 2; return st * 1024 + (ob ^ (((ob >> 9) & 1) << 5)); }
__host__ __device__ __forceinline__ void stage_rc(int b, int& R, int& C) { const int st = b / 1024, sb = b % 1024, swz = sb ^ (((sb >> 9) & 1) << 5); R = (st >> 1) * 16 + swz / 64; C = (st & 1) * 32 + (swz % 64) / 2; }
__host__ __device__ __forceinline__ int perm32(int rho) { const int n = rho >> 4, i = rho & 15; return 8 * (i >> 2) + 4 * n + (i & 3); }
struct Unit { int pm, pn; };
struct Gemm { const bf16_t* A; const bf16_t* Bt; int M, N, K, lda, ldb, amode; };
struct StaticOrder {
    int nM, nN, nwg, G, c;
    __device__ void init(int M_, int N_, int G_, int c_) { nM = M_ / BM; nN = N_ / BM; nwg = nM * nN; G = G_; c = c_; }
    __device__ bool next(int i, Unit& u) const {
        const long L = (long)i * G + c; if (L >= nwg) return false;
        int wgid = (int)L; { const int q = nwg / NXCD, r = nwg % NXCD, xcd = wgid % NXCD, off = wgid / NXCD; wgid = (xcd < r ? xcd * (q + 1) : r * (q + 1) + (xcd - r) * q) + off; }
        const int nig = WGM * nN, gid = wgid / nig, fm = gid * WGM, gsz = (nM - fm) < WGM ? (nM - fm) : WGM;
        u.pm = fm + ((wgid % nig) % gsz); u.pn = (wgid % nig) / gsz; return true;
    }
};
__device__ __forceinline__ const char* a_base(const Gemm& g, int pm) { const size_t row = (size_t)pm * BM + (g.amode == 1 ? (size_t)(pm / 64) : 0); return (const char*)g.A + row * (size_t)g.lda * 2; }

template <class Epi, bool ALIGN_EPI>
__device__ __forceinline__ void gemm_phase(LAS unsigned char* lds, const Gemm g, const StaticOrder& S, const Epi& E, int tid_in) {
    int tid = tid_in; asm volatile("" : "+v"(tid));
    const int wid = __builtin_amdgcn_readfirstlane(tid >> 6), lane = tid & 63, wr = wid >> 2, wc = wid & 3, fr = lane & 15, fq = lane >> 4;
    int K = g.K; asm volatile("" : "+s"(K));
    const int nt = K / BK;
    unsigned voffA[2], voffB[2];
#pragma unroll
    for (int i = 0; i < 2; ++i) { int R, C; stage_rc(tid * 16 + i * 8192, R, C); const int Rb = Epi::PERM ? ((R & ~31) + perm32(R & 31)) : R;
        voffA[i] = (unsigned)(R * g.lda + C) * 2u; voffB[i] = (unsigned)(Rb * g.ldb + C) * 2u; }
    const size_t kstep = (size_t)(BK * 2);
    const size_t hstepA = (size_t)HALF * g.lda * 2, hstepB = (size_t)HALF * g.ldb * 2;
    const size_t tstepB = 2 * hstepB;
    const unsigned ldsw = (unsigned)wid * 1024u;
    const int aoff = lds_byte(wr * 64 + fr, fq * 8), boff = lds_byte(wc * 32 + fr, fq * 8);
#define PG8_SA(b, h) (((b) * 2 + (h)) * HTB)
#define PG8_SB(b, h) ((4 + (b) * 2 + (h)) * HTB)
#define PG8_STAGE(bufoff, gbase, voff) do { _Pragma("unroll") for (int _i = 0; _i < 2; ++_i) \
        __builtin_amdgcn_global_load_lds((const unsigned*)((const char*)(gbase) + (voff)[_i]), (LAS unsigned*)(lds + (bufoff) + ldsw + _i * 8192), 16, 0, 0); } while (0)
#define PG8_LDA(dst, b, h) do { _Pragma("unroll") for (int m = 0; m < 4; ++m) _Pragma("unroll") for (int k = 0; k < 2; ++k) dst[m][k] = *(const LAS bf16x8*)(lds + PG8_SA(b, h) + aoff + m * 2048 + k * 1024); } while (0)
#define PG8_LDB(dst, b, h) do { _Pragma("unroll") for (int n = 0; n < 2; ++n) _Pragma("unroll") for (int k = 0; k < 2; ++k) dst[n][k] = *(const LAS bf16x8*)(lds + PG8_SB(b, h) + boff + n * 2048 + k * 1024); } while (0)
#define PG8_MMA(ai, bj, At, Bt) do { __builtin_amdgcn_s_setprio(1); _Pragma("unroll") for (int m = 0; m < 4; ++m) _Pragma("unroll") for (int n = 0; n < 2; ++n) _Pragma("unroll") for (int k = 0; k < 2; ++k) \
        acc[ai][bj][m][n] = __builtin_amdgcn_mfma_f32_16x16x32_bf16(Bt[n][k], At[m][k], acc[ai][bj][m][n], 0, 0, 0); __builtin_amdgcn_s_setprio(0); } while (0)
#define PG8_WAIT_V(n) asm volatile("s_waitcnt vmcnt(" #n ")" ::: "memory")
#define PG8_WAIT_L(n) asm volatile("s_waitcnt lgkmcnt(" #n ")" ::: "memory")
#define PG8_BAR __builtin_amdgcn_s_barrier()
#define PG8_SCHED __builtin_amdgcn_sched_barrier(0)
    Unit cur, nxt; int ui = 0;
    if (!S.next(0, cur)) return;
    f32x4 acc[2][2][4][2];
#pragma unroll
    for (int a = 0; a < 2; ++a)
#pragma unroll
        for (int b = 0; b < 2; ++b)
#pragma unroll
            for (int m = 0; m < 4; ++m)
#pragma unroll
                for (int n = 0; n < 2; ++n) acc[a][b][m][n] = (f32x4){0.f, 0.f, 0.f, 0.f};
    bf16x8 At[4][2], B0[2][2], B1[2][2];
    const char* cA = a_base(g, cur.pm); const char* cB = (const char*)g.Bt + (size_t)cur.pn * tstepB;
    PG8_STAGE(PG8_SB(0, 0), cB, voffB); PG8_STAGE(PG8_SB(0, 1), cB + hstepB, voffB); PG8_STAGE(PG8_SA(0, 0), cA, voffA); PG8_STAGE(PG8_SA(0, 1), cA + hstepA, voffA);
    if (wr == 1) PG8_BAR;
    PG8_WAIT_V(2); PG8_BAR;
    PG8_STAGE(PG8_SB(1, 0), cB + kstep, voffB); PG8_STAGE(PG8_SA(1, 0), cA + kstep, voffA); PG8_STAGE(PG8_SB(1, 1), cB + hstepB + kstep, voffB);
    PG8_WAIT_V(6); PG8_BAR;
    for (;;) {
        const bool has_next = S.next(ui + 1, nxt);
        const char* nA = has_next ? a_base(g, nxt.pm) : cA; const char* nB = has_next ? (const char*)g.Bt + (size_t)nxt.pn * tstepB : cB;
        for (int t = 0; t < nt; t += 2) {
            const bool last = (t == nt - 2);
            const char* a1 = cA + (size_t)(t + 1) * kstep;
            const char* a2 = last ? nA : cA + (size_t)(t + 2) * kstep; const char* b2 = last ? nB : cB + (size_t)(t + 2) * kstep;
            const char* a3 = a2 + kstep; const char* b3 = b2 + kstep;
            PG8_LDB(B0, 0, 0); PG8_LDB(B1, 0, 1); PG8_SCHED; PG8_LDA(At, 0, 0); PG8_STAGE(PG8_SA(1, 1), a1 + hstepA, voffA);
            PG8_WAIT_V(8); PG8_WAIT_L(0); PG8_BAR; PG8_MMA(0, 0, At, B0); PG8_MMA(0, 1, At, B1); PG8_BAR; PG8_SCHED;
            PG8_LDA(At, 0, 1); PG8_STAGE(PG8_SB(0, 0), b2, voffB); PG8_STAGE(PG8_SB(0, 1), b2 + hstepB, voffB); PG8_STAGE(PG8_SA(0, 0), a2, voffA);
            PG8_WAIT_V(8); PG8_WAIT_L(0); PG8_BAR; PG8_MMA(1, 0, At, B0); PG8_MMA(1, 1, At, B1); PG8_BAR; PG8_SCHED;
            PG8_LDB(B0, 1, 0); PG8_LDB(B1, 1, 1); PG8_SCHED; PG8_LDA(At, 1, 0); PG8_STAGE(PG8_SA(0, 1), a2 + hstepA, voffA);
            PG8_WAIT_V(8); PG8_WAIT_L(0); PG8_BAR; PG8_MMA(0, 0, At, B0); PG8_MMA(0, 1, At, B1); PG8_BAR; PG8_SCHED;
            PG8_LDA(At, 1, 1); PG8_STAGE(PG8_SB(1, 0), b3, voffB); PG8_STAGE(PG8_SB(1, 1), b3 + hstepB, voffB); PG8_STAGE(PG8_SA(1, 0), a3, voffA);
            PG8_WAIT_V(8); PG8_WAIT_L(0); PG8_BAR; PG8_MMA(1, 0, At, B0); PG8_MMA(1, 1, At, B1); PG8_BAR; PG8_SCHED;
        }
        if constexpr (ALIGN_EPI) { if (wr == 0) PG8_BAR; }
        E(acc, cur, wr, wc, fr, fq);
        if (!has_next) break;
#pragma unroll
        for (int a = 0; a < 2; ++a)
#pragma unroll
            for (int b = 0; b < 2; ++b)
#pragma unroll
                for (int m = 0; m < 4; ++m)
#pragma unroll
                    for (int n = 0; n < 2; ++n) acc[a][b][m][n] = (f32x4){0.f, 0.f, 0.f, 0.f};
        cur = nxt; cA = nA; cB = nB; ++ui;
        if constexpr (ALIGN_EPI) { if (wr == 1) PG8_BAR; }
    }
    PG8_WAIT_V(0);
    if constexpr (!ALIGN_EPI) { if (wr == 0) PG8_BAR; }
    PG8_BAR;
#undef PG8_SA
#undef PG8_SB
#undef PG8_STAGE
#undef PG8_LDA
#undef PG8_LDB
#undef PG8_MMA
#undef PG8_WAIT_V
#undef PG8_WAIT_L
#undef PG8_BAR
#undef PG8_SCHED
}
template <class F> struct EpiP {
    static constexpr bool PERM = true; F f;
    __device__ __forceinline__ void operator()(const f32x4 (&acc)[2][2][4][2], const Unit& u, int wr, int wc, int fr, int fq) const {
#pragma unroll
        for (int ai = 0; ai < 2; ++ai)
#pragma unroll
            for (int m = 0; m < 4; ++m) { int row = u.pm * BM + ai * HALF + wr * 64 + m * 16 + fr; asm volatile("" : "+v"(row));
#pragma unroll
                for (int bj = 0; bj < 2; ++bj) { const int col0 = u.pn * BM + bj * HALF + wc * 32 + 8 * fq; f(row, col0, acc[ai][bj][m][0], acc[ai][bj][m][1]); } asm volatile("" ::: "memory"); }
    }
};
template <class F> struct EpiN {
    static constexpr bool PERM = false; F f;
    __device__ __forceinline__ void operator()(const f32x4 (&acc)[2][2][4][2], const Unit& u, int wr, int wc, int fr, int fq) const {
#pragma unroll
        for (int ai = 0; ai < 2; ++ai)
#pragma unroll
            for (int m = 0; m < 4; ++m) { int row = u.pm * BM + ai * HALF + wr * 64 + m * 16 + fr; asm volatile("" : "+v"(row));
#pragma unroll
                for (int bj = 0; bj < 2; ++bj)
#pragma unroll
                    for (int n = 0; n < 2; ++n) { const int col0 = u.pn * BM + bj * HALF + wc * 32 + 16 * n + 4 * fq; f(row, col0, acc[ai][bj][m][n]); } asm volatile("" ::: "memory"); }
    }
};
}

struct Params {
    const float* in[33];
    float* out;
    unsigned char* ws;
};

struct TJob { const float* W; int ldw, n0src, Nsrc, Ksrc; bf16_t* WT; int ldt, row_off, col_off, Npad, Kpad; const float* mix; int mode; };
__device__ __forceinline__ void transpose_job(const TJob& j, LAS float* scr, int gw, int NGW, int lane_) {
    int lane = lane_; asm volatile("" : "+v"(lane));
    const int nblk = j.Npad / 32, kblk = j.Kpad / 64, items = nblk * kblk;
    for (int it = gw; it < items; it += NGW) {
        const int kb = it / nblk, nb = it % nblk, k0 = 64 * kb, n0 = 32 * nb;
#pragma unroll 4
        for (int i = 0; i < 32; ++i) { const int kk = 2 * i + (lane >> 5), n = lane & 31; float v = 0.f;
            if (k0 + kk < j.Ksrc && n0 + n < j.Nsrc) { v = j.W[(size_t)(k0 + kk) * j.ldw + j.n0src + n0 + n];
                if (j.mode == 1) v *= j.mix[k0 + kk]; else if (j.mode == 2) v *= (1.0f - j.mix[k0 + kk]); }
            scr[kk * 33 + n] = v; }
        asm volatile("s_waitcnt lgkmcnt(0)" ::: "memory");
        const int c = lane & 7;
#pragma unroll
        for (int jj = 0; jj < 4; ++jj) { const int n = (lane >> 3) + 8 * jj; const LAS float* s = scr + (8 * c) * 33 + n;
            u32x4 o; o.x = cvt_pk_bf16(s[0 * 33], s[1 * 33]); o.y = cvt_pk_bf16(s[2 * 33], s[3 * 33]); o.z = cvt_pk_bf16(s[4 * 33], s[5 * 33]); o.w = cvt_pk_bf16(s[6 * 33], s[7 * 33]);
            *(u32x4*)(j.WT + (size_t)(j.row_off + n0 + n) * j.ldt + j.col_off + k0 + 8 * c) = o; }
        asm volatile("s_waitcnt lgkmcnt(0)" ::: "memory");
    }
}

__device__ __forceinline__ void rms_row_bf16(const float* xrow, const float* g, bf16_t* orow, float* copy_to, int lane_) {
    int lane = lane_; asm volatile("" : "+v"(lane));
    const f32x4* xr = (const f32x4*)xrow + lane; const f32x4* gr = (const f32x4*)g + lane;
    f32x4 v[4]; float s = 0.f;
#pragma unroll
    for (int j = 0; j < 4; ++j) { v[j] = xr[64 * j]; s += (v[j].x * v[j].x + v[j].y * v[j].y) + (v[j].z * v[j].z + v[j].w * v[j].w); }
    if (copy_to) {
#pragma unroll
        for (int j = 0; j < 4; ++j) ((f32x4*)copy_to + lane)[64 * j] = v[j];
    }
    const float r = rsqrtf(wave_sum(s) * (1.f / D) + 1e-5f);
    u32x2* o8 = (u32x2*)orow + lane;
#pragma unroll
    for (int j = 0; j < 4; ++j) { const f32x4 gg = gr[64 * j]; u32x2 w; w.x = cvt_pk_bf16(v[j].x * r * gg.x, v[j].y * r * gg.y); w.y = cvt_pk_bf16(v[j].z * r * gg.z, v[j].w * r * gg.w); o8[64 * j] = w; }
}

struct FRelu2 { bf16_t* O; __device__ __forceinline__ void operator()(int row, int col0, f32x4 a, f32x4 b) const {
    f32x4 x = a, y = b;
#pragma unroll
    for (int i = 0; i < 4; ++i) { float t = fmaxf(x[i], 0.f); x[i] = t * t; t = fmaxf(y[i], 0.f); y[i] = t * t; }
    u32x4 w; w.x = cvt_pk_bf16(x[0], x[1]); w.y = cvt_pk_bf16(x[2], x[3]); w.z = cvt_pk_bf16(y[0], y[1]); w.w = cvt_pk_bf16(y[2], y[3]);
    *(u32x4*)(O + (size_t)row * FF + col0) = w; } };
struct FResAdd { float* X; __device__ __forceinline__ void operator()(int row, int col0, f32x4 a) const {
    f32x4* p = (f32x4*)(X + (size_t)row * D + col0); *p = *p + a; } };


struct FRwIn { h16* R; h16* Kk; h16* V; bf16_t* LH;
    __device__ __forceinline__ void operator()(int row, int col0, f32x4 a, f32x4 b) const {
        const int seg = __builtin_amdgcn_readfirstlane(col0 >> 10);
        if (seg < 3) { const long dK = (const char*)Kk - (const char*)R, dV = (const char*)V - (const char*)R; const long off = (seg == 1 ? dK : 0l) + (seg == 2 ? dV : 0l); h16* dst = (h16*)((char*)R + off); const int c = col0 & 1023;
            u32x4 w; w.x = pk_h16(a[0], a[1]); w.y = pk_h16(a[2], a[3]); w.z = pk_h16(b[0], b[1]); w.w = pk_h16(b[2], b[3]);
            *(u32x4*)(dst + (size_t)row * D + c) = w; }
        else { const int c = col0 - 3072; f32x4 x = a, y = b;
            if (c < 128) {
#pragma unroll
                for (int i = 0; i < 4; ++i) { x[i] = tanhf_(x[i]); y[i] = tanhf_(y[i]); } }
            else if (c >= 256 && c < 512) {
#pragma unroll
                for (int i = 0; i < 4; ++i) { x[i] = sigmoidf_(x[i]); y[i] = sigmoidf_(y[i]); } }
            u32x4 w; w.x = cvt_pk_bf16(x[0], x[1]); w.y = cvt_pk_bf16(x[2], x[3]); w.z = cvt_pk_bf16(y[0], y[1]); w.w = cvt_pk_bf16(y[2], y[3]);
            *(u32x4*)(LH + (size_t)row * 768 + c) = w; }
    } };
struct FLoraW { h16* EW; const float* w0;
    __device__ __forceinline__ void operator()(int row, int col0, f32x4 a, f32x4 b) const {
        const f32x4 p = *(const f32x4*)(w0 + col0), q = *(const f32x4*)(w0 + col0 + 4); float o[8];
#pragma unroll
        for (int i = 0; i < 4; ++i) { o[i] = 0.60653066f * sigmoidf_(p[i] + a[i]); o[4 + i] = 0.60653066f * sigmoidf_(q[i] + b[i]); }
        u32x4 w; w.x = pk_h16(o[0], o[1]); w.y = pk_h16(o[2], o[3]); w.z = pk_h16(o[4], o[5]); w.w = pk_h16(o[6], o[7]);
        *(u32x4*)(EW + (size_t)row * D + col0) = w; } };
struct FLoraA { h16* Aa; const float* a0;
    __device__ __forceinline__ void operator()(int row, int col0, f32x4 a, f32x4 b) const {
        const f32x4 p = *(const f32x4*)(a0 + col0), q = *(const f32x4*)(a0 + col0 + 4); float o[8];
#pragma unroll
        for (int i = 0; i < 4; ++i) { o[i] = sigmoidf_(p[i] + a[i]); o[4 + i] = sigmoidf_(q[i] + b[i]); }
        u32x4 w; w.x = pk_h16(o[0], o[1]); w.y = pk_h16(o[2], o[3]); w.z = pk_h16(o[4], o[5]); w.w = pk_h16(o[6], o[7]);
        *(u32x4*)(Aa + (size_t)row * D + col0) = w; } };
struct FLoraV { h16* V; const h16* VFm; const float* v0;
    __device__ __forceinline__ void operator()(int row, int col0, f32x4 a, f32x4 b) const {
        const f32x4 p = *(const f32x4*)(v0 + col0), q = *(const f32x4*)(v0 + col0 + 4);
        typedef h16 h16x8 __attribute__((ext_vector_type(8)));
        const h16x8 vv = *(const h16x8*)(V + (size_t)row * D + col0), vf = *(const h16x8*)(VFm + (size_t)row * D + col0); float o[8];
#pragma unroll
        for (int i = 0; i < 4; ++i) { float v = (float)vv[i], f = (float)vf[i]; o[i] = v + (f - v) * sigmoidf_(p[i] + a[i]); v = (float)vv[4 + i]; f = (float)vf[4 + i]; o[4 + i] = v + (f - v) * sigmoidf_(q[i] + b[i]); }
        u32x4 w; w.x = pk_h16(o[0], o[1]); w.y = pk_h16(o[2], o[3]); w.z = pk_h16(o[4], o[5]); w.w = pk_h16(o[6], o[7]);
        *(u32x4*)(V + (size_t)row * D + col0) = w; } };
struct FGate { bf16_t* O; const h16* Y;
    __device__ __forceinline__ void operator()(int row, int col0, f32x4 a, f32x4 b) const {
        typedef h16 h16x8 __attribute__((ext_vector_type(8)));
        const h16x8 yy = *(const h16x8*)(Y + (size_t)row * D + col0);
        u32x4 w; w.x = cvt_pk_bf16(a[0] * (float)yy[0], a[1] * (float)yy[1]); w.y = cvt_pk_bf16(a[2] * (float)yy[2], a[3] * (float)yy[3]);
        w.z = cvt_pk_bf16(b[0] * (float)yy[4], b[1] * (float)yy[5]); w.w = cvt_pk_bf16(b[2] * (float)yy[6], b[3] * (float)yy[7]);
        *(u32x4*)(O + (size_t)row * D + col0) = w; } };

template <int CTRL> __device__ __forceinline__ float dppmov(float v) { return __builtin_bit_cast(float, __builtin_amdgcn_update_dpp(0, __builtin_bit_cast(int, v), CTRL, 0xF, 0xF, true)); }
__device__ __forceinline__ float row16_sum(float v) { v += dppmov<0xB1>(v); v += dppmov<0x4E>(v); v += dppmov<0x124>(v); v += dppmov<0x128>(v); return v; }
typedef _Float16 h16x4 __attribute__((ext_vector_type(4)));
__device__ __forceinline__ void h4_to_f(h16x4 u, float* f) { f[0] = (float)u[0]; f[1] = (float)u[1]; f[2] = (float)u[2]; f[3] = (float)u[3]; }
__device__ __forceinline__ void rwkv_scan(const h16* R, const h16* Kk, const h16* V, const h16* EW, const h16* Aa, const float* k_k, const float* k_a, h16* Yraw, int G, int wave, int lane_) {
    int lane = lane_; asm volatile("" : "+v"(lane));
    const int NT = G * NWAVES;
    for (int task = wave * G + (int)blockIdx.x; task < 512; task += NT) {
        const int bh = task >> 4, rg = task & 15, b = bh >> 4, h = bh & 15;
        const int row = lane >> 4, jg = lane & 15, i = rg * 4 + row;
        const int colj = h * 64 + 4 * jg, coli = h * 64 + i;
        float kkc[4], kac[4];
#pragma unroll
        for (int j = 0; j < 4; ++j) { kkc[j] = k_k[colj + j]; kac[j] = k_a[colj + j]; }
        float s[4] = {0.f, 0.f, 0.f, 0.f};
        const size_t base = (size_t)b * S * D;
        const h16* pR = R + base + colj; const h16* pK = Kk + base + colj; const h16* pA = Aa + base + colj; const h16* pE = EW + base + colj; const h16* pV = V + base + coli;
        h16* pY = Yraw + ((size_t)task * S) * 4 + row;
        constexpr int TC = 4;
        h16x4 cr[TC], ck[TC], ca[TC], ce[TC]; h16 cv[TC];
#pragma unroll
        for (int u = 0; u < TC; ++u) { const size_t o = (size_t)u * D; cr[u] = *(const h16x4*)(pR + o); ck[u] = *(const h16x4*)(pK + o); ca[u] = *(const h16x4*)(pA + o); ce[u] = *(const h16x4*)(pE + o); cv[u] = pV[o]; }
        for (int t0 = 0; t0 < S; t0 += TC) {
            const int tn = (t0 + TC < S) ? t0 + TC : t0;
            h16x4 nr[TC], nk[TC], na[TC], ne[TC]; h16 nv[TC];
#pragma unroll
            for (int u = 0; u < TC; ++u) { const size_t o = (size_t)(tn + u) * D; nr[u] = *(const h16x4*)(pR + o); nk[u] = *(const h16x4*)(pK + o); na[u] = *(const h16x4*)(pA + o); ne[u] = *(const h16x4*)(pE + o); nv[u] = pV[o]; }
#pragma unroll
            for (int u = 0; u < TC; ++u) {
                float rv[4], kv[4], av[4], ev[4]; h4_to_f(cr[u], rv); h4_to_f(ck[u], kv); h4_to_f(ca[u], av); h4_to_f(ce[u], ev);
                const float vi = (float)cv[u];
                float kq[4], n2 = 0.f;
#pragma unroll
                for (int j = 0; j < 4; ++j) { kq[j] = kv[j] * kkc[j]; n2 += kq[j] * kq[j]; }
                n2 = row16_sum(n2);
                const float inv = 1.0f / fmaxf(sqrtf(n2), 1e-12f);
                float kkj[4], kt[4], bb[4], w[4], dot = 0.f;
#pragma unroll
                for (int j = 0; j < 4; ++j) { kkj[j] = kq[j] * inv; kt[j] = kv[j] * (1.0f + (av[j] - 1.0f) * kac[j]); bb[j] = kkj[j] * av[j]; w[j] = __expf(-ev[j]); dot += s[j] * kkj[j]; }
                const float sa = -row16_sum(dot);
                float yd = 0.f;
#pragma unroll
                for (int j = 0; j < 4; ++j) { s[j] = s[j] * w[j] + (sa * bb[j] + vi * kt[j]); yd += s[j] * rv[j]; }
                const float y = row16_sum(yd);
                if (jg == 0) pY[(size_t)(t0 + u) * 4] = (h16)y;
            }
#pragma unroll
            for (int u = 0; u < TC; ++u) { cr[u] = nr[u]; ck[u] = nk[u]; ca[u] = na[u]; ce[u] = ne[u]; cv[u] = nv[u]; }
        }
    }
}
constexpr int SC_CS = 32, SC_STEP_F = 5 * 64 + 8, SC_BUF_F = SC_CS * SC_STEP_F;
#define SC_BAR() do { asm volatile("s_waitcnt lgkmcnt(0)" ::: "memory"); __builtin_amdgcn_s_barrier(); asm volatile("" ::: "memory"); } while (0)
__device__ __forceinline__ float wave_sum_dpp(float v) {
    v = row16_sum(v);
    const float a = __builtin_bit_cast(float, __builtin_amdgcn_readlane(__builtin_bit_cast(int, v), 0)), b = __builtin_bit_cast(float, __builtin_amdgcn_readlane(__builtin_bit_cast(int, v), 16));
    const float c = __builtin_bit_cast(float, __builtin_amdgcn_readlane(__builtin_bit_cast(int, v), 32)), d = __builtin_bit_cast(float, __builtin_amdgcn_readlane(__builtin_bit_cast(int, v), 48));
    return (a + b) + (c + d);
}
struct ScRegs { h16 k[8], a[8], e[8], r[8], v[8]; };
__device__ __forceinline__ void sc_load(ScRegs& g, const h16* R, const h16* Kk, const h16* V, const h16* EW, const h16* Aa, size_t base, int c, int pw, int sub, int lane) {
#pragma unroll
    for (int q = 0; q < 8; ++q) { const size_t o = base + (size_t)(c * SC_CS + pw + 4 * q) * D;
        g.k[q] = Kk[o + lane]; g.a[q] = Aa[o + lane]; g.e[q] = EW[o + lane]; g.r[q] = R[o + lane]; g.v[q] = V[o + sub * 8 + (lane & 7)]; }
}
__device__ __forceinline__ void sc_compute(const ScRegs& g, LAS float* sb, int pw, float kkc, float kac, int lane) {
#pragma unroll
    for (int q = 0; q < 8; ++q) {
        const float kv = (float)g.k[q], av = (float)g.a[q], ev = (float)g.e[q], rv = (float)g.r[q]; const float kq = kv * kkc;
        const float n2 = wave_sum_dpp(kq * kq);
        const float kkj = kq * rsqrtf(fmaxf(n2, 1e-24f)); LAS float* p = sb + (pw + 4 * q) * SC_STEP_F;
        p[lane] = kkj; p[64 + lane] = kkj * av; p[128 + lane] = kv * (1.0f + (av - 1.0f) * kac); p[192 + lane] = __expf(-ev); p[256 + lane] = rv; if (lane < 8) p[320 + lane] = (float)g.v[q];
    }
}
__device__ __forceinline__ void rwkv_scan2(const h16* R, const h16* Kk, const h16* V, const h16* EW, const h16* Aa, const float* k_k, const float* k_a, h16* Yraw, LAS unsigned char* lds, int wave, int lane_) {
    int lane = lane_; asm volatile("" : "+v"(lane));
    LAS float* buf = (LAS float*)lds;
    constexpr int NCH = S / SC_CS;
#pragma unroll 1
    for (int vb = (int)blockIdx.x; vb < 256; vb += (int)gridDim.x) {
        const int bh = vb >> 3, sub = vb & 7, b = bh >> 4, h = bh & 15;
        const size_t base = (size_t)b * S * D + h * 64;
        if (wave >= 4) {
            const int pw = wave - 4;
            const float kkc = k_k[h * 64 + lane], kac = k_a[h * 64 + lane];
            ScRegs ga, gb;
            sc_load(ga, R, Kk, V, EW, Aa, base, 0, pw, sub, lane);
            sc_load(gb, R, Kk, V, EW, Aa, base, 1, pw, sub, lane);
            sc_compute(ga, buf, pw, kkc, kac, lane);
            SC_BAR();
#pragma unroll 1
            for (int c = 0; c < NCH; c += 2) {
                { const int c2 = (c + 2 < NCH) ? c + 2 : c; sc_load(ga, R, Kk, V, EW, Aa, base, c2, pw, sub, lane); }
                sc_compute(gb, buf + SC_BUF_F, pw, kkc, kac, lane);
                SC_BAR();
                { const int c3 = (c + 3 < NCH) ? c + 3 : c + 1; sc_load(gb, R, Kk, V, EW, Aa, base, c3, pw, sub, lane); }
                if (c + 2 < NCH) sc_compute(ga, buf, pw, kkc, kac, lane);
                SC_BAR();
            }
            SC_BAR();
        } else if (wave < 2) {
            const int jg = lane & 15, cw = wave;
            float s0 = 0.f, s1 = 0.f, s2 = 0.f, s3 = 0.f;
            SC_BAR();
#pragma unroll 1
            for (int c = 0; c < NCH; ++c) {
                const LAS float* sb = buf + (c & 1) * SC_BUF_F + 4 * jg;
                const LAS float* vb_ = buf + (c & 1) * SC_BUF_F + 320 + cw * 4 + (lane >> 4);
                LAS float* yp = buf + 2 * SC_BUF_F + ((c & 1) * 2 + cw) * (SC_CS * 64) + lane;
                f32x4 kk4 = *(const LAS f32x4*)(sb), bb4 = *(const LAS f32x4*)(sb + 64), kt4 = *(const LAS f32x4*)(sb + 128), w4 = *(const LAS f32x4*)(sb + 192), r4 = *(const LAS f32x4*)(sb + 256); float vi = vb_[0];
#pragma unroll 4
                for (int st = 0; st < SC_CS; ++st) {
                    const int sn = (st + 1 < SC_CS) ? st + 1 : st;
                    const f32x4 nkk = *(const LAS f32x4*)(sb + sn * SC_STEP_F), nbb = *(const LAS f32x4*)(sb + sn * SC_STEP_F + 64), nkt = *(const LAS f32x4*)(sb + sn * SC_STEP_F + 128), nw = *(const LAS f32x4*)(sb + sn * SC_STEP_F + 192), nr4 = *(const LAS f32x4*)(sb + sn * SC_STEP_F + 256);
                    const float nvi = vb_[sn * SC_STEP_F];
                    const float sa = -row16_sum((s0 * kk4[0] + s1 * kk4[1]) + (s2 * kk4[2] + s3 * kk4[3]));
                    s0 = s0 * w4[0] + (sa * bb4[0] + vi * kt4[0]); s1 = s1 * w4[1] + (sa * bb4[1] + vi * kt4[1]);
                    s2 = s2 * w4[2] + (sa * bb4[2] + vi * kt4[2]); s3 = s3 * w4[3] + (sa * bb4[3] + vi * kt4[3]);
                    yp[st * 64] = (s0 * r4[0] + s1 * r4[1]) + (s2 * r4[2] + s3 * r4[3]);
                    kk4 = nkk; bb4 = nbb; kt4 = nkt; w4 = nw; r4 = nr4; vi = nvi;
                }
                SC_BAR();
            }
            SC_BAR();
        } else {
            const int cw = wave - 2;
            h16* pY = Yraw + ((size_t)(bh * 16 + sub * 2 + cw) * S) * 4;
            SC_BAR();
#pragma unroll 1
            for (int c = 0; c <= NCH; ++c) {
                if (c > 0) {
                    const LAS float* yp = buf + 2 * SC_BUF_F + (((c - 1) & 1) * 2 + cw) * (SC_CS * 64);
                    const int st = lane >> 1, r0 = 2 * (lane & 1);
                    float a0 = 0.f, a1 = 0.f;
#pragma unroll
                    for (int q = 0; q < 4; ++q) { const f32x4 x = *(const LAS f32x4*)(yp + st * 64 + r0 * 16 + 4 * q), z = *(const LAS f32x4*)(yp + st * 64 + (r0 + 1) * 16 + 4 * q);
                        a0 += (x[0] + x[1]) + (x[2] + x[3]); a1 += (z[0] + z[1]) + (z[2] + z[3]); }
                    *(unsigned*)(pY + (size_t)((c - 1) * SC_CS + st) * 4 + r0) = pk_h16(a0, a1);
                }
                SC_BAR();
            }
        }
        if (false) {
            SC_BAR();
#pragma unroll 1
            for (int c = 0; c < NCH; ++c) SC_BAR();
        }
    }
}
__device__ __forceinline__ void rwkv_gn(h16* R, const h16* Kk, const h16* V, const h16* Aa, const h16* Yraw, const float* k_a, const float* r_k, const float* ln_w, const float* ln_b, int gw, int NGW, int lane_) {
    int lane = lane_; asm volatile("" : "+v"(lane));
    const int hq = lane >> 4, c4 = 4 * (lane & 15);
#pragma unroll 2
    for (int idx = gw; idx < M * 4; idx += NGW) {
        const int m = idx >> 2, h = (idx & 3) * 4 + hq, col = h * 64 + c4; const size_t o = (size_t)m * D + col;
        const int bq = m / S, tq = m - bq * S;
        float y[4], r[4], k[4], a[4], v[4];
        h4_to_f(*(const h16x4*)(Yraw + ((size_t)((bq * 16 + h) * 16 + (lane & 15)) * S + tq) * 4), y);
        h4_to_f(*(const h16x4*)(R + o), r); h4_to_f(*(const h16x4*)(Kk + o), k); h4_to_f(*(const h16x4*)(Aa + o), a); h4_to_f(*(const h16x4*)(V + o), v);
        const f32x4 ka4 = *(const f32x4*)(k_a + col), rk4 = *(const f32x4*)(r_k + col), lw4 = *(const f32x4*)(ln_w + col), lb4 = *(const f32x4*)(ln_b + col);
        const float mu = row16_sum((y[0] + y[1]) + (y[2] + y[3])) * (1.f / 64.f);
        float d[4], q = 0.f, bsp = 0.f;
#pragma unroll
        for (int i = 0; i < 4; ++i) { d[i] = y[i] - mu; q += d[i] * d[i]; const float kt = k[i] * (1.0f + (a[i] - 1.0f) * ka4[i]); bsp += r[i] * kt * rk4[i]; }
        const float rstd = rsqrtf(row16_sum(q) * (1.f / 64.f) + 64e-5f), bs = row16_sum(bsp);
        h16x4 outv;
#pragma unroll
        for (int i = 0; i < 4; ++i) outv[i] = (h16)(d[i] * rstd * lw4[i] + lb4[i] + bs * v[i]);
        *(h16x4*)(R + o) = outv;
    }
}

constexpr size_t KF_STRIDE = (size_t)NB * 4 * S * 64;
__device__ __forceinline__ float gelu_tanh(float x) { const float u = 0.7978845608f * (x + 0.044715f * x * x * x); return 0.5f * x * (1.0f + tanhf_(u)); }
__device__ __forceinline__ void store_vf8(bf16_t* chunk_base_d, int keyp0  , f32x4 a, f32x4 b) {
    const int tile = keyp0 >> 4, rq0 = (keyp0 & 15) >> 2;
    u32x2 w0, w1; w0.x = cvt_pk_bf16(a[0], a[1]); w0.y = cvt_pk_bf16(a[2], a[3]); w1.x = cvt_pk_bf16(b[0], b[1]); w1.y = cvt_pk_bf16(b[2], b[3]);
    *(u32x2*)(chunk_base_d + 8 * rq0 + 4 * tile) = w0; *(u32x2*)(chunk_base_d + 8 * (rq0 + 1) + 4 * tile) = w1;
}
struct FNsaIn { bf16_t* Q; bf16_t* KF; float* gates; const float* rope;
    __device__ __forceinline__ void operator()(int row, int col0, f32x4 a, f32x4 b) const {
        const int tile = __builtin_amdgcn_readfirstlane(col0 >> 8);
        const int bb = row / S, t = row - bb * S;
        if (tile < 7) {
            f32x4 x = a, y = b;
            if ((col0 & 32) == 0) {
                f32x4 px, py;
#pragma unroll
                for (int i = 0; i < 4; ++i) { px[i] = __shfl_xor(x[i], 16); py[i] = __shfl_xor(y[i], 16); }
                const int d0 = col0 & 63;
                if (d0 < 16) { const f32x4 c0 = *(const f32x4*)(rope + t * 16), c1 = *(const f32x4*)(rope + t * 16 + 4), s0 = *(const f32x4*)(rope + t * 16 + 8), s1 = *(const f32x4*)(rope + t * 16 + 12);
                    if (d0 == 0) { x = x * c0 - px * s0; y = y * c1 - py * s1; } else { x = x * c0 + px * s0; y = y * c1 + py * s1; } }
            }
            if (tile < 4) { x = x * 0.18033688011112042f; y = y * 0.18033688011112042f;
                u32x4 w; w.x = cvt_pk_bf16(x[0], x[1]); w.y = cvt_pk_bf16(x[2], x[3]); w.z = cvt_pk_bf16(y[0], y[1]); w.w = cvt_pk_bf16(y[2], y[3]);
                *(u32x4*)(Q + (size_t)row * D + col0) = w; }
            else { const int idx = tile - 4, g = (col0 & 255) >> 6, d0 = col0 & 63;
                u32x4 w; w.x = cvt_pk_bf16(x[0], x[1]); w.y = cvt_pk_bf16(x[2], x[3]); w.z = cvt_pk_bf16(y[0], y[1]); w.w = cvt_pk_bf16(y[2], y[3]);
                *(u32x4*)(KF + (size_t)idx * KF_STRIDE + ((size_t)(bb * 4 + g) * S + t) * 64 + d0) = w; }
        } else if (tile == 7) { const int g = (col0 & 255) >> 6, d0 = col0 & 63;
            u32x4 w; w.x = cvt_pk_bf16(a[0], a[1]); w.y = cvt_pk_bf16(a[2], a[3]); w.z = cvt_pk_bf16(b[0], b[1]); w.w = cvt_pk_bf16(b[2], b[3]);
            *(u32x4*)(KF + (size_t)3 * KF_STRIDE + ((size_t)(bb * 4 + g) * S + t) * 64 + d0) = w;
        } else { const int c = col0 - 2048;
            if (c < 48) { f32x4 x, y;
#pragma unroll
                for (int i = 0; i < 4; ++i) { x[i] = sigmoidf_(a[i]); y[i] = sigmoidf_(b[i]); }
                *(f32x4*)(gates + (size_t)row * 48 + c) = x; *(f32x4*)(gates + (size_t)row * 48 + c + 4) = y; }
        }
    } };
struct FNsaVT { bf16_t* VF;
    __device__ __forceinline__ void operator()(int row, int col0, f32x4 a, f32x4 b) const {
        const int br = row >> 8, g = (row >> 6) & 3, d = row & 63, bb = col0 / S, t0 = col0 - bb * S;
        bf16_t* base = VF + (size_t)br * KF_STRIDE + (size_t)(bb * 4 + g) * S * 64 + (size_t)(t0 >> 5) * 2048 + d * 32;
        store_vf8(base, t0 & 31, a, b); } };
struct FCmp1 { bf16_t* CH; const float* bias;
    __device__ __forceinline__ void operator()(int row, int col0, f32x4 a, f32x4 b) const {
        const f32x4 p = *(const f32x4*)(bias + col0), q = *(const f32x4*)(bias + col0 + 4); float o[8];
#pragma unroll
        for (int i = 0; i < 4; ++i) { o[i] = gelu_tanh(a[i] + p[i]); o[4 + i] = gelu_tanh(b[i] + q[i]); }
        u32x4 w; w.x = cvt_pk_bf16(o[0], o[1]); w.y = cvt_pk_bf16(o[2], o[3]); w.z = cvt_pk_bf16(o[4], o[5]); w.w = cvt_pk_bf16(o[6], o[7]);
        *(u32x4*)(CH + (size_t)row * 256 + col0) = w; } };
struct FCmp2K { bf16_t* KC;
    __device__ __forceinline__ void operator()(int row, int col0, f32x4 a, f32x4 b) const {
        if (col0 < 64) { u32x4 w; w.x = cvt_pk_bf16(a[0], a[1]); w.y = cvt_pk_bf16(a[2], a[3]); w.z = cvt_pk_bf16(b[0], b[1]); w.w = cvt_pk_bf16(b[2], b[3]);
            *(u32x4*)(KC + (size_t)row * 64 + col0) = w; } } };
struct FCmp2VT { bf16_t* VC;
    __device__ __forceinline__ void operator()(int row, int col0, f32x4 a, f32x4 b) const {
        if (row < 64) { const int bg = col0 >> 10, n0 = col0 & 1023;
            bf16_t* base = VC + (size_t)bg * 65536 + (size_t)(n0 >> 5) * 2048 + row * 32; store_vf8(base, n0 & 31, a, b); } } };

__device__ __forceinline__ f32x4 mfma16(bf16x8 a, bf16x8 b, f32x4 c) { return __builtin_amdgcn_mfma_f32_16x16x32_bf16(a, b, c, 0, 0, 0); }
__device__ __forceinline__ bf16x8 ld8(const bf16_t* p) { return *(const bf16x8*)p; }
__device__ __forceinline__ bf16x8 pack8(f32x4 a, f32x4 b) { u32x4 w; w.x = cvt_pk_bf16(a[0], a[1]); w.y = cvt_pk_bf16(a[2], a[3]); w.z = cvt_pk_bf16(b[0], b[1]); w.w = cvt_pk_bf16(b[2], b[3]); return __builtin_bit_cast(bf16x8, w); }
__device__ __forceinline__ float colmax(float x) {
    const auto r = __builtin_amdgcn_permlane16_swap(__float_as_uint(x), __float_as_uint(x), false, false); x = fmaxf(__uint_as_float(r[0]), __uint_as_float(r[1]));
    const auto q = __builtin_amdgcn_permlane32_swap(__float_as_uint(x), __float_as_uint(x), false, false); return fmaxf(__uint_as_float(q[0]), __uint_as_float(q[1])); }
__device__ __forceinline__ float colsum(float x) {
    const auto r = __builtin_amdgcn_permlane16_swap(__float_as_uint(x), __float_as_uint(x), false, false); x = __uint_as_float(r[0]) + __uint_as_float(r[1]);
    const auto q = __builtin_amdgcn_permlane32_swap(__float_as_uint(x), __float_as_uint(x), false, false); return __uint_as_float(q[0]) + __uint_as_float(q[1]); }
template <int CTRL> __device__ __forceinline__ unsigned dppmov_u(unsigned v) { return (unsigned)__builtin_amdgcn_update_dpp(0, (int)v, CTRL, 0xF, 0xF, true); }
__device__ __forceinline__ unsigned wave_max_u32(unsigned v) {
    v = max(v, dppmov_u<0xB1>(v)); v = max(v, dppmov_u<0x4E>(v)); v = max(v, dppmov_u<0x124>(v)); v = max(v, dppmov_u<0x128>(v));
    const auto r = __builtin_amdgcn_permlane16_swap(v, v, false, false); v = max((unsigned)r[0], (unsigned)r[1]);
    const auto q = __builtin_amdgcn_permlane32_swap(v, v, false, false); return max((unsigned)q[0], (unsigned)q[1]); }
struct AttnState { float m, l; f32x4 o[4]; };
__device__ __forceinline__ void attn_init(AttnState& st) { st.m = -1e30f; st.l = 0.f;
#pragma unroll
    for (int d = 0; d < 4; ++d) st.o[d] = (f32x4){0.f, 0.f, 0.f, 0.f}; }
struct KVChunk { bf16x8 k[4]; bf16x8 v[4]; };
__device__ __forceinline__ void kv_load(KVChunk& B, const bf16_t* kptr, const bf16_t* vptr) {
#pragma unroll
    for (int tl = 0; tl < 2; ++tl) { B.k[tl * 2] = ld8(kptr + tl * 1024); B.k[tl * 2 + 1] = ld8(kptr + tl * 1024 + 32); }
#pragma unroll
    for (int d = 0; d < 4; ++d) B.v[d] = ld8(vptr + d * 512);
}
struct KRange { int klo, span; };
__device__ __forceinline__ KRange krange(int klo, int khi) { KRange r; if (khi < klo) { r.klo = 64; r.span = 0; } else { r.klo = klo; r.span = khi - klo; } return r; }
template <bool MASKED>
__device__ __forceinline__ void attn_chunk_r(AttnState& st, const bf16x8 (&kf)[4], const bf16x8 (&vf)[4], const bf16x8 q0, const bf16x8 q1, KRange kr) {
    f32x4 s[2];
#pragma unroll
    for (int tl = 0; tl < 2; ++tl) { s[tl] = mfma16(kf[tl * 2], q0, (f32x4){0.f, 0.f, 0.f, 0.f}); s[tl] = mfma16(kf[tl * 2 + 1], q1, s[tl]); }
    float mx = -1e30f;
#pragma unroll
    for (int tl = 0; tl < 2; ++tl)
#pragma unroll
        for (int i = 0; i < 4; ++i) { if (MASKED) { const bool v = (unsigned)(tl * 16 + i - kr.klo) <= (unsigned)kr.span; s[tl][i] = v ? s[tl][i] : -1e30f; } mx = fmaxf(mx, s[tl][i]); }
    mx = colmax(mx);
    if (__any(mx > st.m)) {
        const float mnew = fmaxf(st.m, mx), alpha = __builtin_amdgcn_exp2f(st.m - mnew);
        st.l *= alpha; st.m = mnew;
#pragma unroll
        for (int d = 0; d < 4; ++d) st.o[d] = st.o[d] * alpha;
    }
    const float mcur = st.m;
    f32x4 p[2]; float ps = 0.f;
#pragma unroll
    for (int tl = 0; tl < 2; ++tl)
#pragma unroll
        for (int i = 0; i < 4; ++i) { const float e = __builtin_amdgcn_exp2f(s[tl][i] - mcur); p[tl][i] = e; ps += e; }
    st.l += ps;
    const bf16x8 pb = pack8(p[0], p[1]);
#pragma unroll
    for (int d = 0; d < 4; ++d) st.o[d] = mfma16(vf[d], pb, st.o[d]);
}

#define ATT_STEPN(C, idx) do { _Pragma("unroll") for (int gg = 0; gg < NG; ++gg) { if (act(gg, idx)) { \
        if (ff(gg, idx)) attn_chunk_r<false>(gs[gg], C.k, C.v, gq[gg][0], gq[gg][1], KRange{0, 0}); else attn_chunk_r<true>(gs[gg], C.k, C.v, gq[gg][0], gq[gg][1], mf(gg, idx)); } \
        __builtin_amdgcn_sched_barrier(0); } } while (0)
template <int NG, class AddrK, class AddrV, class ActF, class FullF, class MaskF>
__device__ __forceinline__ void attn_chunksN(AttnState (&gs)[NG], const bf16x8 (&gq)[NG][2], int n, AddrK ak, AddrV av, ActF act, FullF ff, MaskF mf) {
    if constexpr (NG <= 2) {
        KVChunk C0, C1;
        if (n > 0) kv_load(C0, ak(0), av(0));
#pragma unroll 1
        for (int i = 0; i < n; i += 2) {
            if (i + 1 < n) kv_load(C1, ak(i + 1), av(i + 1));
            ATT_STEPN(C0, i);
            if (i + 1 < n) {
                if (i + 2 < n) kv_load(C0, ak(i + 2), av(i + 2));
                ATT_STEPN(C1, i + 1);
            }
        }
    } else {
#pragma unroll 1
        for (int i = 0; i < n; ++i) { KVChunk C0; kv_load(C0, ak(i), av(i)); ATT_STEPN(C0, i); }
    }
}

__device__ __forceinline__ void nsa_attention(const bf16_t* Q, const bf16_t* KF, const bf16_t* VF, const bf16_t* KC, const bf16_t* VC, const float* gates, bf16_t* OUT, LAS unsigned char* lds, int G, int wave, int lane_) {
    int lane0 = lane_; asm volatile("" : "+v"(lane0));
    LAS float* imp = (LAS float*)(lds + wave * 18432);
    LAS float* tl = imp;
    LAS int* sel = (LAS int*)(lds + wave * 18432 + 16384);
    LAS unsigned* smask32 = (LAS unsigned*)(lds + wave * 18432 + 16384 + 1088);
    LAS unsigned char* blist = (LAS unsigned char*)(lds + wave * 18432 + 16384 + 1088 + 512);
    const bool xcd_map = (G % 8) == 0;
    const int nslots = xcd_map ? (G >> 3) * NWAVES : G * NWAVES, slot = xcd_map ? ((int)blockIdx.x >> 3) * NWAVES + wave : (int)blockIdx.x * NWAVES + wave;
    const int ntask = xcd_map ? 1024 : 8192;
#pragma unroll 1
    for (int task = slot; task < ntask; task += nslots) {
        int lane = lane0; asm volatile("" : "+v"(lane)); lane &= 63;
        const int col = lane & 15, rq = lane >> 4;
        const int tilei = xcd_map ? task : (task >> 3), bg = xcd_map ? ((int)blockIdx.x & 7) : (task & 7), b = bg >> 2, g = bg & 3, t0 = tilei * 16, t = t0 + col;
        const size_t rowq = (size_t)b * S + t;
        const bf16_t* qrow = Q + rowq * D + (g * 4) * 64 + 8 * rq;
        const float* grow = gates + rowq * 48 + g * 12;
        const int cur_max = (t0 + 15) >> 6;
        int n_end = 4 * (cur_max + 1); if (n_end > 1024) n_end = 1024;
        const int nchunk_c = (n_end + 31) >> 5;
        const bf16_t* kc_l = KC + (size_t)bg * 65536 + (size_t)col * 64 + 8 * rq;
        const bf16_t* vc_l = VC + (size_t)bg * 65536 + (size_t)col * 32 + 8 * rq;
        {
        AttnState gs[4]; bf16x8 gq[4][2];
#pragma unroll
        for (int h = 0; h < 4; ++h) { gq[h][0] = ld8(qrow + h * 64); gq[h][1] = ld8(qrow + h * 64 + 32); attn_init(gs[h]); }
        attn_chunksN<4>(gs, gq, nchunk_c,
            [&](int ci) { return kc_l + (size_t)ci * 2048; }, [&](int ci) { return vc_l + (size_t)ci * 2048; },
            [&](int, int) { return true; },
            [&](int, int ci) { return 16 * (ci * 32 + 31) + 31 <= t0; },
            [&](int, int ci) { const int nhi = (t >= 31) ? ((t - 31) >> 4) : -1; return krange(0, nhi - ci * 32 - 4 * rq); });
        {
            float mc[4], lc[4];
#pragma unroll
            for (int h = 0; h < 4; ++h) { const float lt = colsum(gs[h].l); mc[h] = gs[h].m; lc[h] = (gs[h].m > -1e29f && lt > 0.f) ? 1.0f / lt : 0.f; }
            {
                float carry = 0.f;
#pragma unroll 1
                for (int kc = 0; kc < nchunk_c; ++kc) {
#pragma unroll
                    for (int tt = 0; tt < 2; ++tt) {
                        const bf16x8 k0 = ld8(kc_l + (size_t)kc * 2048 + tt * 1024), k1 = ld8(kc_l + (size_t)kc * 2048 + tt * 1024 + 32);
                        float own = 0.f, p3 = 0.f;
#pragma unroll
                        for (int h = 0; h < 4; ++h) {
                            f32x4 sc = mfma16(k0, gq[h][0], (f32x4){0.f, 0.f, 0.f, 0.f}); sc = mfma16(k1, gq[h][1], sc);
#pragma unroll
                            for (int i = 0; i < 4; ++i) { const int n = kc * 32 + tt * 16 + 4 * rq + i; const float p = (16 * n + 31 <= t) ? __builtin_amdgcn_exp2f(sc[i] - mc[h]) * lc[h] : 0.f; own += p; if (i == 3) p3 += p; }
                        }
                        const float up = __shfl(p3, (lane + 48) & 63);
                        const float add = (rq == 0) ? carry : up;
                        imp[col * 256 + kc * 8 + tt * 4 + rq] = own + add;
                        carry = __shfl(p3, col + 48);
                    }
                }
            }
#pragma unroll 1
            for (int c = 0; c < 16; ++c) {
                const int tc = t0 + c, cur = tc >> 6;
                if (cur < 16) { if (lane <= cur) sel[c * 17 + lane] = lane; if (lane == 0) sel[c * 17 + 16] = cur + 1; }
                else {
                    unsigned key[4];
#pragma unroll
                    for (int jx = 0; jx < 4; ++jx) { const int sb = lane + 64 * jx; const float v = imp[c * 256 + sb]; key[jx] = (sb >= 1 && sb <= cur - 2) ? ((__float_as_uint(v) & 0xFFFFFF00u) | (unsigned)(255 - sb)) : 0u; }
                    if (lane == 0) { sel[c * 17 + 0] = 0; sel[c * 17 + 1] = cur - 1; sel[c * 17 + 2] = cur; sel[c * 17 + 16] = 16; }
#pragma unroll 1
                    for (int r = 0; r < 13; ++r) {
                        unsigned best = max(max(key[0], key[1]), max(key[2], key[3]));
                        best = wave_max_u32(best);
                        if (lane == 0) sel[c * 17 + 3 + r] = 255 - (int)(best & 255u);
#pragma unroll
                        for (int jx = 0; jx < 4; ++jx) if (key[jx] == best) key[jx] = 0u;
                    }
                }
            }
#pragma unroll
            for (int h = 0; h < 4; ++h) { const float gc = grow[h * 3 + 0] * lc[h];
#pragma unroll
                for (int d = 0; d < 4; ++d)
#pragma unroll
                    for (int i = 0; i < 4; ++i) tl[(h * 16 + d * 4 + i) * 64 + lane] = gs[h].o[d][i] * gc; }
        }
        }
        {
            smask32[lane] = 0u; smask32[64 + lane] = 0u;
#pragma unroll
            for (int k4 = 0; k4 < 4; ++k4) { const int pp = lane + 64 * k4, c = pp >> 4, e = pp & 15; if (e < sel[c * 17 + 16]) { const int jb = sel[c * 17 + e]; atomicOr((unsigned*)(smask32 + (jb >> 1)), 1u << (c + 16 * (jb & 1))); } }
            const bf16_t* ks_b = KF + (size_t)1 * KF_STRIDE + (size_t)bg * S * 64 + (size_t)col * 64 + 8 * rq;
            const bf16_t* vs_b = VF + (size_t)bg * S * 64 + (size_t)col * 32 + 8 * rq;
            const int tokl = col >> 2, hd = col & 3;
            {
                int nblk = 0;
                LAS unsigned* bl32 = (LAS unsigned*)sel;
                unsigned mk4[4];
#pragma unroll
                for (int k4 = 0; k4 < 4; ++k4) { const int jb = lane + 64 * k4; mk4[k4] = (smask32[jb >> 1] >> (16 * (jb & 1))) & 0xFFFFu; }
#pragma unroll
                for (int k4 = 0; k4 < 4; ++k4) { const int jb = lane + 64 * k4; const unsigned mk = mk4[k4];
                    const unsigned long long bal = __ballot(mk != 0u); const int pos = nblk + __popcll(bal & ((1ull << lane) - 1ull)); if (mk != 0u) bl32[pos] = (unsigned)jb | (mk << 8); nblk += __popcll(bal); }
                AttnState hs[4]; bf16x8 hq[4][2];
#pragma unroll
                for (int cg = 0; cg < 4; ++cg) { const bf16_t* qp = Q + ((size_t)b * S + t0 + 4 * cg + tokl) * D + (g * 4 + hd) * 64 + 8 * rq; hq[cg][0] = ld8(qp); hq[cg][1] = ld8(qp + 32); attn_init(hs[cg]); }
                auto wrd_of = [&](int ci) { return (unsigned)__builtin_amdgcn_readfirstlane((int)bl32[ci >> 1]); };
                const int tb = t0;
                attn_chunksN<4>(hs, hq, nblk * 2,
                    [&](int ci) { return ks_b + (size_t)((int)(wrd_of(ci) & 255u) * 2 + (ci & 1)) * 2048; },
                    [&](int ci) { return vs_b + (size_t)((int)(wrd_of(ci) & 255u) * 2 + (ci & 1)) * 2048; },
                    [&](int cg, int ci) { return ((wrd_of(ci) >> (8 + 4 * cg)) & 15u) != 0u; },
                    [&](int cg, int ci) { const unsigned wd = wrd_of(ci); const int jb = (int)(wd & 255u); return ((wd >> (8 + 4 * cg)) & 15u) == 15u && jb * 64 + (ci & 1) * 32 + 31 <= tb + 4 * cg; },
                    [&](int cg, int ci) { const unsigned wd = wrd_of(ci); const int jb = (int)(wd & 255u); const unsigned mk = wd >> 8; const int tok = 4 * cg + tokl; const int kp0 = jb * 64 + (ci & 1) * 32 + 4 * rq;
                        return krange(0, ((mk >> tok) & 1u) ? (tb + tok - kp0) : -1); });
#pragma unroll
                for (int cg = 0; cg < 4; ++cg) { const int tok = 4 * cg + tokl;
                    const float lt = colsum(hs[cg].l); const float inv = (hs[cg].m > -1e29f && lt > 0.f) ? 1.0f / lt : 0.f;
                    const float gsv = gates[((size_t)b * S + t0 + tok) * 48 + g * 12 + hd * 3 + 1] * inv;
#pragma unroll
                    for (int d = 0; d < 4; ++d)
#pragma unroll
                        for (int i = 0; i < 4; ++i) tl[(hd * 16 + d * 4 + i) * 64 + tok + 16 * rq] += hs[cg].o[d][i] * gsv; }
            }
        }
        {
            int lo = t0 - 511; if (lo < 0) lo = 0; const int c0 = lo >> 5, c1 = (t0 + 15) >> 5;
            const bf16_t* kw_b = KF + (size_t)2 * KF_STRIDE + (size_t)bg * S * 64 + (size_t)col * 64 + 8 * rq;
            const bf16_t* vw_b = VF + (size_t)1 * KF_STRIDE + (size_t)bg * S * 64 + (size_t)col * 32 + 8 * rq;
            {
                AttnState gs[4]; bf16x8 gq[4][2];
#pragma unroll
                for (int h = 0; h < 4; ++h) { gq[h][0] = ld8(qrow + h * 64); gq[h][1] = ld8(qrow + h * 64 + 32); attn_init(gs[h]); }
                attn_chunksN<4>(gs, gq, c1 - c0 + 1,
                    [&](int ci) { return kw_b + (size_t)(c0 + ci) * 2048; }, [&](int ci) { return vw_b + (size_t)(c0 + ci) * 2048; },
                    [&](int, int) { return true; },
                    [&](int, int ci) { return (c0 + ci) * 32 + 31 <= t0 && (c0 + ci) * 32 + 512 > t0 + 15; },
                    [&](int, int ci) { const int cb = (c0 + ci) * 32 + 4 * rq; return krange(t - 511 - cb, t - cb); });
#pragma unroll
                for (int h = 0; h < 4; ++h) { const float lt = colsum(gs[h].l); const float inv = (gs[h].m > -1e29f && lt > 0.f) ? 1.0f / lt : 0.f; const float gwv = grow[h * 3 + 2] * inv;
#pragma unroll
                    for (int d = 0; d < 4; ++d)
#pragma unroll
                        for (int i = 0; i < 4; ++i) tl[(h * 16 + d * 4 + i) * 64 + lane] += gs[h].o[d][i] * gwv; }
            }
        }
#pragma unroll
        for (int h = 0; h < 4; ++h)
#pragma unroll
            for (int d = 0; d < 4; ++d) { float v4[4];
#pragma unroll
                for (int i = 0; i < 4; ++i) v4[i] = tl[(h * 16 + d * 4 + i) * 64 + lane];
                u32x2 w; w.x = cvt_pk_bf16(v4[0], v4[1]); w.y = cvt_pk_bf16(v4[2], v4[3]);
                *(u32x2*)(OUT + rowq * D + (g * 4 + h) * 64 + d * 16 + 4 * rq) = w; }
    }
}

#define XB_TMO      128
#define XB_XCNT(j)  (256  + 64 * (j))
#define XB_XSUB(j)  (1280 + 64 * (j))
#define XB_XGEN(j)  (2304 + 64 * (j))
#define XB_TOP      3328
#define XB_TOPGEN   3392
#define XCD_BAR_WORDS 3456
#define XB_SPIN_CAP (1u << 22)
__device__ __forceinline__ unsigned xb_ld(unsigned* p)              { return __hip_atomic_load(p, __ATOMIC_RELAXED, __HIP_MEMORY_SCOPE_AGENT); }
__device__ __forceinline__ unsigned xb_add(unsigned* p, unsigned v) { return __hip_atomic_fetch_add(p, v, __ATOMIC_RELAXED, __HIP_MEMORY_SCOPE_AGENT); }
__device__ __forceinline__ unsigned xb_xcc_id() { return (unsigned)__builtin_amdgcn_s_getreg((3 << 11) | 20) & 0xFu; }
#define XB_SPIN(cond, bar) do { unsigned _sp = 0; while (cond) { __builtin_amdgcn_s_sleep(1); \
    if ((++_sp & 255u) == 0u) { if (xb_ld(&(bar)[XB_TMO])) break; if (_sp > XB_SPIN_CAP) { atomicAdd(&(bar)[XB_TMO], 1u); break; } } } } while (0)
struct XcdBarrier { unsigned* bar; unsigned x; volatile LAS unsigned* st; };
__device__ __forceinline__ void xcd_barrier_complete(unsigned* bar, unsigned x, unsigned& nloc, unsigned& nx) {
    const unsigned Gn = gridDim.x * gridDim.y * gridDim.z;
    unsigned sum, cnt, mine, sp = 0u;
    for (;;) {
        sum = 0u; cnt = 0u; mine = 0u;
#pragma unroll
        for (unsigned j = 0; j < 16; ++j) { const unsigned c = xb_ld(&bar[XB_XCNT(j)]); sum += c; cnt += (c > 0u) ? 1u : 0u; mine = (j == x) ? c : mine; }
        if (sum == Gn) break;
        __builtin_amdgcn_s_sleep(1);
        if ((++sp & 255u) == 0u) { if (xb_ld(&bar[XB_TMO])) break; if (sp > XB_SPIN_CAP) { atomicAdd(&bar[XB_TMO], 1u); break; } }
    }
    nloc = mine > 0u ? mine : 1u; nx = cnt > 0u ? cnt : 1u;
}
__device__ __forceinline__ void xcd_barrier(const XcdBarrier& b, bool leader) {
    asm volatile("s_waitcnt vmcnt(0)" ::: "memory");
    __syncthreads();
    if (leader) {
        unsigned* bar = b.bar;
        __builtin_amdgcn_s_waitcnt(0);
        unsigned nloc = b.st[0], nx = b.st[1];
        if (nloc == 0u) { xcd_barrier_complete(bar, b.x, nloc, nx); b.st[0] = nloc; b.st[1] = nx; }
        const unsigned old = xb_add(&bar[XB_XSUB(b.x)], 1u);
        const unsigned gen = old / nloc;
        if (old + 1u == (gen + 1u) * nloc) {
            __builtin_amdgcn_fence(__ATOMIC_RELEASE, "agent");
            asm volatile("s_waitcnt vmcnt(0)" ::: "memory");
            const unsigned og = xb_add(&bar[XB_TOP], 1u);
            const unsigned tg = og / nx;
            if (og + 1u == (tg + 1u) * nx) xb_add(&bar[XB_TOPGEN], 1u);
            else XB_SPIN(xb_ld(&bar[XB_TOPGEN]) == tg, bar);
            __builtin_amdgcn_fence(__ATOMIC_ACQUIRE, "agent");
            xb_add(&bar[XB_XGEN(b.x)], 1u);
            asm volatile("s_waitcnt vmcnt(0)" ::: "memory");
        } else {
            XB_SPIN(xb_ld(&bar[XB_XGEN(b.x)]) == gen, bar);
            __builtin_amdgcn_fence(__ATOMIC_ACQUIRE, "agent");
            asm volatile("s_waitcnt vmcnt(0)" ::: "memory");
        }
    }
    __syncthreads();
}
#define GSYNC() xcd_barrier(xbar, wave == 0 && lane_id() == 0)

__global__ void __launch_bounds__(NTHREADS, 2) fwd_kernel(Params P) {
    extern __shared__ __attribute__((aligned(16))) unsigned char lds_raw[];
    LAS unsigned char* lds = (LAS unsigned char*)lds_raw;
    cg::grid_group grid = cg::this_grid();
    int tidv = threadIdx.x;
    const int wave = __builtin_amdgcn_readfirstlane(tidv >> 6);
    const int G = gridDim.x, gw_k = blockIdx.x * NWAVES + wave, NGW = G * NWAVES;
    unsigned char* ws = P.ws;
    float* xres = P.out;
    LAS float* scr = (LAS float*)(lds + wave * 16384);
    const float* x_in = P.in[0];
    const float* norm_mix = P.in[1]; const float* norm_mlp = P.in[2]; const float* norm_final = P.in[3];
    const float* mlp_w1 = P.in[4]; const float* mlp_w2 = P.in[5];

    XcdBarrier xbar; xbar.bar = (unsigned*)(ws + WS_BAR); xbar.x = xb_xcc_id(); xbar.st = (volatile LAS unsigned*)(lds + 147456);
    if (tidv < 2) xbar.st[tidv] = 0u;
    if (tidv == 0) (void)xb_add(&xbar.bar[XB_XCNT(xbar.x)], 1u);
    __syncthreads();
    grid.sync();
    for (int layer = 0; layer < 4; ++layer) {
        int lane = tidv; asm volatile("" : "+v"(lane)); lane &= 63;
        int gw = gw_k; asm volatile("" : "+s"(gw));
        const bool is_rwkv = (layer & 1) != 0; const int lj = layer >> 1;
        const float* xsrc = (layer == 0) ? x_in : xres;
        {
            TJob j1{mlp_w1 + (size_t)layer * D * FF, FF, 0, FF, D, (bf16_t*)(ws + WS_W + W_MLP1), D, 0, 0, FF, D, nullptr, 0};
            transpose_job(j1, scr, gw, NGW, lane);
            TJob j2{mlp_w2 + (size_t)layer * FF * D, D, 0, D, FF, (bf16_t*)(ws + WS_W + W_MLP2), FF, 0, 0, D, FF, nullptr, 0};
            transpose_job(j2, scr, gw, NGW, lane);
            if (is_rwkv) {
                const float* mix = P.in[14] + (size_t)lj * 6 * D;
                bf16_t* WrT = (bf16_t*)(ws + WS_W + W_RW_IN);
                const float* wrkv = P.in[15] + (size_t)lj * 3 * D * D;
                for (int part = 0; part < 8; ++part) {
                    const float* W; int ldw, Nsrc, mi, r0, Npad;
                    if (part == 0) { W = wrkv; ldw = D; Nsrc = D; mi = 0; r0 = 0; Npad = D; }
                    else if (part == 1) { W = wrkv + (size_t)D * D; ldw = D; Nsrc = D; mi = 2; r0 = 1024; Npad = D; }
                    else if (part == 2) { W = wrkv + (size_t)2 * D * D; ldw = D; Nsrc = D; mi = 3; r0 = 2048; Npad = D; }
                    else if (part == 3) { W = P.in[17] + (size_t)lj * D * 64; ldw = 64; Nsrc = 64; mi = 1; r0 = 3072; Npad = 128; }
                    else if (part == 4) { W = P.in[20] + (size_t)lj * D * 64; ldw = 64; Nsrc = 64; mi = 4; r0 = 3200; Npad = 128; }
                    else if (part == 5) { W = P.in[22] + (size_t)lj * D * 160; ldw = 160; Nsrc = 160; mi = 5; r0 = 3328; Npad = 256; }
                    else if (part == 6) { W = P.in[31]; ldw = 32; Nsrc = (lj >= 1) ? 32 : 0; mi = 3; r0 = 3584; Npad = 128; }
                    else { W = P.in[31]; ldw = 32; Nsrc = 0; mi = 3; r0 = 3712; Npad = 128; }
                    TJob ja{W, ldw, 0, Nsrc, D, WrT, 2048, r0, 0, Npad, D, mix + mi * D, 1};
                    transpose_job(ja, scr, gw, NGW, lane);
                    TJob jb{W, ldw, 0, Nsrc, D, WrT, 2048, r0, 1024, Npad, D, mix + mi * D, 2};
                    transpose_job(jb, scr, gw, NGW, lane);
                }
                TJob jw{P.in[18] + (size_t)lj * 64 * D, D, 0, D, 64, (bf16_t*)(ws + WS_W + W_RW_W2), 128, 0, 0, D, 128, nullptr, 0}; transpose_job(jw, scr, gw, NGW, lane);
                TJob jaa{P.in[21] + (size_t)lj * 64 * D, D, 0, D, 64, (bf16_t*)(ws + WS_W + W_RW_A2), 128, 0, 0, D, 128, nullptr, 0}; transpose_job(jaa, scr, gw, NGW, lane);
                TJob jv{P.in[32], D, 0, D, (lj >= 1) ? 32 : 0, (bf16_t*)(ws + WS_W + W_RW_V2), 128, 0, 0, D, 128, nullptr, 0}; transpose_job(jv, scr, gw, NGW, lane);
                TJob jg{P.in[23] + (size_t)lj * 160 * D, D, 0, D, 160, (bf16_t*)(ws + WS_W + W_RW_G2), 256, 0, 0, D, 256, nullptr, 0}; transpose_job(jg, scr, gw, NGW, lane);
                TJob jo{P.in[29] + (size_t)lj * D * D, D, 0, D, D, (bf16_t*)(ws + WS_W + W_RW_O), D, 0, 0, D, D, nullptr, 0}; transpose_job(jo, scr, gw, NGW, lane);
                bf16_t* HN = (bf16_t*)(ws + A_HN);
                if (gw < 2) { u32x4* z = (u32x4*)(HN + (size_t)gw * (S + 1) * D); unsigned zz; asm volatile("v_mov_b32 %0, 0" : "=v"(zz)); for (int q = lane; q < D / 8; q += 64) z[q] = (u32x4){zz, zz, zz, zz}; }
                for (int m = gw; m < M; m += NGW) { const int b = m / S; rms_row_bf16(xsrc + (size_t)m * D, norm_mix + layer * D, HN + ((size_t)m + b + 1) * D, nullptr, lane); }
            } else {
                const float* win = P.in[6] + (size_t)lj * D * 2608;
                bf16_t* WnT = (bf16_t*)(ws + WS_W + W_NSA_IN); bf16_t* WvT = (bf16_t*)(ws + WS_W + W_NSA_V);
                for (int part = 0; part < 8; ++part) {
                    int n0src, Nsrc, r0, Npad; bf16_t* WT = WnT;
                    if (part == 0) { n0src = 0; Nsrc = 1024; r0 = 0; Npad = 1024; }
                    else if (part == 1) { n0src = 1024; Nsrc = 256; r0 = 1024; Npad = 256; }
                    else if (part == 2) { n0src = 1024 + 512; Nsrc = 256; r0 = 1280; Npad = 256; }
                    else if (part == 3) { n0src = 1024 + 1024; Nsrc = 256; r0 = 1536; Npad = 256; }
                    else if (part == 4) { n0src = 1024 + 256; Nsrc = 256; r0 = 1792; Npad = 256; }
                    else if (part == 5) { n0src = 2560; Nsrc = 48; r0 = 2048; Npad = 256; }
                    else if (part == 6) { n0src = 1024 + 768; Nsrc = 256; r0 = 0; Npad = 256; WT = WvT; }
                    else { n0src = 1024 + 1280; Nsrc = 256; r0 = 256; Npad = 256; WT = WvT; }
                    TJob jn{win, 2608, n0src, Nsrc, D, WT, D, r0, 0, Npad, D, nullptr, 0}; transpose_job(jn, scr, gw, NGW, lane);
                }
                TJob jo{P.in[13] + (size_t)lj * D * D, D, 0, D, D, (bf16_t*)(ws + WS_W + W_NSA_O), D, 0, 0, D, D, nullptr, 0}; transpose_job(jo, scr, gw, NGW, lane);
                TJob jc1k{P.in[8] + (size_t)lj * 2048 * 256, 256, 0, 256, 2048, (bf16_t*)(ws + WS_W + W_C1K), 2048, 0, 0, 256, 2048, nullptr, 0}; transpose_job(jc1k, scr, gw, NGW, lane);
                TJob jc1v{P.in[11] + (size_t)lj * 2048 * 256, 256, 0, 256, 2048, (bf16_t*)(ws + WS_W + W_C1V), 2048, 0, 0, 256, 2048, nullptr, 0}; transpose_job(jc1v, scr, gw, NGW, lane);
                TJob jc2k{P.in[9] + (size_t)lj * 256 * 64, 64, 0, 64, 256, (bf16_t*)(ws + WS_W + W_C2K), 256, 0, 0, 256, 256, nullptr, 0}; transpose_job(jc2k, scr, gw, NGW, lane);
                TJob jc2v{P.in[12] + (size_t)lj * 256 * 64, 64, 0, 64, 256, (bf16_t*)(ws + WS_W + W_C2V), 256, 0, 0, 256, 256, nullptr, 0}; transpose_job(jc2v, scr, gw, NGW, lane);
                {
                    int ln = lane; asm volatile("" : "+v"(ln));
                    float* cb = (float*)(ws + WS_W + W_CBIAS);
#pragma unroll 1
                    for (int o = gw; o < 512; o += NGW) { const int isv = o >> 8, c = o & 255;
                        const float* pe = (isv ? P.in[10] : P.in[7]) + (size_t)lj * 2048; const float* w1 = (isv ? P.in[11] : P.in[8]) + (size_t)lj * 2048 * 256;
                        float acc = 0.f;
#pragma unroll 1
                        for (int k = ln; k < 2048; k += 64) acc += pe[k] * w1[(size_t)k * 256 + c];
                        acc = wave_sum(acc); if (ln == 0) cb[o] = acc; }
                    if (layer == 0) {
                        float* rt = (float*)(ws + WS_ROPE);
                        int tix = tidv; asm volatile("" : "+v"(tix)); const int gt = (int)blockIdx.x * NTHREADS + tix;
#pragma unroll 1
                        for (int e = gt; e < S * 8; e += G * NTHREADS) { const int tt = e >> 3, i = e & 7;
                            const float invf = (i == 0) ? 1.0f : (i == 1) ? 0.1939227432012558f : (i == 2) ? 0.03760603070259094f : (i == 3) ? 0.007292664609849453f : (i == 4) ? 0.0014142135623842478f : (i == 5) ? 0.00027424818836152554f : (i == 6) ? 5.318296098266728e-05f : 1.0313386155758053e-05f;
                            const float ang = (float)tt * invf; const double rev = (double)ang * 0.15915494309189535; const float fr = (float)(rev - __builtin_rint(rev));
                            rt[tt * 16 + i] = __builtin_amdgcn_cosf(fr); rt[tt * 16 + 8 + i] = __builtin_amdgcn_sinf(fr); }
                    }
                }
                for (int m = gw; m < M; m += NGW) rms_row_bf16(xsrc + (size_t)m * D, norm_mix + layer * D, (bf16_t*)(ws + A_HN) + (size_t)m * D, (layer == 0) ? xres + (size_t)m * D : nullptr, lane);
            }
        }
        GSYNC();
        if (!is_rwkv) {
            bf16_t* HN = (bf16_t*)(ws + A_HN); bf16_t* Qb = (bf16_t*)(ws + A_Q); bf16_t* KFb = (bf16_t*)(ws + A_KF); bf16_t* VFb = (bf16_t*)(ws + A_VF);
            float* GT = (float*)(ws + A_GATES); bf16_t* CHK = (bf16_t*)(ws + A_CHK); bf16_t* CHV = (bf16_t*)(ws + A_CHV); bf16_t* KCb = (bf16_t*)(ws + A_KC); bf16_t* VCb = (bf16_t*)(ws + A_VC);
            {
                pg8::Gemm g{HN, (const bf16_t*)(ws + WS_W + W_NSA_IN), M, 2304, D, D, D, 0};
                pg8::StaticOrder so; so.init(M, 2304, G, (int)blockIdx.x);
                pg8::EpiP<FNsaIn> E{FNsaIn{Qb, KFb, GT, (const float*)(ws + WS_ROPE)}};
                pg8::gemm_phase<pg8::EpiP<FNsaIn>, true>(lds, g, so, E, tidv);
                pg8::Gemm g2{(const bf16_t*)(ws + WS_W + W_NSA_V), HN, 512, M, D, D, D, 0};
                pg8::StaticOrder so2; so2.init(512, M, G, (int)blockIdx.x);
                pg8::EpiP<FNsaVT> E2{FNsaVT{VFb}};
                pg8::gemm_phase<pg8::EpiP<FNsaVT>, true>(lds, g2, so2, E2, tidv);
            }
            GSYNC();
            {
                pg8::StaticOrder so; so.init(8192, 256, G, (int)blockIdx.x);
                pg8::StaticOrder sov; sov.init(8192, 256, G, (int)((blockIdx.x + G - G / 2) % G));
                { pg8::Gemm g{KFb, (const bf16_t*)(ws + WS_W + W_C1K), 8192, 256, 2048, 1024, 2048, 0}; pg8::EpiP<FCmp1> E{FCmp1{CHK, (const float*)(ws + WS_W + W_CBIAS)}}; pg8::gemm_phase<pg8::EpiP<FCmp1>, true>(lds, g, so, E, tidv); }
                { pg8::Gemm g{KFb + 3 * KF_STRIDE, (const bf16_t*)(ws + WS_W + W_C1V), 8192, 256, 2048, 1024, 2048, 0}; pg8::EpiP<FCmp1> E{FCmp1{CHV, (const float*)(ws + WS_W + W_CBIAS) + 256}}; pg8::gemm_phase<pg8::EpiP<FCmp1>, true>(lds, g, sov, E, tidv); }
            }
            GSYNC();
            {
                { pg8::StaticOrder so; so.init(8192, 256, G, (int)blockIdx.x); pg8::Gemm g{CHK, (const bf16_t*)(ws + WS_W + W_C2K), 8192, 256, 256, 256, 256, 0}; pg8::EpiP<FCmp2K> E{FCmp2K{KCb}}; pg8::gemm_phase<pg8::EpiP<FCmp2K>, true>(lds, g, so, E, tidv); }
                { pg8::StaticOrder so; so.init(256, 8192, G, (int)((blockIdx.x + G - G / 2) % G)); pg8::Gemm g{(const bf16_t*)(ws + WS_W + W_C2V), CHV, 256, 8192, 256, 256, 256, 0}; pg8::EpiP<FCmp2VT> E{FCmp2VT{VCb}}; pg8::gemm_phase<pg8::EpiP<FCmp2VT>, true>(lds, g, so, E, tidv); }
            }
            GSYNC();
            nsa_attention(Qb, KFb, VFb, KCb, VCb, GT, HN, lds, G, wave, lane_id());
            tidv = wave * 64 + (lane_id() & 63); asm volatile("" : "+v"(tidv)); tidv &= 511; lane = tidv & 63;
            GSYNC();
            {
                pg8::StaticOrder so; so.init(M, D, G, (int)blockIdx.x);
                pg8::Gemm g{HN, (const bf16_t*)(ws + WS_W + W_NSA_O), M, D, D, D, D, 0}; pg8::EpiN<FResAdd> E{FResAdd{xres}}; pg8::gemm_phase<pg8::EpiN<FResAdd>, true>(lds, g, so, E, tidv);
            }
            GSYNC();
        }
        if (is_rwkv) {
            h16* Rb = (h16*)(ws + A_R); h16* Kb = (h16*)(ws + A_K); h16* Ab = (h16*)(ws + A_A); h16* EWb = (h16*)(ws + A_HN);
            h16* Vb = (lj == 0) ? (h16*)(ws + WS_VF) : (h16*)(ws + A_V2);
            h16* Yraw = (lj == 0) ? (h16*)(ws + A_V2) : (h16*)(ws + WS_VF);
            bf16_t* LH = (bf16_t*)(ws + A_LH);
            {
                pg8::Gemm g{(const bf16_t*)(ws + A_HN), (const bf16_t*)(ws + WS_W + W_RW_IN), M, 3840, 2048, D, 2048, 1};
                pg8::StaticOrder so; so.init(M, 3840, G, (int)blockIdx.x);
                pg8::EpiP<FRwIn> E{FRwIn{Rb, Kb, Vb, LH}};
                pg8::gemm_phase<pg8::EpiP<FRwIn>, true>(lds, g, so, E, tidv);
            }
            GSYNC();
            {
                pg8::StaticOrder so; so.init(M, D, G, (int)blockIdx.x);
                { pg8::Gemm g{LH, (const bf16_t*)(ws + WS_W + W_RW_W2), M, D, 128, 768, 128, 0}; pg8::EpiP<FLoraW> E{FLoraW{EWb, P.in[16] + lj * D}}; pg8::gemm_phase<pg8::EpiP<FLoraW>, true>(lds, g, so, E, tidv); }
                { pg8::Gemm g{LH + 128, (const bf16_t*)(ws + WS_W + W_RW_A2), M, D, 128, 768, 128, 0}; pg8::EpiP<FLoraA> E{FLoraA{Ab, P.in[19] + lj * D}}; pg8::gemm_phase<pg8::EpiP<FLoraA>, true>(lds, g, so, E, tidv); }
                if (lj >= 1) { pg8::Gemm g{LH + 512, (const bf16_t*)(ws + WS_W + W_RW_V2), M, D, 128, 768, 128, 0}; pg8::EpiP<FLoraV> E{FLoraV{Vb, (const h16*)(ws + WS_VF), P.in[30]}}; pg8::gemm_phase<pg8::EpiP<FLoraV>, true>(lds, g, so, E, tidv); }
            }
            GSYNC();
            rwkv_scan2(Rb, Kb, Vb, EWb, Ab, P.in[24] + lj * D, P.in[25] + lj * D, Yraw, lds, wave, lane);
            GSYNC();
            rwkv_gn(Rb, Kb, Vb, Ab, Yraw, P.in[25] + lj * D, P.in[26] + lj * D, P.in[27] + lj * D, P.in[28] + lj * D, gw, NGW, lane);
            GSYNC();
            {
                pg8::StaticOrder so; so.init(M, D, G, (int)blockIdx.x);
                pg8::Gemm g{LH + 256, (const bf16_t*)(ws + WS_W + W_RW_G2), M, D, 256, 768, 256, 0}; pg8::EpiP<FGate> E{FGate{(bf16_t*)Kb, Rb}}; pg8::gemm_phase<pg8::EpiP<FGate>, true>(lds, g, so, E, tidv);
            }
            GSYNC();
            {
                pg8::StaticOrder so; so.init(M, D, G, (int)blockIdx.x);
                pg8::Gemm g{(const bf16_t*)Kb, (const bf16_t*)(ws + WS_W + W_RW_O), M, D, D, D, D, 0}; pg8::EpiN<FResAdd> E{FResAdd{xres}}; pg8::gemm_phase<pg8::EpiN<FResAdd>, true>(lds, g, so, E, tidv);
            }
            GSYNC();
        }
        for (int m = gw; m < M; m += NGW) rms_row_bf16(xres + (size_t)m * D, norm_mlp + layer * D, (bf16_t*)(ws + A_HN) + (size_t)m * D, nullptr, lane);
        GSYNC();
        {
            pg8::Gemm g{(const bf16_t*)(ws + A_HN), (const bf16_t*)(ws + WS_W + W_MLP1), M, FF, D, D, D, 0};
            pg8::StaticOrder so; so.init(M, FF, G, (int)blockIdx.x);
            pg8::EpiP<FRelu2> E{FRelu2{(bf16_t*)(ws + A_HID)}};
            pg8::gemm_phase<pg8::EpiP<FRelu2>, true>(lds, g, so, E, tidv);
        }
        GSYNC();
        {
            pg8::Gemm g{(const bf16_t*)(ws + A_HID), (const bf16_t*)(ws + WS_W + W_MLP2), M, D, FF, FF, FF, 0};
            pg8::StaticOrder so; so.init(M, D, G, (int)blockIdx.x);
            pg8::EpiN<FResAdd> E{FResAdd{xres}};
            pg8::gemm_phase<pg8::EpiN<FResAdd>, true>(lds, g, so, E, tidv);
        }
        GSYNC();
    }
    for (int m = gw_k; m < M; m += NGW) {
        int lane2 = tidv; asm volatile("" : "+v"(lane2)); lane2 &= 63;
        f32x4* xr = (f32x4*)(xres + (size_t)m * D) + lane2; const f32x4* gr = (const f32x4*)norm_final + lane2;
        f32x4 v[4]; float s = 0.f;
#pragma unroll
        for (int j = 0; j < 4; ++j) { v[j] = xr[64 * j]; s += (v[j].x * v[j].x + v[j].y * v[j].y) + (v[j].z * v[j].z + v[j].w * v[j].w); }
        const float r = rsqrtf(wave_sum(s) * (1.f / D) + 1e-5f);
#pragma unroll
        for (int j = 0; j < 4; ++j) { const f32x4 gg = gr[64 * j]; xr[64 * j] = v[j] * r * gg; }
    }
}

extern "C" void kernel_launch(void* const* d_in, const int* in_sizes, int n_in, void* d_out, int out_size, void* d_ws, size_t ws_size, hipStream_t stream) {
    static int grid = 0;
    if (grid == 0) {
        if (n_in != 33 || out_size != M * D || ws_size < WS_NEED) { fprintf(stderr, "kernel_launch: unexpected sizes n_in %d out %d ws %zu (need %zu)\n", n_in, out_size, ws_size, (size_t)WS_NEED); grid = -1; return; }
        int dev = 0, cus = 0, per_cu = 0;
        hipGetDevice(&dev);
        hipDeviceGetAttribute(&cus, hipDeviceAttributeMultiprocessorCount, dev);
        if (hipFuncSetAttribute((const void*)fwd_kernel, hipFuncAttributeMaxDynamicSharedMemorySize, LDS_BYTES) != hipSuccess) { fprintf(stderr, "hipFuncSetAttribute failed\n"); grid = -1; return; }
        hipOccupancyMaxActiveBlocksPerMultiprocessor(&per_cu, (const void*)fwd_kernel, NTHREADS, LDS_BYTES);
        if (per_cu < 1) { fprintf(stderr, "occupancy query returned %d\n", per_cu); per_cu = 1; }
        (void)hipGetLastError();
        grid = cus * 1;
    }
    if (grid < 0) return;
    if (hipMemsetAsync((char*)d_ws + WS_BAR, 0, 16384, stream) != hipSuccess) { fprintf(stderr, "hipMemsetAsync of the barrier words failed\n"); return; }
    Params p{};
    for (int i = 0; i < 33; ++i) p.in[i] = (const float*)d_in[i];
    p.out = (float*)d_out; p.ws = (unsigned char*)d_ws;
    void* args[] = {&p};
    hipError_t e = hipLaunchCooperativeKernel((const void*)fwd_kernel, dim3(grid), dim3(NTHREADS), args, LDS_BYTES, stream);
    if (e != hipSuccess) fprintf(stderr, "cooperative launch failed: %s (grid %d)\n", hipGetErrorString(e), grid);
}
```

```cpp
#include <hip/hip_runtime.h>
#include <hip/hip_cooperative_groups.h>
#include <cstdio>
#include <cstdint>
namespace cg = cooperative_groups;

#define LAS __attribute__((address_space(3)))
typedef unsigned short bf16_t;
typedef short bf16x8 __attribute__((ext_vector_type(8)));
typedef float f32x4 __attribute__((ext_vector_type(4)));
typedef float f32x2 __attribute__((ext_vector_type(2)));
typedef unsigned u32x4 __attribute__((ext_vector_type(4)));
typedef unsigned u32x2 __attribute__((ext_vector_type(2)));
typedef _Float16 h16;
typedef _Float16 h16x2 __attribute__((ext_vector_type(2)));

constexpr int S = 16384, NB = 2, M = NB * S, D = 1024, FF = 4096;
constexpr int NWAVES = 8, NTHREADS = 512;
constexpr int LDS_BYTES = 147456 + 64;
constexpr size_t MiB = 1u << 20;
constexpr size_t WS_W = 0;
constexpr size_t W_MLP1 = 0, W_MLP2 = 8 * MiB;
constexpr size_t W_NSA_IN = 16 * MiB, W_NSA_V = 21 * MiB, W_NSA_O = 22 * MiB, W_C1K = 24 * MiB, W_C1V = 25 * MiB, W_C2K = 26 * MiB, W_C2V = 26 * MiB + 256 * 1024, W_CBIAS = 26 * MiB + 512 * 1024;
constexpr size_t W_RW_IN = 16 * MiB, W_RW_W2 = 31 * MiB, W_RW_A2 = 31 * MiB + 256 * 1024, W_RW_V2 = 31 * MiB + 512 * 1024, W_RW_G2 = 31 * MiB + 768 * 1024, W_RW_O = 33 * MiB;
constexpr size_t WS_ROPE = 36 * MiB;
constexpr size_t WS_BAR = 38 * MiB;
constexpr size_t WS_VF = 40 * MiB;
constexpr size_t ACT = 104 * MiB;
constexpr size_t A_HN = ACT;
constexpr size_t A_Q = ACT + 65 * MiB;
constexpr size_t A_KF = ACT + 129 * MiB;
constexpr size_t A_VF = ACT + 194 * MiB;
constexpr size_t A_GATES = ACT + 226 * MiB;
constexpr size_t A_CHK = ACT + 233 * MiB, A_CHV = ACT + 237 * MiB, A_KC = ACT + 241 * MiB, A_VC = ACT + 242 * MiB;
constexpr size_t A_HID = ACT + 65 * MiB;
constexpr size_t A_R = ACT + 65 * MiB, A_K = ACT + 129 * MiB, A_V2 = ACT + 193 * MiB, A_A = ACT + 257 * MiB, A_LH = ACT + 321 * MiB;
constexpr size_t WS_NEED = ACT + 370 * MiB;

__device__ __forceinline__ int lane_id() { return (int)__builtin_amdgcn_mbcnt_hi(~0u, __builtin_amdgcn_mbcnt_lo(~0u, 0u)); }
__device__ __forceinline__ unsigned cvt_pk_bf16(float lo, float hi) { unsigned r; asm volatile("v_cvt_pk_bf16_f32 %0, %1, %2" : "=v"(r) : "v"(lo), "v"(hi)); return r; }
__device__ __forceinline__ unsigned pk_h16(float lo, float hi) { h16x2 v; v.x = (h16)lo; v.y = (h16)hi; return __builtin_bit_cast(unsigned, v); }
__device__ __forceinline__ float bf2f(bf16_t b) { return __uint_as_float(((unsigned)b) << 16); }
__device__ __forceinline__ float wave_sum(float v) {
#pragma unroll
    for (int o = 1; o < 64; o <<= 1) v += __shfl_xor(v, o);
    return v;
}
__device__ __forceinline__ float sigmoidf_(float x) { return 1.0f / (1.0f + __expf(-x)); }
__device__ __forceinline__ float tanhf_(float x) { float e = __expf(-2.0f * fabsf(x)); float t = (1.0f - e) / (1.0f + e); return x < 0.f ? -t : t; }

namespace pg8 {
constexpr int BM = 256, BK = 64, HALF = 128, HTB = HALF * BK * 2, STAGE_BYTES = 8 * HTB, NXCD = 8, WGM = 8;
__host__ __device__ __forceinline__ int lds_byte(int r, int c) { const int st = (r >> 4) * 2 + (c >> 5), rr = r & 15, cc = c & 31, ob = rr * 64 + cc * 2; return st * 1024 + (ob ^ (((ob >> 9) & 1) << 5)); }
__host__ __device__ __forceinline__ void stage_rc(int b, int& R, int& C) { const int st = b / 1024, sb = b % 1024, swz = sb ^ (((sb >> 9) & 1) << 5); R = (st >> 1) * 16 + swz / 64; C = (st & 1) * 32 + (swz % 64) / 2; }
__host__ __device__ __forceinline__ int perm32(int rho) { const int n = rho >> 4, i = rho & 15; return 8 * (i >> 2) + 4 * n + (i & 3); }
struct Unit { int pm, pn; };
struct Gemm { const bf16_t* A; const bf16_t* Bt; int M, N, K, lda, ldb, amode; };
struct StaticOrder {
    int nM, nN, nwg, G, c;
    __device__ void init(int M_, int N_, int G_, int c_) { nM = M_ / BM; nN = N_ / BM; nwg = nM * nN; G = G_; c = c_; }
    __device__ bool next(int i, Unit& u) const {
        const long L = (long)i * G + c; if (L >= nwg) return false;
        int wgid = (int)L; { const int q = nwg / NXCD, r = nwg % NXCD, xcd = wgid % NXCD, off = wgid / NXCD; wgid = (xcd < r ? xcd * (q + 1) : r * (q + 1) + (xcd - r) * q) + off; }
        const int nig = WGM * nN, gid = wgid / nig, fm = gid * WGM, gsz = (nM - fm) < WGM ? (nM - fm) : WGM;
        u.pm = fm + ((wgid % nig) % gsz); u.pn = (wgid % nig) / gsz; return true;
    }
};
__device__ __forceinline__ const char* a_base(const Gemm& g, int pm) { const size_t row = (size_t)pm * BM + (g.amode == 1 ? (size_t)(pm / 64) : 0); return (const char*)g.A + row * (size_t)g.lda * 2; }

template <class Epi, bool ALIGN_EPI>
__device__ __forceinline__ void gemm_phase(LAS unsigned char* lds, const Gemm g, const StaticOrder& S, const Epi& E, int tid_in) {
    int tid = tid_in; asm volatile("" : "+v"(tid));
    const int wid = __builtin_amdgcn_readfirstlane(tid >> 6), lane = tid & 63, wr = wid >> 2, wc = wid & 3, fr = lane & 15, fq = lane >> 4;
    int K = g.K; asm volatile("" : "+s"(K));
    const int nt = K / BK;
    unsigned voffA[2], voffB[2];
#pragma unroll
    for (int i = 0; i < 2; ++i) { int R, C; stage_rc(tid * 16 + i * 8192, R, C); const int Rb = Epi::PERM ? ((R & ~31) + perm32(R & 31)) : R;
        voffA[i] = (unsigned)(R * g.lda + C) * 2u; voffB[i] = (unsigned)(Rb * g.ldb + C) * 2u; }
    const size_t kstep = (size_t)(BK * 2);
    const size_t hstepA = (size_t)HALF * g.lda * 2, hstepB = (size_t)HALF * g.ldb * 2;
    const size_t tstepB = 2 * hstepB;
    const unsigned ldsw = (unsigned)wid * 1024u;
    const int aoff = lds_byte(wr * 64 + fr, fq * 8), boff = lds_byte(wc * 32 + fr, fq * 8);
#define PG8_SA(b, h) (((b) * 2 + (h)) * HTB)
#define PG8_SB(b, h) ((4 + (b) * 2 + (h)) * HTB)
#define PG8_STAGE(bufoff, gbase, voff) do { _Pragma("unroll") for (int _i = 0; _i < 2; ++_i) \
        __builtin_amdgcn_global_load_lds((const unsigned*)((const char*)(gbase) + (voff)[_i]), (LAS unsigned*)(lds + (bufoff) + ldsw + _i * 8192), 16, 0, 0); } while (0)
#define PG8_LDA(dst, b, h) do { _Pragma("unroll") for (int m = 0; m < 4; ++m) _Pragma("unroll") for (int k = 0; k < 2; ++k) dst[m][k] = *(const LAS bf16x8*)(lds + PG8_SA(b, h) + aoff + m * 2048 + k * 1024); } while (0)
#define PG8_LDB(dst, b, h) do { _Pragma("unroll") for (int n = 0; n < 2; ++n) _Pragma("unroll") for (int k = 0; k < 2; ++k) dst[n][k] = *(const LAS bf16x8*)(lds + PG8_SB(b, h) + boff + n * 2048 + k * 1024); } while (0)
#define PG8_MMA(ai, bj, At, Bt) do { __builtin_amdgcn_s_setprio(1); _Pragma("unroll") for (int m = 0; m < 4; ++m) _Pragma("unroll") for (int n = 0; n < 2; ++n) _Pragma("unroll") for (int k = 0; k < 2; ++k) \
        acc[ai][bj][m][n] = __builtin_amdgcn_mfma_f32_16x16x32_bf16(Bt[n][k], At[m][k], acc[ai][bj][m][n], 0, 0, 0); __builtin_amdgcn_s_setprio(0); } while (0)
#define PG8_WAIT_V(n) asm volatile("s_waitcnt vmcnt(" #n ")" ::: "memory")
#define PG8_WAIT_L(n) asm volatile("s_waitcnt lgkmcnt(" #n ")" ::: "memory")
#define PG8_BAR __builtin_amdgcn_s_barrier()
#define PG8_SCHED __builtin_amdgcn_sched_barrier(0)
    Unit cur, nxt; int ui = 0;
    if (!S.next(0, cur)) return;
    f32x4 acc[2][2][4][2];
#pragma unroll
    for (int a = 0; a < 2; ++a)
#pragma unroll
        for (int b = 0; b < 2; ++b)
#pragma unroll
            for (int m = 0; m < 4; ++m)
#pragma unroll
                for (int n = 0; n < 2; ++n) acc[a][b][m][n] = (f32x4){0.f, 0.f, 0.f, 0.f};
    bf16x8 At[4][2], B0[2][2], B1[2][2];
    const char* cA = a_base(g, cur.pm); const char* cB = (const char*)g.Bt + (size_t)cur.pn * tstepB;
    PG8_STAGE(PG8_SB(0, 0), cB, voffB); PG8_STAGE(PG8_SB(0, 1), cB + hstepB, voffB); PG8_STAGE(PG8_SA(0, 0), cA, voffA); PG8_STAGE(PG8_SA(0, 1), cA + hstepA, voffA);
    if (wr == 1) PG8_BAR;
    PG8_WAIT_V(2); PG8_BAR;
    PG8_STAGE(PG8_SB(1, 0), cB + kstep, voffB); PG8_STAGE(PG8_SA(1, 0), cA + kstep, voffA); PG8_STAGE(PG8_SB(1, 1), cB + hstepB + kstep, voffB);
    PG8_WAIT_V(6); PG8_BAR;
    for (;;) {
        const bool has_next = S.next(ui + 1, nxt);
        const char* nA = has_next ? a_base(g, nxt.pm) : cA; const char* nB = has_next ? (const char*)g.Bt + (size_t)nxt.pn * tstepB : cB;
        for (int t = 0; t < nt; t += 2) {
            const bool last = (t == nt - 2);
            const char* a1 = cA + (size_t)(t + 1) * kstep;
            const char* a2 = last ? nA : cA + (size_t)(t + 2) * kstep; const char* b2 = last ? nB : cB + (size_t)(t + 2) * kstep;
            const char* a3 = a2 + kstep; const char* b3 = b2 + kstep;
            PG8_LDB(B0, 0, 0); PG8_LDB(B1, 0, 1); PG8_SCHED; PG8_LDA(At, 0, 0); PG8_STAGE(PG8_SA(1, 1), a1 + hstepA, voffA);
            PG8_WAIT_V(8); PG8_WAIT_L(0); PG8_BAR; PG8_MMA(0, 0, At, B0); PG8_MMA(0, 1, At, B1); PG8_BAR; PG8_SCHED;
            PG8_LDA(At, 0, 1); PG8_STAGE(PG8_SB(0, 0), b2, voffB); PG8_STAGE(PG8_SB(0, 1), b2 + hstepB, voffB); PG8_STAGE(PG8_SA(0, 0), a2, voffA);
            PG8_WAIT_V(8); PG8_WAIT_L(0); PG8_BAR; PG8_MMA(1, 0, At, B0); PG8_MMA(1, 1, At, B1); PG8_BAR; PG8_SCHED;
            PG8_LDB(B0, 1, 0); PG8_LDB(B1, 1, 1); PG8_SCHED; PG8_LDA(At, 1, 0); PG8_STAGE(PG8_SA(0, 1), a2 + hstepA, voffA);
            PG8_WAIT_V(8); PG8_WAIT_L(0); PG8_BAR; PG8_MMA(0, 0, At, B0); PG8_MMA(0, 1, At, B1); PG8_BAR; PG8_SCHED;
            PG8_LDA(At, 1, 1); PG8_STAGE(PG8_SB(1, 0), b3, voffB); PG8_STAGE(PG8_SB(1, 1), b3 + hstepB, voffB); PG8_STAGE(PG8_SA(1, 0), a3, voffA);
            PG8_WAIT_V(8); PG8_WAIT_L(0); PG8_BAR; PG8_MMA(1, 0, At, B0); PG8_MMA(1, 1, At, B1); PG8_BAR; PG8_SCHED;
        }
        if constexpr (ALIGN_EPI) { if (wr == 0) PG8_BAR; }
        E(acc, cur, wr, wc, fr, fq);
        if (!has_next) break;
#pragma unroll
        for (int a = 0; a < 2; ++a)
#pragma unroll
            for (int b = 0; b < 2; ++b)
#pragma unroll
                for (int m = 0; m < 4; ++m)
#pragma unroll
                    for (int n = 0; n < 2; ++n) acc[a][b][m][n] = (f32x4){0.f, 0.f, 0.f, 0.f};
        cur = nxt; cA = nA; cB = nB; ++ui;
        if constexpr (ALIGN_EPI) { if (wr == 1) PG8_BAR; }
    }
    PG8_WAIT_V(0);
    if constexpr (!ALIGN_EPI) { if (wr == 0) PG8_BAR; }
    PG8_BAR;
#undef PG8_SA
#undef PG8_SB
#undef PG8_STAGE
#undef PG8_LDA
#undef PG8_LDB
#undef PG8_MMA
#undef PG8_WAIT_V
#undef PG8_WAIT_L
#undef PG8_BAR
#undef PG8_SCHED
}
template <class F> struct EpiP {
    static constexpr bool PERM = true; F f;
    __device__ __forceinline__ void operator()(const f32x4 (&acc)[2][2][4][2], const Unit& u, int wr, int wc, int fr, int fq) const {
#pragma unroll
        for (int ai = 0; ai < 2; ++ai)
#pragma unroll
            for (int m = 0; m < 4; ++m) { int row = u.pm * BM + ai * HALF + wr * 64 + m * 16 + fr; asm volatile("" : "+v"(row));
#pragma unroll
                for (int bj = 0; bj < 2; ++bj) { const int col0 = u.pn * BM + bj * HALF + wc * 32 + 8 * fq; f(row, col0, acc[ai][bj][m][0], acc[ai][bj][m][1]); } asm volatile("" ::: "memory"); }
    }
};
template <class F> struct EpiN {
    static constexpr bool PERM = false; F f;
    __device__ __forceinline__ void operator()(const f32x4 (&acc)[2][2][4][2], const Unit& u, int wr, int wc, int fr, int fq) const {
#pragma unroll
        for (int ai = 0; ai < 2; ++ai)
#pragma unroll
            for (int m = 0; m < 4; ++m) { int row = u.pm * BM + ai * HALF + wr * 64 + m * 16 + fr; asm volatile("" : "+v"(row));
#pragma unroll
                for (int bj = 0; bj < 2; ++bj)
#pragma unroll
                    for (int n = 0; n < 2; ++n) { const int col0 = u.pn * BM + bj * HALF + wc * 32 + 16 * n + 4 * fq; f(row, col0, acc[ai][bj][m][n]); } asm volatile("" ::: "memory"); }
    }
};
}

struct Params {
    const float* in[33];
    float* out;
    unsigned char* ws;
};

struct TJob { const float* W; int ldw, n0src, Nsrc, Ksrc; bf16_t* WT; int ldt, row_off, col_off, Npad, Kpad; const float* mix; int mode; };
__device__ __forceinline__ void transpose_job(const TJob& j, LAS float* scr, int gw, int NGW, int lane_) {
    int lane = lane_; asm volatile("" : "+v"(lane));
    const int nblk = j.Npad / 32, kblk = j.Kpad / 64, items = nblk * kblk;
    for (int it = gw; it < items; it += NGW) {
        const int kb = it / nblk, nb = it % nblk, k0 = 64 * kb, n0 = 32 * nb;
#pragma unroll 4
        for (int i = 0; i < 32; ++i) { const int kk = 2 * i + (lane >> 5), n = lane & 31; float v = 0.f;
            if (k0 + kk < j.Ksrc && n0 + n < j.Nsrc) { v = j.W[(size_t)(k0 + kk) * j.ldw + j.n0src + n0 + n];
                if (j.mode == 1) v *= j.mix[k0 + kk]; else if (j.mode == 2) v *= (1.0f - j.mix[k0 + kk]); }
            scr[kk * 33 + n] = v; }
        asm volatile("s_waitcnt lgkmcnt(0)" ::: "memory");
        const int c = lane & 7;
#pragma unroll
        for (int jj = 0; jj < 4; ++jj) { const int n = (lane >> 3) + 8 * jj; const LAS float* s = scr + (8 * c) * 33 + n;
            u32x4 o; o.x = cvt_pk_bf16(s[0 * 33], s[1 * 33]); o.y = cvt_pk_bf16(s[2 * 33], s[3 * 33]); o.z = cvt_pk_bf16(s[4 * 33], s[5 * 33]); o.w = cvt_pk_bf16(s[6 * 33], s[7 * 33]);
            *(u32x4*)(j.WT + (size_t)(j.row_off + n0 + n) * j.ldt + j.col_off + k0 + 8 * c) = o; }
        asm volatile("s_waitcnt lgkmcnt(0)" ::: "memory");
    }
}

__device__ __forceinline__ void rms_row_bf16(const float* xrow, const float* g, bf16_t* orow, float* copy_to, int lane_) {
    int lane = lane_; asm volatile("" : "+v"(lane));
    const f32x4* xr = (const f32x4*)xrow + lane; const f32x4* gr = (const f32x4*)g + lane;
    f32x4 v[4]; float s = 0.f;
#pragma unroll
    for (int j = 0; j < 4; ++j) { v[j] = xr[64 * j]; s += (v[j].x * v[j].x + v[j].y * v[j].y) + (v[j].z * v[j].z + v[j].w * v[j].w); }
    if (copy_to) {
#pragma unroll
        for (int j = 0; j < 4; ++j) ((f32x4*)copy_to + lane)[64 * j] = v[j];
    }
    const float r = rsqrtf(wave_sum(s) * (1.f / D) + 1e-5f);
    u32x2* o8 = (u32x2*)orow + lane;
#pragma unroll
    for (int j = 0; j < 4; ++j) { const f32x4 gg = gr[64 * j]; u32x2 w; w.x = cvt_pk_bf16(v[j].x * r * gg.x, v[j].y * r * gg.y); w.y = cvt_pk_bf16(v[j].z * r * gg.z, v[j].w * r * gg.w); o8[64 * j] = w; }
}

struct FRelu2 { bf16_t* O; __device__ __forceinline__ void operator()(int row, int col0, f32x4 a, f32x4 b) const {
    f32x4 x = a, y = b;
#pragma unroll
    for (int i = 0; i < 4; ++i) { float t = fmaxf(x[i], 0.f); x[i] = t * t; t = fmaxf(y[i], 0.f); y[i] = t * t; }
    u32x4 w; w.x = cvt_pk_bf16(x[0], x[1]); w.y = cvt_pk_bf16(x[2], x[3]); w.z = cvt_pk_bf16(y[0], y[1]); w.w = cvt_pk_bf16(y[2], y[3]);
    *(u32x4*)(O + (size_t)row * FF + col0) = w; } };
struct FResAdd { float* X; __device__ __forceinline__ void operator()(int row, int col0, f32x4 a) const {
    f32x4* p = (f32x4*)(X + (size_t)row * D + col0); *p = *p + a; } };


struct FRwIn { h16* R; h16* Kk; h16* V; bf16_t* LH;
    __device__ __forceinline__ void operator()(int row, int col0, f32x4 a, f32x4 b) const {
        const int seg = __builtin_amdgcn_readfirstlane(col0 >> 10);
        if (seg < 3) { const long dK = (const char*)Kk - (const char*)R, dV = (const char*)V - (const char*)R; const long off = (seg == 1 ? dK : 0l) + (seg == 2 ? dV : 0l); h16* dst = (h16*)((char*)R + off); const int c = col0 & 1023;
            u32x4 w; w.x = pk_h16(a[0], a[1]); w.y = pk_h16(a[2], a[3]); w.z = pk_h16(b[0], b[1]); w.w = pk_h16(b[2], b[3]);
            *(u32x4*)(dst + (size_t)row * D + c) = w; }
        else { const int c = col0 - 3072; f32x4 x = a, y = b;
            if (c < 128) {
#pragma unroll
                for (int i = 0; i < 4; ++i) { x[i] = tanhf_(x[i]); y[i] = tanhf_(y[i]); } }
            else if (c >= 256 && c < 512) {
#pragma unroll
                for (int i = 0; i < 4; ++i) { x[i] = sigmoidf_(x[i]); y[i] = sigmoidf_(y[i]); } }
            u32x4 w; w.x = cvt_pk_bf16(x[0], x[1]); w.y = cvt_pk_bf16(x[2], x[3]); w.z = cvt_pk_bf16(y[0], y[1]); w.w = cvt_pk_bf16(y[2], y[3]);
            *(u32x4*)(LH + (size_t)row * 768 + c) = w; }
    } };
struct FLoraW { h16* EW; const float* w0;
    __device__ __forceinline__ void operator()(int row, int col0, f32x4 a, f32x4 b) const {
        const f32x4 p = *(const f32x4*)(w0 + col0), q = *(const f32x4*)(w0 + col0 + 4); float o[8];
#pragma unroll
        for (int i = 0; i < 4; ++i) { o[i] = 0.60653066f * sigmoidf_(p[i] + a[i]); o[4 + i] = 0.60653066f * sigmoidf_(q[i] + b[i]); }
        u32x4 w; w.x = pk_h16(o[0], o[1]); w.y = pk_h16(o[2], o[3]); w.z = pk_h16(o[4], o[5]); w.w = pk_h16(o[6], o[7]);
        *(u32x4*)(EW + (size_t)row * D + col0) = w; } };
struct FLoraA { h16* Aa; const float* a0;
    __device__ __forceinline__ void operator()(int row, int col0, f32x4 a, f32x4 b) const {
        const f32x4 p = *(const f32x4*)(a0 + col0), q = *(const f32x4*)(a0 + col0 + 4); float o[8];
#pragma unroll
        for (int i = 0; i < 4; ++i) { o[i] = sigmoidf_(p[i] + a[i]); o[4 + i] = sigmoidf_(q[i] + b[i]); }
        u32x4 w; w.x = pk_h16(o[0], o[1]); w.y = pk_h16(o[2], o[3]); w.z = pk_h16(o[4], o[5]); w.w = pk_h16(o[6], o[7]);
        *(u32x4*)(Aa + (size_t)row * D + col0) = w; } };
struct FLoraV { h16* V; const h16* VFm; const float* v0;
    __device__ __forceinline__ void operator()(int row, int col0, f32x4 a, f32x4 b) const {
        const f32x4 p = *(const f32x4*)(v0 + col0), q = *(const f32x4*)(v0 + col0 + 4);
        typedef h16 h16x8 __attribute__((ext_vector_type(8)));
        const h16x8 vv = *(const h16x8*)(V + (size_t)row * D + col0), vf = *(const h16x8*)(VFm + (size_t)row * D + col0); float o[8];
#pragma unroll
        for (int i = 0; i < 4; ++i) { float v = (float)vv[i], f = (float)vf[i]; o[i] = v + (f - v) * sigmoidf_(p[i] + a[i]); v = (float)vv[4 + i]; f = (float)vf[4 + i]; o[4 + i] = v + (f - v) * sigmoidf_(q[i] + b[i]); }
        u32x4 w; w.x = pk_h16(o[0], o[1]); w.y = pk_h16(o[2], o[3]); w.z = pk_h16(o[4], o[5]); w.w = pk_h16(o[6], o[7]);
        *(u32x4*)(V + (size_t)row * D + col0) = w; } };
struct FGate { bf16_t* O; const h16* Y;
    __device__ __forceinline__ void operator()(int row, int col0, f32x4 a, f32x4 b) const {
        typedef h16 h16x8 __attribute__((ext_vector_type(8)));
        const h16x8 yy = *(const h16x8*)(Y + (size_t)row * D + col0);
        u32x4 w; w.x = cvt_pk_bf16(a[0] * (float)yy[0], a[1] * (float)yy[1]); w.y = cvt_pk_bf16(a[2] * (float)yy[2], a[3] * (float)yy[3]);
        w.z = cvt_pk_bf16(b[0] * (float)yy[4], b[1] * (float)yy[5]); w.w = cvt_pk_bf16(b[2] * (float)yy[6], b[3] * (float)yy[7]);
        *(u32x4*)(O + (size_t)row * D + col0) = w; } };

template <int CTRL> __device__ __forceinline__ float dppmov(float v) { return __builtin_bit_cast(float, __builtin_amdgcn_update_dpp(0, __builtin_bit_cast(int, v), CTRL, 0xF, 0xF, true)); }
__device__ __forceinline__ float row16_sum(float v) { v += dppmov<0xB1>(v); v += dppmov<0x4E>(v); v += dppmov<0x124>(v); v += dppmov<0x128>(v); return v; }
typedef _Float16 h16x4 __attribute__((ext_vector_type(4)));
__device__ __forceinline__ void h4_to_f(h16x4 u, float* f) { f[0] = (float)u[0]; f[1] = (float)u[1]; f[2] = (float)u[2]; f[3] = (float)u[3]; }
__device__ __forceinline__ void rwkv_scan(const h16* R, const h16* Kk, const h16* V, const h16* EW, const h16* Aa, const float* k_k, const float* k_a, h16* Yraw, int G, int wave, int lane_) {
    int lane = lane_; asm volatile("" : "+v"(lane));
    const int NT = G * NWAVES;
    for (int task = wave * G + (int)blockIdx.x; task < 512; task += NT) {
        const int bh = task >> 4, rg = task & 15, b = bh >> 4, h = bh & 15;
        const int row = lane >> 4, jg = lane & 15, i = rg * 4 + row;
        const int colj = h * 64 + 4 * jg, coli = h * 64 + i;
        float kkc[4], kac[4];
#pragma unroll
        for (int j = 0; j < 4; ++j) { kkc[j] = k_k[colj + j]; kac[j] = k_a[colj + j]; }
        float s[4] = {0.f, 0.f, 0.f, 0.f};
        const size_t base = (size_t)b * S * D;
        const h16* pR = R + base + colj; const h16* pK = Kk + base + colj; const h16* pA = Aa + base + colj; const h16* pE = EW + base + colj; const h16* pV = V + base + coli;
        h16* pY = Yraw + ((size_t)task * S) * 4 + row;
        constexpr int TC = 4;
        h16x4 cr[TC], ck[TC], ca[TC], ce[TC]; h16 cv[TC];
#pragma unroll
        for (int u = 0; u < TC; ++u) { const size_t o = (size_t)u * D; cr[u] = *(const h16x4*)(pR + o); ck[u] = *(const h16x4*)(pK + o); ca[u] = *(const h16x4*)(pA + o); ce[u] = *(const h16x4*)(pE + o); cv[u] = pV[o]; }
        for (int t0 = 0; t0 < S; t0 += TC) {
            const int tn = (t0 + TC < S) ? t0 + TC : t0;
            h16x4 nr[TC], nk[TC], na[TC], ne[TC]; h16 nv[TC];
#pragma unroll
            for (int u = 0; u < TC; ++u) { const size_t o = (size_t)(tn + u) * D; nr[u] = *(const h16x4*)(pR + o); nk[u] = *(const h16x4*)(pK + o); na[u] = *(const h16x4*)(pA + o); ne[u] = *(const h16x4*)(pE + o); nv[u] = pV[o]; }
#pragma unroll
            for (int u = 0; u < TC; ++u) {
                float rv[4], kv[4], av[4], ev[4]; h4_to_f(cr[u], rv); h4_to_f(ck[u], kv); h4_to_f(ca[u], av); h4_to_f(ce[u], ev);
                const float vi = (float)cv[u];
                float kq[4], n2 = 0.f;
#pragma unroll
                for (int j = 0; j < 4; ++j) { kq[j] = kv[j] * kkc[j]; n2 += kq[j] * kq[j]; }
                n2 = row16_sum(n2);
                const float inv = 1.0f / fmaxf(sqrtf(n2), 1e-12f);
                float kkj[4], kt[4], bb[4], w[4], dot = 0.f;
#pragma unroll
                for (int j = 0; j < 4; ++j) { kkj[j] = kq[j] * inv; kt[j] = kv[j] * (1.0f + (av[j] - 1.0f) * kac[j]); bb[j] = kkj[j] * av[j]; w[j] = __expf(-ev[j]); dot += s[j] * kkj[j]; }
                const float sa = -row16_sum(dot);
                float yd = 0.f;
#pragma unroll
                for (int j = 0; j < 4; ++j) { s[j] = s[j] * w[j] + (sa * bb[j] + vi * kt[j]); yd += s[j] * rv[j]; }
                const float y = row16_sum(yd);
                if (jg == 0) pY[(size_t)(t0 + u) * 4] = (h16)y;
            }
#pragma unroll
            for (int u = 0; u < TC; ++u) { cr[u] = nr[u]; ck[u] = nk[u]; ca[u] = na[u]; ce[u] = ne[u]; cv[u] = nv[u]; }
        }
    }
}
constexpr int SC_CS = 32, SC_STEP_F = 5 * 64 + 8, SC_BUF_F = SC_CS * SC_STEP_F;
#define SC_BAR() do { asm volatile("s_waitcnt lgkmcnt(0)" ::: "memory"); __builtin_amdgcn_s_barrier(); asm volatile("" ::: "memory"); } while (0)
__device__ __forceinline__ float wave_sum_dpp(float v) {
    v = row16_sum(v);
    const float a = __builtin_bit_cast(float, __builtin_amdgcn_readlane(__builtin_bit_cast(int, v), 0)), b = __builtin_bit_cast(float, __builtin_amdgcn_readlane(__builtin_bit_cast(int, v), 16));
    const float c = __builtin_bit_cast(float, __builtin_amdgcn_readlane(__builtin_bit_cast(int, v), 32)), d = __builtin_bit_cast(float, __builtin_amdgcn_readlane(__builtin_bit_cast(int, v), 48));
    return (a + b) + (c + d);
}
struct ScRegs { h16 k[8], a[8], e[8], r[8], v[8]; };
__device__ __forceinline__ void sc_load(ScRegs& g, const h16* R, const h16* Kk, const h16* V, const h16* EW, const h16* Aa, size_t base, int c, int pw, int sub, int lane) {
#pragma unroll
    for (int q = 0; q < 8; ++q) { const size_t o = base + (size_t)(c * SC_CS + pw + 4 * q) * D;
        g.k[q] = Kk[o + lane]; g.a[q] = Aa[o + lane]; g.e[q] = EW[o + lane]; g.r[q] = R[o + lane]; g.v[q] = V[o + sub * 8 + (lane & 7)]; }
}
__device__ __forceinline__ void sc_compute(const ScRegs& g, LAS float* sb, int pw, float kkc, float kac, int lane) {
#pragma unroll
    for (int q = 0; q < 8; ++q) {
        const float kv = (float)g.k[q], av = (float)g.a[q], ev = (float)g.e[q], rv = (float)g.r[q]; const float kq = kv * kkc;
        const float n2 = wave_sum_dpp(kq * kq);
        const float kkj = kq * rsqrtf(fmaxf(n2, 1e-24f)); LAS float* p = sb + (pw + 4 * q) * SC_STEP_F;
        p[lane] = kkj; p[64 + lane] = kkj * av; p[128 + lane] = kv * (1.0f + (av - 1.0f) * kac); p[192 + lane] = __expf(-ev); p[256 + lane] = rv; if (lane < 8) p[320 + lane] = (float)g.v[q];
    }
}
__device__ __forceinline__ void rwkv_scan2(const h16* R, const h16* Kk, const h16* V, const h16* EW, const h16* Aa, const float* k_k, const float* k_a, h16* Yraw, LAS unsigned char* lds, int wave, int lane_) {
    int lane = lane_; asm volatile("" : "+v"(lane));
    LAS float* buf = (LAS float*)lds;
    constexpr int NCH = S / SC_CS;
#pragma unroll 1
    for (int vb = (int)blockIdx.x; vb < 256; vb += (int)gridDim.x) {
        const int bh = vb >> 3, sub = vb & 7, b = bh >> 4, h = bh & 15;
        const size_t base = (size_t)b * S * D + h * 64;
        if (wave >= 4) {
            const int pw = wave - 4;
            const float kkc = k_k[h * 64 + lane], kac = k_a[h * 64 + lane];
            ScRegs ga, gb;
            sc_load(ga, R, Kk, V, EW, Aa, base, 0, pw, sub, lane);
            sc_load(gb, R, Kk, V, EW, Aa, base, 1, pw, sub, lane);
            sc_compute(ga, buf, pw, kkc, kac, lane);
            SC_BAR();
#pragma unroll 1
            for (int c = 0; c < NCH; c += 2) {
                { const int c2 = (c + 2 < NCH) ? c + 2 : c; sc_load(ga, R, Kk, V, EW, Aa, base, c2, pw, sub, lane); }
                sc_compute(gb, buf + SC_BUF_F, pw, kkc, kac, lane);
                SC_BAR();
                { const int c3 = (c + 3 < NCH) ? c + 3 : c + 1; sc_load(gb, R, Kk, V, EW, Aa, base, c3, pw, sub, lane); }
                if (c + 2 < NCH) sc_compute(ga, buf, pw, kkc, kac, lane);
                SC_BAR();
            }
            SC_BAR();
        } else if (wave < 2) {
            const int jg = lane & 15, cw = wave;
            f32x2 sA = {0.f, 0.f}, sB = {0.f, 0.f};
#define SC_LO(v) __builtin_shufflevector(v, v, 0, 1)
#define SC_HI(v) __builtin_shufflevector(v, v, 2, 3)
            SC_BAR();
#pragma unroll 1
            for (int c = 0; c < NCH; ++c) {
                const LAS float* sb = buf + (c & 1) * SC_BUF_F + 4 * jg;
                const LAS float* vb_ = buf + (c & 1) * SC_BUF_F + 320 + cw * 4 + (lane >> 4);
                LAS float* yp = buf + 2 * SC_BUF_F + ((c & 1) * 2 + cw) * (SC_CS * 64) + lane;
                f32x4 kk4 = *(const LAS f32x4*)(sb), bb4 = *(const LAS f32x4*)(sb + 64), kt4 = *(const LAS f32x4*)(sb + 128), w4 = *(const LAS f32x4*)(sb + 192), r4 = *(const LAS f32x4*)(sb + 256); float vi = vb_[0];
#pragma unroll 4
                for (int st = 0; st < SC_CS; ++st) {
                    const int sn = (st + 1 < SC_CS) ? st + 1 : st;
                    const f32x4 nkk = *(const LAS f32x4*)(sb + sn * SC_STEP_F), nbb = *(const LAS f32x4*)(sb + sn * SC_STEP_F + 64), nkt = *(const LAS f32x4*)(sb + sn * SC_STEP_F + 128), nw = *(const LAS f32x4*)(sb + sn * SC_STEP_F + 192), nr4 = *(const LAS f32x4*)(sb + sn * SC_STEP_F + 256);
                    const float nvi = vb_[sn * SC_STEP_F];
                    f32x2 tt = sA * SC_LO(kk4); tt = sB * SC_HI(kk4) + tt;
                    const float sa = -row16_sum(tt.x + tt.y);
                    const f32x2 sa2 = {sa, sa}, vi2 = {vi, vi};
                    f32x2 uA = vi2 * SC_LO(kt4); uA = sa2 * SC_LO(bb4) + uA; sA = sA * SC_LO(w4) + uA;
                    f32x2 uB = vi2 * SC_HI(kt4); uB = sa2 * SC_HI(bb4) + uB; sB = sB * SC_HI(w4) + uB;
                    f32x2 yy = sA * SC_LO(r4); yy = sB * SC_HI(r4) + yy;
                    yp[st * 64] = yy.x + yy.y;
                    kk4 = nkk; bb4 = nbb; kt4 = nkt; w4 = nw; r4 = nr4; vi = nvi;
                }
                SC_BAR();
            }
            SC_BAR();
        } else {
            const int cw = wave - 2;
            h16* pY = Yraw + ((size_t)(bh * 16 + sub * 2 + cw) * S) * 4;
            SC_BAR();
#pragma unroll 1
            for (int c = 0; c <= NCH; ++c) {
                if (c > 0) {
                    const LAS float* yp = buf + 2 * SC_BUF_F + (((c - 1) & 1) * 2 + cw) * (SC_CS * 64);
                    const int st = lane >> 1, r0 = 2 * (lane & 1);
                    float a0 = 0.f, a1 = 0.f;
#pragma unroll
                    for (int q = 0; q < 4; ++q) { const f32x4 x = *(const LAS f32x4*)(yp + st * 64 + r0 * 16 + 4 * q), z = *(const LAS f32x4*)(yp + st * 64 + (r0 + 1) * 16 + 4 * q);
                        a0 += (x[0] + x[1]) + (x[2] + x[3]); a1 += (z[0] + z[1]) + (z[2] + z[3]); }
                    *(unsigned*)(pY + (size_t)((c - 1) * SC_CS + st) * 4 + r0) = pk_h16(a0, a1);
                }
                SC_BAR();
            }
        }
        if (false) {
            SC_BAR();
#pragma unroll 1
            for (int c = 0; c < NCH; ++c) SC_BAR();
        }
    }
}
__device__ __forceinline__ void rwkv_gn(h16* R, const h16* Kk, const h16* V, const h16* Aa, const h16* Yraw, const float* k_a, const float* r_k, const float* ln_w, const float* ln_b, int gw, int NGW, int lane_) {
    int lane = lane_; asm volatile("" : "+v"(lane));
    const int hq = lane >> 4, c4 = 4 * (lane & 15);
#pragma unroll 2
    for (int idx = gw; idx < M * 4; idx += NGW) {
        const int m = idx >> 2, h = (idx & 3) * 4 + hq, col = h * 64 + c4; const size_t o = (size_t)m * D + col;
        const int bq = m / S, tq = m - bq * S;
        float y[4], r[4], k[4], a[4], v[4];
        h4_to_f(*(const h16x4*)(Yraw + ((size_t)((bq * 16 + h) * 16 + (lane & 15)) * S + tq) * 4), y);
        h4_to_f(*(const h16x4*)(R + o), r); h4_to_f(*(const h16x4*)(Kk + o), k); h4_to_f(*(const h16x4*)(Aa + o), a); h4_to_f(*(const h16x4*)(V + o), v);
        const f32x4 ka4 = *(const f32x4*)(k_a + col), rk4 = *(const f32x4*)(r_k + col), lw4 = *(const f32x4*)(ln_w + col), lb4 = *(const f32x4*)(ln_b + col);
        const float mu = row16_sum((y[0] + y[1]) + (y[2] + y[3])) * (1.f / 64.f);
        float d[4], q = 0.f, bsp = 0.f;
#pragma unroll
        for (int i = 0; i < 4; ++i) { d[i] = y[i] - mu; q += d[i] * d[i]; const float kt = k[i] * (1.0f + (a[i] - 1.0f) * ka4[i]); bsp += r[i] * kt * rk4[i]; }
        const float rstd = rsqrtf(row16_sum(q) * (1.f / 64.f) + 64e-5f), bs = row16_sum(bsp);
        h16x4 outv;
#pragma unroll
        for (int i = 0; i < 4; ++i) outv[i] = (h16)(d[i] * rstd * lw4[i] + lb4[i] + bs * v[i]);
        *(h16x4*)(R + o) = outv;
    }
}

constexpr size_t KF_STRIDE = (size_t)NB * 4 * S * 64;
__device__ __forceinline__ float gelu_tanh(float x) { const float u = 0.7978845608f * (x + 0.044715f * x * x * x); return 0.5f * x * (1.0f + tanhf_(u)); }
__device__ __forceinline__ void store_vf8(bf16_t* chunk_base_d, int keyp0  , f32x4 a, f32x4 b) {
    const int tile = keyp0 >> 4, rq0 = (keyp0 & 15) >> 2;
    u32x2 w0, w1; w0.x = cvt_pk_bf16(a[0], a[1]); w0.y = cvt_pk_bf16(a[2], a[3]); w1.x = cvt_pk_bf16(b[0], b[1]); w1.y = cvt_pk_bf16(b[2], b[3]);
    *(u32x2*)(chunk_base_d + 8 * rq0 + 4 * tile) = w0; *(u32x2*)(chunk_base_d + 8 * (rq0 + 1) + 4 * tile) = w1;
}
struct FNsaIn { bf16_t* Q; bf16_t* KF; float* gates; const float* rope;
    __device__ __forceinline__ void operator()(int row, int col0, f32x4 a, f32x4 b) const {
        const int tile = __builtin_amdgcn_readfirstlane(col0 >> 8);
        const int bb = row / S, t = row - bb * S;
        if (tile < 7) {
            f32x4 x = a, y = b;
            if ((col0 & 32) == 0) {
                f32x4 px, py;
#pragma unroll
                for (int i = 0; i < 4; ++i) { px[i] = __shfl_xor(x[i], 16); py[i] = __shfl_xor(y[i], 16); }
                const int d0 = col0 & 63;
                if (d0 < 16) { const f32x4 c0 = *(const f32x4*)(rope + t * 16), c1 = *(const f32x4*)(rope + t * 16 + 4), s0 = *(const f32x4*)(rope + t * 16 + 8), s1 = *(const f32x4*)(rope + t * 16 + 12);
                    if (d0 == 0) { x = x * c0 - px * s0; y = y * c1 - py * s1; } else { x = x * c0 + px * s0; y = y * c1 + py * s1; } }
            }
            if (tile < 4) { x = x * 0.18033688011112042f; y = y * 0.18033688011112042f;
                u32x4 w; w.x = cvt_pk_bf16(x[0], x[1]); w.y = cvt_pk_bf16(x[2], x[3]); w.z = cvt_pk_bf16(y[0], y[1]); w.w = cvt_pk_bf16(y[2], y[3]);
                *(u32x4*)(Q + (size_t)row * D + col0) = w; }
            else { const int idx = tile - 4, g = (col0 & 255) >> 6, d0 = col0 & 63;
                u32x4 w; w.x = cvt_pk_bf16(x[0], x[1]); w.y = cvt_pk_bf16(x[2], x[3]); w.z = cvt_pk_bf16(y[0], y[1]); w.w = cvt_pk_bf16(y[2], y[3]);
                *(u32x4*)(KF + (size_t)idx * KF_STRIDE + ((size_t)(bb * 4 + g) * S + t) * 64 + d0) = w; }
        } else if (tile == 7) { const int g = (col0 & 255) >> 6, d0 = col0 & 63;
            u32x4 w; w.x = cvt_pk_bf16(a[0], a[1]); w.y = cvt_pk_bf16(a[2], a[3]); w.z = cvt_pk_bf16(b[0], b[1]); w.w = cvt_pk_bf16(b[2], b[3]);
            *(u32x4*)(KF + (size_t)3 * KF_STRIDE + ((size_t)(bb * 4 + g) * S + t) * 64 + d0) = w;
        } else { const int c = col0 - 2048;
            if (c < 48) { f32x4 x, y;
#pragma unroll
                for (int i = 0; i < 4; ++i) { x[i] = sigmoidf_(a[i]); y[i] = sigmoidf_(b[i]); }
                *(f32x4*)(gates + (size_t)row * 48 + c) = x; *(f32x4*)(gates + (size_t)row * 48 + c + 4) = y; }
        }
    } };
struct FNsaVT { bf16_t* VF;
    __device__ __forceinline__ void operator()(int row, int col0, f32x4 a, f32x4 b) const {
        const int br = row >> 8, g = (row >> 6) & 3, d = row & 63, bb = col0 / S, t0 = col0 - bb * S;
        bf16_t* base = VF + (size_t)br * KF_STRIDE + (size_t)(bb * 4 + g) * S * 64 + (size_t)(t0 >> 5) * 2048 + d * 32;
        store_vf8(base, t0 & 31, a, b); } };
struct FCmp1 { bf16_t* CH; const float* bias;
    __device__ __forceinline__ void operator()(int row, int col0, f32x4 a, f32x4 b) const {
        const f32x4 p = *(const f32x4*)(bias + col0), q = *(const f32x4*)(bias + col0 + 4); float o[8];
#pragma unroll
        for (int i = 0; i < 4; ++i) { o[i] = gelu_tanh(a[i] + p[i]); o[4 + i] = gelu_tanh(b[i] + q[i]); }
        u32x4 w; w.x = cvt_pk_bf16(o[0], o[1]); w.y = cvt_pk_bf16(o[2], o[3]); w.z = cvt_pk_bf16(o[4], o[5]); w.w = cvt_pk_bf16(o[6], o[7]);
        *(u32x4*)(CH + (size_t)row * 256 + col0) = w; } };
struct FCmp2K { bf16_t* KC;
    __device__ __forceinline__ void operator()(int row, int col0, f32x4 a, f32x4 b) const {
        if (col0 < 64) { u32x4 w; w.x = cvt_pk_bf16(a[0], a[1]); w.y = cvt_pk_bf16(a[2], a[3]); w.z = cvt_pk_bf16(b[0], b[1]); w.w = cvt_pk_bf16(b[2], b[3]);
            *(u32x4*)(KC + (size_t)row * 64 + col0) = w; } } };
struct FCmp2VT { bf16_t* VC;
    __device__ __forceinline__ void operator()(int row, int col0, f32x4 a, f32x4 b) const {
        if (row < 64) { const int bg = col0 >> 10, n0 = col0 & 1023;
            bf16_t* base = VC + (size_t)bg * 65536 + (size_t)(n0 >> 5) * 2048 + row * 32; store_vf8(base, n0 & 31, a, b); } } };

__device__ __forceinline__ f32x4 mfma16(bf16x8 a, bf16x8 b, f32x4 c) { return __builtin_amdgcn_mfma_f32_16x16x32_bf16(a, b, c, 0, 0, 0); }
__device__ __forceinline__ bf16x8 ld8(const bf16_t* p) { return *(const bf16x8*)p; }
__device__ __forceinline__ bf16x8 pack8(f32x4 a, f32x4 b) { u32x4 w; w.x = cvt_pk_bf16(a[0], a[1]); w.y = cvt_pk_bf16(a[2], a[3]); w.z = cvt_pk_bf16(b[0], b[1]); w.w = cvt_pk_bf16(b[2], b[3]); return __builtin_bit_cast(bf16x8, w); }
__device__ __forceinline__ float colmax(float x) {
    const auto r = __builtin_amdgcn_permlane16_swap(__float_as_uint(x), __float_as_uint(x), false, false); x = fmaxf(__uint_as_float(r[0]), __uint_as_float(r[1]));
    const auto q = __builtin_amdgcn_permlane32_swap(__float_as_uint(x), __float_as_uint(x), false, false); return fmaxf(__uint_as_float(q[0]), __uint_as_float(q[1])); }
__device__ __forceinline__ float colsum(float x) {
    const auto r = __builtin_amdgcn_permlane16_swap(__float_as_uint(x), __float_as_uint(x), false, false); x = __uint_as_float(r[0]) + __uint_as_float(r[1]);
    const auto q = __builtin_amdgcn_permlane32_swap(__float_as_uint(x), __float_as_uint(x), false, false); return __uint_as_float(q[0]) + __uint_as_float(q[1]); }
template <int CTRL> __device__ __forceinline__ unsigned dppmov_u(unsigned v) { return (unsigned)__builtin_amdgcn_update_dpp(0, (int)v, CTRL, 0xF, 0xF, true); }
__device__ __forceinline__ unsigned wave_max_u32(unsigned v) {
    v = max(v, dppmov_u<0xB1>(v)); v = max(v, dppmov_u<0x4E>(v)); v = max(v, dppmov_u<0x124>(v)); v = max(v, dppmov_u<0x128>(v));
    const auto r = __builtin_amdgcn_permlane16_swap(v, v, false, false); v = max((unsigned)r[0], (unsigned)r[1]);
    const auto q = __builtin_amdgcn_permlane32_swap(v, v, false, false); return max((unsigned)q[0], (unsigned)q[1]); }
struct AttnState { float m, l; f32x4 o[4]; };
__device__ __forceinline__ void attn_init(AttnState& st) { st.m = -1e30f; st.l = 0.f;
#pragma unroll
    for (int d = 0; d < 4; ++d) st.o[d] = (f32x4){0.f, 0.f, 0.f, 0.f}; }
struct KVChunk { bf16x8 k[4]; bf16x8 v[4]; };
__device__ __forceinline__ void kv_load(KVChunk& B, const bf16_t* kptr, const bf16_t* vptr) {
#pragma unroll
    for (int tl = 0; tl < 2; ++tl) { B.k[tl * 2] = ld8(kptr + tl * 1024); B.k[tl * 2 + 1] = ld8(kptr + tl * 1024 + 32); }
#pragma unroll
    for (int d = 0; d < 4; ++d) B.v[d] = ld8(vptr + d * 512);
}
struct KRange { int klo, span; };
__device__ __forceinline__ KRange krange(int klo, int khi) { KRange r; if (khi < klo) { r.klo = 64; r.span = 0; } else { r.klo = klo; r.span = khi - klo; } return r; }
template <bool MASKED>
__device__ __forceinline__ void attn_chunk_r(AttnState& st, const bf16x8 (&kf)[4], const bf16x8 (&vf)[4], const bf16x8 q0, const bf16x8 q1, KRange kr) {
    f32x4 s[2];
#pragma unroll
    for (int tl = 0; tl < 2; ++tl) { s[tl] = mfma16(kf[tl * 2], q0, (f32x4){0.f, 0.f, 0.f, 0.f}); s[tl] = mfma16(kf[tl * 2 + 1], q1, s[tl]); }
    float mx = -1e30f;
#pragma unroll
    for (int tl = 0; tl < 2; ++tl)
#pragma unroll
        for (int i = 0; i < 4; ++i) { if (MASKED) { const bool v = (unsigned)(tl * 16 + i - kr.klo) <= (unsigned)kr.span; s[tl][i] = v ? s[tl][i] : -1e30f; } mx = fmaxf(mx, s[tl][i]); }
    mx = colmax(mx);
    if (__any(mx > st.m)) {
        const float mnew = fmaxf(st.m, mx), alpha = __builtin_amdgcn_exp2f(st.m - mnew);
        st.l *= alpha; st.m = mnew;
#pragma unroll
        for (int d = 0; d < 4; ++d) st.o[d] = st.o[d] * alpha;
    }
    const float mcur = st.m;
    f32x4 p[2]; float ps = 0.f;
#pragma unroll
    for (int tl = 0; tl < 2; ++tl)
#pragma unroll
        for (int i = 0; i < 4; ++i) { const float e = __builtin_amdgcn_exp2f(s[tl][i] - mcur); p[tl][i] = e; ps += e; }
    st.l += ps;
    const bf16x8 pb = pack8(p[0], p[1]);
#pragma unroll
    for (int d = 0; d < 4; ++d) st.o[d] = mfma16(vf[d], pb, st.o[d]);
}

#define ATT_STEPN(C, idx) do { _Pragma("unroll") for (int gg = 0; gg < NG; ++gg) { if (act(gg, idx)) { \
        if (ff(gg, idx)) attn_chunk_r<false>(gs[gg], C.k, C.v, gq[gg][0], gq[gg][1], KRange{0, 0}); else attn_chunk_r<true>(gs[gg], C.k, C.v, gq[gg][0], gq[gg][1], mf(gg, idx)); } \
        __builtin_amdgcn_sched_barrier(0); } } while (0)
template <int NG, class AddrK, class AddrV, class ActF, class FullF, class MaskF>
__device__ __forceinline__ void attn_chunksN(AttnState (&gs)[NG], const bf16x8 (&gq)[NG][2], int n, AddrK ak, AddrV av, ActF act, FullF ff, MaskF mf) {
    if constexpr (NG <= 2) {
        KVChunk C0, C1;
        if (n > 0) kv_load(C0, ak(0), av(0));
#pragma unroll 1
        for (int i = 0; i < n; i += 2) {
            if (i + 1 < n) kv_load(C1, ak(i + 1), av(i + 1));
            ATT_STEPN(C0, i);
            if (i + 1 < n) {
                if (i + 2 < n) kv_load(C0, ak(i + 2), av(i + 2));
                ATT_STEPN(C1, i + 1);
            }
        }
    } else {
#pragma unroll 1
        for (int i = 0; i < n; ++i) { KVChunk C0; kv_load(C0, ak(i), av(i)); ATT_STEPN(C0, i); }
    }
}

__device__ __forceinline__ void nsa_attention(const bf16_t* Q, const bf16_t* KF, const bf16_t* VF, const bf16_t* KC, const bf16_t* VC, const float* gates, bf16_t* OUT, LAS unsigned char* lds, int G, int wave, int lane_) {
    int lane0 = lane_; asm volatile("" : "+v"(lane0));
    LAS float* imp = (LAS float*)(lds + wave * 18432);
    LAS float* tl = imp;
    LAS int* sel = (LAS int*)(lds + wave * 18432 + 16384);
    LAS unsigned* smask32 = (LAS unsigned*)(lds + wave * 18432 + 16384 + 1088);
    LAS unsigned char* blist = (LAS unsigned char*)(lds + wave * 18432 + 16384 + 1088 + 512);
    const bool xcd_map = (G % 8) == 0;
    const int nslots = xcd_map ? (G >> 3) * NWAVES : G * NWAVES, slot = xcd_map ? ((int)blockIdx.x >> 3) * NWAVES + wave : (int)blockIdx.x * NWAVES + wave;
    const int ntask = xcd_map ? 1024 : 8192;
#pragma unroll 1
    for (int task = slot; task < ntask; task += nslots) {
        int lane = lane0; asm volatile("" : "+v"(lane)); lane &= 63;
        const int col = lane & 15, rq = lane >> 4;
        const int tilei = xcd_map ? task : (task >> 3), bg = xcd_map ? ((int)blockIdx.x & 7) : (task & 7), b = bg >> 2, g = bg & 3, t0 = tilei * 16, t = t0 + col;
        const size_t rowq = (size_t)b * S + t;
        const bf16_t* qrow = Q + rowq * D + (g * 4) * 64 + 8 * rq;
        const float* grow = gates + rowq * 48 + g * 12;
        const int cur_max = (t0 + 15) >> 6;
        int n_end = 4 * (cur_max + 1); if (n_end > 1024) n_end = 1024;
        const int nchunk_c = (n_end + 31) >> 5;
        const bf16_t* kc_l = KC + (size_t)bg * 65536 + (size_t)col * 64 + 8 * rq;
        const bf16_t* vc_l = VC + (size_t)bg * 65536 + (size_t)col * 32 + 8 * rq;
        {
        AttnState gs[4]; bf16x8 gq[4][2];
#pragma unroll
        for (int h = 0; h < 4; ++h) { gq[h][0] = ld8(qrow + h * 64); gq[h][1] = ld8(qrow + h * 64 + 32); attn_init(gs[h]); }
        attn_chunksN<4>(gs, gq, nchunk_c,
            [&](int ci) { return kc_l + (size_t)ci * 2048; }, [&](int ci) { return vc_l + (size_t)ci * 2048; },
            [&](int, int) { return true; },
            [&](int, int ci) { return 16 * (ci * 32 + 31) + 31 <= t0; },
            [&](int, int ci) { const int nhi = (t >= 31) ? ((t - 31) >> 4) : -1; return krange(0, nhi - ci * 32 - 4 * rq); });
        {
            float mc[4], lc[4];
#pragma unroll
            for (int h = 0; h < 4; ++h) { const float lt = colsum(gs[h].l); mc[h] = gs[h].m; lc[h] = (gs[h].m > -1e29f && lt > 0.f) ? 1.0f / lt : 0.f; }
            {
                float carry = 0.f;
#pragma unroll 1
                for (int kc = 0; kc < nchunk_c; ++kc) {
#pragma unroll
                    for (int tt = 0; tt < 2; ++tt) {
                        const bf16x8 k0 = ld8(kc_l + (size_t)kc * 2048 + tt * 1024), k1 = ld8(kc_l + (size_t)kc * 2048 + tt * 1024 + 32);
                        float own = 0.f, p3 = 0.f;
#pragma unroll
                        for (int h = 0; h < 4; ++h) {
                            f32x4 sc = mfma16(k0, gq[h][0], (f32x4){0.f, 0.f, 0.f, 0.f}); sc = mfma16(k1, gq[h][1], sc);
#pragma unroll
                            for (int i = 0; i < 4; ++i) { const int n = kc * 32 + tt * 16 + 4 * rq + i; const float p = (16 * n + 31 <= t) ? __builtin_amdgcn_exp2f(sc[i] - mc[h]) * lc[h] : 0.f; own += p; if (i == 3) p3 += p; }
                        }
                        const float up = __shfl(p3, (lane + 48) & 63);
                        const float add = (rq == 0) ? carry : up;
                        imp[col * 256 + kc * 8 + tt * 4 + rq] = own + add;
                        carry = __shfl(p3, col + 48);
                    }
                }
            }
#pragma unroll 1
            for (int c = 0; c < 16; ++c) {
                const int tc = t0 + c, cur = tc >> 6;
                if (cur < 16) { if (lane <= cur) sel[c * 17 + lane] = lane; if (lane == 0) sel[c * 17 + 16] = cur + 1; }
                else {
                    unsigned key[4];
#pragma unroll
                    for (int jx = 0; jx < 4; ++jx) { const int sb = lane + 64 * jx; const float v = imp[c * 256 + sb]; key[jx] = (sb >= 1 && sb <= cur - 2) ? ((__float_as_uint(v) & 0xFFFFFF00u) | (unsigned)(255 - sb)) : 0u; }
                    if (lane == 0) { sel[c * 17 + 0] = 0; sel[c * 17 + 1] = cur - 1; sel[c * 17 + 2] = cur; sel[c * 17 + 16] = 16; }
#pragma unroll 1
                    for (int r = 0; r < 13; ++r) {
                        unsigned best = max(max(key[0], key[1]), max(key[2], key[3]));
                        best = wave_max_u32(best);
                        if (lane == 0) sel[c * 17 + 3 + r] = 255 - (int)(best & 255u);
#pragma unroll
                        for (int jx = 0; jx < 4; ++jx) if (key[jx] == best) key[jx] = 0u;
                    }
                }
            }
#pragma unroll
            for (int h = 0; h < 4; ++h) { const float gc = grow[h * 3 + 0] * lc[h];
#pragma unroll
                for (int d = 0; d < 4; ++d)
#pragma unroll
                    for (int i = 0; i < 4; ++i) tl[(h * 16 + d * 4 + i) * 64 + lane] = gs[h].o[d][i] * gc; }
        }
        }
        {
            smask32[lane] = 0u; smask32[64 + lane] = 0u;
#pragma unroll
            for (int k4 = 0; k4 < 4; ++k4) { const int pp = lane + 64 * k4, c = pp >> 4, e = pp & 15; if (e < sel[c * 17 + 16]) { const int jb = sel[c * 17 + e]; atomicOr((unsigned*)(smask32 + (jb >> 1)), 1u << (c + 16 * (jb & 1))); } }
            const bf16_t* ks_b = KF + (size_t)1 * KF_STRIDE + (size_t)bg * S * 64 + (size_t)col * 64 + 8 * rq;
            const bf16_t* vs_b = VF + (size_t)bg * S * 64 + (size_t)col * 32 + 8 * rq;
            const int tokl = col >> 2, hd = col & 3;
            {
                int nblk = 0;
                LAS unsigned* bl32 = (LAS unsigned*)sel;
                unsigned mk4[4];
#pragma unroll
                for (int k4 = 0; k4 < 4; ++k4) { const int jb = lane + 64 * k4; mk4[k4] = (smask32[jb >> 1] >> (16 * (jb & 1))) & 0xFFFFu; }
#pragma unroll
                for (int k4 = 0; k4 < 4; ++k4) { const int jb = lane + 64 * k4; const unsigned mk = mk4[k4];
                    const unsigned long long bal = __ballot(mk != 0u); const int pos = nblk + __popcll(bal & ((1ull << lane) - 1ull)); if (mk != 0u) bl32[pos] = (unsigned)jb | (mk << 8); nblk += __popcll(bal); }
                AttnState hs[4]; bf16x8 hq[4][2];
#pragma unroll
                for (int cg = 0; cg < 4; ++cg) { const bf16_t* qp = Q + ((size_t)b * S + t0 + 4 * cg + tokl) * D + (g * 4 + hd) * 64 + 8 * rq; hq[cg][0] = ld8(qp); hq[cg][1] = ld8(qp + 32); attn_init(hs[cg]); }
                auto wrd_of = [&](int ci) { return (unsigned)__builtin_amdgcn_readfirstlane((int)bl32[ci >> 1]); };
                const int tb = t0;
                attn_chunksN<4>(hs, hq, nblk * 2,
                    [&](int ci) { return ks_b + (size_t)((int)(wrd_of(ci) & 255u) * 2 + (ci & 1)) * 2048; },
                    [&](int ci) { return vs_b + (size_t)((int)(wrd_of(ci) & 255u) * 2 + (ci & 1)) * 2048; },
                    [&](int cg, int ci) { return ((wrd_of(ci) >> (8 + 4 * cg)) & 15u) != 0u; },
                    [&](int cg, int ci) { const unsigned wd = wrd_of(ci); const int jb = (int)(wd & 255u); return ((wd >> (8 + 4 * cg)) & 15u) == 15u && jb * 64 + (ci & 1) * 32 + 31 <= tb + 4 * cg; },
                    [&](int cg, int ci) { const unsigned wd = wrd_of(ci); const int jb = (int)(wd & 255u); const unsigned mk = wd >> 8; const int tok = 4 * cg + tokl; const int kp0 = jb * 64 + (ci & 1) * 32 + 4 * rq;
                        return krange(0, ((mk >> tok) & 1u) ? (tb + tok - kp0) : -1); });
#pragma unroll
                for (int cg = 0; cg < 4; ++cg) { const int tok = 4 * cg + tokl;
                    const float lt = colsum(hs[cg].l); const float inv = (hs[cg].m > -1e29f && lt > 0.f) ? 1.0f / lt : 0.f;
                    const float gsv = gates[((size_t)b * S + t0 + tok) * 48 + g * 12 + hd * 3 + 1] * inv;
#pragma unroll
                    for (int d = 0; d < 4; ++d)
#pragma unroll
                        for (int i = 0; i < 4; ++i) tl[(hd * 16 + d * 4 + i) * 64 + tok + 16 * rq] += hs[cg].o[d][i] * gsv; }
            }
        }
        {
            int lo = t0 - 511; if (lo < 0) lo = 0; const int c0 = lo >> 5, c1 = (t0 + 15) >> 5;
            const bf16_t* kw_b = KF + (size_t)2 * KF_STRIDE + (size_t)bg * S * 64 + (size_t)col * 64 + 8 * rq;
            const bf16_t* vw_b = VF + (size_t)1 * KF_STRIDE + (size_t)bg * S * 64 + (size_t)col * 32 + 8 * rq;
            {
                AttnState gs[4]; bf16x8 gq[4][2];
#pragma unroll
                for (int h = 0; h < 4; ++h) { gq[h][0] = ld8(qrow + h * 64); gq[h][1] = ld8(qrow + h * 64 + 32); attn_init(gs[h]); }
                attn_chunksN<4>(gs, gq, c1 - c0 + 1,
                    [&](int ci) { return kw_b + (size_t)(c0 + ci) * 2048; }, [&](int ci) { return vw_b + (size_t)(c0 + ci) * 2048; },
                    [&](int, int) { return true; },
                    [&](int, int ci) { return (c0 + ci) * 32 + 31 <= t0 && (c0 + ci) * 32 + 512 > t0 + 15; },
                    [&](int, int ci) { const int cb = (c0 + ci) * 32 + 4 * rq; return krange(t - 511 - cb, t - cb); });
#pragma unroll
                for (int h = 0; h < 4; ++h) { const float lt = colsum(gs[h].l); const float inv = (gs[h].m > -1e29f && lt > 0.f) ? 1.0f / lt : 0.f; const float gwv = grow[h * 3 + 2] * inv;
#pragma unroll
                    for (int d = 0; d < 4; ++d)
#pragma unroll
                        for (int i = 0; i < 4; ++i) tl[(h * 16 + d * 4 + i) * 64 + lane] += gs[h].o[d][i] * gwv; }
            }
        }
#pragma unroll
        for (int h = 0; h < 4; ++h)
#pragma unroll
            for (int d = 0; d < 4; ++d) { float v4[4];
#pragma unroll
                for (int i = 0; i < 4; ++i) v4[i] = tl[(h * 16 + d * 4 + i) * 64 + lane];
                u32x2 w; w.x = cvt_pk_bf16(v4[0], v4[1]); w.y = cvt_pk_bf16(v4[2], v4[3]);
                *(u32x2*)(OUT + rowq * D + (g * 4 + h) * 64 + d * 16 + 4 * rq) = w; }
    }
}

#define XB_TMO      128
#define XB_XCNT(j)  (256  + 64 * (j))
#define XB_XSUB(j)  (1280 + 64 * (j))
#define XB_XGEN(j)  (2304 + 64 * (j))
#define XB_TOP      3328
#define XB_TOPGEN   3392
#define XCD_BAR_WORDS 3456
#define XB_SPIN_CAP (1u << 22)
__device__ __forceinline__ unsigned xb_ld(unsigned* p)              { return __hip_atomic_load(p, __ATOMIC_RELAXED, __HIP_MEMORY_SCOPE_AGENT); }
__device__ __forceinline__ unsigned xb_add(unsigned* p, unsigned v) { return __hip_atomic_fetch_add(p, v, __ATOMIC_RELAXED, __HIP_MEMORY_SCOPE_AGENT); }
__device__ __forceinline__ unsigned xb_xcc_id() { return (unsigned)__builtin_amdgcn_s_getreg((3 << 11) | 20) & 0xFu; }
#define XB_SPIN(cond, bar) do { unsigned _sp = 0; while (cond) { __builtin_amdgcn_s_sleep(1); \
    if ((++_sp & 255u) == 0u) { if (xb_ld(&(bar)[XB_TMO])) break; if (_sp > XB_SPIN_CAP) { atomicAdd(&(bar)[XB_TMO], 1u); break; } } } } while (0)
struct XcdBarrier { unsigned* bar; unsigned x; volatile LAS unsigned* st; };
__device__ __forceinline__ void xcd_barrier_complete(unsigned* bar, unsigned x, unsigned& nloc, unsigned& nx) {
    const unsigned Gn = gridDim.x * gridDim.y * gridDim.z;
    unsigned sum, cnt, mine, sp = 0u;
    for (;;) {
        sum = 0u; cnt = 0u; mine = 0u;
#pragma unroll
        for (unsigned j = 0; j < 16; ++j) { const unsigned c = xb_ld(&bar[XB_XCNT(j)]); sum += c; cnt += (c > 0u) ? 1u : 0u; mine = (j == x) ? c : mine; }
        if (sum == Gn) break;
        __builtin_amdgcn_s_sleep(1);
        if ((++sp & 255u) == 0u) { if (xb_ld(&bar[XB_TMO])) break; if (sp > XB_SPIN_CAP) { atomicAdd(&bar[XB_TMO], 1u); break; } }
    }
    nloc = mine > 0u ? mine : 1u; nx = cnt > 0u ? cnt : 1u;
}
__device__ __forceinline__ void xcd_barrier(const XcdBarrier& b, bool leader) {
    asm volatile("s_waitcnt vmcnt(0)" ::: "memory");
    __syncthreads();
    if (leader) {
        unsigned* bar = b.bar;
        __builtin_amdgcn_s_waitcnt(0);
        unsigned nloc = b.st[0], nx = b.st[1];
        if (nloc == 0u) { xcd_barrier_complete(bar, b.x, nloc, nx); b.st[0] = nloc; b.st[1] = nx; }
        const unsigned old = xb_add(&bar[XB_XSUB(b.x)], 1u);
        const unsigned gen = old / nloc;
        if (old + 1u == (gen + 1u) * nloc) {
            __builtin_amdgcn_fence(__ATOMIC_RELEASE, "agent");
            asm volatile("s_waitcnt vmcnt(0)" ::: "memory");
            const unsigned og = xb_add(&bar[XB_TOP], 1u);
            const unsigned tg = og / nx;
            if (og + 1u == (tg + 1u) * nx) xb_add(&bar[XB_TOPGEN], 1u);
            else XB_SPIN(xb_ld(&bar[XB_TOPGEN]) == tg, bar);
            __builtin_amdgcn_fence(__ATOMIC_ACQUIRE, "agent");
            xb_add(&bar[XB_XGEN(b.x)], 1u);
            asm volatile("s_waitcnt vmcnt(0)" ::: "memory");
        } else {
            XB_SPIN(xb_ld(&bar[XB_XGEN(b.x)]) == gen, bar);
            __builtin_amdgcn_fence(__ATOMIC_ACQUIRE, "agent");
            asm volatile("s_waitcnt vmcnt(0)" ::: "memory");
        }
    }
    __syncthreads();
}
#define GSYNC() xcd_barrier(xbar, wave == 0 && lane_id() == 0)

__global__ void __launch_bounds__(NTHREADS, 2) fwd_kernel(Params P) {
    extern __shared__ __attribute__((aligned(16))) unsigned char lds_raw[];
    LAS unsigned char* lds = (LAS unsigned char*)lds_raw;
    cg::grid_group grid = cg::this_grid();
    int tidv = threadIdx.x;
    const int wave = __builtin_amdgcn_readfirstlane(tidv >> 6);
    const int G = gridDim.x, gw_k = blockIdx.x * NWAVES + wave, NGW = G * NWAVES;
    unsigned char* ws = P.ws;
    float* xres = P.out;
    LAS float* scr = (LAS float*)(lds + wave * 16384);
    const float* x_in = P.in[0];
    const float* norm_mix = P.in[1]; const float* norm_mlp = P.in[2]; const float* norm_final = P.in[3];
    const float* mlp_w1 = P.in[4]; const float* mlp_w2 = P.in[5];

    XcdBarrier xbar; xbar.bar = (unsigned*)(ws + WS_BAR); xbar.x = xb_xcc_id(); xbar.st = (volatile LAS unsigned*)(lds + 147456);
    if (tidv < 2) xbar.st[tidv] = 0u;
    if (tidv == 0) (void)xb_add(&xbar.bar[XB_XCNT(xbar.x)], 1u);
    __syncthreads();
    grid.sync();
    for (int layer = 0; layer < 4; ++layer) {
        int lane = tidv; asm volatile("" : "+v"(lane)); lane &= 63;
        int gw = gw_k; asm volatile("" : "+s"(gw));
        const bool is_rwkv = (layer & 1) != 0; const int lj = layer >> 1;
        const float* xsrc = (layer == 0) ? x_in : xres;
        {
            TJob j1{mlp_w1 + (size_t)layer * D * FF, FF, 0, FF, D, (bf16_t*)(ws + WS_W + W_MLP1), D, 0, 0, FF, D, nullptr, 0};
            transpose_job(j1, scr, gw, NGW, lane);
            TJob j2{mlp_w2 + (size_t)layer * FF * D, D, 0, D, FF, (bf16_t*)(ws + WS_W + W_MLP2), FF, 0, 0, D, FF, nullptr, 0};
            transpose_job(j2, scr, gw, NGW, lane);
            if (is_rwkv) {
                const float* mix = P.in[14] + (size_t)lj * 6 * D;
                bf16_t* WrT = (bf16_t*)(ws + WS_W + W_RW_IN);
                const float* wrkv = P.in[15] + (size_t)lj * 3 * D * D;
                for (int part = 0; part < 8; ++part) {
                    const float* W; int ldw, Nsrc, mi, r0, Npad;
                    if (part == 0) { W = wrkv; ldw = D; Nsrc = D; mi = 0; r0 = 0; Npad = D; }
                    else if (part == 1) { W = wrkv + (size_t)D * D; ldw = D; Nsrc = D; mi = 2; r0 = 1024; Npad = D; }
                    else if (part == 2) { W = wrkv + (size_t)2 * D * D; ldw = D; Nsrc = D; mi = 3; r0 = 2048; Npad = D; }
                    else if (part == 3) { W = P.in[17] + (size_t)lj * D * 64; ldw = 64; Nsrc = 64; mi = 1; r0 = 3072; Npad = 128; }
                    else if (part == 4) { W = P.in[20] + (size_t)lj * D * 64; ldw = 64; Nsrc = 64; mi = 4; r0 = 3200; Npad = 128; }
                    else if (part == 5) { W = P.in[22] + (size_t)lj * D * 160; ldw = 160; Nsrc = 160; mi = 5; r0 = 3328; Npad = 256; }
                    else if (part == 6) { W = P.in[31]; ldw = 32; Nsrc = (lj >= 1) ? 32 : 0; mi = 3; r0 = 3584; Npad = 128; }
                    else { W = P.in[31]; ldw = 32; Nsrc = 0; mi = 3; r0 = 3712; Npad = 128; }
                    TJob ja{W, ldw, 0, Nsrc, D, WrT, 2048, r0, 0, Npad, D, mix + mi * D, 1};
                    transpose_job(ja, scr, gw, NGW, lane);
                    TJob jb{W, ldw, 0, Nsrc, D, WrT, 2048, r0, 1024, Npad, D, mix + mi * D, 2};
                    transpose_job(jb, scr, gw, NGW, lane);
                }
                TJob jw{P.in[18] + (size_t)lj * 64 * D, D, 0, D, 64, (bf16_t*)(ws + WS_W + W_RW_W2), 128, 0, 0, D, 128, nullptr, 0}; transpose_job(jw, scr, gw, NGW, lane);
                TJob jaa{P.in[21] + (size_t)lj * 64 * D, D, 0, D, 64, (bf16_t*)(ws + WS_W + W_RW_A2), 128, 0, 0, D, 128, nullptr, 0}; transpose_job(jaa, scr, gw, NGW, lane);
                TJob jv{P.in[32], D, 0, D, (lj >= 1) ? 32 : 0, (bf16_t*)(ws + WS_W + W_RW_V2), 128, 0, 0, D, 128, nullptr, 0}; transpose_job(jv, scr, gw, NGW, lane);
                TJob jg{P.in[23] + (size_t)lj * 160 * D, D, 0, D, 160, (bf16_t*)(ws + WS_W + W_RW_G2), 256, 0, 0, D, 256, nullptr, 0}; transpose_job(jg, scr, gw, NGW, lane);
                TJob jo{P.in[29] + (size_t)lj * D * D, D, 0, D, D, (bf16_t*)(ws + WS_W + W_RW_O), D, 0, 0, D, D, nullptr, 0}; transpose_job(jo, scr, gw, NGW, lane);
                bf16_t* HN = (bf16_t*)(ws + A_HN);
                if (gw < 2) { u32x4* z = (u32x4*)(HN + (size_t)gw * (S + 1) * D); unsigned zz; asm volatile("v_mov_b32 %0, 0" : "=v"(zz)); for (int q = lane; q < D / 8; q += 64) z[q] = (u32x4){zz, zz, zz, zz}; }
                for (int m = gw; m < M; m += NGW) { const int b = m / S; rms_row_bf16(xsrc + (size_t)m * D, norm_mix + layer * D, HN + ((size_t)m + b + 1) * D, nullptr, lane); }
            } else {
                const float* win = P.in[6] + (size_t)lj * D * 2608;
                bf16_t* WnT = (bf16_t*)(ws + WS_W + W_NSA_IN); bf16_t* WvT = (bf16_t*)(ws + WS_W + W_NSA_V);
                for (int part = 0; part < 8; ++part) {
                    int n0src, Nsrc, r0, Npad; bf16_t* WT = WnT;
                    if (part == 0) { n0src = 0; Nsrc = 1024; r0 = 0; Npad = 1024; }
                    else if (part == 1) { n0src = 1024; Nsrc = 256; r0 = 1024; Npad = 256; }
                    else if (part == 2) { n0src = 1024 + 512; Nsrc = 256; r0 = 1280; Npad = 256; }
                    else if (part == 3) { n0src = 1024 + 1024; Nsrc = 256; r0 = 1536; Npad = 256; }
                    else if (part == 4) { n0src = 1024 + 256; Nsrc = 256; r0 = 1792; Npad = 256; }
                    else if (part == 5) { n0src = 2560; Nsrc = 48; r0 = 2048; Npad = 256; }
                    else if (part == 6) { n0src = 1024 + 768; Nsrc = 256; r0 = 0; Npad = 256; WT = WvT; }
                    else { n0src = 1024 + 1280; Nsrc = 256; r0 = 256; Npad = 256; WT = WvT; }
                    TJob jn{win, 2608, n0src, Nsrc, D, WT, D, r0, 0, Npad, D, nullptr, 0}; transpose_job(jn, scr, gw, NGW, lane);
                }
                TJob jo{P.in[13] + (size_t)lj * D * D, D, 0, D, D, (bf16_t*)(ws + WS_W + W_NSA_O), D, 0, 0, D, D, nullptr, 0}; transpose_job(jo, scr, gw, NGW, lane);
                TJob jc1k{P.in[8] + (size_t)lj * 2048 * 256, 256, 0, 256, 2048, (bf16_t*)(ws + WS_W + W_C1K), 2048, 0, 0, 256, 2048, nullptr, 0}; transpose_job(jc1k, scr, gw, NGW, lane);
                TJob jc1v{P.in[11] + (size_t)lj * 2048 * 256, 256, 0, 256, 2048, (bf16_t*)(ws + WS_W + W_C1V), 2048, 0, 0, 256, 2048, nullptr, 0}; transpose_job(jc1v, scr, gw, NGW, lane);
                TJob jc2k{P.in[9] + (size_t)lj * 256 * 64, 64, 0, 64, 256, (bf16_t*)(ws + WS_W + W_C2K), 256, 0, 0, 256, 256, nullptr, 0}; transpose_job(jc2k, scr, gw, NGW, lane);
                TJob jc2v{P.in[12] + (size_t)lj * 256 * 64, 64, 0, 64, 256, (bf16_t*)(ws + WS_W + W_C2V), 256, 0, 0, 256, 256, nullptr, 0}; transpose_job(jc2v, scr, gw, NGW, lane);
                {
                    int ln = lane; asm volatile("" : "+v"(ln));
                    float* cb = (float*)(ws + WS_W + W_CBIAS);
#pragma unroll 1
                    for (int o = gw; o < 512; o += NGW) { const int isv = o >> 8, c = o & 255;
                        const float* pe = (isv ? P.in[10] : P.in[7]) + (size_t)lj * 2048; const float* w1 = (isv ? P.in[11] : P.in[8]) + (size_t)lj * 2048 * 256;
                        float acc = 0.f;
#pragma unroll 1
                        for (int k = ln; k < 2048; k += 64) acc += pe[k] * w1[(size_t)k * 256 + c];
                        acc = wave_sum(acc); if (ln == 0) cb[o] = acc; }
                    if (layer == 0) {
                        float* rt = (float*)(ws + WS_ROPE);
                        int tix = tidv; asm volatile("" : "+v"(tix)); const int gt = (int)blockIdx.x * NTHREADS + tix;
#pragma unroll 1
                        for (int e = gt; e < S * 8; e += G * NTHREADS) { const int tt = e >> 3, i = e & 7;
                            const float invf = (i == 0) ? 1.0f : (i == 1) ? 0.1939227432012558f : (i == 2) ? 0.03760603070259094f : (i == 3) ? 0.007292664609849453f : (i == 4) ? 0.0014142135623842478f : (i == 5) ? 0.00027424818836152554f : (i == 6) ? 5.318296098266728e-05f : 1.0313386155758053e-05f;
                            const float ang = (float)tt * invf; const double rev = (double)ang * 0.15915494309189535; const float fr = (float)(rev - __builtin_rint(rev));
                            rt[tt * 16 + i] = __builtin_amdgcn_cosf(fr); rt[tt * 16 + 8 + i] = __builtin_amdgcn_sinf(fr); }
                    }
                }
                for (int m = gw; m < M; m += NGW) rms_row_bf16(xsrc + (size_t)m * D, norm_mix + layer * D, (bf16_t*)(ws + A_HN) + (size_t)m * D, (layer == 0) ? xres + (size_t)m * D : nullptr, lane);
            }
        }
        GSYNC();
        if (!is_rwkv) {
            bf16_t* HN = (bf16_t*)(ws + A_HN); bf16_t* Qb = (bf16_t*)(ws + A_Q); bf16_t* KFb = (bf16_t*)(ws + A_KF); bf16_t* VFb = (bf16_t*)(ws + A_VF);
            float* GT = (float*)(ws + A_GATES); bf16_t* CHK = (bf16_t*)(ws + A_CHK); bf16_t* CHV = (bf16_t*)(ws + A_CHV); bf16_t* KCb = (bf16_t*)(ws + A_KC); bf16_t* VCb = (bf16_t*)(ws + A_VC);
            {
                pg8::Gemm g{HN, (const bf16_t*)(ws + WS_W + W_NSA_IN), M, 2304, D, D, D, 0};
                pg8::StaticOrder so; so.init(M, 2304, G, (int)blockIdx.x);
                pg8::EpiP<FNsaIn> E{FNsaIn{Qb, KFb, GT, (const float*)(ws + WS_ROPE)}};
                pg8::gemm_phase<pg8::EpiP<FNsaIn>, true>(lds, g, so, E, tidv);
                pg8::Gemm g2{(const bf16_t*)(ws + WS_W + W_NSA_V), HN, 512, M, D, D, D, 0};
                pg8::StaticOrder so2; so2.init(512, M, G, (int)blockIdx.x);
                pg8::EpiP<FNsaVT> E2{FNsaVT{VFb}};
                pg8::gemm_phase<pg8::EpiP<FNsaVT>, true>(lds, g2, so2, E2, tidv);
            }
            GSYNC();
            {
                pg8::StaticOrder so; so.init(8192, 256, G, (int)blockIdx.x);
                pg8::StaticOrder sov; sov.init(8192, 256, G, (int)((blockIdx.x + G - G / 2) % G));
                { pg8::Gemm g{KFb, (const bf16_t*)(ws + WS_W + W_C1K), 8192, 256, 2048, 1024, 2048, 0}; pg8::EpiP<FCmp1> E{FCmp1{CHK, (const float*)(ws + WS_W + W_CBIAS)}}; pg8::gemm_phase<pg8::EpiP<FCmp1>, true>(lds, g, so, E, tidv); }
                { pg8::Gemm g{KFb + 3 * KF_STRIDE, (const bf16_t*)(ws + WS_W + W_C1V), 8192, 256, 2048, 1024, 2048, 0}; pg8::EpiP<FCmp1> E{FCmp1{CHV, (const float*)(ws + WS_W + W_CBIAS) + 256}}; pg8::gemm_phase<pg8::EpiP<FCmp1>, true>(lds, g, sov, E, tidv); }
            }
            GSYNC();
            {
                { pg8::StaticOrder so; so.init(8192, 256, G, (int)blockIdx.x); pg8::Gemm g{CHK, (const bf16_t*)(ws + WS_W + W_C2K), 8192, 256, 256, 256, 256, 0}; pg8::EpiP<FCmp2K> E{FCmp2K{KCb}}; pg8::gemm_phase<pg8::EpiP<FCmp2K>, true>(lds, g, so, E, tidv); }
                { pg8::StaticOrder so; so.init(256, 8192, G, (int)((blockIdx.x + G - G / 2) % G)); pg8::Gemm g{(const bf16_t*)(ws + WS_W + W_C2V), CHV, 256, 8192, 256, 256, 256, 0}; pg8::EpiP<FCmp2VT> E{FCmp2VT{VCb}}; pg8::gemm_phase<pg8::EpiP<FCmp2VT>, true>(lds, g, so, E, tidv); }
            }
            GSYNC();
            nsa_attention(Qb, KFb, VFb, KCb, VCb, GT, HN, lds, G, wave, lane_id());
            tidv = wave * 64 + (lane_id() & 63); asm volatile("" : "+v"(tidv)); tidv &= 511; lane = tidv & 63;
            GSYNC();
            {
                pg8::StaticOrder so; so.init(M, D, G, (int)blockIdx.x);
                pg8::Gemm g{HN, (const bf16_t*)(ws + WS_W + W_NSA_O), M, D, D, D, D, 0}; pg8::EpiN<FResAdd> E{FResAdd{xres}}; pg8::gemm_phase<pg8::EpiN<FResAdd>, true>(lds, g, so, E, tidv);
            }
            GSYNC();
        }
        if (is_rwkv) {
            h16* Rb = (h16*)(ws + A_R); h16* Kb = (h16*)(ws + A_K); h16* Ab = (h16*)(ws + A_A); h16* EWb = (h16*)(ws + A_HN);
            h16* Vb = (lj == 0) ? (h16*)(ws + WS_VF) : (h16*)(ws + A_V2);
            h16* Yraw = (lj == 0) ? (h16*)(ws + A_V2) : (h16*)(ws + WS_VF);
            bf16_t* LH = (bf16_t*)(ws + A_LH);
            {
                pg8::Gemm g{(const bf16_t*)(ws + A_HN), (const bf16_t*)(ws + WS_W + W_RW_IN), M, 3840, 2048, D, 2048, 1};
                pg8::StaticOrder so; so.init(M, 3840, G, (int)blockIdx.x);
                pg8::EpiP<FRwIn> E{FRwIn{Rb, Kb, Vb, LH}};
                pg8::gemm_phase<pg8::EpiP<FRwIn>, true>(lds, g, so, E, tidv);
            }
            GSYNC();
            {
                pg8::StaticOrder so; so.init(M, D, G, (int)blockIdx.x);
                { pg8::Gemm g{LH, (const bf16_t*)(ws + WS_W + W_RW_W2), M, D, 128, 768, 128, 0}; pg8::EpiP<FLoraW> E{FLoraW{EWb, P.in[16] + lj * D}}; pg8::gemm_phase<pg8::EpiP<FLoraW>, true>(lds, g, so, E, tidv); }
                { pg8::Gemm g{LH + 128, (const bf16_t*)(ws + WS_W + W_RW_A2), M, D, 128, 768, 128, 0}; pg8::EpiP<FLoraA> E{FLoraA{Ab, P.in[19] + lj * D}}; pg8::gemm_phase<pg8::EpiP<FLoraA>, true>(lds, g, so, E, tidv); }
                if (lj >= 1) { pg8::Gemm g{LH + 512, (const bf16_t*)(ws + WS_W + W_RW_V2), M, D, 128, 768, 128, 0}; pg8::EpiP<FLoraV> E{FLoraV{Vb, (const h16*)(ws + WS_VF), P.in[30]}}; pg8::gemm_phase<pg8::EpiP<FLoraV>, true>(lds, g, so, E, tidv); }
            }
            GSYNC();
            rwkv_scan2(Rb, Kb, Vb, EWb, Ab, P.in[24] + lj * D, P.in[25] + lj * D, Yraw, lds, wave, lane);
            GSYNC();
            rwkv_gn(Rb, Kb, Vb, Ab, Yraw, P.in[25] + lj * D, P.in[26] + lj * D, P.in[27] + lj * D, P.in[28] + lj * D, gw, NGW, lane);
            GSYNC();
            {
                pg8::StaticOrder so; so.init(M, D, G, (int)blockIdx.x);
                pg8::Gemm g{LH + 256, (const bf16_t*)(ws + WS_W + W_RW_G2), M, D, 256, 768, 256, 0}; pg8::EpiP<FGate> E{FGate{(bf16_t*)Kb, Rb}}; pg8::gemm_phase<pg8::EpiP<FGate>, true>(lds, g, so, E, tidv);
            }
            GSYNC();
            {
                pg8::StaticOrder so; so.init(M, D, G, (int)blockIdx.x);
                pg8::Gemm g{(const bf16_t*)Kb, (const bf16_t*)(ws + WS_W + W_RW_O), M, D, D, D, D, 0}; pg8::EpiN<FResAdd> E{FResAdd{xres}}; pg8::gemm_phase<pg8::EpiN<FResAdd>, true>(lds, g, so, E, tidv);
            }
            GSYNC();
        }
        for (int m = gw; m < M; m += NGW) rms_row_bf16(xres + (size_t)m * D, norm_mlp + layer * D, (bf16_t*)(ws + A_HN) + (size_t)m * D, nullptr, lane);
        GSYNC();
        {
            pg8::Gemm g{(const bf16_t*)(ws + A_HN), (const bf16_t*)(ws + WS_W + W_MLP1), M, FF, D, D, D, 0};
            pg8::StaticOrder so; so.init(M, FF, G, (int)blockIdx.x);
            pg8::EpiP<FRelu2> E{FRelu2{(bf16_t*)(ws + A_HID)}};
            pg8::gemm_phase<pg8::EpiP<FRelu2>, true>(lds, g, so, E, tidv);
        }
        GSYNC();
        {
            pg8::Gemm g{(const bf16_t*)(ws + A_HID), (const bf16_t*)(ws + WS_W + W_MLP2), M, D, FF, FF, FF, 0};
            pg8::StaticOrder so; so.init(M, D, G, (int)blockIdx.x);
            pg8::EpiN<FResAdd> E{FResAdd{xres}};
            pg8::gemm_phase<pg8::EpiN<FResAdd>, true>(lds, g, so, E, tidv);
        }
        GSYNC();
    }
    for (int m = gw_k; m < M; m += NGW) {
        int lane2 = tidv; asm volatile("" : "+v"(lane2)); lane2 &= 63;
        f32x4* xr = (f32x4*)(xres + (size_t)m * D) + lane2; const f32x4* gr = (const f32x4*)norm_final + lane2;
        f32x4 v[4]; float s = 0.f;
#pragma unroll
        for (int j = 0; j < 4; ++j) { v[j] = xr[64 * j]; s += (v[j].x * v[j].x + v[j].y * v[j].y) + (v[j].z * v[j].z + v[j].w * v[j].w); }
        const float r = rsqrtf(wave_sum(s) * (1.f / D) + 1e-5f);
#pragma unroll
        for (int j = 0; j < 4; ++j) { const f32x4 gg = gr[64 * j]; xr[64 * j] = v[j] * r * gg; }
    }
}

extern "C" void kernel_launch(void* const* d_in, const int* in_sizes, int n_in, void* d_out, int out_size, void* d_ws, size_t ws_size, hipStream_t stream) {
    static int grid = 0;
    if (grid == 0) {
        if (n_in != 33 || out_size != M * D || ws_size < WS_NEED) { fprintf(stderr, "kernel_launch: unexpected sizes n_in %d out %d ws %zu (need %zu)\n", n_in, out_size, ws_size, (size_t)WS_NEED); grid = -1; return; }
        int dev = 0, cus = 0, per_cu = 0;
        hipGetDevice(&dev);
        hipDeviceGetAttribute(&cus, hipDeviceAttributeMultiprocessorCount, dev);
        if (hipFuncSetAttribute((const void*)fwd_kernel, hipFuncAttributeMaxDynamicSharedMemorySize, LDS_BYTES) != hipSuccess) { fprintf(stderr, "hipFuncSetAttribute failed\n"); grid = -1; return; }
        hipOccupancyMaxActiveBlocksPerMultiprocessor(&per_cu, (const void*)fwd_kernel, NTHREADS, LDS_BYTES);
        if (per_cu < 1) { fprintf(stderr, "occupancy query returned %d\n", per_cu); per_cu = 1; }
        (void)hipGetLastError();
        grid = cus * 1;
    }
    if (grid < 0) return;
    if (hipMemsetAsync((char*)d_ws + WS_BAR, 0, 16384, stream) != hipSuccess) { fprintf(stderr, "hipMemsetAsync of the barrier words failed\n"); return; }
    Params p{};
    for (int i = 0; i < 33; ++i) p.in[i] = (const float*)d_in[i];
    p.out = (float*)d_out; p.ws = (unsigned char*)d_ws;
    void* args[] = {&p};
    hipError_t e = hipLaunchCooperativeKernel((const void*)fwd_kernel, dim3(grid), dim3(NTHREADS), args, LDS_BYTES, stream);
    if (e != hipSuccess) fprintf(stderr, "cooperative launch failed: %s (grid %d)\n", hipGetErrorString(e), grid);
}
```

```cpp
#include <hip/hip_runtime.h>
#include <hip/hip_cooperative_groups.h>
#include <cstdio>
#include <cstdint>
namespace cg = cooperative_groups;

#define LAS __attribute__((address_space(3)))
typedef unsigned short bf16_t;
typedef short bf16x8 __attribute__((ext_vector_type(8)));
typedef float f32x4 __attribute__((ext_vector_type(4)));
typedef float f32x2 __attribute__((ext_vector_type(2)));
typedef unsigned u32x4 __attribute__((ext_vector_type(4)));
typedef unsigned u32x2 __attribute__((ext_vector_type(2)));
typedef _Float16 h16;
typedef _Float16 h16x2 __attribute__((ext_vector_type(2)));

constexpr int S = 16384, NB = 2, M = NB * S, D = 1024, FF = 4096;
constexpr int NWAVES = 8, NTHREADS = 512;
constexpr int LDS_BYTES = 147456 + 64;
constexpr size_t MiB = 1u << 20;
constexpr size_t WS_W = 0;
constexpr size_t W_MLP1 = 0, W_MLP2 = 8 * MiB;
constexpr size_t W_NSA_IN = 16 * MiB, W_NSA_V = 21 * MiB, W_NSA_O = 22 * MiB, W_C1K = 24 * MiB, W_C1V = 25 * MiB, W_C2K = 26 * MiB, W_C2V = 26 * MiB + 256 * 1024, W_CBIAS = 26 * MiB + 512 * 1024;
constexpr size_t W_RW_IN = 16 * MiB, W_RW_W2 = 31 * MiB, W_RW_A2 = 31 * MiB + 256 * 1024, W_RW_V2 = 31 * MiB + 512 * 1024, W_RW_G2 = 31 * MiB + 768 * 1024, W_RW_O = 33 * MiB;
constexpr size_t WS_ROPE = 36 * MiB;
constexpr size_t WS_BAR = 38 * MiB;
constexpr size_t WS_VF = 40 * MiB;
constexpr size_t ACT = 104 * MiB;
constexpr size_t A_HN = ACT;
constexpr size_t A_Q = ACT + 65 * MiB;
constexpr size_t A_KF = ACT + 129 * MiB;
constexpr size_t A_VF = ACT + 194 * MiB;
constexpr size_t A_GATES = ACT + 226 * MiB;
constexpr size_t A_CHK = ACT + 233 * MiB, A_CHV = ACT + 237 * MiB, A_KC = ACT + 241 * MiB, A_VC = ACT + 242 * MiB;
constexpr size_t A_HID = ACT + 65 * MiB;
constexpr size_t A_R = ACT + 65 * MiB, A_K = ACT + 129 * MiB, A_V2 = ACT + 193 * MiB, A_A = ACT + 257 * MiB, A_LH = ACT + 321 * MiB;
constexpr size_t WS_NEED = ACT + 370 * MiB;

__device__ __forceinline__ int lane_id() { return (int)__builtin_amdgcn_mbcnt_hi(~0u, __builtin_amdgcn_mbcnt_lo(~0u, 0u)); }
__device__ __forceinline__ unsigned cvt_pk_bf16(float lo, float hi) { unsigned r; asm volatile("v_cvt_pk_bf16_f32 %0, %1, %2" : "=v"(r) : "v"(lo), "v"(hi)); return r; }
__device__ __forceinline__ unsigned pk_h16(float lo, float hi) { h16x2 v; v.x = (h16)lo; v.y = (h16)hi; return __builtin_bit_cast(unsigned, v); }
__device__ __forceinline__ float bf2f(bf16_t b) { return __uint_as_float(((unsigned)b) << 16); }
__device__ __forceinline__ float wave_sum(float v) {
#pragma unroll
    for (int o = 1; o < 64; o <<= 1) v += __shfl_xor(v, o);
    return v;
}
__device__ __forceinline__ float sigmoidf_(float x) { return 1.0f / (1.0f + __expf(-x)); }
__device__ __forceinline__ float tanhf_(float x) { float e = __expf(-2.0f * fabsf(x)); float t = (1.0f - e) / (1.0f + e); return x < 0.f ? -t : t; }

namespace pg8 {
constexpr int BM = 256, BK = 64, HALF = 128, HTB = HALF * BK * 2, STAGE_BYTES = 8 * HTB, NXCD = 8, WGM = 8;
__host__ __device__ __forceinline__ int lds_byte(int r, int c) { const int st = (r >> 4) * 2 + (c >> 5), rr = r & 15, cc = c & 31, ob = rr * 64 + cc * 2; return st * 1024 + (ob ^ (((ob >> 9) & 1) << 5)); }
__host__ __device__ __forceinline__ void stage_rc(int b, int& R, int& C) { const int st = b / 1024, sb = b % 1024, swz = sb ^ (((sb >> 9) & 1) << 5); R = (st >> 1) * 16 + swz / 64; C = (st & 1) * 32 + (swz % 64) / 2; }
__host__ __device__ __forceinline__ int perm32(int rho) { const int n = rho >> 4, i = rho & 15; return 8 * (i >> 2) + 4 * n + (i & 3); }
struct Unit { int pm, pn; };
struct Gemm { const bf16_t* A; const bf16_t* Bt; int M, N, K, lda, ldb, amode; };
struct StaticOrder {
    int nM, nN, nwg, G, c;
    __device__ void init(int M_, int N_, int G_, int c_) { nM = M_ / BM; nN = N_ / BM; nwg = nM * nN; G = G_; c = c_; }
    __device__ bool next(int i, Unit& u) const {
        const long L = (long)i * G + c; if (L >= nwg) return false;
        int wgid = (int)L; { const int q = nwg / NXCD, r = nwg % NXCD, xcd = wgid % NXCD, off = wgid / NXCD; wgid = (xcd < r ? xcd * (q + 1) : r * (q + 1) + (xcd - r) * q) + off; }
        const int nig = WGM * nN, gid = wgid / nig, fm = gid * WGM, gsz = (nM - fm) < WGM ? (nM - fm) : WGM;
        u.pm = fm + ((wgid % nig) % gsz); u.pn = (wgid % nig) / gsz; return true;
    }
};
__device__ __forceinline__ const char* a_base(const Gemm& g, int pm) { const size_t row = (size_t)pm * BM + (g.amode == 1 ? (size_t)(pm / 64) : 0); return (const char*)g.A + row * (size_t)g.lda * 2; }

template <class Epi, bool ALIGN_EPI>
__device__ __forceinline__ void gemm_phase(LAS unsigned char* lds, const Gemm g, const StaticOrder& S, const Epi& E, int tid_in) {
    int tid = tid_in; asm volatile("" : "+v"(tid));
    const int wid = __builtin_amdgcn_readfirstlane(tid >> 6), lane = tid & 63, wr = wid >> 2, wc = wid & 3, fr = lane & 15, fq = lane >> 4;
    int K = g.K; asm volatile("" : "+s"(K));
    const int nt = K / BK;
    unsigned voffA[2], voffB[2];
#pragma unroll
    for (int i = 0; i < 2; ++i) { int R, C; stage_rc(tid * 16 + i * 8192, R, C); const int Rb = Epi::PERM ? ((R & ~31) + perm32(R & 31)) : R;
        voffA[i] = (unsigned)(R * g.lda + C) * 2u; voffB[i] = (unsigned)(Rb * g.ldb + C) * 2u; }
    const size_t kstep = (size_t)(BK * 2);
    const size_t hstepA = (size_t)HALF * g.lda * 2, hstepB = (size_t)HALF * g.ldb * 2;
    const size_t tstepB = 2 * hstepB;
    const unsigned ldsw = (unsigned)wid * 1024u;
    const int aoff = lds_byte(wr * 64 + fr, fq * 8), boff = lds_byte(wc * 32 + fr, fq * 8);
#define PG8_SA(b, h) (((b) * 2 + (h)) * HTB)
#define PG8_SB(b, h) ((4 + (b) * 2 + (h)) * HTB)
#define PG8_STAGE(bufoff, gbase, voff) do { _Pragma("unroll") for (int _i = 0; _i < 2; ++_i) \
        __builtin_amdgcn_global_load_lds((const unsigned*)((const char*)(gbase) + (voff)[_i]), (LAS unsigned*)(lds + (bufoff) + ldsw + _i * 8192), 16, 0, 0); } while (0)
#define PG8_LDA(dst, b, h) do { _Pragma("unroll") for (int m = 0; m < 4; ++m) _Pragma("unroll") for (int k = 0; k < 2; ++k) dst[m][k] = *(const LAS bf16x8*)(lds + PG8_SA(b, h) + aoff + m * 2048 + k * 1024); } while (0)
#define PG8_LDB(dst, b, h) do { _Pragma("unroll") for (int n = 0; n < 2; ++n) _Pragma("unroll") for (int k = 0; k < 2; ++k) dst[n][k] = *(const LAS bf16x8*)(lds + PG8_SB(b, h) + boff + n * 2048 + k * 1024); } while (0)
#define PG8_MMA(ai, bj, At, Bt) do { __builtin_amdgcn_s_setprio(1); _Pragma("unroll") for (int m = 0; m < 4; ++m) _Pragma("unroll") for (int n = 0; n < 2; ++n) _Pragma("unroll") for (int k = 0; k < 2; ++k) \
        acc[ai][bj][m][n] = __builtin_amdgcn_mfma_f32_16x16x32_bf16(Bt[n][k], At[m][k], acc[ai][bj][m][n], 0, 0, 0); __builtin_amdgcn_s_setprio(0); } while (0)
#define PG8_WAIT_V(n) asm volatile("s_waitcnt vmcnt(" #n ")" ::: "memory")
#define PG8_WAIT_L(n) asm volatile("s_waitcnt lgkmcnt(" #n ")" ::: "memory")
#define PG8_BAR __builtin_amdgcn_s_barrier()
#define PG8_SCHED __builtin_amdgcn_sched_barrier(0)
    Unit cur, nxt; int ui = 0;
    if (!S.next(0, cur)) return;
    f32x4 acc[2][2][4][2];
#pragma unroll
    for (int a = 0; a < 2; ++a)
#pragma unroll
        for (int b = 0; b < 2; ++b)
#pragma unroll
            for (int m = 0; m < 4; ++m)
#pragma unroll
                for (int n = 0; n < 2; ++n) acc[a][b][m][n] = (f32x4){0.f, 0.f, 0.f, 0.f};
    bf16x8 At[4][2], B0[2][2], B1[2][2];
    const char* cA = a_base(g, cur.pm); const char* cB = (const char*)g.Bt + (size_t)cur.pn * tstepB;
    PG8_STAGE(PG8_SB(0, 0), cB, voffB); PG8_STAGE(PG8_SB(0, 1), cB + hstepB, voffB); PG8_STAGE(PG8_SA(0, 0), cA, voffA); PG8_STAGE(PG8_SA(0, 1), cA + hstepA, voffA);
    if (wr == 1) PG8_BAR;
    PG8_WAIT_V(2); PG8_BAR;
    PG8_STAGE(PG8_SB(1, 0), cB + kstep, voffB); PG8_STAGE(PG8_SA(1, 0), cA + kstep, voffA); PG8_STAGE(PG8_SB(1, 1), cB + hstepB + kstep, voffB);
    PG8_WAIT_V(6); PG8_BAR;
    for (;;) {
        const bool has_next = S.next(ui + 1, nxt);
        const char* nA = has_next ? a_base(g, nxt.pm) : cA; const char* nB = has_next ? (const char*)g.Bt + (size_t)nxt.pn * tstepB : cB;
        for (int t = 0; t < nt; t += 2) {
            const bool last = (t == nt - 2);
            const char* a1 = cA + (size_t)(t + 1) * kstep;
            const char* a2 = last ? nA : cA + (size_t)(t + 2) * kstep; const char* b2 = last ? nB : cB + (size_t)(t + 2) * kstep;
            const char* a3 = a2 + kstep; const char* b3 = b2 + kstep;
            PG8_LDB(B0, 0, 0); PG8_LDB(B1, 0, 1); PG8_SCHED; PG8_LDA(At, 0, 0); PG8_STAGE(PG8_SA(1, 1), a1 + hstepA, voffA);
            PG8_WAIT_V(8); PG8_WAIT_L(0); PG8_BAR; PG8_MMA(0, 0, At, B0); PG8_MMA(0, 1, At, B1); PG8_BAR; PG8_SCHED;
            PG8_LDA(At, 0, 1); PG8_STAGE(PG8_SB(0, 0), b2, voffB); PG8_STAGE(PG8_SB(0, 1), b2 + hstepB, voffB); PG8_STAGE(PG8_SA(0, 0), a2, voffA);
            PG8_WAIT_V(8); PG8_WAIT_L(0); PG8_BAR; PG8_MMA(1, 0, At, B0); PG8_MMA(1, 1, At, B1); PG8_BAR; PG8_SCHED;
            PG8_LDB(B0, 1, 0); PG8_LDB(B1, 1, 1); PG8_SCHED; PG8_LDA(At, 1, 0); PG8_STAGE(PG8_SA(0, 1), a2 + hstepA, voffA);
            PG8_WAIT_V(8); PG8_WAIT_L(0); PG8_BAR; PG8_MMA(0, 0, At, B0); PG8_MMA(0, 1, At, B1); PG8_BAR; PG8_SCHED;
            PG8_LDA(At, 1, 1); PG8_STAGE(PG8_SB(1, 0), b3, voffB); PG8_STAGE(PG8_SB(1, 1), b3 + hstepB, voffB); PG8_STAGE(PG8_SA(1, 0), a3, voffA);
            PG8_WAIT_V(8); PG8_WAIT_L(0); PG8_BAR; PG8_MMA(1, 0, At, B0); PG8_MMA(1, 1, At, B1); PG8_BAR; PG8_SCHED;
        }
        if constexpr (ALIGN_EPI) { if (wr == 0) PG8_BAR; }
        E(acc, cur, wr, wc, fr, fq);
        if (!has_next) break;
#pragma unroll
        for (int a = 0; a < 2; ++a)
#pragma unroll
            for (int b = 0; b < 2; ++b)
#pragma unroll
                for (int m = 0; m < 4; ++m)
#pragma unroll
                    for (int n = 0; n < 2; ++n) acc[a][b][m][n] = (f32x4){0.f, 0.f, 0.f, 0.f};
        cur = nxt; cA = nA; cB = nB; ++ui;
        if constexpr (ALIGN_EPI) { if (wr == 1) PG8_BAR; }
    }
    PG8_WAIT_V(0);
    if constexpr (!ALIGN_EPI) { if (wr == 0) PG8_BAR; }
    PG8_BAR;
#undef PG8_SA
#undef PG8_SB
#undef PG8_STAGE
#undef PG8_LDA
#undef PG8_LDB
#undef PG8_MMA
#undef PG8_WAIT_V
#undef PG8_WAIT_L
#undef PG8_BAR
#undef PG8_SCHED
}
template <class F> struct EpiP {
    static constexpr bool PERM = true; F f;
    __device__ __forceinline__ void operator()(const f32x4 (&acc)[2][2][4][2], const Unit& u, int wr, int wc, int fr, int fq) const {
#pragma unroll
        for (int ai = 0; ai < 2; ++ai)
#pragma unroll
            for (int m = 0; m < 4; ++m) { int row = u.pm * BM + ai * HALF + wr * 64 + m * 16 + fr; asm volatile("" : "+v"(row));
#pragma unroll
                for (int bj = 0; bj < 2; ++bj) { const int col0 = u.pn * BM + bj * HALF + wc * 32 + 8 * fq; f(row, col0, acc[ai][bj][m][0], acc[ai][bj][m][1]); } asm volatile("" ::: "memory"); }
    }
};
template <class F> struct EpiN {
    static constexpr bool PERM = false; F f;
    __device__ __forceinline__ void operator()(const f32x4 (&acc)[2][2][4][2], const Unit& u, int wr, int wc, int fr, int fq) const {
#pragma unroll
        for (int ai = 0; ai < 2; ++ai)
#pragma unroll
            for (int m = 0; m < 4; ++m) { int row = u.pm * BM + ai * HALF + wr * 64 + m * 16 + fr; asm volatile("" : "+v"(row));
#pragma unroll
                for (int bj = 0; bj < 2; ++bj)
#pragma unroll
                    for (int n = 0; n < 2; ++n) { const int col0 = u.pn * BM + bj * HALF + wc * 32 + 16 * n + 4 * fq; f(row, col0, acc[ai][bj][m][n]); } asm volatile("" ::: "memory"); }
    }
};
}

struct Params {
    const float* in[33];
    float* out;
    unsigned char* ws;
};

struct TJob { const float* W; int ldw, n0src, Nsrc, Ksrc; bf16_t* WT; int ldt, row_off, col_off, Npad, Kpad; const float* mix; int mode; };
__device__ __forceinline__ void transpose_job(const TJob& j, LAS float* scr, int gw, int NGW, int lane_) {
    int lane = lane_; asm volatile("" : "+v"(lane));
    const int nblk = j.Npad / 32, kblk = j.Kpad / 64, items = nblk * kblk;
    for (int it = gw; it < items; it += NGW) {
        const int kb = it / nblk, nb = it % nblk, k0 = 64 * kb, n0 = 32 * nb;
#pragma unroll 4
        for (int i = 0; i < 32; ++i) { const int kk = 2 * i + (lane >> 5), n = lane & 31; float v = 0.f;
            if (k0 + kk < j.Ksrc && n0 + n < j.Nsrc) { v = j.W[(size_t)(k0 + kk) * j.ldw + j.n0src + n0 + n];
                if (j.mode == 1) v *= j.mix[k0 + kk]; else if (j.mode == 2) v *= (1.0f - j.mix[k0 + kk]); }
            scr[kk * 33 + n] = v; }
        asm volatile("s_waitcnt lgkmcnt(0)" ::: "memory");
        const int c = lane & 7;
#pragma unroll
        for (int jj = 0; jj < 4; ++jj) { const int n = (lane >> 3) + 8 * jj; const LAS float* s = scr + (8 * c) * 33 + n;
            u32x4 o; o.x = cvt_pk_bf16(s[0 * 33], s[1 * 33]); o.y = cvt_pk_bf16(s[2 * 33], s[3 * 33]); o.z = cvt_pk_bf16(s[4 * 33], s[5 * 33]); o.w = cvt_pk_bf16(s[6 * 33], s[7 * 33]);
            *(u32x4*)(j.WT + (size_t)(j.row_off + n0 + n) * j.ldt + j.col_off + k0 + 8 * c) = o; }
        asm volatile("s_waitcnt lgkmcnt(0)" ::: "memory");
    }
}

__device__ __forceinline__ void rms_row_bf16(const float* xrow, const float* g, bf16_t* orow, float* copy_to, int lane_) {
    int lane = lane_; asm volatile("" : "+v"(lane));
    const f32x4* xr = (const f32x4*)xrow + lane; const f32x4* gr = (const f32x4*)g + lane;
    f32x4 v[4]; float s = 0.f;
#pragma unroll
    for (int j = 0; j < 4; ++j) { v[j] = xr[64 * j]; s += (v[j].x * v[j].x + v[j].y * v[j].y) + (v[j].z * v[j].z + v[j].w * v[j].w); }
    if (copy_to) {
#pragma unroll
        for (int j = 0; j < 4; ++j) ((f32x4*)copy_to + lane)[64 * j] = v[j];
    }
    const float r = rsqrtf(wave_sum(s) * (1.f / D) + 1e-5f);
    u32x2* o8 = (u32x2*)orow + lane;
#pragma unroll
    for (int j = 0; j < 4; ++j) { const f32x4 gg = gr[64 * j]; u32x2 w; w.x = cvt_pk_bf16(v[j].x * r * gg.x, v[j].y * r * gg.y); w.y = cvt_pk_bf16(v[j].z * r * gg.z, v[j].w * r * gg.w); o8[64 * j] = w; }
}

struct FRelu2 { bf16_t* O; __device__ __forceinline__ void operator()(int row, int col0, f32x4 a, f32x4 b) const {
    f32x4 x = a, y = b;
#pragma unroll
    for (int i = 0; i < 4; ++i) { float t = fmaxf(x[i], 0.f); x[i] = t * t; t = fmaxf(y[i], 0.f); y[i] = t * t; }
    u32x4 w; w.x = cvt_pk_bf16(x[0], x[1]); w.y = cvt_pk_bf16(x[2], x[3]); w.z = cvt_pk_bf16(y[0], y[1]); w.w = cvt_pk_bf16(y[2], y[3]);
    *(u32x4*)(O + (size_t)row * FF + col0) = w; } };
struct FResAdd { float* X; __device__ __forceinline__ void operator()(int row, int col0, f32x4 a) const {
    f32x4* p = (f32x4*)(X + (size_t)row * D + col0); *p = *p + a; } };


struct FRwIn { h16* R; h16* Kk; h16* V; bf16_t* LH;
    __device__ __forceinline__ void operator()(int row, int col0, f32x4 a, f32x4 b) const {
        const int seg = __builtin_amdgcn_readfirstlane(col0 >> 10);
        if (seg < 3) { const long dK = (const char*)Kk - (const char*)R, dV = (const char*)V - (const char*)R; const long off = (seg == 1 ? dK : 0l) + (seg == 2 ? dV : 0l); h16* dst = (h16*)((char*)R + off); const int c = col0 & 1023;
            u32x4 w; w.x = pk_h16(a[0], a[1]); w.y = pk_h16(a[2], a[3]); w.z = pk_h16(b[0], b[1]); w.w = pk_h16(b[2], b[3]);
            *(u32x4*)(dst + (size_t)row * D + c) = w; }
        else { const int c = col0 - 3072; f32x4 x = a, y = b;
            if (c < 128) {
#pragma unroll
                for (int i = 0; i < 4; ++i) { x[i] = tanhf_(x[i]); y[i] = tanhf_(y[i]); } }
            else if (c >= 256 && c < 512) {
#pragma unroll
                for (int i = 0; i < 4; ++i) { x[i] = sigmoidf_(x[i]); y[i] = sigmoidf_(y[i]); } }
            u32x4 w; w.x = cvt_pk_bf16(x[0], x[1]); w.y = cvt_pk_bf16(x[2], x[3]); w.z = cvt_pk_bf16(y[0], y[1]); w.w = cvt_pk_bf16(y[2], y[3]);
            *(u32x4*)(LH + (size_t)row * 768 + c) = w; }
    } };
struct FLoraW { h16* EW; const float* w0;
    __device__ __forceinline__ void operator()(int row, int col0, f32x4 a, f32x4 b) const {
        const f32x4 p = *(const f32x4*)(w0 + col0), q = *(const f32x4*)(w0 + col0 + 4); float o[8];
#pragma unroll
        for (int i = 0; i < 4; ++i) { o[i] = 0.60653066f * sigmoidf_(p[i] + a[i]); o[4 + i] = 0.60653066f * sigmoidf_(q[i] + b[i]); }
        u32x4 w; w.x = pk_h16(o[0], o[1]); w.y = pk_h16(o[2], o[3]); w.z = pk_h16(o[4], o[5]); w.w = pk_h16(o[6], o[7]);
        *(u32x4*)(EW + (size_t)row * D + col0) = w; } };
struct FLoraA { h16* Aa; const float* a0;
    __device__ __forceinline__ void operator()(int row, int col0, f32x4 a, f32x4 b) const {
        const f32x4 p = *(const f32x4*)(a0 + col0), q = *(const f32x4*)(a0 + col0 + 4); float o[8];
#pragma unroll
        for (int i = 0; i < 4; ++i) { o[i] = sigmoidf_(p[i] + a[i]); o[4 + i] = sigmoidf_(q[i] + b[i]); }
        u32x4 w; w.x = pk_h16(o[0], o[1]); w.y = pk_h16(o[2], o[3]); w.z = pk_h16(o[4], o[5]); w.w = pk_h16(o[6], o[7]);
        *(u32x4*)(Aa + (size_t)row * D + col0) = w; } };
struct FLoraV { h16* V; const h16* VFm; const float* v0;
    __device__ __forceinline__ void operator()(int row, int col0, f32x4 a, f32x4 b) const {
        const f32x4 p = *(const f32x4*)(v0 + col0), q = *(const f32x4*)(v0 + col0 + 4);
        typedef h16 h16x8 __attribute__((ext_vector_type(8)));
        const h16x8 vv = *(const h16x8*)(V + (size_t)row * D + col0), vf = *(const h16x8*)(VFm + (size_t)row * D + col0); float o[8];
#pragma unroll
        for (int i = 0; i < 4; ++i) { float v = (float)vv[i], f = (float)vf[i]; o[i] = v + (f - v) * sigmoidf_(p[i] + a[i]); v = (float)vv[4 + i]; f = (float)vf[4 + i]; o[4 + i] = v + (f - v) * sigmoidf_(q[i] + b[i]); }
        u32x4 w; w.x = pk_h16(o[0], o[1]); w.y = pk_h16(o[2], o[3]); w.z = pk_h16(o[4], o[5]); w.w = pk_h16(o[6], o[7]);
        *(u32x4*)(V + (size_t)row * D + col0) = w; } };
struct FGate { bf16_t* O; const h16* Y;
    __device__ __forceinline__ void operator()(int row, int col0, f32x4 a, f32x4 b) const {
        typedef h16 h16x8 __attribute__((ext_vector_type(8)));
        const h16x8 yy = *(const h16x8*)(Y + (size_t)row * D + col0);
        u32x4 w; w.x = cvt_pk_bf16(a[0] * (float)yy[0], a[1] * (float)yy[1]); w.y = cvt_pk_bf16(a[2] * (float)yy[2], a[3] * (float)yy[3]);
        w.z = cvt_pk_bf16(b[0] * (float)yy[4], b[1] * (float)yy[5]); w.w = cvt_pk_bf16(b[2] * (float)yy[6], b[3] * (float)yy[7]);
        *(u32x4*)(O + (size_t)row * D + col0) = w; } };

template <int CTRL> __device__ __forceinline__ float dppmov(float v) { return __builtin_bit_cast(float, __builtin_amdgcn_update_dpp(0, __builtin_bit_cast(int, v), CTRL, 0xF, 0xF, true)); }
__device__ __forceinline__ float row16_sum(float v) { v += dppmov<0xB1>(v); v += dppmov<0x4E>(v); v += dppmov<0x124>(v); v += dppmov<0x128>(v); return v; }
typedef _Float16 h16x4 __attribute__((ext_vector_type(4)));
__device__ __forceinline__ void h4_to_f(h16x4 u, float* f) { f[0] = (float)u[0]; f[1] = (float)u[1]; f[2] = (float)u[2]; f[3] = (float)u[3]; }
__device__ __forceinline__ void rwkv_scan(const h16* R, const h16* Kk, const h16* V, const h16* EW, const h16* Aa, const float* k_k, const float* k_a, h16* Yraw, int G, int wave, int lane_) {
    int lane = lane_; asm volatile("" : "+v"(lane));
    const int NT = G * NWAVES;
    for (int task = wave * G + (int)blockIdx.x; task < 512; task += NT) {
        const int bh = task >> 4, rg = task & 15, b = bh >> 4, h = bh & 15;
        const int row = lane >> 4, jg = lane & 15, i = rg * 4 + row;
        const int colj = h * 64 + 4 * jg, coli = h * 64 + i;
        float kkc[4], kac[4];
#pragma unroll
        for (int j = 0; j < 4; ++j) { kkc[j] = k_k[colj + j]; kac[j] = k_a[colj + j]; }
        float s[4] = {0.f, 0.f, 0.f, 0.f};
        const size_t base = (size_t)b * S * D;
        const h16* pR = R + base + colj; const h16* pK = Kk + base + colj; const h16* pA = Aa + base + colj; const h16* pE = EW + base + colj; const h16* pV = V + base + coli;
        h16* pY = Yraw + ((size_t)task * S) * 4 + row;
        constexpr int TC = 4;
        h16x4 cr[TC], ck[TC], ca[TC], ce[TC]; h16 cv[TC];
#pragma unroll
        for (int u = 0; u < TC; ++u) { const size_t o = (size_t)u * D; cr[u] = *(const h16x4*)(pR + o); ck[u] = *(const h16x4*)(pK + o); ca[u] = *(const h16x4*)(pA + o); ce[u] = *(const h16x4*)(pE + o); cv[u] = pV[o]; }
        for (int t0 = 0; t0 < S; t0 += TC) {
            const int tn = (t0 + TC < S) ? t0 + TC : t0;
            h16x4 nr[TC], nk[TC], na[TC], ne[TC]; h16 nv[TC];
#pragma unroll
            for (int u = 0; u < TC; ++u) { const size_t o = (size_t)(tn + u) * D; nr[u] = *(const h16x4*)(pR + o); nk[u] = *(const h16x4*)(pK + o); na[u] = *(const h16x4*)(pA + o); ne[u] = *(const h16x4*)(pE + o); nv[u] = pV[o]; }
#pragma unroll
            for (int u = 0; u < TC; ++u) {
                float rv[4], kv[4], av[4], ev[4]; h4_to_f(cr[u], rv); h4_to_f(ck[u], kv); h4_to_f(ca[u], av); h4_to_f(ce[u], ev);
                const float vi = (float)cv[u];
                float kq[4], n2 = 0.f;
#pragma unroll
                for (int j = 0; j < 4; ++j) { kq[j] = kv[j] * kkc[j]; n2 += kq[j] * kq[j]; }
                n2 = row16_sum(n2);
                const float inv = 1.0f / fmaxf(sqrtf(n2), 1e-12f);
                float kkj[4], kt[4], bb[4], w[4], dot = 0.f;
#pragma unroll
                for (int j = 0; j < 4; ++j) { kkj[j] = kq[j] * inv; kt[j] = kv[j] * (1.0f + (av[j] - 1.0f) * kac[j]); bb[j] = kkj[j] * av[j]; w[j] = __expf(-ev[j]); dot += s[j] * kkj[j]; }
                const float sa = -row16_sum(dot);
                float yd = 0.f;
#pragma unroll
                for (int j = 0; j < 4; ++j) { s[j] = s[j] * w[j] + (sa * bb[j] + vi * kt[j]); yd += s[j] * rv[j]; }
                const float y = row16_sum(yd);
                if (jg == 0) pY[(size_t)(t0 + u) * 4] = (h16)y;
            }
#pragma unroll
            for (int u = 0; u < TC; ++u) { cr[u] = nr[u]; ck[u] = nk[u]; ca[u] = na[u]; ce[u] = ne[u]; cv[u] = nv[u]; }
        }
    }
}
constexpr int SC_CS = 32, SC_STEP_F = 5 * 64 + 8, SC_BUF_F = SC_CS * SC_STEP_F;
#define SC_BAR() do { asm volatile("s_waitcnt lgkmcnt(0)" ::: "memory"); __builtin_amdgcn_s_barrier(); asm volatile("" ::: "memory"); } while (0)
__device__ __forceinline__ float wave_sum_dpp(float v) {
    v = row16_sum(v);
    const float a = __builtin_bit_cast(float, __builtin_amdgcn_readlane(__builtin_bit_cast(int, v), 0)), b = __builtin_bit_cast(float, __builtin_amdgcn_readlane(__builtin_bit_cast(int, v), 16));
    const float c = __builtin_bit_cast(float, __builtin_amdgcn_readlane(__builtin_bit_cast(int, v), 32)), d = __builtin_bit_cast(float, __builtin_amdgcn_readlane(__builtin_bit_cast(int, v), 48));
    return (a + b) + (c + d);
}
struct ScRegs { h16 k[8], a[8], e[8], r[8], v[8]; };
__device__ __forceinline__ void sc_load(ScRegs& g, const h16* R, const h16* Kk, const h16* V, const h16* EW, const h16* Aa, size_t base, int c, int pw, int sub, int lane) {
#pragma unroll
    for (int q = 0; q < 8; ++q) { const size_t o = base + (size_t)(c * SC_CS + pw + 4 * q) * D;
        g.k[q] = Kk[o + lane]; g.a[q] = Aa[o + lane]; g.e[q] = EW[o + lane]; g.r[q] = R[o + lane]; g.v[q] = V[o + sub * 8 + (lane & 7)]; }
}
__device__ __forceinline__ void sc_compute(const ScRegs& g, LAS float* sb, int pw, float kkc, float kac, int lane) {
#pragma unroll
    for (int q = 0; q < 8; ++q) {
        const float kv = (float)g.k[q], av = (float)g.a[q], ev = (float)g.e[q], rv = (float)g.r[q]; const float kq = kv * kkc;
        const float n2 = wave_sum_dpp(kq * kq);
        const float kkj = kq * rsqrtf(fmaxf(n2, 1e-24f)); LAS float* p = sb + (pw + 4 * q) * SC_STEP_F;
        p[lane] = kkj; p[64 + lane] = kkj * av; p[128 + lane] = kv * (1.0f + (av - 1.0f) * kac); p[192 + lane] = __expf(-ev); p[256 + lane] = rv; if (lane < 8) p[320 + lane] = (float)g.v[q];
    }
}
__device__ __forceinline__ void rwkv_scan2(const h16* R, const h16* Kk, const h16* V, const h16* EW, const h16* Aa, const float* k_k, const float* k_a, h16* Yraw, LAS unsigned char* lds, int wave, int lane_) {
    int lane = lane_; asm volatile("" : "+v"(lane));
    LAS float* buf = (LAS float*)lds;
    constexpr int NCH = S / SC_CS;
#pragma unroll 1
    for (int vb = (int)blockIdx.x; vb < 256; vb += (int)gridDim.x) {
        const int bh = vb >> 3, sub = vb & 7, b = bh >> 4, h = bh & 15;
        const size_t base = (size_t)b * S * D + h * 64;
        if (wave >= 4) {
            const int pw = wave - 4;
            const float kkc = k_k[h * 64 + lane], kac = k_a[h * 64 + lane];
            ScRegs ga, gb;
            sc_load(ga, R, Kk, V, EW, Aa, base, 0, pw, sub, lane);
            sc_load(gb, R, Kk, V, EW, Aa, base, 1, pw, sub, lane);
            sc_compute(ga, buf, pw, kkc, kac, lane);
            SC_BAR();
#pragma unroll 1
            for (int c = 0; c < NCH; c += 2) {
                { const int c2 = (c + 2 < NCH) ? c + 2 : c; sc_load(ga, R, Kk, V, EW, Aa, base, c2, pw, sub, lane); }
                sc_compute(gb, buf + SC_BUF_F, pw, kkc, kac, lane);
                SC_BAR();
                { const int c3 = (c + 3 < NCH) ? c + 3 : c + 1; sc_load(gb, R, Kk, V, EW, Aa, base, c3, pw, sub, lane); }
                if (c + 2 < NCH) sc_compute(ga, buf, pw, kkc, kac, lane);
                SC_BAR();
            }
            SC_BAR();
        } else if (wave < 2) {
            const int jg = lane & 15, cw = wave;
            f32x2 sA = {0.f, 0.f}, sB = {0.f, 0.f};
#define SC_LO(v) __builtin_shufflevector(v, v, 0, 1)
#define SC_HI(v) __builtin_shufflevector(v, v, 2, 3)
            SC_BAR();
#pragma unroll 1
            for (int c = 0; c < NCH; ++c) {
                const LAS float* sb = buf + (c & 1) * SC_BUF_F + 4 * jg;
                const LAS float* vb_ = buf + (c & 1) * SC_BUF_F + 320 + cw * 4 + (lane >> 4);
                LAS float* yp = buf + 2 * SC_BUF_F + ((c & 1) * 2 + cw) * (SC_CS * 64) + lane;
                f32x4 kk4 = *(const LAS f32x4*)(sb), bb4 = *(const LAS f32x4*)(sb + 64), kt4 = *(const LAS f32x4*)(sb + 128), w4 = *(const LAS f32x4*)(sb + 192), r4 = *(const LAS f32x4*)(sb + 256); float vi = vb_[0];
#pragma unroll
                for (int st = 0; st < SC_CS; ++st) {
                    const int sn = (st + 1 < SC_CS) ? st + 1 : st;
                    const f32x4 nkk = *(const LAS f32x4*)(sb + sn * SC_STEP_F), nbb = *(const LAS f32x4*)(sb + sn * SC_STEP_F + 64), nkt = *(const LAS f32x4*)(sb + sn * SC_STEP_F + 128), nw = *(const LAS f32x4*)(sb + sn * SC_STEP_F + 192), nr4 = *(const LAS f32x4*)(sb + sn * SC_STEP_F + 256);
                    const float nvi = vb_[sn * SC_STEP_F];
                    f32x2 tt = sA * SC_LO(kk4); tt = sB * SC_HI(kk4) + tt;
                    const float sa = -row16_sum(tt.x + tt.y);
                    const f32x2 sa2 = {sa, sa}, vi2 = {vi, vi};
                    f32x2 uA = vi2 * SC_LO(kt4); uA = sa2 * SC_LO(bb4) + uA; sA = sA * SC_LO(w4) + uA;
                    f32x2 uB = vi2 * SC_HI(kt4); uB = sa2 * SC_HI(bb4) + uB; sB = sB * SC_HI(w4) + uB;
                    f32x2 yy = sA * SC_LO(r4); yy = sB * SC_HI(r4) + yy;
                    yp[st * 64] = yy.x + yy.y;
                    kk4 = nkk; bb4 = nbb; kt4 = nkt; w4 = nw; r4 = nr4; vi = nvi;
                }
                SC_BAR();
            }
            SC_BAR();
        } else {
            const int cw = wave - 2;
            h16* pY = Yraw + ((size_t)(bh * 16 + sub * 2 + cw) * S) * 4;
            SC_BAR();
#pragma unroll 1
            for (int c = 0; c <= NCH; ++c) {
                if (c > 0) {
                    const LAS float* yp = buf + 2 * SC_BUF_F + (((c - 1) & 1) * 2 + cw) * (SC_CS * 64);
                    const int st = lane >> 1, r0 = 2 * (lane & 1);
                    float a0 = 0.f, a1 = 0.f;
#pragma unroll
                    for (int q = 0; q < 4; ++q) { const f32x4 x = *(const LAS f32x4*)(yp + st * 64 + r0 * 16 + 4 * q), z = *(const LAS f32x4*)(yp + st * 64 + (r0 + 1) * 16 + 4 * q);
                        a0 += (x[0] + x[1]) + (x[2] + x[3]); a1 += (z[0] + z[1]) + (z[2] + z[3]); }
                    *(unsigned*)(pY + (size_t)((c - 1) * SC_CS + st) * 4 + r0) = pk_h16(a0, a1);
                }
                SC_BAR();
            }
        }
        if (false) {
            SC_BAR();
#pragma unroll 1
            for (int c = 0; c < NCH; ++c) SC_BAR();
        }
    }
}
__device__ __forceinline__ void rwkv_gn(h16* R, const h16* Kk, const h16* V, const h16* Aa, const h16* Yraw, const float* k_a, const float* r_k, const float* ln_w, const float* ln_b, int gw, int NGW, int lane_) {
    int lane = lane_; asm volatile("" : "+v"(lane));
    const int hq = lane >> 4, c4 = 4 * (lane & 15);
#pragma unroll 2
    for (int idx = gw; idx < M * 4; idx += NGW) {
        const int m = idx >> 2, h = (idx & 3) * 4 + hq, col = h * 64 + c4; const size_t o = (size_t)m * D + col;
        const int bq = m / S, tq = m - bq * S;
        float y[4], r[4], k[4], a[4], v[4];
        h4_to_f(*(const h16x4*)(Yraw + ((size_t)((bq * 16 + h) * 16 + (lane & 15)) * S + tq) * 4), y);
        h4_to_f(*(const h16x4*)(R + o), r); h4_to_f(*(const h16x4*)(Kk + o), k); h4_to_f(*(const h16x4*)(Aa + o), a); h4_to_f(*(const h16x4*)(V + o), v);
        const f32x4 ka4 = *(const f32x4*)(k_a + col), rk4 = *(const f32x4*)(r_k + col), lw4 = *(const f32x4*)(ln_w + col), lb4 = *(const f32x4*)(ln_b + col);
        const float mu = row16_sum((y[0] + y[1]) + (y[2] + y[3])) * (1.f / 64.f);
        float d[4], q = 0.f, bsp = 0.f;
#pragma unroll
        for (int i = 0; i < 4; ++i) { d[i] = y[i] - mu; q += d[i] * d[i]; const float kt = k[i] * (1.0f + (a[i] - 1.0f) * ka4[i]); bsp += r[i] * kt * rk4[i]; }
        const float rstd = rsqrtf(row16_sum(q) * (1.f / 64.f) + 64e-5f), bs = row16_sum(bsp);
        h16x4 outv;
#pragma unroll
        for (int i = 0; i < 4; ++i) outv[i] = (h16)(d[i] * rstd * lw4[i] + lb4[i] + bs * v[i]);
        *(h16x4*)(R + o) = outv;
    }
}

constexpr size_t KF_STRIDE = (size_t)NB * 4 * S * 64;
__device__ __forceinline__ float gelu_tanh(float x) { const float u = 0.7978845608f * (x + 0.044715f * x * x * x); return 0.5f * x * (1.0f + tanhf_(u)); }
__device__ __forceinline__ void store_vf8(bf16_t* chunk_base_d, int keyp0  , f32x4 a, f32x4 b) {
    const int tile = keyp0 >> 4, rq0 = (keyp0 & 15) >> 2;
    u32x2 w0, w1; w0.x = cvt_pk_bf16(a[0], a[1]); w0.y = cvt_pk_bf16(a[2], a[3]); w1.x = cvt_pk_bf16(b[0], b[1]); w1.y = cvt_pk_bf16(b[2], b[3]);
    *(u32x2*)(chunk_base_d + 8 * rq0 + 4 * tile) = w0; *(u32x2*)(chunk_base_d + 8 * (rq0 + 1) + 4 * tile) = w1;
}
struct FNsaIn { bf16_t* Q; bf16_t* KF; float* gates; const float* rope;
    __device__ __forceinline__ void operator()(int row, int col0, f32x4 a, f32x4 b) const {
        const int tile = __builtin_amdgcn_readfirstlane(col0 >> 8);
        const int bb = row / S, t = row - bb * S;
        if (tile < 7) {
            f32x4 x = a, y = b;
            if ((col0 & 32) == 0) {
                f32x4 px, py;
#pragma unroll
                for (int i = 0; i < 4; ++i) { px[i] = __shfl_xor(x[i], 16); py[i] = __shfl_xor(y[i], 16); }
                const int d0 = col0 & 63;
                if (d0 < 16) { const f32x4 c0 = *(const f32x4*)(rope + t * 16), c1 = *(const f32x4*)(rope + t * 16 + 4), s0 = *(const f32x4*)(rope + t * 16 + 8), s1 = *(const f32x4*)(rope + t * 16 + 12);
                    if (d0 == 0) { x = x * c0 - px * s0; y = y * c1 - py * s1; } else { x = x * c0 + px * s0; y = y * c1 + py * s1; } }
            }
            if (tile < 4) { x = x * 0.18033688011112042f; y = y * 0.18033688011112042f;
                u32x4 w; w.x = cvt_pk_bf16(x[0], x[1]); w.y = cvt_pk_bf16(x[2], x[3]); w.z = cvt_pk_bf16(y[0], y[1]); w.w = cvt_pk_bf16(y[2], y[3]);
                *(u32x4*)(Q + (size_t)row * D + col0) = w; }
            else { const int idx = tile - 4, g = (col0 & 255) >> 6, d0 = col0 & 63;
                u32x4 w; w.x = cvt_pk_bf16(x[0], x[1]); w.y = cvt_pk_bf16(x[2], x[3]); w.z = cvt_pk_bf16(y[0], y[1]); w.w = cvt_pk_bf16(y[2], y[3]);
                *(u32x4*)(KF + (size_t)idx * KF_STRIDE + ((size_t)(bb * 4 + g) * S + t) * 64 + d0) = w; }
        } else if (tile == 7) { const int g = (col0 & 255) >> 6, d0 = col0 & 63;
            u32x4 w; w.x = cvt_pk_bf16(a[0], a[1]); w.y = cvt_pk_bf16(a[2], a[3]); w.z = cvt_pk_bf16(b[0], b[1]); w.w = cvt_pk_bf16(b[2], b[3]);
            *(u32x4*)(KF + (size_t)3 * KF_STRIDE + ((size_t)(bb * 4 + g) * S + t) * 64 + d0) = w;
        } else { const int c = col0 - 2048;
            if (c < 48) { f32x4 x, y;
#pragma unroll
                for (int i = 0; i < 4; ++i) { x[i] = sigmoidf_(a[i]); y[i] = sigmoidf_(b[i]); }
                *(f32x4*)(gates + (size_t)row * 48 + c) = x; *(f32x4*)(gates + (size_t)row * 48 + c + 4) = y; }
        }
    } };
struct FNsaVT { bf16_t* VF;
    __device__ __forceinline__ void operator()(int row, int col0, f32x4 a, f32x4 b) const {
        const int br = row >> 8, g = (row >> 6) & 3, d = row & 63, bb = col0 / S, t0 = col0 - bb * S;
        bf16_t* base = VF + (size_t)br * KF_STRIDE + (size_t)(bb * 4 + g) * S * 64 + (size_t)(t0 >> 5) * 2048 + d * 32;
        store_vf8(base, t0 & 31, a, b); } };
struct FCmp1 { bf16_t* CH; const float* bias;
    __device__ __forceinline__ void operator()(int row, int col0, f32x4 a, f32x4 b) const {
        const f32x4 p = *(const f32x4*)(bias + col0), q = *(const f32x4*)(bias + col0 + 4); float o[8];
#pragma unroll
        for (int i = 0; i < 4; ++i) { o[i] = gelu_tanh(a[i] + p[i]); o[4 + i] = gelu_tanh(b[i] + q[i]); }
        u32x4 w; w.x = cvt_pk_bf16(o[0], o[1]); w.y = cvt_pk_bf16(o[2], o[3]); w.z = cvt_pk_bf16(o[4], o[5]); w.w = cvt_pk_bf16(o[6], o[7]);
        *(u32x4*)(CH + (size_t)row * 256 + col0) = w; } };
struct FCmp2K { bf16_t* KC;
    __device__ __forceinline__ void operator()(int row, int col0, f32x4 a, f32x4 b) const {
        if (col0 < 64) { u32x4 w; w.x = cvt_pk_bf16(a[0], a[1]); w.y = cvt_pk_bf16(a[2], a[3]); w.z = cvt_pk_bf16(b[0], b[1]); w.w = cvt_pk_bf16(b[2], b[3]);
            *(u32x4*)(KC + (size_t)row * 64 + col0) = w; } } };
struct FCmp2VT { bf16_t* VC;
    __device__ __forceinline__ void operator()(int row, int col0, f32x4 a, f32x4 b) const {
        if (row < 64) { const int bg = col0 >> 10, n0 = col0 & 1023;
            bf16_t* base = VC + (size_t)bg * 65536 + (size_t)(n0 >> 5) * 2048 + row * 32; store_vf8(base, n0 & 31, a, b); } } };

__device__ __forceinline__ f32x4 mfma16(bf16x8 a, bf16x8 b, f32x4 c) { return __builtin_amdgcn_mfma_f32_16x16x32_bf16(a, b, c, 0, 0, 0); }
__device__ __forceinline__ bf16x8 ld8(const bf16_t* p) { return *(const bf16x8*)p; }
__device__ __forceinline__ bf16x8 pack8(f32x4 a, f32x4 b) { u32x4 w; w.x = cvt_pk_bf16(a[0], a[1]); w.y = cvt_pk_bf16(a[2], a[3]); w.z = cvt_pk_bf16(b[0], b[1]); w.w = cvt_pk_bf16(b[2], b[3]); return __builtin_bit_cast(bf16x8, w); }
__device__ __forceinline__ float colmax(float x) {
    const auto r = __builtin_amdgcn_permlane16_swap(__float_as_uint(x), __float_as_uint(x), false, false); x = fmaxf(__uint_as_float(r[0]), __uint_as_float(r[1]));
    const auto q = __builtin_amdgcn_permlane32_swap(__float_as_uint(x), __float_as_uint(x), false, false); return fmaxf(__uint_as_float(q[0]), __uint_as_float(q[1])); }
__device__ __forceinline__ float colsum(float x) {
    const auto r = __builtin_amdgcn_permlane16_swap(__float_as_uint(x), __float_as_uint(x), false, false); x = __uint_as_float(r[0]) + __uint_as_float(r[1]);
    const auto q = __builtin_amdgcn_permlane32_swap(__float_as_uint(x), __float_as_uint(x), false, false); return __uint_as_float(q[0]) + __uint_as_float(q[1]); }
template <int CTRL> __device__ __forceinline__ unsigned dppmov_u(unsigned v) { return (unsigned)__builtin_amdgcn_update_dpp(0, (int)v, CTRL, 0xF, 0xF, true); }
__device__ __forceinline__ unsigned wave_max_u32(unsigned v) {
    v = max(v, dppmov_u<0xB1>(v)); v = max(v, dppmov_u<0x4E>(v)); v = max(v, dppmov_u<0x124>(v)); v = max(v, dppmov_u<0x128>(v));
    const auto r = __builtin_amdgcn_permlane16_swap(v, v, false, false); v = max((unsigned)r[0], (unsigned)r[1]);
    const auto q = __builtin_amdgcn_permlane32_swap(v, v, false, false); return max((unsigned)q[0], (unsigned)q[1]); }
struct AttnState { float m, l; f32x4 o[4]; };
__device__ __forceinline__ void attn_init(AttnState& st) { st.m = -1e30f; st.l = 0.f;
#pragma unroll
    for (int d = 0; d < 4; ++d) st.o[d] = (f32x4){0.f, 0.f, 0.f, 0.f}; }
struct KVChunk { bf16x8 k[4]; bf16x8 v[4]; };
__device__ __forceinline__ void kv_load(KVChunk& B, const bf16_t* kptr, const bf16_t* vptr) {
#pragma unroll
    for (int tl = 0; tl < 2; ++tl) { B.k[tl * 2] = ld8(kptr + tl * 1024); B.k[tl * 2 + 1] = ld8(kptr + tl * 1024 + 32); }
#pragma unroll
    for (int d = 0; d < 4; ++d) B.v[d] = ld8(vptr + d * 512);
}
struct KRange { int klo, span; };
__device__ __forceinline__ KRange krange(int klo, int khi) { KRange r; if (khi < klo) { r.klo = 64; r.span = 0; } else { r.klo = klo; r.span = khi - klo; } return r; }
template <bool MASKED>
__device__ __forceinline__ void attn_chunk_r(AttnState& st, const bf16x8 (&kf)[4], const bf16x8 (&vf)[4], const bf16x8 q0, const bf16x8 q1, KRange kr) {
    f32x4 s[2];
#pragma unroll
    for (int tl = 0; tl < 2; ++tl) { s[tl] = mfma16(kf[tl * 2], q0, (f32x4){0.f, 0.f, 0.f, 0.f}); s[tl] = mfma16(kf[tl * 2 + 1], q1, s[tl]); }
    float mx = -1e30f;
#pragma unroll
    for (int tl = 0; tl < 2; ++tl)
#pragma unroll
        for (int i = 0; i < 4; ++i) { if (MASKED) { const bool v = (unsigned)(tl * 16 + i - kr.klo) <= (unsigned)kr.span; s[tl][i] = v ? s[tl][i] : -1e30f; } mx = fmaxf(mx, s[tl][i]); }
    mx = colmax(mx);
    if (__any(mx > st.m)) {
        const float mnew = fmaxf(st.m, mx), alpha = __builtin_amdgcn_exp2f(st.m - mnew);
        st.l *= alpha; st.m = mnew;
#pragma unroll
        for (int d = 0; d < 4; ++d) st.o[d] = st.o[d] * alpha;
    }
    const float mcur = st.m;
    f32x4 p[2]; float ps = 0.f;
#pragma unroll
    for (int tl = 0; tl < 2; ++tl)
#pragma unroll
        for (int i = 0; i < 4; ++i) { const float e = __builtin_amdgcn_exp2f(s[tl][i] - mcur); p[tl][i] = e; ps += e; }
    st.l += ps;
    const bf16x8 pb = pack8(p[0], p[1]);
#pragma unroll
    for (int d = 0; d < 4; ++d) st.o[d] = mfma16(vf[d], pb, st.o[d]);
}

#define ATT_STEPN(C, idx) do { _Pragma("unroll") for (int gg = 0; gg < NG; ++gg) { if (act(gg, idx)) { \
        if (ff(gg, idx)) attn_chunk_r<false>(gs[gg], C.k, C.v, gq[gg][0], gq[gg][1], KRange{0, 0}); else attn_chunk_r<true>(gs[gg], C.k, C.v, gq[gg][0], gq[gg][1], mf(gg, idx)); } \
        __builtin_amdgcn_sched_barrier(0); } } while (0)
template <int NG, class AddrK, class AddrV, class ActF, class FullF, class MaskF>
__device__ __forceinline__ void attn_chunksN(AttnState (&gs)[NG], const bf16x8 (&gq)[NG][2], int n, AddrK ak, AddrV av, ActF act, FullF ff, MaskF mf) {
    if constexpr (NG <= 2) {
        KVChunk C0, C1;
        if (n > 0) kv_load(C0, ak(0), av(0));
#pragma unroll 1
        for (int i = 0; i < n; i += 2) {
            if (i + 1 < n) kv_load(C1, ak(i + 1), av(i + 1));
            ATT_STEPN(C0, i);
            if (i + 1 < n) {
                if (i + 2 < n) kv_load(C0, ak(i + 2), av(i + 2));
                ATT_STEPN(C1, i + 1);
            }
        }
    } else {
#pragma unroll 1
        for (int i = 0; i < n; ++i) { KVChunk C0; kv_load(C0, ak(i), av(i)); ATT_STEPN(C0, i); }
    }
}

__device__ __forceinline__ void nsa_attention(const bf16_t* Q, const bf16_t* KF, const bf16_t* VF, const bf16_t* KC, const bf16_t* VC, const float* gates, bf16_t* OUT, LAS unsigned char* lds, int G, int wave, int lane_) {
    int lane0 = lane_; asm volatile("" : "+v"(lane0));
    LAS float* imp = (LAS float*)(lds + wave * 18432);
    LAS float* tl = imp;
    LAS int* sel = (LAS int*)(lds + wave * 18432 + 16384);
    LAS unsigned* smask32 = (LAS unsigned*)(lds + wave * 18432 + 16384 + 1088);
    LAS unsigned char* blist = (LAS unsigned char*)(lds + wave * 18432 + 16384 + 1088 + 512);
    const bool xcd_map = (G % 8) == 0;
    const int nslots = xcd_map ? (G >> 3) * NWAVES : G * NWAVES, slot = xcd_map ? ((int)blockIdx.x >> 3) * NWAVES + wave : (int)blockIdx.x * NWAVES + wave;
    const int ntask = xcd_map ? 1024 : 8192;
#pragma unroll 1
    for (int task = slot; task < ntask; task += nslots) {
        int lane = lane0; asm volatile("" : "+v"(lane)); lane &= 63;
        const int col = lane & 15, rq = lane >> 4;
        const int tilei = xcd_map ? task : (task >> 3), bg = xcd_map ? ((int)blockIdx.x & 7) : (task & 7), b = bg >> 2, g = bg & 3, t0 = tilei * 16, t = t0 + col;
        const size_t rowq = (size_t)b * S + t;
        const bf16_t* qrow = Q + rowq * D + (g * 4) * 64 + 8 * rq;
        const float* grow = gates + rowq * 48 + g * 12;
        const int cur_max = (t0 + 15) >> 6;
        int n_end = 4 * (cur_max + 1); if (n_end > 1024) n_end = 1024;
        const int nchunk_c = (n_end + 31) >> 5;
        const bf16_t* kc_l = KC + (size_t)bg * 65536 + (size_t)col * 64 + 8 * rq;
        const bf16_t* vc_l = VC + (size_t)bg * 65536 + (size_t)col * 32 + 8 * rq;
        {
        AttnState gs[4]; bf16x8 gq[4][2];
#pragma unroll
        for (int h = 0; h < 4; ++h) { gq[h][0] = ld8(qrow + h * 64); gq[h][1] = ld8(qrow + h * 64 + 32); attn_init(gs[h]); }
        attn_chunksN<4>(gs, gq, nchunk_c,
            [&](int ci) { return kc_l + (size_t)ci * 2048; }, [&](int ci) { return vc_l + (size_t)ci * 2048; },
            [&](int, int) { return true; },
            [&](int, int ci) { return 16 * (ci * 32 + 31) + 31 <= t0; },
            [&](int, int ci) { const int nhi = (t >= 31) ? ((t - 31) >> 4) : -1; return krange(0, nhi - ci * 32 - 4 * rq); });
        {
            float mc[4], lc[4];
#pragma unroll
            for (int h = 0; h < 4; ++h) { const float lt = colsum(gs[h].l); mc[h] = gs[h].m; lc[h] = (gs[h].m > -1e29f && lt > 0.f) ? 1.0f / lt : 0.f; }
            {
                float carry = 0.f;
#pragma unroll 1
                for (int kc = 0; kc < nchunk_c; ++kc) {
#pragma unroll
                    for (int tt = 0; tt < 2; ++tt) {
                        const bf16x8 k0 = ld8(kc_l + (size_t)kc * 2048 + tt * 1024), k1 = ld8(kc_l + (size_t)kc * 2048 + tt * 1024 + 32);
                        float own = 0.f, p3 = 0.f;
#pragma unroll
                        for (int h = 0; h < 4; ++h) {
                            f32x4 sc = mfma16(k0, gq[h][0], (f32x4){0.f, 0.f, 0.f, 0.f}); sc = mfma16(k1, gq[h][1], sc);
#pragma unroll
                            for (int i = 0; i < 4; ++i) { const int n = kc * 32 + tt * 16 + 4 * rq + i; const float p = (16 * n + 31 <= t) ? __builtin_amdgcn_exp2f(sc[i] - mc[h]) * lc[h] : 0.f; own += p; if (i == 3) p3 += p; }
                        }
                        const float up = __shfl(p3, (lane + 48) & 63);
                        const float add = (rq == 0) ? carry : up;
                        imp[col * 256 + kc * 8 + tt * 4 + rq] = own + add;
                        carry = __shfl(p3, col + 48);
                    }
                }
            }
#pragma unroll 1
            for (int c = 0; c < 16; ++c) {
                const int tc = t0 + c, cur = tc >> 6;
                if (cur < 16) { if (lane <= cur) sel[c * 17 + lane] = lane; if (lane == 0) sel[c * 17 + 16] = cur + 1; }
                else {
                    unsigned key[4];
#pragma unroll
                    for (int jx = 0; jx < 4; ++jx) { const int sb = lane + 64 * jx; const float v = imp[c * 256 + sb]; key[jx] = (sb >= 1 && sb <= cur - 2) ? ((__float_as_uint(v) & 0xFFFFFF00u) | (unsigned)(255 - sb)) : 0u; }
                    if (lane == 0) { sel[c * 17 + 0] = 0; sel[c * 17 + 1] = cur - 1; sel[c * 17 + 2] = cur; sel[c * 17 + 16] = 16; }
#pragma unroll 1
                    for (int r = 0; r < 13; ++r) {
                        unsigned best = max(max(key[0], key[1]), max(key[2], key[3]));
                        best = wave_max_u32(best);
                        if (lane == 0) sel[c * 17 + 3 + r] = 255 - (int)(best & 255u);
#pragma unroll
                        for (int jx = 0; jx < 4; ++jx) if (key[jx] == best) key[jx] = 0u;
                    }
                }
            }
#pragma unroll
            for (int h = 0; h < 4; ++h) { const float gc = grow[h * 3 + 0] * lc[h];
#pragma unroll
                for (int d = 0; d < 4; ++d)
#pragma unroll
                    for (int i = 0; i < 4; ++i) tl[(h * 16 + d * 4 + i) * 64 + lane] = gs[h].o[d][i] * gc; }
        }
        }
        {
            smask32[lane] = 0u; smask32[64 + lane] = 0u;
#pragma unroll
            for (int k4 = 0; k4 < 4; ++k4) { const int pp = lane + 64 * k4, c = pp >> 4, e = pp & 15; if (e < sel[c * 17 + 16]) { const int jb = sel[c * 17 + e]; atomicOr((unsigned*)(smask32 + (jb >> 1)), 1u << (c + 16 * (jb & 1))); } }
            const bf16_t* ks_b = KF + (size_t)1 * KF_STRIDE + (size_t)bg * S * 64 + (size_t)col * 64 + 8 * rq;
            const bf16_t* vs_b = VF + (size_t)bg * S * 64 + (size_t)col * 32 + 8 * rq;
            const int tokl = col >> 2, hd = col & 3;
            {
                int nblk = 0;
                LAS unsigned* bl32 = (LAS unsigned*)sel;
                unsigned mk4[4];
#pragma unroll
                for (int k4 = 0; k4 < 4; ++k4) { const int jb = lane + 64 * k4; mk4[k4] = (smask32[jb >> 1] >> (16 * (jb & 1))) & 0xFFFFu; }
#pragma unroll
                for (int k4 = 0; k4 < 4; ++k4) { const int jb = lane + 64 * k4; const unsigned mk = mk4[k4];
                    const unsigned long long bal = __ballot(mk != 0u); const int pos = nblk + __popcll(bal & ((1ull << lane) - 1ull)); if (mk != 0u) bl32[pos] = (unsigned)jb | (mk << 8); nblk += __popcll(bal); }
                AttnState hs[4]; bf16x8 hq[4][2];
#pragma unroll
                for (int cg = 0; cg < 4; ++cg) { const bf16_t* qp = Q + ((size_t)b * S + t0 + 4 * cg + tokl) * D + (g * 4 + hd) * 64 + 8 * rq; hq[cg][0] = ld8(qp); hq[cg][1] = ld8(qp + 32); attn_init(hs[cg]); }
                auto wrd_of = [&](int ci) { return (unsigned)__builtin_amdgcn_readfirstlane((int)bl32[ci >> 1]); };
                const int tb = t0;
                attn_chunksN<4>(hs, hq, nblk * 2,
                    [&](int ci) { return ks_b + (size_t)((int)(wrd_of(ci) & 255u) * 2 + (ci & 1)) * 2048; },
                    [&](int ci) { return vs_b + (size_t)((int)(wrd_of(ci) & 255u) * 2 + (ci & 1)) * 2048; },
                    [&](int cg, int ci) { return ((wrd_of(ci) >> (8 + 4 * cg)) & 15u) != 0u; },
                    [&](int cg, int ci) { const unsigned wd = wrd_of(ci); const int jb = (int)(wd & 255u); return ((wd >> (8 + 4 * cg)) & 15u) == 15u && jb * 64 + (ci & 1) * 32 + 31 <= tb + 4 * cg; },
                    [&](int cg, int ci) { const unsigned wd = wrd_of(ci); const int jb = (int)(wd & 255u); const unsigned mk = wd >> 8; const int tok = 4 * cg + tokl; const int kp0 = jb * 64 + (ci & 1) * 32 + 4 * rq;
                        return krange(0, ((mk >> tok) & 1u) ? (tb + tok - kp0) : -1); });
#pragma unroll
                for (int cg = 0; cg < 4; ++cg) { const int tok = 4 * cg + tokl;
                    const float lt = colsum(hs[cg].l); const float inv = (hs[cg].m > -1e29f && lt > 0.f) ? 1.0f / lt : 0.f;
                    const float gsv = gates[((size_t)b * S + t0 + tok) * 48 + g * 12 + hd * 3 + 1] * inv;
#pragma unroll
                    for (int d = 0; d < 4; ++d)
#pragma unroll
                        for (int i = 0; i < 4; ++i) tl[(hd * 16 + d * 4 + i) * 64 + tok + 16 * rq] += hs[cg].o[d][i] * gsv; }
            }
        }
        {
            int lo = t0 - 511; if (lo < 0) lo = 0; const int c0 = lo >> 5, c1 = (t0 + 15) >> 5;
            const bf16_t* kw_b = KF + (size_t)2 * KF_STRIDE + (size_t)bg * S * 64 + (size_t)col * 64 + 8 * rq;
            const bf16_t* vw_b = VF + (size_t)1 * KF_STRIDE + (size_t)bg * S * 64 + (size_t)col * 32 + 8 * rq;
            {
                AttnState gs[4]; bf16x8 gq[4][2];
#pragma unroll
                for (int h = 0; h < 4; ++h) { gq[h][0] = ld8(qrow + h * 64); gq[h][1] = ld8(qrow + h * 64 + 32); attn_init(gs[h]); }
                attn_chunksN<4>(gs, gq, c1 - c0 + 1,
                    [&](int ci) { return kw_b + (size_t)(c0 + ci) * 2048; }, [&](int ci) { return vw_b + (size_t)(c0 + ci) * 2048; },
                    [&](int, int) { return true; },
                    [&](int, int ci) { return (c0 + ci) * 32 + 31 <= t0 && (c0 + ci) * 32 + 512 > t0 + 15; },
                    [&](int, int ci) { const int cb = (c0 + ci) * 32 + 4 * rq; return krange(t - 511 - cb, t - cb); });
#pragma unroll
                for (int h = 0; h < 4; ++h) { const float lt = colsum(gs[h].l); const float inv = (gs[h].m > -1e29f && lt > 0.f) ? 1.0f / lt : 0.f; const float gwv = grow[h * 3 + 2] * inv;
#pragma unroll
                    for (int d = 0; d < 4; ++d)
#pragma unroll
                        for (int i = 0; i < 4; ++i) tl[(h * 16 + d * 4 + i) * 64 + lane] += gs[h].o[d][i] * gwv; }
            }
        }
#pragma unroll
        for (int h = 0; h < 4; ++h)
#pragma unroll
            for (int d = 0; d < 4; ++d) { float v4[4];
#pragma unroll
                for (int i = 0; i < 4; ++i) v4[i] = tl[(h * 16 + d * 4 + i) * 64 + lane];
                u32x2 w; w.x = cvt_pk_bf16(v4[0], v4[1]); w.y = cvt_pk_bf16(v4[2], v4[3]);
                *(u32x2*)(OUT + rowq * D + (g * 4 + h) * 64 + d * 16 + 4 * rq) = w; }
    }
}

#define XB_TMO      128
#define XB_XCNT(j)  (256  + 64 * (j))
#define XB_XSUB(j)  (1280 + 64 * (j))
#define XB_XGEN(j)  (2304 + 64 * (j))
#define XB_TOP      3328
#define XB_TOPGEN   3392
#define XCD_BAR_WORDS 3456
#define XB_SPIN_CAP (1u << 22)
__device__ __forceinline__ unsigned xb_ld(unsigned* p)              { return __hip_atomic_load(p, __ATOMIC_RELAXED, __HIP_MEMORY_SCOPE_AGENT); }
__device__ __forceinline__ unsigned xb_add(unsigned* p, unsigned v) { return __hip_atomic_fetch_add(p, v, __ATOMIC_RELAXED, __HIP_MEMORY_SCOPE_AGENT); }
__device__ __forceinline__ unsigned xb_xcc_id() { return (unsigned)__builtin_amdgcn_s_getreg((3 << 11) | 20) & 0xFu; }
#define XB_SPIN(cond, bar) do { unsigned _sp = 0; while (cond) { __builtin_amdgcn_s_sleep(1); \
    if ((++_sp & 255u) == 0u) { if (xb_ld(&(bar)[XB_TMO])) break; if (_sp > XB_SPIN_CAP) { atomicAdd(&(bar)[XB_TMO], 1u); break; } } } } while (0)
struct XcdBarrier { unsigned* bar; unsigned x; volatile LAS unsigned* st; };
__device__ __forceinline__ void xcd_barrier_complete(unsigned* bar, unsigned x, unsigned& nloc, unsigned& nx) {
    const unsigned Gn = gridDim.x * gridDim.y * gridDim.z;
    unsigned sum, cnt, mine, sp = 0u;
    for (;;) {
        sum = 0u; cnt = 0u; mine = 0u;
#pragma unroll
        for (unsigned j = 0; j < 16; ++j) { const unsigned c = xb_ld(&bar[XB_XCNT(j)]); sum += c; cnt += (c > 0u) ? 1u : 0u; mine = (j == x) ? c : mine; }
        if (sum == Gn) break;
        __builtin_amdgcn_s_sleep(1);
        if ((++sp & 255u) == 0u) { if (xb_ld(&bar[XB_TMO])) break; if (sp > XB_SPIN_CAP) { atomicAdd(&bar[XB_TMO], 1u); break; } }
    }
    nloc = mine > 0u ? mine : 1u; nx = cnt > 0u ? cnt : 1u;
}
__device__ __forceinline__ void xcd_barrier(const XcdBarrier& b, bool leader) {
    asm volatile("s_waitcnt vmcnt(0)" ::: "memory");
    __syncthreads();
    if (leader) {
        unsigned* bar = b.bar;
        __builtin_amdgcn_s_waitcnt(0);
        unsigned nloc = b.st[0], nx = b.st[1];
        if (nloc == 0u) { xcd_barrier_complete(bar, b.x, nloc, nx); b.st[0] = nloc; b.st[1] = nx; }
        const unsigned old = xb_add(&bar[XB_XSUB(b.x)], 1u);
        const unsigned gen = old / nloc;
        if (old + 1u == (gen + 1u) * nloc) {
            __builtin_amdgcn_fence(__ATOMIC_RELEASE, "agent");
            asm volatile("s_waitcnt vmcnt(0)" ::: "memory");
            const unsigned og = xb_add(&bar[XB_TOP], 1u);
            const unsigned tg = og / nx;
            if (og + 1u == (tg + 1u) * nx) xb_add(&bar[XB_TOPGEN], 1u);
            else XB_SPIN(xb_ld(&bar[XB_TOPGEN]) == tg, bar);
            __builtin_amdgcn_fence(__ATOMIC_ACQUIRE, "agent");
            xb_add(&bar[XB_XGEN(b.x)], 1u);
            asm volatile("s_waitcnt vmcnt(0)" ::: "memory");
        } else {
            XB_SPIN(xb_ld(&bar[XB_XGEN(b.x)]) == gen, bar);
            __builtin_amdgcn_fence(__ATOMIC_ACQUIRE, "agent");
            asm volatile("s_waitcnt vmcnt(0)" ::: "memory");
        }
    }
    __syncthreads();
}
#define GSYNC() xcd_barrier(xbar, wave == 0 && lane_id() == 0)

__global__ void __launch_bounds__(NTHREADS, 2) fwd_kernel(Params P) {
    extern __shared__ __attribute__((aligned(16))) unsigned char lds_raw[];
    LAS unsigned char* lds = (LAS unsigned char*)lds_raw;
    cg::grid_group grid = cg::this_grid();
    int tidv = threadIdx.x;
    const int wave = __builtin_amdgcn_readfirstlane(tidv >> 6);
    const int G = gridDim.x, gw_k = blockIdx.x * NWAVES + wave, NGW = G * NWAVES;
    unsigned char* ws = P.ws;
    float* xres = P.out;
    LAS float* scr = (LAS float*)(lds + wave * 16384);
    const float* x_in = P.in[0];
    const float* norm_mix = P.in[1]; const float* norm_mlp = P.in[2]; const float* norm_final = P.in[3];
    const float* mlp_w1 = P.in[4]; const float* mlp_w2 = P.in[5];

    XcdBarrier xbar; xbar.bar = (unsigned*)(ws + WS_BAR); xbar.x = xb_xcc_id(); xbar.st = (volatile LAS unsigned*)(lds + 147456);
    if (tidv < 2) xbar.st[tidv] = 0u;
    if (tidv == 0) (void)xb_add(&xbar.bar[XB_XCNT(xbar.x)], 1u);
    __syncthreads();
    grid.sync();
    for (int layer = 0; layer < 4; ++layer) {
        int lane = tidv; asm volatile("" : "+v"(lane)); lane &= 63;
        int gw = gw_k; asm volatile("" : "+s"(gw));
        const bool is_rwkv = (layer & 1) != 0; const int lj = layer >> 1;
        const float* xsrc = (layer == 0) ? x_in : xres;
        {
            TJob j1{mlp_w1 + (size_t)layer * D * FF, FF, 0, FF, D, (bf16_t*)(ws + WS_W + W_MLP1), D, 0, 0, FF, D, nullptr, 0};
            transpose_job(j1, scr, gw, NGW, lane);
            TJob j2{mlp_w2 + (size_t)layer * FF * D, D, 0, D, FF, (bf16_t*)(ws + WS_W + W_MLP2), FF, 0, 0, D, FF, nullptr, 0};
            transpose_job(j2, scr, gw, NGW, lane);
            if (is_rwkv) {
                const float* mix = P.in[14] + (size_t)lj * 6 * D;
                bf16_t* WrT = (bf16_t*)(ws + WS_W + W_RW_IN);
                const float* wrkv = P.in[15] + (size_t)lj * 3 * D * D;
                for (int part = 0; part < 8; ++part) {
                    const float* W; int ldw, Nsrc, mi, r0, Npad;
                    if (part == 0) { W = wrkv; ldw = D; Nsrc = D; mi = 0; r0 = 0; Npad = D; }
                    else if (part == 1) { W = wrkv + (size_t)D * D; ldw = D; Nsrc = D; mi = 2; r0 = 1024; Npad = D; }
                    else if (part == 2) { W = wrkv + (size_t)2 * D * D; ldw = D; Nsrc = D; mi = 3; r0 = 2048; Npad = D; }
                    else if (part == 3) { W = P.in[17] + (size_t)lj * D * 64; ldw = 64; Nsrc = 64; mi = 1; r0 = 3072; Npad = 128; }
                    else if (part == 4) { W = P.in[20] + (size_t)lj * D * 64; ldw = 64; Nsrc = 64; mi = 4; r0 = 3200; Npad = 128; }
                    else if (part == 5) { W = P.in[22] + (size_t)lj * D * 160; ldw = 160; Nsrc = 160; mi = 5; r0 = 3328; Npad = 256; }
                    else if (part == 6) { W = P.in[31]; ldw = 32; Nsrc = (lj >= 1) ? 32 : 0; mi = 3; r0 = 3584; Npad = 128; }
                    else { W = P.in[31]; ldw = 32; Nsrc = 0; mi = 3; r0 = 3712; Npad = 128; }
                    TJob ja{W, ldw, 0, Nsrc, D, WrT, 2048, r0, 0, Npad, D, mix + mi * D, 1};
                    transpose_job(ja, scr, gw, NGW, lane);
                    TJob jb{W, ldw, 0, Nsrc, D, WrT, 2048, r0, 1024, Npad, D, mix + mi * D, 2};
                    transpose_job(jb, scr, gw, NGW, lane);
                }
                TJob jw{P.in[18] + (size_t)lj * 64 * D, D, 0, D, 64, (bf16_t*)(ws + WS_W + W_RW_W2), 128, 0, 0, D, 128, nullptr, 0}; transpose_job(jw, scr, gw, NGW, lane);
                TJob jaa{P.in[21] + (size_t)lj * 64 * D, D, 0, D, 64, (bf16_t*)(ws + WS_W + W_RW_A2), 128, 0, 0, D, 128, nullptr, 0}; transpose_job(jaa, scr, gw, NGW, lane);
                TJob jv{P.in[32], D, 0, D, (lj >= 1) ? 32 : 0, (bf16_t*)(ws + WS_W + W_RW_V2), 128, 0, 0, D, 128, nullptr, 0}; transpose_job(jv, scr, gw, NGW, lane);
                TJob jg{P.in[23] + (size_t)lj * 160 * D, D, 0, D, 160, (bf16_t*)(ws + WS_W + W_RW_G2), 256, 0, 0, D, 256, nullptr, 0}; transpose_job(jg, scr, gw, NGW, lane);
                TJob jo{P.in[29] + (size_t)lj * D * D, D, 0, D, D, (bf16_t*)(ws + WS_W + W_RW_O), D, 0, 0, D, D, nullptr, 0}; transpose_job(jo, scr, gw, NGW, lane);
                bf16_t* HN = (bf16_t*)(ws + A_HN);
                if (gw < 2) { u32x4* z = (u32x4*)(HN + (size_t)gw * (S + 1) * D); unsigned zz; asm volatile("v_mov_b32 %0, 0" : "=v"(zz)); for (int q = lane; q < D / 8; q += 64) z[q] = (u32x4){zz, zz, zz, zz}; }
                for (int m = gw; m < M; m += NGW) { const int b = m / S; rms_row_bf16(xsrc + (size_t)m * D, norm_mix + layer * D, HN + ((size_t)m + b + 1) * D, nullptr, lane); }
            } else {
                const float* win = P.in[6] + (size_t)lj * D * 2608;
                bf16_t* WnT = (bf16_t*)(ws + WS_W + W_NSA_IN); bf16_t* WvT = (bf16_t*)(ws + WS_W + W_NSA_V);
                for (int part = 0; part < 8; ++part) {
                    int n0src, Nsrc, r0, Npad; bf16_t* WT = WnT;
                    if (part == 0) { n0src = 0; Nsrc = 1024; r0 = 0; Npad = 1024; }
                    else if (part == 1) { n0src = 1024; Nsrc = 256; r0 = 1024; Npad = 256; }
                    else if (part == 2) { n0src = 1024 + 512; Nsrc = 256; r0 = 1280; Npad = 256; }
                    else if (part == 3) { n0src = 1024 + 1024; Nsrc = 256; r0 = 1536; Npad = 256; }
                    else if (part == 4) { n0src = 1024 + 256; Nsrc = 256; r0 = 1792; Npad = 256; }
                    else if (part == 5) { n0src = 2560; Nsrc = 48; r0 = 2048; Npad = 256; }
                    else if (part == 6) { n0src = 1024 + 768; Nsrc = 256; r0 = 0; Npad = 256; WT = WvT; }
                    else { n0src = 1024 + 1280; Nsrc = 256; r0 = 256; Npad = 256; WT = WvT; }
                    TJob jn{win, 2608, n0src, Nsrc, D, WT, D, r0, 0, Npad, D, nullptr, 0}; transpose_job(jn, scr, gw, NGW, lane);
                }
                TJob jo{P.in[13] + (size_t)lj * D * D, D, 0, D, D, (bf16_t*)(ws + WS_W + W_NSA_O), D, 0, 0, D, D, nullptr, 0}; transpose_job(jo, scr, gw, NGW, lane);
                TJob jc1k{P.in[8] + (size_t)lj * 2048 * 256, 256, 0, 256, 2048, (bf16_t*)(ws + WS_W + W_C1K), 2048, 0, 0, 256, 2048, nullptr, 0}; transpose_job(jc1k, scr, gw, NGW, lane);
                TJob jc1v{P.in[11] + (size_t)lj * 2048 * 256, 256, 0, 256, 2048, (bf16_t*)(ws + WS_W + W_C1V), 2048, 0, 0, 256, 2048, nullptr, 0}; transpose_job(jc1v, scr, gw, NGW, lane);
                TJob jc2k{P.in[9] + (size_t)lj * 256 * 64, 64, 0, 64, 256, (bf16_t*)(ws + WS_W + W_C2K), 256, 0, 0, 256, 256, nullptr, 0}; transpose_job(jc2k, scr, gw, NGW, lane);
                TJob jc2v{P.in[12] + (size_t)lj * 256 * 64, 64, 0, 64, 256, (bf16_t*)(ws + WS_W + W_C2V), 256, 0, 0, 256, 256, nullptr, 0}; transpose_job(jc2v, scr, gw, NGW, lane);
                {
                    int ln = lane; asm volatile("" : "+v"(ln));
                    float* cb = (float*)(ws + WS_W + W_CBIAS);
#pragma unroll 1
                    for (int o = gw; o < 512; o += NGW) { const int isv = o >> 8, c = o & 255;
                        const float* pe = (isv ? P.in[10] : P.in[7]) + (size_t)lj * 2048; const float* w1 = (isv ? P.in[11] : P.in[8]) + (size_t)lj * 2048 * 256;
                        float acc = 0.f;
#pragma unroll 1
                        for (int k = ln; k < 2048; k += 64) acc += pe[k] * w1[(size_t)k * 256 + c];
                        acc = wave_sum(acc); if (ln == 0) cb[o] = acc; }
                    if (layer == 0) {
                        float* rt = (float*)(ws + WS_ROPE);
                        int tix = tidv; asm volatile("" : "+v"(tix)); const int gt = (int)blockIdx.x * NTHREADS + tix;
#pragma unroll 1
                        for (int e = gt; e < S * 8; e += G * NTHREADS) { const int tt = e >> 3, i = e & 7;
                            const float invf = (i == 0) ? 1.0f : (i == 1) ? 0.1939227432012558f : (i == 2) ? 0.03760603070259094f : (i == 3) ? 0.007292664609849453f : (i == 4) ? 0.0014142135623842478f : (i == 5) ? 0.00027424818836152554f : (i == 6) ? 5.318296098266728e-05f : 1.0313386155758053e-05f;
                            const float ang = (float)tt * invf; const double rev = (double)ang * 0.15915494309189535; const float fr = (float)(rev - __builtin_rint(rev));
                            rt[tt * 16 + i] = __builtin_amdgcn_cosf(fr); rt[tt * 16 + 8 + i] = __builtin_amdgcn_sinf(fr); }
                    }
                }
                for (int m = gw; m < M; m += NGW) rms_row_bf16(xsrc + (size_t)m * D, norm_mix + layer * D, (bf16_t*)(ws + A_HN) + (size_t)m * D, (layer == 0) ? xres + (size_t)m * D : nullptr, lane);
            }
        }
        GSYNC();
        if (!is_rwkv) {
            bf16_t* HN = (bf16_t*)(ws + A_HN); bf16_t* Qb = (bf16_t*)(ws + A_Q); bf16_t* KFb = (bf16_t*)(ws + A_KF); bf16_t* VFb = (bf16_t*)(ws + A_VF);
            float* GT = (float*)(ws + A_GATES); bf16_t* CHK = (bf16_t*)(ws + A_CHK); bf16_t* CHV = (bf16_t*)(ws + A_CHV); bf16_t* KCb = (bf16_t*)(ws + A_KC); bf16_t* VCb = (bf16_t*)(ws + A_VC);
            {
                pg8::Gemm g{HN, (const bf16_t*)(ws + WS_W + W_NSA_IN), M, 2304, D, D, D, 0};
                pg8::StaticOrder so; so.init(M, 2304, G, (int)blockIdx.x);
                pg8::EpiP<FNsaIn> E{FNsaIn{Qb, KFb, GT, (const float*)(ws + WS_ROPE)}};
                pg8::gemm_phase<pg8::EpiP<FNsaIn>, true>(lds, g, so, E, tidv);
                pg8::Gemm g2{(const bf16_t*)(ws + WS_W + W_NSA_V), HN, 512, M, D, D, D, 0};
                pg8::StaticOrder so2; so2.init(512, M, G, (int)blockIdx.x);
                pg8::EpiP<FNsaVT> E2{FNsaVT{VFb}};
                pg8::gemm_phase<pg8::EpiP<FNsaVT>, true>(lds, g2, so2, E2, tidv);
            }
            GSYNC();
            {
                pg8::StaticOrder so; so.init(8192, 256, G, (int)blockIdx.x);
                pg8::StaticOrder sov; sov.init(8192, 256, G, (int)((blockIdx.x + G - G / 2) % G));
                { pg8::Gemm g{KFb, (const bf16_t*)(ws + WS_W + W_C1K), 8192, 256, 2048, 1024, 2048, 0}; pg8::EpiP<FCmp1> E{FCmp1{CHK, (const float*)(ws + WS_W + W_CBIAS)}}; pg8::gemm_phase<pg8::EpiP<FCmp1>, true>(lds, g, so, E, tidv); }
                { pg8::Gemm g{KFb + 3 * KF_STRIDE, (const bf16_t*)(ws + WS_W + W_C1V), 8192, 256, 2048, 1024, 2048, 0}; pg8::EpiP<FCmp1> E{FCmp1{CHV, (const float*)(ws + WS_W + W_CBIAS) + 256}}; pg8::gemm_phase<pg8::EpiP<FCmp1>, true>(lds, g, sov, E, tidv); }
            }
            GSYNC();
            {
                { pg8::StaticOrder so; so.init(8192, 256, G, (int)blockIdx.x); pg8::Gemm g{CHK, (const bf16_t*)(ws + WS_W + W_C2K), 8192, 256, 256, 256, 256, 0}; pg8::EpiP<FCmp2K> E{FCmp2K{KCb}}; pg8::gemm_phase<pg8::EpiP<FCmp2K>, true>(lds, g, so, E, tidv); }
                { pg8::StaticOrder so; so.init(256, 8192, G, (int)((blockIdx.x + G - G / 2) % G)); pg8::Gemm g{(const bf16_t*)(ws + WS_W + W_C2V), CHV, 256, 8192, 256, 256, 256, 0}; pg8::EpiP<FCmp2VT> E{FCmp2VT{VCb}}; pg8::gemm_phase<pg8::EpiP<FCmp2VT>, true>(lds, g, so, E, tidv); }
            }
            GSYNC();
            nsa_attention(Qb, KFb, VFb, KCb, VCb, GT, HN, lds, G, wave, lane_id());
            tidv = wave * 64 + (lane_id() & 63); asm volatile("" : "+v"(tidv)); tidv &= 511; lane = tidv & 63;
            GSYNC();
            {
                pg8::StaticOrder so; so.init(M, D, G, (int)blockIdx.x);
                pg8::Gemm g{HN, (const bf16_t*)(ws + WS_W + W_NSA_O), M, D, D, D, D, 0}; pg8::EpiN<FResAdd> E{FResAdd{xres}}; pg8::gemm_phase<pg8::EpiN<FResAdd>, true>(lds, g, so, E, tidv);
            }
            GSYNC();
        }
        if (is_rwkv) {
            h16* Rb = (h16*)(ws + A_R); h16* Kb = (h16*)(ws + A_K); h16* Ab = (h16*)(ws + A_A); h16* EWb = (h16*)(ws + A_HN);
            h16* Vb = (lj == 0) ? (h16*)(ws + WS_VF) : (h16*)(ws + A_V2);
            h16* Yraw = (lj == 0) ? (h16*)(ws + A_V2) : (h16*)(ws + WS_VF);
            bf16_t* LH = (bf16_t*)(ws + A_LH);
            {
                pg8::Gemm g{(const bf16_t*)(ws + A_HN), (const bf16_t*)(ws + WS_W + W_RW_IN), M, 3840, 2048, D, 2048, 1};
                pg8::StaticOrder so; so.init(M, 3840, G, (int)blockIdx.x);
                pg8::EpiP<FRwIn> E{FRwIn{Rb, Kb, Vb, LH}};
                pg8::gemm_phase<pg8::EpiP<FRwIn>, true>(lds, g, so, E, tidv);
            }
            GSYNC();
            {
                pg8::StaticOrder so; so.init(M, D, G, (int)blockIdx.x);
                { pg8::Gemm g{LH, (const bf16_t*)(ws + WS_W + W_RW_W2), M, D, 128, 768, 128, 0}; pg8::EpiP<FLoraW> E{FLoraW{EWb, P.in[16] + lj * D}}; pg8::gemm_phase<pg8::EpiP<FLoraW>, true>(lds, g, so, E, tidv); }
                { pg8::Gemm g{LH + 128, (const bf16_t*)(ws + WS_W + W_RW_A2), M, D, 128, 768, 128, 0}; pg8::EpiP<FLoraA> E{FLoraA{Ab, P.in[19] + lj * D}}; pg8::gemm_phase<pg8::EpiP<FLoraA>, true>(lds, g, so, E, tidv); }
                if (lj >= 1) { pg8::Gemm g{LH + 512, (const bf16_t*)(ws + WS_W + W_RW_V2), M, D, 128, 768, 128, 0}; pg8::EpiP<FLoraV> E{FLoraV{Vb, (const h16*)(ws + WS_VF), P.in[30]}}; pg8::gemm_phase<pg8::EpiP<FLoraV>, true>(lds, g, so, E, tidv); }
            }
            GSYNC();
            rwkv_scan2(Rb, Kb, Vb, EWb, Ab, P.in[24] + lj * D, P.in[25] + lj * D, Yraw, lds, wave, lane);
            GSYNC();
            rwkv_gn(Rb, Kb, Vb, Ab, Yraw, P.in[25] + lj * D, P.in[26] + lj * D, P.in[27] + lj * D, P.in[28] + lj * D, gw, NGW, lane);
            GSYNC();
            {
                pg8::StaticOrder so; so.init(M, D, G, (int)blockIdx.x);
                pg8::Gemm g{LH + 256, (const bf16_t*)(ws + WS_W + W_RW_G2), M, D, 256, 768, 256, 0}; pg8::EpiP<FGate> E{FGate{(bf16_t*)Kb, Rb}}; pg8::gemm_phase<pg8::EpiP<FGate>, true>(lds, g, so, E, tidv);
            }
            GSYNC();
            {
                pg8::StaticOrder so; so.init(M, D, G, (int)blockIdx.x);
                pg8::Gemm g{(const bf16_t*)Kb, (const bf16_t*)(ws + WS_W + W_RW_O), M, D, D, D, D, 0}; pg8::EpiN<FResAdd> E{FResAdd{xres}}; pg8::gemm_phase<pg8::EpiN<FResAdd>, true>(lds, g, so, E, tidv);
            }
            GSYNC();
        }
        for (int m = gw; m < M; m += NGW) rms_row_bf16(xres + (size_t)m * D, norm_mlp + layer * D, (bf16_t*)(ws + A_HN) + (size_t)m * D, nullptr, lane);
        GSYNC();
        {
            pg8::Gemm g{(const bf16_t*)(ws + A_HN), (const bf16_t*)(ws + WS_W + W_MLP1), M, FF, D, D, D, 0};
            pg8::StaticOrder so; so.init(M, FF, G, (int)blockIdx.x);
            pg8::EpiP<FRelu2> E{FRelu2{(bf16_t*)(ws + A_HID)}};
            pg8::gemm_phase<pg8::EpiP<FRelu2>, true>(lds, g, so, E, tidv);
        }
        GSYNC();
        {
            pg8::Gemm g{(const bf16_t*)(ws + A_HID), (const bf16_t*)(ws + WS_W + W_MLP2), M, D, FF, FF, FF, 0};
            pg8::StaticOrder so; so.init(M, D, G, (int)blockIdx.x);
            pg8::EpiN<FResAdd> E{FResAdd{xres}};
            pg8::gemm_phase<pg8::EpiN<FResAdd>, true>(lds, g, so, E, tidv);
        }
        GSYNC();
    }
    for (int m = gw_k; m < M; m += NGW) {
        int lane2 = tidv; asm volatile("" : "+v"(lane2)); lane2 &= 63;
        f32x4* xr = (f32x4*)(xres + (size_t)m * D) + lane2; const f32x4* gr = (const f32x4*)norm_final + lane2;
        f32x4 v[4]; float s = 0.f;
#pragma unroll
        for (int j = 0; j < 4; ++j) { v[j] = xr[64 * j]; s += (v[j].x * v[j].x + v[j].y * v[j].y) + (v[j].z * v[j].z + v[j].w * v[j].w); }
        const float r = rsqrtf(wave_sum(s) * (1.f / D) + 1e-5f);
#pragma unroll
        for (int j = 0; j < 4; ++j) { const f32x4 gg = gr[64 * j]; xr[64 * j] = v[j] * r * gg; }
    }
}

extern "C" void kernel_launch(void* const* d_in, const int* in_sizes, int n_in, void* d_out, int out_size, void* d_ws, size_t ws_size, hipStream_t stream) {
    static int grid = 0;
    if (grid == 0) {
        if (n_in != 33 || out_size != M * D || ws_size < WS_NEED) { fprintf(stderr, "kernel_launch: unexpected sizes n_in %d out %d ws %zu (need %zu)\n", n_in, out_size, ws_size, (size_t)WS_NEED); grid = -1; return; }
        int dev = 0, cus = 0, per_cu = 0;
        hipGetDevice(&dev);
        hipDeviceGetAttribute(&cus, hipDeviceAttributeMultiprocessorCount, dev);
        if (hipFuncSetAttribute((const void*)fwd_kernel, hipFuncAttributeMaxDynamicSharedMemorySize, LDS_BYTES) != hipSuccess) { fprintf(stderr, "hipFuncSetAttribute failed\n"); grid = -1; return; }
        hipOccupancyMaxActiveBlocksPerMultiprocessor(&per_cu, (const void*)fwd_kernel, NTHREADS, LDS_BYTES);
        if (per_cu < 1) { fprintf(stderr, "occupancy query returned %d\n", per_cu); per_cu = 1; }
        (void)hipGetLastError();
        grid = cus * 1;
    }
    if (grid < 0) return;
    if (hipMemsetAsync((char*)d_ws + WS_BAR, 0, 16384, stream) != hipSuccess) { fprintf(stderr, "hipMemsetAsync of the barrier words failed\n"); return; }
    Params p{};
    for (int i = 0; i < 33; ++i) p.in[i] = (const float*)d_in[i];
    p.out = (float*)d_out; p.ws = (unsigned char*)d_ws;
    void* args[] = {&p};
    hipError_t e = hipLaunchCooperativeKernel((const void*)fwd_kernel, dim3(grid), dim3(NTHREADS), args, LDS_BYTES, stream);
    if (e != hipSuccess) fprintf(stderr, "cooperative launch failed: %s (grid %d)\n", hipGetErrorString(e), grid);
}
```

```cpp
#include <hip/hip_runtime.h>
#include <hip/hip_cooperative_groups.h>
#include <cstdio>
#include <cstdint>
namespace cg = cooperative_groups;

#define LAS __attribute__((address_space(3)))
typedef unsigned short bf16_t;
typedef short bf16x8 __attribute__((ext_vector_type(8)));
typedef float f32x4 __attribute__((ext_vector_type(4)));
typedef float f32x2 __attribute__((ext_vector_type(2)));
typedef unsigned u32x4 __attribute__((ext_vector_type(4)));
typedef unsigned u32x2 __attribute__((ext_vector_type(2)));
typedef _Float16 h16;
typedef _Float16 h16x2 __attribute__((ext_vector_type(2)));

constexpr int S = 16384, NB = 2, M = NB * S, D = 1024, FF = 4096;
constexpr int NWAVES = 8, NTHREADS = 512;
constexpr int LDS_BYTES = 147456 + 64;
constexpr size_t MiB = 1u << 20;
constexpr size_t WS_W = 0;
constexpr size_t W_MLP1 = 0, W_MLP2 = 8 * MiB;
constexpr size_t W_NSA_IN = 16 * MiB, W_NSA_V = 21 * MiB, W_NSA_O = 22 * MiB, W_C1K = 24 * MiB, W_C1V = 25 * MiB, W_C2K = 26 * MiB, W_C2V = 26 * MiB + 256 * 1024, W_CBIAS = 26 * MiB + 512 * 1024;
constexpr size_t W_RW_IN = 16 * MiB, W_RW_W2 = 31 * MiB, W_RW_A2 = 31 * MiB + 256 * 1024, W_RW_V2 = 31 * MiB + 512 * 1024, W_RW_G2 = 31 * MiB + 768 * 1024, W_RW_O = 33 * MiB;
constexpr size_t WS_ROPE = 36 * MiB;
constexpr size_t WS_BAR = 38 * MiB;
constexpr size_t WS_VF = 40 * MiB;
constexpr size_t ACT = 104 * MiB;
constexpr size_t A_HN = ACT;
constexpr size_t A_Q = ACT + 65 * MiB;
constexpr size_t A_KF = ACT + 129 * MiB;
constexpr size_t A_VF = ACT + 194 * MiB;
constexpr size_t A_GATES = ACT + 226 * MiB;
constexpr size_t A_CHK = ACT + 233 * MiB, A_CHV = ACT + 237 * MiB, A_KC = ACT + 241 * MiB, A_VC = ACT + 242 * MiB;
constexpr size_t A_HID = ACT + 65 * MiB;
constexpr size_t A_R = ACT + 65 * MiB, A_K = ACT + 129 * MiB, A_V2 = ACT + 193 * MiB, A_A = ACT + 257 * MiB, A_LH = ACT + 321 * MiB;
constexpr size_t WS_NEED = ACT + 370 * MiB;

__device__ __forceinline__ int lane_id() { return (int)__builtin_amdgcn_mbcnt_hi(~0u, __builtin_amdgcn_mbcnt_lo(~0u, 0u)); }
__device__ __forceinline__ unsigned cvt_pk_bf16(float lo, float hi) { unsigned r; asm volatile("v_cvt_pk_bf16_f32 %0, %1, %2" : "=v"(r) : "v"(lo), "v"(hi)); return r; }
__device__ __forceinline__ unsigned pk_h16(float lo, float hi) { h16x2 v; v.x = (h16)lo; v.y = (h16)hi; return __builtin_bit_cast(unsigned, v); }
__device__ __forceinline__ float bf2f(bf16_t b) { return __uint_as_float(((unsigned)b) << 16); }
__device__ __forceinline__ float wave_sum(float v) {
#pragma unroll
    for (int o = 1; o < 64; o <<= 1) v += __shfl_xor(v, o);
    return v;
}
__device__ __forceinline__ float sigmoidf_(float x) { return 1.0f / (1.0f + __expf(-x)); }
__device__ __forceinline__ float tanhf_(float x) { float e = __expf(-2.0f * fabsf(x)); float t = (1.0f - e) / (1.0f + e); return x < 0.f ? -t : t; }

namespace pg8 {
constexpr int BM = 256, BK = 64, HALF = 128, HTB = HALF * BK * 2, STAGE_BYTES = 8 * HTB, NXCD = 8, WGM = 8;
__host__ __device__ __forceinline__ int lds_byte(int r, int c) { const int st = (r >> 4) * 2 + (c >> 5), rr = r & 15, cc = c & 31, ob = rr * 64 + cc * 2; return st * 1024 + (ob ^ (((ob >> 9) & 1) << 5)); }
__host__ __device__ __forceinline__ void stage_rc(int b, int& R, int& C) { const int st = b / 1024, sb = b % 1024, swz = sb ^ (((sb >> 9) & 1) << 5); R = (st >> 1) * 16 + swz / 64; C = (st & 1) * 32 + (swz % 64) / 2; }
__host__ __device__ __forceinline__ int perm32(int rho) { const int n = rho >> 4, i = rho & 15; return 8 * (i >> 2) + 4 * n + (i & 3); }
struct Unit { int pm, pn; };
struct Gemm { const bf16_t* A; const bf16_t* Bt; int M, N, K, lda, ldb, amode; };
struct StaticOrder {
    int nM, nN, nwg, G, c;
    __device__ void init(int M_, int N_, int G_, int c_) { nM = M_ / BM; nN = N_ / BM; nwg = nM * nN; G = G_; c = c_; }
    __device__ bool next(int i, Unit& u) const {
        const long L = (long)i * G + c; if (L >= nwg) return false;
        int wgid = (int)L; { const int q = nwg / NXCD, r = nwg % NXCD, xcd = wgid % NXCD, off = wgid / NXCD; wgid = (xcd < r ? xcd * (q + 1) : r * (q + 1) + (xcd - r) * q) + off; }
        const int nig = WGM * nN, gid = wgid / nig, fm = gid * WGM, gsz = (nM - fm) < WGM ? (nM - fm) : WGM;
        u.pm = fm + ((wgid % nig) % gsz); u.pn = (wgid % nig) / gsz; return true;
    }
};
__device__ __forceinline__ const char* a_base(const Gemm& g, int pm) { const size_t row = (size_t)pm * BM + (g.amode == 1 ? (size_t)(pm / 64) : 0); return (const char*)g.A + row * (size_t)g.lda * 2; }

template <class Epi, bool ALIGN_EPI>
__device__ __forceinline__ void gemm_phase(LAS unsigned char* lds, const Gemm g, const StaticOrder& S, const Epi& E, int tid_in) {
    int tid = tid_in; asm volatile("" : "+v"(tid));
    const int wid = __builtin_amdgcn_readfirstlane(tid >> 6), lane = tid & 63, wr = wid >> 2, wc = wid & 3, fr = lane & 15, fq = lane >> 4;
    int K = g.K; asm volatile("" : "+s"(K));
    const int nt = K / BK;
    unsigned voffA[2], voffB[2];
#pragma unroll
    for (int i = 0; i < 2; ++i) { int R, C; stage_rc(tid * 16 + i * 8192, R, C); const int Rb = Epi::PERM ? ((R & ~31) + perm32(R & 31)) : R;
        voffA[i] = (unsigned)(R * g.lda + C) * 2u; voffB[i] = (unsigned)(Rb * g.ldb + C) * 2u; }
    const size_t kstep = (size_t)(BK * 2);
    const size_t hstepA = (size_t)HALF * g.lda * 2, hstepB = (size_t)HALF * g.ldb * 2;
    const size_t tstepB = 2 * hstepB;
    const unsigned ldsw = (unsigned)wid * 1024u;
    const int aoff = lds_byte(wr * 64 + fr, fq * 8), boff = lds_byte(wc * 32 + fr, fq * 8);
#define PG8_SA(b, h) (((b) * 2 + (h)) * HTB)
#define PG8_SB(b, h) ((4 + (b) * 2 + (h)) * HTB)
#define PG8_STAGE(bufoff, gbase, voff) do { _Pragma("unroll") for (int _i = 0; _i < 2; ++_i) \
        __builtin_amdgcn_global_load_lds((const unsigned*)((const char*)(gbase) + (voff)[_i]), (LAS unsigned*)(lds + (bufoff) + ldsw + _i * 8192), 16, 0, 0); } while (0)
#define PG8_LDA(dst, b, h) do { _Pragma("unroll") for (int m = 0; m < 4; ++m) _Pragma("unroll") for (int k = 0; k < 2; ++k) dst[m][k] = *(const LAS bf16x8*)(lds + PG8_SA(b, h) + aoff + m * 2048 + k * 1024); } while (0)
#define PG8_LDB(dst, b, h) do { _Pragma("unroll") for (int n = 0; n < 2; ++n) _Pragma("unroll") for (int k = 0; k < 2; ++k) dst[n][k] = *(const LAS bf16x8*)(lds + PG8_SB(b, h) + boff + n * 2048 + k * 1024); } while (0)
#define PG8_MMA(ai, bj, At, Bt) do { __builtin_amdgcn_s_setprio(1); _Pragma("unroll") for (int m = 0; m < 4; ++m) _Pragma("unroll") for (int n = 0; n < 2; ++n) _Pragma("unroll") for (int k = 0; k < 2; ++k) \
        acc[ai][bj][m][n] = __builtin_amdgcn_mfma_f32_16x16x32_bf16(Bt[n][k], At[m][k], acc[ai][bj][m][n], 0, 0, 0); __builtin_amdgcn_s_setprio(0); } while (0)
#define PG8_WAIT_V(n) asm volatile("s_waitcnt vmcnt(" #n ")" ::: "memory")
#define PG8_WAIT_L(n) asm volatile("s_waitcnt lgkmcnt(" #n ")" ::: "memory")
#define PG8_BAR __builtin_amdgcn_s_barrier()
#define PG8_SCHED __builtin_amdgcn_sched_barrier(0)
    Unit cur, nxt; int ui = 0;
    if (!S.next(0, cur)) return;
    f32x4 acc[2][2][4][2];
#pragma unroll
    for (int a = 0; a < 2; ++a)
#pragma unroll
        for (int b = 0; b < 2; ++b)
#pragma unroll
            for (int m = 0; m < 4; ++m)
#pragma unroll
                for (int n = 0; n < 2; ++n) acc[a][b][m][n] = (f32x4){0.f, 0.f, 0.f, 0.f};
    bf16x8 At[4][2], B0[2][2], B1[2][2];
    const char* cA = a_base(g, cur.pm); const char* cB = (const char*)g.Bt + (size_t)cur.pn * tstepB;
    PG8_STAGE(PG8_SB(0, 0), cB, voffB); PG8_STAGE(PG8_SB(0, 1), cB + hstepB, voffB); PG8_STAGE(PG8_SA(0, 0), cA, voffA); PG8_STAGE(PG8_SA(0, 1), cA + hstepA, voffA);
    if (wr == 1) PG8_BAR;
    PG8_WAIT_V(2); PG8_BAR;
    PG8_STAGE(PG8_SB(1, 0), cB + kstep, voffB); PG8_STAGE(PG8_SA(1, 0), cA + kstep, voffA); PG8_STAGE(PG8_SB(1, 1), cB + hstepB + kstep, voffB);
    PG8_WAIT_V(6); PG8_BAR;
    for (;;) {
        const bool has_next = S.next(ui + 1, nxt);
        const char* nA = has_next ? a_base(g, nxt.pm) : cA; const char* nB = has_next ? (const char*)g.Bt + (size_t)nxt.pn * tstepB : cB;
        for (int t = 0; t < nt; t += 2) {
            const bool last = (t == nt - 2);
            const char* a1 = cA + (size_t)(t + 1) * kstep;
            const char* a2 = last ? nA : cA + (size_t)(t + 2) * kstep; const char* b2 = last ? nB : cB + (size_t)(t + 2) * kstep;
            const char* a3 = a2 + kstep; const char* b3 = b2 + kstep;
            PG8_LDB(B0, 0, 0); PG8_LDB(B1, 0, 1); PG8_SCHED; PG8_LDA(At, 0, 0); PG8_STAGE(PG8_SA(1, 1), a1 + hstepA, voffA);
            PG8_WAIT_V(8); PG8_WAIT_L(0); PG8_BAR; PG8_MMA(0, 0, At, B0); PG8_MMA(0, 1, At, B1); PG8_BAR; PG8_SCHED;
            PG8_LDA(At, 0, 1); PG8_STAGE(PG8_SB(0, 0), b2, voffB); PG8_STAGE(PG8_SB(0, 1), b2 + hstepB, voffB); PG8_STAGE(PG8_SA(0, 0), a2, voffA);
            PG8_WAIT_V(8); PG8_WAIT_L(0); PG8_BAR; PG8_MMA(1, 0, At, B0); PG8_MMA(1, 1, At, B1); PG8_BAR; PG8_SCHED;
            PG8_LDB(B0, 1, 0); PG8_LDB(B1, 1, 1); PG8_SCHED; PG8_LDA(At, 1, 0); PG8_STAGE(PG8_SA(0, 1), a2 + hstepA, voffA);
            PG8_WAIT_V(8); PG8_WAIT_L(0); PG8_BAR; PG8_MMA(0, 0, At, B0); PG8_MMA(0, 1, At, B1); PG8_BAR; PG8_SCHED;
            PG8_LDA(At, 1, 1); PG8_STAGE(PG8_SB(1, 0), b3, voffB); PG8_STAGE(PG8_SB(1, 1), b3 + hstepB, voffB); PG8_STAGE(PG8_SA(1, 0), a3, voffA);
            PG8_WAIT_V(8); PG8_WAIT_L(0); PG8_BAR; PG8_MMA(1, 0, At, B0); PG8_MMA(1, 1, At, B1); PG8_BAR; PG8_SCHED;
        }
        if constexpr (ALIGN_EPI) { if (wr == 0) PG8_BAR; }
        E(acc, cur, wr, wc, fr, fq);
        if (!has_next) break;
#pragma unroll
        for (int a = 0; a < 2; ++a)
#pragma unroll
            for (int b = 0; b < 2; ++b)
#pragma unroll
                for (int m = 0; m < 4; ++m)
#pragma unroll
                    for (int n = 0; n < 2; ++n) acc[a][b][m][n] = (f32x4){0.f, 0.f, 0.f, 0.f};
        cur = nxt; cA = nA; cB = nB; ++ui;
        if constexpr (ALIGN_EPI) { if (wr == 1) PG8_BAR; }
    }
    PG8_WAIT_V(0);
    if constexpr (!ALIGN_EPI) { if (wr == 0) PG8_BAR; }
    PG8_BAR;
#undef PG8_SA
#undef PG8_SB
#undef PG8_STAGE
#undef PG8_LDA
#undef PG8_LDB
#undef PG8_MMA
#undef PG8_WAIT_V
#undef PG8_WAIT_L
#undef PG8_BAR
#undef PG8_SCHED
}
template <class F> struct EpiP {
    static constexpr bool PERM = true; F f;
    __device__ __forceinline__ void operator()(const f32x4 (&acc)[2][2][4][2], const Unit& u, int wr, int wc, int fr, int fq) const {
#pragma unroll
        for (int ai = 0; ai < 2; ++ai)
#pragma unroll
            for (int m = 0; m < 4; ++m) { int row = u.pm * BM + ai * HALF + wr * 64 + m * 16 + fr; asm volatile("" : "+v"(row));
#pragma unroll
                for (int bj = 0; bj < 2; ++bj) { const int col0 = u.pn * BM + bj * HALF + wc * 32 + 8 * fq; f(row, col0, acc[ai][bj][m][0], acc[ai][bj][m][1]); } asm volatile("" ::: "memory"); }
    }
};
template <class F> struct EpiN {
    static constexpr bool PERM = false; F f;
    __device__ __forceinline__ void operator()(const f32x4 (&acc)[2][2][4][2], const Unit& u, int wr, int wc, int fr, int fq) const {
#pragma unroll
        for (int ai = 0; ai < 2; ++ai)
#pragma unroll
            for (int m = 0; m < 4; ++m) { int row = u.pm * BM + ai * HALF + wr * 64 + m * 16 + fr; asm volatile("" : "+v"(row));
#pragma unroll
                for (int bj = 0; bj < 2; ++bj)
#pragma unroll
                    for (int n = 0; n < 2; ++n) { const int col0 = u.pn * BM + bj * HALF + wc * 32 + 16 * n + 4 * fq; f(row, col0, acc[ai][bj][m][n]); } asm volatile("" ::: "memory"); }
    }
};
}

struct Params {
    const float* in[33];
    float* out;
    unsigned char* ws;
};

struct TJob { const float* W; int ldw, n0src, Nsrc, Ksrc; bf16_t* WT; int ldt, row_off, col_off, Npad, Kpad; const float* mix; int mode; };
__device__ __forceinline__ void transpose_job(const TJob& j, LAS float* scr, int gw, int NGW, int lane_) {
    int lane = lane_; asm volatile("" : "+v"(lane));
    const int nblk = j.Npad / 32, kblk = j.Kpad / 64, items = nblk * kblk;
    for (int it = gw; it < items; it += NGW) {
        const int kb = it / nblk, nb = it % nblk, k0 = 64 * kb, n0 = 32 * nb;
#pragma unroll 4
        for (int i = 0; i < 32; ++i) { const int kk = 2 * i + (lane >> 5), n = lane & 31; float v = 0.f;
            if (k0 + kk < j.Ksrc && n0 + n < j.Nsrc) { v = j.W[(size_t)(k0 + kk) * j.ldw + j.n0src + n0 + n];
                if (j.mode == 1) v *= j.mix[k0 + kk]; else if (j.mode == 2) v *= (1.0f - j.mix[k0 + kk]); }
            scr[kk * 33 + n] = v; }
        asm volatile("s_waitcnt lgkmcnt(0)" ::: "memory");
        const int c = lane & 7;
#pragma unroll
        for (int jj = 0; jj < 4; ++jj) { const int n = (lane >> 3) + 8 * jj; const LAS float* s = scr + (8 * c) * 33 + n;
            u32x4 o; o.x = cvt_pk_bf16(s[0 * 33], s[1 * 33]); o.y = cvt_pk_bf16(s[2 * 33], s[3 * 33]); o.z = cvt_pk_bf16(s[4 * 33], s[5 * 33]); o.w = cvt_pk_bf16(s[6 * 33], s[7 * 33]);
            *(u32x4*)(j.WT + (size_t)(j.row_off + n0 + n) * j.ldt + j.col_off + k0 + 8 * c) = o; }
        asm volatile("s_waitcnt lgkmcnt(0)" ::: "memory");
    }
}

__device__ __forceinline__ void rms_row_bf16(const float* xrow, const float* g, bf16_t* orow, float* copy_to, int lane_) {
    int lane = lane_; asm volatile("" : "+v"(lane));
    const f32x4* xr = (const f32x4*)xrow + lane; const f32x4* gr = (const f32x4*)g + lane;
    f32x4 v[4]; float s = 0.f;
#pragma unroll
    for (int j = 0; j < 4; ++j) { v[j] = xr[64 * j]; s += (v[j].x * v[j].x + v[j].y * v[j].y) + (v[j].z * v[j].z + v[j].w * v[j].w); }
    if (copy_to) {
#pragma unroll
        for (int j = 0; j < 4; ++j) ((f32x4*)copy_to + lane)[64 * j] = v[j];
    }
    const float r = rsqrtf(wave_sum(s) * (1.f / D) + 1e-5f);
    u32x2* o8 = (u32x2*)orow + lane;
#pragma unroll
    for (int j = 0; j < 4; ++j) { const f32x4 gg = gr[64 * j]; u32x2 w; w.x = cvt_pk_bf16(v[j].x * r * gg.x, v[j].y * r * gg.y); w.y = cvt_pk_bf16(v[j].z * r * gg.z, v[j].w * r * gg.w); o8[64 * j] = w; }
}

struct FRelu2 { bf16_t* O; __device__ __forceinline__ void operator()(int row, int col0, f32x4 a, f32x4 b) const {
    f32x4 x = a, y = b;
#pragma unroll
    for (int i = 0; i < 4; ++i) { float t = fmaxf(x[i], 0.f); x[i] = t * t; t = fmaxf(y[i], 0.f); y[i] = t * t; }
    u32x4 w; w.x = cvt_pk_bf16(x[0], x[1]); w.y = cvt_pk_bf16(x[2], x[3]); w.z = cvt_pk_bf16(y[0], y[1]); w.w = cvt_pk_bf16(y[2], y[3]);
    *(u32x4*)(O + (size_t)row * FF + col0) = w; } };
struct FResAdd { float* X; __device__ __forceinline__ void operator()(int row, int col0, f32x4 a) const {
    f32x4* p = (f32x4*)(X + (size_t)row * D + col0); *p = *p + a; } };


struct FRwIn { h16* R; h16* Kk; h16* V; bf16_t* LH;
    __device__ __forceinline__ void operator()(int row, int col0, f32x4 a, f32x4 b) const {
        const int seg = __builtin_amdgcn_readfirstlane(col0 >> 10);
        if (seg < 3) { const long dK = (const char*)Kk - (const char*)R, dV = (const char*)V - (const char*)R; const long off = (seg == 1 ? dK : 0l) + (seg == 2 ? dV : 0l); h16* dst = (h16*)((char*)R + off); const int c = col0 & 1023;
            u32x4 w; w.x = pk_h16(a[0], a[1]); w.y = pk_h16(a[2], a[3]); w.z = pk_h16(b[0], b[1]); w.w = pk_h16(b[2], b[3]);
            *(u32x4*)(dst + (size_t)row * D + c) = w; }
        else { const int c = col0 - 3072; f32x4 x = a, y = b;
            if (c < 128) {
#pragma unroll
                for (int i = 0; i < 4; ++i) { x[i] = tanhf_(x[i]); y[i] = tanhf_(y[i]); } }
            else if (c >= 256 && c < 512) {
#pragma unroll
                for (int i = 0; i < 4; ++i) { x[i] = sigmoidf_(x[i]); y[i] = sigmoidf_(y[i]); } }
            u32x4 w; w.x = cvt_pk_bf16(x[0], x[1]); w.y = cvt_pk_bf16(x[2], x[3]); w.z = cvt_pk_bf16(y[0], y[1]); w.w = cvt_pk_bf16(y[2], y[3]);
            *(u32x4*)(LH + (size_t)row * 768 + c) = w; }
    } };
struct FLoraW { h16* EW; const float* w0;
    __device__ __forceinline__ void operator()(int row, int col0, f32x4 a, f32x4 b) const {
        const f32x4 p = *(const f32x4*)(w0 + col0), q = *(const f32x4*)(w0 + col0 + 4); float o[8];
#pragma unroll
        for (int i = 0; i < 4; ++i) { o[i] = 0.60653066f * sigmoidf_(p[i] + a[i]); o[4 + i] = 0.60653066f * sigmoidf_(q[i] + b[i]); }
        u32x4 w; w.x = pk_h16(o[0], o[1]); w.y = pk_h16(o[2], o[3]); w.z = pk_h16(o[4], o[5]); w.w = pk_h16(o[6], o[7]);
        *(u32x4*)(EW + (size_t)row * D + col0) = w; } };
struct FLoraA { h16* Aa; const float* a0;
    __device__ __forceinline__ void operator()(int row, int col0, f32x4 a, f32x4 b) const {
        const f32x4 p = *(const f32x4*)(a0 + col0), q = *(const f32x4*)(a0 + col0 + 4); float o[8];
#pragma unroll
        for (int i = 0; i < 4; ++i) { o[i] = sigmoidf_(p[i] + a[i]); o[4 + i] = sigmoidf_(q[i] + b[i]); }
        u32x4 w; w.x = pk_h16(o[0], o[1]); w.y = pk_h16(o[2], o[3]); w.z = pk_h16(o[4], o[5]); w.w = pk_h16(o[6], o[7]);
        *(u32x4*)(Aa + (size_t)row * D + col0) = w; } };
struct FLoraV { h16* V; const h16* VFm; const float* v0;
    __device__ __forceinline__ void operator()(int row, int col0, f32x4 a, f32x4 b) const {
        const f32x4 p = *(const f32x4*)(v0 + col0), q = *(const f32x4*)(v0 + col0 + 4);
        typedef h16 h16x8 __attribute__((ext_vector_type(8)));
        const h16x8 vv = *(const h16x8*)(V + (size_t)row * D + col0), vf = *(const h16x8*)(VFm + (size_t)row * D + col0); float o[8];
#pragma unroll
        for (int i = 0; i < 4; ++i) { float v = (float)vv[i], f = (float)vf[i]; o[i] = v + (f - v) * sigmoidf_(p[i] + a[i]); v = (float)vv[4 + i]; f = (float)vf[4 + i]; o[4 + i] = v + (f - v) * sigmoidf_(q[i] + b[i]); }
        u32x4 w; w.x = pk_h16(o[0], o[1]); w.y = pk_h16(o[2], o[3]); w.z = pk_h16(o[4], o[5]); w.w = pk_h16(o[6], o[7]);
        *(u32x4*)(V + (size_t)row * D + col0) = w; } };
struct FGate { bf16_t* O; const h16* Y;
    __device__ __forceinline__ void operator()(int row, int col0, f32x4 a, f32x4 b) const {
        typedef h16 h16x8 __attribute__((ext_vector_type(8)));
        const h16x8 yy = *(const h16x8*)(Y + (size_t)row * D + col0);
        u32x4 w; w.x = cvt_pk_bf16(a[0] * (float)yy[0], a[1] * (float)yy[1]); w.y = cvt_pk_bf16(a[2] * (float)yy[2], a[3] * (float)yy[3]);
        w.z = cvt_pk_bf16(b[0] * (float)yy[4], b[1] * (float)yy[5]); w.w = cvt_pk_bf16(b[2] * (float)yy[6], b[3] * (float)yy[7]);
        *(u32x4*)(O + (size_t)row * D + col0) = w; } };

template <int CTRL> __device__ __forceinline__ float dppmov(float v) { return __builtin_bit_cast(float, __builtin_amdgcn_update_dpp(0, __builtin_bit_cast(int, v), CTRL, 0xF, 0xF, true)); }
__device__ __forceinline__ float row16_sum(float v) { v += dppmov<0xB1>(v); v += dppmov<0x4E>(v); v += dppmov<0x124>(v); v += dppmov<0x128>(v); return v; }
typedef _Float16 h16x4 __attribute__((ext_vector_type(4)));
__device__ __forceinline__ void h4_to_f(h16x4 u, float* f) { f[0] = (float)u[0]; f[1] = (float)u[1]; f[2] = (float)u[2]; f[3] = (float)u[3]; }
__device__ __forceinline__ void rwkv_scan(const h16* R, const h16* Kk, const h16* V, const h16* EW, const h16* Aa, const float* k_k, const float* k_a, h16* Yraw, int G, int wave, int lane_) {
    int lane = lane_; asm volatile("" : "+v"(lane));
    const int NT = G * NWAVES;
    for (int task = wave * G + (int)blockIdx.x; task < 512; task += NT) {
        const int bh = task >> 4, rg = task & 15, b = bh >> 4, h = bh & 15;
        const int row = lane >> 4, jg = lane & 15, i = rg * 4 + row;
        const int colj = h * 64 + 4 * jg, coli = h * 64 + i;
        float kkc[4], kac[4];
#pragma unroll
        for (int j = 0; j < 4; ++j) { kkc[j] = k_k[colj + j]; kac[j] = k_a[colj + j]; }
        float s[4] = {0.f, 0.f, 0.f, 0.f};
        const size_t base = (size_t)b * S * D;
        const h16* pR = R + base + colj; const h16* pK = Kk + base + colj; const h16* pA = Aa + base + colj; const h16* pE = EW + base + colj; const h16* pV = V + base + coli;
        h16* pY = Yraw + ((size_t)task * S) * 4 + row;
        constexpr int TC = 4;
        h16x4 cr[TC], ck[TC], ca[TC], ce[TC]; h16 cv[TC];
#pragma unroll
        for (int u = 0; u < TC; ++u) { const size_t o = (size_t)u * D; cr[u] = *(const h16x4*)(pR + o); ck[u] = *(const h16x4*)(pK + o); ca[u] = *(const h16x4*)(pA + o); ce[u] = *(const h16x4*)(pE + o); cv[u] = pV[o]; }
        for (int t0 = 0; t0 < S; t0 += TC) {
            const int tn = (t0 + TC < S) ? t0 + TC : t0;
            h16x4 nr[TC], nk[TC], na[TC], ne[TC]; h16 nv[TC];
#pragma unroll
            for (int u = 0; u < TC; ++u) { const size_t o = (size_t)(tn + u) * D; nr[u] = *(const h16x4*)(pR + o); nk[u] = *(const h16x4*)(pK + o); na[u] = *(const h16x4*)(pA + o); ne[u] = *(const h16x4*)(pE + o); nv[u] = pV[o]; }
#pragma unroll
            for (int u = 0; u < TC; ++u) {
                float rv[4], kv[4], av[4], ev[4]; h4_to_f(cr[u], rv); h4_to_f(ck[u], kv); h4_to_f(ca[u], av); h4_to_f(ce[u], ev);
                const float vi = (float)cv[u];
                float kq[4], n2 = 0.f;
#pragma unroll
                for (int j = 0; j < 4; ++j) { kq[j] = kv[j] * kkc[j]; n2 += kq[j] * kq[j]; }
                n2 = row16_sum(n2);
                const float inv = 1.0f / fmaxf(sqrtf(n2), 1e-12f);
                float kkj[4], kt[4], bb[4], w[4], dot = 0.f;
#pragma unroll
                for (int j = 0; j < 4; ++j) { kkj[j] = kq[j] * inv; kt[j] = kv[j] * (1.0f + (av[j] - 1.0f) * kac[j]); bb[j] = kkj[j] * av[j]; w[j] = __expf(-ev[j]); dot += s[j] * kkj[j]; }
                const float sa = -row16_sum(dot);
                float yd = 0.f;
#pragma unroll
                for (int j = 0; j < 4; ++j) { s[j] = s[j] * w[j] + (sa * bb[j] + vi * kt[j]); yd += s[j] * rv[j]; }
                const float y = row16_sum(yd);
                if (jg == 0) pY[(size_t)(t0 + u) * 4] = (h16)y;
            }
#pragma unroll
            for (int u = 0; u < TC; ++u) { cr[u] = nr[u]; ck[u] = nk[u]; ca[u] = na[u]; ce[u] = ne[u]; cv[u] = nv[u]; }
        }
    }
}
constexpr int SC_CS = 32, SC_STEP_F = 5 * 64 + 8, SC_BUF_F = SC_CS * SC_STEP_F;
#define SC_BAR() do { asm volatile("s_waitcnt lgkmcnt(0)" ::: "memory"); __builtin_amdgcn_s_barrier(); asm volatile("" ::: "memory"); } while (0)
__device__ __forceinline__ float wave_sum_dpp(float v) {
    v = row16_sum(v);
    const float a = __builtin_bit_cast(float, __builtin_amdgcn_readlane(__builtin_bit_cast(int, v), 0)), b = __builtin_bit_cast(float, __builtin_amdgcn_readlane(__builtin_bit_cast(int, v), 16));
    const float c = __builtin_bit_cast(float, __builtin_amdgcn_readlane(__builtin_bit_cast(int, v), 32)), d = __builtin_bit_cast(float, __builtin_amdgcn_readlane(__builtin_bit_cast(int, v), 48));
    return (a + b) + (c + d);
}
struct ScRegs { h16 k[8], a[8], e[8], r[8], v[8]; };
__device__ __forceinline__ void sc_load(ScRegs& g, const h16* R, const h16* Kk, const h16* V, const h16* EW, const h16* Aa, size_t base, int c, int pw, int sub, int lane) {
#pragma unroll
    for (int q = 0; q < 8; ++q) { const size_t o = base + (size_t)(c * SC_CS + pw + 4 * q) * D;
        g.k[q] = Kk[o + lane]; g.a[q] = Aa[o + lane]; g.e[q] = EW[o + lane]; g.r[q] = R[o + lane]; g.v[q] = V[o + sub * 8 + (lane & 7)]; }
}
__device__ __forceinline__ void sc_compute(const ScRegs& g, LAS float* sb, int pw, float kkc, float kac, int lane) {
#pragma unroll
    for (int q = 0; q < 8; ++q) {
        const float kv = (float)g.k[q], av = (float)g.a[q], ev = (float)g.e[q], rv = (float)g.r[q]; const float kq = kv * kkc;
        const float n2 = wave_sum_dpp(kq * kq);
        const float kkj = kq * rsqrtf(fmaxf(n2, 1e-24f)); LAS float* p = sb + (pw + 4 * q) * SC_STEP_F;
        p[lane] = kkj; p[64 + lane] = kkj * av; p[128 + lane] = kv * (1.0f + (av - 1.0f) * kac); p[192 + lane] = __expf(-ev); p[256 + lane] = rv; if (lane < 8) p[320 + lane] = (float)g.v[q];
    }
}
__device__ __forceinline__ void rwkv_scan2(const h16* R, const h16* Kk, const h16* V, const h16* EW, const h16* Aa, const float* k_k, const float* k_a, h16* Yraw, LAS unsigned char* lds, int wave, int lane_) {
    int lane = lane_; asm volatile("" : "+v"(lane));
    LAS float* buf = (LAS float*)lds;
    constexpr int NCH = S / SC_CS;
#pragma unroll 1
    for (int vb = (int)blockIdx.x; vb < 256; vb += (int)gridDim.x) {
        const int bh = vb >> 3, sub = vb & 7, b = bh >> 4, h = bh & 15;
        const size_t base = (size_t)b * S * D + h * 64;
        if (wave >= 4) {
            const int pw = wave - 4;
            const float kkc = k_k[h * 64 + lane], kac = k_a[h * 64 + lane];
            ScRegs ga, gb;
            sc_load(ga, R, Kk, V, EW, Aa, base, 0, pw, sub, lane);
            sc_load(gb, R, Kk, V, EW, Aa, base, 1, pw, sub, lane);
            sc_compute(ga, buf, pw, kkc, kac, lane);
            SC_BAR();
#pragma unroll 1
            for (int c = 0; c < NCH; c += 2) {
                { const int c2 = (c + 2 < NCH) ? c + 2 : c; sc_load(ga, R, Kk, V, EW, Aa, base, c2, pw, sub, lane); }
                sc_compute(gb, buf + SC_BUF_F, pw, kkc, kac, lane);
                SC_BAR();
                { const int c3 = (c + 3 < NCH) ? c + 3 : c + 1; sc_load(gb, R, Kk, V, EW, Aa, base, c3, pw, sub, lane); }
                if (c + 2 < NCH) sc_compute(ga, buf, pw, kkc, kac, lane);
                SC_BAR();
            }
            SC_BAR();
        } else if (wave < 2) {
            const int jg = lane & 15, cw = wave;
            f32x2 sA = {0.f, 0.f}, sB = {0.f, 0.f};
#define SC_LO(v) __builtin_shufflevector(v, v, 0, 1)
#define SC_HI(v) __builtin_shufflevector(v, v, 2, 3)
            SC_BAR();
#pragma unroll 1
            for (int c = 0; c < NCH; ++c) {
                const LAS float* sb = buf + (c & 1) * SC_BUF_F + 4 * jg;
                const LAS float* vb_ = buf + (c & 1) * SC_BUF_F + 320 + cw * 4 + (lane >> 4);
                LAS float* yp = buf + 2 * SC_BUF_F + ((c & 1) * 2 + cw) * (SC_CS * 64) + lane;
                f32x4 kk4 = *(const LAS f32x4*)(sb), bb4 = *(const LAS f32x4*)(sb + 64), kt4 = *(const LAS f32x4*)(sb + 128), w4 = *(const LAS f32x4*)(sb + 192), r4 = *(const LAS f32x4*)(sb + 256); float vi = vb_[0];
                f32x4 kk5 = *(const LAS f32x4*)(sb + SC_STEP_F), bb5 = *(const LAS f32x4*)(sb + SC_STEP_F + 64), kt5 = *(const LAS f32x4*)(sb + SC_STEP_F + 128), w5 = *(const LAS f32x4*)(sb + SC_STEP_F + 192), r5 = *(const LAS f32x4*)(sb + SC_STEP_F + 256); float vi5 = vb_[SC_STEP_F];
#pragma unroll
                for (int st = 0; st < SC_CS; ++st) {
                    const int sn = (st + 2 < SC_CS) ? st + 2 : SC_CS - 1;
                    const f32x4 nkk = *(const LAS f32x4*)(sb + sn * SC_STEP_F), nbb = *(const LAS f32x4*)(sb + sn * SC_STEP_F + 64), nkt = *(const LAS f32x4*)(sb + sn * SC_STEP_F + 128), nw = *(const LAS f32x4*)(sb + sn * SC_STEP_F + 192), nr4 = *(const LAS f32x4*)(sb + sn * SC_STEP_F + 256);
                    const float nvi = vb_[sn * SC_STEP_F];
                    f32x2 tt = sA * SC_LO(kk4); tt = sB * SC_HI(kk4) + tt;
                    const float sa = -row16_sum(tt.x + tt.y);
                    const f32x2 sa2 = {sa, sa}, vi2 = {vi, vi};
                    f32x2 uA = vi2 * SC_LO(kt4); uA = sa2 * SC_LO(bb4) + uA; sA = sA * SC_LO(w4) + uA;
                    f32x2 uB = vi2 * SC_HI(kt4); uB = sa2 * SC_HI(bb4) + uB; sB = sB * SC_HI(w4) + uB;
                    f32x2 yy = sA * SC_LO(r4); yy = sB * SC_HI(r4) + yy;
                    yp[st * 64] = yy.x + yy.y;
                    kk4 = kk5; bb4 = bb5; kt4 = kt5; w4 = w5; r4 = r5; vi = vi5;
                    kk5 = nkk; bb5 = nbb; kt5 = nkt; w5 = nw; r5 = nr4; vi5 = nvi;
                }
                SC_BAR();
            }
            SC_BAR();
        } else {
            const int cw = wave - 2;
            h16* pY = Yraw + ((size_t)(bh * 16 + sub * 2 + cw) * S) * 4;
            SC_BAR();
#pragma unroll 1
            for (int c = 0; c <= NCH; ++c) {
                if (c > 0) {
                    const LAS float* yp = buf + 2 * SC_BUF_F + (((c - 1) & 1) * 2 + cw) * (SC_CS * 64);
                    const int st = lane >> 1, r0 = 2 * (lane & 1);
                    float a0 = 0.f, a1 = 0.f;
#pragma unroll
                    for (int q = 0; q < 4; ++q) { const f32x4 x = *(const LAS f32x4*)(yp + st * 64 + r0 * 16 + 4 * q), z = *(const LAS f32x4*)(yp + st * 64 + (r0 + 1) * 16 + 4 * q);
                        a0 += (x[0] + x[1]) + (x[2] + x[3]); a1 += (z[0] + z[1]) + (z[2] + z[3]); }
                    *(unsigned*)(pY + (size_t)((c - 1) * SC_CS + st) * 4 + r0) = pk_h16(a0, a1);
                }
                SC_BAR();
            }
        }
        if (false) {
            SC_BAR();
#pragma unroll 1
            for (int c = 0; c < NCH; ++c) SC_BAR();
        }
    }
}
__device__ __forceinline__ void rwkv_gn(h16* R, const h16* Kk, const h16* V, const h16* Aa, const h16* Yraw, const float* k_a, const float* r_k, const float* ln_w, const float* ln_b, int gw, int NGW, int lane_) {
    int lane = lane_; asm volatile("" : "+v"(lane));
    const int hq = lane >> 4, c4 = 4 * (lane & 15);
#pragma unroll 2
    for (int idx = gw; idx < M * 4; idx += NGW) {
        const int m = idx >> 2, h = (idx & 3) * 4 + hq, col = h * 64 + c4; const size_t o = (size_t)m * D + col;
        const int bq = m / S, tq = m - bq * S;
        float y[4], r[4], k[4], a[4], v[4];
        h4_to_f(*(const h16x4*)(Yraw + ((size_t)((bq * 16 + h) * 16 + (lane & 15)) * S + tq) * 4), y);
        h4_to_f(*(const h16x4*)(R + o), r); h4_to_f(*(const h16x4*)(Kk + o), k); h4_to_f(*(const h16x4*)(Aa + o), a); h4_to_f(*(const h16x4*)(V + o), v);
        const f32x4 ka4 = *(const f32x4*)(k_a + col), rk4 = *(const f32x4*)(r_k + col), lw4 = *(const f32x4*)(ln_w + col), lb4 = *(const f32x4*)(ln_b + col);
        const float mu = row16_sum((y[0] + y[1]) + (y[2] + y[3])) * (1.f / 64.f);
        float d[4], q = 0.f, bsp = 0.f;
#pragma unroll
        for (int i = 0; i < 4; ++i) { d[i] = y[i] - mu; q += d[i] * d[i]; const float kt = k[i] * (1.0f + (a[i] - 1.0f) * ka4[i]); bsp += r[i] * kt * rk4[i]; }
        const float rstd = rsqrtf(row16_sum(q) * (1.f / 64.f) + 64e-5f), bs = row16_sum(bsp);
        h16x4 outv;
#pragma unroll
        for (int i = 0; i < 4; ++i) outv[i] = (h16)(d[i] * rstd * lw4[i] + lb4[i] + bs * v[i]);
        *(h16x4*)(R + o) = outv;
    }
}

constexpr size_t KF_STRIDE = (size_t)NB * 4 * S * 64;
__device__ __forceinline__ float gelu_tanh(float x) { const float u = 0.7978845608f * (x + 0.044715f * x * x * x); return 0.5f * x * (1.0f + tanhf_(u)); }
__device__ __forceinline__ void store_vf8(bf16_t* chunk_base_d, int keyp0  , f32x4 a, f32x4 b) {
    const int tile = keyp0 >> 4, rq0 = (keyp0 & 15) >> 2;
    u32x2 w0, w1; w0.x = cvt_pk_bf16(a[0], a[1]); w0.y = cvt_pk_bf16(a[2], a[3]); w1.x = cvt_pk_bf16(b[0], b[1]); w1.y = cvt_pk_bf16(b[2], b[3]);
    *(u32x2*)(chunk_base_d + 8 * rq0 + 4 * tile) = w0; *(u32x2*)(chunk_base_d + 8 * (rq0 + 1) + 4 * tile) = w1;
}
struct FNsaIn { bf16_t* Q; bf16_t* KF; float* gates; const float* rope;
    __device__ __forceinline__ void operator()(int row, int col0, f32x4 a, f32x4 b) const {
        const int tile = __builtin_amdgcn_readfirstlane(col0 >> 8);
        const int bb = row / S, t = row - bb * S;
        if (tile < 7) {
            f32x4 x = a, y = b;
            if ((col0 & 32) == 0) {
                f32x4 px, py;
#pragma unroll
                for (int i = 0; i < 4; ++i) { px[i] = __shfl_xor(x[i], 16); py[i] = __shfl_xor(y[i], 16); }
                const int d0 = col0 & 63;
                if (d0 < 16) { const f32x4 c0 = *(const f32x4*)(rope + t * 16), c1 = *(const f32x4*)(rope + t * 16 + 4), s0 = *(const f32x4*)(rope + t * 16 + 8), s1 = *(const f32x4*)(rope + t * 16 + 12);
                    if (d0 == 0) { x = x * c0 - px * s0; y = y * c1 - py * s1; } else { x = x * c0 + px * s0; y = y * c1 + py * s1; } }
            }
            if (tile < 4) { x = x * 0.18033688011112042f; y = y * 0.18033688011112042f;
                u32x4 w; w.x = cvt_pk_bf16(x[0], x[1]); w.y = cvt_pk_bf16(x[2], x[3]); w.z = cvt_pk_bf16(y[0], y[1]); w.w = cvt_pk_bf16(y[2], y[3]);
                *(u32x4*)(Q + (size_t)row * D + col0) = w; }
            else { const int idx = tile - 4, g = (col0 & 255) >> 6, d0 = col0 & 63;
                u32x4 w; w.x = cvt_pk_bf16(x[0], x[1]); w.y = cvt_pk_bf16(x[2], x[3]); w.z = cvt_pk_bf16(y[0], y[1]); w.w = cvt_pk_bf16(y[2], y[3]);
                *(u32x4*)(KF + (size_t)idx * KF_STRIDE + ((size_t)(bb * 4 + g) * S + t) * 64 + d0) = w; }
        } else if (tile == 7) { const int g = (col0 & 255) >> 6, d0 = col0 & 63;
            u32x4 w; w.x = cvt_pk_bf16(a[0], a[1]); w.y = cvt_pk_bf16(a[2], a[3]); w.z = cvt_pk_bf16(b[0], b[1]); w.w = cvt_pk_bf16(b[2], b[3]);
            *(u32x4*)(KF + (size_t)3 * KF_STRIDE + ((size_t)(bb * 4 + g) * S + t) * 64 + d0) = w;
        } else { const int c = col0 - 2048;
            if (c < 48) { f32x4 x, y;
#pragma unroll
                for (int i = 0; i < 4; ++i) { x[i] = sigmoidf_(a[i]); y[i] = sigmoidf_(b[i]); }
                *(f32x4*)(gates + (size_t)row * 48 + c) = x; *(f32x4*)(gates + (size_t)row * 48 + c + 4) = y; }
        }
    } };
struct FNsaVT { bf16_t* VF;
    __device__ __forceinline__ void operator()(int row, int col0, f32x4 a, f32x4 b) const {
        const int br = row >> 8, g = (row >> 6) & 3, d = row & 63, bb = col0 / S, t0 = col0 - bb * S;
        bf16_t* base = VF + (size_t)br * KF_STRIDE + (size_t)(bb * 4 + g) * S * 64 + (size_t)(t0 >> 5) * 2048 + d * 32;
        store_vf8(base, t0 & 31, a, b); } };
struct FCmp1 { bf16_t* CH; const float* bias;
    __device__ __forceinline__ void operator()(int row, int col0, f32x4 a, f32x4 b) const {
        const f32x4 p = *(const f32x4*)(bias + col0), q = *(const f32x4*)(bias + col0 + 4); float o[8];
#pragma unroll
        for (int i = 0; i < 4; ++i) { o[i] = gelu_tanh(a[i] + p[i]); o[4 + i] = gelu_tanh(b[i] + q[i]); }
        u32x4 w; w.x = cvt_pk_bf16(o[0], o[1]); w.y = cvt_pk_bf16(o[2], o[3]); w.z = cvt_pk_bf16(o[4], o[5]); w.w = cvt_pk_bf16(o[6], o[7]);
        *(u32x4*)(CH + (size_t)row * 256 + col0) = w; } };
struct FCmp2K { bf16_t* KC;
    __device__ __forceinline__ void operator()(int row, int col0, f32x4 a, f32x4 b) const {
        if (col0 < 64) { u32x4 w; w.x = cvt_pk_bf16(a[0], a[1]); w.y = cvt_pk_bf16(a[2], a[3]); w.z = cvt_pk_bf16(b[0], b[1]); w.w = cvt_pk_bf16(b[2], b[3]);
            *(u32x4*)(KC + (size_t)row * 64 + col0) = w; } } };
struct FCmp2VT { bf16_t* VC;
    __device__ __forceinline__ void operator()(int row, int col0, f32x4 a, f32x4 b) const {
        if (row < 64) { const int bg = col0 >> 10, n0 = col0 & 1023;
            bf16_t* base = VC + (size_t)bg * 65536 + (size_t)(n0 >> 5) * 2048 + row * 32; store_vf8(base, n0 & 31, a, b); } } };

__device__ __forceinline__ f32x4 mfma16(bf16x8 a, bf16x8 b, f32x4 c) { return __builtin_amdgcn_mfma_f32_16x16x32_bf16(a, b, c, 0, 0, 0); }
__device__ __forceinline__ bf16x8 ld8(const bf16_t* p) { return *(const bf16x8*)p; }
__device__ __forceinline__ bf16x8 pack8(f32x4 a, f32x4 b) { u32x4 w; w.x = cvt_pk_bf16(a[0], a[1]); w.y = cvt_pk_bf16(a[2], a[3]); w.z = cvt_pk_bf16(b[0], b[1]); w.w = cvt_pk_bf16(b[2], b[3]); return __builtin_bit_cast(bf16x8, w); }
__device__ __forceinline__ float colmax(float x) {
    const auto r = __builtin_amdgcn_permlane16_swap(__float_as_uint(x), __float_as_uint(x), false, false); x = fmaxf(__uint_as_float(r[0]), __uint_as_float(r[1]));
    const auto q = __builtin_amdgcn_permlane32_swap(__float_as_uint(x), __float_as_uint(x), false, false); return fmaxf(__uint_as_float(q[0]), __uint_as_float(q[1])); }
__device__ __forceinline__ float colsum(float x) {
    const auto r = __builtin_amdgcn_permlane16_swap(__float_as_uint(x), __float_as_uint(x), false, false); x = __uint_as_float(r[0]) + __uint_as_float(r[1]);
    const auto q = __builtin_amdgcn_permlane32_swap(__float_as_uint(x), __float_as_uint(x), false, false); return __uint_as_float(q[0]) + __uint_as_float(q[1]); }
template <int CTRL> __device__ __forceinline__ unsigned dppmov_u(unsigned v) { return (unsigned)__builtin_amdgcn_update_dpp(0, (int)v, CTRL, 0xF, 0xF, true); }
__device__ __forceinline__ unsigned wave_max_u32(unsigned v) {
    v = max(v, dppmov_u<0xB1>(v)); v = max(v, dppmov_u<0x4E>(v)); v = max(v, dppmov_u<0x124>(v)); v = max(v, dppmov_u<0x128>(v));
    const auto r = __builtin_amdgcn_permlane16_swap(v, v, false, false); v = max((unsigned)r[0], (unsigned)r[1]);
    const auto q = __builtin_amdgcn_permlane32_swap(v, v, false, false); return max((unsigned)q[0], (unsigned)q[1]); }
struct AttnState { float m, l; f32x4 o[4]; };
__device__ __forceinline__ void attn_init(AttnState& st) { st.m = -1e30f; st.l = 0.f;
#pragma unroll
    for (int d = 0; d < 4; ++d) st.o[d] = (f32x4){0.f, 0.f, 0.f, 0.f}; }
struct KVChunk { bf16x8 k[4]; bf16x8 v[4]; };
__device__ __forceinline__ void kv_load(KVChunk& B, const bf16_t* kptr, const bf16_t* vptr) {
#pragma unroll
    for (int tl = 0; tl < 2; ++tl) { B.k[tl * 2] = ld8(kptr + tl * 1024); B.k[tl * 2 + 1] = ld8(kptr + tl * 1024 + 32); }
#pragma unroll
    for (int d = 0; d < 4; ++d) B.v[d] = ld8(vptr + d * 512);
}
struct KRange { int klo, span; };
__device__ __forceinline__ KRange krange(int klo, int khi) { KRange r; if (khi < klo) { r.klo = 64; r.span = 0; } else { r.klo = klo; r.span = khi - klo; } return r; }
template <bool MASKED>
__device__ __forceinline__ void attn_chunk_r(AttnState& st, const bf16x8 (&kf)[4], const bf16x8 (&vf)[4], const bf16x8 q0, const bf16x8 q1, KRange kr) {
    f32x4 s[2];
#pragma unroll
    for (int tl = 0; tl < 2; ++tl) { s[tl] = mfma16(kf[tl * 2], q0, (f32x4){0.f, 0.f, 0.f, 0.f}); s[tl] = mfma16(kf[tl * 2 + 1], q1, s[tl]); }
    float mx = -1e30f;
#pragma unroll
    for (int tl = 0; tl < 2; ++tl)
#pragma unroll
        for (int i = 0; i < 4; ++i) { if (MASKED) { const bool v = (unsigned)(tl * 16 + i - kr.klo) <= (unsigned)kr.span; s[tl][i] = v ? s[tl][i] : -1e30f; } mx = fmaxf(mx, s[tl][i]); }
    mx = colmax(mx);
    if (__any(mx > st.m)) {
        const float mnew = fmaxf(st.m, mx), alpha = __builtin_amdgcn_exp2f(st.m - mnew);
        st.l *= alpha; st.m = mnew;
#pragma unroll
        for (int d = 0; d < 4; ++d) st.o[d] = st.o[d] * alpha;
    }
    const float mcur = st.m;
    f32x4 p[2]; float ps = 0.f;
#pragma unroll
    for (int tl = 0; tl < 2; ++tl)
#pragma unroll
        for (int i = 0; i < 4; ++i) { const float e = __builtin_amdgcn_exp2f(s[tl][i] - mcur); p[tl][i] = e; ps += e; }
    st.l += ps;
    const bf16x8 pb = pack8(p[0], p[1]);
#pragma unroll
    for (int d = 0; d < 4; ++d) st.o[d] = mfma16(vf[d], pb, st.o[d]);
}

#define ATT_STEPN(C, idx) do { _Pragma("unroll") for (int gg = 0; gg < NG; ++gg) { if (act(gg, idx)) { \
        if (ff(gg, idx)) attn_chunk_r<false>(gs[gg], C.k, C.v, gq[gg][0], gq[gg][1], KRange{0, 0}); else attn_chunk_r<true>(gs[gg], C.k, C.v, gq[gg][0], gq[gg][1], mf(gg, idx)); } \
        __builtin_amdgcn_sched_barrier(0); } } while (0)
template <int NG, class AddrK, class AddrV, class ActF, class FullF, class MaskF>
__device__ __forceinline__ void attn_chunksN(AttnState (&gs)[NG], const bf16x8 (&gq)[NG][2], int n, AddrK ak, AddrV av, ActF act, FullF ff, MaskF mf) {
    if constexpr (NG <= 2) {
        KVChunk C0, C1;
        if (n > 0) kv_load(C0, ak(0), av(0));
#pragma unroll 1
        for (int i = 0; i < n; i += 2) {
            if (i + 1 < n) kv_load(C1, ak(i + 1), av(i + 1));
            ATT_STEPN(C0, i);
            if (i + 1 < n) {
                if (i + 2 < n) kv_load(C0, ak(i + 2), av(i + 2));
                ATT_STEPN(C1, i + 1);
            }
        }
    } else {
#pragma unroll 1
        for (int i = 0; i < n; ++i) { KVChunk C0; kv_load(C0, ak(i), av(i)); ATT_STEPN(C0, i); }
    }
}

__device__ __forceinline__ void nsa_attention(const bf16_t* Q, const bf16_t* KF, const bf16_t* VF, const bf16_t* KC, const bf16_t* VC, const float* gates, bf16_t* OUT, LAS unsigned char* lds, int G, int wave, int lane_) {
    int lane0 = lane_; asm volatile("" : "+v"(lane0));
    LAS float* imp = (LAS float*)(lds + wave * 18432);
    LAS float* tl = imp;
    LAS int* sel = (LAS int*)(lds + wave * 18432 + 16384);
    LAS unsigned* smask32 = (LAS unsigned*)(lds + wave * 18432 + 16384 + 1088);
    LAS unsigned char* blist = (LAS unsigned char*)(lds + wave * 18432 + 16384 + 1088 + 512);
    const bool xcd_map = (G % 8) == 0;
    const int nslots = xcd_map ? (G >> 3) * NWAVES : G * NWAVES, slot = xcd_map ? ((int)blockIdx.x >> 3) * NWAVES + wave : (int)blockIdx.x * NWAVES + wave;
    const int ntask = xcd_map ? 1024 : 8192;
#pragma unroll 1
    for (int task = slot; task < ntask; task += nslots) {
        int lane = lane0; asm volatile("" : "+v"(lane)); lane &= 63;
        const int col = lane & 15, rq = lane >> 4;
        const int tilei = xcd_map ? task : (task >> 3), bg = xcd_map ? ((int)blockIdx.x & 7) : (task & 7), b = bg >> 2, g = bg & 3, t0 = tilei * 16, t = t0 + col;
        const size_t rowq = (size_t)b * S + t;
        const bf16_t* qrow = Q + rowq * D + (g * 4) * 64 + 8 * rq;
        const float* grow = gates + rowq * 48 + g * 12;
        const int cur_max = (t0 + 15) >> 6;
        int n_end = 4 * (cur_max + 1); if (n_end > 1024) n_end = 1024;
        const int nchunk_c = (n_end + 31) >> 5;
        const bf16_t* kc_l = KC + (size_t)bg * 65536 + (size_t)col * 64 + 8 * rq;
        const bf16_t* vc_l = VC + (size_t)bg * 65536 + (size_t)col * 32 + 8 * rq;
        {
        AttnState gs[4]; bf16x8 gq[4][2];
#pragma unroll
        for (int h = 0; h < 4; ++h) { gq[h][0] = ld8(qrow + h * 64); gq[h][1] = ld8(qrow + h * 64 + 32); attn_init(gs[h]); }
        attn_chunksN<4>(gs, gq, nchunk_c,
            [&](int ci) { return kc_l + (size_t)ci * 2048; }, [&](int ci) { return vc_l + (size_t)ci * 2048; },
            [&](int, int) { return true; },
            [&](int, int ci) { return 16 * (ci * 32 + 31) + 31 <= t0; },
            [&](int, int ci) { const int nhi = (t >= 31) ? ((t - 31) >> 4) : -1; return krange(0, nhi - ci * 32 - 4 * rq); });
        {
            float mc[4], lc[4];
#pragma unroll
            for (int h = 0; h < 4; ++h) { const float lt = colsum(gs[h].l); mc[h] = gs[h].m; lc[h] = (gs[h].m > -1e29f && lt > 0.f) ? 1.0f / lt : 0.f; }
            {
                float carry = 0.f;
#pragma unroll 1
                for (int kc = 0; kc < nchunk_c; ++kc) {
#pragma unroll
                    for (int tt = 0; tt < 2; ++tt) {
                        const bf16x8 k0 = ld8(kc_l + (size_t)kc * 2048 + tt * 1024), k1 = ld8(kc_l + (size_t)kc * 2048 + tt * 1024 + 32);
                        float own = 0.f, p3 = 0.f;
#pragma unroll
                        for (int h = 0; h < 4; ++h) {
                            f32x4 sc = mfma16(k0, gq[h][0], (f32x4){0.f, 0.f, 0.f, 0.f}); sc = mfma16(k1, gq[h][1], sc);
#pragma unroll
                            for (int i = 0; i < 4; ++i) { const int n = kc * 32 + tt * 16 + 4 * rq + i; const float p = (16 * n + 31 <= t) ? __builtin_amdgcn_exp2f(sc[i] - mc[h]) * lc[h] : 0.f; own += p; if (i == 3) p3 += p; }
                        }
                        const float up = __shfl(p3, (lane + 48) & 63);
                        const float add = (rq == 0) ? carry : up;
                        imp[col * 256 + kc * 8 + tt * 4 + rq] = own + add;
                        carry = __shfl(p3, col + 48);
                    }
                }
            }
#pragma unroll 1
            for (int c = 0; c < 16; ++c) {
                const int tc = t0 + c, cur = tc >> 6;
                if (cur < 16) { if (lane <= cur) sel[c * 17 + lane] = lane; if (lane == 0) sel[c * 17 + 16] = cur + 1; }
                else {
                    unsigned key[4];
#pragma unroll
                    for (int jx = 0; jx < 4; ++jx) { const int sb = lane + 64 * jx; const float v = imp[c * 256 + sb]; key[jx] = (sb >= 1 && sb <= cur - 2) ? ((__float_as_uint(v) & 0xFFFFFF00u) | (unsigned)(255 - sb)) : 0u; }
                    if (lane == 0) { sel[c * 17 + 0] = 0; sel[c * 17 + 1] = cur - 1; sel[c * 17 + 2] = cur; sel[c * 17 + 16] = 16; }
#pragma unroll 1
                    for (int r = 0; r < 13; ++r) {
                        unsigned best = max(max(key[0], key[1]), max(key[2], key[3]));
                        best = wave_max_u32(best);
                        if (lane == 0) sel[c * 17 + 3 + r] = 255 - (int)(best & 255u);
#pragma unroll
                        for (int jx = 0; jx < 4; ++jx) if (key[jx] == best) key[jx] = 0u;
                    }
                }
            }
#pragma unroll
            for (int h = 0; h < 4; ++h) { const float gc = grow[h * 3 + 0] * lc[h];
#pragma unroll
                for (int d = 0; d < 4; ++d)
#pragma unroll
                    for (int i = 0; i < 4; ++i) tl[(h * 16 + d * 4 + i) * 64 + lane] = gs[h].o[d][i] * gc; }
        }
        }
        {
            smask32[lane] = 0u; smask32[64 + lane] = 0u;
#pragma unroll
            for (int k4 = 0; k4 < 4; ++k4) { const int pp = lane + 64 * k4, c = pp >> 4, e = pp & 15; if (e < sel[c * 17 + 16]) { const int jb = sel[c * 17 + e]; atomicOr((unsigned*)(smask32 + (jb >> 1)), 1u << (c + 16 * (jb & 1))); } }
            const bf16_t* ks_b = KF + (size_t)1 * KF_STRIDE + (size_t)bg * S * 64 + (size_t)col * 64 + 8 * rq;
            const bf16_t* vs_b = VF + (size_t)bg * S * 64 + (size_t)col * 32 + 8 * rq;
            const int tokl = col >> 2, hd = col & 3;
            {
                int nblk = 0;
                LAS unsigned* bl32 = (LAS unsigned*)sel;
                unsigned mk4[4];
#pragma unroll
                for (int k4 = 0; k4 < 4; ++k4) { const int jb = lane + 64 * k4; mk4[k4] = (smask32[jb >> 1] >> (16 * (jb & 1))) & 0xFFFFu; }
#pragma unroll
                for (int k4 = 0; k4 < 4; ++k4) { const int jb = lane + 64 * k4; const unsigned mk = mk4[k4];
                    const unsigned long long bal = __ballot(mk != 0u); const int pos = nblk + __popcll(bal & ((1ull << lane) - 1ull)); if (mk != 0u) bl32[pos] = (unsigned)jb | (mk << 8); nblk += __popcll(bal); }
                AttnState hs[4]; bf16x8 hq[4][2];
#pragma unroll
                for (int cg = 0; cg < 4; ++cg) { const bf16_t* qp = Q + ((size_t)b * S + t0 + 4 * cg + tokl) * D + (g * 4 + hd) * 64 + 8 * rq; hq[cg][0] = ld8(qp); hq[cg][1] = ld8(qp + 32); attn_init(hs[cg]); }
                auto wrd_of = [&](int ci) { return (unsigned)__builtin_amdgcn_readfirstlane((int)bl32[ci >> 1]); };
                const int tb = t0;
                attn_chunksN<4>(hs, hq, nblk * 2,
                    [&](int ci) { return ks_b + (size_t)((int)(wrd_of(ci) & 255u) * 2 + (ci & 1)) * 2048; },
                    [&](int ci) { return vs_b + (size_t)((int)(wrd_of(ci) & 255u) * 2 + (ci & 1)) * 2048; },
                    [&](int cg, int ci) { return ((wrd_of(ci) >> (8 + 4 * cg)) & 15u) != 0u; },
                    [&](int cg, int ci) { const unsigned wd = wrd_of(ci); const int jb = (int)(wd & 255u); return ((wd >> (8 + 4 * cg)) & 15u) == 15u && jb * 64 + (ci & 1) * 32 + 31 <= tb + 4 * cg; },
                    [&](int cg, int ci) { const unsigned wd = wrd_of(ci); const int jb = (int)(wd & 255u); const unsigned mk = wd >> 8; const int tok = 4 * cg + tokl; const int kp0 = jb * 64 + (ci & 1) * 32 + 4 * rq;
                        return krange(0, ((mk >> tok) & 1u) ? (tb + tok - kp0) : -1); });
#pragma unroll
                for (int cg = 0; cg < 4; ++cg) { const int tok = 4 * cg + tokl;
                    const float lt = colsum(hs[cg].l); const float inv = (hs[cg].m > -1e29f && lt > 0.f) ? 1.0f / lt : 0.f;
                    const float gsv = gates[((size_t)b * S + t0 + tok) * 48 + g * 12 + hd * 3 + 1] * inv;
#pragma unroll
                    for (int d = 0; d < 4; ++d)
#pragma unroll
                        for (int i = 0; i < 4; ++i) tl[(hd * 16 + d * 4 + i) * 64 + tok + 16 * rq] += hs[cg].o[d][i] * gsv; }
            }
        }
        {
            int lo = t0 - 511; if (lo < 0) lo = 0; const int c0 = lo >> 5, c1 = (t0 + 15) >> 5;
            const bf16_t* kw_b = KF + (size_t)2 * KF_STRIDE + (size_t)bg * S * 64 + (size_t)col * 64 + 8 * rq;
            const bf16_t* vw_b = VF + (size_t)1 * KF_STRIDE + (size_t)bg * S * 64 + (size_t)col * 32 + 8 * rq;
            {
                AttnState gs[4]; bf16x8 gq[4][2];
#pragma unroll
                for (int h = 0; h < 4; ++h) { gq[h][0] = ld8(qrow + h * 64); gq[h][1] = ld8(qrow + h * 64 + 32); attn_init(gs[h]); }
                attn_chunksN<4>(gs, gq, c1 - c0 + 1,
                    [&](int ci) { return kw_b + (size_t)(c0 + ci) * 2048; }, [&](int ci) { return vw_b + (size_t)(c0 + ci) * 2048; },
                    [&](int, int) { return true; },
                    [&](int, int ci) { return (c0 + ci) * 32 + 31 <= t0 && (c0 + ci) * 32 + 512 > t0 + 15; },
                    [&](int, int ci) { const int cb = (c0 + ci) * 32 + 4 * rq; return krange(t - 511 - cb, t - cb); });
#pragma unroll
                for (int h = 0; h < 4; ++h) { const float lt = colsum(gs[h].l); const float inv = (gs[h].m > -1e29f && lt > 0.f) ? 1.0f / lt : 0.f; const float gwv = grow[h * 3 + 2] * inv;
#pragma unroll
                    for (int d = 0; d < 4; ++d)
#pragma unroll
                        for (int i = 0; i < 4; ++i) tl[(h * 16 + d * 4 + i) * 64 + lane] += gs[h].o[d][i] * gwv; }
            }
        }
#pragma unroll
        for (int h = 0; h < 4; ++h)
#pragma unroll
            for (int d = 0; d < 4; ++d) { float v4[4];
#pragma unroll
                for (int i = 0; i < 4; ++i) v4[i] = tl[(h * 16 + d * 4 + i) * 64 + lane];
                u32x2 w; w.x = cvt_pk_bf16(v4[0], v4[1]); w.y = cvt_pk_bf16(v4[2], v4[3]);
                *(u32x2*)(OUT + rowq * D + (g * 4 + h) * 64 + d * 16 + 4 * rq) = w; }
    }
}

#define XB_TMO      128
#define XB_XCNT(j)  (256  + 64 * (j))
#define XB_XSUB(j)  (1280 + 64 * (j))
#define XB_XGEN(j)  (2304 + 64 * (j))
#define XB_TOP      3328
#define XB_TOPGEN   3392
#define XCD_BAR_WORDS 3456
#define XB_SPIN_CAP (1u << 22)
__device__ __forceinline__ unsigned xb_ld(unsigned* p)              { return __hip_atomic_load(p, __ATOMIC_RELAXED, __HIP_MEMORY_SCOPE_AGENT); }
__device__ __forceinline__ unsigned xb_add(unsigned* p, unsigned v) { return __hip_atomic_fetch_add(p, v, __ATOMIC_RELAXED, __HIP_MEMORY_SCOPE_AGENT); }
__device__ __forceinline__ unsigned xb_xcc_id() { return (unsigned)__builtin_amdgcn_s_getreg((3 << 11) | 20) & 0xFu; }
#define XB_SPIN(cond, bar) do { unsigned _sp = 0; while (cond) { __builtin_amdgcn_s_sleep(1); \
    if ((++_sp & 255u) == 0u) { if (xb_ld(&(bar)[XB_TMO])) break; if (_sp > XB_SPIN_CAP) { atomicAdd(&(bar)[XB_TMO], 1u); break; } } } } while (0)
struct XcdBarrier { unsigned* bar; unsigned x; volatile LAS unsigned* st; };
__device__ __forceinline__ void xcd_barrier_complete(unsigned* bar, unsigned x, unsigned& nloc, unsigned& nx) {
    const unsigned Gn = gridDim.x * gridDim.y * gridDim.z;
    unsigned sum, cnt, mine, sp = 0u;
    for (;;) {
        sum = 0u; cnt = 0u; mine = 0u;
#pragma unroll
        for (unsigned j = 0; j < 16; ++j) { const unsigned c = xb_ld(&bar[XB_XCNT(j)]); sum += c; cnt += (c > 0u) ? 1u : 0u; mine = (j == x) ? c : mine; }
        if (sum == Gn) break;
        __builtin_amdgcn_s_sleep(1);
        if ((++sp & 255u) == 0u) { if (xb_ld(&bar[XB_TMO])) break; if (sp > XB_SPIN_CAP) { atomicAdd(&bar[XB_TMO], 1u); break; } }
    }
    nloc = mine > 0u ? mine : 1u; nx = cnt > 0u ? cnt : 1u;
}
__device__ __forceinline__ void xcd_barrier(const XcdBarrier& b, bool leader) {
    asm volatile("s_waitcnt vmcnt(0)" ::: "memory");
    __syncthreads();
    if (leader) {
        unsigned* bar = b.bar;
        __builtin_amdgcn_s_waitcnt(0);
        unsigned nloc = b.st[0], nx = b.st[1];
        if (nloc == 0u) { xcd_barrier_complete(bar, b.x, nloc, nx); b.st[0] = nloc; b.st[1] = nx; }
        const unsigned old = xb_add(&bar[XB_XSUB(b.x)], 1u);
        const unsigned gen = old / nloc;
        if (old + 1u == (gen + 1u) * nloc) {
            __builtin_amdgcn_fence(__ATOMIC_RELEASE, "agent");
            asm volatile("s_waitcnt vmcnt(0)" ::: "memory");
            const unsigned og = xb_add(&bar[XB_TOP], 1u);
            const unsigned tg = og / nx;
            if (og + 1u == (tg + 1u) * nx) xb_add(&bar[XB_TOPGEN], 1u);
            else XB_SPIN(xb_ld(&bar[XB_TOPGEN]) == tg, bar);
            __builtin_amdgcn_fence(__ATOMIC_ACQUIRE, "agent");
            xb_add(&bar[XB_XGEN(b.x)], 1u);
            asm volatile("s_waitcnt vmcnt(0)" ::: "memory");
        } else {
            XB_SPIN(xb_ld(&bar[XB_XGEN(b.x)]) == gen, bar);
            __builtin_amdgcn_fence(__ATOMIC_ACQUIRE, "agent");
            asm volatile("s_waitcnt vmcnt(0)" ::: "memory");
        }
    }
    __syncthreads();
}
#define GSYNC() xcd_barrier(xbar, wave == 0 && lane_id() == 0)

__global__ void __launch_bounds__(NTHREADS, 2) fwd_kernel(Params P) {
    extern __shared__ __attribute__((aligned(16))) unsigned char lds_raw[];
    LAS unsigned char* lds = (LAS unsigned char*)lds_raw;
    cg::grid_group grid = cg::this_grid();
    int tidv = threadIdx.x;
    const int wave = __builtin_amdgcn_readfirstlane(tidv >> 6);
    const int G = gridDim.x, gw_k = blockIdx.x * NWAVES + wave, NGW = G * NWAVES;
    unsigned char* ws = P.ws;
    float* xres = P.out;
    LAS float* scr = (LAS float*)(lds + wave * 16384);
    const float* x_in = P.in[0];
    const float* norm_mix = P.in[1]; const float* norm_mlp = P.in[2]; const float* norm_final = P.in[3];
    const float* mlp_w1 = P.in[4]; const float* mlp_w2 = P.in[5];

    XcdBarrier xbar; xbar.bar = (unsigned*)(ws + WS_BAR); xbar.x = xb_xcc_id(); xbar.st = (volatile LAS unsigned*)(lds + 147456);
    if (tidv < 2) xbar.st[tidv] = 0u;
    if (tidv == 0) (void)xb_add(&xbar.bar[XB_XCNT(xbar.x)], 1u);
    __syncthreads();
    grid.sync();
    for (int layer = 0; layer < 4; ++layer) {
        int lane = tidv; asm volatile("" : "+v"(lane)); lane &= 63;
        int gw = gw_k; asm volatile("" : "+s"(gw));
        const bool is_rwkv = (layer & 1) != 0; const int lj = layer >> 1;
        const float* xsrc = (layer == 0) ? x_in : xres;
        {
            TJob j1{mlp_w1 + (size_t)layer * D * FF, FF, 0, FF, D, (bf16_t*)(ws + WS_W + W_MLP1), D, 0, 0, FF, D, nullptr, 0};
            transpose_job(j1, scr, gw, NGW, lane);
            TJob j2{mlp_w2 + (size_t)layer * FF * D, D, 0, D, FF, (bf16_t*)(ws + WS_W + W_MLP2), FF, 0, 0, D, FF, nullptr, 0};
            transpose_job(j2, scr, gw, NGW, lane);
            if (is_rwkv) {
                const float* mix = P.in[14] + (size_t)lj * 6 * D;
                bf16_t* WrT = (bf16_t*)(ws + WS_W + W_RW_IN);
                const float* wrkv = P.in[15] + (size_t)lj * 3 * D * D;
                for (int part = 0; part < 8; ++part) {
                    const float* W; int ldw, Nsrc, mi, r0, Npad;
                    if (part == 0) { W = wrkv; ldw = D; Nsrc = D; mi = 0; r0 = 0; Npad = D; }
                    else if (part == 1) { W = wrkv + (size_t)D * D; ldw = D; Nsrc = D; mi = 2; r0 = 1024; Npad = D; }
                    else if (part == 2) { W = wrkv + (size_t)2 * D * D; ldw = D; Nsrc = D; mi = 3; r0 = 2048; Npad = D; }
                    else if (part == 3) { W = P.in[17] + (size_t)lj * D * 64; ldw = 64; Nsrc = 64; mi = 1; r0 = 3072; Npad = 128; }
                    else if (part == 4) { W = P.in[20] + (size_t)lj * D * 64; ldw = 64; Nsrc = 64; mi = 4; r0 = 3200; Npad = 128; }
                    else if (part == 5) { W = P.in[22] + (size_t)lj * D * 160; ldw = 160; Nsrc = 160; mi = 5; r0 = 3328; Npad = 256; }
                    else if (part == 6) { W = P.in[31]; ldw = 32; Nsrc = (lj >= 1) ? 32 : 0; mi = 3; r0 = 3584; Npad = 128; }
                    else { W = P.in[31]; ldw = 32; Nsrc = 0; mi = 3; r0 = 3712; Npad = 128; }
                    TJob ja{W, ldw, 0, Nsrc, D, WrT, 2048, r0, 0, Npad, D, mix + mi * D, 1};
                    transpose_job(ja, scr, gw, NGW, lane);
                    TJob jb{W, ldw, 0, Nsrc, D, WrT, 2048, r0, 1024, Npad, D, mix + mi * D, 2};
                    transpose_job(jb, scr, gw, NGW, lane);
                }
                TJob jw{P.in[18] + (size_t)lj * 64 * D, D, 0, D, 64, (bf16_t*)(ws + WS_W + W_RW_W2), 128, 0, 0, D, 128, nullptr, 0}; transpose_job(jw, scr, gw, NGW, lane);
                TJob jaa{P.in[21] + (size_t)lj * 64 * D, D, 0, D, 64, (bf16_t*)(ws + WS_W + W_RW_A2), 128, 0, 0, D, 128, nullptr, 0}; transpose_job(jaa, scr, gw, NGW, lane);
                TJob jv{P.in[32], D, 0, D, (lj >= 1) ? 32 : 0, (bf16_t*)(ws + WS_W + W_RW_V2), 128, 0, 0, D, 128, nullptr, 0}; transpose_job(jv, scr, gw, NGW, lane);
                TJob jg{P.in[23] + (size_t)lj * 160 * D, D, 0, D, 160, (bf16_t*)(ws + WS_W + W_RW_G2), 256, 0, 0, D, 256, nullptr, 0}; transpose_job(jg, scr, gw, NGW, lane);
                TJob jo{P.in[29] + (size_t)lj * D * D, D, 0, D, D, (bf16_t*)(ws + WS_W + W_RW_O), D, 0, 0, D, D, nullptr, 0}; transpose_job(jo, scr, gw, NGW, lane);
                bf16_t* HN = (bf16_t*)(ws + A_HN);
                if (gw < 2) { u32x4* z = (u32x4*)(HN + (size_t)gw * (S + 1) * D); unsigned zz; asm volatile("v_mov_b32 %0, 0" : "=v"(zz)); for (int q = lane; q < D / 8; q += 64) z[q] = (u32x4){zz, zz, zz, zz}; }
                for (int m = gw; m < M; m += NGW) { const int b = m / S; rms_row_bf16(xsrc + (size_t)m * D, norm_mix + layer * D, HN + ((size_t)m + b + 1) * D, nullptr, lane); }
            } else {
                const float* win = P.in[6] + (size_t)lj * D * 2608;
                bf16_t* WnT = (bf16_t*)(ws + WS_W + W_NSA_IN); bf16_t* WvT = (bf16_t*)(ws + WS_W + W_NSA_V);
                for (int part = 0; part < 8; ++part) {
                    int n0src, Nsrc, r0, Npad; bf16_t* WT = WnT;
                    if (part == 0) { n0src = 0; Nsrc = 1024; r0 = 0; Npad = 1024; }
                    else if (part == 1) { n0src = 1024; Nsrc = 256; r0 = 1024; Npad = 256; }
                    else if (part == 2) { n0src = 1024 + 512; Nsrc = 256; r0 = 1280; Npad = 256; }
                    else if (part == 3) { n0src = 1024 + 1024; Nsrc = 256; r0 = 1536; Npad = 256; }
                    else if (part == 4) { n0src = 1024 + 256; Nsrc = 256; r0 = 1792; Npad = 256; }
                    else if (part == 5) { n0src = 2560; Nsrc = 48; r0 = 2048; Npad = 256; }
                    else if (part == 6) { n0src = 1024 + 768; Nsrc = 256; r0 = 0; Npad = 256; WT = WvT; }
                    else { n0src = 1024 + 1280; Nsrc = 256; r0 = 256; Npad = 256; WT = WvT; }
                    TJob jn{win, 2608, n0src, Nsrc, D, WT, D, r0, 0, Npad, D, nullptr, 0}; transpose_job(jn, scr, gw, NGW, lane);
                }
                TJob jo{P.in[13] + (size_t)lj * D * D, D, 0, D, D, (bf16_t*)(ws + WS_W + W_NSA_O), D, 0, 0, D, D, nullptr, 0}; transpose_job(jo, scr, gw, NGW, lane);
                TJob jc1k{P.in[8] + (size_t)lj * 2048 * 256, 256, 0, 256, 2048, (bf16_t*)(ws + WS_W + W_C1K), 2048, 0, 0, 256, 2048, nullptr, 0}; transpose_job(jc1k, scr, gw, NGW, lane);
                TJob jc1v{P.in[11] + (size_t)lj * 2048 * 256, 256, 0, 256, 2048, (bf16_t*)(ws + WS_W + W_C1V), 2048, 0, 0, 256, 2048, nullptr, 0}; transpose_job(jc1v, scr, gw, NGW, lane);
                TJob jc2k{P.in[9] + (size_t)lj * 256 * 64, 64, 0, 64, 256, (bf16_t*)(ws + WS_W + W_C2K), 256, 0, 0, 256, 256, nullptr, 0}; transpose_job(jc2k, scr, gw, NGW, lane);
                TJob jc2v{P.in[12] + (size_t)lj * 256 * 64, 64, 0, 64, 256, (bf16_t*)(ws + WS_W + W_C2V), 256, 0, 0, 256, 256, nullptr, 0}; transpose_job(jc2v, scr, gw, NGW, lane);
                {
                    int ln = lane; asm volatile("" : "+v"(ln));
                    float* cb = (float*)(ws + WS_W + W_CBIAS);
#pragma unroll 1
                    for (int o = gw; o < 512; o += NGW) { const int isv = o >> 8, c = o & 255;
                        const float* pe = (isv ? P.in[10] : P.in[7]) + (size_t)lj * 2048; const float* w1 = (isv ? P.in[11] : P.in[8]) + (size_t)lj * 2048 * 256;
                        float acc = 0.f;
#pragma unroll 1
                        for (int k = ln; k < 2048; k += 64) acc += pe[k] * w1[(size_t)k * 256 + c];
                        acc = wave_sum(acc); if (ln == 0) cb[o] = acc; }
                    if (layer == 0) {
                        float* rt = (float*)(ws + WS_ROPE);
                        int tix = tidv; asm volatile("" : "+v"(tix)); const int gt = (int)blockIdx.x * NTHREADS + tix;
#pragma unroll 1
                        for (int e = gt; e < S * 8; e += G * NTHREADS) { const int tt = e >> 3, i = e & 7;
                            const float invf = (i == 0) ? 1.0f : (i == 1) ? 0.1939227432012558f : (i == 2) ? 0.03760603070259094f : (i == 3) ? 0.007292664609849453f : (i == 4) ? 0.0014142135623842478f : (i == 5) ? 0.00027424818836152554f : (i == 6) ? 5.318296098266728e-05f : 1.0313386155758053e-05f;
                            const float ang = (float)tt * invf; const double rev = (double)ang * 0.15915494309189535; const float fr = (float)(rev - __builtin_rint(rev));
                            rt[tt * 16 + i] = __builtin_amdgcn_cosf(fr); rt[tt * 16 + 8 + i] = __builtin_amdgcn_sinf(fr); }
                    }
                }
                for (int m = gw; m < M; m += NGW) rms_row_bf16(xsrc + (size_t)m * D, norm_mix + layer * D, (bf16_t*)(ws + A_HN) + (size_t)m * D, (layer == 0) ? xres + (size_t)m * D : nullptr, lane);
            }
        }
        GSYNC();
        if (!is_rwkv) {
            bf16_t* HN = (bf16_t*)(ws + A_HN); bf16_t* Qb = (bf16_t*)(ws + A_Q); bf16_t* KFb = (bf16_t*)(ws + A_KF); bf16_t* VFb = (bf16_t*)(ws + A_VF);
            float* GT = (float*)(ws + A_GATES); bf16_t* CHK = (bf16_t*)(ws + A_CHK); bf16_t* CHV = (bf16_t*)(ws + A_CHV); bf16_t* KCb = (bf16_t*)(ws + A_KC); bf16_t* VCb = (bf16_t*)(ws + A_VC);
            {
                pg8::Gemm g{HN, (const bf16_t*)(ws + WS_W + W_NSA_IN), M, 2304, D, D, D, 0};
                pg8::StaticOrder so; so.init(M, 2304, G, (int)blockIdx.x);
                pg8::EpiP<FNsaIn> E{FNsaIn{Qb, KFb, GT, (const float*)(ws + WS_ROPE)}};
                pg8::gemm_phase<pg8::EpiP<FNsaIn>, true>(lds, g, so, E, tidv);
                pg8::Gemm g2{(const bf16_t*)(ws + WS_W + W_NSA_V), HN, 512, M, D, D, D, 0};
                pg8::StaticOrder so2; so2.init(512, M, G, (int)blockIdx.x);
                pg8::EpiP<FNsaVT> E2{FNsaVT{VFb}};
                pg8::gemm_phase<pg8::EpiP<FNsaVT>, true>(lds, g2, so2, E2, tidv);
            }
            GSYNC();
            {
                pg8::StaticOrder so; so.init(8192, 256, G, (int)blockIdx.x);
                pg8::StaticOrder sov; sov.init(8192, 256, G, (int)((blockIdx.x + G - G / 2) % G));
                { pg8::Gemm g{KFb, (const bf16_t*)(ws + WS_W + W_C1K), 8192, 256, 2048, 1024, 2048, 0}; pg8::EpiP<FCmp1> E{FCmp1{CHK, (const float*)(ws + WS_W + W_CBIAS)}}; pg8::gemm_phase<pg8::EpiP<FCmp1>, true>(lds, g, so, E, tidv); }
                { pg8::Gemm g{KFb + 3 * KF_STRIDE, (const bf16_t*)(ws + WS_W + W_C1V), 8192, 256, 2048, 1024, 2048, 0}; pg8::EpiP<FCmp1> E{FCmp1{CHV, (const float*)(ws + WS_W + W_CBIAS) + 256}}; pg8::gemm_phase<pg8::EpiP<FCmp1>, true>(lds, g, sov, E, tidv); }
            }
            GSYNC();
            {
                { pg8::StaticOrder so; so.init(8192, 256, G, (int)blockIdx.x); pg8::Gemm g{CHK, (const bf16_t*)(ws + WS_W + W_C2K), 8192, 256, 256, 256, 256, 0}; pg8::EpiP<FCmp2K> E{FCmp2K{KCb}}; pg8::gemm_phase<pg8::EpiP<FCmp2K>, true>(lds, g, so, E, tidv); }
                { pg8::StaticOrder so; so.init(256, 8192, G, (int)((blockIdx.x + G - G / 2) % G)); pg8::Gemm g{(const bf16_t*)(ws + WS_W + W_C2V), CHV, 256, 8192, 256, 256, 256, 0}; pg8::EpiP<FCmp2VT> E{FCmp2VT{VCb}}; pg8::gemm_phase<pg8::EpiP<FCmp2VT>, true>(lds, g, so, E, tidv); }
            }
            GSYNC();
            nsa_attention(Qb, KFb, VFb, KCb, VCb, GT, HN, lds, G, wave, lane_id());
            tidv = wave * 64 + (lane_id() & 63); asm volatile("" : "+v"(tidv)); tidv &= 511; lane = tidv & 63;
            GSYNC();
            {
                pg8::StaticOrder so; so.init(M, D, G, (int)blockIdx.x);
                pg8::Gemm g{HN, (const bf16_t*)(ws + WS_W + W_NSA_O), M, D, D, D, D, 0}; pg8::EpiN<FResAdd> E{FResAdd{xres}}; pg8::gemm_phase<pg8::EpiN<FResAdd>, true>(lds, g, so, E, tidv);
            }
            GSYNC();
        }
        if (is_rwkv) {
            h16* Rb = (h16*)(ws + A_R); h16* Kb = (h16*)(ws + A_K); h16* Ab = (h16*)(ws + A_A); h16* EWb = (h16*)(ws + A_HN);
            h16* Vb = (lj == 0) ? (h16*)(ws + WS_VF) : (h16*)(ws + A_V2);
            h16* Yraw = (lj == 0) ? (h16*)(ws + A_V2) : (h16*)(ws + WS_VF);
            bf16_t* LH = (bf16_t*)(ws + A_LH);
            {
                pg8::Gemm g{(const bf16_t*)(ws + A_HN), (const bf16_t*)(ws + WS_W + W_RW_IN), M, 3840, 2048, D, 2048, 1};
                pg8::StaticOrder so; so.init(M, 3840, G, (int)blockIdx.x);
                pg8::EpiP<FRwIn> E{FRwIn{Rb, Kb, Vb, LH}};
                pg8::gemm_phase<pg8::EpiP<FRwIn>, true>(lds, g, so, E, tidv);
            }
            GSYNC();
            {
                pg8::StaticOrder so; so.init(M, D, G, (int)blockIdx.x);
                { pg8::Gemm g{LH, (const bf16_t*)(ws + WS_W + W_RW_W2), M, D, 128, 768, 128, 0}; pg8::EpiP<FLoraW> E{FLoraW{EWb, P.in[16] + lj * D}}; pg8::gemm_phase<pg8::EpiP<FLoraW>, true>(lds, g, so, E, tidv); }
                { pg8::Gemm g{LH + 128, (const bf16_t*)(ws + WS_W + W_RW_A2), M, D, 128, 768, 128, 0}; pg8::EpiP<FLoraA> E{FLoraA{Ab, P.in[19] + lj * D}}; pg8::gemm_phase<pg8::EpiP<FLoraA>, true>(lds, g, so, E, tidv); }
                if (lj >= 1) { pg8::Gemm g{LH + 512, (const bf16_t*)(ws + WS_W + W_RW_V2), M, D, 128, 768, 128, 0}; pg8::EpiP<FLoraV> E{FLoraV{Vb, (const h16*)(ws + WS_VF), P.in[30]}}; pg8::gemm_phase<pg8::EpiP<FLoraV>, true>(lds, g, so, E, tidv); }
            }
            GSYNC();
            rwkv_scan2(Rb, Kb, Vb, EWb, Ab, P.in[24] + lj * D, P.in[25] + lj * D, Yraw, lds, wave, lane);
            GSYNC();
            rwkv_gn(Rb, Kb, Vb, Ab, Yraw, P.in[25] + lj * D, P.in[26] + lj * D, P.in[27] + lj * D, P.in[28] + lj * D, gw, NGW, lane);
            GSYNC();
            {
                pg8::StaticOrder so; so.init(M, D, G, (int)blockIdx.x);
                pg8::Gemm g{LH + 256, (const bf16_t*)(ws + WS_W + W_RW_G2), M, D, 256, 768, 256, 0}; pg8::EpiP<FGate> E{FGate{(bf16_t*)Kb, Rb}}; pg8::gemm_phase<pg8::EpiP<FGate>, true>(lds, g, so, E, tidv);
            }
            GSYNC();
            {
                pg8::StaticOrder so; so.init(M, D, G, (int)blockIdx.x);
                pg8::Gemm g{(const bf16_t*)Kb, (const bf16_t*)(ws + WS_W + W_RW_O), M, D, D, D, D, 0}; pg8::EpiN<FResAdd> E{FResAdd{xres}}; pg8::gemm_phase<pg8::EpiN<FResAdd>, true>(lds, g, so, E, tidv);
            }
            GSYNC();
        }
        for (int m = gw; m < M; m += NGW) rms_row_bf16(xres + (size_t)m * D, norm_mlp + layer * D, (bf16_t*)(ws + A_HN) + (size_t)m * D, nullptr, lane);
        GSYNC();
        {
            pg8::Gemm g{(const bf16_t*)(ws + A_HN), (const bf16_t*)(ws + WS_W + W_MLP1), M, FF, D, D, D, 0};
            pg8::StaticOrder so; so.init(M, FF, G, (int)blockIdx.x);
            pg8::EpiP<FRelu2> E{FRelu2{(bf16_t*)(ws + A_HID)}};
            pg8::gemm_phase<pg8::EpiP<FRelu2>, true>(lds, g, so, E, tidv);
        }
        GSYNC();
        {
            pg8::Gemm g{(const bf16_t*)(ws + A_HID), (const bf16_t*)(ws + WS_W + W_MLP2), M, D, FF, FF, FF, 0};
            pg8::StaticOrder so; so.init(M, D, G, (int)blockIdx.x);
            pg8::EpiN<FResAdd> E{FResAdd{xres}};
            pg8::gemm_phase<pg8::EpiN<FResAdd>, true>(lds, g, so, E, tidv);
        }
        GSYNC();
    }
    for (int m = gw_k; m < M; m += NGW) {
        int lane2 = tidv; asm volatile("" : "+v"(lane2)); lane2 &= 63;
        f32x4* xr = (f32x4*)(xres + (size_t)m * D) + lane2; const f32x4* gr = (const f32x4*)norm_final + lane2;
        f32x4 v[4]; float s = 0.f;
#pragma unroll
        for (int j = 0; j < 4; ++j) { v[j] = xr[64 * j]; s += (v[j].x * v[j].x + v[j].y * v[j].y) + (v[j].z * v[j].z + v[j].w * v[j].w); }
        const float r = rsqrtf(wave_sum(s) * (1.f / D) + 1e-5f);
#pragma unroll
        for (int j = 0; j < 4; ++j) { const f32x4 gg = gr[64 * j]; xr[64 * j] = v[j] * r * gg; }
    }
}

extern "C" void kernel_launch(void* const* d_in, const int* in_sizes, int n_in, void* d_out, int out_size, void* d_ws, size_t ws_size, hipStream_t stream) {
    static int grid = 0;
    if (grid == 0) {
        if (n_in != 33 || out_size != M * D || ws_size < WS_NEED) { fprintf(stderr, "kernel_launch: unexpected sizes n_in %d out %d ws %zu (need %zu)\n", n_in, out_size, ws_size, (size_t)WS_NEED); grid = -1; return; }
        int dev = 0, cus = 0, per_cu = 0;
        hipGetDevice(&dev);
        hipDeviceGetAttribute(&cus, hipDeviceAttributeMultiprocessorCount, dev);
        if (hipFuncSetAttribute((const void*)fwd_kernel, hipFuncAttributeMaxDynamicSharedMemorySize, LDS_BYTES) != hipSuccess) { fprintf(stderr, "hipFuncSetAttribute failed\n"); grid = -1; return; }
        hipOccupancyMaxActiveBlocksPerMultiprocessor(&per_cu, (const void*)fwd_kernel, NTHREADS, LDS_BYTES);
        if (per_cu < 1) { fprintf(stderr, "occupancy query returned %d\n", per_cu); per_cu = 1; }
        (void)hipGetLastError();
        grid = cus * 1;
    }
    if (grid < 0) return;
    if (hipMemsetAsync((char*)d_ws + WS_BAR, 0, 16384, stream) != hipSuccess) { fprintf(stderr, "hipMemsetAsync of the barrier words failed\n"); return; }
    Params p{};
    for (int i = 0; i < 33; ++i) p.in[i] = (const float*)d_in[i];
    p.out = (float*)d_out; p.ws = (unsigned char*)d_ws;
    void* args[] = {&p};
    hipError_t e = hipLaunchCooperativeKernel((const void*)fwd_kernel, dim3(grid), dim3(NTHREADS), args, LDS_BYTES, stream);
    if (e != hipSuccess) fprintf(stderr, "cooperative launch failed: %s (grid %d)\n", hipGetErrorString(e), grid);
}
```

```cpp
#include <hip/hip_runtime.h>
#include <hip/hip_cooperative_groups.h>
#include <cstdio>
#include <cstdint>
namespace cg = cooperative_groups;

#define LAS __attribute__((address_space(3)))
typedef unsigned short bf16_t;
typedef short bf16x8 __attribute__((ext_vector_type(8)));
typedef float f32x4 __attribute__((ext_vector_type(4)));
typedef float f32x2 __attribute__((ext_vector_type(2)));
typedef unsigned u32x4 __attribute__((ext_vector_type(4)));
typedef unsigned u32x2 __attribute__((ext_vector_type(2)));
typedef _Float16 h16;
typedef _Float16 h16x2 __attribute__((ext_vector_type(2)));

constexpr int S = 16384, NB = 2, M = NB * S, D = 1024, FF = 4096;
constexpr int NWAVES = 8, NTHREADS = 512;
constexpr int LDS_BYTES = 147456 + 64;
constexpr size_t MiB = 1u << 20;
constexpr size_t WS_W = 0;
constexpr size_t W_MLP1 = 0, W_MLP2 = 8 * MiB;
constexpr size_t W_NSA_IN = 16 * MiB, W_NSA_V = 21 * MiB, W_NSA_O = 22 * MiB, W_C1K = 24 * MiB, W_C1V = 25 * MiB, W_C2K = 26 * MiB, W_C2V = 26 * MiB + 256 * 1024, W_CBIAS = 26 * MiB + 512 * 1024;
constexpr size_t W_RW_IN = 16 * MiB, W_RW_W2 = 31 * MiB, W_RW_A2 = 31 * MiB + 256 * 1024, W_RW_V2 = 31 * MiB + 512 * 1024, W_RW_G2 = 31 * MiB + 768 * 1024, W_RW_O = 33 * MiB;
constexpr size_t WS_ROPE = 36 * MiB;
constexpr size_t WS_BAR = 38 * MiB;
constexpr size_t WS_VF = 40 * MiB;
constexpr size_t ACT = 104 * MiB;
constexpr size_t A_HN = ACT;
constexpr size_t A_Q = ACT + 65 * MiB;
constexpr size_t A_KF = ACT + 129 * MiB;
constexpr size_t A_VF = ACT + 194 * MiB;
constexpr size_t A_GATES = ACT + 226 * MiB;
constexpr size_t A_CHK = ACT + 233 * MiB, A_CHV = ACT + 237 * MiB, A_KC = ACT + 241 * MiB, A_VC = ACT + 242 * MiB;
constexpr size_t A_HID = ACT + 65 * MiB;
constexpr size_t A_R = ACT + 65 * MiB, A_K = ACT + 129 * MiB, A_V2 = ACT + 193 * MiB, A_A = ACT + 257 * MiB, A_LH = ACT + 321 * MiB;
constexpr size_t WS_NEED = ACT + 370 * MiB;

__device__ __forceinline__ int lane_id() { return (int)__builtin_amdgcn_mbcnt_hi(~0u, __builtin_amdgcn_mbcnt_lo(~0u, 0u)); }
__device__ __forceinline__ unsigned cvt_pk_bf16(float lo, float hi) { unsigned r; asm volatile("v_cvt_pk_bf16_f32 %0, %1, %2" : "=v"(r) : "v"(lo), "v"(hi)); return r; }
__device__ __forceinline__ unsigned pk_h16(float lo, float hi) { h16x2 v; v.x = (h16)lo; v.y = (h16)hi; return __builtin_bit_cast(unsigned, v); }
__device__ __forceinline__ float bf2f(bf16_t b) { return __uint_as_float(((unsigned)b) << 16); }
__device__ __forceinline__ float wave_sum(float v) {
#pragma unroll
    for (int o = 1; o < 64; o <<= 1) v += __shfl_xor(v, o);
    return v;
}
__device__ __forceinline__ float sigmoidf_(float x) { return 1.0f / (1.0f + __expf(-x)); }
__device__ __forceinline__ float tanhf_(float x) { float e = __expf(-2.0f * fabsf(x)); float t = (1.0f - e) / (1.0f + e); return x < 0.f ? -t : t; }

namespace pg8 {
constexpr int BM = 256, BK = 64, HALF = 128, HTB = HALF * BK * 2, STAGE_BYTES = 8 * HTB, NXCD = 8, WGM = 8;
__host__ __device__ __forceinline__ int lds_byte(int r, int c) { const int st = (r >> 4) * 2 + (c >> 5), rr = r & 15, cc = c & 31, ob = rr * 64 + cc * 2; return st * 1024 + (ob ^ (((ob >> 9) & 1) << 5)); }
__host__ __device__ __forceinline__ void stage_rc(int b, int& R, int& C) { const int st = b / 1024, sb = b % 1024, swz = sb ^ (((sb >> 9) & 1) << 5); R = (st >> 1) * 16 + swz / 64; C = (st & 1) * 32 + (swz % 64) / 2; }
__host__ __device__ __forceinline__ int perm32(int rho) { const int n = rho >> 4, i = rho & 15; return 8 * (i >> 2) + 4 * n + (i & 3); }
struct Unit { int pm, pn; };
struct Gemm { const bf16_t* A; const bf16_t* Bt; int M, N, K, lda, ldb, amode; };
struct StaticOrder {
    int nM, nN, nwg, G, c;
    __device__ void init(int M_, int N_, int G_, int c_) { nM = M_ / BM; nN = N_ / BM; nwg = nM * nN; G = G_; c = c_; }
    __device__ bool next(int i, Unit& u) const {
        const long L = (long)i * G + c; if (L >= nwg) return false;
        int wgid = (int)L; { const int q = nwg / NXCD, r = nwg % NXCD, xcd = wgid % NXCD, off = wgid / NXCD; wgid = (xcd < r ? xcd * (q + 1) : r * (q + 1) + (xcd - r) * q) + off; }
        const int nig = WGM * nN, gid = wgid / nig, fm = gid * WGM, gsz = (nM - fm) < WGM ? (nM - fm) : WGM;
        u.pm = fm + ((wgid % nig) % gsz); u.pn = (wgid % nig) / gsz; return true;
    }
};
__device__ __forceinline__ const char* a_base(const Gemm& g, int pm) { const size_t row = (size_t)pm * BM + (g.amode == 1 ? (size_t)(pm / 64) : 0); return (const char*)g.A + row * (size_t)g.lda * 2; }

template <class Epi, bool ALIGN_EPI>
__device__ __forceinline__ void gemm_phase(LAS unsigned char* lds, const Gemm g, const StaticOrder& S, const Epi& E, int tid_in) {
    int tid = tid_in; asm volatile("" : "+v"(tid));
    const int wid = __builtin_amdgcn_readfirstlane(tid >> 6), lane = tid & 63, wr = wid >> 2, wc = wid & 3, fr = lane & 15, fq = lane >> 4;
    int K = g.K; asm volatile("" : "+s"(K));
    const int nt = K / BK;
    unsigned voffA[2], voffB[2];
#pragma unroll
    for (int i = 0; i < 2; ++i) { int R, C; stage_rc(tid * 16 + i * 8192, R, C); const int Rb = Epi::PERM ? ((R & ~31) + perm32(R & 31)) : R;
        voffA[i] = (unsigned)(R * g.lda + C) * 2u; voffB[i] = (unsigned)(Rb * g.ldb + C) * 2u; }
    const size_t kstep = (size_t)(BK * 2);
    const size_t hstepA = (size_t)HALF * g.lda * 2, hstepB = (size_t)HALF * g.ldb * 2;
    const size_t tstepB = 2 * hstepB;
    const unsigned ldsw = (unsigned)wid * 1024u;
    const int aoff = lds_byte(wr * 64 + fr, fq * 8), boff = lds_byte(wc * 32 + fr, fq * 8);
#define PG8_SA(b, h) (((b) * 2 + (h)) * HTB)
#define PG8_SB(b, h) ((4 + (b) * 2 + (h)) * HTB)
#define PG8_STAGE(bufoff, gbase, voff) do { _Pragma("unroll") for (int _i = 0; _i < 2; ++_i) \
        __builtin_amdgcn_global_load_lds((const unsigned*)((const char*)(gbase) + (voff)[_i]), (LAS unsigned*)(lds + (bufoff) + ldsw + _i * 8192), 16, 0, 0); } while (0)
#define PG8_LDA(dst, b, h) do { _Pragma("unroll") for (int m = 0; m < 4; ++m) _Pragma("unroll") for (int k = 0; k < 2; ++k) dst[m][k] = *(const LAS bf16x8*)(lds + PG8_SA(b, h) + aoff + m * 2048 + k * 1024); } while (0)
#define PG8_LDB(dst, b, h) do { _Pragma("unroll") for (int n = 0; n < 2; ++n) _Pragma("unroll") for (int k = 0; k < 2; ++k) dst[n][k] = *(const LAS bf16x8*)(lds + PG8_SB(b, h) + boff + n * 2048 + k * 1024); } while (0)
#define PG8_MMA(ai, bj, At, Bt) do { __builtin_amdgcn_s_setprio(1); _Pragma("unroll") for (int m = 0; m < 4; ++m) _Pragma("unroll") for (int n = 0; n < 2; ++n) _Pragma("unroll") for (int k = 0; k < 2; ++k) \
        acc[ai][bj][m][n] = __builtin_amdgcn_mfma_f32_16x16x32_bf16(Bt[n][k], At[m][k], acc[ai][bj][m][n], 0, 0, 0); __builtin_amdgcn_s_setprio(0); } while (0)
#define PG8_WAIT_V(n) asm volatile("s_waitcnt vmcnt(" #n ")" ::: "memory")
#define PG8_WAIT_L(n) asm volatile("s_waitcnt lgkmcnt(" #n ")" ::: "memory")
#define PG8_BAR __builtin_amdgcn_s_barrier()
#define PG8_SCHED __builtin_amdgcn_sched_barrier(0)
    Unit cur, nxt; int ui = 0;
    if (!S.next(0, cur)) return;
    f32x4 acc[2][2][4][2];
#pragma unroll
    for (int a = 0; a < 2; ++a)
#pragma unroll
        for (int b = 0; b < 2; ++b)
#pragma unroll
            for (int m = 0; m < 4; ++m)
#pragma unroll
                for (int n = 0; n < 2; ++n) acc[a][b][m][n] = (f32x4){0.f, 0.f, 0.f, 0.f};
    bf16x8 At[4][2], B0[2][2], B1[2][2];
    const char* cA = a_base(g, cur.pm); const char* cB = (const char*)g.Bt + (size_t)cur.pn * tstepB;
    PG8_STAGE(PG8_SB(0, 0), cB, voffB); PG8_STAGE(PG8_SB(0, 1), cB + hstepB, voffB); PG8_STAGE(PG8_SA(0, 0), cA, voffA); PG8_STAGE(PG8_SA(0, 1), cA + hstepA, voffA);
    if (wr == 1) PG8_BAR;
    PG8_WAIT_V(2); PG8_BAR;
    PG8_STAGE(PG8_SB(1, 0), cB + kstep, voffB); PG8_STAGE(PG8_SA(1, 0), cA + kstep, voffA); PG8_STAGE(PG8_SB(1, 1), cB + hstepB + kstep, voffB);
    PG8_WAIT_V(6); PG8_BAR;
    for (;;) {
        const bool has_next = S.next(ui + 1, nxt);
        const char* nA = has_next ? a_base(g, nxt.pm) : cA; const char* nB = has_next ? (const char*)g.Bt + (size_t)nxt.pn * tstepB : cB;
        for (int t = 0; t < nt; t += 2) {
            const bool last = (t == nt - 2);
            const char* a1 = cA + (size_t)(t + 1) * kstep;
            const char* a2 = last ? nA : cA + (size_t)(t + 2) * kstep; const char* b2 = last ? nB : cB + (size_t)(t + 2) * kstep;
            const char* a3 = a2 + kstep; const char* b3 = b2 + kstep;
            PG8_LDB(B0, 0, 0); PG8_LDB(B1, 0, 1); PG8_SCHED; PG8_LDA(At, 0, 0); PG8_STAGE(PG8_SA(1, 1), a1 + hstepA, voffA);
            PG8_WAIT_V(8); PG8_WAIT_L(0); PG8_BAR; PG8_MMA(0, 0, At, B0); PG8_MMA(0, 1, At, B1); PG8_BAR; PG8_SCHED;
            PG8_LDA(At, 0, 1); PG8_STAGE(PG8_SB(0, 0), b2, voffB); PG8_STAGE(PG8_SB(0, 1), b2 + hstepB, voffB); PG8_STAGE(PG8_SA(0, 0), a2, voffA);
            PG8_WAIT_V(8); PG8_WAIT_L(0); PG8_BAR; PG8_MMA(1, 0, At, B0); PG8_MMA(1, 1, At, B1); PG8_BAR; PG8_SCHED;
            PG8_LDB(B0, 1, 0); PG8_LDB(B1, 1, 1); PG8_SCHED; PG8_LDA(At, 1, 0); PG8_STAGE(PG8_SA(0, 1), a2 + hstepA, voffA);
            PG8_WAIT_V(8); PG8_WAIT_L(0); PG8_BAR; PG8_MMA(0, 0, At, B0); PG8_MMA(0, 1, At, B1); PG8_BAR; PG8_SCHED;
            PG8_LDA(At, 1, 1); PG8_STAGE(PG8_SB(1, 0), b3, voffB); PG8_STAGE(PG8_SB(1, 1), b3 + hstepB, voffB); PG8_STAGE(PG8_SA(1, 0), a3, voffA);
            PG8_WAIT_V(8); PG8_WAIT_L(0); PG8_BAR; PG8_MMA(1, 0, At, B0); PG8_MMA(1, 1, At, B1); PG8_BAR; PG8_SCHED;
        }
        if constexpr (ALIGN_EPI) { if (wr == 0) PG8_BAR; }
        E(acc, cur, wr, wc, fr, fq);
        if (!has_next) break;
#pragma unroll
        for (int a = 0; a < 2; ++a)
#pragma unroll
            for (int b = 0; b < 2; ++b)
#pragma unroll
                for (int m = 0; m < 4; ++m)
#pragma unroll
                    for (int n = 0; n < 2; ++n) acc[a][b][m][n] = (f32x4){0.f, 0.f, 0.f, 0.f};
        cur = nxt; cA = nA; cB = nB; ++ui;
        if constexpr (ALIGN_EPI) { if (wr == 1) PG8_BAR; }
    }
    PG8_WAIT_V(0);
    if constexpr (!ALIGN_EPI) { if (wr == 0) PG8_BAR; }
    PG8_BAR;
#undef PG8_SA
#undef PG8_SB
#undef PG8_STAGE
#undef PG8_LDA
#undef PG8_LDB
#undef PG8_MMA
#undef PG8_WAIT_V
#undef PG8_WAIT_L
#undef PG8_BAR
#undef PG8_SCHED
}
template <class F> struct EpiP {
    static constexpr bool PERM = true; F f;
    __device__ __forceinline__ void operator()(const f32x4 (&acc)[2][2][4][2], const Unit& u, int wr, int wc, int fr, int fq) const {
#pragma unroll
        for (int ai = 0; ai < 2; ++ai)
#pragma unroll
            for (int m = 0; m < 4; ++m) { int row = u.pm * BM + ai * HALF + wr * 64 + m * 16 + fr; asm volatile("" : "+v"(row));
#pragma unroll
                for (int bj = 0; bj < 2; ++bj) { const int col0 = u.pn * BM + bj * HALF + wc * 32 + 8 * fq; f(row, col0, acc[ai][bj][m][0], acc[ai][bj][m][1]); } asm volatile("" ::: "memory"); }
    }
};
template <class F> struct EpiN {
    static constexpr bool PERM = false; F f;
    __device__ __forceinline__ void operator()(const f32x4 (&acc)[2][2][4][2], const Unit& u, int wr, int wc, int fr, int fq) const {
#pragma unroll
        for (int ai = 0; ai < 2; ++ai)
#pragma unroll
            for (int m = 0; m < 4; ++m) { int row = u.pm * BM + ai * HALF + wr * 64 + m * 16 + fr; asm volatile("" : "+v"(row));
#pragma unroll
                for (int bj = 0; bj < 2; ++bj)
#pragma unroll
                    for (int n = 0; n < 2; ++n) { const int col0 = u.pn * BM + bj * HALF + wc * 32 + 16 * n + 4 * fq; f(row, col0, acc[ai][bj][m][n]); } asm volatile("" ::: "memory"); }
    }
};
}

struct Params {
    const float* in[33];
    float* out;
    unsigned char* ws;
};

struct TJob { const float* W; int ldw, n0src, Nsrc, Ksrc; bf16_t* WT; int ldt, row_off, col_off, Npad, Kpad; const float* mix; int mode; };
__device__ __forceinline__ void transpose_job(const TJob& j, LAS float* scr, int gw, int NGW, int lane_) {
    int lane = lane_; asm volatile("" : "+v"(lane));
    const int nblk = j.Npad / 32, kblk = j.Kpad / 64, items = nblk * kblk;
    for (int it = gw; it < items; it += NGW) {
        const int kb = it / nblk, nb = it % nblk, k0 = 64 * kb, n0 = 32 * nb;
#pragma unroll 4
        for (int i = 0; i < 32; ++i) { const int kk = 2 * i + (lane >> 5), n = lane & 31; float v = 0.f;
            if (k0 + kk < j.Ksrc && n0 + n < j.Nsrc) { v = j.W[(size_t)(k0 + kk) * j.ldw + j.n0src + n0 + n];
                if (j.mode == 1) v *= j.mix[k0 + kk]; else if (j.mode == 2) v *= (1.0f - j.mix[k0 + kk]); }
            scr[kk * 33 + n] = v; }
        asm volatile("s_waitcnt lgkmcnt(0)" ::: "memory");
        const int c = lane & 7;
#pragma unroll
        for (int jj = 0; jj < 4; ++jj) { const int n = (lane >> 3) + 8 * jj; const LAS float* s = scr + (8 * c) * 33 + n;
            u32x4 o; o.x = cvt_pk_bf16(s[0 * 33], s[1 * 33]); o.y = cvt_pk_bf16(s[2 * 33], s[3 * 33]); o.z = cvt_pk_bf16(s[4 * 33], s[5 * 33]); o.w = cvt_pk_bf16(s[6 * 33], s[7 * 33]);
            *(u32x4*)(j.WT + (size_t)(j.row_off + n0 + n) * j.ldt + j.col_off + k0 + 8 * c) = o; }
        asm volatile("s_waitcnt lgkmcnt(0)" ::: "memory");
    }
}

__device__ __forceinline__ void rms_row_bf16(const float* xrow, const float* g, bf16_t* orow, float* copy_to, int lane_) {
    int lane = lane_; asm volatile("" : "+v"(lane));
    const f32x4* xr = (const f32x4*)xrow + lane; const f32x4* gr = (const f32x4*)g + lane;
    f32x4 v[4]; float s = 0.f;
#pragma unroll
    for (int j = 0; j < 4; ++j) { v[j] = xr[64 * j]; s += (v[j].x * v[j].x + v[j].y * v[j].y) + (v[j].z * v[j].z + v[j].w * v[j].w); }
    if (copy_to) {
#pragma unroll
        for (int j = 0; j < 4; ++j) ((f32x4*)copy_to + lane)[64 * j] = v[j];
    }
    const float r = rsqrtf(wave_sum(s) * (1.f / D) + 1e-5f);
    u32x2* o8 = (u32x2*)orow + lane;
#pragma unroll
    for (int j = 0; j < 4; ++j) { const f32x4 gg = gr[64 * j]; u32x2 w; w.x = cvt_pk_bf16(v[j].x * r * gg.x, v[j].y * r * gg.y); w.y = cvt_pk_bf16(v[j].z * r * gg.z, v[j].w * r * gg.w); o8[64 * j] = w; }
}

struct FRelu2 { bf16_t* O; __device__ __forceinline__ void operator()(int row, int col0, f32x4 a, f32x4 b) const {
    f32x4 x = a, y = b;
#pragma unroll
    for (int i = 0; i < 4; ++i) { float t = fmaxf(x[i], 0.f); x[i] = t * t; t = fmaxf(y[i], 0.f); y[i] = t * t; }
    u32x4 w; w.x = cvt_pk_bf16(x[0], x[1]); w.y = cvt_pk_bf16(x[2], x[3]); w.z = cvt_pk_bf16(y[0], y[1]); w.w = cvt_pk_bf16(y[2], y[3]);
    *(u32x4*)(O + (size_t)row * FF + col0) = w; } };
struct FResAdd { float* X; __device__ __forceinline__ void operator()(int row, int col0, f32x4 a) const {
    f32x4* p = (f32x4*)(X + (size_t)row * D + col0); *p = *p + a; } };


struct FRwIn { h16* R; h16* Kk; h16* V; bf16_t* LH;
    __device__ __forceinline__ void operator()(int row, int col0, f32x4 a, f32x4 b) const {
        const int seg = __builtin_amdgcn_readfirstlane(col0 >> 10);
        if (seg < 3) { const long dK = (const char*)Kk - (const char*)R, dV = (const char*)V - (const char*)R; const long off = (seg == 1 ? dK : 0l) + (seg == 2 ? dV : 0l); h16* dst = (h16*)((char*)R + off); const int c = col0 & 1023;
            u32x4 w; w.x = pk_h16(a[0], a[1]); w.y = pk_h16(a[2], a[3]); w.z = pk_h16(b[0], b[1]); w.w = pk_h16(b[2], b[3]);
            *(u32x4*)(dst + (size_t)row * D + c) = w; }
        else { const int c = col0 - 3072; f32x4 x = a, y = b;
            if (c < 128) {
#pragma unroll
                for (int i = 0; i < 4; ++i) { x[i] = tanhf_(x[i]); y[i] = tanhf_(y[i]); } }
            else if (c >= 256 && c < 512) {
#pragma unroll
                for (int i = 0; i < 4; ++i) { x[i] = sigmoidf_(x[i]); y[i] = sigmoidf_(y[i]); } }
            u32x4 w; w.x = cvt_pk_bf16(x[0], x[1]); w.y = cvt_pk_bf16(x[2], x[3]); w.z = cvt_pk_bf16(y[0], y[1]); w.w = cvt_pk_bf16(y[2], y[3]);
            *(u32x4*)(LH + (size_t)row * 768 + c) = w; }
    } };
struct FLoraW { h16* EW; const float* w0;
    __device__ __forceinline__ void operator()(int row, int col0, f32x4 a, f32x4 b) const {
        const f32x4 p = *(const f32x4*)(w0 + col0), q = *(const f32x4*)(w0 + col0 + 4); float o[8];
#pragma unroll
        for (int i = 0; i < 4; ++i) { o[i] = 0.60653066f * sigmoidf_(p[i] + a[i]); o[4 + i] = 0.60653066f * sigmoidf_(q[i] + b[i]); }
        u32x4 w; w.x = pk_h16(o[0], o[1]); w.y = pk_h16(o[2], o[3]); w.z = pk_h16(o[4], o[5]); w.w = pk_h16(o[6], o[7]);
        *(u32x4*)(EW + (size_t)row * D + col0) = w; } };
struct FLoraA { h16* Aa; const float* a0;
    __device__ __forceinline__ void operator()(int row, int col0, f32x4 a, f32x4 b) const {
        const f32x4 p = *(const f32x4*)(a0 + col0), q = *(const f32x4*)(a0 + col0 + 4); float o[8];
#pragma unroll
        for (int i = 0; i < 4; ++i) { o[i] = sigmoidf_(p[i] + a[i]); o[4 + i] = sigmoidf_(q[i] + b[i]); }
        u32x4 w; w.x = pk_h16(o[0], o[1]); w.y = pk_h16(o[2], o[3]); w.z = pk_h16(o[4], o[5]); w.w = pk_h16(o[6], o[7]);
        *(u32x4*)(Aa + (size_t)row * D + col0) = w; } };
struct FLoraV { h16* V; const h16* VFm; const float* v0;
    __device__ __forceinline__ void operator()(int row, int col0, f32x4 a, f32x4 b) const {
        const f32x4 p = *(const f32x4*)(v0 + col0), q = *(const f32x4*)(v0 + col0 + 4);
        typedef h16 h16x8 __attribute__((ext_vector_type(8)));
        const h16x8 vv = *(const h16x8*)(V + (size_t)row * D + col0), vf = *(const h16x8*)(VFm + (size_t)row * D + col0); float o[8];
#pragma unroll
        for (int i = 0; i < 4; ++i) { float v = (float)vv[i], f = (float)vf[i]; o[i] = v + (f - v) * sigmoidf_(p[i] + a[i]); v = (float)vv[4 + i]; f = (float)vf[4 + i]; o[4 + i] = v + (f - v) * sigmoidf_(q[i] + b[i]); }
        u32x4 w; w.x = pk_h16(o[0], o[1]); w.y = pk_h16(o[2], o[3]); w.z = pk_h16(o[4], o[5]); w.w = pk_h16(o[6], o[7]);
        *(u32x4*)(V + (size_t)row * D + col0) = w; } };
struct FGate { bf16_t* O; const h16* Y;
    __device__ __forceinline__ void operator()(int row, int col0, f32x4 a, f32x4 b) const {
        typedef h16 h16x8 __attribute__((ext_vector_type(8)));
        const h16x8 yy = *(const h16x8*)(Y + (size_t)row * D + col0);
        u32x4 w; w.x = cvt_pk_bf16(a[0] * (float)yy[0], a[1] * (float)yy[1]); w.y = cvt_pk_bf16(a[2] * (float)yy[2], a[3] * (float)yy[3]);
        w.z = cvt_pk_bf16(b[0] * (float)yy[4], b[1] * (float)yy[5]); w.w = cvt_pk_bf16(b[2] * (float)yy[6], b[3] * (float)yy[7]);
        *(u32x4*)(O + (size_t)row * D + col0) = w; } };

template <int CTRL> __device__ __forceinline__ float dppmov(float v) { return __builtin_bit_cast(float, __builtin_amdgcn_update_dpp(0, __builtin_bit_cast(int, v), CTRL, 0xF, 0xF, true)); }
__device__ __forceinline__ float row16_sum(float v) { v += dppmov<0xB1>(v); v += dppmov<0x4E>(v); v += dppmov<0x124>(v); v += dppmov<0x128>(v); return v; }
typedef _Float16 h16x4 __attribute__((ext_vector_type(4)));
__device__ __forceinline__ void h4_to_f(h16x4 u, float* f) { f[0] = (float)u[0]; f[1] = (float)u[1]; f[2] = (float)u[2]; f[3] = (float)u[3]; }
__device__ __forceinline__ void rwkv_scan(const h16* R, const h16* Kk, const h16* V, const h16* EW, const h16* Aa, const float* k_k, const float* k_a, h16* Yraw, int G, int wave, int lane_) {
    int lane = lane_; asm volatile("" : "+v"(lane));
    const int NT = G * NWAVES;
    for (int task = wave * G + (int)blockIdx.x; task < 512; task += NT) {
        const int bh = task >> 4, rg = task & 15, b = bh >> 4, h = bh & 15;
        const int row = lane >> 4, jg = lane & 15, i = rg * 4 + row;
        const int colj = h * 64 + 4 * jg, coli = h * 64 + i;
        float kkc[4], kac[4];
#pragma unroll
        for (int j = 0; j < 4; ++j) { kkc[j] = k_k[colj + j]; kac[j] = k_a[colj + j]; }
        float s[4] = {0.f, 0.f, 0.f, 0.f};
        const size_t base = (size_t)b * S * D;
        const h16* pR = R + base + colj; const h16* pK = Kk + base + colj; const h16* pA = Aa + base + colj; const h16* pE = EW + base + colj; const h16* pV = V + base + coli;
        h16* pY = Yraw + ((size_t)task * S) * 4 + row;
        constexpr int TC = 4;
        h16x4 cr[TC], ck[TC], ca[TC], ce[TC]; h16 cv[TC];
#pragma unroll
        for (int u = 0; u < TC; ++u) { const size_t o = (size_t)u * D; cr[u] = *(const h16x4*)(pR + o); ck[u] = *(const h16x4*)(pK + o); ca[u] = *(const h16x4*)(pA + o); ce[u] = *(const h16x4*)(pE + o); cv[u] = pV[o]; }
        for (int t0 = 0; t0 < S; t0 += TC) {
            const int tn = (t0 + TC < S) ? t0 + TC : t0;
            h16x4 nr[TC], nk[TC], na[TC], ne[TC]; h16 nv[TC];
#pragma unroll
            for (int u = 0; u < TC; ++u) { const size_t o = (size_t)(tn + u) * D; nr[u] = *(const h16x4*)(pR + o); nk[u] = *(const h16x4*)(pK + o); na[u] = *(const h16x4*)(pA + o); ne[u] = *(const h16x4*)(pE + o); nv[u] = pV[o]; }
#pragma unroll
            for (int u = 0; u < TC; ++u) {
                float rv[4], kv[4], av[4], ev[4]; h4_to_f(cr[u], rv); h4_to_f(ck[u], kv); h4_to_f(ca[u], av); h4_to_f(ce[u], ev);
                const float vi = (float)cv[u];
                float kq[4], n2 = 0.f;
#pragma unroll
                for (int j = 0; j < 4; ++j) { kq[j] = kv[j] * kkc[j]; n2 += kq[j] * kq[j]; }
                n2 = row16_sum(n2);
                const float inv = 1.0f / fmaxf(sqrtf(n2), 1e-12f);
                float kkj[4], kt[4], bb[4], w[4], dot = 0.f;
#pragma unroll
                for (int j = 0; j < 4; ++j) { kkj[j] = kq[j] * inv; kt[j] = kv[j] * (1.0f + (av[j] - 1.0f) * kac[j]); bb[j] = kkj[j] * av[j]; w[j] = __expf(-ev[j]); dot += s[j] * kkj[j]; }
                const float sa = -row16_sum(dot);
                float yd = 0.f;
#pragma unroll
                for (int j = 0; j < 4; ++j) { s[j] = s[j] * w[j] + (sa * bb[j] + vi * kt[j]); yd += s[j] * rv[j]; }
                const float y = row16_sum(yd);
                if (jg == 0) pY[(size_t)(t0 + u) * 4] = (h16)y;
            }
#pragma unroll
            for (int u = 0; u < TC; ++u) { cr[u] = nr[u]; ck[u] = nk[u]; ca[u] = na[u]; ce[u] = ne[u]; cv[u] = nv[u]; }
        }
    }
}
constexpr int SC_CS = 32, SC_STEP_F = 5 * 64 + 8, SC_BUF_F = SC_CS * SC_STEP_F;
#define SC_BAR() do { asm volatile("s_waitcnt lgkmcnt(0)" ::: "memory"); __builtin_amdgcn_s_barrier(); asm volatile("" ::: "memory"); } while (0)
__device__ __forceinline__ float wave_sum_dpp(float v) {
    v = row16_sum(v);
    const float a = __builtin_bit_cast(float, __builtin_amdgcn_readlane(__builtin_bit_cast(int, v), 0)), b = __builtin_bit_cast(float, __builtin_amdgcn_readlane(__builtin_bit_cast(int, v), 16));
    const float c = __builtin_bit_cast(float, __builtin_amdgcn_readlane(__builtin_bit_cast(int, v), 32)), d = __builtin_bit_cast(float, __builtin_amdgcn_readlane(__builtin_bit_cast(int, v), 48));
    return (a + b) + (c + d);
}
struct ScRegs { h16 k[8], a[8], e[8], r[8], v[8]; };
__device__ __forceinline__ void sc_load(ScRegs& g, const h16* R, const h16* Kk, const h16* V, const h16* EW, const h16* Aa, size_t base, int c, int pw, int sub, int lane) {
#pragma unroll
    for (int q = 0; q < 8; ++q) { const size_t o = base + (size_t)(c * SC_CS + pw + 4 * q) * D;
        g.k[q] = Kk[o + lane]; g.a[q] = Aa[o + lane]; g.e[q] = EW[o + lane]; g.r[q] = R[o + lane]; g.v[q] = V[o + sub * 8 + (lane & 7)]; }
}
__device__ __forceinline__ void sc_compute(const ScRegs& g, LAS float* sb, int pw, float kkc, float kac, int lane) {
#pragma unroll
    for (int q = 0; q < 8; ++q) {
        const float kv = (float)g.k[q], av = (float)g.a[q], ev = (float)g.e[q], rv = (float)g.r[q]; const float kq = kv * kkc;
        const float n2 = wave_sum_dpp(kq * kq);
        const float kkj = kq * rsqrtf(fmaxf(n2, 1e-24f)); LAS float* p = sb + (pw + 4 * q) * SC_STEP_F;
        p[lane] = kkj; p[64 + lane] = kkj * av; p[128 + lane] = kv * (1.0f + (av - 1.0f) * kac); p[192 + lane] = __expf(-ev); p[256 + lane] = rv; if (lane < 8) p[320 + lane] = (float)g.v[q];
    }
}
__device__ __forceinline__ void rwkv_scan2(const h16* R, const h16* Kk, const h16* V, const h16* EW, const h16* Aa, const float* k_k, const float* k_a, h16* Yraw, LAS unsigned char* lds, int wave, int lane_) {
    int lane = lane_; asm volatile("" : "+v"(lane));
    LAS float* buf = (LAS float*)lds;
    constexpr int NCH = S / SC_CS;
#pragma unroll 1
    for (int vb = (int)blockIdx.x; vb < 256; vb += (int)gridDim.x) {
        const int bh = vb >> 3, sub = vb & 7, b = bh >> 4, h = bh & 15;
        const size_t base = (size_t)b * S * D + h * 64;
        if (wave >= 4) {
            const int pw = wave - 4;
            const float kkc = k_k[h * 64 + lane], kac = k_a[h * 64 + lane];
            ScRegs ga, gb;
            sc_load(ga, R, Kk, V, EW, Aa, base, 0, pw, sub, lane);
            sc_load(gb, R, Kk, V, EW, Aa, base, 1, pw, sub, lane);
            sc_compute(ga, buf, pw, kkc, kac, lane);
            SC_BAR();
#pragma unroll 1
            for (int c = 0; c < NCH; c += 2) {
                { const int c2 = (c + 2 < NCH) ? c + 2 : c; sc_load(ga, R, Kk, V, EW, Aa, base, c2, pw, sub, lane); }
                sc_compute(gb, buf + SC_BUF_F, pw, kkc, kac, lane);
                SC_BAR();
                { const int c3 = (c + 3 < NCH) ? c + 3 : c + 1; sc_load(gb, R, Kk, V, EW, Aa, base, c3, pw, sub, lane); }
                if (c + 2 < NCH) sc_compute(ga, buf, pw, kkc, kac, lane);
                SC_BAR();
            }
            SC_BAR();
        } else if (wave < 2) {
            const int jg = lane & 15, cw = wave;
            f32x2 sA = {0.f, 0.f}, sB = {0.f, 0.f};
#define SC_LO(v) __builtin_shufflevector(v, v, 0, 1)
#define SC_HI(v) __builtin_shufflevector(v, v, 2, 3)
            SC_BAR();
#pragma unroll 1
            for (int c = 0; c < NCH; ++c) {
                const LAS float* sb = buf + (c & 1) * SC_BUF_F + 4 * jg;
                const LAS float* vb_ = buf + (c & 1) * SC_BUF_F + 320 + cw * 4 + (lane >> 4);
                LAS float* yp = buf + 2 * SC_BUF_F + ((c & 1) * 2 + cw) * (SC_CS * 64) + lane;
                f32x4 kk4 = *(const LAS f32x4*)(sb), bb4 = *(const LAS f32x4*)(sb + 64), kt4 = *(const LAS f32x4*)(sb + 128), w4 = *(const LAS f32x4*)(sb + 192), r4 = *(const LAS f32x4*)(sb + 256); float vi = vb_[0];
                f32x4 kk5 = *(const LAS f32x4*)(sb + SC_STEP_F), bb5 = *(const LAS f32x4*)(sb + SC_STEP_F + 64), kt5 = *(const LAS f32x4*)(sb + SC_STEP_F + 128), w5 = *(const LAS f32x4*)(sb + SC_STEP_F + 192), r5 = *(const LAS f32x4*)(sb + SC_STEP_F + 256); float vi5 = vb_[SC_STEP_F];
#pragma unroll
                for (int st = 0; st < SC_CS; ++st) {
                    const int sn = (st + 2 < SC_CS) ? st + 2 : SC_CS - 1;
                    const f32x4 nkk = *(const LAS f32x4*)(sb + sn * SC_STEP_F), nbb = *(const LAS f32x4*)(sb + sn * SC_STEP_F + 64), nkt = *(const LAS f32x4*)(sb + sn * SC_STEP_F + 128), nw = *(const LAS f32x4*)(sb + sn * SC_STEP_F + 192), nr4 = *(const LAS f32x4*)(sb + sn * SC_STEP_F + 256);
                    const float nvi = vb_[sn * SC_STEP_F];
                    f32x2 tt = sA * SC_LO(kk4); tt = sB * SC_HI(kk4) + tt;
                    const float sa = -row16_sum(tt.x + tt.y);
                    const f32x2 sa2 = {sa, sa}, vi2 = {vi, vi};
                    f32x2 uA = vi2 * SC_LO(kt4); uA = sa2 * SC_LO(bb4) + uA; sA = sA * SC_LO(w4) + uA;
                    f32x2 uB = vi2 * SC_HI(kt4); uB = sa2 * SC_HI(bb4) + uB; sB = sB * SC_HI(w4) + uB;
                    f32x2 yy = sA * SC_LO(r4); yy = sB * SC_HI(r4) + yy;
                    yp[st * 64] = yy.x + yy.y;
                    kk4 = kk5; bb4 = bb5; kt4 = kt5; w4 = w5; r4 = r5; vi = vi5;
                    kk5 = nkk; bb5 = nbb; kt5 = nkt; w5 = nw; r5 = nr4; vi5 = nvi;
                }
                SC_BAR();
            }
            SC_BAR();
        } else {
            const int cw = wave - 2;
            h16* pY = Yraw + ((size_t)(bh * 16 + sub * 2 + cw) * S) * 4;
            SC_BAR();
#pragma unroll 1
            for (int c = 0; c <= NCH; ++c) {
                if (c > 0) {
                    const LAS float* yp = buf + 2 * SC_BUF_F + (((c - 1) & 1) * 2 + cw) * (SC_CS * 64);
                    const int st = lane >> 1, r0 = 2 * (lane & 1);
                    float a0 = 0.f, a1 = 0.f;
#pragma unroll
                    for (int q = 0; q < 4; ++q) { const f32x4 x = *(const LAS f32x4*)(yp + st * 64 + r0 * 16 + 4 * q), z = *(const LAS f32x4*)(yp + st * 64 + (r0 + 1) * 16 + 4 * q);
                        a0 += (x[0] + x[1]) + (x[2] + x[3]); a1 += (z[0] + z[1]) + (z[2] + z[3]); }
                    *(unsigned*)(pY + (size_t)((c - 1) * SC_CS + st) * 4 + r0) = pk_h16(a0, a1);
                }
                SC_BAR();
            }
        }
        if (false) {
            SC_BAR();
#pragma unroll 1
            for (int c = 0; c < NCH; ++c) SC_BAR();
        }
    }
}
__device__ __forceinline__ void rwkv_gn(h16* R, const h16* Kk, const h16* V, const h16* Aa, const h16* Yraw, const float* k_a, const float* r_k, const float* ln_w, const float* ln_b, int gw, int NGW, int lane_) {
    int lane = lane_; asm volatile("" : "+v"(lane));
    const int hq = lane >> 4, c4 = 4 * (lane & 15);
#pragma unroll 2
    for (int idx = gw; idx < M * 4; idx += NGW) {
        const int m = idx >> 2, h = (idx & 3) * 4 + hq, col = h * 64 + c4; const size_t o = (size_t)m * D + col;
        const int bq = m / S, tq = m - bq * S;
        float y[4], r[4], k[4], a[4], v[4];
        h4_to_f(*(const h16x4*)(Yraw + ((size_t)((bq * 16 + h) * 16 + (lane & 15)) * S + tq) * 4), y);
        h4_to_f(*(const h16x4*)(R + o), r); h4_to_f(*(const h16x4*)(Kk + o), k); h4_to_f(*(const h16x4*)(Aa + o), a); h4_to_f(*(const h16x4*)(V + o), v);
        const f32x4 ka4 = *(const f32x4*)(k_a + col), rk4 = *(const f32x4*)(r_k + col), lw4 = *(const f32x4*)(ln_w + col), lb4 = *(const f32x4*)(ln_b + col);
        const float mu = row16_sum((y[0] + y[1]) + (y[2] + y[3])) * (1.f / 64.f);
        float d[4], q = 0.f, bsp = 0.f;
#pragma unroll
        for (int i = 0; i < 4; ++i) { d[i] = y[i] - mu; q += d[i] * d[i]; const float kt = k[i] * (1.0f + (a[i] - 1.0f) * ka4[i]); bsp += r[i] * kt * rk4[i]; }
        const float rstd = rsqrtf(row16_sum(q) * (1.f / 64.f) + 64e-5f), bs = row16_sum(bsp);
        h16x4 outv;
#pragma unroll
        for (int i = 0; i < 4; ++i) outv[i] = (h16)(d[i] * rstd * lw4[i] + lb4[i] + bs * v[i]);
        *(h16x4*)(R + o) = outv;
    }
}

constexpr size_t KF_STRIDE = (size_t)NB * 4 * S * 64;
__device__ __forceinline__ float gelu_tanh(float x) { const float u = 0.7978845608f * (x + 0.044715f * x * x * x); return 0.5f * x * (1.0f + tanhf_(u)); }
__device__ __forceinline__ void store_vf8(bf16_t* chunk_base_d, int keyp0  , f32x4 a, f32x4 b) {
    const int tile = keyp0 >> 4, rq0 = (keyp0 & 15) >> 2;
    u32x2 w0, w1; w0.x = cvt_pk_bf16(a[0], a[1]); w0.y = cvt_pk_bf16(a[2], a[3]); w1.x = cvt_pk_bf16(b[0], b[1]); w1.y = cvt_pk_bf16(b[2], b[3]);
    *(u32x2*)(chunk_base_d + 8 * rq0 + 4 * tile) = w0; *(u32x2*)(chunk_base_d + 8 * (rq0 + 1) + 4 * tile) = w1;
}
struct FNsaIn { bf16_t* Q; bf16_t* KF; float* gates; const float* rope;
    __device__ __forceinline__ void operator()(int row, int col0, f32x4 a, f32x4 b) const {
        const int tile = __builtin_amdgcn_readfirstlane(col0 >> 8);
        const int bb = row / S, t = row - bb * S;
        if (tile < 7) {
            f32x4 x = a, y = b;
            if ((col0 & 32) == 0) {
                f32x4 px, py;
#pragma unroll
                for (int i = 0; i < 4; ++i) { px[i] = __shfl_xor(x[i], 16); py[i] = __shfl_xor(y[i], 16); }
                const int d0 = col0 & 63;
                if (d0 < 16) { const f32x4 c0 = *(const f32x4*)(rope + t * 16), c1 = *(const f32x4*)(rope + t * 16 + 4), s0 = *(const f32x4*)(rope + t * 16 + 8), s1 = *(const f32x4*)(rope + t * 16 + 12);
                    if (d0 == 0) { x = x * c0 - px * s0; y = y * c1 - py * s1; } else { x = x * c0 + px * s0; y = y * c1 + py * s1; } }
            }
            if (tile < 4) { x = x * 0.18033688011112042f; y = y * 0.18033688011112042f;
                u32x4 w; w.x = cvt_pk_bf16(x[0], x[1]); w.y = cvt_pk_bf16(x[2], x[3]); w.z = cvt_pk_bf16(y[0], y[1]); w.w = cvt_pk_bf16(y[2], y[3]);
                *(u32x4*)(Q + (size_t)row * D + col0) = w; }
            else { const int idx = tile - 4, g = (col0 & 255) >> 6, d0 = col0 & 63;
                u32x4 w; w.x = cvt_pk_bf16(x[0], x[1]); w.y = cvt_pk_bf16(x[2], x[3]); w.z = cvt_pk_bf16(y[0], y[1]); w.w = cvt_pk_bf16(y[2], y[3]);
                *(u32x4*)(KF + (size_t)idx * KF_STRIDE + ((size_t)(bb * 4 + g) * S + t) * 64 + d0) = w; }
        } else if (tile == 7) { const int g = (col0 & 255) >> 6, d0 = col0 & 63;
            u32x4 w; w.x = cvt_pk_bf16(a[0], a[1]); w.y = cvt_pk_bf16(a[2], a[3]); w.z = cvt_pk_bf16(b[0], b[1]); w.w = cvt_pk_bf16(b[2], b[3]);
            *(u32x4*)(KF + (size_t)3 * KF_STRIDE + ((size_t)(bb * 4 + g) * S + t) * 64 + d0) = w;
        } else { const int c = col0 - 2048;
            if (c < 48) { f32x4 x, y;
#pragma unroll
                for (int i = 0; i < 4; ++i) { x[i] = sigmoidf_(a[i]); y[i] = sigmoidf_(b[i]); }
                *(f32x4*)(gates + (size_t)row * 48 + c) = x; *(f32x4*)(gates + (size_t)row * 48 + c + 4) = y; }
        }
    } };
struct FNsaVT { bf16_t* VF;
    __device__ __forceinline__ void operator()(int row, int col0, f32x4 a, f32x4 b) const {
        const int br = row >> 8, g = (row >> 6) & 3, d = row & 63, bb = col0 / S, t0 = col0 - bb * S;
        bf16_t* base = VF + (size_t)br * KF_STRIDE + (size_t)(bb * 4 + g) * S * 64 + (size_t)(t0 >> 5) * 2048 + d * 32;
        store_vf8(base, t0 & 31, a, b); } };
struct FCmp1 { bf16_t* CH; const float* bias;
    __device__ __forceinline__ void operator()(int row, int col0, f32x4 a, f32x4 b) const {
        const f32x4 p = *(const f32x4*)(bias + col0), q = *(const f32x4*)(bias + col0 + 4); float o[8];
#pragma unroll
        for (int i = 0; i < 4; ++i) { o[i] = gelu_tanh(a[i] + p[i]); o[4 + i] = gelu_tanh(b[i] + q[i]); }
        u32x4 w; w.x = cvt_pk_bf16(o[0], o[1]); w.y = cvt_pk_bf16(o[2], o[3]); w.z = cvt_pk_bf16(o[4], o[5]); w.w = cvt_pk_bf16(o[6], o[7]);
        *(u32x4*)(CH + (size_t)row * 256 + col0) = w; } };
struct FCmp2K { bf16_t* KC;
    __device__ __forceinline__ void operator()(int row, int col0, f32x4 a, f32x4 b) const {
        if (col0 < 64) { u32x4 w; w.x = cvt_pk_bf16(a[0], a[1]); w.y = cvt_pk_bf16(a[2], a[3]); w.z = cvt_pk_bf16(b[0], b[1]); w.w = cvt_pk_bf16(b[2], b[3]);
            *(u32x4*)(KC + (size_t)row * 64 + col0) = w; } } };
struct FCmp2VT { bf16_t* VC;
    __device__ __forceinline__ void operator()(int row, int col0, f32x4 a, f32x4 b) const {
        if (row < 64) { const int bg = col0 >> 10, n0 = col0 & 1023;
            bf16_t* base = VC + (size_t)bg * 65536 + (size_t)(n0 >> 5) * 2048 + row * 32; store_vf8(base, n0 & 31, a, b); } } };

__device__ __forceinline__ f32x4 mfma16(bf16x8 a, bf16x8 b, f32x4 c) { return __builtin_amdgcn_mfma_f32_16x16x32_bf16(a, b, c, 0, 0, 0); }
__device__ __forceinline__ bf16x8 ld8(const bf16_t* p) { return *(const bf16x8*)p; }
__device__ __forceinline__ bf16x8 pack8(f32x4 a, f32x4 b) { u32x4 w; w.x = cvt_pk_bf16(a[0], a[1]); w.y = cvt_pk_bf16(a[2], a[3]); w.z = cvt_pk_bf16(b[0], b[1]); w.w = cvt_pk_bf16(b[2], b[3]); return __builtin_bit_cast(bf16x8, w); }
__device__ __forceinline__ float colmax(float x) {
    const auto r = __builtin_amdgcn_permlane16_swap(__float_as_uint(x), __float_as_uint(x), false, false); x = fmaxf(__uint_as_float(r[0]), __uint_as_float(r[1]));
    const auto q = __builtin_amdgcn_permlane32_swap(__float_as_uint(x), __float_as_uint(x), false, false); return fmaxf(__uint_as_float(q[0]), __uint_as_float(q[1])); }
__device__ __forceinline__ float colsum(float x) {
    const auto r = __builtin_amdgcn_permlane16_swap(__float_as_uint(x), __float_as_uint(x), false, false); x = __uint_as_float(r[0]) + __uint_as_float(r[1]);
    const auto q = __builtin_amdgcn_permlane32_swap(__float_as_uint(x), __float_as_uint(x), false, false); return __uint_as_float(q[0]) + __uint_as_float(q[1]); }
template <int CTRL> __device__ __forceinline__ unsigned dppmov_u(unsigned v) { return (unsigned)__builtin_amdgcn_update_dpp(0, (int)v, CTRL, 0xF, 0xF, true); }
__device__ __forceinline__ unsigned wave_max_u32(unsigned v) {
    v = max(v, dppmov_u<0xB1>(v)); v = max(v, dppmov_u<0x4E>(v)); v = max(v, dppmov_u<0x124>(v)); v = max(v, dppmov_u<0x128>(v));
    const auto r = __builtin_amdgcn_permlane16_swap(v, v, false, false); v = max((unsigned)r[0], (unsigned)r[1]);
    const auto q = __builtin_amdgcn_permlane32_swap(v, v, false, false); return max((unsigned)q[0], (unsigned)q[1]); }
struct AttnState { float m, l; f32x4 o[4]; };
__device__ __forceinline__ void attn_init(AttnState& st) { st.m = -1e30f; st.l = 0.f;
#pragma unroll
    for (int d = 0; d < 4; ++d) st.o[d] = (f32x4){0.f, 0.f, 0.f, 0.f}; }
struct KVChunk { bf16x8 k[4]; bf16x8 v[4]; };
__device__ __forceinline__ void kv_load(KVChunk& B, const bf16_t* kptr, const bf16_t* vptr) {
#pragma unroll
    for (int tl = 0; tl < 2; ++tl) { B.k[tl * 2] = ld8(kptr + tl * 1024); B.k[tl * 2 + 1] = ld8(kptr + tl * 1024 + 32); }
#pragma unroll
    for (int d = 0; d < 4; ++d) B.v[d] = ld8(vptr + d * 512);
}
struct KRange { int klo, span; };
__device__ __forceinline__ KRange krange(int klo, int khi) { KRange r; if (khi < klo) { r.klo = 64; r.span = 0; } else { r.klo = klo; r.span = khi - klo; } return r; }
template <bool MASKED>
__device__ __forceinline__ void attn_chunk_r(AttnState& st, const bf16x8 (&kf)[4], const bf16x8 (&vf)[4], const bf16x8 q0, const bf16x8 q1, KRange kr) {
    f32x4 s[2];
#pragma unroll
    for (int tl = 0; tl < 2; ++tl) { s[tl] = mfma16(kf[tl * 2], q0, (f32x4){0.f, 0.f, 0.f, 0.f}); s[tl] = mfma16(kf[tl * 2 + 1], q1, s[tl]); }
    float mx = -1e30f;
#pragma unroll
    for (int tl = 0; tl < 2; ++tl)
#pragma unroll
        for (int i = 0; i < 4; ++i) { if (MASKED) { const bool v = (unsigned)(tl * 16 + i - kr.klo) <= (unsigned)kr.span; s[tl][i] = v ? s[tl][i] : -1e30f; } mx = fmaxf(mx, s[tl][i]); }
    mx = colmax(mx);
    if (__any(mx > st.m)) {
        const float mnew = fmaxf(st.m, mx), alpha = __builtin_amdgcn_exp2f(st.m - mnew);
        st.l *= alpha; st.m = mnew;
#pragma unroll
        for (int d = 0; d < 4; ++d) st.o[d] = st.o[d] * alpha;
    }
    const float mcur = st.m;
    f32x4 p[2]; float ps = 0.f;
#pragma unroll
    for (int tl = 0; tl < 2; ++tl)
#pragma unroll
        for (int i = 0; i < 4; ++i) { const float e = __builtin_amdgcn_exp2f(s[tl][i] - mcur); p[tl][i] = e; ps += e; }
    st.l += ps;
    const bf16x8 pb = pack8(p[0], p[1]);
#pragma unroll
    for (int d = 0; d < 4; ++d) st.o[d] = mfma16(vf[d], pb, st.o[d]);
}

#define ATT_STEPN(C, idx) do { _Pragma("unroll") for (int gg = 0; gg < NG; ++gg) { if (act(gg, idx)) { \
        if (ff(gg, idx)) attn_chunk_r<false>(gs[gg], C.k, C.v, gq[gg][0], gq[gg][1], KRange{0, 0}); else attn_chunk_r<true>(gs[gg], C.k, C.v, gq[gg][0], gq[gg][1], mf(gg, idx)); } \
        __builtin_amdgcn_sched_barrier(0); } } while (0)
template <int NG, class AddrK, class AddrV, class ActF, class FullF, class MaskF>
__device__ __forceinline__ void attn_chunksN(AttnState (&gs)[NG], const bf16x8 (&gq)[NG][2], int n, AddrK ak, AddrV av, ActF act, FullF ff, MaskF mf) {
    if constexpr (NG <= 2) {
        KVChunk C0, C1;
        if (n > 0) kv_load(C0, ak(0), av(0));
#pragma unroll 1
        for (int i = 0; i < n; i += 2) {
            if (i + 1 < n) kv_load(C1, ak(i + 1), av(i + 1));
            ATT_STEPN(C0, i);
            if (i + 1 < n) {
                if (i + 2 < n) kv_load(C0, ak(i + 2), av(i + 2));
                ATT_STEPN(C1, i + 1);
            }
        }
    } else {
#pragma unroll 1
        for (int i = 0; i < n; ++i) { KVChunk C0; kv_load(C0, ak(i), av(i)); ATT_STEPN(C0, i); }
    }
}

__device__ __forceinline__ void nsa_attention(const bf16_t* Q, const bf16_t* KF, const bf16_t* VF, const bf16_t* KC, const bf16_t* VC, const float* gates, bf16_t* OUT, LAS unsigned char* lds, int G, int wave, int lane_) {
    int lane0 = lane_; asm volatile("" : "+v"(lane0));
    LAS float* imp = (LAS float*)(lds + wave * 18432);
    LAS float* tl = imp;
    LAS int* sel = (LAS int*)(lds + wave * 18432 + 16384);
    LAS unsigned* smask32 = (LAS unsigned*)(lds + wave * 18432 + 16384 + 1088);
    LAS unsigned char* blist = (LAS unsigned char*)(lds + wave * 18432 + 16384 + 1088 + 512);
    const bool xcd_map = (G % 8) == 0;
    const int nslots = xcd_map ? (G >> 3) * NWAVES : G * NWAVES, slot = xcd_map ? ((int)blockIdx.x >> 3) * NWAVES + wave : (int)blockIdx.x * NWAVES + wave;
    const int ntask = xcd_map ? 1024 : 8192;
#pragma unroll 1
    for (int task = slot; task < ntask; task += nslots) {
        int lane = lane0; asm volatile("" : "+v"(lane)); lane &= 63;
        const int col = lane & 15, rq = lane >> 4;
        const int tilei = xcd_map ? task : (task >> 3), bg = xcd_map ? ((int)blockIdx.x & 7) : (task & 7), b = bg >> 2, g = bg & 3, t0 = tilei * 16, t = t0 + col;
        const size_t rowq = (size_t)b * S + t;
        const bf16_t* qrow = Q + rowq * D + (g * 4) * 64 + 8 * rq;
        const float* grow = gates + rowq * 48 + g * 12;
        const int cur_max = (t0 + 15) >> 6;
        int n_end = 4 * (cur_max + 1); if (n_end > 1024) n_end = 1024;
        const int nchunk_c = (n_end + 31) >> 5;
        const bf16_t* kc_l = KC + (size_t)bg * 65536 + (size_t)col * 64 + 8 * rq;
        const bf16_t* vc_l = VC + (size_t)bg * 65536 + (size_t)col * 32 + 8 * rq;
        {
        AttnState gs[4]; bf16x8 gq[4][2];
#pragma unroll
        for (int h = 0; h < 4; ++h) { gq[h][0] = ld8(qrow + h * 64); gq[h][1] = ld8(qrow + h * 64 + 32); attn_init(gs[h]); }
        attn_chunksN<4>(gs, gq, nchunk_c,
            [&](int ci) { return kc_l + (size_t)ci * 2048; }, [&](int ci) { return vc_l + (size_t)ci * 2048; },
            [&](int, int) { return true; },
            [&](int, int ci) { return 16 * (ci * 32 + 31) + 31 <= t0; },
            [&](int, int ci) { const int nhi = (t >= 31) ? ((t - 31) >> 4) : -1; return krange(0, nhi - ci * 32 - 4 * rq); });
        {
            float mc[4], lc[4];
#pragma unroll
            for (int h = 0; h < 4; ++h) { const float lt = colsum(gs[h].l); mc[h] = gs[h].m; lc[h] = (gs[h].m > -1e29f && lt > 0.f) ? 1.0f / lt : 0.f; }
            {
                float carry = 0.f;
#pragma unroll 1
                for (int kc = 0; kc < nchunk_c; ++kc) {
#pragma unroll
                    for (int tt = 0; tt < 2; ++tt) {
                        const bf16x8 k0 = ld8(kc_l + (size_t)kc * 2048 + tt * 1024), k1 = ld8(kc_l + (size_t)kc * 2048 + tt * 1024 + 32);
                        float own = 0.f, p3 = 0.f;
#pragma unroll
                        for (int h = 0; h < 4; ++h) {
                            f32x4 sc = mfma16(k0, gq[h][0], (f32x4){0.f, 0.f, 0.f, 0.f}); sc = mfma16(k1, gq[h][1], sc);
#pragma unroll
                            for (int i = 0; i < 4; ++i) { const int n = kc * 32 + tt * 16 + 4 * rq + i; const float p = (16 * n + 31 <= t) ? __builtin_amdgcn_exp2f(sc[i] - mc[h]) * lc[h] : 0.f; own += p; if (i == 3) p3 += p; }
                        }
                        const float up = __shfl(p3, (lane + 48) & 63);
                        const float add = (rq == 0) ? carry : up;
                        imp[col * 256 + kc * 8 + tt * 4 + rq] = own + add;
                        carry = __shfl(p3, col + 48);
                    }
                }
            }
#pragma unroll 1
            for (int c = 0; c < 16; ++c) {
                const int tc = t0 + c, cur = tc >> 6;
                if (cur < 16) { if (lane <= cur) sel[c * 17 + lane] = lane; if (lane == 0) sel[c * 17 + 16] = cur + 1; }
                else {
                    unsigned key[4];
#pragma unroll
                    for (int jx = 0; jx < 4; ++jx) { const int sb = lane + 64 * jx; const float v = imp[c * 256 + sb]; key[jx] = (sb >= 1 && sb <= cur - 2) ? ((__float_as_uint(v) & 0xFFFFFF00u) | (unsigned)(255 - sb)) : 0u; }
                    if (lane == 0) { sel[c * 17 + 0] = 0; sel[c * 17 + 1] = cur - 1; sel[c * 17 + 2] = cur; sel[c * 17 + 16] = 16; }
#pragma unroll 1
                    for (int r = 0; r < 13; ++r) {
                        unsigned best = max(max(key[0], key[1]), max(key[2], key[3]));
                        best = wave_max_u32(best);
                        if (lane == 0) sel[c * 17 + 3 + r] = 255 - (int)(best & 255u);
#pragma unroll
                        for (int jx = 0; jx < 4; ++jx) if (key[jx] == best) key[jx] = 0u;
                    }
                }
            }
#pragma unroll
            for (int h = 0; h < 4; ++h) { const float gc = grow[h * 3 + 0] * lc[h];
#pragma unroll
                for (int d = 0; d < 4; ++d)
#pragma unroll
                    for (int i = 0; i < 4; ++i) tl[(h * 16 + d * 4 + i) * 64 + lane] = gs[h].o[d][i] * gc; }
        }
        }
        {
            smask32[lane] = 0u; smask32[64 + lane] = 0u;
#pragma unroll
            for (int k4 = 0; k4 < 4; ++k4) { const int pp = lane + 64 * k4, c = pp >> 4, e = pp & 15; if (e < sel[c * 17 + 16]) { const int jb = sel[c * 17 + e]; atomicOr((unsigned*)(smask32 + (jb >> 1)), 1u << (c + 16 * (jb & 1))); } }
            const bf16_t* ks_b = KF + (size_t)1 * KF_STRIDE + (size_t)bg * S * 64 + (size_t)col * 64 + 8 * rq;
            const bf16_t* vs_b = VF + (size_t)bg * S * 64 + (size_t)col * 32 + 8 * rq;
            const int tokl = col >> 2, hd = col & 3;
            {
                int nblk = 0;
                LAS unsigned* bl32 = (LAS unsigned*)sel;
                unsigned mk4[4];
#pragma unroll
                for (int k4 = 0; k4 < 4; ++k4) { const int jb = lane + 64 * k4; mk4[k4] = (smask32[jb >> 1] >> (16 * (jb & 1))) & 0xFFFFu; }
#pragma unroll
                for (int k4 = 0; k4 < 4; ++k4) { const int jb = lane + 64 * k4; const unsigned mk = mk4[k4];
                    const unsigned long long bal = __ballot(mk != 0u); const int pos = nblk + __popcll(bal & ((1ull << lane) - 1ull)); if (mk != 0u) bl32[pos] = (unsigned)jb | (mk << 8); nblk += __popcll(bal); }
                AttnState hs[4]; bf16x8 hq[4][2];
#pragma unroll
                for (int cg = 0; cg < 4; ++cg) { const bf16_t* qp = Q + ((size_t)b * S + t0 + 4 * cg + tokl) * D + (g * 4 + hd) * 64 + 8 * rq; hq[cg][0] = ld8(qp); hq[cg][1] = ld8(qp + 32); attn_init(hs[cg]); }
                auto wrd_of = [&](int ci) { return (unsigned)__builtin_amdgcn_readfirstlane((int)bl32[ci >> 1]); };
                const int tb = t0;
                attn_chunksN<4>(hs, hq, nblk * 2,
                    [&](int ci) { return ks_b + (size_t)((int)(wrd_of(ci) & 255u) * 2 + (ci & 1)) * 2048; },
                    [&](int ci) { return vs_b + (size_t)((int)(wrd_of(ci) & 255u) * 2 + (ci & 1)) * 2048; },
                    [&](int cg, int ci) { return ((wrd_of(ci) >> (8 + 4 * cg)) & 15u) != 0u; },
                    [&](int cg, int ci) { const unsigned wd = wrd_of(ci); const int jb = (int)(wd & 255u); return ((wd >> (8 + 4 * cg)) & 15u) == 15u && jb * 64 + (ci & 1) * 32 + 31 <= tb + 4 * cg; },
                    [&](int cg, int ci) { const unsigned wd = wrd_of(ci); const int jb = (int)(wd & 255u); const unsigned mk = wd >> 8; const int tok = 4 * cg + tokl; const int kp0 = jb * 64 + (ci & 1) * 32 + 4 * rq;
                        return krange(0, ((mk >> tok) & 1u) ? (tb + tok - kp0) : -1); });
#pragma unroll
                for (int cg = 0; cg < 4; ++cg) { const int tok = 4 * cg + tokl;
                    const float lt = colsum(hs[cg].l); const float inv = (hs[cg].m > -1e29f && lt > 0.f) ? 1.0f / lt : 0.f;
                    const float gsv = gates[((size_t)b * S + t0 + tok) * 48 + g * 12 + hd * 3 + 1] * inv;
#pragma unroll
                    for (int d = 0; d < 4; ++d)
#pragma unroll
                        for (int i = 0; i < 4; ++i) tl[(hd * 16 + d * 4 + i) * 64 + tok + 16 * rq] += hs[cg].o[d][i] * gsv; }
            }
        }
        {
            int lo = t0 - 511; if (lo < 0) lo = 0; const int c0 = lo >> 5, c1 = (t0 + 15) >> 5;
            const bf16_t* kw_b = KF + (size_t)2 * KF_STRIDE + (size_t)bg * S * 64 + (size_t)col * 64 + 8 * rq;
            const bf16_t* vw_b = VF + (size_t)1 * KF_STRIDE + (size_t)bg * S * 64 + (size_t)col * 32 + 8 * rq;
            {
                AttnState gs[4]; bf16x8 gq[4][2];
#pragma unroll
                for (int h = 0; h < 4; ++h) { gq[h][0] = ld8(qrow + h * 64); gq[h][1] = ld8(qrow + h * 64 + 32); attn_init(gs[h]); }
                attn_chunksN<4>(gs, gq, c1 - c0 + 1,
                    [&](int ci) { return kw_b + (size_t)(c0 + ci) * 2048; }, [&](int ci) { return vw_b + (size_t)(c0 + ci) * 2048; },
                    [&](int, int) { return true; },
                    [&](int, int ci) { return (c0 + ci) * 32 + 31 <= t0 && (c0 + ci) * 32 + 512 > t0 + 15; },
                    [&](int, int ci) { const int cb = (c0 + ci) * 32 + 4 * rq; return krange(t - 511 - cb, t - cb); });
#pragma unroll
                for (int h = 0; h < 4; ++h) { const float lt = colsum(gs[h].l); const float inv = (gs[h].m > -1e29f && lt > 0.f) ? 1.0f / lt : 0.f; const float gwv = grow[h * 3 + 2] * inv;
#pragma unroll
                    for (int d = 0; d < 4; ++d)
#pragma unroll
                        for (int i = 0; i < 4; ++i) tl[(h * 16 + d * 4 + i) * 64 + lane] += gs[h].o[d][i] * gwv; }
            }
        }
#pragma unroll
        for (int h = 0; h < 4; ++h)
#pragma unroll
            for (int d = 0; d < 4; ++d) { float v4[4];
#pragma unroll
                for (int i = 0; i < 4; ++i) v4[i] = tl[(h * 16 + d * 4 + i) * 64 + lane];
                u32x2 w; w.x = cvt_pk_bf16(v4[0], v4[1]); w.y = cvt_pk_bf16(v4[2], v4[3]);
                *(u32x2*)(OUT + rowq * D + (g * 4 + h) * 64 + d * 16 + 4 * rq) = w; }
    }
}

#define XB_TMO      128
#define XB_XCNT(j)  (256  + 64 * (j))
#define XB_XSUB(j)  (1280 + 64 * (j))
#define XB_XGEN(j)  (2304 + 64 * (j))
#define XB_TOP      3328
#define XB_TOPGEN   3392
#define XCD_BAR_WORDS 3456
#define XB_SPIN_CAP (1u << 22)
__device__ __forceinline__ unsigned xb_ld(unsigned* p)              { return __hip_atomic_load(p, __ATOMIC_RELAXED, __HIP_MEMORY_SCOPE_AGENT); }
__device__ __forceinline__ unsigned xb_add(unsigned* p, unsigned v) { return __hip_atomic_fetch_add(p, v, __ATOMIC_RELAXED, __HIP_MEMORY_SCOPE_AGENT); }
__device__ __forceinline__ unsigned xb_xcc_id() { return (unsigned)__builtin_amdgcn_s_getreg((3 << 11) | 20) & 0xFu; }
#define XB_SPIN(cond, bar) do { unsigned _sp = 0; while (cond) { __builtin_amdgcn_s_sleep(1); \
    if ((++_sp & 255u) == 0u) { if (xb_ld(&(bar)[XB_TMO])) break; if (_sp > XB_SPIN_CAP) { atomicAdd(&(bar)[XB_TMO], 1u); break; } } } } while (0)
struct XcdBarrier { unsigned* bar; unsigned x; volatile LAS unsigned* st; };
__device__ __forceinline__ void xcd_barrier_complete(unsigned* bar, unsigned x, unsigned& nloc, unsigned& nx) {
    const unsigned Gn = gridDim.x * gridDim.y * gridDim.z;
    unsigned sum, cnt, mine, sp = 0u;
    for (;;) {
        sum = 0u; cnt = 0u; mine = 0u;
#pragma unroll
        for (unsigned j = 0; j < 16; ++j) { const unsigned c = xb_ld(&bar[XB_XCNT(j)]); sum += c; cnt += (c > 0u) ? 1u : 0u; mine = (j == x) ? c : mine; }
        if (sum == Gn) break;
        __builtin_amdgcn_s_sleep(1);
        if ((++sp & 255u) == 0u) { if (xb_ld(&bar[XB_TMO])) break; if (sp > XB_SPIN_CAP) { atomicAdd(&bar[XB_TMO], 1u); break; } }
    }
    nloc = mine > 0u ? mine : 1u; nx = cnt > 0u ? cnt : 1u;
}
__device__ __forceinline__ void xcd_barrier(const XcdBarrier& b, bool leader) {
    asm volatile("s_waitcnt vmcnt(0)" ::: "memory");
    __syncthreads();
    if (leader) {
        unsigned* bar = b.bar;
        __builtin_amdgcn_s_waitcnt(0);
        unsigned nloc = b.st[0], nx = b.st[1];
        if (nloc == 0u) { xcd_barrier_complete(bar, b.x, nloc, nx); b.st[0] = nloc; b.st[1] = nx; }
        const unsigned old = xb_add(&bar[XB_XSUB(b.x)], 1u);
        const unsigned gen = old / nloc;
        if (old + 1u == (gen + 1u) * nloc) {
            __builtin_amdgcn_fence(__ATOMIC_RELEASE, "agent");
            asm volatile("s_waitcnt vmcnt(0)" ::: "memory");
            const unsigned og = xb_add(&bar[XB_TOP], 1u);
            const unsigned tg = og / nx;
            if (og + 1u == (tg + 1u) * nx) xb_add(&bar[XB_TOPGEN], 1u);
            else XB_SPIN(xb_ld(&bar[XB_TOPGEN]) == tg, bar);
            __builtin_amdgcn_fence(__ATOMIC_ACQUIRE, "agent");
            xb_add(&bar[XB_XGEN(b.x)], 1u);
            asm volatile("s_waitcnt vmcnt(0)" ::: "memory");
        } else {
            XB_SPIN(xb_ld(&bar[XB_XGEN(b.x)]) == gen, bar);
            __builtin_amdgcn_fence(__ATOMIC_ACQUIRE, "agent");
            asm volatile("s_waitcnt vmcnt(0)" ::: "memory");
        }
    }
    __syncthreads();
}
#define GSYNC() xcd_barrier(xbar, wave == 0 && lane_id() == 0)

__global__ void __launch_bounds__(NTHREADS, 2) fwd_kernel(Params P) {
    extern __shared__ __attribute__((aligned(16))) unsigned char lds_raw[];
    LAS unsigned char* lds = (LAS unsigned char*)lds_raw;
    cg::grid_group grid = cg::this_grid();
    int tidv = threadIdx.x;
    const int wave = __builtin_amdgcn_readfirstlane(tidv >> 6);
    const int G = gridDim.x, gw_k = blockIdx.x * NWAVES + wave, NGW = G * NWAVES;
    unsigned char* ws = P.ws;
    float* xres = P.out;
    LAS float* scr = (LAS float*)(lds + wave * 16384);
    const float* x_in = P.in[0];
    const float* norm_mix = P.in[1]; const float* norm_mlp = P.in[2]; const float* norm_final = P.in[3];
    const float* mlp_w1 = P.in[4]; const float* mlp_w2 = P.in[5];

    XcdBarrier xbar; xbar.bar = (unsigned*)(ws + WS_BAR); xbar.x = xb_xcc_id(); xbar.st = (volatile LAS unsigned*)(lds + 147456);
    if (tidv < 2) xbar.st[tidv] = 0u;
    if (tidv == 0) (void)xb_add(&xbar.bar[XB_XCNT(xbar.x)], 1u);
    __syncthreads();
    grid.sync();
    for (int layer = 0; layer < 4; ++layer) {
        int lane = tidv; asm volatile("" : "+v"(lane)); lane &= 63;
        int gw = gw_k; asm volatile("" : "+s"(gw));
        const bool is_rwkv = (layer & 1) != 0; const int lj = layer >> 1;
        const float* xsrc = (layer == 0) ? x_in : xres;
        {
            TJob j1{mlp_w1 + (size_t)layer * D * FF, FF, 0, FF, D, (bf16_t*)(ws + WS_W + W_MLP1), D, 0, 0, FF, D, nullptr, 0};
            transpose_job(j1, scr, gw, NGW, lane);
            TJob j2{mlp_w2 + (size_t)layer * FF * D, D, 0, D, FF, (bf16_t*)(ws + WS_W + W_MLP2), FF, 0, 0, D, FF, nullptr, 0};
            transpose_job(j2, scr, gw, NGW, lane);
            if (is_rwkv) {
                const float* mix = P.in[14] + (size_t)lj * 6 * D;
                bf16_t* WrT = (bf16_t*)(ws + WS_W + W_RW_IN);
                const float* wrkv = P.in[15] + (size_t)lj * 3 * D * D;
                for (int part = 0; part < 8; ++part) {
                    const float* W; int ldw, Nsrc, mi, r0, Npad;
                    if (part == 0) { W = wrkv; ldw = D; Nsrc = D; mi = 0; r0 = 0; Npad = D; }
                    else if (part == 1) { W = wrkv + (size_t)D * D; ldw = D; Nsrc = D; mi = 2; r0 = 1024; Npad = D; }
                    else if (part == 2) { W = wrkv + (size_t)2 * D * D; ldw = D; Nsrc = D; mi = 3; r0 = 2048; Npad = D; }
                    else if (part == 3) { W = P.in[17] + (size_t)lj * D * 64; ldw = 64; Nsrc = 64; mi = 1; r0 = 3072; Npad = 128; }
                    else if (part == 4) { W = P.in[20] + (size_t)lj * D * 64; ldw = 64; Nsrc = 64; mi = 4; r0 = 3200; Npad = 128; }
                    else if (part == 5) { W = P.in[22] + (size_t)lj * D * 160; ldw = 160; Nsrc = 160; mi = 5; r0 = 3328; Npad = 256; }
                    else if (part == 6) { W = P.in[31]; ldw = 32; Nsrc = (lj >= 1) ? 32 : 0; mi = 3; r0 = 3584; Npad = 128; }
                    else { W = P.in[31]; ldw = 32; Nsrc = 0; mi = 3; r0 = 3712; Npad = 128; }
                    TJob ja{W, ldw, 0, Nsrc, D, WrT, 2048, r0, 0, Npad, D, mix + mi * D, 1};
                    transpose_job(ja, scr, gw, NGW, lane);
                    TJob jb{W, ldw, 0, Nsrc, D, WrT, 2048, r0, 1024, Npad, D, mix + mi * D, 2};
                    transpose_job(jb, scr, gw, NGW, lane);
                }
                TJob jw{P.in[18] + (size_t)lj * 64 * D, D, 0, D, 64, (bf16_t*)(ws + WS_W + W_RW_W2), 128, 0, 0, D, 128, nullptr, 0}; transpose_job(jw, scr, gw, NGW, lane);
                TJob jaa{P.in[21] + (size_t)lj * 64 * D, D, 0, D, 64, (bf16_t*)(ws + WS_W + W_RW_A2), 128, 0, 0, D, 128, nullptr, 0}; transpose_job(jaa, scr, gw, NGW, lane);
                TJob jv{P.in[32], D, 0, D, (lj >= 1) ? 32 : 0, (bf16_t*)(ws + WS_W + W_RW_V2), 128, 0, 0, D, 128, nullptr, 0}; transpose_job(jv, scr, gw, NGW, lane);
                TJob jg{P.in[23] + (size_t)lj * 160 * D, D, 0, D, 160, (bf16_t*)(ws + WS_W + W_RW_G2), 256, 0, 0, D, 256, nullptr, 0}; transpose_job(jg, scr, gw, NGW, lane);
                TJob jo{P.in[29] + (size_t)lj * D * D, D, 0, D, D, (bf16_t*)(ws + WS_W + W_RW_O), D, 0, 0, D, D, nullptr, 0}; transpose_job(jo, scr, gw, NGW, lane);
                bf16_t* HN = (bf16_t*)(ws + A_HN);
                if (gw < 2) { u32x4* z = (u32x4*)(HN + (size_t)gw * (S + 1) * D); unsigned zz; asm volatile("v_mov_b32 %0, 0" : "=v"(zz)); for (int q = lane; q < D / 8; q += 64) z[q] = (u32x4){zz, zz, zz, zz}; }
                for (int m = gw; m < M; m += NGW) { const int b = m / S; rms_row_bf16(xsrc + (size_t)m * D, norm_mix + layer * D, HN + ((size_t)m + b + 1) * D, nullptr, lane); }
            } else {
                const float* win = P.in[6] + (size_t)lj * D * 2608;
                bf16_t* WnT = (bf16_t*)(ws + WS_W + W_NSA_IN); bf16_t* WvT = (bf16_t*)(ws + WS_W + W_NSA_V);
                for (int part = 0; part < 8; ++part) {
                    int n0src, Nsrc, r0, Npad; bf16_t* WT = WnT;
                    if (part == 0) { n0src = 0; Nsrc = 1024; r0 = 0; Npad = 1024; }
                    else if (part == 1) { n0src = 1024; Nsrc = 256; r0 = 1024; Npad = 256; }
                    else if (part == 2) { n0src = 1024 + 512; Nsrc = 256; r0 = 1280; Npad = 256; }
                    else if (part == 3) { n0src = 1024 + 1024; Nsrc = 256; r0 = 1536; Npad = 256; }
                    else if (part == 4) { n0src = 1024 + 256; Nsrc = 256; r0 = 1792; Npad = 256; }
                    else if (part == 5) { n0src = 2560; Nsrc = 48; r0 = 2048; Npad = 256; }
                    else if (part == 6) { n0src = 1024 + 768; Nsrc = 256; r0 = 0; Npad = 256; WT = WvT; }
                    else { n0src = 1024 + 1280; Nsrc = 256; r0 = 256; Npad = 256; WT = WvT; }
                    TJob jn{win, 2608, n0src, Nsrc, D, WT, D, r0, 0, Npad, D, nullptr, 0}; transpose_job(jn, scr, gw, NGW, lane);
                }
                TJob jo{P.in[13] + (size_t)lj * D * D, D, 0, D, D, (bf16_t*)(ws + WS_W + W_NSA_O), D, 0, 0, D, D, nullptr, 0}; transpose_job(jo, scr, gw, NGW, lane);
                TJob jc1k{P.in[8] + (size_t)lj * 2048 * 256, 256, 0, 256, 2048, (bf16_t*)(ws + WS_W + W_C1K), 2048, 0, 0, 256, 2048, nullptr, 0}; transpose_job(jc1k, scr, gw, NGW, lane);
                TJob jc1v{P.in[11] + (size_t)lj * 2048 * 256, 256, 0, 256, 2048, (bf16_t*)(ws + WS_W + W_C1V), 2048, 0, 0, 256, 2048, nullptr, 0}; transpose_job(jc1v, scr, gw, NGW, lane);
                TJob jc2k{P.in[9] + (size_t)lj * 256 * 64, 64, 0, 64, 256, (bf16_t*)(ws + WS_W + W_C2K), 256, 0, 0, 256, 256, nullptr, 0}; transpose_job(jc2k, scr, gw, NGW, lane);
                TJob jc2v{P.in[12] + (size_t)lj * 256 * 64, 64, 0, 64, 256, (bf16_t*)(ws + WS_W + W_C2V), 256, 0, 0, 256, 256, nullptr, 0}; transpose_job(jc2v, scr, gw, NGW, lane);
                {
                    int ln = lane; asm volatile("" : "+v"(ln));
                    float* cb = (float*)(ws + WS_W + W_CBIAS);
#pragma unroll 1
                    for (int o = gw; o < 512; o += NGW) { const int isv = o >> 8, c = o & 255;
                        const float* pe = (isv ? P.in[10] : P.in[7]) + (size_t)lj * 2048; const float* w1 = (isv ? P.in[11] : P.in[8]) + (size_t)lj * 2048 * 256;
                        float acc = 0.f;
#pragma unroll 1
                        for (int k = ln; k < 2048; k += 64) acc += pe[k] * w1[(size_t)k * 256 + c];
                        acc = wave_sum(acc); if (ln == 0) cb[o] = acc; }
                    if (layer == 0) {
                        float* rt = (float*)(ws + WS_ROPE);
                        int tix = tidv; asm volatile("" : "+v"(tix)); const int gt = (int)blockIdx.x * NTHREADS + tix;
#pragma unroll 1
                        for (int e = gt; e < S * 8; e += G * NTHREADS) { const int tt = e >> 3, i = e & 7;
                            const float invf = (i == 0) ? 1.0f : (i == 1) ? 0.1939227432012558f : (i == 2) ? 0.03760603070259094f : (i == 3) ? 0.007292664609849453f : (i == 4) ? 0.0014142135623842478f : (i == 5) ? 0.00027424818836152554f : (i == 6) ? 5.318296098266728e-05f : 1.0313386155758053e-05f;
                            const float ang = (float)tt * invf; const double rev = (double)ang * 0.15915494309189535; const float fr = (float)(rev - __builtin_rint(rev));
                            rt[tt * 16 + i] = __builtin_amdgcn_cosf(fr); rt[tt * 16 + 8 + i] = __builtin_amdgcn_sinf(fr); }
                    }
                }
                for (int m = gw; m < M; m += NGW) rms_row_bf16(xsrc + (size_t)m * D, norm_mix + layer * D, (bf16_t*)(ws + A_HN) + (size_t)m * D, (layer == 0) ? xres + (size_t)m * D : nullptr, lane);
            }
        }
        GSYNC();
        if (!is_rwkv) {
            bf16_t* HN = (bf16_t*)(ws + A_HN); bf16_t* Qb = (bf16_t*)(ws + A_Q); bf16_t* KFb = (bf16_t*)(ws + A_KF); bf16_t* VFb = (bf16_t*)(ws + A_VF);
            float* GT = (float*)(ws + A_GATES); bf16_t* CHK = (bf16_t*)(ws + A_CHK); bf16_t* CHV = (bf16_t*)(ws + A_CHV); bf16_t* KCb = (bf16_t*)(ws + A_KC); bf16_t* VCb = (bf16_t*)(ws + A_VC);
            {
                pg8::Gemm g{HN, (const bf16_t*)(ws + WS_W + W_NSA_IN), M, 2304, D, D, D, 0};
                pg8::StaticOrder so; so.init(M, 2304, G, (int)blockIdx.x);
                pg8::EpiP<FNsaIn> E{FNsaIn{Qb, KFb, GT, (const float*)(ws + WS_ROPE)}};
                pg8::gemm_phase<pg8::EpiP<FNsaIn>, true>(lds, g, so, E, tidv);
                pg8::Gemm g2{(const bf16_t*)(ws + WS_W + W_NSA_V), HN, 512, M, D, D, D, 0};
                pg8::StaticOrder so2; so2.init(512, M, G, (int)blockIdx.x);
                pg8::EpiP<FNsaVT> E2{FNsaVT{VFb}};
                pg8::gemm_phase<pg8::EpiP<FNsaVT>, true>(lds, g2, so2, E2, tidv);
            }
            GSYNC();
            {
                pg8::StaticOrder so; so.init(8192, 256, G, (int)blockIdx.x);
                pg8::StaticOrder sov; sov.init(8192, 256, G, (int)((blockIdx.x + G - G / 2) % G));
                { pg8::Gemm g{KFb, (const bf16_t*)(ws + WS_W + W_C1K), 8192, 256, 2048, 1024, 2048, 0}; pg8::EpiP<FCmp1> E{FCmp1{CHK, (const float*)(ws + WS_W + W_CBIAS)}}; pg8::gemm_phase<pg8::EpiP<FCmp1>, true>(lds, g, so, E, tidv); }
                { pg8::Gemm g{KFb + 3 * KF_STRIDE, (const bf16_t*)(ws + WS_W + W_C1V), 8192, 256, 2048, 1024, 2048, 0}; pg8::EpiP<FCmp1> E{FCmp1{CHV, (const float*)(ws + WS_W + W_CBIAS) + 256}}; pg8::gemm_phase<pg8::EpiP<FCmp1>, true>(lds, g, sov, E, tidv); }
            }
            asm volatile("s_waitcnt vmcnt(0)" ::: "memory"); __syncthreads();
            {
                { pg8::StaticOrder so; so.init(8192, 256, G, (int)blockIdx.x); pg8::Gemm g{CHK, (const bf16_t*)(ws + WS_W + W_C2K), 8192, 256, 256, 256, 256, 0}; pg8::EpiP<FCmp2K> E{FCmp2K{KCb}}; pg8::gemm_phase<pg8::EpiP<FCmp2K>, true>(lds, g, so, E, tidv); }
                { pg8::StaticOrder so; so.init(256, 8192, G, (int)((blockIdx.x + G - G / 2) % G)); pg8::Gemm g{(const bf16_t*)(ws + WS_W + W_C2V), CHV, 256, 8192, 256, 256, 256, 0}; pg8::EpiP<FCmp2VT> E{FCmp2VT{VCb}}; pg8::gemm_phase<pg8::EpiP<FCmp2VT>, true>(lds, g, so, E, tidv); }
            }
            GSYNC();
            nsa_attention(Qb, KFb, VFb, KCb, VCb, GT, HN, lds, G, wave, lane_id());
            tidv = wave * 64 + (lane_id() & 63); asm volatile("" : "+v"(tidv)); tidv &= 511; lane = tidv & 63;
            GSYNC();
            {
                pg8::StaticOrder so; so.init(M, D, G, (int)blockIdx.x);
                pg8::Gemm g{HN, (const bf16_t*)(ws + WS_W + W_NSA_O), M, D, D, D, D, 0}; pg8::EpiN<FResAdd> E{FResAdd{xres}}; pg8::gemm_phase<pg8::EpiN<FResAdd>, true>(lds, g, so, E, tidv);
            }
            GSYNC();
        }
        if (is_rwkv) {
            h16* Rb = (h16*)(ws + A_R); h16* Kb = (h16*)(ws + A_K); h16* Ab = (h16*)(ws + A_A); h16* EWb = (h16*)(ws + A_HN);
            h16* Vb = (lj == 0) ? (h16*)(ws + WS_VF) : (h16*)(ws + A_V2);
            h16* Yraw = (lj == 0) ? (h16*)(ws + A_V2) : (h16*)(ws + WS_VF);
            bf16_t* LH = (bf16_t*)(ws + A_LH);
            {
                pg8::Gemm g{(const bf16_t*)(ws + A_HN), (const bf16_t*)(ws + WS_W + W_RW_IN), M, 3840, 2048, D, 2048, 1};
                pg8::StaticOrder so; so.init(M, 3840, G, (int)blockIdx.x);
                pg8::EpiP<FRwIn> E{FRwIn{Rb, Kb, Vb, LH}};
                pg8::gemm_phase<pg8::EpiP<FRwIn>, true>(lds, g, so, E, tidv);
            }
            GSYNC();
            {
                pg8::StaticOrder so; so.init(M, D, G, (int)blockIdx.x);
                { pg8::Gemm g{LH, (const bf16_t*)(ws + WS_W + W_RW_W2), M, D, 128, 768, 128, 0}; pg8::EpiP<FLoraW> E{FLoraW{EWb, P.in[16] + lj * D}}; pg8::gemm_phase<pg8::EpiP<FLoraW>, true>(lds, g, so, E, tidv); }
                { pg8::Gemm g{LH + 128, (const bf16_t*)(ws + WS_W + W_RW_A2), M, D, 128, 768, 128, 0}; pg8::EpiP<FLoraA> E{FLoraA{Ab, P.in[19] + lj * D}}; pg8::gemm_phase<pg8::EpiP<FLoraA>, true>(lds, g, so, E, tidv); }
                if (lj >= 1) { pg8::Gemm g{LH + 512, (const bf16_t*)(ws + WS_W + W_RW_V2), M, D, 128, 768, 128, 0}; pg8::EpiP<FLoraV> E{FLoraV{Vb, (const h16*)(ws + WS_VF), P.in[30]}}; pg8::gemm_phase<pg8::EpiP<FLoraV>, true>(lds, g, so, E, tidv); }
            }
            GSYNC();
            rwkv_scan2(Rb, Kb, Vb, EWb, Ab, P.in[24] + lj * D, P.in[25] + lj * D, Yraw, lds, wave, lane);
            GSYNC();
            rwkv_gn(Rb, Kb, Vb, Ab, Yraw, P.in[25] + lj * D, P.in[26] + lj * D, P.in[27] + lj * D, P.in[28] + lj * D, gw, NGW, lane);
            GSYNC();
            {
                pg8::StaticOrder so; so.init(M, D, G, (int)blockIdx.x);
                pg8::Gemm g{LH + 256, (const bf16_t*)(ws + WS_W + W_RW_G2), M, D, 256, 768, 256, 0}; pg8::EpiP<FGate> E{FGate{(bf16_t*)Kb, Rb}}; pg8::gemm_phase<pg8::EpiP<FGate>, true>(lds, g, so, E, tidv);
            }
            GSYNC();
            {
                pg8::StaticOrder so; so.init(M, D, G, (int)blockIdx.x);
                pg8::Gemm g{(const bf16_t*)Kb, (const bf16_t*)(ws + WS_W + W_RW_O), M, D, D, D, D, 0}; pg8::EpiN<FResAdd> E{FResAdd{xres}}; pg8::gemm_phase<pg8::EpiN<FResAdd>, true>(lds, g, so, E, tidv);
            }
            GSYNC();
        }
        for (int m = gw; m < M; m += NGW) rms_row_bf16(xres + (size_t)m * D, norm_mlp + layer * D, (bf16_t*)(ws + A_HN) + (size_t)m * D, nullptr, lane);
        GSYNC();
        {
            pg8::Gemm g{(const bf16_t*)(ws + A_HN), (const bf16_t*)(ws + WS_W + W_MLP1), M, FF, D, D, D, 0};
            pg8::StaticOrder so; so.init(M, FF, G, (int)blockIdx.x);
            pg8::EpiP<FRelu2> E{FRelu2{(bf16_t*)(ws + A_HID)}};
            pg8::gemm_phase<pg8::EpiP<FRelu2>, true>(lds, g, so, E, tidv);
        }
        GSYNC();
        {
            pg8::Gemm g{(const bf16_t*)(ws + A_HID), (const bf16_t*)(ws + WS_W + W_MLP2), M, D, FF, FF, FF, 0};
            pg8::StaticOrder so; so.init(M, D, G, (int)blockIdx.x);
            pg8::EpiN<FResAdd> E{FResAdd{xres}};
            pg8::gemm_phase<pg8::EpiN<FResAdd>, true>(lds, g, so, E, tidv);
        }
        GSYNC();
    }
    for (int m = gw_k; m < M; m += NGW) {
        int lane2 = tidv; asm volatile("" : "+v"(lane2)); lane2 &= 63;
        f32x4* xr = (f32x4*)(xres + (size_t)m * D) + lane2; const f32x4* gr = (const f32x4*)norm_final + lane2;
        f32x4 v[4]; float s = 0.f;
#pragma unroll
        for (int j = 0; j < 4; ++j) { v[j] = xr[64 * j]; s += (v[j].x * v[j].x + v[j].y * v[j].y) + (v[j].z * v[j].z + v[j].w * v[j].w); }
        const float r = rsqrtf(wave_sum(s) * (1.f / D) + 1e-5f);
#pragma unroll
        for (int j = 0; j < 4; ++j) { const f32x4 gg = gr[64 * j]; xr[64 * j] = v[j] * r * gg; }
    }
}

extern "C" void kernel_launch(void* const* d_in, const int* in_sizes, int n_in, void* d_out, int out_size, void* d_ws, size_t ws_size, hipStream_t stream) {
    static int grid = 0;
    if (grid == 0) {
        if (n_in != 33 || out_size != M * D || ws_size < WS_NEED) { fprintf(stderr, "kernel_launch: unexpected sizes n_in %d out %d ws %zu (need %zu)\n", n_in, out_size, ws_size, (size_t)WS_NEED); grid = -1; return; }
        int dev = 0, cus = 0, per_cu = 0;
        hipGetDevice(&dev);
        hipDeviceGetAttribute(&cus, hipDeviceAttributeMultiprocessorCount, dev);
        if (hipFuncSetAttribute((const void*)fwd_kernel, hipFuncAttributeMaxDynamicSharedMemorySize, LDS_BYTES) != hipSuccess) { fprintf(stderr, "hipFuncSetAttribute failed\n"); grid = -1; return; }
        hipOccupancyMaxActiveBlocksPerMultiprocessor(&per_cu, (const void*)fwd_kernel, NTHREADS, LDS_BYTES);
        if (per_cu < 1) { fprintf(stderr, "occupancy query returned %d\n", per_cu); per_cu = 1; }
        (void)hipGetLastError();
        grid = cus * 1;
    }
    if (grid < 0) return;
    if (hipMemsetAsync((char*)d_ws + WS_BAR, 0, 16384, stream) != hipSuccess) { fprintf(stderr, "hipMemsetAsync of the barrier words failed\n"); return; }
    Params p{};
    for (int i = 0; i < 33; ++i) p.in[i] = (const float*)d_in[i];
    p.out = (float*)d_out; p.ws = (unsigned char*)d_ws;
    void* args[] = {&p};
    hipError_t e = hipLaunchCooperativeKernel((const void*)fwd_kernel, dim3(grid), dim3(NTHREADS), args, LDS_BYTES, stream);
    if (e != hipSuccess) fprintf(stderr, "cooperative launch failed: %s (grid %d)\n", hipGetErrorString(e), grid);
}
```

```cpp
#include <hip/hip_runtime.h>
#include <hip/hip_cooperative_groups.h>
#include <cstdio>
#include <cstdint>
namespace cg = cooperative_groups;

#define LAS __attribute__((address_space(3)))
typedef unsigned short bf16_t;
typedef short bf16x8 __attribute__((ext_vector_type(8)));
typedef float f32x4 __attribute__((ext_vector_type(4)));
typedef float f32x2 __attribute__((ext_vector_type(2)));
typedef unsigned u32x4 __attribute__((ext_vector_type(4)));
typedef unsigned u32x2 __attribute__((ext_vector_type(2)));
typedef _Float16 h16;
typedef _Float16 h16x2 __attribute__((ext_vector_type(2)));

constexpr int S = 16384, NB = 2, M = NB * S, D = 1024, FF = 4096;
constexpr int NWAVES = 8, NTHREADS = 512;
constexpr int LDS_BYTES = 147456 + 64;
constexpr size_t MiB = 1u << 20;
constexpr size_t WS_W = 0;
constexpr size_t W_MLP1 = 0, W_MLP2 = 8 * MiB;
constexpr size_t W_NSA_IN = 16 * MiB, W_NSA_V = 21 * MiB, W_NSA_O = 22 * MiB, W_C1K = 24 * MiB, W_C1V = 25 * MiB, W_C2K = 26 * MiB, W_C2V = 26 * MiB + 256 * 1024, W_CBIAS = 26 * MiB + 512 * 1024;
constexpr size_t W_RW_IN = 16 * MiB, W_RW_W2 = 31 * MiB, W_RW_A2 = 31 * MiB + 256 * 1024, W_RW_V2 = 31 * MiB + 512 * 1024, W_RW_G2 = 31 * MiB + 768 * 1024, W_RW_O = 33 * MiB;
constexpr size_t WS_ROPE = 36 * MiB;
constexpr size_t WS_BAR = 38 * MiB;
constexpr size_t WS_VF = 40 * MiB;
constexpr size_t ACT = 104 * MiB;
constexpr size_t A_HN = ACT;
constexpr size_t A_Q = ACT + 65 * MiB;
constexpr size_t A_KF = ACT + 129 * MiB;
constexpr size_t A_VF = ACT + 194 * MiB;
constexpr size_t A_GATES = ACT + 226 * MiB;
constexpr size_t A_CHK = ACT + 233 * MiB, A_CHV = ACT + 237 * MiB, A_KC = ACT + 241 * MiB, A_VC = ACT + 242 * MiB;
constexpr size_t A_HID = ACT + 65 * MiB;
constexpr size_t A_R = ACT + 65 * MiB, A_K = ACT + 129 * MiB, A_V2 = ACT + 193 * MiB, A_A = ACT + 257 * MiB, A_LH = ACT + 321 * MiB;
constexpr size_t WS_NEED = ACT + 370 * MiB;

__device__ __forceinline__ int lane_id() { return (int)__builtin_amdgcn_mbcnt_hi(~0u, __builtin_amdgcn_mbcnt_lo(~0u, 0u)); }
__device__ __forceinline__ unsigned cvt_pk_bf16(float lo, float hi) { unsigned r; asm volatile("v_cvt_pk_bf16_f32 %0, %1, %2" : "=v"(r) : "v"(lo), "v"(hi)); return r; }
__device__ __forceinline__ unsigned pk_h16(float lo, float hi) { h16x2 v; v.x = (h16)lo; v.y = (h16)hi; return __builtin_bit_cast(unsigned, v); }
__device__ __forceinline__ float bf2f(bf16_t b) { return __uint_as_float(((unsigned)b) << 16); }
__device__ __forceinline__ float wave_sum(float v) {
#pragma unroll
    for (int o = 1; o < 64; o <<= 1) v += __shfl_xor(v, o);
    return v;
}
__device__ __forceinline__ float sigmoidf_(float x) { return 1.0f / (1.0f + __expf(-x)); }
__device__ __forceinline__ float tanhf_(float x) { float e = __expf(-2.0f * fabsf(x)); float t = (1.0f - e) / (1.0f + e); return x < 0.f ? -t : t; }

namespace pg8 {
constexpr int BM = 256, BK = 64, HALF = 128, HTB = HALF * BK * 2, STAGE_BYTES = 8 * HTB, NXCD = 8, WGM = 8;
__host__ __device__ __forceinline__ int lds_byte(int r, int c) { const int st = (r >> 4) * 2 + (c >> 5), rr = r & 15, cc = c & 31, ob = rr * 64 + cc * 2; return st * 1024 + (ob ^ (((ob >> 9) & 1) << 5)); }
__host__ __device__ __forceinline__ void stage_rc(int b, int& R, int& C) { const int st = b / 1024, sb = b % 1024, swz = sb ^ (((sb >> 9) & 1) << 5); R = (st >> 1) * 16 + swz / 64; C = (st & 1) * 32 + (swz % 64) / 2; }
__host__ __device__ __forceinline__ int perm32(int rho) { const int n = rho >> 4, i = rho & 15; return 8 * (i >> 2) + 4 * n + (i & 3); }
struct Unit { int pm, pn; };
struct Gemm { const bf16_t* A; const bf16_t* Bt; int M, N, K, lda, ldb, amode; };
struct StaticOrder {
    int nM, nN, nwg, G, c;
    __device__ void init(int M_, int N_, int G_, int c_) { nM = M_ / BM; nN = N_ / BM; nwg = nM * nN; G = G_; c = c_; }
    __device__ bool next(int i, Unit& u) const {
        const long L = (long)i * G + c; if (L >= nwg) return false;
        int wgid = (int)L; { const int q = nwg / NXCD, r = nwg % NXCD, xcd = wgid % NXCD, off = wgid / NXCD; wgid = (xcd < r ? xcd * (q + 1) : r * (q + 1) + (xcd - r) * q) + off; }
        const int nig = WGM * nN, gid = wgid / nig, fm = gid * WGM, gsz = (nM - fm) < WGM ? (nM - fm) : WGM;
        u.pm = fm + ((wgid % nig) % gsz); u.pn = (wgid % nig) / gsz; return true;
    }
};
__device__ __forceinline__ const char* a_base(const Gemm& g, int pm) { const size_t row = (size_t)pm * BM + (g.amode == 1 ? (size_t)(pm / 64) : 0); return (const char*)g.A + row * (size_t)g.lda * 2; }

template <class Epi, bool ALIGN_EPI>
__device__ __forceinline__ void gemm_phase(LAS unsigned char* lds, const Gemm g, const StaticOrder& S, const Epi& E, int tid_in) {
    int tid = tid_in; asm volatile("" : "+v"(tid));
    const int wid = __builtin_amdgcn_readfirstlane(tid >> 6), lane = tid & 63, wr = wid >> 2, wc = wid & 3, fr = lane & 15, fq = lane >> 4;
    int K = g.K; asm volatile("" : "+s"(K));
    const int nt = K / BK;
    unsigned voffA[2], voffB[2];
#pragma unroll
    for (int i = 0; i < 2; ++i) { int R, C; stage_rc(tid * 16 + i * 8192, R, C); const int Rb = Epi::PERM ? ((R & ~31) + perm32(R & 31)) : R;
        voffA[i] = (unsigned)(R * g.lda + C) * 2u; voffB[i] = (unsigned)(Rb * g.ldb + C) * 2u; }
    const size_t kstep = (size_t)(BK * 2);
    const size_t hstepA = (size_t)HALF * g.lda * 2, hstepB = (size_t)HALF * g.ldb * 2;
    const size_t tstepB = 2 * hstepB;
    const unsigned ldsw = (unsigned)wid * 1024u;
    const int aoff = lds_byte(wr * 64 + fr, fq * 8), boff = lds_byte(wc * 32 + fr, fq * 8);
#define PG8_SA(b, h) (((b) * 2 + (h)) * HTB)
#define PG8_SB(b, h) ((4 + (b) * 2 + (h)) * HTB)
#define PG8_STAGE(bufoff, gbase, voff) do { _Pragma("unroll") for (int _i = 0; _i < 2; ++_i) \
        __builtin_amdgcn_global_load_lds((const unsigned*)((const char*)(gbase) + (voff)[_i]), (LAS unsigned*)(lds + (bufoff) + ldsw + _i * 8192), 16, 0, 0); } while (0)
#define PG8_LDA(dst, b, h) do { _Pragma("unroll") for (int m = 0; m < 4; ++m) _Pragma("unroll") for (int k = 0; k < 2; ++k) dst[m][k] = *(const LAS bf16x8*)(lds + PG8_SA(b, h) + aoff + m * 2048 + k * 1024); } while (0)
#define PG8_LDB(dst, b, h) do { _Pragma("unroll") for (int n = 0; n < 2; ++n) _Pragma("unroll") for (int k = 0; k < 2; ++k) dst[n][k] = *(const LAS bf16x8*)(lds + PG8_SB(b, h) + boff + n * 2048 + k * 1024); } while (0)
#define PG8_MMA(ai, bj, At, Bt) do { __builtin_amdgcn_s_setprio(1); _Pragma("unroll") for (int m = 0; m < 4; ++m) _Pragma("unroll") for (int n = 0; n < 2; ++n) _Pragma("unroll") for (int k = 0; k < 2; ++k) \
        acc[ai][bj][m][n] = __builtin_amdgcn_mfma_f32_16x16x32_bf16(Bt[n][k], At[m][k], acc[ai][bj][m][n], 0, 0, 0); __builtin_amdgcn_s_setprio(0); } while (0)
#define PG8_WAIT_V(n) asm volatile("s_waitcnt vmcnt(" #n ")" ::: "memory")
#define PG8_WAIT_L(n) asm volatile("s_waitcnt lgkmcnt(" #n ")" ::: "memory")
#define PG8_BAR __builtin_amdgcn_s_barrier()
#define PG8_SCHED __builtin_amdgcn_sched_barrier(0)
    Unit cur, nxt; int ui = 0;
    if (!S.next(0, cur)) return;
    f32x4 acc[2][2][4][2];
#pragma unroll
    for (int a = 0; a < 2; ++a)
#pragma unroll
        for (int b = 0; b < 2; ++b)
#pragma unroll
            for (int m = 0; m < 4; ++m)
#pragma unroll
                for (int n = 0; n < 2; ++n) acc[a][b][m][n] = (f32x4){0.f, 0.f, 0.f, 0.f};
    bf16x8 At[4][2], B0[2][2], B1[2][2];
    const char* cA = a_base(g, cur.pm); const char* cB = (const char*)g.Bt + (size_t)cur.pn * tstepB;
    PG8_STAGE(PG8_SB(0, 0), cB, voffB); PG8_STAGE(PG8_SB(0, 1), cB + hstepB, voffB); PG8_STAGE(PG8_SA(0, 0), cA, voffA); PG8_STAGE(PG8_SA(0, 1), cA + hstepA, voffA);
    if (wr == 1) PG8_BAR;
    PG8_WAIT_V(2); PG8_BAR;
    PG8_STAGE(PG8_SB(1, 0), cB + kstep, voffB); PG8_STAGE(PG8_SA(1, 0), cA + kstep, voffA); PG8_STAGE(PG8_SB(1, 1), cB + hstepB + kstep, voffB);
    PG8_WAIT_V(6); PG8_BAR;
    for (;;) {
        const bool has_next = S.next(ui + 1, nxt);
        const char* nA = has_next ? a_base(g, nxt.pm) : cA; const char* nB = has_next ? (const char*)g.Bt + (size_t)nxt.pn * tstepB : cB;
        for (int t = 0; t < nt; t += 2) {
            const bool last = (t == nt - 2);
            const char* a1 = cA + (size_t)(t + 1) * kstep;
            const char* a2 = last ? nA : cA + (size_t)(t + 2) * kstep; const char* b2 = last ? nB : cB + (size_t)(t + 2) * kstep;
            const char* a3 = a2 + kstep; const char* b3 = b2 + kstep;
            PG8_LDB(B0, 0, 0); PG8_LDB(B1, 0, 1); PG8_SCHED; PG8_LDA(At, 0, 0); PG8_STAGE(PG8_SA(1, 1), a1 + hstepA, voffA);
            PG8_WAIT_V(8); PG8_WAIT_L(0); PG8_BAR; PG8_MMA(0, 0, At, B0); PG8_MMA(0, 1, At, B1); PG8_BAR; PG8_SCHED;
            PG8_LDA(At, 0, 1); PG8_STAGE(PG8_SB(0, 0), b2, voffB); PG8_STAGE(PG8_SB(0, 1), b2 + hstepB, voffB); PG8_STAGE(PG8_SA(0, 0), a2, voffA);
            PG8_WAIT_V(8); PG8_WAIT_L(0); PG8_BAR; PG8_MMA(1, 0, At, B0); PG8_MMA(1, 1, At, B1); PG8_BAR; PG8_SCHED;
            PG8_LDB(B0, 1, 0); PG8_LDB(B1, 1, 1); PG8_SCHED; PG8_LDA(At, 1, 0); PG8_STAGE(PG8_SA(0, 1), a2 + hstepA, voffA);
            PG8_WAIT_V(8); PG8_WAIT_L(0); PG8_BAR; PG8_MMA(0, 0, At, B0); PG8_MMA(0, 1, At, B1); PG8_BAR; PG8_SCHED;
            PG8_LDA(At, 1, 1); PG8_STAGE(PG8_SB(1, 0), b3, voffB); PG8_STAGE(PG8_SB(1, 1), b3 + hstepB, voffB); PG8_STAGE(PG8_SA(1, 0), a3, voffA);
            PG8_WAIT_V(8); PG8_WAIT_L(0); PG8_BAR; PG8_MMA(1, 0, At, B0); PG8_MMA(1, 1, At, B1); PG8_BAR; PG8_SCHED;
        }
        if constexpr (ALIGN_EPI) { if (wr == 0) PG8_BAR; }
        E(acc, cur, wr, wc, fr, fq);
        if (!has_next) break;
#pragma unroll
        for (int a = 0; a < 2; ++a)
#pragma unroll
            for (int b = 0; b < 2; ++b)
#pragma unroll
                for (int m = 0; m < 4; ++m)
#pragma unroll
                    for (int n = 0; n < 2; ++n) acc[a][b][m][n] = (f32x4){0.f, 0.f, 0.f, 0.f};
        cur = nxt; cA = nA; cB = nB; ++ui;
        if constexpr (ALIGN_EPI) { if (wr == 1) PG8_BAR; }
    }
    PG8_WAIT_V(0);
    if constexpr (!ALIGN_EPI) { if (wr == 0) PG8_BAR; }
    PG8_BAR;
#undef PG8_SA
#undef PG8_SB
#undef PG8_STAGE
#undef PG8_LDA
#undef PG8_LDB
#undef PG8_MMA
#undef PG8_WAIT_V
#undef PG8_WAIT_L
#undef PG8_BAR
#undef PG8_SCHED
}
template <class F> struct EpiP {
    static constexpr bool PERM = true; F f;
    __device__ __forceinline__ void operator()(const f32x4 (&acc)[2][2][4][2], const Unit& u, int wr, int wc, int fr, int fq) const {
#pragma unroll
        for (int ai = 0; ai < 2; ++ai)
#pragma unroll
            for (int m = 0; m < 4; ++m) { int row = u.pm * BM + ai * HALF + wr * 64 + m * 16 + fr; asm volatile("" : "+v"(row));
#pragma unroll
                for (int bj = 0; bj < 2; ++bj) { const int col0 = u.pn * BM + bj * HALF + wc * 32 + 8 * fq; f(row, col0, acc[ai][bj][m][0], acc[ai][bj][m][1]); } asm volatile("" ::: "memory"); }
    }
};
template <class F> struct EpiN {
    static constexpr bool PERM = false; F f;
    __device__ __forceinline__ void operator()(const f32x4 (&acc)[2][2][4][2], const Unit& u, int wr, int wc, int fr, int fq) const {
#pragma unroll
        for (int ai = 0; ai < 2; ++ai)
#pragma unroll
            for (int m = 0; m < 4; ++m) { int row = u.pm * BM + ai * HALF + wr * 64 + m * 16 + fr; asm volatile("" : "+v"(row));
#pragma unroll
                for (int bj = 0; bj < 2; ++bj)
#pragma unroll
                    for (int n = 0; n < 2; ++n) { const int col0 = u.pn * BM + bj * HALF + wc * 32 + 16 * n + 4 * fq; f(row, col0, acc[ai][bj][m][n]); } asm volatile("" ::: "memory"); }
    }
};
}

struct Params {
    const float* in[33];
    float* out;
    unsigned char* ws;
};

struct TJob { const float* W; int ldw, n0src, Nsrc, Ksrc; bf16_t* WT; int ldt, row_off, col_off, Npad, Kpad; const float* mix; int mode; };
__device__ __forceinline__ void transpose_job(const TJob& j, LAS float* scr, int gw, int NGW, int lane_) {
    int lane = lane_; asm volatile("" : "+v"(lane));
    const int nblk = j.Npad / 32, kblk = j.Kpad / 64, items = nblk * kblk;
    for (int it = gw; it < items; it += NGW) {
        const int kb = it / nblk, nb = it % nblk, k0 = 64 * kb, n0 = 32 * nb;
#pragma unroll 4
        for (int i = 0; i < 32; ++i) { const int kk = 2 * i + (lane >> 5), n = lane & 31; float v = 0.f;
            if (k0 + kk < j.Ksrc && n0 + n < j.Nsrc) { v = j.W[(size_t)(k0 + kk) * j.ldw + j.n0src + n0 + n];
                if (j.mode == 1) v *= j.mix[k0 + kk]; else if (j.mode == 2) v *= (1.0f - j.mix[k0 + kk]); }
            scr[kk * 33 + n] = v; }
        asm volatile("s_waitcnt lgkmcnt(0)" ::: "memory");
        const int c = lane & 7;
#pragma unroll
        for (int jj = 0; jj < 4; ++jj) { const int n = (lane >> 3) + 8 * jj; const LAS float* s = scr + (8 * c) * 33 + n;
            u32x4 o; o.x = cvt_pk_bf16(s[0 * 33], s[1 * 33]); o.y = cvt_pk_bf16(s[2 * 33], s[3 * 33]); o.z = cvt_pk_bf16(s[4 * 33], s[5 * 33]); o.w = cvt_pk_bf16(s[6 * 33], s[7 * 33]);
            *(u32x4*)(j.WT + (size_t)(j.row_off + n0 + n) * j.ldt + j.col_off + k0 + 8 * c) = o; }
        asm volatile("s_waitcnt lgkmcnt(0)" ::: "memory");
    }
}

__device__ __forceinline__ void rms_row_bf16(const float* xrow, const float* g, bf16_t* orow, float* copy_to, int lane_) {
    int lane = lane_; asm volatile("" : "+v"(lane));
    const f32x4* xr = (const f32x4*)xrow + lane; const f32x4* gr = (const f32x4*)g + lane;
    f32x4 v[4]; float s = 0.f;
#pragma unroll
    for (int j = 0; j < 4; ++j) { v[j] = xr[64 * j]; s += (v[j].x * v[j].x + v[j].y * v[j].y) + (v[j].z * v[j].z + v[j].w * v[j].w); }
    if (copy_to) {
#pragma unroll
        for (int j = 0; j < 4; ++j) ((f32x4*)copy_to + lane)[64 * j] = v[j];
    }
    const float r = rsqrtf(wave_sum(s) * (1.f / D) + 1e-5f);
    u32x2* o8 = (u32x2*)orow + lane;
#pragma unroll
    for (int j = 0; j < 4; ++j) { const f32x4 gg = gr[64 * j]; u32x2 w; w.x = cvt_pk_bf16(v[j].x * r * gg.x, v[j].y * r * gg.y); w.y = cvt_pk_bf16(v[j].z * r * gg.z, v[j].w * r * gg.w); o8[64 * j] = w; }
}

struct FRelu2 { bf16_t* O; __device__ __forceinline__ void operator()(int row, int col0, f32x4 a, f32x4 b) const {
    f32x4 x = a, y = b;
#pragma unroll
    for (int i = 0; i < 4; ++i) { float t = fmaxf(x[i], 0.f); x[i] = t * t; t = fmaxf(y[i], 0.f); y[i] = t * t; }
    u32x4 w; w.x = cvt_pk_bf16(x[0], x[1]); w.y = cvt_pk_bf16(x[2], x[3]); w.z = cvt_pk_bf16(y[0], y[1]); w.w = cvt_pk_bf16(y[2], y[3]);
    __builtin_nontemporal_store(w, (u32x4*)(O + (size_t)row * FF + col0)); } };
struct FResAdd { float* X; __device__ __forceinline__ void operator()(int row, int col0, f32x4 a) const {
    f32x4* p = (f32x4*)(X + (size_t)row * D + col0); *p = *p + a; } };


struct FRwIn { h16* R; h16* Kk; h16* V; bf16_t* LH;
    __device__ __forceinline__ void operator()(int row, int col0, f32x4 a, f32x4 b) const {
        const int seg = __builtin_amdgcn_readfirstlane(col0 >> 10);
        if (seg < 3) { const long dK = (const char*)Kk - (const char*)R, dV = (const char*)V - (const char*)R; const long off = (seg == 1 ? dK : 0l) + (seg == 2 ? dV : 0l); h16* dst = (h16*)((char*)R + off); const int c = col0 & 1023;
            u32x4 w; w.x = pk_h16(a[0], a[1]); w.y = pk_h16(a[2], a[3]); w.z = pk_h16(b[0], b[1]); w.w = pk_h16(b[2], b[3]);
            *(u32x4*)(dst + (size_t)row * D + c) = w; }
        else { const int c = col0 - 3072; f32x4 x = a, y = b;
            if (c < 128) {
#pragma unroll
                for (int i = 0; i < 4; ++i) { x[i] = tanhf_(x[i]); y[i] = tanhf_(y[i]); } }
            else if (c >= 256 && c < 512) {
#pragma unroll
                for (int i = 0; i < 4; ++i) { x[i] = sigmoidf_(x[i]); y[i] = sigmoidf_(y[i]); } }
            u32x4 w; w.x = cvt_pk_bf16(x[0], x[1]); w.y = cvt_pk_bf16(x[2], x[3]); w.z = cvt_pk_bf16(y[0], y[1]); w.w = cvt_pk_bf16(y[2], y[3]);
            *(u32x4*)(LH + (size_t)row * 768 + c) = w; }
    } };
struct FLoraW { h16* EW; const float* w0;
    __device__ __forceinline__ void operator()(int row, int col0, f32x4 a, f32x4 b) const {
        const f32x4 p = *(const f32x4*)(w0 + col0), q = *(const f32x4*)(w0 + col0 + 4); float o[8];
#pragma unroll
        for (int i = 0; i < 4; ++i) { o[i] = 0.60653066f * sigmoidf_(p[i] + a[i]); o[4 + i] = 0.60653066f * sigmoidf_(q[i] + b[i]); }
        u32x4 w; w.x = pk_h16(o[0], o[1]); w.y = pk_h16(o[2], o[3]); w.z = pk_h16(o[4], o[5]); w.w = pk_h16(o[6], o[7]);
        *(u32x4*)(EW + (size_t)row * D + col0) = w; } };
struct FLoraA { h16* Aa; const float* a0;
    __device__ __forceinline__ void operator()(int row, int col0, f32x4 a, f32x4 b) const {
        const f32x4 p = *(const f32x4*)(a0 + col0), q = *(const f32x4*)(a0 + col0 + 4); float o[8];
#pragma unroll
        for (int i = 0; i < 4; ++i) { o[i] = sigmoidf_(p[i] + a[i]); o[4 + i] = sigmoidf_(q[i] + b[i]); }
        u32x4 w; w.x = pk_h16(o[0], o[1]); w.y = pk_h16(o[2], o[3]); w.z = pk_h16(o[4], o[5]); w.w = pk_h16(o[6], o[7]);
        *(u32x4*)(Aa + (size_t)row * D + col0) = w; } };
struct FLoraV { h16* V; const h16* VFm; const float* v0;
    __device__ __forceinline__ void operator()(int row, int col0, f32x4 a, f32x4 b) const {
        const f32x4 p = *(const f32x4*)(v0 + col0), q = *(const f32x4*)(v0 + col0 + 4);
        typedef h16 h16x8 __attribute__((ext_vector_type(8)));
        const h16x8 vv = *(const h16x8*)(V + (size_t)row * D + col0), vf = *(const h16x8*)(VFm + (size_t)row * D + col0); float o[8];
#pragma unroll
        for (int i = 0; i < 4; ++i) { float v = (float)vv[i], f = (float)vf[i]; o[i] = v + (f - v) * sigmoidf_(p[i] + a[i]); v = (float)vv[4 + i]; f = (float)vf[4 + i]; o[4 + i] = v + (f - v) * sigmoidf_(q[i] + b[i]); }
        u32x4 w; w.x = pk_h16(o[0], o[1]); w.y = pk_h16(o[2], o[3]); w.z = pk_h16(o[4], o[5]); w.w = pk_h16(o[6], o[7]);
        *(u32x4*)(V + (size_t)row * D + col0) = w; } };
struct FGate { bf16_t* O; const h16* Y;
    __device__ __forceinline__ void operator()(int row, int col0, f32x4 a, f32x4 b) const {
        typedef h16 h16x8 __attribute__((ext_vector_type(8)));
        const h16x8 yy = *(const h16x8*)(Y + (size_t)row * D + col0);
        u32x4 w; w.x = cvt_pk_bf16(a[0] * (float)yy[0], a[1] * (float)yy[1]); w.y = cvt_pk_bf16(a[2] * (float)yy[2], a[3] * (float)yy[3]);
        w.z = cvt_pk_bf16(b[0] * (float)yy[4], b[1] * (float)yy[5]); w.w = cvt_pk_bf16(b[2] * (float)yy[6], b[3] * (float)yy[7]);
        *(u32x4*)(O + (size_t)row * D + col0) = w; } };

template <int CTRL> __device__ __forceinline__ float dppmov(float v) { return __builtin_bit_cast(float, __builtin_amdgcn_update_dpp(0, __builtin_bit_cast(int, v), CTRL, 0xF, 0xF, true)); }
__device__ __forceinline__ float row16_sum(float v) { v += dppmov<0xB1>(v); v += dppmov<0x4E>(v); v += dppmov<0x124>(v); v += dppmov<0x128>(v); return v; }
typedef _Float16 h16x4 __attribute__((ext_vector_type(4)));
__device__ __forceinline__ void h4_to_f(h16x4 u, float* f) { f[0] = (float)u[0]; f[1] = (float)u[1]; f[2] = (float)u[2]; f[3] = (float)u[3]; }
__device__ __forceinline__ void rwkv_scan(const h16* R, const h16* Kk, const h16* V, const h16* EW, const h16* Aa, const float* k_k, const float* k_a, h16* Yraw, int G, int wave, int lane_) {
    int lane = lane_; asm volatile("" : "+v"(lane));
    const int NT = G * NWAVES;
    for (int task = wave * G + (int)blockIdx.x; task < 512; task += NT) {
        const int bh = task >> 4, rg = task & 15, b = bh >> 4, h = bh & 15;
        const int row = lane >> 4, jg = lane & 15, i = rg * 4 + row;
        const int colj = h * 64 + 4 * jg, coli = h * 64 + i;
        float kkc[4], kac[4];
#pragma unroll
        for (int j = 0; j < 4; ++j) { kkc[j] = k_k[colj + j]; kac[j] = k_a[colj + j]; }
        float s[4] = {0.f, 0.f, 0.f, 0.f};
        const size_t base = (size_t)b * S * D;
        const h16* pR = R + base + colj; const h16* pK = Kk + base + colj; const h16* pA = Aa + base + colj; const h16* pE = EW + base + colj; const h16* pV = V + base + coli;
        h16* pY = Yraw + ((size_t)task * S) * 4 + row;
        constexpr int TC = 4;
        h16x4 cr[TC], ck[TC], ca[TC], ce[TC]; h16 cv[TC];
#pragma unroll
        for (int u = 0; u < TC; ++u) { const size_t o = (size_t)u * D; cr[u] = *(const h16x4*)(pR + o); ck[u] = *(const h16x4*)(pK + o); ca[u] = *(const h16x4*)(pA + o); ce[u] = *(const h16x4*)(pE + o); cv[u] = pV[o]; }
        for (int t0 = 0; t0 < S; t0 += TC) {
            const int tn = (t0 + TC < S) ? t0 + TC : t0;
            h16x4 nr[TC], nk[TC], na[TC], ne[TC]; h16 nv[TC];
#pragma unroll
            for (int u = 0; u < TC; ++u) { const size_t o = (size_t)(tn + u) * D; nr[u] = *(const h16x4*)(pR + o); nk[u] = *(const h16x4*)(pK + o); na[u] = *(const h16x4*)(pA + o); ne[u] = *(const h16x4*)(pE + o); nv[u] = pV[o]; }
#pragma unroll
            for (int u = 0; u < TC; ++u) {
                float rv[4], kv[4], av[4], ev[4]; h4_to_f(cr[u], rv); h4_to_f(ck[u], kv); h4_to_f(ca[u], av); h4_to_f(ce[u], ev);
                const float vi = (float)cv[u];
                float kq[4], n2 = 0.f;
#pragma unroll
                for (int j = 0; j < 4; ++j) { kq[j] = kv[j] * kkc[j]; n2 += kq[j] * kq[j]; }
                n2 = row16_sum(n2);
                const float inv = 1.0f / fmaxf(sqrtf(n2), 1e-12f);
                float kkj[4], kt[4], bb[4], w[4], dot = 0.f;
#pragma unroll
                for (int j = 0; j < 4; ++j) { kkj[j] = kq[j] * inv; kt[j] = kv[j] * (1.0f + (av[j] - 1.0f) * kac[j]); bb[j] = kkj[j] * av[j]; w[j] = __expf(-ev[j]); dot += s[j] * kkj[j]; }
                const float sa = -row16_sum(dot);
                float yd = 0.f;
#pragma unroll
                for (int j = 0; j < 4; ++j) { s[j] = s[j] * w[j] + (sa * bb[j] + vi * kt[j]); yd += s[j] * rv[j]; }
                const float y = row16_sum(yd);
                if (jg == 0) pY[(size_t)(t0 + u) * 4] = (h16)y;
            }
#pragma unroll
            for (int u = 0; u < TC; ++u) { cr[u] = nr[u]; ck[u] = nk[u]; ca[u] = na[u]; ce[u] = ne[u]; cv[u] = nv[u]; }
        }
    }
}
constexpr int SC_CS = 32, SC_STEP_F = 5 * 64 + 8, SC_BUF_F = SC_CS * SC_STEP_F;
#define SC_BAR() do { asm volatile("s_waitcnt lgkmcnt(0)" ::: "memory"); __builtin_amdgcn_s_barrier(); asm volatile("" ::: "memory"); } while (0)
__device__ __forceinline__ float wave_sum_dpp(float v) {
    v = row16_sum(v);
    const float a = __builtin_bit_cast(float, __builtin_amdgcn_readlane(__builtin_bit_cast(int, v), 0)), b = __builtin_bit_cast(float, __builtin_amdgcn_readlane(__builtin_bit_cast(int, v), 16));
    const float c = __builtin_bit_cast(float, __builtin_amdgcn_readlane(__builtin_bit_cast(int, v), 32)), d = __builtin_bit_cast(float, __builtin_amdgcn_readlane(__builtin_bit_cast(int, v), 48));
    return (a + b) + (c + d);
}
struct ScRegs { h16 k[8], a[8], e[8], r[8], v[8]; };
__device__ __forceinline__ void sc_load(ScRegs& g, const h16* R, const h16* Kk, const h16* V, const h16* EW, const h16* Aa, size_t base, int c, int pw, int sub, int lane) {
#pragma unroll
    for (int q = 0; q < 8; ++q) { const size_t o = base + (size_t)(c * SC_CS + pw + 4 * q) * D;
        g.k[q] = Kk[o + lane]; g.a[q] = Aa[o + lane]; g.e[q] = EW[o + lane]; g.r[q] = R[o + lane]; g.v[q] = V[o + sub * 8 + (lane & 7)]; }
}
__device__ __forceinline__ void sc_compute(const ScRegs& g, LAS float* sb, int pw, float kkc, float kac, int lane) {
#pragma unroll
    for (int q = 0; q < 8; ++q) {
        const float kv = (float)g.k[q], av = (float)g.a[q], ev = (float)g.e[q], rv = (float)g.r[q]; const float kq = kv * kkc;
        const float n2 = wave_sum_dpp(kq * kq);
        const float kkj = kq * rsqrtf(fmaxf(n2, 1e-24f)); LAS float* p = sb + (pw + 4 * q) * SC_STEP_F;
        p[lane] = kkj; p[64 + lane] = kkj * av; p[128 + lane] = kv * (1.0f + (av - 1.0f) * kac); p[192 + lane] = __expf(-ev); p[256 + lane] = rv; if (lane < 8) p[320 + lane] = (float)g.v[q];
    }
}
__device__ __forceinline__ void rwkv_scan2(const h16* R, const h16* Kk, const h16* V, const h16* EW, const h16* Aa, const float* k_k, const float* k_a, h16* Yraw, LAS unsigned char* lds, int wave, int lane_) {
    int lane = lane_; asm volatile("" : "+v"(lane));
    LAS float* buf = (LAS float*)lds;
    constexpr int NCH = S / SC_CS;
#pragma unroll 1
    for (int vb = (int)blockIdx.x; vb < 256; vb += (int)gridDim.x) {
        const int bh = vb >> 3, sub = vb & 7, b = bh >> 4, h = bh & 15;
        const size_t base = (size_t)b * S * D + h * 64;
        if (wave >= 4) {
            const int pw = wave - 4;
            const float kkc = k_k[h * 64 + lane], kac = k_a[h * 64 + lane];
            ScRegs ga, gb;
            sc_load(ga, R, Kk, V, EW, Aa, base, 0, pw, sub, lane);
            sc_load(gb, R, Kk, V, EW, Aa, base, 1, pw, sub, lane);
            sc_compute(ga, buf, pw, kkc, kac, lane);
            SC_BAR();
#pragma unroll 1
            for (int c = 0; c < NCH; c += 2) {
                { const int c2 = (c + 2 < NCH) ? c + 2 : c; sc_load(ga, R, Kk, V, EW, Aa, base, c2, pw, sub, lane); }
                sc_compute(gb, buf + SC_BUF_F, pw, kkc, kac, lane);
                SC_BAR();
                { const int c3 = (c + 3 < NCH) ? c + 3 : c + 1; sc_load(gb, R, Kk, V, EW, Aa, base, c3, pw, sub, lane); }
                if (c + 2 < NCH) sc_compute(ga, buf, pw, kkc, kac, lane);
                SC_BAR();
            }
            SC_BAR();
        } else if (wave < 2) {
            const int jg = lane & 15, cw = wave;
            f32x2 sA = {0.f, 0.f}, sB = {0.f, 0.f};
#define SC_LO(v) __builtin_shufflevector(v, v, 0, 1)
#define SC_HI(v) __builtin_shufflevector(v, v, 2, 3)
            SC_BAR();
#pragma unroll 1
            for (int c = 0; c < NCH; ++c) {
                const LAS float* sb = buf + (c & 1) * SC_BUF_F + 4 * jg;
                const LAS float* vb_ = buf + (c & 1) * SC_BUF_F + 320 + cw * 4 + (lane >> 4);
                LAS float* yp = buf + 2 * SC_BUF_F + ((c & 1) * 2 + cw) * (SC_CS * 64) + lane;
                f32x4 kk4 = *(const LAS f32x4*)(sb), bb4 = *(const LAS f32x4*)(sb + 64), kt4 = *(const LAS f32x4*)(sb + 128), w4 = *(const LAS f32x4*)(sb + 192), r4 = *(const LAS f32x4*)(sb + 256); float vi = vb_[0];
                f32x4 kk5 = *(const LAS f32x4*)(sb + SC_STEP_F), bb5 = *(const LAS f32x4*)(sb + SC_STEP_F + 64), kt5 = *(const LAS f32x4*)(sb + SC_STEP_F + 128), w5 = *(const LAS f32x4*)(sb + SC_STEP_F + 192), r5 = *(const LAS f32x4*)(sb + SC_STEP_F + 256); float vi5 = vb_[SC_STEP_F];
#pragma unroll
                for (int st = 0; st < SC_CS; ++st) {
                    const int sn = (st + 2 < SC_CS) ? st + 2 : SC_CS - 1;
                    const f32x4 nkk = *(const LAS f32x4*)(sb + sn * SC_STEP_F), nbb = *(const LAS f32x4*)(sb + sn * SC_STEP_F + 64), nkt = *(const LAS f32x4*)(sb + sn * SC_STEP_F + 128), nw = *(const LAS f32x4*)(sb + sn * SC_STEP_F + 192), nr4 = *(const LAS f32x4*)(sb + sn * SC_STEP_F + 256);
                    const float nvi = vb_[sn * SC_STEP_F];
                    f32x2 tt = sA * SC_LO(kk4); tt = sB * SC_HI(kk4) + tt;
                    const float sa = -row16_sum(tt.x + tt.y);
                    const f32x2 sa2 = {sa, sa}, vi2 = {vi, vi};
                    f32x2 uA = vi2 * SC_LO(kt4); uA = sa2 * SC_LO(bb4) + uA; sA = sA * SC_LO(w4) + uA;
                    f32x2 uB = vi2 * SC_HI(kt4); uB = sa2 * SC_HI(bb4) + uB; sB = sB * SC_HI(w4) + uB;
                    f32x2 yy = sA * SC_LO(r4); yy = sB * SC_HI(r4) + yy;
                    yp[st * 64] = yy.x + yy.y;
                    kk4 = kk5; bb4 = bb5; kt4 = kt5; w4 = w5; r4 = r5; vi = vi5;
                    kk5 = nkk; bb5 = nbb; kt5 = nkt; w5 = nw; r5 = nr4; vi5 = nvi;
                }
                SC_BAR();
            }
            SC_BAR();
        } else {
            const int cw = wave - 2;
            h16* pY = Yraw + ((size_t)(bh * 16 + sub * 2 + cw) * S) * 4;
            SC_BAR();
#pragma unroll 1
            for (int c = 0; c <= NCH; ++c) {
                if (c > 0) {
                    const LAS float* yp = buf + 2 * SC_BUF_F + (((c - 1) & 1) * 2 + cw) * (SC_CS * 64);
                    const int st = lane >> 1, r0 = 2 * (lane & 1);
                    float a0 = 0.f, a1 = 0.f;
#pragma unroll
                    for (int q = 0; q < 4; ++q) { const f32x4 x = *(const LAS f32x4*)(yp + st * 64 + r0 * 16 + 4 * q), z = *(const LAS f32x4*)(yp + st * 64 + (r0 + 1) * 16 + 4 * q);
                        a0 += (x[0] + x[1]) + (x[2] + x[3]); a1 += (z[0] + z[1]) + (z[2] + z[3]); }
                    *(unsigned*)(pY + (size_t)((c - 1) * SC_CS + st) * 4 + r0) = pk_h16(a0, a1);
                }
                SC_BAR();
            }
        }
        if (false) {
            SC_BAR();
#pragma unroll 1
            for (int c = 0; c < NCH; ++c) SC_BAR();
        }
    }
}
__device__ __forceinline__ void rwkv_gn(h16* R, const h16* Kk, const h16* V, const h16* Aa, const h16* Yraw, const float* k_a, const float* r_k, const float* ln_w, const float* ln_b, int gw, int NGW, int lane_) {
    int lane = lane_; asm volatile("" : "+v"(lane));
    const int hq = lane >> 4, c4 = 4 * (lane & 15);
#pragma unroll 2
    for (int idx = gw; idx < M * 4; idx += NGW) {
        const int m = idx >> 2, h = (idx & 3) * 4 + hq, col = h * 64 + c4; const size_t o = (size_t)m * D + col;
        const int bq = m / S, tq = m - bq * S;
        float y[4], r[4], k[4], a[4], v[4];
        h4_to_f(*(const h16x4*)(Yraw + ((size_t)((bq * 16 + h) * 16 + (lane & 15)) * S + tq) * 4), y);
        h4_to_f(*(const h16x4*)(R + o), r); h4_to_f(*(const h16x4*)(Kk + o), k); h4_to_f(*(const h16x4*)(Aa + o), a); h4_to_f(*(const h16x4*)(V + o), v);
        const f32x4 ka4 = *(const f32x4*)(k_a + col), rk4 = *(const f32x4*)(r_k + col), lw4 = *(const f32x4*)(ln_w + col), lb4 = *(const f32x4*)(ln_b + col);
        const float mu = row16_sum((y[0] + y[1]) + (y[2] + y[3])) * (1.f / 64.f);
        float d[4], q = 0.f, bsp = 0.f;
#pragma unroll
        for (int i = 0; i < 4; ++i) { d[i] = y[i] - mu; q += d[i] * d[i]; const float kt = k[i] * (1.0f + (a[i] - 1.0f) * ka4[i]); bsp += r[i] * kt * rk4[i]; }
        const float rstd = rsqrtf(row16_sum(q) * (1.f / 64.f) + 64e-5f), bs = row16_sum(bsp);
        h16x4 outv;
#pragma unroll
        for (int i = 0; i < 4; ++i) outv[i] = (h16)(d[i] * rstd * lw4[i] + lb4[i] + bs * v[i]);
        *(h16x4*)(R + o) = outv;
    }
}

constexpr size_t KF_STRIDE = (size_t)NB * 4 * S * 64;
__device__ __forceinline__ float gelu_tanh(float x) { const float u = 0.7978845608f * (x + 0.044715f * x * x * x); return 0.5f * x * (1.0f + tanhf_(u)); }
__device__ __forceinline__ void store_vf8(bf16_t* chunk_base_d, int keyp0  , f32x4 a, f32x4 b) {
    const int tile = keyp0 >> 4, rq0 = (keyp0 & 15) >> 2;
    u32x2 w0, w1; w0.x = cvt_pk_bf16(a[0], a[1]); w0.y = cvt_pk_bf16(a[2], a[3]); w1.x = cvt_pk_bf16(b[0], b[1]); w1.y = cvt_pk_bf16(b[2], b[3]);
    *(u32x2*)(chunk_base_d + 8 * rq0 + 4 * tile) = w0; *(u32x2*)(chunk_base_d + 8 * (rq0 + 1) + 4 * tile) = w1;
}
struct FNsaIn { bf16_t* Q; bf16_t* KF; float* gates; const float* rope;
    __device__ __forceinline__ void operator()(int row, int col0, f32x4 a, f32x4 b) const {
        const int tile = __builtin_amdgcn_readfirstlane(col0 >> 8);
        const int bb = row / S, t = row - bb * S;
        if (tile < 7) {
            f32x4 x = a, y = b;
            if ((col0 & 32) == 0) {
                f32x4 px, py;
#pragma unroll
                for (int i = 0; i < 4; ++i) { px[i] = __shfl_xor(x[i], 16); py[i] = __shfl_xor(y[i], 16); }
                const int d0 = col0 & 63;
                if (d0 < 16) { const f32x4 c0 = *(const f32x4*)(rope + t * 16), c1 = *(const f32x4*)(rope + t * 16 + 4), s0 = *(const f32x4*)(rope + t * 16 + 8), s1 = *(const f32x4*)(rope + t * 16 + 12);
                    if (d0 == 0) { x = x * c0 - px * s0; y = y * c1 - py * s1; } else { x = x * c0 + px * s0; y = y * c1 + py * s1; } }
            }
            if (tile < 4) { x = x * 0.18033688011112042f; y = y * 0.18033688011112042f;
                u32x4 w; w.x = cvt_pk_bf16(x[0], x[1]); w.y = cvt_pk_bf16(x[2], x[3]); w.z = cvt_pk_bf16(y[0], y[1]); w.w = cvt_pk_bf16(y[2], y[3]);
                *(u32x4*)(Q + (size_t)row * D + col0) = w; }
            else { const int idx = tile - 4, g = (col0 & 255) >> 6, d0 = col0 & 63;
                u32x4 w; w.x = cvt_pk_bf16(x[0], x[1]); w.y = cvt_pk_bf16(x[2], x[3]); w.z = cvt_pk_bf16(y[0], y[1]); w.w = cvt_pk_bf16(y[2], y[3]);
                *(u32x4*)(KF + (size_t)idx * KF_STRIDE + ((size_t)(bb * 4 + g) * S + t) * 64 + d0) = w; }
        } else if (tile == 7) { const int g = (col0 & 255) >> 6, d0 = col0 & 63;
            u32x4 w; w.x = cvt_pk_bf16(a[0], a[1]); w.y = cvt_pk_bf16(a[2], a[3]); w.z = cvt_pk_bf16(b[0], b[1]); w.w = cvt_pk_bf16(b[2], b[3]);
            *(u32x4*)(KF + (size_t)3 * KF_STRIDE + ((size_t)(bb * 4 + g) * S + t) * 64 + d0) = w;
        } else { const int c = col0 - 2048;
            if (c < 48) { f32x4 x, y;
#pragma unroll
                for (int i = 0; i < 4; ++i) { x[i] = sigmoidf_(a[i]); y[i] = sigmoidf_(b[i]); }
                *(f32x4*)(gates + (size_t)row * 48 + c) = x; *(f32x4*)(gates + (size_t)row * 48 + c + 4) = y; }
        }
    } };
struct FNsaVT { bf16_t* VF;
    __device__ __forceinline__ void operator()(int row, int col0, f32x4 a, f32x4 b) const {
        const int br = row >> 8, g = (row >> 6) & 3, d = row & 63, bb = col0 / S, t0 = col0 - bb * S;
        bf16_t* base = VF + (size_t)br * KF_STRIDE + (size_t)(bb * 4 + g) * S * 64 + (size_t)(t0 >> 5) * 2048 + d * 32;
        store_vf8(base, t0 & 31, a, b); } };
struct FCmp1 { bf16_t* CH; const float* bias;
    __device__ __forceinline__ void operator()(int row, int col0, f32x4 a, f32x4 b) const {
        const f32x4 p = *(const f32x4*)(bias + col0), q = *(const f32x4*)(bias + col0 + 4); float o[8];
#pragma unroll
        for (int i = 0; i < 4; ++i) { o[i] = gelu_tanh(a[i] + p[i]); o[4 + i] = gelu_tanh(b[i] + q[i]); }
        u32x4 w; w.x = cvt_pk_bf16(o[0], o[1]); w.y = cvt_pk_bf16(o[2], o[3]); w.z = cvt_pk_bf16(o[4], o[5]); w.w = cvt_pk_bf16(o[6], o[7]);
        *(u32x4*)(CH + (size_t)row * 256 + col0) = w; } };
struct FCmp2K { bf16_t* KC;
    __device__ __forceinline__ void operator()(int row, int col0, f32x4 a, f32x4 b) const {
        if (col0 < 64) { u32x4 w; w.x = cvt_pk_bf16(a[0], a[1]); w.y = cvt_pk_bf16(a[2], a[3]); w.z = cvt_pk_bf16(b[0], b[1]); w.w = cvt_pk_bf16(b[2], b[3]);
            *(u32x4*)(KC + (size_t)row * 64 + col0) = w; } } };
struct FCmp2VT { bf16_t* VC;
    __device__ __forceinline__ void operator()(int row, int col0, f32x4 a, f32x4 b) const {
        if (row < 64) { const int bg = col0 >> 10, n0 = col0 & 1023;
            bf16_t* base = VC + (size_t)bg * 65536 + (size_t)(n0 >> 5) * 2048 + row * 32; store_vf8(base, n0 & 31, a, b); } } };

__device__ __forceinline__ f32x4 mfma16(bf16x8 a, bf16x8 b, f32x4 c) { return __builtin_amdgcn_mfma_f32_16x16x32_bf16(a, b, c, 0, 0, 0); }
__device__ __forceinline__ bf16x8 ld8(const bf16_t* p) { return *(const bf16x8*)p; }
__device__ __forceinline__ bf16x8 pack8(f32x4 a, f32x4 b) { u32x4 w; w.x = cvt_pk_bf16(a[0], a[1]); w.y = cvt_pk_bf16(a[2], a[3]); w.z = cvt_pk_bf16(b[0], b[1]); w.w = cvt_pk_bf16(b[2], b[3]); return __builtin_bit_cast(bf16x8, w); }
__device__ __forceinline__ float colmax(float x) {
    const auto r = __builtin_amdgcn_permlane16_swap(__float_as_uint(x), __float_as_uint(x), false, false); x = fmaxf(__uint_as_float(r[0]), __uint_as_float(r[1]));
    const auto q = __builtin_amdgcn_permlane32_swap(__float_as_uint(x), __float_as_uint(x), false, false); return fmaxf(__uint_as_float(q[0]), __uint_as_float(q[1])); }
__device__ __forceinline__ float colsum(float x) {
    const auto r = __builtin_amdgcn_permlane16_swap(__float_as_uint(x), __float_as_uint(x), false, false); x = __uint_as_float(r[0]) + __uint_as_float(r[1]);
    const auto q = __builtin_amdgcn_permlane32_swap(__float_as_uint(x), __float_as_uint(x), false, false); return __uint_as_float(q[0]) + __uint_as_float(q[1]); }
template <int CTRL> __device__ __forceinline__ unsigned dppmov_u(unsigned v) { return (unsigned)__builtin_amdgcn_update_dpp(0, (int)v, CTRL, 0xF, 0xF, true); }
__device__ __forceinline__ unsigned wave_max_u32(unsigned v) {
    v = max(v, dppmov_u<0xB1>(v)); v = max(v, dppmov_u<0x4E>(v)); v = max(v, dppmov_u<0x124>(v)); v = max(v, dppmov_u<0x128>(v));
    const auto r = __builtin_amdgcn_permlane16_swap(v, v, false, false); v = max((unsigned)r[0], (unsigned)r[1]);
    const auto q = __builtin_amdgcn_permlane32_swap(v, v, false, false); return max((unsigned)q[0], (unsigned)q[1]); }
struct AttnState { float m, l; f32x4 o[4]; };
__device__ __forceinline__ void attn_init(AttnState& st) { st.m = -1e30f; st.l = 0.f;
#pragma unroll
    for (int d = 0; d < 4; ++d) st.o[d] = (f32x4){0.f, 0.f, 0.f, 0.f}; }
struct KVChunk { bf16x8 k[4]; bf16x8 v[4]; };
__device__ __forceinline__ void kv_load(KVChunk& B, const bf16_t* kptr, const bf16_t* vptr) {
#pragma unroll
    for (int tl = 0; tl < 2; ++tl) { B.k[tl * 2] = ld8(kptr + tl * 1024); B.k[tl * 2 + 1] = ld8(kptr + tl * 1024 + 32); }
#pragma unroll
    for (int d = 0; d < 4; ++d) B.v[d] = ld8(vptr + d * 512);
}
struct KRange { int klo, span; };
__device__ __forceinline__ KRange krange(int klo, int khi) { KRange r; if (khi < klo) { r.klo = 64; r.span = 0; } else { r.klo = klo; r.span = khi - klo; } return r; }
template <bool MASKED>
__device__ __forceinline__ void attn_chunk_r(AttnState& st, const bf16x8 (&kf)[4], const bf16x8 (&vf)[4], const bf16x8 q0, const bf16x8 q1, KRange kr) {
    f32x4 s[2];
#pragma unroll
    for (int tl = 0; tl < 2; ++tl) { s[tl] = mfma16(kf[tl * 2], q0, (f32x4){0.f, 0.f, 0.f, 0.f}); s[tl] = mfma16(kf[tl * 2 + 1], q1, s[tl]); }
    float mx = -1e30f;
#pragma unroll
    for (int tl = 0; tl < 2; ++tl)
#pragma unroll
        for (int i = 0; i < 4; ++i) { if (MASKED) { const bool v = (unsigned)(tl * 16 + i - kr.klo) <= (unsigned)kr.span; s[tl][i] = v ? s[tl][i] : -1e30f; } mx = fmaxf(mx, s[tl][i]); }
    mx = colmax(mx);
    if (__any(mx > st.m)) {
        const float mnew = fmaxf(st.m, mx), alpha = __builtin_amdgcn_exp2f(st.m - mnew);
        st.l *= alpha; st.m = mnew;
#pragma unroll
        for (int d = 0; d < 4; ++d) st.o[d] = st.o[d] * alpha;
    }
    const float mcur = st.m;
    f32x4 p[2]; float ps = 0.f;
#pragma unroll
    for (int tl = 0; tl < 2; ++tl)
#pragma unroll
        for (int i = 0; i < 4; ++i) { const float e = __builtin_amdgcn_exp2f(s[tl][i] - mcur); p[tl][i] = e; ps += e; }
    st.l += ps;
    const bf16x8 pb = pack8(p[0], p[1]);
#pragma unroll
    for (int d = 0; d < 4; ++d) st.o[d] = mfma16(vf[d], pb, st.o[d]);
}

#define ATT_STEPN(C, idx) do { _Pragma("unroll") for (int gg = 0; gg < NG; ++gg) { if (act(gg, idx)) { \
        if (ff(gg, idx)) attn_chunk_r<false>(gs[gg], C.k, C.v, gq[gg][0], gq[gg][1], KRange{0, 0}); else attn_chunk_r<true>(gs[gg], C.k, C.v, gq[gg][0], gq[gg][1], mf(gg, idx)); } \
        __builtin_amdgcn_sched_barrier(0); } } while (0)
template <int NG, class AddrK, class AddrV, class ActF, class FullF, class MaskF>
__device__ __forceinline__ void attn_chunksN(AttnState (&gs)[NG], const bf16x8 (&gq)[NG][2], int n, AddrK ak, AddrV av, ActF act, FullF ff, MaskF mf) {
    if constexpr (NG <= 2) {
        KVChunk C0, C1;
        if (n > 0) kv_load(C0, ak(0), av(0));
#pragma unroll 1
        for (int i = 0; i < n; i += 2) {
            if (i + 1 < n) kv_load(C1, ak(i + 1), av(i + 1));
            ATT_STEPN(C0, i);
            if (i + 1 < n) {
                if (i + 2 < n) kv_load(C0, ak(i + 2), av(i + 2));
                ATT_STEPN(C1, i + 1);
            }
        }
    } else {
#pragma unroll 1
        for (int i = 0; i < n; ++i) { KVChunk C0; kv_load(C0, ak(i), av(i)); ATT_STEPN(C0, i); }
    }
}

__device__ __forceinline__ void nsa_attention(const bf16_t* Q, const bf16_t* KF, const bf16_t* VF, const bf16_t* KC, const bf16_t* VC, const float* gates, bf16_t* OUT, LAS unsigned char* lds, int G, int wave, int lane_) {
    int lane0 = lane_; asm volatile("" : "+v"(lane0));
    LAS float* imp = (LAS float*)(lds + wave * 18432);
    LAS float* tl = imp;
    LAS int* sel = (LAS int*)(lds + wave * 18432 + 16384);
    LAS unsigned* smask32 = (LAS unsigned*)(lds + wave * 18432 + 16384 + 1088);
    LAS unsigned char* blist = (LAS unsigned char*)(lds + wave * 18432 + 16384 + 1088 + 512);
    const bool xcd_map = (G % 8) == 0;
    const int nslots = xcd_map ? (G >> 3) * NWAVES : G * NWAVES, slot = xcd_map ? ((int)blockIdx.x >> 3) * NWAVES + wave : (int)blockIdx.x * NWAVES + wave;
    const int ntask = xcd_map ? 1024 : 8192;
#pragma unroll 1
    for (int task = slot; task < ntask; task += nslots) {
        int lane = lane0; asm volatile("" : "+v"(lane)); lane &= 63;
        const int col = lane & 15, rq = lane >> 4;
        const int tilei = xcd_map ? task : (task >> 3), bg = xcd_map ? ((int)blockIdx.x & 7) : (task & 7), b = bg >> 2, g = bg & 3, t0 = tilei * 16, t = t0 + col;
        const size_t rowq = (size_t)b * S + t;
        const bf16_t* qrow = Q + rowq * D + (g * 4) * 64 + 8 * rq;
        const float* grow = gates + rowq * 48 + g * 12;
        const int cur_max = (t0 + 15) >> 6;
        int n_end = 4 * (cur_max + 1); if (n_end > 1024) n_end = 1024;
        const int nchunk_c = (n_end + 31) >> 5;
        const bf16_t* kc_l = KC + (size_t)bg * 65536 + (size_t)col * 64 + 8 * rq;
        const bf16_t* vc_l = VC + (size_t)bg * 65536 + (size_t)col * 32 + 8 * rq;
        {
        AttnState gs[4]; bf16x8 gq[4][2];
#pragma unroll
        for (int h = 0; h < 4; ++h) { gq[h][0] = ld8(qrow + h * 64); gq[h][1] = ld8(qrow + h * 64 + 32); attn_init(gs[h]); }
        attn_chunksN<4>(gs, gq, nchunk_c,
            [&](int ci) { return kc_l + (size_t)ci * 2048; }, [&](int ci) { return vc_l + (size_t)ci * 2048; },
            [&](int, int) { return true; },
            [&](int, int ci) { return 16 * (ci * 32 + 31) + 31 <= t0; },
            [&](int, int ci) { const int nhi = (t >= 31) ? ((t - 31) >> 4) : -1; return krange(0, nhi - ci * 32 - 4 * rq); });
        {
            float mc[4], lc[4];
#pragma unroll
            for (int h = 0; h < 4; ++h) { const float lt = colsum(gs[h].l); mc[h] = gs[h].m; lc[h] = (gs[h].m > -1e29f && lt > 0.f) ? 1.0f / lt : 0.f; }
            {
                float carry = 0.f;
#pragma unroll 1
                for (int kc = 0; kc < nchunk_c; ++kc) {
#pragma unroll
                    for (int tt = 0; tt < 2; ++tt) {
                        const bf16x8 k0 = ld8(kc_l + (size_t)kc * 2048 + tt * 1024), k1 = ld8(kc_l + (size_t)kc * 2048 + tt * 1024 + 32);
                        float own = 0.f, p3 = 0.f;
#pragma unroll
                        for (int h = 0; h < 4; ++h) {
                            f32x4 sc = mfma16(k0, gq[h][0], (f32x4){0.f, 0.f, 0.f, 0.f}); sc = mfma16(k1, gq[h][1], sc);
#pragma unroll
                            for (int i = 0; i < 4; ++i) { const int n = kc * 32 + tt * 16 + 4 * rq + i; const float p = (16 * n + 31 <= t) ? __builtin_amdgcn_exp2f(sc[i] - mc[h]) * lc[h] : 0.f; own += p; if (i == 3) p3 += p; }
                        }
                        const float up = __shfl(p3, (lane + 48) & 63);
                        const float add = (rq == 0) ? carry : up;
                        imp[col * 256 + kc * 8 + tt * 4 + rq] = own + add;
                        carry = __shfl(p3, col + 48);
                    }
                }
            }
#pragma unroll 1
            for (int c = 0; c < 16; ++c) {
                const int tc = t0 + c, cur = tc >> 6;
                if (cur < 16) { if (lane <= cur) sel[c * 17 + lane] = lane; if (lane == 0) sel[c * 17 + 16] = cur + 1; }
                else {
                    unsigned key[4];
#pragma unroll
                    for (int jx = 0; jx < 4; ++jx) { const int sb = lane + 64 * jx; const float v = imp[c * 256 + sb]; key[jx] = (sb >= 1 && sb <= cur - 2) ? ((__float_as_uint(v) & 0xFFFFFF00u) | (unsigned)(255 - sb)) : 0u; }
                    if (lane == 0) { sel[c * 17 + 0] = 0; sel[c * 17 + 1] = cur - 1; sel[c * 17 + 2] = cur; sel[c * 17 + 16] = 16; }
#pragma unroll 1
                    for (int r = 0; r < 13; ++r) {
                        unsigned best = max(max(key[0], key[1]), max(key[2], key[3]));
                        best = wave_max_u32(best);
                        if (lane == 0) sel[c * 17 + 3 + r] = 255 - (int)(best & 255u);
#pragma unroll
                        for (int jx = 0; jx < 4; ++jx) if (key[jx] == best) key[jx] = 0u;
                    }
                }
            }
#pragma unroll
            for (int h = 0; h < 4; ++h) { const float gc = grow[h * 3 + 0] * lc[h];
#pragma unroll
                for (int d = 0; d < 4; ++d)
#pragma unroll
                    for (int i = 0; i < 4; ++i) tl[(h * 16 + d * 4 + i) * 64 + lane] = gs[h].o[d][i] * gc; }
        }
        }
        {
            smask32[lane] = 0u; smask32[64 + lane] = 0u;
#pragma unroll
            for (int k4 = 0; k4 < 4; ++k4) { const int pp = lane + 64 * k4, c = pp >> 4, e = pp & 15; if (e < sel[c * 17 + 16]) { const int jb = sel[c * 17 + e]; atomicOr((unsigned*)(smask32 + (jb >> 1)), 1u << (c + 16 * (jb & 1))); } }
            const bf16_t* ks_b = KF + (size_t)1 * KF_STRIDE + (size_t)bg * S * 64 + (size_t)col * 64 + 8 * rq;
            const bf16_t* vs_b = VF + (size_t)bg * S * 64 + (size_t)col * 32 + 8 * rq;
            const int tokl = col >> 2, hd = col & 3;
            {
                int nblk = 0;
                LAS unsigned* bl32 = (LAS unsigned*)sel;
                unsigned mk4[4];
#pragma unroll
                for (int k4 = 0; k4 < 4; ++k4) { const int jb = lane + 64 * k4; mk4[k4] = (smask32[jb >> 1] >> (16 * (jb & 1))) & 0xFFFFu; }
#pragma unroll
                for (int k4 = 0; k4 < 4; ++k4) { const int jb = lane + 64 * k4; const unsigned mk = mk4[k4];
                    const unsigned long long bal = __ballot(mk != 0u); const int pos = nblk + __popcll(bal & ((1ull << lane) - 1ull)); if (mk != 0u) bl32[pos] = (unsigned)jb | (mk << 8); nblk += __popcll(bal); }
                AttnState hs[4]; bf16x8 hq[4][2];
#pragma unroll
                for (int cg = 0; cg < 4; ++cg) { const bf16_t* qp = Q + ((size_t)b * S + t0 + 4 * cg + tokl) * D + (g * 4 + hd) * 64 + 8 * rq; hq[cg][0] = ld8(qp); hq[cg][1] = ld8(qp + 32); attn_init(hs[cg]); }
                auto wrd_of = [&](int ci) { return (unsigned)__builtin_amdgcn_readfirstlane((int)bl32[ci >> 1]); };
                const int tb = t0;
                attn_chunksN<4>(hs, hq, nblk * 2,
                    [&](int ci) { return ks_b + (size_t)((int)(wrd_of(ci) & 255u) * 2 + (ci & 1)) * 2048; },
                    [&](int ci) { return vs_b + (size_t)((int)(wrd_of(ci) & 255u) * 2 + (ci & 1)) * 2048; },
                    [&](int cg, int ci) { return ((wrd_of(ci) >> (8 + 4 * cg)) & 15u) != 0u; },
                    [&](int cg, int ci) { const unsigned wd = wrd_of(ci); const int jb = (int)(wd & 255u); return ((wd >> (8 + 4 * cg)) & 15u) == 15u && jb * 64 + (ci & 1) * 32 + 31 <= tb + 4 * cg; },
                    [&](int cg, int ci) { const unsigned wd = wrd_of(ci); const int jb = (int)(wd & 255u); const unsigned mk = wd >> 8; const int tok = 4 * cg + tokl; const int kp0 = jb * 64 + (ci & 1) * 32 + 4 * rq;
                        return krange(0, ((mk >> tok) & 1u) ? (tb + tok - kp0) : -1); });
#pragma unroll
                for (int cg = 0; cg < 4; ++cg) { const int tok = 4 * cg + tokl;
                    const float lt = colsum(hs[cg].l); const float inv = (hs[cg].m > -1e29f && lt > 0.f) ? 1.0f / lt : 0.f;
                    const float gsv = gates[((size_t)b * S + t0 + tok) * 48 + g * 12 + hd * 3 + 1] * inv;
#pragma unroll
                    for (int d = 0; d < 4; ++d)
#pragma unroll
                        for (int i = 0; i < 4; ++i) tl[(hd * 16 + d * 4 + i) * 64 + tok + 16 * rq] += hs[cg].o[d][i] * gsv; }
            }
        }
        {
            int lo = t0 - 511; if (lo < 0) lo = 0; const int c0 = lo >> 5, c1 = (t0 + 15) >> 5;
            const bf16_t* kw_b = KF + (size_t)2 * KF_STRIDE + (size_t)bg * S * 64 + (size_t)col * 64 + 8 * rq;
            const bf16_t* vw_b = VF + (size_t)1 * KF_STRIDE + (size_t)bg * S * 64 + (size_t)col * 32 + 8 * rq;
            {
                AttnState gs[4]; bf16x8 gq[4][2];
#pragma unroll
                for (int h = 0; h < 4; ++h) { gq[h][0] = ld8(qrow + h * 64); gq[h][1] = ld8(qrow + h * 64 + 32); attn_init(gs[h]); }
                attn_chunksN<4>(gs, gq, c1 - c0 + 1,
                    [&](int ci) { return kw_b + (size_t)(c0 + ci) * 2048; }, [&](int ci) { return vw_b + (size_t)(c0 + ci) * 2048; },
                    [&](int, int) { return true; },
                    [&](int, int ci) { return (c0 + ci) * 32 + 31 <= t0 && (c0 + ci) * 32 + 512 > t0 + 15; },
                    [&](int, int ci) { const int cb = (c0 + ci) * 32 + 4 * rq; return krange(t - 511 - cb, t - cb); });
#pragma unroll
                for (int h = 0; h < 4; ++h) { const float lt = colsum(gs[h].l); const float inv = (gs[h].m > -1e29f && lt > 0.f) ? 1.0f / lt : 0.f; const float gwv = grow[h * 3 + 2] * inv;
#pragma unroll
                    for (int d = 0; d < 4; ++d)
#pragma unroll
                        for (int i = 0; i < 4; ++i) tl[(h * 16 + d * 4 + i) * 64 + lane] += gs[h].o[d][i] * gwv; }
            }
        }
#pragma unroll
        for (int h = 0; h < 4; ++h)
#pragma unroll
            for (int d = 0; d < 4; ++d) { float v4[4];
#pragma unroll
                for (int i = 0; i < 4; ++i) v4[i] = tl[(h * 16 + d * 4 + i) * 64 + lane];
                u32x2 w; w.x = cvt_pk_bf16(v4[0], v4[1]); w.y = cvt_pk_bf16(v4[2], v4[3]);
                *(u32x2*)(OUT + rowq * D + (g * 4 + h) * 64 + d * 16 + 4 * rq) = w; }
    }
}

#define XB_TMO      128
#define XB_XCNT(j)  (256  + 64 * (j))
#define XB_XSUB(j)  (1280 + 64 * (j))
#define XB_XGEN(j)  (2304 + 64 * (j))
#define XB_TOP      3328
#define XB_TOPGEN   3392
#define XCD_BAR_WORDS 3456
#define XB_SPIN_CAP (1u << 22)
__device__ __forceinline__ unsigned xb_ld(unsigned* p)              { return __hip_atomic_load(p, __ATOMIC_RELAXED, __HIP_MEMORY_SCOPE_AGENT); }
__device__ __forceinline__ unsigned xb_add(unsigned* p, unsigned v) { return __hip_atomic_fetch_add(p, v, __ATOMIC_RELAXED, __HIP_MEMORY_SCOPE_AGENT); }
__device__ __forceinline__ unsigned xb_xcc_id() { return (unsigned)__builtin_amdgcn_s_getreg((3 << 11) | 20) & 0xFu; }
#define XB_SPIN(cond, bar) do { unsigned _sp = 0; while (cond) { __builtin_amdgcn_s_sleep(1); \
    if ((++_sp & 255u) == 0u) { if (xb_ld(&(bar)[XB_TMO])) break; if (_sp > XB_SPIN_CAP) { atomicAdd(&(bar)[XB_TMO], 1u); break; } } } } while (0)
struct XcdBarrier { unsigned* bar; unsigned x; volatile LAS unsigned* st; };
__device__ __forceinline__ void xcd_barrier_complete(unsigned* bar, unsigned x, unsigned& nloc, unsigned& nx) {
    const unsigned Gn = gridDim.x * gridDim.y * gridDim.z;
    unsigned sum, cnt, mine, sp = 0u;
    for (;;) {
        sum = 0u; cnt = 0u; mine = 0u;
#pragma unroll
        for (unsigned j = 0; j < 16; ++j) { const unsigned c = xb_ld(&bar[XB_XCNT(j)]); sum += c; cnt += (c > 0u) ? 1u : 0u; mine = (j == x) ? c : mine; }
        if (sum == Gn) break;
        __builtin_amdgcn_s_sleep(1);
        if ((++sp & 255u) == 0u) { if (xb_ld(&bar[XB_TMO])) break; if (sp > XB_SPIN_CAP) { atomicAdd(&bar[XB_TMO], 1u); break; } }
    }
    nloc = mine > 0u ? mine : 1u; nx = cnt > 0u ? cnt : 1u;
}
__device__ __forceinline__ void xcd_barrier(const XcdBarrier& b, bool leader) {
    asm volatile("s_waitcnt vmcnt(0)" ::: "memory");
    __syncthreads();
    if (leader) {
        unsigned* bar = b.bar;
        __builtin_amdgcn_s_waitcnt(0);
        unsigned nloc = b.st[0], nx = b.st[1];
        if (nloc == 0u) { xcd_barrier_complete(bar, b.x, nloc, nx); b.st[0] = nloc; b.st[1] = nx; }
        const unsigned old = xb_add(&bar[XB_XSUB(b.x)], 1u);
        const unsigned gen = old / nloc;
        if (old + 1u == (gen + 1u) * nloc) {
            __builtin_amdgcn_fence(__ATOMIC_RELEASE, "agent");
            asm volatile("s_waitcnt vmcnt(0)" ::: "memory");
            const unsigned og = xb_add(&bar[XB_TOP], 1u);
            const unsigned tg = og / nx;
            if (og + 1u == (tg + 1u) * nx) xb_add(&bar[XB_TOPGEN], 1u);
            else XB_SPIN(xb_ld(&bar[XB_TOPGEN]) == tg, bar);
            __builtin_amdgcn_fence(__ATOMIC_ACQUIRE, "agent");
            xb_add(&bar[XB_XGEN(b.x)], 1u);
            asm volatile("s_waitcnt vmcnt(0)" ::: "memory");
        } else {
            XB_SPIN(xb_ld(&bar[XB_XGEN(b.x)]) == gen, bar);
            __builtin_amdgcn_fence(__ATOMIC_ACQUIRE, "agent");
            asm volatile("s_waitcnt vmcnt(0)" ::: "memory");
        }
    }
    __syncthreads();
}
#define GSYNC() xcd_barrier(xbar, wave == 0 && lane_id() == 0)

__global__ void __launch_bounds__(NTHREADS, 2) fwd_kernel(Params P) {
    extern __shared__ __attribute__((aligned(16))) unsigned char lds_raw[];
    LAS unsigned char* lds = (LAS unsigned char*)lds_raw;
    cg::grid_group grid = cg::this_grid();
    int tidv = threadIdx.x;
    const int wave = __builtin_amdgcn_readfirstlane(tidv >> 6);
    const int G = gridDim.x, gw_k = blockIdx.x * NWAVES + wave, NGW = G * NWAVES;
    unsigned char* ws = P.ws;
    float* xres = P.out;
    LAS float* scr = (LAS float*)(lds + wave * 16384);
    const float* x_in = P.in[0];
    const float* norm_mix = P.in[1]; const float* norm_mlp = P.in[2]; const float* norm_final = P.in[3];
    const float* mlp_w1 = P.in[4]; const float* mlp_w2 = P.in[5];

    XcdBarrier xbar; xbar.bar = (unsigned*)(ws + WS_BAR); xbar.x = xb_xcc_id(); xbar.st = (volatile LAS unsigned*)(lds + 147456);
    if (tidv < 2) xbar.st[tidv] = 0u;
    if (tidv == 0) (void)xb_add(&xbar.bar[XB_XCNT(xbar.x)], 1u);
    __syncthreads();
    grid.sync();
    for (int layer = 0; layer < 4; ++layer) {
        int lane = tidv; asm volatile("" : "+v"(lane)); lane &= 63;
        int gw = gw_k; asm volatile("" : "+s"(gw));
        const bool is_rwkv = (layer & 1) != 0; const int lj = layer >> 1;
        const float* xsrc = (layer == 0) ? x_in : xres;
        {
            TJob j1{mlp_w1 + (size_t)layer * D * FF, FF, 0, FF, D, (bf16_t*)(ws + WS_W + W_MLP1), D, 0, 0, FF, D, nullptr, 0};
            transpose_job(j1, scr, gw, NGW, lane);
            TJob j2{mlp_w2 + (size_t)layer * FF * D, D, 0, D, FF, (bf16_t*)(ws + WS_W + W_MLP2), FF, 0, 0, D, FF, nullptr, 0};
            transpose_job(j2, scr, gw, NGW, lane);
            if (is_rwkv) {
                const float* mix = P.in[14] + (size_t)lj * 6 * D;
                bf16_t* WrT = (bf16_t*)(ws + WS_W + W_RW_IN);
                const float* wrkv = P.in[15] + (size_t)lj * 3 * D * D;
                for (int part = 0; part < 8; ++part) {
                    const float* W; int ldw, Nsrc, mi, r0, Npad;
                    if (part == 0) { W = wrkv; ldw = D; Nsrc = D; mi = 0; r0 = 0; Npad = D; }
                    else if (part == 1) { W = wrkv + (size_t)D * D; ldw = D; Nsrc = D; mi = 2; r0 = 1024; Npad = D; }
                    else if (part == 2) { W = wrkv + (size_t)2 * D * D; ldw = D; Nsrc = D; mi = 3; r0 = 2048; Npad = D; }
                    else if (part == 3) { W = P.in[17] + (size_t)lj * D * 64; ldw = 64; Nsrc = 64; mi = 1; r0 = 3072; Npad = 128; }
                    else if (part == 4) { W = P.in[20] + (size_t)lj * D * 64; ldw = 64; Nsrc = 64; mi = 4; r0 = 3200; Npad = 128; }
                    else if (part == 5) { W = P.in[22] + (size_t)lj * D * 160; ldw = 160; Nsrc = 160; mi = 5; r0 = 3328; Npad = 256; }
                    else if (part == 6) { W = P.in[31]; ldw = 32; Nsrc = (lj >= 1) ? 32 : 0; mi = 3; r0 = 3584; Npad = 128; }
                    else { W = P.in[31]; ldw = 32; Nsrc = 0; mi = 3; r0 = 3712; Npad = 128; }
                    TJob ja{W, ldw, 0, Nsrc, D, WrT, 2048, r0, 0, Npad, D, mix + mi * D, 1};
                    transpose_job(ja, scr, gw, NGW, lane);
                    TJob jb{W, ldw, 0, Nsrc, D, WrT, 2048, r0, 1024, Npad, D, mix + mi * D, 2};
                    transpose_job(jb, scr, gw, NGW, lane);
                }
                TJob jw{P.in[18] + (size_t)lj * 64 * D, D, 0, D, 64, (bf16_t*)(ws + WS_W + W_RW_W2), 128, 0, 0, D, 128, nullptr, 0}; transpose_job(jw, scr, gw, NGW, lane);
                TJob jaa{P.in[21] + (size_t)lj * 64 * D, D, 0, D, 64, (bf16_t*)(ws + WS_W + W_RW_A2), 128, 0, 0, D, 128, nullptr, 0}; transpose_job(jaa, scr, gw, NGW, lane);
                TJob jv{P.in[32], D, 0, D, (lj >= 1) ? 32 : 0, (bf16_t*)(ws + WS_W + W_RW_V2), 128, 0, 0, D, 128, nullptr, 0}; transpose_job(jv, scr, gw, NGW, lane);
                TJob jg{P.in[23] + (size_t)lj * 160 * D, D, 0, D, 160, (bf16_t*)(ws + WS_W + W_RW_G2), 256, 0, 0, D, 256, nullptr, 0}; transpose_job(jg, scr, gw, NGW, lane);
                TJob jo{P.in[29] + (size_t)lj * D * D, D, 0, D, D, (bf16_t*)(ws + WS_W + W_RW_O), D, 0, 0, D, D, nullptr, 0}; transpose_job(jo, scr, gw, NGW, lane);
                bf16_t* HN = (bf16_t*)(ws + A_HN);
                if (gw < 2) { u32x4* z = (u32x4*)(HN + (size_t)gw * (S + 1) * D); unsigned zz; asm volatile("v_mov_b32 %0, 0" : "=v"(zz)); for (int q = lane; q < D / 8; q += 64) z[q] = (u32x4){zz, zz, zz, zz}; }
                for (int m = gw; m < M; m += NGW) { const int b = m / S; rms_row_bf16(xsrc + (size_t)m * D, norm_mix + layer * D, HN + ((size_t)m + b + 1) * D, nullptr, lane); }
            } else {
                const float* win = P.in[6] + (size_t)lj * D * 2608;
                bf16_t* WnT = (bf16_t*)(ws + WS_W + W_NSA_IN); bf16_t* WvT = (bf16_t*)(ws + WS_W + W_NSA_V);
                for (int part = 0; part < 8; ++part) {
                    int n0src, Nsrc, r0, Npad; bf16_t* WT = WnT;
                    if (part == 0) { n0src = 0; Nsrc = 1024; r0 = 0; Npad = 1024; }
                    else if (part == 1) { n0src = 1024; Nsrc = 256; r0 = 1024; Npad = 256; }
                    else if (part == 2) { n0src = 1024 + 512; Nsrc = 256; r0 = 1280; Npad = 256; }
                    else if (part == 3) { n0src = 1024 + 1024; Nsrc = 256; r0 = 1536; Npad = 256; }
                    else if (part == 4) { n0src = 1024 + 256; Nsrc = 256; r0 = 1792; Npad = 256; }
                    else if (part == 5) { n0src = 2560; Nsrc = 48; r0 = 2048; Npad = 256; }
                    else if (part == 6) { n0src = 1024 + 768; Nsrc = 256; r0 = 0; Npad = 256; WT = WvT; }
                    else { n0src = 1024 + 1280; Nsrc = 256; r0 = 256; Npad = 256; WT = WvT; }
                    TJob jn{win, 2608, n0src, Nsrc, D, WT, D, r0, 0, Npad, D, nullptr, 0}; transpose_job(jn, scr, gw, NGW, lane);
                }
                TJob jo{P.in[13] + (size_t)lj * D * D, D, 0, D, D, (bf16_t*)(ws + WS_W + W_NSA_O), D, 0, 0, D, D, nullptr, 0}; transpose_job(jo, scr, gw, NGW, lane);
                TJob jc1k{P.in[8] + (size_t)lj * 2048 * 256, 256, 0, 256, 2048, (bf16_t*)(ws + WS_W + W_C1K), 2048, 0, 0, 256, 2048, nullptr, 0}; transpose_job(jc1k, scr, gw, NGW, lane);
                TJob jc1v{P.in[11] + (size_t)lj * 2048 * 256, 256, 0, 256, 2048, (bf16_t*)(ws + WS_W + W_C1V), 2048, 0, 0, 256, 2048, nullptr, 0}; transpose_job(jc1v, scr, gw, NGW, lane);
                TJob jc2k{P.in[9] + (size_t)lj * 256 * 64, 64, 0, 64, 256, (bf16_t*)(ws + WS_W + W_C2K), 256, 0, 0, 256, 256, nullptr, 0}; transpose_job(jc2k, scr, gw, NGW, lane);
                TJob jc2v{P.in[12] + (size_t)lj * 256 * 64, 64, 0, 64, 256, (bf16_t*)(ws + WS_W + W_C2V), 256, 0, 0, 256, 256, nullptr, 0}; transpose_job(jc2v, scr, gw, NGW, lane);
                {
                    int ln = lane; asm volatile("" : "+v"(ln));
                    float* cb = (float*)(ws + WS_W + W_CBIAS);
#pragma unroll 1
                    for (int o = gw; o < 512; o += NGW) { const int isv = o >> 8, c = o & 255;
                        const float* pe = (isv ? P.in[10] : P.in[7]) + (size_t)lj * 2048; const float* w1 = (isv ? P.in[11] : P.in[8]) + (size_t)lj * 2048 * 256;
                        float acc = 0.f;
#pragma unroll 1
                        for (int k = ln; k < 2048; k += 64) acc += pe[k] * w1[(size_t)k * 256 + c];
                        acc = wave_sum(acc); if (ln == 0) cb[o] = acc; }
                    if (layer == 0) {
                        float* rt = (float*)(ws + WS_ROPE);
                        int tix = tidv; asm volatile("" : "+v"(tix)); const int gt = (int)blockIdx.x * NTHREADS + tix;
#pragma unroll 1
                        for (int e = gt; e < S * 8; e += G * NTHREADS) { const int tt = e >> 3, i = e & 7;
                            const float invf = (i == 0) ? 1.0f : (i == 1) ? 0.1939227432012558f : (i == 2) ? 0.03760603070259094f : (i == 3) ? 0.007292664609849453f : (i == 4) ? 0.0014142135623842478f : (i == 5) ? 0.00027424818836152554f : (i == 6) ? 5.318296098266728e-05f : 1.0313386155758053e-05f;
                            const float ang = (float)tt * invf; const double rev = (double)ang * 0.15915494309189535; const float fr = (float)(rev - __builtin_rint(rev));
                            rt[tt * 16 + i] = __builtin_amdgcn_cosf(fr); rt[tt * 16 + 8 + i] = __builtin_amdgcn_sinf(fr); }
                    }
                }
                for (int m = gw; m < M; m += NGW) rms_row_bf16(xsrc + (size_t)m * D, norm_mix + layer * D, (bf16_t*)(ws + A_HN) + (size_t)m * D, (layer == 0) ? xres + (size_t)m * D : nullptr, lane);
            }
        }
        GSYNC();
        if (!is_rwkv) {
            bf16_t* HN = (bf16_t*)(ws + A_HN); bf16_t* Qb = (bf16_t*)(ws + A_Q); bf16_t* KFb = (bf16_t*)(ws + A_KF); bf16_t* VFb = (bf16_t*)(ws + A_VF);
            float* GT = (float*)(ws + A_GATES); bf16_t* CHK = (bf16_t*)(ws + A_CHK); bf16_t* CHV = (bf16_t*)(ws + A_CHV); bf16_t* KCb = (bf16_t*)(ws + A_KC); bf16_t* VCb = (bf16_t*)(ws + A_VC);
            {
                pg8::Gemm g{HN, (const bf16_t*)(ws + WS_W + W_NSA_IN), M, 2304, D, D, D, 0};
                pg8::StaticOrder so; so.init(M, 2304, G, (int)blockIdx.x);
                pg8::EpiP<FNsaIn> E{FNsaIn{Qb, KFb, GT, (const float*)(ws + WS_ROPE)}};
                pg8::gemm_phase<pg8::EpiP<FNsaIn>, true>(lds, g, so, E, tidv);
                pg8::Gemm g2{(const bf16_t*)(ws + WS_W + W_NSA_V), HN, 512, M, D, D, D, 0};
                pg8::StaticOrder so2; so2.init(512, M, G, (int)blockIdx.x);
                pg8::EpiP<FNsaVT> E2{FNsaVT{VFb}};
                pg8::gemm_phase<pg8::EpiP<FNsaVT>, true>(lds, g2, so2, E2, tidv);
            }
            GSYNC();
            {
                pg8::StaticOrder so; so.init(8192, 256, G, (int)blockIdx.x);
                pg8::StaticOrder sov; sov.init(8192, 256, G, (int)((blockIdx.x + G - G / 2) % G));
                { pg8::Gemm g{KFb, (const bf16_t*)(ws + WS_W + W_C1K), 8192, 256, 2048, 1024, 2048, 0}; pg8::EpiP<FCmp1> E{FCmp1{CHK, (const float*)(ws + WS_W + W_CBIAS)}}; pg8::gemm_phase<pg8::EpiP<FCmp1>, true>(lds, g, so, E, tidv); }
                { pg8::Gemm g{KFb + 3 * KF_STRIDE, (const bf16_t*)(ws + WS_W + W_C1V), 8192, 256, 2048, 1024, 2048, 0}; pg8::EpiP<FCmp1> E{FCmp1{CHV, (const float*)(ws + WS_W + W_CBIAS) + 256}}; pg8::gemm_phase<pg8::EpiP<FCmp1>, true>(lds, g, sov, E, tidv); }
            }
            asm volatile("s_waitcnt vmcnt(0)" ::: "memory"); __syncthreads();
            {
                { pg8::StaticOrder so; so.init(8192, 256, G, (int)blockIdx.x); pg8::Gemm g{CHK, (const bf16_t*)(ws + WS_W + W_C2K), 8192, 256, 256, 256, 256, 0}; pg8::EpiP<FCmp2K> E{FCmp2K{KCb}}; pg8::gemm_phase<pg8::EpiP<FCmp2K>, true>(lds, g, so, E, tidv); }
                { pg8::StaticOrder so; so.init(256, 8192, G, (int)((blockIdx.x + G - G / 2) % G)); pg8::Gemm g{(const bf16_t*)(ws + WS_W + W_C2V), CHV, 256, 8192, 256, 256, 256, 0}; pg8::EpiP<FCmp2VT> E{FCmp2VT{VCb}}; pg8::gemm_phase<pg8::EpiP<FCmp2VT>, true>(lds, g, so, E, tidv); }
            }
            GSYNC();
            nsa_attention(Qb, KFb, VFb, KCb, VCb, GT, HN, lds, G, wave, lane_id());
            tidv = wave * 64 + (lane_id() & 63); asm volatile("" : "+v"(tidv)); tidv &= 511; lane = tidv & 63;
            GSYNC();
            {
                pg8::StaticOrder so; so.init(M, D, G, (int)blockIdx.x);
                pg8::Gemm g{HN, (const bf16_t*)(ws + WS_W + W_NSA_O), M, D, D, D, D, 0}; pg8::EpiN<FResAdd> E{FResAdd{xres}}; pg8::gemm_phase<pg8::EpiN<FResAdd>, true>(lds, g, so, E, tidv);
            }
            GSYNC();
        }
        if (is_rwkv) {
            h16* Rb = (h16*)(ws + A_R); h16* Kb = (h16*)(ws + A_K); h16* Ab = (h16*)(ws + A_A); h16* EWb = (h16*)(ws + A_HN);
            h16* Vb = (lj == 0) ? (h16*)(ws + WS_VF) : (h16*)(ws + A_V2);
            h16* Yraw = (lj == 0) ? (h16*)(ws + A_V2) : (h16*)(ws + WS_VF);
            bf16_t* LH = (bf16_t*)(ws + A_LH);
            {
                pg8::Gemm g{(const bf16_t*)(ws + A_HN), (const bf16_t*)(ws + WS_W + W_RW_IN), M, 3840, 2048, D, 2048, 1};
                pg8::StaticOrder so; so.init(M, 3840, G, (int)blockIdx.x);
                pg8::EpiP<FRwIn> E{FRwIn{Rb, Kb, Vb, LH}};
                pg8::gemm_phase<pg8::EpiP<FRwIn>, true>(lds, g, so, E, tidv);
            }
            GSYNC();
            {
                pg8::StaticOrder so; so.init(M, D, G, (int)blockIdx.x);
                { pg8::Gemm g{LH, (const bf16_t*)(ws + WS_W + W_RW_W2), M, D, 128, 768, 128, 0}; pg8::EpiP<FLoraW> E{FLoraW{EWb, P.in[16] + lj * D}}; pg8::gemm_phase<pg8::EpiP<FLoraW>, true>(lds, g, so, E, tidv); }
                { pg8::Gemm g{LH + 128, (const bf16_t*)(ws + WS_W + W_RW_A2), M, D, 128, 768, 128, 0}; pg8::EpiP<FLoraA> E{FLoraA{Ab, P.in[19] + lj * D}}; pg8::gemm_phase<pg8::EpiP<FLoraA>, true>(lds, g, so, E, tidv); }
                if (lj >= 1) { pg8::Gemm g{LH + 512, (const bf16_t*)(ws + WS_W + W_RW_V2), M, D, 128, 768, 128, 0}; pg8::EpiP<FLoraV> E{FLoraV{Vb, (const h16*)(ws + WS_VF), P.in[30]}}; pg8::gemm_phase<pg8::EpiP<FLoraV>, true>(lds, g, so, E, tidv); }
            }
            GSYNC();
            rwkv_scan2(Rb, Kb, Vb, EWb, Ab, P.in[24] + lj * D, P.in[25] + lj * D, Yraw, lds, wave, lane);
            GSYNC();
            rwkv_gn(Rb, Kb, Vb, Ab, Yraw, P.in[25] + lj * D, P.in[26] + lj * D, P.in[27] + lj * D, P.in[28] + lj * D, gw, NGW, lane);
            GSYNC();
            {
                pg8::StaticOrder so; so.init(M, D, G, (int)blockIdx.x);
                pg8::Gemm g{LH + 256, (const bf16_t*)(ws + WS_W + W_RW_G2), M, D, 256, 768, 256, 0}; pg8::EpiP<FGate> E{FGate{(bf16_t*)Kb, Rb}}; pg8::gemm_phase<pg8::EpiP<FGate>, true>(lds, g, so, E, tidv);
            }
            GSYNC();
            {
                pg8::StaticOrder so; so.init(M, D, G, (int)blockIdx.x);
                pg8::Gemm g{(const bf16_t*)Kb, (const bf16_t*)(ws + WS_W + W_RW_O), M, D, D, D, D, 0}; pg8::EpiN<FResAdd> E{FResAdd{xres}}; pg8::gemm_phase<pg8::EpiN<FResAdd>, true>(lds, g, so, E, tidv);
            }
            GSYNC();
        }
        for (int m = gw; m < M; m += NGW) rms_row_bf16(xres + (size_t)m * D, norm_mlp + layer * D, (bf16_t*)(ws + A_HN) + (size_t)m * D, nullptr, lane);
        GSYNC();
        {
            pg8::Gemm g{(const bf16_t*)(ws + A_HN), (const bf16_t*)(ws + WS_W + W_MLP1), M, FF, D, D, D, 0};
            pg8::StaticOrder so; so.init(M, FF, G, (int)blockIdx.x);
            pg8::EpiP<FRelu2> E{FRelu2{(bf16_t*)(ws + A_HID)}};
            pg8::gemm_phase<pg8::EpiP<FRelu2>, true>(lds, g, so, E, tidv);
        }
        GSYNC();
        {
            pg8::Gemm g{(const bf16_t*)(ws + A_HID), (const bf16_t*)(ws + WS_W + W_MLP2), M, D, FF, FF, FF, 0};
            pg8::StaticOrder so; so.init(M, D, G, (int)blockIdx.x);
            pg8::EpiN<FResAdd> E{FResAdd{xres}};
            pg8::gemm_phase<pg8::EpiN<FResAdd>, true>(lds, g, so, E, tidv);
        }
        GSYNC();
    }
    for (int m = gw_k; m < M; m += NGW) {
        int lane2 = tidv; asm volatile("" : "+v"(lane2)); lane2 &= 63;
        f32x4* xr = (f32x4*)(xres + (size_t)m * D) + lane2; const f32x4* gr = (const f32x4*)norm_final + lane2;
        f32x4 v[4]; float s = 0.f;
#pragma unroll
        for (int j = 0; j < 4; ++j) { v[j] = xr[64 * j]; s += (v[j].x * v[j].x + v[j].y * v[j].y) + (v[j].z * v[j].z + v[j].w * v[j].w); }
        const float r = rsqrtf(wave_sum(s) * (1.f / D) + 1e-5f);
#pragma unroll
        for (int j = 0; j < 4; ++j) { const f32x4 gg = gr[64 * j]; xr[64 * j] = v[j] * r * gg; }
    }
}

extern "C" void kernel_launch(void* const* d_in, const int* in_sizes, int n_in, void* d_out, int out_size, void* d_ws, size_t ws_size, hipStream_t stream) {
    static int grid = 0;
    if (grid == 0) {
        if (n_in != 33 || out_size != M * D || ws_size < WS_NEED) { fprintf(stderr, "kernel_launch: unexpected sizes n_in %d out %d ws %zu (need %zu)\n", n_in, out_size, ws_size, (size_t)WS_NEED); grid = -1; return; }
        int dev = 0, cus = 0, per_cu = 0;
        hipGetDevice(&dev);
        hipDeviceGetAttribute(&cus, hipDeviceAttributeMultiprocessorCount, dev);
        if (hipFuncSetAttribute((const void*)fwd_kernel, hipFuncAttributeMaxDynamicSharedMemorySize, LDS_BYTES) != hipSuccess) { fprintf(stderr, "hipFuncSetAttribute failed\n"); grid = -1; return; }
        hipOccupancyMaxActiveBlocksPerMultiprocessor(&per_cu, (const void*)fwd_kernel, NTHREADS, LDS_BYTES);
        if (per_cu < 1) { fprintf(stderr, "occupancy query returned %d\n", per_cu); per_cu = 1; }
        (void)hipGetLastError();
        grid = cus * 1;
    }
    if (grid < 0) return;
    if (hipMemsetAsync((char*)d_ws + WS_BAR, 0, 16384, stream) != hipSuccess) { fprintf(stderr, "hipMemsetAsync of the barrier words failed\n"); return; }
    Params p{};
    for (int i = 0; i < 33; ++i) p.in[i] = (const float*)d_in[i];
    p.out = (float*)d_out; p.ws = (unsigned char*)d_ws;
    void* args[] = {&p};
    hipError_t e = hipLaunchCooperativeKernel((const void*)fwd_kernel, dim3(grid), dim3(NTHREADS), args, LDS_BYTES, stream);
    if (e != hipSuccess) fprintf(stderr, "cooperative launch failed: %s (grid %d)\n", hipGetErrorString(e), grid);
}
```
